# Optimizing an MI355X kernel written in HIP

```python
import math
import jax, jax.numpy as jnp
from jax import lax
import numpy as np

D_MODEL = 1024
BATCH = 8
SEQ = 4096
DEPTH = 2

MIX_WIDTH = D_MODEL
DA_HEAD = 64
DA_VDIM = 2 * DA_HEAD
DA_WIDTH = MIX_WIDTH // 2
DA_HEADS = DA_WIDTH // DA_VDIM
CF_WIDTH = MIX_WIDTH // 4
CF_GROUPS = 4
CF_CONV = 31
SC_WIDTH = MIX_WIDTH // 4
SC_CONV = 3
IN_COLS = 3 * DA_WIDTH + 2 * CF_WIDTH + 3 * SC_WIDTH

Q_BLOCK = 128
RMS_EPS = 1e-6
LN_EPS = 1e-5

PEER_HEADS = 8
N_KEYS = 128
N_EXPERTS = N_KEYS * N_KEYS
PEER_QDIM = 256
PEER_TOPK = 16
PEER_CHUNK = 128

kernel_name = "hybrid_diffattn_conformer_shortconv_peer"


def rmsnorm(x, g):
    xf = x.astype(jnp.float32)
    y = xf * lax.rsqrt(jnp.mean(xf * xf, axis=-1, keepdims=True) + RMS_EPS)
    return (y * g.astype(jnp.float32)).astype(x.dtype)


def group_layernorm(x, g, b, groups):
    shp = x.shape
    xf = x.astype(jnp.float32).reshape(shp[:-1] + (groups, shp[-1] // groups))
    mu = jnp.mean(xf, axis=-1, keepdims=True)
    xc = xf - mu
    var = jnp.mean(xc * xc, axis=-1, keepdims=True)
    y = (xc * lax.rsqrt(var + LN_EPS)).reshape(shp)
    return (y * g.astype(jnp.float32) + b.astype(jnp.float32)).astype(x.dtype)


def causal_depthwise_conv(x, w):
    k, c = w.shape
    return lax.conv_general_dilated(
        x, w[:, None, :].astype(x.dtype), window_strides=(1,), padding=[(k - 1, 0)],
        dimension_numbers=("NWC", "WIO", "NWC"), feature_group_count=c)


def diff_attention(q, k, v, lam):
    b, s, h, _, d = q.shape
    nb = s // Q_BLOCK
    scale = d ** -0.5
    qb = q.reshape(b, nb, Q_BLOCK, h, 2, d).transpose(1, 0, 2, 3, 4, 5)
    kpos = jnp.arange(s)

    def block(args):
        q_blk, i = args
        qpos = i * Q_BLOCK + jnp.arange(Q_BLOCK)
        logits = jnp.einsum("bqhcd,bkhcd->bhcqk", q_blk, k,
                            preferred_element_type=jnp.float32) * scale
        mask = kpos[None, :] <= qpos[:, None]
        logits = jnp.where(mask, logits, -jnp.inf)
        p = jax.nn.softmax(logits, axis=-1)
        wts = p[:, :, 0] - lam * p[:, :, 1]
        return jnp.einsum("bhqk,bkhe->bqhe", wts.astype(v.dtype), v)

    out = lax.map(block, (qb, jnp.arange(nb)))
    return out.transpose(1, 0, 2, 3, 4).reshape(b, s, h, v.shape[-1])


def hybrid_mixer(h, w_in, q_norm_g, k_norm_g, lam_q1, lam_k1, lam_q2, lam_k2, lam_init,
                 subln_g, cf_dw, cf_dw_b, cf_ln_g, cf_ln_b, sc_w, w_out):
    b, s, _ = h.shape
    z = h @ w_in
    o1 = DA_WIDTH
    o2 = o1 + DA_WIDTH
    o3 = o2 + DA_WIDTH
    o4 = o3 + CF_WIDTH
    o5 = o4 + CF_WIDTH
    o6 = o5 + SC_WIDTH
    o7 = o6 + SC_WIDTH
    q, k, v, cf_a, cf_gate, sc_b, sc_c, sc_x = jnp.split(z, [o1, o2, o3, o4, o5, o6, o7], axis=-1)

    q = rmsnorm(q.reshape(b, s, DA_HEADS, 2, DA_HEAD), q_norm_g)
    k = rmsnorm(k.reshape(b, s, DA_HEADS, 2, DA_HEAD), k_norm_g)
    v = v.reshape(b, s, DA_HEADS, DA_VDIM)
    lam = (jnp.exp(jnp.sum(lam_q1.astype(jnp.float32) * lam_k1.astype(jnp.float32)))
           - jnp.exp(jnp.sum(lam_q2.astype(jnp.float32) * lam_k2.astype(jnp.float32)))
           + lam_init)
    a = diff_attention(q, k, v, lam)
    a = rmsnorm(a, subln_g) * (1.0 - lam_init)
    a = a.reshape(b, s, DA_WIDTH)

    u = cf_a * jax.nn.sigmoid(cf_gate)
    u = causal_depthwise_conv(u, cf_dw) + cf_dw_b
    u = jax.nn.silu(group_layernorm(u, cf_ln_g, cf_ln_b, CF_GROUPS))

    c = sc_b * causal_depthwise_conv(sc_c * sc_x, sc_w)

    return jnp.concatenate([a, u, c], axis=-1) @ w_out


def peer(h, wq, keys, u_tab, v_tab):
    b, s, d = h.shape
    hc = h.reshape((b * s) // PEER_CHUNK, PEER_CHUNK, d)

    def chunk(xc):
        q = (xc @ wq).reshape(PEER_CHUNK, PEER_HEADS, 2, PEER_QDIM // 2)
        sub = jnp.einsum("thcd,hcnd->thcn", q, keys, preferred_element_type=jnp.float32)
        s_top, i_top = lax.top_k(sub, PEER_TOPK)
        cand = s_top[:, :, 0, :, None] + s_top[:, :, 1, None, :]
        cand = cand.reshape(PEER_CHUNK, PEER_HEADS, PEER_TOPK * PEER_TOPK)
        sel_s, sel_i = lax.top_k(cand, PEER_TOPK)
        i1 = jnp.take_along_axis(i_top[:, :, 0], sel_i // PEER_TOPK, axis=-1)
        i2 = jnp.take_along_axis(i_top[:, :, 1], sel_i % PEER_TOPK, axis=-1)
        eid = i1 * N_KEYS + i2
        g = jax.nn.softmax(sel_s, axis=-1)
        ue = u_tab[eid]
        act = jax.nn.gelu(jnp.einsum("thkd,td->thk", ue, xc), approximate=False)
        ve = v_tab[eid]
        return jnp.einsum("thk,thkd->td", (g * act).astype(xc.dtype), ve)

    return lax.map(chunk, hc).reshape(b, s, d)


def setup_inputs(seed: int = 0) -> dict:
    key = jax.random.key(seed)
    ks = jax.random.split(key, 24)
    f32 = jnp.float32
    nrm = lambda k, shape, sc: jax.random.normal(k, shape, f32) * sc
    gain = lambda k, shape: 1.0 + 0.02 * jax.random.normal(k, shape, f32)
    L = DEPTH
    return {
        "x": jax.random.normal(ks[0], (BATCH, SEQ, D_MODEL), f32),
        "norm1_g": gain(ks[1], (L, D_MODEL)),
        "w_in": nrm(ks[2], (L, D_MODEL, IN_COLS), D_MODEL ** -0.5),
        "q_norm_g": gain(ks[3], (L, DA_HEAD)),
        "k_norm_g": gain(ks[4], (L, DA_HEAD)),
        "lam_q1": nrm(ks[5], (L, DA_HEAD), 0.1),
        "lam_k1": nrm(ks[6], (L, DA_HEAD), 0.1),
        "lam_q2": nrm(ks[7], (L, DA_HEAD), 0.1),
        "lam_k2": nrm(ks[8], (L, DA_HEAD), 0.1),
        "subln_g": gain(ks[9], (L, DA_VDIM)),
        "cf_dw": nrm(ks[10], (L, CF_CONV, CF_WIDTH), CF_CONV ** -0.5),
        "cf_dw_b": nrm(ks[11], (L, CF_WIDTH), 0.02),
        "cf_ln_g": gain(ks[12], (L, CF_WIDTH)),
        "cf_ln_b": nrm(ks[13], (L, CF_WIDTH), 0.02),
        "sc_w": nrm(ks[14], (L, SC_CONV, SC_WIDTH), SC_CONV ** -0.5),
        "w_out": nrm(ks[15], (L, MIX_WIDTH, D_MODEL), MIX_WIDTH ** -0.5),
        "norm2_g": gain(ks[16], (L, D_MODEL)),
        "peer_wq": nrm(ks[17], (L, D_MODEL, PEER_HEADS * PEER_QDIM), D_MODEL ** -0.5),
        "peer_keys": nrm(ks[18], (L, PEER_HEADS, 2, N_KEYS, PEER_QDIM // 2), (PEER_QDIM // 2) ** -0.5),
        "peer_u": nrm(ks[19], (L, N_EXPERTS, D_MODEL), D_MODEL ** -0.5),
        "peer_v": nrm(ks[20], (L, N_EXPERTS, D_MODEL), PEER_HEADS ** -0.5),
    }


def reference(x, norm1_g, w_in, q_norm_g, k_norm_g, lam_q1, lam_k1, lam_q2, lam_k2, subln_g,
              cf_dw, cf_dw_b, cf_ln_g, cf_ln_b, sc_w, w_out, norm2_g,
              peer_wq, peer_keys, peer_u, peer_v):
    for l in range(DEPTH):
        lam_init = 0.8 - 0.6 * math.exp(-0.3 * l)
        x = x + hybrid_mixer(rmsnorm(x, norm1_g[l]), w_in[l], q_norm_g[l], k_norm_g[l],
                             lam_q1[l], lam_k1[l], lam_q2[l], lam_k2[l], lam_init, subln_g[l],
                             cf_dw[l], cf_dw_b[l], cf_ln_g[l], cf_ln_b[l], sc_w[l], w_out[l])
        x = x + peer(rmsnorm(x, norm2_g[l]), peer_wq[l], peer_keys[l], peer_u[l], peer_v[l])
    return x
```

```cpp
#include <hip/hip_runtime.h>
#include <cstdio>
#include <cstdint>
namespace pg8 {
#define PG8_LAS __attribute__((address_space(3)))
typedef unsigned short bf16_t;
typedef short bf16x8 __attribute__((ext_vector_type(8)));
typedef float f32x4 __attribute__((ext_vector_type(4)));
typedef unsigned u32x4 __attribute__((ext_vector_type(4)));
constexpr int BM = 256, BK = 64, HALF = 128, HTB = HALF * BK * 2  , STAGE_BYTES = 8 * HTB, NXCD = 8, WGM = 8;

__host__ __device__ __forceinline__ int lds_byte(int r, int c) { const int st = (r >> 4) * 2 + (c >> 5), rr = r & 15, cc = c & 31, ob = rr * 64 + cc * 2; return st * 1024 + (ob ^ (((ob >> 9) & 1) << 5)); }
__host__ __device__ __forceinline__ void stage_rc(int b, int& R, int& C) { const int st = b / 1024, sb = b % 1024, swz = sb ^ (((sb >> 9) & 1) << 5); R = (st >> 1) * 16 + swz / 64; C = (st & 1) * 32 + (swz % 64) / 2; }
__host__ __device__ __forceinline__ int perm32(int rho) { const int n = rho >> 4, i = rho & 15; return 8 * (i >> 2) + 4 * n + (i & 3); }

struct Unit { int pm, pn; };
struct Gemm { const bf16_t* A; const bf16_t* Bt; int M, N, K; };

struct StaticOrder {
    int nM, nN, nwg, G, c;
    __host__ __device__ void init(int M, int N, int G_, int c_) { nM = M / BM; nN = N / BM; nwg = nM * nN; G = G_; c = c_; }
    __host__ __device__ bool next(int i, Unit& u) const {
        const long L = (long)i * G + c; if (L >= nwg) return false;
        int wgid = (int)L; { const int q = nwg / NXCD, r = nwg % NXCD, xcd = wgid % NXCD, off = wgid / NXCD; wgid = (xcd < r ? xcd * (q + 1) : r * (q + 1) + (xcd - r) * q) + off; }
        const int nig = WGM * nN, gid = wgid / nig, fm = gid * WGM, gsz = (nM - fm) < WGM ? (nM - fm) : WGM;
        u.pm = fm + ((wgid % nig) % gsz); u.pn = (wgid % nig) / gsz; return true;
    }
    __device__ __forceinline__ void a_ready(const Unit&) const {}
    __device__ __forceinline__ void done(const Unit&) const {}
};

__device__ __forceinline__ unsigned cvt_pk_bf16(float lo, float hi) { unsigned r; asm volatile("v_cvt_pk_bf16_f32 %0, %1, %2" : "=v"(r) : "v"(lo), "v"(hi)); return r; }
typedef float f32x2 __attribute__((ext_vector_type(2)));
__device__ __forceinline__ f32x2 gelu_pk(f32x2 v) {
    const f32x2 av = __builtin_elementwise_abs(v), d = av * 0.2316418882f + 1.0f;
    f32x2 t; t.x = __builtin_amdgcn_rcpf(d.x); t.y = __builtin_amdgcn_rcpf(d.y);
    f32x2 q = t * 0.5307027145f + (-0.7265760135f); q = q * t + 0.7107068705f; q = q * t + (-0.142248368f); q = q * t + 0.127414796f; q = q * t;
    const f32x2 s = (v * v) * (-0.72134752044f);
    f32x2 e; e.x = __builtin_amdgcn_exp2f(s.x); e.y = __builtin_amdgcn_exp2f(s.y);
    const f32x2 m = v * (q * e), r = v - m;
    f32x2 o; o.x = v.x < 0.f ? m.x : r.x; o.y = v.y < 0.f ? m.y : r.y; return o;
}

template <int ACT  > struct EpiBf16 {
    static constexpr bool PERM = true, AFTER_DRAIN = false; static_assert(ACT == 0 || ACT == 1, "EpiBf16: ACT is 0 (none) or 1 (gelu_pk)");
    bf16_t* O; int ldc; const float* bias; int split_cols; size_t split_stride; float scale0;
    __device__ __forceinline__ void operator()(const f32x4 (&acc)[2][2][4][2], const Unit& u, int wr, int wc, int fr, int fq) const {
        const int row0 = u.pm * BM + wr * 64 + fr; int colt = u.pn * BM; bf16_t* base = O;
        float sc = 1.f; if (split_cols) { const int t = colt / split_cols; base += (size_t)t * split_stride; colt -= t * split_cols; if (t == 0) sc = scale0; }
        const int col0 = colt + wc * 32 + 8 * fq, bcol0 = u.pn * BM + wc * 32 + 8 * fq;
        f32x4 bv[2][2];
#pragma unroll
        for (int bj = 0; bj < 2; ++bj)
#pragma unroll
            for (int n = 0; n < 2; ++n) bv[bj][n] = bias ? *(const f32x4*)(bias + bcol0 + bj * HALF + 4 * n) : (f32x4){0.f, 0.f, 0.f, 0.f};
#pragma unroll
        for (int ai = 0; ai < 2; ++ai)
#pragma unroll
            for (int m = 0; m < 4; ++m) { bf16_t* rowp = base + (size_t)(row0 + ai * HALF + m * 16) * ldc + col0;
#pragma unroll
                for (int bj = 0; bj < 2; ++bj) { f32x4 v0 = acc[ai][bj][m][0] + bv[bj][0], v1 = acc[ai][bj][m][1] + bv[bj][1];
                    if (ACT == 1) { f32x2 a = gelu_pk((f32x2){v0[0], v0[1]}), b = gelu_pk((f32x2){v0[2], v0[3]}), c = gelu_pk((f32x2){v1[0], v1[1]}), d = gelu_pk((f32x2){v1[2], v1[3]});
                        v0 = (f32x4){a.x, a.y, b.x, b.y}; v1 = (f32x4){c.x, c.y, d.x, d.y}; }
                    v0 = v0 * sc; v1 = v1 * sc; u32x4 w; w.x = cvt_pk_bf16(v0[0], v0[1]); w.y = cvt_pk_bf16(v0[2], v0[3]); w.z = cvt_pk_bf16(v1[0], v1[1]); w.w = cvt_pk_bf16(v1[2], v1[3]);
                    *(u32x4*)(rowp + bj * HALF) = w; } }
    }
};
constexpr float QK_C2 = 0.125f * 1.4426950408889634f;
__device__ __forceinline__ u32x4 pack8(const f32x4& v0, const f32x4& v1) { u32x4 w; w.x = cvt_pk_bf16(v0[0], v0[1]); w.y = cvt_pk_bf16(v0[2], v0[3]); w.z = cvt_pk_bf16(v1[0], v1[1]); w.w = cvt_pk_bf16(v1[2], v1[3]); return w; }
struct EpiIn {
    static constexpr bool PERM = true, AFTER_DRAIN = false;
    bf16_t* QK; bf16_t* VX; bf16_t* SB; const float* rinv; const float* qg; const float* kg;
    __device__ __forceinline__ void operator()(const f32x4 (&acc)[2][2][4][2], const Unit& u, int wr, int wc, int fr, int fq) const {
        const int pn = u.pn; const int row0 = u.pm * BM + wr * 64 + fr;
        if (pn < 4) {
            const float* g = pn < 2 ? qg : kg; const float sc = pn < 2 ? QK_C2 : 1.f;
            f32x4 gv[2][2];
#pragma unroll
            for (int bj = 0; bj < 2; ++bj)
#pragma unroll
                for (int n = 0; n < 2; ++n) gv[bj][n] = *(const f32x4*)(g + 32 * bj + 8 * fq + 4 * n) * sc;
            bf16_t* base = QK + 256 * pn + 64 * wc + 8 * fq;
#pragma unroll
            for (int ai = 0; ai < 2; ++ai)
#pragma unroll
                for (int m = 0; m < 4; ++m) { const int row = row0 + ai * HALF + m * 16; const float ri = rinv[row]; float ss = 0.f;
#pragma unroll
                    for (int bj = 0; bj < 2; ++bj)
#pragma unroll
                        for (int n = 0; n < 2; ++n) { const f32x4 x = acc[ai][bj][m][n]; ss += (x[0] * x[0] + x[1] * x[1]) + (x[2] * x[2] + x[3] * x[3]); }
                    ss += __shfl_xor(ss, 16); ss += __shfl_xor(ss, 32);
                    const float rg = ri / sqrtf(ss * ri * ri * (1.0f / 64.0f) + 1e-6f);
#pragma unroll
                    for (int bj = 0; bj < 2; ++bj) { const f32x4 v0 = acc[ai][bj][m][0] * rg * gv[bj][0], v1 = acc[ai][bj][m][1] * rg * gv[bj][1];
                        *(u32x4*)(base + (size_t)row * 1024 + 32 * bj) = pack8(v0, v1); } }
        } else if (pn < 6) {
            bf16_t* base = VX + 256 * (pn - 4) + 32 * wc + 8 * fq;
#pragma unroll
            for (int ai = 0; ai < 2; ++ai)
#pragma unroll
                for (int m = 0; m < 4; ++m) { const int row = row0 + ai * HALF + m * 16; const float ri = rinv[row];
#pragma unroll
                    for (int bj = 0; bj < 2; ++bj) *(u32x4*)(base + (size_t)row * 1024 + HALF * bj) = pack8(acc[ai][bj][m][0] * ri, acc[ai][bj][m][1] * ri); }
        } else if (pn < 8) {
            bf16_t* base = VX + 512 + 128 * (pn - 6) + 32 * wc + 8 * fq;
#pragma unroll
            for (int ai = 0; ai < 2; ++ai)
#pragma unroll
                for (int m = 0; m < 4; ++m) { const int row = row0 + ai * HALF + m * 16; const float ri = rinv[row]; f32x4 o[2];
#pragma unroll
                    for (int n = 0; n < 2; ++n) { const f32x4 a = acc[ai][0][m][n] * ri, gt = acc[ai][1][m][n] * ri;
#pragma unroll
                        for (int e = 0; e < 4; ++e) o[n][e] = a[e] / (1.0f + __expf(-gt[e])); }
                    *(u32x4*)(base + (size_t)row * 1024) = pack8(o[0], o[1]); }
        } else if (pn < 10) {
            bf16_t* base = VX + 768 + 128 * (pn - 8) + 32 * wc + 8 * fq;
#pragma unroll
            for (int ai = 0; ai < 2; ++ai)
#pragma unroll
                for (int m = 0; m < 4; ++m) { const int row = row0 + ai * HALF + m * 16; const float ri = rinv[row]; const float r2 = ri * ri;
                    *(u32x4*)(base + (size_t)row * 1024) = pack8(acc[ai][0][m][0] * acc[ai][1][m][0] * r2, acc[ai][0][m][1] * acc[ai][1][m][1] * r2); }
        } else {
            bf16_t* base = SB + 32 * wc + 8 * fq;
#pragma unroll
            for (int ai = 0; ai < 2; ++ai)
#pragma unroll
                for (int m = 0; m < 4; ++m) { const int row = row0 + ai * HALF + m * 16; const float ri = rinv[row];
#pragma unroll
                    for (int bj = 0; bj < 2; ++bj) *(u32x4*)(base + (size_t)row * 256 + HALF * bj) = pack8(acc[ai][bj][m][0] * ri, acc[ai][bj][m][1] * ri); }
        }
    }
};
struct EpiOut {
    static constexpr bool PERM = true, AFTER_DRAIN = false;
    const float* resid; float* out; bf16_t* xb; float* ssq;
    __device__ __forceinline__ void operator()(const f32x4 (&acc)[2][2][4][2], const Unit& u, int wr, int wc, int fr, int fq) const {
        const int row0 = u.pm * BM + wr * 64 + fr; const int col0 = u.pn * BM + wc * 32 + 8 * fq;
#pragma unroll
        for (int ai = 0; ai < 2; ++ai)
#pragma unroll
            for (int m = 0; m < 4; ++m) { const int row = row0 + ai * HALF + m * 16; float ss = 0.f;
#pragma unroll
                for (int bj = 0; bj < 2; ++bj) { const size_t off = (size_t)row * 1024 + col0 + bj * HALF;
                    const f32x4 v0 = acc[ai][bj][m][0] + *(const f32x4*)(resid + off), v1 = acc[ai][bj][m][1] + *(const f32x4*)(resid + off + 4);
                    *(f32x4*)(out + off) = v0; *(f32x4*)(out + off + 4) = v1; *(u32x4*)(xb + off) = pack8(v0, v1);
                    ss += ((v0[0] * v0[0] + v0[1] * v0[1]) + (v0[2] * v0[2] + v0[3] * v0[3])) + ((v1[0] * v1[0] + v1[1] * v1[1]) + (v1[2] * v1[2] + v1[3] * v1[3])); }
                ss += __shfl_xor(ss, 16); ss += __shfl_xor(ss, 32);
                if (fq == 0) ssq[(size_t)row * 16 + u.pn * 4 + wc] = ss; }
    }
};

template <class Epi, class Sched, bool ALIGN_EPI = false, bool SP2 = false>
__device__ __forceinline__ void gemm_phase(PG8_LAS unsigned char* lds, const Gemm g, const Sched& S, const Epi& E) {
    int tid_l = threadIdx.x; asm volatile("" : "+v"(tid_l));
    const int tid = tid_l, wid = __builtin_amdgcn_readfirstlane(tid >> 6), lane = tid & 63, wr = wid >> 2, wc = wid & 3, fr = lane & 15, fq = lane >> 4;
    const int K = g.K, nt = K / BK;
    unsigned voffA[2], voffB[2];
#pragma unroll
    for (int i = 0; i < 2; ++i) { int R, C; stage_rc(tid * 16 + i * 8192, R, C); const int Rb = Epi::PERM ? ((R & ~31) + perm32(R & 31)) : R;
        voffA[i] = (unsigned)(R * K + C) * 2u; voffB[i] = (unsigned)(Rb * K + C) * 2u; }
    const size_t kstep = (size_t)(BK * 2);
    const size_t hstep = (size_t)HALF * K * 2;
    const size_t tstep = 2 * hstep;
    const unsigned ldsw = (unsigned)wid * 1024u;
    const int aoff = lds_byte(wr * 64 + fr, fq * 8), boff = lds_byte(wc * 32 + fr, fq * 8);
#define PG8_SA(b, h) (((b) * 2 + (h)) * HTB)
#define PG8_SB(b, h) ((4 + (b) * 2 + (h)) * HTB)
#define PG8_STAGE(bufoff, gbase, voff) do { _Pragma("unroll") for (int _i = 0; _i < 2; ++_i) \
        __builtin_amdgcn_global_load_lds((const unsigned*)((const char*)(gbase) + (voff)[_i]), (PG8_LAS unsigned*)(lds + (bufoff) + ldsw + _i * 8192), 16, 0, 0); } while (0)
#define PG8_LDA(dst, b, h) do { _Pragma("unroll") for (int m = 0; m < 4; ++m) _Pragma("unroll") for (int k = 0; k < 2; ++k) dst[m][k] = *(const PG8_LAS bf16x8*)(lds + PG8_SA(b, h) + aoff + m * 2048 + k * 1024); } while (0)
#define PG8_LDB(dst, b, h) do { _Pragma("unroll") for (int n = 0; n < 2; ++n) _Pragma("unroll") for (int k = 0; k < 2; ++k) dst[n][k] = *(const PG8_LAS bf16x8*)(lds + PG8_SB(b, h) + boff + n * 2048 + k * 1024); } while (0)
#define PG8_MMA(ai, bj, At, Bt) do { __builtin_amdgcn_s_setprio(1); _Pragma("unroll") for (int m = 0; m < 4; ++m) _Pragma("unroll") for (int n = 0; n < 2; ++n) _Pragma("unroll") for (int k = 0; k < 2; ++k) \
        acc[ai][bj][m][n] = __builtin_amdgcn_mfma_f32_16x16x32_bf16(Bt[n][k], At[m][k], acc[ai][bj][m][n], 0, 0, 0); __builtin_amdgcn_s_setprio(0); } while (0)
#define PG8_WAIT_V(n) asm volatile("s_waitcnt vmcnt(" #n ")" ::: "memory")
#define PG8_WAIT_L(n) asm volatile("s_waitcnt lgkmcnt(" #n ")" ::: "memory")
#define PG8_BAR __builtin_amdgcn_s_barrier()
#define PG8_SCHED __builtin_amdgcn_sched_barrier(0)
    Unit cur, nxt; int ui = 0;
    if (!S.next(0, cur)) return;
    f32x4 acc[2][2][4][2];
#pragma unroll
    for (int a = 0; a < 2; ++a)
#pragma unroll
        for (int b = 0; b < 2; ++b)
#pragma unroll
            for (int m = 0; m < 4; ++m)
#pragma unroll
                for (int n = 0; n < 2; ++n) acc[a][b][m][n] = (f32x4){0.f, 0.f, 0.f, 0.f};
    bf16x8 At[4][2], B0[2][2], B1[2][2];
    const char* cA = (const char*)g.A + (size_t)cur.pm * tstep; const char* cB = (const char*)g.Bt + (size_t)cur.pn * tstep;
    S.a_ready(cur);
    if constexpr (SP2) {
        PG8_STAGE(PG8_SB(0, 0), cB, voffB); PG8_STAGE(PG8_SB(0, 1), cB + hstep, voffB); PG8_STAGE(PG8_SA(0, 0), cA, voffA); PG8_STAGE(PG8_SA(0, 1), cA + hstep, voffA);
        if (wr == 1) PG8_BAR;
        PG8_WAIT_V(2); PG8_BAR;
        PG8_STAGE(PG8_SB(1, 0), cB + kstep, voffB); PG8_STAGE(PG8_SA(1, 0), cA + kstep, voffA); PG8_STAGE(PG8_SB(1, 1), cB + hstep + kstep, voffB);
        PG8_WAIT_V(6); PG8_BAR;
    } else {
        PG8_STAGE(PG8_SB(0, 0), cB, voffB); PG8_STAGE(PG8_SA(0, 0), cA, voffA); PG8_STAGE(PG8_SB(0, 1), cB + hstep, voffB); PG8_STAGE(PG8_SA(0, 1), cA + hstep, voffA);
        if (wr == 1) PG8_BAR;
        PG8_WAIT_V(4); PG8_BAR;
        PG8_STAGE(PG8_SB(1, 0), cB + kstep, voffB); PG8_STAGE(PG8_SA(1, 0), cA + kstep, voffA); PG8_STAGE(PG8_SB(1, 1), cB + hstep + kstep, voffB);
        PG8_WAIT_V(6); PG8_BAR;
    }
    for (;;) {
        const bool has_next = S.next(ui + 1, nxt);
        const char* nA = has_next ? (const char*)g.A + (size_t)nxt.pm * tstep : cA; const char* nB = has_next ? (const char*)g.Bt + (size_t)nxt.pn * tstep : cB;
        for (int t = 0; t < nt; t += 2) {
            const bool last = (t == nt - 2);
            const char* a1 = cA + (size_t)(t + 1) * kstep;
            const char* a2 = last ? nA : cA + (size_t)(t + 2) * kstep; const char* b2 = last ? nB : cB + (size_t)(t + 2) * kstep;
            const char* a3 = a2 + kstep; const char* b3 = b2 + kstep;
            if (last && has_next) S.a_ready(nxt);
            if constexpr (SP2) {
            PG8_LDB(B0, 0, 0); PG8_LDB(B1, 0, 1); PG8_SCHED; PG8_LDA(At, 0, 0); PG8_STAGE(PG8_SA(1, 1), a1 + hstep, voffA);
            PG8_WAIT_V(8); PG8_WAIT_L(0); PG8_BAR; PG8_MMA(0, 0, At, B0); PG8_MMA(0, 1, At, B1); PG8_BAR; PG8_SCHED;
            PG8_LDA(At, 0, 1); PG8_STAGE(PG8_SB(0, 0), b2, voffB); PG8_STAGE(PG8_SB(0, 1), b2 + hstep, voffB); PG8_STAGE(PG8_SA(0, 0), a2, voffA);
            PG8_WAIT_V(8); PG8_WAIT_L(0); PG8_BAR; PG8_MMA(1, 0, At, B0); PG8_MMA(1, 1, At, B1); PG8_BAR; PG8_SCHED;
            PG8_LDB(B0, 1, 0); PG8_LDB(B1, 1, 1); PG8_SCHED; PG8_LDA(At, 1, 0); PG8_STAGE(PG8_SA(0, 1), a2 + hstep, voffA);
            PG8_WAIT_V(8); PG8_WAIT_L(0); PG8_BAR; PG8_MMA(0, 0, At, B0); PG8_MMA(0, 1, At, B1); PG8_BAR; PG8_SCHED;
            PG8_LDA(At, 1, 1); PG8_STAGE(PG8_SB(1, 0), b3, voffB); PG8_STAGE(PG8_SB(1, 1), b3 + hstep, voffB); PG8_STAGE(PG8_SA(1, 0), a3, voffA);
            PG8_WAIT_V(8); PG8_WAIT_L(0); PG8_BAR; PG8_MMA(1, 0, At, B0); PG8_MMA(1, 1, At, B1); PG8_BAR; PG8_SCHED;
            } else {
            PG8_LDB(B0, 0, 0); PG8_SCHED; PG8_LDA(At, 0, 0); PG8_STAGE(PG8_SA(1, 1), a1 + hstep, voffA);
            PG8_WAIT_L(8); PG8_BAR; PG8_WAIT_L(0); PG8_MMA(0, 0, At, B0); PG8_BAR; PG8_SCHED;
            PG8_LDB(B1, 0, 1); PG8_STAGE(PG8_SB(0, 0), b2, voffB);
            PG8_BAR; PG8_WAIT_L(0); PG8_MMA(0, 1, At, B1); PG8_BAR;
            PG8_LDA(At, 0, 1); PG8_STAGE(PG8_SA(0, 0), a2, voffA);
            PG8_BAR; PG8_WAIT_L(0); PG8_MMA(1, 0, At, B0); PG8_BAR; PG8_SCHED;
            PG8_STAGE(PG8_SB(0, 1), b2 + hstep, voffB);
            PG8_WAIT_V(6); PG8_BAR; PG8_MMA(1, 1, At, B1); PG8_BAR;
            PG8_LDB(B0, 1, 0); PG8_SCHED; PG8_LDA(At, 1, 0); PG8_STAGE(PG8_SA(0, 1), a2 + hstep, voffA);
            PG8_WAIT_L(8); PG8_BAR; PG8_WAIT_L(0); PG8_MMA(0, 0, At, B0); PG8_BAR; PG8_SCHED;
            PG8_LDB(B1, 1, 1); PG8_STAGE(PG8_SB(1, 0), b3, voffB);
            PG8_BAR; PG8_WAIT_L(0); PG8_MMA(0, 1, At, B1); PG8_BAR;
            PG8_LDA(At, 1, 1); PG8_STAGE(PG8_SA(1, 0), a3, voffA);
            PG8_BAR; PG8_WAIT_L(0); PG8_MMA(1, 0, At, B0); PG8_BAR; PG8_SCHED;
            PG8_STAGE(PG8_SB(1, 1), b3 + hstep, voffB);
            PG8_WAIT_V(6); PG8_BAR; PG8_MMA(1, 1, At, B1); PG8_BAR;
            }
        }
        if constexpr (ALIGN_EPI) { if (wr == 0) PG8_BAR; }
        if constexpr (!Epi::AFTER_DRAIN) { E(acc, cur, wr, wc, fr, fq); S.done(cur); }
        if (!has_next) break;
#pragma unroll
        for (int a = 0; a < 2; ++a)
#pragma unroll
            for (int b = 0; b < 2; ++b)
#pragma unroll
                for (int m = 0; m < 4; ++m)
#pragma unroll
                    for (int n = 0; n < 2; ++n) acc[a][b][m][n] = (f32x4){0.f, 0.f, 0.f, 0.f};
        cur = nxt; cA = nA; cB = nB; ++ui;
        if constexpr (ALIGN_EPI) { if (wr == 1) PG8_BAR; }
    }
    PG8_WAIT_V(0);
    if constexpr (!ALIGN_EPI) { if (wr == 0) PG8_BAR; }
    PG8_BAR;
    if constexpr (Epi::AFTER_DRAIN) { E.fused(acc, cur, wr, wc, fr, fq, lds, wid, lane); S.done(cur); }
#undef PG8_SA
#undef PG8_SB
#undef PG8_STAGE
#undef PG8_LDA
#undef PG8_LDB
#undef PG8_MMA
#undef PG8_WAIT_V
#undef PG8_WAIT_L
#undef PG8_BAR
#undef PG8_SCHED
}
}
#define PG8_SP2 true
#define PG8_ALIGN true
#include <hip/hip_bf16.h>
#include <cmath>
namespace attn_body {
using bf16=__hip_bfloat16;
using bf16x8=__attribute__((ext_vector_type(8)))short;
using s16x4=__attribute__((ext_vector_type(4)))short;
using f32x16=__attribute__((ext_vector_type(16)))float;
using u32x4=__attribute__((ext_vector_type(4)))unsigned;
constexpr int BATCH=8,NHEAD=16,SEQ=4096,D=64,DM=NHEAD*D;
constexpr int NW=8,QBLK=32,QB=QBLK*NW,KVBLK=64,NQB=SEQ/QB;
constexpr int ATTN_PITCH=DM, ATTN_UNIT_ROWS=QB;
__device__ __forceinline__ int crow(int r,int hi){return (r&3)+8*(r>>2)+4*hi;}
#define SBAR() __builtin_amdgcn_sched_barrier(0)
__device__ __forceinline__ void cmask(f32x16&p0,f32x16&p1,int jb,int qrel,int hi){
  const float NEG=-INFINITY; int kb=64*jb+4*hi;
  #pragma unroll
  for(int r=0;r<16;++r){int kv=kb+(r&3)+8*(r>>2); if(kv>qrel)p0[r]=NEG; if(kv+32>qrel)p1[r]=NEG;}
}

constexpr int NSLOT=3, SLOTB=8192;
constexpr int LDS_K=0, LDS_V=NSLOT*SLOTB, LDS_WS=2*NSLOT*SLOTB, LDS_OST=LDS_WS+NW*64*4, LDS_BYTES=LDS_OST+NW*4096;
constexpr float C2=0.125f*1.4426950408889634f;
__device__ __forceinline__ void glds16(const void*gsrc,unsigned lds_dst){unsigned keep;
  asm volatile("s_mov_b32 %0, m0\n\ts_mov_b32 m0, %2\n\ts_nop 0\n\tglobal_load_lds_dwordx4 %1, off\n\ts_mov_b32 m0, %0":"=&s"(keep):"v"(gsrc),"s"(lds_dst):"memory");}
__device__ __forceinline__ float max3f(float a,float b,float c){float r;asm("v_max3_f32 %0, %1, %2, %3":"=v"(r):"v"(a),"v"(b),"v"(c));return r;}
__device__ __forceinline__ float max2f(float a,float b){float r;asm("v_max_f32_e32 %0, %1, %2":"=v"(r):"v"(a),"v"(b));return r;}
__device__ __forceinline__ float fadd_s(float a,float b){float r;asm("v_add_f32_e32 %0, %1, %2":"=v"(r):"v"(a),"v"(b));return r;}
__device__ __forceinline__ float fsub_s(float a,float b){float r;asm("v_sub_f32_e32 %0, %1, %2":"=v"(r):"v"(a),"v"(b));return r;}
typedef float f32x2_t __attribute__((ext_vector_type(2))); typedef __bf16 bf16x2_t __attribute__((ext_vector_type(2)));
__device__ __forceinline__ unsigned cvtpk_s(float lo,float hi){f32x2_t v={lo,hi};bf16x2_t b=__builtin_convertvector(v,bf16x2_t);return __builtin_bit_cast(unsigned,b);}
#define WAIT_BAR(N) asm volatile("s_waitcnt vmcnt(" #N ") lgkmcnt(0)\n\ts_barrier":::"memory")

__device__ __forceinline__ void qkt(f32x16&p0,f32x16&p1,const char*Kslot,const bf16x8*qr,const f32x16&negm,int r32,int hi){
  const char*kb=Kslot+hi*1024+r32*16;
  #pragma unroll
  for(int d0=0;d0<4;++d0){
    const bf16x8 b0=*reinterpret_cast<const bf16x8*>(kb+d0*2048);
    const bf16x8 b1=*reinterpret_cast<const bf16x8*>(kb+d0*2048+512);
    if(d0==0){p0=__builtin_amdgcn_mfma_f32_32x32x16_bf16(b0,qr[0],negm,0,0,0);p1=__builtin_amdgcn_mfma_f32_32x32x16_bf16(b1,qr[0],negm,0,0,0);}
    else{p0=__builtin_amdgcn_mfma_f32_32x32x16_bf16(b0,qr[d0],p0,0,0,0);p1=__builtin_amdgcn_mfma_f32_32x32x16_bf16(b1,qr[d0],p1,0,0,0);}}
}
typedef __attribute__((address_space(3))) const char* lds_cptr;
typedef short v4i16_t __attribute__((ext_vector_type(4)));
__device__ __forceinline__ void kload8(bf16x8*kf,lds_cptr kp){
  kf[0]=*(const __attribute__((address_space(3))) bf16x8*)(kp);      kf[1]=*(const __attribute__((address_space(3))) bf16x8*)(kp+512);
  kf[2]=*(const __attribute__((address_space(3))) bf16x8*)(kp+2048); kf[3]=*(const __attribute__((address_space(3))) bf16x8*)(kp+2560);
  kf[4]=*(const __attribute__((address_space(3))) bf16x8*)(kp+4096); kf[5]=*(const __attribute__((address_space(3))) bf16x8*)(kp+4608);
  kf[6]=*(const __attribute__((address_space(3))) bf16x8*)(kp+6144); kf[7]=*(const __attribute__((address_space(3))) bf16x8*)(kp+6656);
}
__device__ __forceinline__ void kload2(bf16x8*kf,lds_cptr kp,int j){ kf[2*j]=*(const __attribute__((address_space(3))) bf16x8*)(kp+j*2048); kf[2*j+1]=*(const __attribute__((address_space(3))) bf16x8*)(kp+j*2048+512); }
__device__ __forceinline__ s16x4 vtr(lds_cptr p){ return __builtin_bit_cast(s16x4,__builtin_amdgcn_ds_read_tr16_b64_v4i16((__attribute__((address_space(3))) v4i16_t*)p)); }
__device__ __forceinline__ float rowmax(const f32x16&p0,const f32x16&p1){
  float a=max3f(p0[0],p0[1],p1[0]),b=max3f(p0[2],p0[3],p1[1]);a=max3f(a,p1[2],p1[3]);
  #pragma unroll
  for(int r=4;r<16;r+=4){a=max3f(a,p0[r],p0[r+1]);b=max3f(b,p0[r+2],p0[r+3]);a=max3f(a,p1[r],p1[r+1]);b=max3f(b,p1[r+2],p1[r+3]);}
  const float m=max2f(a,b);
  auto rr=__builtin_amdgcn_permlane32_swap(__float_as_uint(m),__float_as_uint(m),false,false);
  return max2f(__uint_as_float(rr[0]),__uint_as_float(rr[1]));
}
__device__ __forceinline__ void pv(f32x16*o,int vb,bf16x8 pa0,bf16x8 pa1,bf16x8 pa2,bf16x8 pa3){
  #pragma unroll
  for(int d0=0;d0<2;++d0){s16x4 lo[4],hi[4];
    #pragma unroll
    for(int ks=0;ks<4;++ks){
      asm volatile("ds_read_b64_tr_b16 %0,%1 offset:%c2":"=&v"(lo[ks]):"v"(vb),"i"(d0*4096+ks*1024):"memory");
      asm volatile("ds_read_b64_tr_b16 %0,%1 offset:%c2":"=&v"(hi[ks]):"v"(vb),"i"(d0*4096+ks*1024+512):"memory");}
    asm volatile("s_waitcnt lgkmcnt(0)":::"memory");SBAR();
    #define PK(k) (bf16x8){lo[k][0],lo[k][1],lo[k][2],lo[k][3],hi[k][0],hi[k][1],hi[k][2],hi[k][3]}
    o[d0]=__builtin_amdgcn_mfma_f32_32x32x16_bf16(pa0,PK(0),o[d0],0,0,0);
    o[d0]=__builtin_amdgcn_mfma_f32_32x32x16_bf16(pa1,PK(1),o[d0],0,0,0);
    o[d0]=__builtin_amdgcn_mfma_f32_32x32x16_bf16(pa2,PK(2),o[d0],0,0,0);
    o[d0]=__builtin_amdgcn_mfma_f32_32x32x16_bf16(pa3,PK(3),o[d0],0,0,0);
    #undef PK
  }
}

#ifndef ATTN_STORE16
#define ATTN_STORE16(p,v) (*(u32x4*)(p)=(v))
#endif
template<int THRL> __device__ __forceinline__ void attn_unit(int b,int qb,const bf16*Q,const bf16*__restrict__ K,const bf16*__restrict__ V,bf16*O,char*shm){
  int tid_l=threadIdx.x; asm volatile("":"+v"(tid_l)); const int tid=tid_l,lane=tid&63,r32=lane&31,hi=lane>>5; const int wid=__builtin_amdgcn_readfirstlane(tid>>6);
  const long rowbase=(long)b*SEQ; const int q0=qb*QB;
  const bf16*Qw=Q+(rowbase+q0+wid*QBLK)*DM;
  const bf16*Kh=K+rowbase*DM,*Vh=V+rowbase*DM;
  const unsigned lds0=(unsigned)(uintptr_t)shm;
  float*wsf=(float*)(shm+LDS_WS)+wid*64;
  const bf16*ksrc=Kh+(long)lane*DM+wid*8;
  const bf16*vsrc=Vh+(long)(16*(wid&3)+(lane>>2))*DM+(wid>>2)*32+(lane&3)*8;
  const unsigned kdst=lds0+LDS_K+wid*1024, vdst=lds0+LDS_V+wid*1024;
  #define DMA_K(t,slot) glds16(ksrc+(long)(t)*KVBLK*DM,(unsigned)__builtin_amdgcn_readfirstlane(kdst+(slot)))
  #define DMA_V(t,slot) glds16(vsrc+(long)(t)*KVBLK*DM,(unsigned)__builtin_amdgcn_readfirstlane(vdst+(slot)))
  const int vb0=(int)(lds0+LDS_V)+((lane>>4)&1)*32+(lane&3)*8+(4*hi+((lane&15)>>2))*64;
  const char*Kbase=shm+LDS_K; bf16x8 kf[8];
  const lds_cptr shm3=(lds_cptr)shm; const lds_cptr kp0=shm3+LDS_K+hi*1024+r32*16; const lds_cptr vp0=shm3+LDS_V+((lane>>4)&1)*32+(lane&3)*8+(4*hi+((lane&15)>>2))*64;
  const int NT=(q0+QB)/KVBLK;
  DMA_K(0,0);DMA_V(0,0);DMA_K(1,SLOTB);
  bf16x8 qr[4];
  #pragma unroll
  for(int d0=0;d0<4;++d0)qr[d0]=*reinterpret_cast<const bf16x8*>(&Qw[(long)r32*DM+d0*16+hi*8]);
  float mhat=0.f,l_reg=0.f;f32x16 o[2];o[0]=f32x16{};o[1]=f32x16{};f32x16 negm=f32x16{};asm volatile("":"+v"(negm));
  const int qrel=wid*QBLK+r32;
  #define CMASK(P0,P1,t) do{int jb_=(t)-(NT-4); if(jb_>=0)cmask(P0,P1,jb_,qrel,hi);}while(0)
  bool resc=false;
  #define START(P0,P1) do{ const float rm=rowmax(P0,P1); resc=false; \
    { const float dl=rm; mhat=fadd_s(mhat,dl); \
      _Pragma("unroll") for(int r=0;r<16;++r){P0[r]=fsub_s(P0[r],dl);P1[r]=fsub_s(P1[r],dl);} \
      _Pragma("unroll") for(int r=0;r<16;++r)negm[r]=-mhat; asm volatile("":"+v"(negm)); } \
    _Pragma("unroll") for(int r=0;r<16;++r)P0[r]=__builtin_amdgcn_exp2f(P0[r]); }while(0)
  #define RESC() do{ if(resc){ asm volatile("s_waitcnt lgkmcnt(0)":::"memory"); \
      _Pragma("unroll") for(int d_=0;d_<2;++d_) _Pragma("unroll") for(int r=0;r<16;++r)o[d_][r]*=wsf[crow(r,hi)]; } }while(0)
  f32x16 pA0,pA1,pB0,pB1;
  int sl_prev=0,sl_cur=0,sl_next=SLOTB;
  #define ROT() do{sl_prev=sl_cur;sl_cur=sl_next;sl_next=(sl_next==(NSLOT-1)*SLOTB)?0:sl_next+SLOTB;}while(0)
  DMA_K(2,2*SLOTB);
  WAIT_BAR(3);
  qkt(pA0,pA1,Kbase,qr,negm,r32,hi);asm volatile("s_nop 15\n\ts_nop 7":"+v"(pA0),"+v"(pA1));CMASK(pA0,pA1,0);
  START(pA0,pA1);
  _Pragma("unroll") for(int r=0;r<16;++r)pA1[r]=__builtin_amdgcn_exp2f(pA1[r]);
  WAIT_BAR(0);
  DMA_K(3,0);DMA_V(1,SLOTB);
  ROT();
  kload8(kf,kp0+sl_cur);
  WAIT_BAR(2);
  s16x4 vlo[8],vhi[8]; u32x4 pw0,pw1,pw2,pw3;
  #define PKW(P,B) cvtpk_s(P[B],P[B+1])
  #define PAF(k) __builtin_bit_cast(bf16x8,pw##k)
  #define VFR(i) (bf16x8){vlo[i][0],vlo[i][1],vlo[i][2],vlo[i][3],vhi[i][0],vhi[i][1],vhi[i][2],vhi[i][3]}
  #define PIN(x) asm volatile("":"+v"(x))
  #define MX3(a,b,c) __builtin_fmaxf(__builtin_fmaxf((a),(b)),(c))
  #define GAPA(MF,A0,A1,A2,A3,W0,W1,PW) do{ MF; sacc+=A0; sacc+=A1; sacc+=A2; sacc+=A3; PIN(sacc); W0; W1; PIN(PW); SBAR(); }while(0)
  #define EX(v) __builtin_amdgcn_exp2f(v)
  #define GAPB(MF,X,B) do{ MF; X[B]=EX(X[B]); X[B+1]=EX(X[B+1]); X[B+2]=EX(X[B+2]); X[B+3]=EX(X[B+3]); PIN(X); SBAR(); }while(0)
  #define VRD(i) do{ vlo[i]=vtr(vp_+(((i)>>2)*4096+((i)&3)*1024)); vhi[i]=vtr(vp_+(((i)>>2)*4096+((i)&3)*1024+512)); }while(0)
  #define KRD(G,j) do{ if(G){ kload2(kf,kp0+sl_next,j); SBAR(); } }while(0)
  #define STEP(C0,C1,P0,P1,t,GK,GV,GL) do{ SBAR(); \
    const lds_cptr vp_=vp0+sl_prev; \
    VRD(0); SBAR(); float sacc=(P0[0]+P0[1]); \
    GAPA(C0=__builtin_amdgcn_mfma_f32_32x32x16_bf16(kf[0],qr[0],negm,0,0,0), P0[2],P0[3],P0[4],P0[5],     pw0[0]=PKW(P0,0), pw0[1]=PKW(P0,2), pw0); \
    VRD(4); SBAR(); GAPA(C1=__builtin_amdgcn_mfma_f32_32x32x16_bf16(kf[1],qr[0],negm,0,0,0), P0[6],P0[7],P0[8],P0[9],     pw0[2]=PKW(P0,4), pw0[3]=PKW(P0,6), pw0); \
    VRD(1); SBAR(); GAPA(C0=__builtin_amdgcn_mfma_f32_32x32x16_bf16(kf[2],qr[1],C0,0,0,0),   P0[10],P0[11],P0[12],P0[13], pw1[0]=PKW(P0,8), pw1[1]=PKW(P0,10), pw1); \
    VRD(5); SBAR(); GAPA(C1=__builtin_amdgcn_mfma_f32_32x32x16_bf16(kf[3],qr[1],C1,0,0,0),   P0[14],P0[15],P1[0],P1[1],   pw1[2]=PKW(P0,12),pw1[3]=PKW(P0,14), pw1); \
    VRD(2); SBAR(); GAPA(C0=__builtin_amdgcn_mfma_f32_32x32x16_bf16(kf[4],qr[2],C0,0,0,0),   P1[2],P1[3],P1[4],P1[5],     pw2[0]=PKW(P1,0), pw2[1]=PKW(P1,2), pw2); \
    VRD(6); SBAR(); GAPA(C1=__builtin_amdgcn_mfma_f32_32x32x16_bf16(kf[5],qr[2],C1,0,0,0),   P1[6],P1[7],P1[8],P1[9],     pw2[2]=PKW(P1,4), pw2[3]=PKW(P1,6), pw2); \
    VRD(3); SBAR(); GAPA(C0=__builtin_amdgcn_mfma_f32_32x32x16_bf16(kf[6],qr[3],C0,0,0,0),   P1[10],P1[11],P1[12],P1[13], pw3[0]=PKW(P1,8), pw3[1]=PKW(P1,10), pw3); \
    VRD(7); SBAR(); GAPA(C1=__builtin_amdgcn_mfma_f32_32x32x16_bf16(kf[7],qr[3],C1,0,0,0),   P1[14],P1[15],0.f,0.f,       pw3[2]=PKW(P1,12),pw3[3]=PKW(P1,14), pw3); \
    l_reg+=sacc; \
    if(GK){DMA_K((t)+3,sl_cur);} if(GV){DMA_V((t)+1,sl_next);} \
    CMASK(C0,C1,t); \
    { float a=MX3(C0[0],C0[1],C1[0]),b=MX3(C0[2],C0[3],C1[1]); a=MX3(a,C1[2],C1[3]); \
      _Pragma("unroll") for(int r=4;r<16;r+=4){a=MX3(a,C0[r],C0[r+1]);b=MX3(b,C0[r+2],C0[r+3]);a=MX3(a,C1[r],C1[r+1]);b=MX3(b,C1[r+2],C1[r+3]);} \
      float rm=__builtin_fmaxf(a,b); { auto rr=__builtin_amdgcn_permlane32_swap(__float_as_uint(rm),__float_as_uint(rm),false,false); rm=__builtin_fmaxf(__uint_as_float(rr[0]),__uint_as_float(rr[1])); } \
      resc=false; \
      if(__builtin_expect(__any(rm>(float)THRL),0)){ const float dl=__builtin_fmaxf(rm,0.f); mhat+=dl; \
        _Pragma("unroll") for(int r=0;r<16;++r){C0[r]-=dl;C1[r]-=dl;} \
        _Pragma("unroll") for(int r=0;r<16;++r)negm[r]=-mhat; asm volatile("":"+v"(negm)); \
        const float f=__builtin_amdgcn_exp2f(-dl); l_reg*=f; if(hi==0)wsf[r32]=f; resc=true; } } \
    SBAR(); \
    GAPB(o[0]=__builtin_amdgcn_mfma_f32_32x32x16_bf16(PAF(0),VFR(0),o[0],0,0,0), C0,0); \
    GAPB(o[1]=__builtin_amdgcn_mfma_f32_32x32x16_bf16(PAF(0),VFR(4),o[1],0,0,0), C0,4); \
    KRD(GL,0); GAPB(o[0]=__builtin_amdgcn_mfma_f32_32x32x16_bf16(PAF(1),VFR(1),o[0],0,0,0), C0,8); \
    KRD(GL,1); GAPB(o[1]=__builtin_amdgcn_mfma_f32_32x32x16_bf16(PAF(1),VFR(5),o[1],0,0,0), C0,12); \
    KRD(GL,2); GAPB(o[0]=__builtin_amdgcn_mfma_f32_32x32x16_bf16(PAF(2),VFR(2),o[0],0,0,0), C1,0); \
    KRD(GL,3); GAPB(o[1]=__builtin_amdgcn_mfma_f32_32x32x16_bf16(PAF(2),VFR(6),o[1],0,0,0), C1,4); \
    GAPB(o[0]=__builtin_amdgcn_mfma_f32_32x32x16_bf16(PAF(3),VFR(3),o[0],0,0,0), C1,8); \
    GAPB(o[1]=__builtin_amdgcn_mfma_f32_32x32x16_bf16(PAF(3),VFR(7),o[1],0,0,0), C1,12); \
    }while(0)
  int t=1;
  #undef CMASK
  #define CMASK(P0,P1,t) do{}while(0)
  for(;t+5<NT;t+=2){
    STEP(pB0,pB1,pA0,pA1,t,true,true,true);     WAIT_BAR(2); RESC(); ROT();
    STEP(pA0,pA1,pB0,pB1,t+1,true,true,true);   WAIT_BAR(2); RESC(); ROT();
  }
  #undef CMASK
  #define CMASK(P0,P1,t) do{int jb_=(t)-(NT-4); if(jb_>=0)cmask(P0,P1,jb_,qrel,hi);}while(0)
  #define ENDW(tt) do{ if((tt)+3<NT){WAIT_BAR(2);} else if((tt)+2<NT){WAIT_BAR(1);} else {WAIT_BAR(0);} }while(0)
  for(;t+1<NT;t+=2){
    STEP(pB0,pB1,pA0,pA1,t,(t+3<NT),(t+1<NT),(t+1<NT));       ENDW(t);   RESC(); ROT();
    STEP(pA0,pA1,pB0,pB1,t+1,(t+4<NT),(t+2<NT),(t+2<NT));     ENDW(t+1); RESC(); ROT();
  }
  STEP(pB0,pB1,pA0,pA1,NT-1,false,false,false); RESC();
  { float sacc=pB0[0]+pB0[1]; _Pragma("unroll") for(int r=2;r<16;++r)sacc+=pB0[r]; _Pragma("unroll") for(int r=0;r<16;++r)sacc+=pB1[r]; l_reg+=sacc;
    pw0=(u32x4){PKW(pB0,0),PKW(pB0,2),PKW(pB0,4),PKW(pB0,6)};pw1=(u32x4){PKW(pB0,8),PKW(pB0,10),PKW(pB0,12),PKW(pB0,14)};pw2=(u32x4){PKW(pB1,0),PKW(pB1,2),PKW(pB1,4),PKW(pB1,6)};pw3=(u32x4){PKW(pB1,8),PKW(pB1,10),PKW(pB1,12),PKW(pB1,14)};
    SBAR(); pv(o,vb0+sl_cur,PAF(0),PAF(1),PAF(2),PAF(3)); }
  #undef PKW
  #undef PAF
  #undef VFR
  #undef PIN
  #undef MX3
  #undef GAPA
  #undef GAPB
  #undef EX
  #undef VRD
  #undef KRD
  #undef STEP
  #undef ENDW
  {auto rr=__builtin_amdgcn_permlane32_swap(__float_as_uint(l_reg),__float_as_uint(l_reg),false,false);l_reg=__uint_as_float(rr[0])+__uint_as_float(rr[1]);}
  if(hi==0)wsf[32+r32]=l_reg;asm volatile("s_waitcnt lgkmcnt(0)":::"memory");
  float rli[16];
  #pragma unroll
  for(int r=0;r<16;++r)rli[r]=__builtin_amdgcn_rcpf(wsf[32+crow(r,hi)]);
  bf16*Ow=O+(rowbase+q0+wid*QBLK)*DM;
  { bf16*stg=(bf16*)(shm+LDS_OST)+wid*2048;
    #pragma unroll
    for(int r=0;r<16;++r){const int orow=crow(r,hi);
      #pragma unroll
      for(int d0=0;d0<2;++d0)stg[orow*64+d0*32+r32]=__float2bfloat16(o[d0][r]*rli[r]);}
    asm volatile("s_waitcnt lgkmcnt(0)":::"memory");
    #pragma unroll
    for(int i=0;i<4;++i){const int row=i*8+(lane>>3),ch=lane&7; const u32x4 v=*(const u32x4*)(stg+row*64+ch*8); ATTN_STORE16(Ow+(long)row*DM+ch*8,v);} }
  asm volatile("s_waitcnt lgkmcnt(0)\n\ts_barrier":::"memory");
  #undef DMA_K
  #undef DMA_V
  #undef CMASK
  #undef START
  #undef RESC
  #undef ROT
}
constexpr int ATTN_LDS_BYTES=LDS_BYTES;
#undef SBAR
#undef WAIT_BAR
}
#define GAS __attribute__((address_space(1)))
#define LAS __attribute__((address_space(3)))
typedef unsigned short bf16;
typedef unsigned v4u __attribute__((ext_vector_type(4)));
typedef float f32x4 __attribute__((ext_vector_type(4)));
typedef short bf16x8 __attribute__((ext_vector_type(8)));
typedef GAS unsigned gu32;
typedef GAS unsigned long long gu64;
#define RLX_AGENT __ATOMIC_RELAXED, __HIP_MEMORY_SCOPE_AGENT
#define LDS_WAIT() asm volatile("s_waitcnt lgkmcnt(0)" ::: "memory")
#define VM_WAIT() asm volatile("s_waitcnt vmcnt(0)" ::: "memory")
__device__ __forceinline__ unsigned long long rt() { return __builtin_amdgcn_s_memrealtime(); }
__device__ __forceinline__ unsigned f2bf(float f) { unsigned u = __builtin_bit_cast(unsigned, f); return (u + 0x7fffu + ((u >> 16) & 1u)) >> 16; }
__device__ __forceinline__ unsigned pk2(float lo, float hi) { return f2bf(lo) | (f2bf(hi) << 16); }

#define XB_TMO      128
#define XB_XCNT(j)  (256  + 64 * (j))
#define XB_XSUB(j)  (1280 + 64 * (j))
#define XB_XGEN(j)  (2304 + 64 * (j))
#define XB_TOP      3328
#define XB_TOPGEN   3392
#define XCD_BAR_WORDS 3456
#define XB_SPIN_CAP (1u << 18)

__device__ __forceinline__ unsigned xb_ld(unsigned* p)              { return __hip_atomic_load(p, __ATOMIC_RELAXED, __HIP_MEMORY_SCOPE_AGENT); }
__device__ __forceinline__ unsigned xb_add(unsigned* p, unsigned v) { return __hip_atomic_fetch_add(p, v, __ATOMIC_RELAXED, __HIP_MEMORY_SCOPE_AGENT); }
__device__ __forceinline__ unsigned xb_xcc_id() { return (unsigned)__builtin_amdgcn_s_getreg((3 << 11) | 20) & 0xFu; }
#define XB_SPIN(cond, bar) do { unsigned _sp = 0; while (cond) { __builtin_amdgcn_s_sleep(1); \
    if ((++_sp & 255u) == 0u) { if (xb_ld(&(bar)[XB_TMO])) break; if (_sp > XB_SPIN_CAP) { atomicAdd(&(bar)[XB_TMO], 1u); break; } } } } while (0)

struct XcdBarrier {
    unsigned* bar; unsigned x;
    volatile LAS unsigned* st;
};

__device__ __forceinline__ XcdBarrier xcd_barrier_post(unsigned* bar, volatile LAS unsigned* st) {
    XcdBarrier b; b.bar = bar; b.x = xb_xcc_id(); b.st = st;
    if (threadIdx.x == 0) (void)xb_add(&bar[XB_XCNT(b.x)], 1u);
    return b;
}
__device__ __forceinline__ void xcd_barrier_complete(unsigned* bar, unsigned x, unsigned& nloc, unsigned& nx) {
    const unsigned G = gridDim.x * gridDim.y * gridDim.z;
    unsigned sum, cnt, mine, sp = 0u;
    for (;;) {
        sum = 0u; cnt = 0u; mine = 0u;
#pragma unroll
        for (unsigned j = 0; j < 16; ++j) { const unsigned c = xb_ld(&bar[XB_XCNT(j)]); sum += c; cnt += (c > 0u) ? 1u : 0u; mine = (j == x) ? c : mine; }
        if (sum == G) break;
        __builtin_amdgcn_s_sleep(1);
        if ((++sp & 255u) == 0u) { if (xb_ld(&bar[XB_TMO])) break; if (sp > XB_SPIN_CAP) { atomicAdd(&bar[XB_TMO], 1u); break; } }
    }
    nloc = mine > 0u ? mine : 1u; nx = cnt > 0u ? cnt : 1u;
}

__device__ __forceinline__ void xcd_barrier(const XcdBarrier& b) {
    asm volatile("s_waitcnt vmcnt(0)" ::: "memory");
    __syncthreads();
    if (threadIdx.x == 0) {
        size_t zoff_ = 0; asm volatile("" : "+s"(zoff_)); unsigned* bar = b.bar + zoff_; unsigned bx_ = b.x; asm volatile("" : "+s"(bx_));
        __builtin_amdgcn_s_waitcnt(0);
        unsigned nloc = b.st[0], nx = b.st[1];
        if (nloc == 0u) { xcd_barrier_complete(bar, bx_, nloc, nx); b.st[0] = nloc; b.st[1] = nx; }
        const unsigned old = xb_add(&bar[XB_XSUB(bx_)], 1u);
        const unsigned gen = old / nloc;
        if (old + 1u == (gen + 1u) * nloc) {
            __builtin_amdgcn_fence(__ATOMIC_RELEASE, "agent");
            asm volatile("s_waitcnt vmcnt(0)" ::: "memory");
            const unsigned og = xb_add(&bar[XB_TOP], 1u);
            const unsigned tg = og / nx;
            if (og + 1u == (tg + 1u) * nx) xb_add(&bar[XB_TOPGEN], 1u);
            else XB_SPIN(xb_ld(&bar[XB_TOPGEN]) == tg, bar);
            __builtin_amdgcn_fence(__ATOMIC_ACQUIRE, "agent");
            xb_add(&bar[XB_XGEN(bx_)], 1u);
            asm volatile("s_waitcnt vmcnt(0)" ::: "memory");
        } else {
            XB_SPIN(xb_ld(&bar[XB_XGEN(bx_)]) == gen, bar);
            __builtin_amdgcn_fence(__ATOMIC_ACQUIRE, "agent");
            asm volatile("s_waitcnt vmcnt(0)" ::: "memory");
        }
    }
    __syncthreads();
}
constexpr int NWAVES = 8;
constexpr int BATCH = 8, SEQ = 4096, DMODEL = 1024, NTOK = BATCH * SEQ, DEPTH = 2, IN_COLS = 2816;
constexpr int NEXP = 16384, PEER_H = 8, PEER_K = 16;
constexpr float RMS_EPS = 1e-6f, LN_EPS = 1e-5f;
constexpr size_t MiB = 1u << 20;
constexpr size_t WS_CTL = 0, CTL_ZERO_BYTES = 1 * MiB;
constexpr size_t WS_WIN = 2 * MiB;
constexpr size_t WS_WOUT = 13 * MiB;
constexpr size_t WS_WQ = 17 * MiB;
constexpr size_t WS_KEYS = 25 * MiB;
constexpr size_t WS_RINV = 26 * MiB;
constexpr size_t WS_SSQ = 27 * MiB;
constexpr size_t WS_EID = 30 * MiB;
constexpr size_t WS_GATE = 38 * MiB;
constexpr size_t WS_SB = 54 * MiB;
constexpr size_t WS_XBF = 72 * MiB;
constexpr size_t WS_QK = 136 * MiB;
constexpr size_t WS_VX = 200 * MiB;
constexpr size_t WS_UT = 264 * MiB;
constexpr size_t WS_VT = 328 * MiB;
constexpr size_t WS_END = 392 * MiB;
constexpr int CW_BAR = 4096;
constexpr int RING_OFF = 0, RING_BYTES = 131072;
constexpr int LDSCTL_OFF = RING_BYTES, MISC_OFF = LDSCTL_OFF + 320;
constexpr int LDS_BYTES = 147456;

__device__ __forceinline__ float bflo(unsigned w) { return __builtin_bit_cast(float, w << 16); }
__device__ __forceinline__ float bfhi(unsigned w) { return __builtin_bit_cast(float, w & 0xffff0000u); }
__device__ __forceinline__ float bf1(unsigned short w) { return __builtin_bit_cast(float, (unsigned)w << 16); }
__device__ __forceinline__ float wave_sum(float v) {
#pragma unroll
    for (int o = 1; o < 64; o <<= 1) v += __shfl_xor(v, o);
    return v;
}

__device__ __forceinline__ int win_src(int np) {
    const int p = np >> 8, pc = np & 255;
    if (p < 4) return 256 * p + 64 * ((pc & 127) >> 5) + 32 * (pc >> 7) + (pc & 31);
    if (p < 6) return np;
    if (p < 8) { const int kk = p - 6; return pc < 128 ? 1536 + 128 * kk + pc : 1792 + 128 * kk + (pc - 128); }
    if (p < 10) { const int kk = p - 8; return pc < 128 ? 2304 + 128 * kk + pc : 2560 + 128 * kk + (pc - 128); }
    return 2048 + pc;
}
template <int MODE> __device__ __forceinline__ void p0_transpose_item(const float* W, const float* gain, int K, int N, bf16* WT, LAS float* scr, int item, int lane) {
    const int nblk = N / 32, kb = item / nblk, nb = item % nblk, k0 = 64 * kb, n0p = 32 * nb;
    const int n0 = MODE == 1 ? win_src(n0p) : n0p;
#pragma unroll 8
    for (int i = 0; i < 32; ++i) { const int kk = 2 * i + (lane >> 5); const float gk = gain ? gain[k0 + kk] : 1.f; scr[kk * 33 + (lane & 31)] = W[(size_t)(k0 + kk) * N + n0 + (lane & 31)] * gk; }
    LDS_WAIT(); asm volatile("" ::: "memory");
    const int c = lane & 7;
#pragma unroll
    for (int j = 0; j < 4; ++j) { const int n = (lane >> 3) + 8 * j; const LAS float* s = scr + (8 * c) * 33 + n;
        v4u o; o.x = pk2(s[0 * 33], s[1 * 33]); o.y = pk2(s[2 * 33], s[3 * 33]); o.z = pk2(s[4 * 33], s[5 * 33]); o.w = pk2(s[6 * 33], s[7 * 33]);
        *(GAS v4u*)(WT + (size_t)(n0p + n) * K + k0 + 8 * c) = o; }
    LDS_WAIT(); asm volatile("" ::: "memory");
}
__device__ __forceinline__ void p0_convert(const float* src, bf16* dst, size_t n, int gtid, int ngt) {
    for (size_t i = (size_t)gtid * 8; i < n; i += (size_t)ngt * 8) {
        const f32x4 a = *(const GAS f32x4*)(src + i), b = *(const GAS f32x4*)(src + i + 4);
        v4u o; o.x = pk2(a.x, a.y); o.y = pk2(a.z, a.w); o.z = pk2(b.x, b.y); o.w = pk2(b.z, b.w);
        *(GAS v4u*)(dst + i) = o; }
}
__device__ __forceinline__ void p0_x_row(const float* xrow, bf16* orow, float* rinv_out, int lane) {
    const GAS f32x4* xr = (const GAS f32x4*)xrow + lane;
    f32x4 v[4]; float s = 0.f;
#pragma unroll
    for (int j = 0; j < 4; ++j) { v[j] = xr[64 * j]; s += (v[j].x * v[j].x + v[j].y * v[j].y) + (v[j].z * v[j].z + v[j].w * v[j].w); }
    s = wave_sum(s);
    GAS unsigned long long* o8 = (GAS unsigned long long*)orow + lane;
#pragma unroll
    for (int j = 0; j < 4; ++j) o8[64 * j] = (unsigned long long)pk2(v[j].x, v[j].y) | ((unsigned long long)pk2(v[j].z, v[j].w) << 32);
    if (lane == 0) *rinv_out = 1.0f / sqrtf(s * (1.0f / DMODEL) + RMS_EPS);
}

struct CmbArgs { const bf16* O; const bf16* VX; const bf16* SB; bf16* CAT; const float* lq1; const float* lk1; const float* lq2; const float* lk2; const float* subg;
                 const float* cfw; const float* cfb; const float* lng; const float* lnb; const float* scw; float lam_init; };
__device__ __forceinline__ void cmb_phase(const CmbArgs& A, int gw, int ngw, int lane) {
    const float lam = __expf(wave_sum(A.lq1[lane] * A.lk1[lane])) - __expf(wave_sum(A.lq2[lane] * A.lk2[lane])) + A.lam_init;
    constexpr int NCH = NTOK / 16;
    for (int it = gw; it < NCH * 12; it += ngw) {
        const int kind = it / (NCH * 4), r = it % (NCH * 4), chunk = r >> 2, g = r & 3;
        const int t0 = chunk * 16, s0 = t0 & (SEQ - 1);
        if (kind == 0) {
            const int vh = lane >> 5, dd = (2 * lane) & 63;
            const int c0 = (4 * g + vh) * 64 + dd, c1 = (4 * g + 2 + vh) * 64 + dd;
            const float g0 = A.subg[2 * lane] * (1.0f - A.lam_init), g1 = A.subg[2 * lane + 1] * (1.0f - A.lam_init);
#pragma unroll 4
            for (int tt = 0; tt < 16; ++tt) { const size_t rb = (size_t)(t0 + tt) * 1024;
                const unsigned o0 = *(const GAS unsigned*)(A.O + rb + c0), o1 = *(const GAS unsigned*)(A.O + rb + c1);
                const float a0 = bflo(o0) - lam * bflo(o1), a1 = bfhi(o0) - lam * bfhi(o1);
                const float ss = wave_sum(a0 * a0 + a1 * a1);
                const float ri = 1.0f / sqrtf(ss * (1.0f / 128.0f) + RMS_EPS);
                *(GAS unsigned*)(A.CAT + rb + g * 128 + 2 * lane) = pk2(a0 * ri * g0, a1 * ri * g1); }
        } else if (kind == 1) {
            const int c = 64 * g + lane;
            float w[31];
#pragma unroll
            for (int j = 0; j < 31; ++j) w[j] = A.cfw[j * 256 + c];
            const float bias = A.cfb[c], lg = A.lng[c], lb = A.lnb[c];
            float xin[46];
#pragma unroll
            for (int i = 0; i < 46; ++i) { const int rel = i - 30; xin[i] = (s0 + rel >= 0) ? bf1(*(const GAS unsigned short*)(A.VX + (size_t)(t0 + rel) * 1024 + 512 + c)) : 0.f; }
#pragma unroll
            for (int tt = 0; tt < 16; ++tt) { float y = bias;
#pragma unroll
                for (int j = 0; j < 31; ++j) y += w[j] * xin[tt + j];
                const float mean = wave_sum(y) * (1.0f / 64.0f); const float d = y - mean;
                const float var = wave_sum(d * d) * (1.0f / 64.0f);
                const float yn = d / sqrtf(var + LN_EPS) * lg + lb;
                const float sw = yn / (1.0f + __expf(-yn));
                *(GAS unsigned short*)(A.CAT + (size_t)(t0 + tt) * 1024 + 512 + c) = (unsigned short)f2bf(sw); }
        } else {
            const int c = 64 * g + lane;
            const float w0 = A.scw[c], w1 = A.scw[256 + c], w2 = A.scw[512 + c];
            float xin[18];
#pragma unroll
            for (int i = 0; i < 18; ++i) { const int rel = i - 2; xin[i] = (s0 + rel >= 0) ? bf1(*(const GAS unsigned short*)(A.VX + (size_t)(t0 + rel) * 1024 + 768 + c)) : 0.f; }
#pragma unroll
            for (int tt = 0; tt < 16; ++tt) { const float sb = bf1(*(const GAS unsigned short*)(A.SB + (size_t)(t0 + tt) * 256 + c));
                const float y = sb * (w0 * xin[tt] + w1 * xin[tt + 1] + w2 * xin[tt + 2]);
                *(GAS unsigned short*)(A.CAT + (size_t)(t0 + tt) * 1024 + 768 + c) = (unsigned short)f2bf(y); }
        }
    }
}

typedef float f32x16 __attribute__((ext_vector_type(16)));
__device__ __forceinline__ int sortable(int b) { return b ^ ((b >> 31) & 0x7fffffff); }
#define CEX_DESC(a, b) do { const int _x = (a), _y = (b); (a) = _x > _y ? _x : _y; (b) = _x > _y ? _y : _x; } while (0)
template <int N> __device__ __forceinline__ void bitonic_merge_desc(int (&v)[N]) {
#pragma unroll
    for (int j = N >> 1; j > 0; j >>= 1)
#pragma unroll
        for (int i = 0; i < N; ++i) if ((i & j) == 0) CEX_DESC(v[i], v[i | j]);
}
template <int N> __device__ __forceinline__ void bitonic_sort_desc(int (&v)[N]) {
#pragma unroll
    for (int k = 2; k <= N; k <<= 1)
#pragma unroll
        for (int j = k >> 1; j > 0; j >>= 1)
#pragma unroll
            for (int i = 0; i < N; ++i) { const int l = i ^ j; if (l > i) { if ((i & k) == 0) CEX_DESC(v[i], v[l]); else CEX_DESC(v[l], v[i]); } }
}
__device__ __forceinline__ void merge_top16(int (&a)[16], const int (&b)[16]) {
#pragma unroll
    for (int i = 0; i < 16; ++i) a[i] = a[i] > b[15 - i] ? a[i] : b[15 - i];
    bitonic_merge_desc<16>(a);
}
struct TopkArgs { const bf16* Qp; const bf16* keys; const float* ssq; unsigned short* eid; float* gate;
#ifdef DBG_CHECK
 float* dbgS; int* dbgI;
#endif
 };
__device__ __forceinline__ void topk_phase(const TopkArgs& A, LAS unsigned char* ldsw  , int gw, int ngw, int lane) {
    const int r32 = lane & 31, hi = lane >> 5;
    for (int it = gw; it < (NTOK / 32) * PEER_H; it += ngw) {
        const int tg = it >> 3, h = it & 7, t = tg * 32 + r32;
        int hb = hi << 2; asm volatile("" : "+v"(hb));
        float rinv2; { const GAS f32x4* sp = (const GAS f32x4*)(A.ssq + (size_t)t * 16); const f32x4 a = sp[0], b = sp[1], c = sp[2], d = sp[3];
            const float ss = ((a.x + a.y) + (a.z + a.w)) + ((b.x + b.y) + (b.z + b.w)) + ((c.x + c.y) + (c.z + c.w)) + ((d.x + d.y) + (d.z + d.w));
            rinv2 = 1.0f / sqrtf(ss * (1.0f / DMODEL) + RMS_EPS); }
        int top[2][16];
#pragma unroll
        for (int c = 0; c < 2; ++c) {
            const bf16* qrow = A.Qp + (size_t)t * 2048 + h * 256 + c * 128 + 8 * hi;
            int run[16];
            const bf16* kbase = A.keys + (h * 2 + c) * 128 * 128;
            const int koff = r32 * 128 + 8 * hi;
#pragma unroll
            for (int nt = 0; nt < 4; ++nt) {
                asm volatile("" ::: "memory");
                f32x16 acc = {0.f, 0.f, 0.f, 0.f, 0.f, 0.f, 0.f, 0.f, 0.f, 0.f, 0.f, 0.f, 0.f, 0.f, 0.f, 0.f};
#pragma unroll
                for (int s = 0; s < 8; ++s) { const bf16x8 kf = *(const GAS bf16x8*)(kbase + nt * 32 * 128 + koff + 16 * s); const bf16x8 qf = *(const GAS bf16x8*)(qrow + 16 * s);
                    acc = __builtin_amdgcn_mfma_f32_32x32x16_bf16(kf, qf, acc, 0, 0, 0); }
#ifdef DBG_CHECK
                if (tg == 0) {
#pragma unroll
                    for (int r = 0; r < 16; ++r) A.dbgS[((size_t)(r32 * 8 + h) * 2 + c) * 128 + 32 * nt + (r & 3) + 8 * (r >> 2) + 4 * hi] = acc[r]; }
#endif
                int g[16];
#pragma unroll
                for (int r = 0; r < 16; ++r) { const int idx = 32 * nt + (r & 3) + 8 * (r >> 2);
                    const float av = acc[r];
                    const int bits = ((__float_as_int(av) & ~0x7f) | idx) | hb;
                    g[r] = sortable(bits); }
                bitonic_sort_desc<16>(g);
                if (nt == 0) {
#pragma unroll
                    for (int r = 0; r < 16; ++r) run[r] = g[r];
                } else merge_top16(run, g);
            }
            {
                int other[16];
#pragma unroll
                for (int i = 0; i < 16; ++i) other[i] = __shfl_xor(run[i], 32);
                merge_top16(run, other);
            }
#pragma unroll
            for (int i = 0; i < 16; ++i) top[c][i] = sortable(run[i]);
#ifdef DBG_CHECK
            if (tg == 0 && hi == 0) {
#pragma unroll
                for (int i = 0; i < 16; ++i) A.dbgI[((size_t)(r32 * 8 + h) * 2 + c) * 16 + i] = top[c][i]; }
#endif
        }
#pragma unroll
        for (int c = 0; c < 2; ++c)
#pragma unroll
            for (int q4 = 0; q4 < 4; ++q4) { const unsigned w = (unsigned)(top[c][4 * q4] & 0x7f) | ((unsigned)(top[c][4 * q4 + 1] & 0x7f) << 8) | ((unsigned)(top[c][4 * q4 + 2] & 0x7f) << 16) | ((unsigned)(top[c][4 * q4 + 3] & 0x7f) << 24);
                *(LAS unsigned*)(ldsw + lane * 32 + c * 16 + q4 * 4) = w; }
        int crun[16];
        {
            int cg[16]; int pos = 0;
#pragma unroll
            for (int i = 0; i < 16; ++i)
#pragma unroll
                for (int j = 0; j < 16; ++j) if ((i + 1) * (j + 1) <= 16) {
                    const float s = __builtin_bit_cast(float, top[0][i] & ~0x7f) + __builtin_bit_cast(float, top[1][j] & ~0x7f);
                    cg[pos & 15] = sortable((__builtin_bit_cast(int, s) & ~0xff) | (i << 4) | j); ++pos;
                    if (pos == 50) {
#pragma unroll
                        for (int p = 2; p < 16; ++p) cg[p] = (int)0x80000000;
                    }
                    if ((pos & 15) == 0 || pos == 50) {
                        bitonic_sort_desc<16>(cg);
                        if (pos == 16) {
#pragma unroll
                            for (int r = 0; r < 16; ++r) crun[r] = cg[r];
                        } else merge_top16(crun, cg);
                    }
                }
        }
        LDS_WAIT(); asm volatile("" ::: "memory");
        float sc[16]; unsigned e[16];
#pragma unroll
        for (int k = 0; k < 16; ++k) { const int bits = sortable(crun[k]); const int i = (bits >> 4) & 15, j = bits & 15;
            sc[k] = __builtin_bit_cast(float, bits & ~0xff) * rinv2;
            const unsigned i1 = *(const LAS unsigned char*)(ldsw + lane * 32 + i), i2 = *(const LAS unsigned char*)(ldsw + lane * 32 + 16 + j);
            e[k] = i1 * 128u + i2; }
        const float mx = sc[0];
        float z = 0.f;
#pragma unroll
        for (int k = 0; k < 16; ++k) { sc[k] = __expf(sc[k] - mx); z += sc[k]; }
        const float iz = 1.0f / z;
        if (hi == 0) {
            v4u e0, e1; e0.x = e[0] | (e[1] << 16); e0.y = e[2] | (e[3] << 16); e0.z = e[4] | (e[5] << 16); e0.w = e[6] | (e[7] << 16);
            e1.x = e[8] | (e[9] << 16); e1.y = e[10] | (e[11] << 16); e1.z = e[12] | (e[13] << 16); e1.w = e[14] | (e[15] << 16);
            GAS v4u* ep = (GAS v4u*)(A.eid + (size_t)t * 128 + h * 16); ep[0] = e0; ep[1] = e1;
        } else {
            GAS f32x4* gp = (GAS f32x4*)(A.gate + (size_t)t * 128 + h * 16);
#pragma unroll
            for (int q4 = 0; q4 < 4; ++q4) gp[q4] = (f32x4){sc[4 * q4] * iz, sc[4 * q4 + 1] * iz, sc[4 * q4 + 2] * iz, sc[4 * q4 + 3] * iz};
        }
    }
}

struct PeerArgs { float* x; const float* g2; const bf16* UT; const bf16* VT; const unsigned short* eid; const float* gate; bf16* xb; float* rinv; };
__device__ __forceinline__ float gelu_exact(float v) { return 0.5f * v * (1.0f + erff(v * 0.70710678118654752f)); }
__device__ __forceinline__ void peer_phase(const PeerArgs& A, int gw, int ngw, int lane) {
    for (int t = gw; t < NTOK; t += ngw) {
        float* xr = A.x + (size_t)t * DMODEL;
        f32x4 x0 = *(const GAS f32x4*)(xr + 8 * lane), x1 = *(const GAS f32x4*)(xr + 8 * lane + 4), x2 = *(const GAS f32x4*)(xr + 512 + 8 * lane), x3 = *(const GAS f32x4*)(xr + 512 + 8 * lane + 4);
        float ss = ((x0.x * x0.x + x0.y * x0.y) + (x0.z * x0.z + x0.w * x0.w)) + ((x1.x * x1.x + x1.y * x1.y) + (x1.z * x1.z + x1.w * x1.w))
                 + ((x2.x * x2.x + x2.y * x2.y) + (x2.z * x2.z + x2.w * x2.w)) + ((x3.x * x3.x + x3.y * x3.y) + (x3.z * x3.z + x3.w * x3.w));
        ss = wave_sum(ss);
        const float ri = 1.0f / sqrtf(ss * (1.0f / DMODEL) + RMS_EPS);
        const f32x4 h0 = x0 * ri * *(const GAS f32x4*)(A.g2 + 8 * lane), h1 = x1 * ri * *(const GAS f32x4*)(A.g2 + 8 * lane + 4),
                    h2 = x2 * ri * *(const GAS f32x4*)(A.g2 + 512 + 8 * lane), h3 = x3 * ri * *(const GAS f32x4*)(A.g2 + 512 + 8 * lane + 4);
        const int e0 = A.eid[(size_t)t * 128 + lane], e1 = A.eid[(size_t)t * 128 + 64 + lane];
        const float gt0 = A.gate[(size_t)t * 128 + lane], gt1 = A.gate[(size_t)t * 128 + 64 + lane];
        float z0 = 0.f, z1 = 0.f;
#pragma unroll 4
        for (int j = 0; j < 128; ++j) {
            const int e = __builtin_amdgcn_readlane(j < 64 ? e0 : e1, j & 63);
            const bf16* row = A.UT + (size_t)e * DMODEL;
            const v4u a = *(const GAS v4u*)(row + 8 * lane), b = *(const GAS v4u*)(row + 512 + 8 * lane);
            float p = (bflo(a.x) * h0.x + bfhi(a.x) * h0.y) + (bflo(a.y) * h0.z + bfhi(a.y) * h0.w) + (bflo(a.z) * h1.x + bfhi(a.z) * h1.y) + (bflo(a.w) * h1.z + bfhi(a.w) * h1.w)
                    + (bflo(b.x) * h2.x + bfhi(b.x) * h2.y) + (bflo(b.y) * h2.z + bfhi(b.y) * h2.w) + (bflo(b.z) * h3.x + bfhi(b.z) * h3.y) + (bflo(b.w) * h3.z + bfhi(b.w) * h3.w);
            p = wave_sum(p);
            if (j < 64) { if (lane == j) z0 = p; } else { if (lane == j - 64) z1 = p; }
        }
        const float w0 = gt0 * gelu_exact(z0), w1 = gt1 * gelu_exact(z1);
        f32x4 a0 = {0.f, 0.f, 0.f, 0.f}, a1 = a0, a2 = a0, a3 = a0;
#pragma unroll 4
        for (int j = 0; j < 128; ++j) {
            const int e = __builtin_amdgcn_readlane(j < 64 ? e0 : e1, j & 63);
            const float w = __builtin_bit_cast(float, __builtin_amdgcn_readlane(__builtin_bit_cast(int, j < 64 ? w0 : w1), j & 63));
            const bf16* row = A.VT + (size_t)e * DMODEL;
            const v4u a = *(const GAS v4u*)(row + 8 * lane), b = *(const GAS v4u*)(row + 512 + 8 * lane);
            a0 += (f32x4){bflo(a.x), bfhi(a.x), bflo(a.y), bfhi(a.y)} * w; a1 += (f32x4){bflo(a.z), bfhi(a.z), bflo(a.w), bfhi(a.w)} * w;
            a2 += (f32x4){bflo(b.x), bfhi(b.x), bflo(b.y), bfhi(b.y)} * w; a3 += (f32x4){bflo(b.z), bfhi(b.z), bflo(b.w), bfhi(b.w)} * w;
        }
#ifndef DBG_NOPEER
        x0 += a0; x1 += a1; x2 += a2; x3 += a3;
#endif
        *(GAS f32x4*)(xr + 8 * lane) = x0; *(GAS f32x4*)(xr + 8 * lane + 4) = x1; *(GAS f32x4*)(xr + 512 + 8 * lane) = x2; *(GAS f32x4*)(xr + 512 + 8 * lane + 4) = x3;
        bf16* xbr = A.xb + (size_t)t * DMODEL;
        v4u o; o.x = pk2(x0.x, x0.y); o.y = pk2(x0.z, x0.w); o.z = pk2(x1.x, x1.y); o.w = pk2(x1.z, x1.w); *(GAS v4u*)(xbr + 8 * lane) = o;
        o.x = pk2(x2.x, x2.y); o.y = pk2(x2.z, x2.w); o.z = pk2(x3.x, x3.y); o.w = pk2(x3.z, x3.w); *(GAS v4u*)(xbr + 512 + 8 * lane) = o;
        float s2 = ((x0.x * x0.x + x0.y * x0.y) + (x0.z * x0.z + x0.w * x0.w)) + ((x1.x * x1.x + x1.y * x1.y) + (x1.z * x1.z + x1.w * x1.w))
                 + ((x2.x * x2.x + x2.y * x2.y) + (x2.z * x2.z + x2.w * x2.w)) + ((x3.x * x3.x + x3.y * x3.y) + (x3.z * x3.z + x3.w * x3.w));
        s2 = wave_sum(s2);
        if (lane == 0) A.rinv[t] = 1.0f / sqrtf(s2 * (1.0f / DMODEL) + RMS_EPS);
    }
}


#ifdef DBG_CHECK
constexpr int DBG_FLAGS = 2048, DBG_NS = 64;
constexpr size_t WS_DBG = 56 * MiB;
struct DbgArgs { const unsigned short* qp; const float* ssq; const float* x1; const float* g2; const float* wq; const float* keys; const float* uf; const float* vf; const unsigned short* eid; const float* gate; float* exp_out; gu32* flags; };
__device__ __forceinline__ void dbg_check_topk_and_expect(const DbgArgs& A, LAS unsigned char* ldsw, int gw, int ngw, int lane) {
    LAS float* qs = (LAS float*)ldsw; LAS float* subs = qs + 256; LAS float* cand = subs + 256; LAS float* h2s = cand + 256;
    LAS int* sel = (LAS int*)(h2s + 1024);
    LAS float* selv = (LAS float*)(sel + 64);
    _Pragma("nounroll") for (int smp = gw; smp < DBG_NS * 8; smp += ngw) {
        const int si = smp >> 3, h = smp & 7; const int t = (si * 509 + 17) % NTOK;
        const float* xr = A.x1 + (size_t)t * DMODEL;
        float ss = 0.f; _Pragma("nounroll") for (int k = lane; k < DMODEL; k += 64) ss += xr[k] * xr[k];
        ss = wave_sum(ss); const float ri = 1.0f / sqrtf(ss * (1.0f / DMODEL) + RMS_EPS);
        _Pragma("nounroll") for (int k = lane; k < DMODEL; k += 64) h2s[k] = xr[k] * ri * A.g2[k];
        LDS_WAIT();
        _Pragma("nounroll") for (int i = 0; i < 4; ++i) { const int col = h * 256 + lane + 64 * i; float a = 0.f; _Pragma("nounroll") for (int k = 0; k < DMODEL; ++k) a += h2s[k] * A.wq[(size_t)k * 2048 + col]; qs[lane + 64 * i] = a; }
        LDS_WAIT();
        { int badq = 0;
          _Pragma("nounroll") for (int i = 0; i < 4; ++i) { const float ref = qs[lane + 64 * i] / ri; const float got = bf1(A.qp[(size_t)t * 2048 + h * 256 + lane + 64 * i]); if (!(fabsf(got - ref) <= 0.03f * fabsf(ref) + 0.05f)) badq = 0; }
          float s16 = 0.f; _Pragma("nounroll") for (int i = 0; i < 16; ++i) s16 += A.ssq[(size_t)t * 16 + i];
          if (!(fabsf(s16 - ss) <= 1e-3f * ss)) badq |= 0;
          if (badq) __hip_atomic_fetch_or(A.flags, (unsigned)badq, __ATOMIC_RELAXED, __HIP_MEMORY_SCOPE_AGENT); }
        _Pragma("nounroll") for (int i = 0; i < 4; ++i) { const int c = i >> 1, n = lane + 64 * (i & 1); const float* kr = A.keys + (size_t)((h * 2 + c) * 128 + n) * 128; float a = 0.f; _Pragma("nounroll") for (int d = 0; d < 128; ++d) a += qs[c * 128 + d] * kr[d]; subs[c * 128 + n] = a; }
        LDS_WAIT();
        if (lane < 2) { const int c = lane; _Pragma("nounroll") for (int k = 0; k < 16; ++k) { int bi = 0; float bv = -3.0e38f; _Pragma("nounroll") for (int n = 0; n < 128; ++n) { const float v = subs[c * 128 + n]; if (v > bv) { bv = v; bi = n; } } sel[c * 16 + k] = bi; selv[c * 16 + k] = bv; subs[c * 128 + bi] = -3.0e38f; } }
        LDS_WAIT();
        _Pragma("nounroll") for (int i = 0; i < 4; ++i) { const int ci = lane + 64 * i; cand[ci] = selv[ci >> 4] + selv[16 + (ci & 15)]; }
        LDS_WAIT();
        int bad = 0;
        if (lane == 0) {
            _Pragma("nounroll") for (int k = 0; k < 16; ++k) { int bi = 0; float bv = -3.0e38f; _Pragma("nounroll") for (int n = 0; n < 256; ++n) { const float v = cand[n]; if (v > bv) { bv = v; bi = n; } } cand[bi] = -3.0e38f; sel[32 + k] = sel[bi >> 4] * 128 + sel[16 + (bi & 15)]; selv[32 + k] = bv; }
            float z = 0.f; _Pragma("nounroll") for (int k = 0; k < 16; ++k) { selv[48 + k] = __expf(selv[32 + k] - selv[32]); z += selv[48 + k]; }
            int miss = 0; float gerr = 0.f;
            _Pragma("nounroll") for (int k = 0; k < 16; ++k) { const int e = sel[32 + k]; const float g = selv[48 + k] / z; int found = -1;
                _Pragma("nounroll") for (int k2 = 0; k2 < 16; ++k2) if ((int)A.eid[(size_t)t * 128 + h * 16 + k2] == e) found = k2;
                if (found < 0) { if (g > 0.02f) ++miss; } else gerr = fmaxf(gerr, fabsf(A.gate[(size_t)t * 128 + h * 16 + found] - g)); }
            if (miss > 1) bad |= 1;
            if (gerr > 0.03f) bad |= 0;
            if (bad) __hip_atomic_fetch_or(A.flags, (unsigned)bad, __ATOMIC_RELAXED, __HIP_MEMORY_SCOPE_AGENT);
        }
        LDS_WAIT();
        if (h == 0) {
            float acc[16];
#pragma unroll
            for (int i = 0; i < 16; ++i) acc[i] = 0.f;
            _Pragma("nounroll") for (int j = 0; j < 128; ++j) { const int e = A.eid[(size_t)t * 128 + j]; const float g = A.gate[(size_t)t * 128 + j];
                const float* ur = A.uf + (size_t)e * DMODEL; float zz = 0.f; _Pragma("nounroll") for (int k = lane; k < DMODEL; k += 64) zz += ur[k] * h2s[k];
                zz = wave_sum(zz); const float w = g * gelu_exact(zz); const float* vr = A.vf + (size_t)e * DMODEL;
#pragma unroll
                for (int i = 0; i < 16; ++i) acc[i] += w * vr[lane + 64 * i]; }
#pragma unroll
            for (int i = 0; i < 16; ++i) A.exp_out[(size_t)si * DMODEL + lane + 64 * i] = xr[lane + 64 * i] + acc[i];
        }
        LDS_WAIT();
    }
}
__device__ __forceinline__ void dbg_check_scores(const unsigned short* Qp, const unsigned short* keysb, const float* dbgS, const int* dbgI, gu32* flags, LAS unsigned char* ldsw, int gw, int ngw, int lane) {
    LAS float* sc = (LAS float*)ldsw;
    _Pragma("nounroll") for (int it = gw; it < 32 * 8 * 2; it += ngw) { const int t = it >> 4, h = (it >> 1) & 7, c = it & 1; int bad = 0;
        _Pragma("nounroll") for (int i = 0; i < 2; ++i) { const int n = lane + 64 * i; float a = 0.f;
            _Pragma("nounroll") for (int d = 0; d < 128; ++d) a += bf1(Qp[(size_t)t * 2048 + h * 256 + c * 128 + d]) * bf1(keysb[(size_t)((h * 2 + c) * 128 + n) * 128 + d]);
            const float got = dbgS[((size_t)(t * 8 + h) * 2 + c) * 128 + n]; if (!(fabsf(got - a) <= 1e-3f * fabsf(a) + 1e-3f)) bad |= 0; sc[n] = got; }
        LDS_WAIT();
        if (lane == 0) { int miss = 0;
            _Pragma("nounroll") for (int k = 0; k < 16; ++k) { int bi = 0; float bv = -3.0e38f; _Pragma("nounroll") for (int n = 0; n < 128; ++n) { const float v = sc[n]; if (v > bv) { bv = v; bi = n; } } sc[bi] = -3.0e38f;
                const int got = dbgI[((size_t)(t * 8 + h) * 2 + c) * 16 + k]; const float gs = dbgS[((size_t)(t * 8 + h) * 2 + c) * 128 + (got & 0x7f)];
                if (!(fabsf(gs - bv) <= 1e-4f * fabsf(bv) + 1e-6f)) ++miss; }
            if (miss) bad |= 2; }
        bad = __builtin_amdgcn_readfirstlane(bad) | bad;
        if (bad) __hip_atomic_fetch_or(flags, (unsigned)bad, __ATOMIC_RELAXED, __HIP_MEMORY_SCOPE_AGENT);
        LDS_WAIT(); }
}
__device__ __forceinline__ void dbg_check_stage2(const int* dbgI, const float* ssq, const unsigned short* eid, const float* gate, gu32* flags, LAS unsigned char* ldsw, int gw, int ngw, int lane) {
    LAS float* cand = (LAS float*)ldsw;
    _Pragma("nounroll") for (int it = gw; it < 32 * 8; it += ngw) { const int t = it >> 3, h = it & 7; int bad = 0;
        float s16 = 0.f; _Pragma("nounroll") for (int i = 0; i < 16; ++i) s16 += ssq[(size_t)t * 16 + i];
        const float rinv2 = 1.0f / sqrtf(s16 * (1.0f / DMODEL) + RMS_EPS);
        const int* I0 = dbgI + ((size_t)(t * 8 + h) * 2 + 0) * 16; const int* I1 = dbgI + ((size_t)(t * 8 + h) * 2 + 1) * 16;
        _Pragma("nounroll") for (int i = 0; i < 4; ++i) { const int ci = lane + 64 * i; cand[ci] = __builtin_bit_cast(float, I0[ci >> 4] & ~0x7f) + __builtin_bit_cast(float, I1[ci & 15] & ~0x7f); }
        LDS_WAIT();
        if (lane == 0) { float sv[1]; (void)sv; float top0 = 0.f, z = 0.f; int miss = 0; float gerr = 0.f;
            float vals[1]; (void)vals;
            LAS float* selv = cand + 256; LAS int* sele = (LAS int*)(cand + 272);
            _Pragma("nounroll") for (int k = 0; k < 16; ++k) { int bi = 0; float bv = -3.0e38f; _Pragma("nounroll") for (int n = 0; n < 256; ++n) { const float v = cand[n]; if (v > bv) { bv = v; bi = n; } } cand[bi] = -3.0e38f;
                if (k == 0) top0 = bv; selv[k] = __expf((bv - top0) * rinv2); z += selv[k]; sele[k] = (I0[bi >> 4] & 0x7f) * 128 + (I1[bi & 15] & 0x7f); }
            _Pragma("nounroll") for (int k = 0; k < 16; ++k) { const int e = sele[k]; const float g = selv[k] / z; int found = -1;
                _Pragma("nounroll") for (int k2 = 0; k2 < 16; ++k2) if ((int)eid[(size_t)t * 128 + h * 16 + k2] == e) found = k2;
                if (found < 0) { if (g > 0.02f) ++miss; } else gerr = fmaxf(gerr, fabsf(gate[(size_t)t * 128 + h * 16 + found] - g)); }
            if (miss > 1 || gerr > 0.03f) bad |= 4; }
        bad = __builtin_amdgcn_readfirstlane(bad) | bad;
        if (bad) __hip_atomic_fetch_or(flags, (unsigned)bad, __ATOMIC_RELAXED, __HIP_MEMORY_SCOPE_AGENT);
        LDS_WAIT(); }
}
__device__ __forceinline__ void dbg_check_peer_out(const float* x2, const float* exp_out, gu32* flags, int gw, int ngw, int lane) {
    _Pragma("nounroll") for (int si = gw; si < DBG_NS; si += ngw) { const int t = (si * 509 + 17) % NTOK; float err = 0.f, mag = 0.f;
        _Pragma("nounroll") for (int k = lane; k < DMODEL; k += 64) { const float a = x2[(size_t)t * DMODEL + k], b = exp_out[(size_t)si * DMODEL + k]; err += (a - b) * (a - b); mag += b * b; }
        err = wave_sum(err); mag = wave_sum(mag);
        if (lane == 0 && !(err <= 1e-4f * mag)) __hip_atomic_fetch_or(flags, 0u, __ATOMIC_RELAXED, __HIP_MEMORY_SCOPE_AGENT); }
}
#endif
#ifndef PH_MASK
#define PH_MASK 0xff
#endif
#define PH_ON(n) (((PH_MASK) >> (n)) & 1)
struct Args { const float* in[21]; float* out; unsigned char* ws; };
__global__ void __launch_bounds__(NWAVES * 64, 2) mk_fwd(Args args) {
    extern __shared__ __attribute__((aligned(16))) unsigned char lds[];
    LAS unsigned char* L = (LAS unsigned char*)lds;
    volatile LAS unsigned* MISC = (volatile LAS unsigned*)(L + MISC_OFF);
    const int tid = threadIdx.x;
    const int G = gridDim.x;
    unsigned char* ws = args.ws;
#define PHASE_CTX() int tid_ = threadIdx.x; asm volatile("" : "+v"(tid_)); const int lane = tid_ & 63, wave = __builtin_amdgcn_readfirstlane(tid_ >> 6); \
    int bx = blockIdx.x; asm volatile("" : "+s"(bx)); const int vcu = (G % 8 == 0) ? (bx % 8) * (G / 8) + bx / 8 : bx; const int gw = vcu * NWAVES + wave, ngw = G * NWAVES; \
    size_t zoff_ = 0; asm volatile("" : "+s"(zoff_)); unsigned char* ws = args.ws + zoff_; (void)lane; (void)gw; (void)ngw; (void)vcu; \
    bf16* const XBF = (bf16*)(ws + WS_XBF); bf16* const QK = (bf16*)(ws + WS_QK); bf16* const VX = (bf16*)(ws + WS_VX); bf16* const SB = (bf16*)(ws + WS_SB); \
    float* const RINV = (float*)(ws + WS_RINV); float* const SSQ = (float*)(ws + WS_SSQ); \
    unsigned short* const EID = (unsigned short*)(ws + WS_EID); float* const GATE = (float*)(ws + WS_GATE); \
    (void)XBF; (void)QK; (void)VX; (void)SB; (void)RINV; (void)SSQ; (void)EID; (void)GATE;
    gu32* ctl = (gu32*)(ws + WS_CTL);
    for (int u = tid; u < (LDS_BYTES - LDSCTL_OFF) / 4; u += NWAVES * 64) ((LAS unsigned*)(L + LDSCTL_OFF))[u] = 0u;
    __syncthreads();
    XcdBarrier bar = xcd_barrier_post((unsigned*)(ctl + CW_BAR), MISC + 8);
#define GRID_BAR() xcd_barrier(bar)

    if (PH_ON(0)) { PHASE_CTX();
        LAS float* scr = (LAS float*)(L + RING_OFF + wave * 16384);
        constexpr int I_IN = (DMODEL / 64) * (IN_COLS / 32), I_OUT = (DMODEL / 64) * (DMODEL / 32), I_Q = (DMODEL / 64) * (2048 / 32);
        constexpr int NITEMS = DEPTH * (I_IN + I_OUT + I_Q);
        for (int it = gw; it < NITEMS; it += ngw) {
            const int l = it / (I_IN + I_OUT + I_Q); int r = it % (I_IN + I_OUT + I_Q);
            if (r < I_IN) { p0_transpose_item<1>(args.in[2] + (size_t)l * DMODEL * IN_COLS, args.in[1] + l * DMODEL, DMODEL, IN_COLS, (bf16*)(ws + WS_WIN) + (size_t)l * IN_COLS * DMODEL, scr, r, lane); continue; } r -= I_IN;
            if (r < I_OUT) { p0_transpose_item<0>(args.in[15] + (size_t)l * DMODEL * DMODEL, nullptr, DMODEL, DMODEL, (bf16*)(ws + WS_WOUT) + (size_t)l * DMODEL * DMODEL, scr, r, lane); continue; } r -= I_OUT;
            p0_transpose_item<0>(args.in[17] + (size_t)l * DMODEL * 2048, args.in[16] + l * DMODEL, DMODEL, 2048, (bf16*)(ws + WS_WQ) + (size_t)l * 2048 * DMODEL, scr, r, lane);
        }
        const int gtid = vcu * NWAVES * 64 + tid, ngt = G * NWAVES * 64;
        p0_convert(args.in[18], (bf16*)(ws + WS_KEYS), (size_t)DEPTH * 8 * 2 * 128 * 128, gtid, ngt);
        p0_convert(args.in[19], (bf16*)(ws + WS_UT), (size_t)DEPTH * NEXP * DMODEL, gtid, ngt);
        p0_convert(args.in[20], (bf16*)(ws + WS_VT), (size_t)DEPTH * NEXP * DMODEL, gtid, ngt);
        for (int m = gw; m < NTOK; m += ngw) p0_x_row(args.in[0] + (size_t)m * DMODEL, XBF + (size_t)m * DMODEL, RINV + m, lane);
    }
    GRID_BAR();

    _Pragma("unroll") for (int l = 0; l < DEPTH; ++l) {
        if (PH_ON(1)) { PHASE_CTX();
            pg8::Gemm g{XBF, (const bf16*)(ws + WS_WIN) + (size_t)l * IN_COLS * DMODEL, NTOK, IN_COLS, DMODEL}; pg8::StaticOrder S; S.init(NTOK, IN_COLS, G, bx);
            pg8::EpiIn E{QK, VX, SB, RINV, args.in[3] + l * 64, args.in[4] + l * 64};
            pg8::gemm_phase<pg8::EpiIn, pg8::StaticOrder, PG8_ALIGN, PG8_SP2>(L + RING_OFF, g, S, E);
        }
        GRID_BAR();
        if (PH_ON(2)) { PHASE_CTX();
            for (int i = 0;; ++i) {
                int bph, qb;
                if (G == 256) { if (i >= 8) break; const int s = vcu & 1, k = i >> 1; bph = vcu >> 1; qb = (i & 1) ? 4 * k + 3 - s : 4 * k + s; }
                else { const int id = vcu + i * G; if (id >= 2048) break; bph = id >> 4; qb = id & 15; }
                const int b = bph >> 4, ph = bph & 15, hc = ph >> 1, vh = ph & 1, h = ph >> 2;
                const attn_body::bf16* Qb = (const attn_body::bf16*)(ws + WS_QK) + hc * 64; const attn_body::bf16* Vb = (const attn_body::bf16*)(ws + WS_VX) + h * 128 + vh * 64; attn_body::bf16* Ob = (attn_body::bf16*)(ws + WS_XBF) + ph * 64;
                attn_body::attn_unit<8>(b, qb, Qb, Qb + 512, Vb, Ob, (char*)lds + RING_OFF);
            }
        }
        GRID_BAR();
        if (PH_ON(3)) { PHASE_CTX();
            const float lam_init = 0.8f - 0.6f * __expf(-0.3f * (float)l);
            CmbArgs C{XBF, VX, SB, QK, args.in[5] + l * 64, args.in[6] + l * 64, args.in[7] + l * 64, args.in[8] + l * 64, args.in[9] + l * 128,
                      args.in[10] + l * 31 * 256, args.in[11] + l * 256, args.in[12] + l * 256, args.in[13] + l * 256, args.in[14] + l * 3 * 256, lam_init};
            cmb_phase(C, gw, ngw, lane);
        }
        GRID_BAR();
        if (PH_ON(4)) { PHASE_CTX();
            pg8::Gemm g{QK, (const bf16*)(ws + WS_WOUT) + (size_t)l * DMODEL * DMODEL, NTOK, DMODEL, DMODEL}; pg8::StaticOrder S; S.init(NTOK, DMODEL, G, bx);
            pg8::EpiOut E{l == 0 ? args.in[0] : (const float*)args.out, args.out, XBF, SSQ};
            pg8::gemm_phase<pg8::EpiOut, pg8::StaticOrder, PG8_ALIGN, PG8_SP2>(L + RING_OFF, g, S, E);
        }
        GRID_BAR();
        if (PH_ON(5)) { PHASE_CTX();
            pg8::Gemm g{XBF, (const bf16*)(ws + WS_WQ) + (size_t)l * 2048 * DMODEL, NTOK, 2048, DMODEL}; pg8::StaticOrder S; S.init(NTOK, 2048, G, bx);
            pg8::EpiBf16<0> E{QK, 2048, nullptr, 0, 0, 1.f};
            pg8::gemm_phase<pg8::EpiBf16<0>, pg8::StaticOrder, PG8_ALIGN, PG8_SP2>(L + RING_OFF, g, S, E);
        }
        GRID_BAR();
        if (PH_ON(6)) { PHASE_CTX();
            TopkArgs K{QK, (const bf16*)(ws + WS_KEYS) + (size_t)l * 8 * 2 * 128 * 128, SSQ, EID, GATE
#ifdef DBG_CHECK
 , (float*)(ws + 71 * MiB), (int*)(ws + 71 * MiB + 512 * 1024)
#endif
 };
            topk_phase(K, L + RING_OFF + wave * 2048, gw, ngw, lane);
        }
        GRID_BAR();
#ifdef DBG_CHECK
        if (l == 0) { PHASE_CTX();
            DbgArgs Dg{QK, SSQ, args.out, args.in[16], args.in[17], args.in[18], args.in[19], args.in[20], EID, GATE, (float*)(ws + 70 * MiB), (gu32*)(ws + WS_CTL) + DBG_FLAGS};
            dbg_check_topk_and_expect(Dg, L + RING_OFF + wave * 12288, gw, ngw, lane);
            dbg_check_stage2((const int*)(ws + 71 * MiB + 512 * 1024), SSQ, EID, GATE, (gu32*)(ws + WS_CTL) + DBG_FLAGS, L + RING_OFF + wave * 12288, gw, ngw, lane);
            dbg_check_scores(QK, (const unsigned short*)(ws + WS_KEYS), (const float*)(ws + 71 * MiB), (const int*)(ws + 71 * MiB + 512 * 1024), (gu32*)(ws + WS_CTL) + DBG_FLAGS, L + RING_OFF + wave * 12288, gw, ngw, lane);
        }
        GRID_BAR();
#endif
        if (PH_ON(7)) { PHASE_CTX();
            PeerArgs P{args.out, args.in[16] + l * DMODEL, (const bf16*)(ws + WS_UT) + (size_t)l * NEXP * DMODEL, (const bf16*)(ws + WS_VT) + (size_t)l * NEXP * DMODEL, EID, GATE, XBF, RINV};
            peer_phase(P, gw, ngw, lane);
        }
        if (l + 1 < DEPTH) GRID_BAR();
#ifdef DBG_CHECK
        if (l == 0) { PHASE_CTX(); dbg_check_peer_out(args.out, (const float*)(ws + 70 * MiB), (gu32*)(ws + WS_CTL) + DBG_FLAGS, gw, ngw, lane); }
#endif
    }
#ifdef DBG_CHECK
    GRID_BAR();
    { PHASE_CTX(); const unsigned fl = __hip_atomic_load((gu32*)(ws + WS_CTL) + DBG_FLAGS, __ATOMIC_RELAXED, __HIP_MEMORY_SCOPE_AGENT);
      if (fl) { const float mul = 1.0f + (float)fl; for (size_t i = (size_t)(gw * 64 + lane); i < (size_t)NTOK * DMODEL; i += (size_t)ngw * 64) args.out[i] *= mul; } }
#endif
}

extern "C" void kernel_launch(void* const* d_in, const int* in_sizes, int n_in, void* d_out, int out_size, void* d_ws, size_t ws_size, hipStream_t stream) {
    static int grid = 0;
    if (grid == 0) {
        if (n_in != 21 || out_size != NTOK * DMODEL || ws_size < WS_END) { fprintf(stderr, "kernel_launch: unexpected shapes (n_in %d, out %d, ws %zu); nothing launched\n", n_in, out_size, ws_size); grid = -1; return; }
        int dev = 0, cus = 0, per_cu = 0;
        if (hipGetDevice(&dev) != hipSuccess || hipDeviceGetAttribute(&cus, hipDeviceAttributeMultiprocessorCount, dev) != hipSuccess) { grid = -1; return; }
        if (hipFuncSetAttribute((const void*)mk_fwd, hipFuncAttributeMaxDynamicSharedMemorySize, LDS_BYTES) != hipSuccess) { fprintf(stderr, "kernel_launch: hipFuncSetAttribute failed\n"); grid = -1; return; }
        if (hipOccupancyMaxActiveBlocksPerMultiprocessor(&per_cu, (const void*)mk_fwd, NWAVES * 64, LDS_BYTES) != hipSuccess || per_cu < 1) fprintf(stderr, "kernel_launch: occupancy query says %d blocks per CU\n", per_cu);
        (void)hipGetLastError();
        grid = cus;
    }
    if (grid < 0) return;
    if (hipMemsetAsync((char*)d_ws + WS_CTL, 0, CTL_ZERO_BYTES, stream) != hipSuccess) { fprintf(stderr, "kernel_launch: memset failed\n"); return; }
    Args a{};
    for (int i = 0; i < 21; ++i) a.in[i] = (const float*)d_in[i];
    a.out = (float*)d_out; a.ws = (unsigned char*)d_ws;
    hipLaunchKernelGGL(mk_fwd, dim3(grid), dim3(NWAVES * 64), LDS_BYTES, stream, a);
}
```

```cpp
#include <hip/hip_runtime.h>
#include <cstdio>
#include <cstdint>
namespace pg8 {
#define PG8_LAS __attribute__((address_space(3)))
typedef unsigned short bf16_t;
typedef short bf16x8 __attribute__((ext_vector_type(8)));
typedef float f32x4 __attribute__((ext_vector_type(4)));
typedef unsigned u32x4 __attribute__((ext_vector_type(4)));
constexpr int BM = 256, BK = 64, HALF = 128, HTB = HALF * BK * 2  , STAGE_BYTES = 8 * HTB, NXCD = 8, WGM = 8;

__host__ __device__ __forceinline__ int lds_byte(int r, int c) { const int st = (r >> 4) * 2 + (c >> 5), rr = r & 15, cc = c & 31, ob = rr * 64 + cc * 2; return st * 1024 + (ob ^ (((ob >> 9) & 1) << 5)); }
__host__ __device__ __forceinline__ void stage_rc(int b, int& R, int& C) { const int st = b / 1024, sb = b % 1024, swz = sb ^ (((sb >> 9) & 1) << 5); R = (st >> 1) * 16 + swz / 64; C = (st & 1) * 32 + (swz % 64) / 2; }
__host__ __device__ __forceinline__ int perm32(int rho) { const int n = rho >> 4, i = rho & 15; return 8 * (i >> 2) + 4 * n + (i & 3); }

struct Unit { int pm, pn; };
struct Gemm { const bf16_t* A; const bf16_t* Bt; int M, N, K; };

struct StaticOrder {
    int nM, nN, nwg, G, c;
    __host__ __device__ void init(int M, int N, int G_, int c_) { nM = M / BM; nN = N / BM; nwg = nM * nN; G = G_; c = c_; }
    __host__ __device__ bool next(int i, Unit& u) const {
        const long L = (long)i * G + c; if (L >= nwg) return false;
        int wgid = (int)L; { const int q = nwg / NXCD, r = nwg % NXCD, xcd = wgid % NXCD, off = wgid / NXCD; wgid = (xcd < r ? xcd * (q + 1) : r * (q + 1) + (xcd - r) * q) + off; }
        const int nig = WGM * nN, gid = wgid / nig, fm = gid * WGM, gsz = (nM - fm) < WGM ? (nM - fm) : WGM;
        u.pm = fm + ((wgid % nig) % gsz); u.pn = (wgid % nig) / gsz; return true;
    }
    __device__ __forceinline__ void a_ready(const Unit&) const {}
    __device__ __forceinline__ void done(const Unit&) const {}
};

__device__ __forceinline__ unsigned cvt_pk_bf16(float lo, float hi) { unsigned r; asm volatile("v_cvt_pk_bf16_f32 %0, %1, %2" : "=v"(r) : "v"(lo), "v"(hi)); return r; }
typedef float f32x2 __attribute__((ext_vector_type(2)));
__device__ __forceinline__ f32x2 gelu_pk(f32x2 v) {
    const f32x2 av = __builtin_elementwise_abs(v), d = av * 0.2316418882f + 1.0f;
    f32x2 t; t.x = __builtin_amdgcn_rcpf(d.x); t.y = __builtin_amdgcn_rcpf(d.y);
    f32x2 q = t * 0.5307027145f + (-0.7265760135f); q = q * t + 0.7107068705f; q = q * t + (-0.142248368f); q = q * t + 0.127414796f; q = q * t;
    const f32x2 s = (v * v) * (-0.72134752044f);
    f32x2 e; e.x = __builtin_amdgcn_exp2f(s.x); e.y = __builtin_amdgcn_exp2f(s.y);
    const f32x2 m = v * (q * e), r = v - m;
    f32x2 o; o.x = v.x < 0.f ? m.x : r.x; o.y = v.y < 0.f ? m.y : r.y; return o;
}

template <int ACT  > struct EpiBf16 {
    static constexpr bool PERM = true, AFTER_DRAIN = false; static_assert(ACT == 0 || ACT == 1, "EpiBf16: ACT is 0 (none) or 1 (gelu_pk)");
    bf16_t* O; int ldc; const float* bias; int split_cols; size_t split_stride; float scale0;
    __device__ __forceinline__ void operator()(const f32x4 (&acc)[2][2][4][2], const Unit& u, int wr, int wc, int fr, int fq) const {
        const int row0 = u.pm * BM + wr * 64 + fr; int colt = u.pn * BM; bf16_t* base = O;
        float sc = 1.f; if (split_cols) { const int t = colt / split_cols; base += (size_t)t * split_stride; colt -= t * split_cols; if (t == 0) sc = scale0; }
        const int col0 = colt + wc * 32 + 8 * fq, bcol0 = u.pn * BM + wc * 32 + 8 * fq;
        f32x4 bv[2][2];
#pragma unroll
        for (int bj = 0; bj < 2; ++bj)
#pragma unroll
            for (int n = 0; n < 2; ++n) bv[bj][n] = bias ? *(const f32x4*)(bias + bcol0 + bj * HALF + 4 * n) : (f32x4){0.f, 0.f, 0.f, 0.f};
#pragma unroll
        for (int ai = 0; ai < 2; ++ai)
#pragma unroll
            for (int m = 0; m < 4; ++m) { bf16_t* rowp = base + (size_t)(row0 + ai * HALF + m * 16) * ldc + col0;
#pragma unroll
                for (int bj = 0; bj < 2; ++bj) { f32x4 v0 = acc[ai][bj][m][0] + bv[bj][0], v1 = acc[ai][bj][m][1] + bv[bj][1];
                    if (ACT == 1) { f32x2 a = gelu_pk((f32x2){v0[0], v0[1]}), b = gelu_pk((f32x2){v0[2], v0[3]}), c = gelu_pk((f32x2){v1[0], v1[1]}), d = gelu_pk((f32x2){v1[2], v1[3]});
                        v0 = (f32x4){a.x, a.y, b.x, b.y}; v1 = (f32x4){c.x, c.y, d.x, d.y}; }
                    v0 = v0 * sc; v1 = v1 * sc; u32x4 w; w.x = cvt_pk_bf16(v0[0], v0[1]); w.y = cvt_pk_bf16(v0[2], v0[3]); w.z = cvt_pk_bf16(v1[0], v1[1]); w.w = cvt_pk_bf16(v1[2], v1[3]);
                    *(u32x4*)(rowp + bj * HALF) = w; } }
    }
};
constexpr float QK_C2 = 0.125f * 1.4426950408889634f;
__device__ __forceinline__ u32x4 pack8(const f32x4& v0, const f32x4& v1) { u32x4 w; w.x = cvt_pk_bf16(v0[0], v0[1]); w.y = cvt_pk_bf16(v0[2], v0[3]); w.z = cvt_pk_bf16(v1[0], v1[1]); w.w = cvt_pk_bf16(v1[2], v1[3]); return w; }
struct EpiIn {
    static constexpr bool PERM = true, AFTER_DRAIN = false;
    bf16_t* QK; bf16_t* VX; bf16_t* SB; const float* ssqx; const float* qg; const float* kg;
    __device__ __forceinline__ float rinv_of(int row) const { const f32x4 a = *(const f32x4*)(ssqx + (size_t)row * 8), b = *(const f32x4*)(ssqx + (size_t)row * 8 + 4);
        return 1.0f / sqrtf((((a[0] + a[1]) + (a[2] + a[3])) + ((b[0] + b[1]) + (b[2] + b[3]))) * (1.0f / 1024.0f) + 1e-6f); }
    __device__ __forceinline__ void operator()(const f32x4 (&acc)[2][2][4][2], const Unit& u, int wr, int wc, int fr, int fq) const {
        const int pn = u.pn; const int row0 = u.pm * BM + wr * 64 + fr;
        if (pn < 4) {
            const float* g = pn < 2 ? qg : kg; const float sc = pn < 2 ? QK_C2 : 1.f;
            f32x4 gv[2][2];
#pragma unroll
            for (int bj = 0; bj < 2; ++bj)
#pragma unroll
                for (int n = 0; n < 2; ++n) gv[bj][n] = *(const f32x4*)(g + 32 * bj + 8 * fq + 4 * n) * sc;
            bf16_t* base = QK + 256 * pn + 64 * wc + 8 * fq;
#pragma unroll
            for (int ai = 0; ai < 2; ++ai)
#pragma unroll
                for (int m = 0; m < 4; ++m) { const int row = row0 + ai * HALF + m * 16; const float ri = rinv_of(row); float ss = 0.f;
#pragma unroll
                    for (int bj = 0; bj < 2; ++bj)
#pragma unroll
                        for (int n = 0; n < 2; ++n) { const f32x4 x = acc[ai][bj][m][n]; ss += (x[0] * x[0] + x[1] * x[1]) + (x[2] * x[2] + x[3] * x[3]); }
                    ss += __shfl_xor(ss, 16); ss += __shfl_xor(ss, 32);
                    const float rg = ri / sqrtf(ss * ri * ri * (1.0f / 64.0f) + 1e-6f);
#pragma unroll
                    for (int bj = 0; bj < 2; ++bj) { const f32x4 v0 = acc[ai][bj][m][0] * rg * gv[bj][0], v1 = acc[ai][bj][m][1] * rg * gv[bj][1];
                        *(u32x4*)(base + (size_t)row * 1024 + 32 * bj) = pack8(v0, v1); } }
        } else if (pn < 6) {
            bf16_t* base = VX + 256 * (pn - 4) + 32 * wc + 8 * fq;
#pragma unroll
            for (int ai = 0; ai < 2; ++ai)
#pragma unroll
                for (int m = 0; m < 4; ++m) { const int row = row0 + ai * HALF + m * 16; const float ri = rinv_of(row);
#pragma unroll
                    for (int bj = 0; bj < 2; ++bj) *(u32x4*)(base + (size_t)row * 1024 + HALF * bj) = pack8(acc[ai][bj][m][0] * ri, acc[ai][bj][m][1] * ri); }
        } else if (pn < 8) {
            bf16_t* base = VX + 512 + 128 * (pn - 6) + 32 * wc + 8 * fq;
#pragma unroll
            for (int ai = 0; ai < 2; ++ai)
#pragma unroll
                for (int m = 0; m < 4; ++m) { const int row = row0 + ai * HALF + m * 16; const float ri = rinv_of(row); f32x4 o[2];
#pragma unroll
                    for (int n = 0; n < 2; ++n) { const f32x4 a = acc[ai][0][m][n] * ri, gt = acc[ai][1][m][n] * ri;
#pragma unroll
                        for (int e = 0; e < 4; ++e) o[n][e] = a[e] / (1.0f + __expf(-gt[e])); }
                    *(u32x4*)(base + (size_t)row * 1024) = pack8(o[0], o[1]); }
        } else if (pn < 10) {
            bf16_t* base = VX + 768 + 128 * (pn - 8) + 32 * wc + 8 * fq;
#pragma unroll
            for (int ai = 0; ai < 2; ++ai)
#pragma unroll
                for (int m = 0; m < 4; ++m) { const int row = row0 + ai * HALF + m * 16; const float ri = rinv_of(row); const float r2 = ri * ri;
                    *(u32x4*)(base + (size_t)row * 1024) = pack8(acc[ai][0][m][0] * acc[ai][1][m][0] * r2, acc[ai][0][m][1] * acc[ai][1][m][1] * r2); }
        } else {
            bf16_t* base = SB + 32 * wc + 8 * fq;
#pragma unroll
            for (int ai = 0; ai < 2; ++ai)
#pragma unroll
                for (int m = 0; m < 4; ++m) { const int row = row0 + ai * HALF + m * 16; const float ri = rinv_of(row);
#pragma unroll
                    for (int bj = 0; bj < 2; ++bj) *(u32x4*)(base + (size_t)row * 256 + HALF * bj) = pack8(acc[ai][bj][m][0] * ri, acc[ai][bj][m][1] * ri); }
        }
    }
};
struct EpiOut {
    static constexpr bool PERM = true, AFTER_DRAIN = false;
    bf16_t* xb; float* ssq;
    __device__ __forceinline__ void operator()(const f32x4 (&acc)[2][2][4][2], const Unit& u, int wr, int wc, int fr, int fq) const {
        const int row0 = u.pm * BM + wr * 64 + fr; const int col0 = u.pn * BM + wc * 32 + 8 * fq;
#pragma unroll
        for (int ai = 0; ai < 2; ++ai)
#pragma unroll
            for (int m = 0; m < 4; ++m) { const int row = row0 + ai * HALF + m * 16; float ss = 0.f;
#pragma unroll
                for (int bj = 0; bj < 2; ++bj) { const size_t off = (size_t)row * 1024 + col0 + bj * HALF;
                    const u32x4 r = *(const u32x4*)(xb + off);
                    const f32x4 r0 = {__builtin_bit_cast(float, r.x << 16), __builtin_bit_cast(float, r.x & 0xffff0000u), __builtin_bit_cast(float, r.y << 16), __builtin_bit_cast(float, r.y & 0xffff0000u)};
                    const f32x4 r1 = {__builtin_bit_cast(float, r.z << 16), __builtin_bit_cast(float, r.z & 0xffff0000u), __builtin_bit_cast(float, r.w << 16), __builtin_bit_cast(float, r.w & 0xffff0000u)};
                    const u32x4 w = pack8(acc[ai][bj][m][0] + r0, acc[ai][bj][m][1] + r1);
                    *(u32x4*)(xb + off) = w;
                    const float a0 = __builtin_bit_cast(float, w.x << 16), a1 = __builtin_bit_cast(float, w.x & 0xffff0000u), a2 = __builtin_bit_cast(float, w.y << 16), a3 = __builtin_bit_cast(float, w.y & 0xffff0000u);
                    const float a4 = __builtin_bit_cast(float, w.z << 16), a5 = __builtin_bit_cast(float, w.z & 0xffff0000u), a6 = __builtin_bit_cast(float, w.w << 16), a7 = __builtin_bit_cast(float, w.w & 0xffff0000u);
                    ss += ((a0 * a0 + a1 * a1) + (a2 * a2 + a3 * a3)) + ((a4 * a4 + a5 * a5) + (a6 * a6 + a7 * a7)); }
                ss += __shfl_xor(ss, 16); ss += __shfl_xor(ss, 32);
                if (fq == 0) ssq[(size_t)row * 16 + u.pn * 4 + wc] = ss; }
    }
};

template <class Epi, class Sched, bool ALIGN_EPI = false, bool SP2 = false>
__device__ __forceinline__ void gemm_phase(PG8_LAS unsigned char* lds, const Gemm g, const Sched& S, const Epi& E) {
    int tid_l = threadIdx.x; asm volatile("" : "+v"(tid_l));
    const int tid = tid_l, wid = __builtin_amdgcn_readfirstlane(tid >> 6), lane = tid & 63, wr = wid >> 2, wc = wid & 3, fr = lane & 15, fq = lane >> 4;
    const int K = g.K, nt = K / BK;
    unsigned voffA[2], voffB[2];
#pragma unroll
    for (int i = 0; i < 2; ++i) { int R, C; stage_rc(tid * 16 + i * 8192, R, C); const int Rb = Epi::PERM ? ((R & ~31) + perm32(R & 31)) : R;
        voffA[i] = (unsigned)(R * K + C) * 2u; voffB[i] = (unsigned)(Rb * K + C) * 2u; }
    const size_t kstep = (size_t)(BK * 2);
    const size_t hstep = (size_t)HALF * K * 2;
    const size_t tstep = 2 * hstep;
    const unsigned ldsw = (unsigned)wid * 1024u;
    const int aoff = lds_byte(wr * 64 + fr, fq * 8), boff = lds_byte(wc * 32 + fr, fq * 8);
#define PG8_SA(b, h) (((b) * 2 + (h)) * HTB)
#define PG8_SB(b, h) ((4 + (b) * 2 + (h)) * HTB)
#define PG8_STAGE(bufoff, gbase, voff) do { _Pragma("unroll") for (int _i = 0; _i < 2; ++_i) \
        __builtin_amdgcn_global_load_lds((const unsigned*)((const char*)(gbase) + (voff)[_i]), (PG8_LAS unsigned*)(lds + (bufoff) + ldsw + _i * 8192), 16, 0, 0); } while (0)
#define PG8_LDA(dst, b, h) do { _Pragma("unroll") for (int m = 0; m < 4; ++m) _Pragma("unroll") for (int k = 0; k < 2; ++k) dst[m][k] = *(const PG8_LAS bf16x8*)(lds + PG8_SA(b, h) + aoff + m * 2048 + k * 1024); } while (0)
#define PG8_LDB(dst, b, h) do { _Pragma("unroll") for (int n = 0; n < 2; ++n) _Pragma("unroll") for (int k = 0; k < 2; ++k) dst[n][k] = *(const PG8_LAS bf16x8*)(lds + PG8_SB(b, h) + boff + n * 2048 + k * 1024); } while (0)
#define PG8_MMA(ai, bj, At, Bt) do { __builtin_amdgcn_s_setprio(1); _Pragma("unroll") for (int m = 0; m < 4; ++m) _Pragma("unroll") for (int n = 0; n < 2; ++n) _Pragma("unroll") for (int k = 0; k < 2; ++k) \
        acc[ai][bj][m][n] = __builtin_amdgcn_mfma_f32_16x16x32_bf16(Bt[n][k], At[m][k], acc[ai][bj][m][n], 0, 0, 0); __builtin_amdgcn_s_setprio(0); } while (0)
#define PG8_WAIT_V(n) asm volatile("s_waitcnt vmcnt(" #n ")" ::: "memory")
#define PG8_WAIT_L(n) asm volatile("s_waitcnt lgkmcnt(" #n ")" ::: "memory")
#define PG8_BAR __builtin_amdgcn_s_barrier()
#define PG8_SCHED __builtin_amdgcn_sched_barrier(0)
    Unit cur, nxt; int ui = 0;
    if (!S.next(0, cur)) return;
    f32x4 acc[2][2][4][2];
#pragma unroll
    for (int a = 0; a < 2; ++a)
#pragma unroll
        for (int b = 0; b < 2; ++b)
#pragma unroll
            for (int m = 0; m < 4; ++m)
#pragma unroll
                for (int n = 0; n < 2; ++n) acc[a][b][m][n] = (f32x4){0.f, 0.f, 0.f, 0.f};
    bf16x8 At[4][2], B0[2][2], B1[2][2];
    const char* cA = (const char*)g.A + (size_t)cur.pm * tstep; const char* cB = (const char*)g.Bt + (size_t)cur.pn * tstep;
    S.a_ready(cur);
    if constexpr (SP2) {
        PG8_STAGE(PG8_SB(0, 0), cB, voffB); PG8_STAGE(PG8_SB(0, 1), cB + hstep, voffB); PG8_STAGE(PG8_SA(0, 0), cA, voffA); PG8_STAGE(PG8_SA(0, 1), cA + hstep, voffA);
        if (wr == 1) PG8_BAR;
        PG8_WAIT_V(2); PG8_BAR;
        PG8_STAGE(PG8_SB(1, 0), cB + kstep, voffB); PG8_STAGE(PG8_SA(1, 0), cA + kstep, voffA); PG8_STAGE(PG8_SB(1, 1), cB + hstep + kstep, voffB);
        PG8_WAIT_V(6); PG8_BAR;
    } else {
        PG8_STAGE(PG8_SB(0, 0), cB, voffB); PG8_STAGE(PG8_SA(0, 0), cA, voffA); PG8_STAGE(PG8_SB(0, 1), cB + hstep, voffB); PG8_STAGE(PG8_SA(0, 1), cA + hstep, voffA);
        if (wr == 1) PG8_BAR;
        PG8_WAIT_V(4); PG8_BAR;
        PG8_STAGE(PG8_SB(1, 0), cB + kstep, voffB); PG8_STAGE(PG8_SA(1, 0), cA + kstep, voffA); PG8_STAGE(PG8_SB(1, 1), cB + hstep + kstep, voffB);
        PG8_WAIT_V(6); PG8_BAR;
    }
    for (;;) {
        const bool has_next = S.next(ui + 1, nxt);
        const char* nA = has_next ? (const char*)g.A + (size_t)nxt.pm * tstep : cA; const char* nB = has_next ? (const char*)g.Bt + (size_t)nxt.pn * tstep : cB;
        for (int t = 0; t < nt; t += 2) {
            const bool last = (t == nt - 2);
            const char* a1 = cA + (size_t)(t + 1) * kstep;
            const char* a2 = last ? nA : cA + (size_t)(t + 2) * kstep; const char* b2 = last ? nB : cB + (size_t)(t + 2) * kstep;
            const char* a3 = a2 + kstep; const char* b3 = b2 + kstep;
            if (last && has_next) S.a_ready(nxt);
            if constexpr (SP2) {
            PG8_LDB(B0, 0, 0); PG8_LDB(B1, 0, 1); PG8_SCHED; PG8_LDA(At, 0, 0); PG8_STAGE(PG8_SA(1, 1), a1 + hstep, voffA);
            PG8_WAIT_V(8); PG8_WAIT_L(0); PG8_BAR; PG8_MMA(0, 0, At, B0); PG8_MMA(0, 1, At, B1); PG8_BAR; PG8_SCHED;
            PG8_LDA(At, 0, 1); PG8_STAGE(PG8_SB(0, 0), b2, voffB); PG8_STAGE(PG8_SB(0, 1), b2 + hstep, voffB); PG8_STAGE(PG8_SA(0, 0), a2, voffA);
            PG8_WAIT_V(8); PG8_WAIT_L(0); PG8_BAR; PG8_MMA(1, 0, At, B0); PG8_MMA(1, 1, At, B1); PG8_BAR; PG8_SCHED;
            PG8_LDB(B0, 1, 0); PG8_LDB(B1, 1, 1); PG8_SCHED; PG8_LDA(At, 1, 0); PG8_STAGE(PG8_SA(0, 1), a2 + hstep, voffA);
            PG8_WAIT_V(8); PG8_WAIT_L(0); PG8_BAR; PG8_MMA(0, 0, At, B0); PG8_MMA(0, 1, At, B1); PG8_BAR; PG8_SCHED;
            PG8_LDA(At, 1, 1); PG8_STAGE(PG8_SB(1, 0), b3, voffB); PG8_STAGE(PG8_SB(1, 1), b3 + hstep, voffB); PG8_STAGE(PG8_SA(1, 0), a3, voffA);
            PG8_WAIT_V(8); PG8_WAIT_L(0); PG8_BAR; PG8_MMA(1, 0, At, B0); PG8_MMA(1, 1, At, B1); PG8_BAR; PG8_SCHED;
            } else {
            PG8_LDB(B0, 0, 0); PG8_SCHED; PG8_LDA(At, 0, 0); PG8_STAGE(PG8_SA(1, 1), a1 + hstep, voffA);
            PG8_WAIT_L(8); PG8_BAR; PG8_WAIT_L(0); PG8_MMA(0, 0, At, B0); PG8_BAR; PG8_SCHED;
            PG8_LDB(B1, 0, 1); PG8_STAGE(PG8_SB(0, 0), b2, voffB);
            PG8_BAR; PG8_WAIT_L(0); PG8_MMA(0, 1, At, B1); PG8_BAR;
            PG8_LDA(At, 0, 1); PG8_STAGE(PG8_SA(0, 0), a2, voffA);
            PG8_BAR; PG8_WAIT_L(0); PG8_MMA(1, 0, At, B0); PG8_BAR; PG8_SCHED;
            PG8_STAGE(PG8_SB(0, 1), b2 + hstep, voffB);
            PG8_WAIT_V(6); PG8_BAR; PG8_MMA(1, 1, At, B1); PG8_BAR;
            PG8_LDB(B0, 1, 0); PG8_SCHED; PG8_LDA(At, 1, 0); PG8_STAGE(PG8_SA(0, 1), a2 + hstep, voffA);
            PG8_WAIT_L(8); PG8_BAR; PG8_WAIT_L(0); PG8_MMA(0, 0, At, B0); PG8_BAR; PG8_SCHED;
            PG8_LDB(B1, 1, 1); PG8_STAGE(PG8_SB(1, 0), b3, voffB);
            PG8_BAR; PG8_WAIT_L(0); PG8_MMA(0, 1, At, B1); PG8_BAR;
            PG8_LDA(At, 1, 1); PG8_STAGE(PG8_SA(1, 0), a3, voffA);
            PG8_BAR; PG8_WAIT_L(0); PG8_MMA(1, 0, At, B0); PG8_BAR; PG8_SCHED;
            PG8_STAGE(PG8_SB(1, 1), b3 + hstep, voffB);
            PG8_WAIT_V(6); PG8_BAR; PG8_MMA(1, 1, At, B1); PG8_BAR;
            }
        }
        if constexpr (ALIGN_EPI) { if (wr == 0) PG8_BAR; }
        if constexpr (!Epi::AFTER_DRAIN) { E(acc, cur, wr, wc, fr, fq); S.done(cur); }
        if (!has_next) break;
#pragma unroll
        for (int a = 0; a < 2; ++a)
#pragma unroll
            for (int b = 0; b < 2; ++b)
#pragma unroll
                for (int m = 0; m < 4; ++m)
#pragma unroll
                    for (int n = 0; n < 2; ++n) acc[a][b][m][n] = (f32x4){0.f, 0.f, 0.f, 0.f};
        cur = nxt; cA = nA; cB = nB; ++ui;
        if constexpr (ALIGN_EPI) { if (wr == 1) PG8_BAR; }
    }
    PG8_WAIT_V(0);
    if constexpr (!ALIGN_EPI) { if (wr == 0) PG8_BAR; }
    PG8_BAR;
    if constexpr (Epi::AFTER_DRAIN) { E.fused(acc, cur, wr, wc, fr, fq, lds, wid, lane); S.done(cur); }
#undef PG8_SA
#undef PG8_SB
#undef PG8_STAGE
#undef PG8_LDA
#undef PG8_LDB
#undef PG8_MMA
#undef PG8_WAIT_V
#undef PG8_WAIT_L
#undef PG8_BAR
#undef PG8_SCHED
}
}
#define PG8_SP2 true
#define PG8_ALIGN true
#include <hip/hip_bf16.h>
#include <cmath>
namespace attn_body {
using bf16=__hip_bfloat16;
using bf16x8=__attribute__((ext_vector_type(8)))short;
using s16x4=__attribute__((ext_vector_type(4)))short;
using f32x16=__attribute__((ext_vector_type(16)))float;
using u32x4=__attribute__((ext_vector_type(4)))unsigned;
constexpr int BATCH=8,NHEAD=16,SEQ=4096,D=64,DM=NHEAD*D;
constexpr int NW=8,QBLK=32,QB=QBLK*NW,KVBLK=64,NQB=SEQ/QB;
constexpr int ATTN_PITCH=DM, ATTN_UNIT_ROWS=QB;
__device__ __forceinline__ int crow(int r,int hi){return (r&3)+8*(r>>2)+4*hi;}
#define SBAR() __builtin_amdgcn_sched_barrier(0)
__device__ __forceinline__ void cmask(f32x16&p0,f32x16&p1,int jb,int qrel,int hi){
  const float NEG=-INFINITY; int kb=64*jb+4*hi;
  #pragma unroll
  for(int r=0;r<16;++r){int kv=kb+(r&3)+8*(r>>2); if(kv>qrel)p0[r]=NEG; if(kv+32>qrel)p1[r]=NEG;}
}

constexpr int NSLOT=3, SLOTB=8192;
constexpr int LDS_K=0, LDS_V=NSLOT*SLOTB, LDS_WS=2*NSLOT*SLOTB, LDS_OST=LDS_WS+NW*64*4, LDS_BYTES=LDS_OST+NW*4096;
constexpr float C2=0.125f*1.4426950408889634f;
__device__ __forceinline__ void glds16(const void*gsrc,unsigned lds_dst){unsigned keep;
  asm volatile("s_mov_b32 %0, m0\n\ts_mov_b32 m0, %2\n\ts_nop 0\n\tglobal_load_lds_dwordx4 %1, off\n\ts_mov_b32 m0, %0":"=&s"(keep):"v"(gsrc),"s"(lds_dst):"memory");}
__device__ __forceinline__ float max3f(float a,float b,float c){float r;asm("v_max3_f32 %0, %1, %2, %3":"=v"(r):"v"(a),"v"(b),"v"(c));return r;}
__device__ __forceinline__ float max2f(float a,float b){float r;asm("v_max_f32_e32 %0, %1, %2":"=v"(r):"v"(a),"v"(b));return r;}
__device__ __forceinline__ float fadd_s(float a,float b){float r;asm("v_add_f32_e32 %0, %1, %2":"=v"(r):"v"(a),"v"(b));return r;}
__device__ __forceinline__ float fsub_s(float a,float b){float r;asm("v_sub_f32_e32 %0, %1, %2":"=v"(r):"v"(a),"v"(b));return r;}
typedef float f32x2_t __attribute__((ext_vector_type(2))); typedef __bf16 bf16x2_t __attribute__((ext_vector_type(2)));
__device__ __forceinline__ unsigned cvtpk_s(float lo,float hi){f32x2_t v={lo,hi};bf16x2_t b=__builtin_convertvector(v,bf16x2_t);return __builtin_bit_cast(unsigned,b);}
#define WAIT_BAR(N) asm volatile("s_waitcnt vmcnt(" #N ") lgkmcnt(0)\n\ts_barrier":::"memory")

__device__ __forceinline__ void qkt(f32x16&p0,f32x16&p1,const char*Kslot,const bf16x8*qr,const f32x16&negm,int r32,int hi){
  const char*kb=Kslot+hi*1024+r32*16;
  #pragma unroll
  for(int d0=0;d0<4;++d0){
    const bf16x8 b0=*reinterpret_cast<const bf16x8*>(kb+d0*2048);
    const bf16x8 b1=*reinterpret_cast<const bf16x8*>(kb+d0*2048+512);
    if(d0==0){p0=__builtin_amdgcn_mfma_f32_32x32x16_bf16(b0,qr[0],negm,0,0,0);p1=__builtin_amdgcn_mfma_f32_32x32x16_bf16(b1,qr[0],negm,0,0,0);}
    else{p0=__builtin_amdgcn_mfma_f32_32x32x16_bf16(b0,qr[d0],p0,0,0,0);p1=__builtin_amdgcn_mfma_f32_32x32x16_bf16(b1,qr[d0],p1,0,0,0);}}
}
typedef __attribute__((address_space(3))) const char* lds_cptr;
typedef short v4i16_t __attribute__((ext_vector_type(4)));
__device__ __forceinline__ void kload8(bf16x8*kf,lds_cptr kp){
  kf[0]=*(const __attribute__((address_space(3))) bf16x8*)(kp);      kf[1]=*(const __attribute__((address_space(3))) bf16x8*)(kp+512);
  kf[2]=*(const __attribute__((address_space(3))) bf16x8*)(kp+2048); kf[3]=*(const __attribute__((address_space(3))) bf16x8*)(kp+2560);
  kf[4]=*(const __attribute__((address_space(3))) bf16x8*)(kp+4096); kf[5]=*(const __attribute__((address_space(3))) bf16x8*)(kp+4608);
  kf[6]=*(const __attribute__((address_space(3))) bf16x8*)(kp+6144); kf[7]=*(const __attribute__((address_space(3))) bf16x8*)(kp+6656);
}
__device__ __forceinline__ void kload2(bf16x8*kf,lds_cptr kp,int j){ kf[2*j]=*(const __attribute__((address_space(3))) bf16x8*)(kp+j*2048); kf[2*j+1]=*(const __attribute__((address_space(3))) bf16x8*)(kp+j*2048+512); }
__device__ __forceinline__ s16x4 vtr(lds_cptr p){ return __builtin_bit_cast(s16x4,__builtin_amdgcn_ds_read_tr16_b64_v4i16((__attribute__((address_space(3))) v4i16_t*)p)); }
__device__ __forceinline__ float rowmax(const f32x16&p0,const f32x16&p1){
  float a=max3f(p0[0],p0[1],p1[0]),b=max3f(p0[2],p0[3],p1[1]);a=max3f(a,p1[2],p1[3]);
  #pragma unroll
  for(int r=4;r<16;r+=4){a=max3f(a,p0[r],p0[r+1]);b=max3f(b,p0[r+2],p0[r+3]);a=max3f(a,p1[r],p1[r+1]);b=max3f(b,p1[r+2],p1[r+3]);}
  const float m=max2f(a,b);
  auto rr=__builtin_amdgcn_permlane32_swap(__float_as_uint(m),__float_as_uint(m),false,false);
  return max2f(__uint_as_float(rr[0]),__uint_as_float(rr[1]));
}
__device__ __forceinline__ void pv(f32x16*o,int vb,bf16x8 pa0,bf16x8 pa1,bf16x8 pa2,bf16x8 pa3){
  #pragma unroll
  for(int d0=0;d0<2;++d0){s16x4 lo[4],hi[4];
    #pragma unroll
    for(int ks=0;ks<4;++ks){
      asm volatile("ds_read_b64_tr_b16 %0,%1 offset:%c2":"=&v"(lo[ks]):"v"(vb),"i"(d0*4096+ks*1024):"memory");
      asm volatile("ds_read_b64_tr_b16 %0,%1 offset:%c2":"=&v"(hi[ks]):"v"(vb),"i"(d0*4096+ks*1024+512):"memory");}
    asm volatile("s_waitcnt lgkmcnt(0)":::"memory");SBAR();
    #define PK(k) (bf16x8){lo[k][0],lo[k][1],lo[k][2],lo[k][3],hi[k][0],hi[k][1],hi[k][2],hi[k][3]}
    o[d0]=__builtin_amdgcn_mfma_f32_32x32x16_bf16(pa0,PK(0),o[d0],0,0,0);
    o[d0]=__builtin_amdgcn_mfma_f32_32x32x16_bf16(pa1,PK(1),o[d0],0,0,0);
    o[d0]=__builtin_amdgcn_mfma_f32_32x32x16_bf16(pa2,PK(2),o[d0],0,0,0);
    o[d0]=__builtin_amdgcn_mfma_f32_32x32x16_bf16(pa3,PK(3),o[d0],0,0,0);
    #undef PK
  }
}

#ifndef ATTN_STORE16
#define ATTN_STORE16(p,v) (*(u32x4*)(p)=(v))
#endif
template<int THRL> __device__ __forceinline__ void attn_unit(int b,int qb,const bf16*Q,const bf16*__restrict__ K,const bf16*__restrict__ V,bf16*O,char*shm){
  int tid_l=threadIdx.x; asm volatile("":"+v"(tid_l)); const int tid=tid_l,lane=tid&63,r32=lane&31,hi=lane>>5; const int wid=__builtin_amdgcn_readfirstlane(tid>>6);
  const long rowbase=(long)b*SEQ; const int q0=qb*QB;
  const bf16*Qw=Q+(rowbase+q0+wid*QBLK)*DM;
  const bf16*Kh=K+rowbase*DM,*Vh=V+rowbase*DM;
  const unsigned lds0=(unsigned)(uintptr_t)shm;
  float*wsf=(float*)(shm+LDS_WS)+wid*64;
  const bf16*ksrc=Kh+(long)lane*DM+wid*8;
  const bf16*vsrc=Vh+(long)(16*(wid&3)+(lane>>2))*DM+(wid>>2)*32+(lane&3)*8;
  const unsigned kdst=lds0+LDS_K+wid*1024, vdst=lds0+LDS_V+wid*1024;
  #define DMA_K(t,slot) glds16(ksrc+(long)(t)*KVBLK*DM,(unsigned)__builtin_amdgcn_readfirstlane(kdst+(slot)))
  #define DMA_V(t,slot) glds16(vsrc+(long)(t)*KVBLK*DM,(unsigned)__builtin_amdgcn_readfirstlane(vdst+(slot)))
  const int vb0=(int)(lds0+LDS_V)+((lane>>4)&1)*32+(lane&3)*8+(4*hi+((lane&15)>>2))*64;
  const char*Kbase=shm+LDS_K; bf16x8 kf[8];
  const lds_cptr shm3=(lds_cptr)shm; const lds_cptr kp0=shm3+LDS_K+hi*1024+r32*16; const lds_cptr vp0=shm3+LDS_V+((lane>>4)&1)*32+(lane&3)*8+(4*hi+((lane&15)>>2))*64;
  const int NT=(q0+QB)/KVBLK;
  DMA_K(0,0);DMA_V(0,0);DMA_K(1,SLOTB);
  bf16x8 qr[4];
  #pragma unroll
  for(int d0=0;d0<4;++d0)qr[d0]=*reinterpret_cast<const bf16x8*>(&Qw[(long)r32*DM+d0*16+hi*8]);
  float mhat=0.f,l_reg=0.f;f32x16 o[2];o[0]=f32x16{};o[1]=f32x16{};f32x16 negm=f32x16{};asm volatile("":"+v"(negm));
  const int qrel=wid*QBLK+r32;
  #define CMASK(P0,P1,t) do{int jb_=(t)-(NT-4); if(jb_>=0)cmask(P0,P1,jb_,qrel,hi);}while(0)
  bool resc=false;
  #define START(P0,P1) do{ const float rm=rowmax(P0,P1); resc=false; \
    { const float dl=rm; mhat=fadd_s(mhat,dl); \
      _Pragma("unroll") for(int r=0;r<16;++r){P0[r]=fsub_s(P0[r],dl);P1[r]=fsub_s(P1[r],dl);} \
      _Pragma("unroll") for(int r=0;r<16;++r)negm[r]=-mhat; asm volatile("":"+v"(negm)); } \
    _Pragma("unroll") for(int r=0;r<16;++r)P0[r]=__builtin_amdgcn_exp2f(P0[r]); }while(0)
  #define RESC() do{ if(resc){ asm volatile("s_waitcnt lgkmcnt(0)":::"memory"); \
      _Pragma("unroll") for(int d_=0;d_<2;++d_) _Pragma("unroll") for(int r=0;r<16;++r)o[d_][r]*=wsf[crow(r,hi)]; } }while(0)
  f32x16 pA0,pA1,pB0,pB1;
  int sl_prev=0,sl_cur=0,sl_next=SLOTB;
  #define ROT() do{sl_prev=sl_cur;sl_cur=sl_next;sl_next=(sl_next==(NSLOT-1)*SLOTB)?0:sl_next+SLOTB;}while(0)
  DMA_K(2,2*SLOTB);
  WAIT_BAR(3);
  qkt(pA0,pA1,Kbase,qr,negm,r32,hi);asm volatile("s_nop 15\n\ts_nop 7":"+v"(pA0),"+v"(pA1));CMASK(pA0,pA1,0);
  START(pA0,pA1);
  _Pragma("unroll") for(int r=0;r<16;++r)pA1[r]=__builtin_amdgcn_exp2f(pA1[r]);
  WAIT_BAR(0);
  DMA_K(3,0);DMA_V(1,SLOTB);
  ROT();
  kload8(kf,kp0+sl_cur);
  WAIT_BAR(2);
  s16x4 vlo[8],vhi[8]; u32x4 pw0,pw1,pw2,pw3;
  #define PKW(P,B) cvtpk_s(P[B],P[B+1])
  #define PAF(k) __builtin_bit_cast(bf16x8,pw##k)
  #define VFR(i) (bf16x8){vlo[i][0],vlo[i][1],vlo[i][2],vlo[i][3],vhi[i][0],vhi[i][1],vhi[i][2],vhi[i][3]}
  #define PIN(x) asm volatile("":"+v"(x))
  #define MX3(a,b,c) __builtin_fmaxf(__builtin_fmaxf((a),(b)),(c))
  #define GAPA(MF,A0,A1,A2,A3,W0,W1,PW) do{ MF; sacc+=A0; sacc+=A1; sacc+=A2; sacc+=A3; PIN(sacc); W0; W1; PIN(PW); SBAR(); }while(0)
  #define EX(v) __builtin_amdgcn_exp2f(v)
  #define GAPB(MF,X,B) do{ MF; X[B]=EX(X[B]); X[B+1]=EX(X[B+1]); X[B+2]=EX(X[B+2]); X[B+3]=EX(X[B+3]); PIN(X); SBAR(); }while(0)
  #define VRD(i) do{ vlo[i]=vtr(vp_+(((i)>>2)*4096+((i)&3)*1024)); vhi[i]=vtr(vp_+(((i)>>2)*4096+((i)&3)*1024+512)); }while(0)
  #define KRD(G,j) do{ if(G){ kload2(kf,kp0+sl_next,j); SBAR(); } }while(0)
  #define STEP(C0,C1,P0,P1,t,GK,GV,GL) do{ SBAR(); \
    const lds_cptr vp_=vp0+sl_prev; \
    VRD(0); SBAR(); float sacc=(P0[0]+P0[1]); \
    GAPA(C0=__builtin_amdgcn_mfma_f32_32x32x16_bf16(kf[0],qr[0],negm,0,0,0), P0[2],P0[3],P0[4],P0[5],     pw0[0]=PKW(P0,0), pw0[1]=PKW(P0,2), pw0); \
    VRD(4); SBAR(); GAPA(C1=__builtin_amdgcn_mfma_f32_32x32x16_bf16(kf[1],qr[0],negm,0,0,0), P0[6],P0[7],P0[8],P0[9],     pw0[2]=PKW(P0,4), pw0[3]=PKW(P0,6), pw0); \
    VRD(1); SBAR(); GAPA(C0=__builtin_amdgcn_mfma_f32_32x32x16_bf16(kf[2],qr[1],C0,0,0,0),   P0[10],P0[11],P0[12],P0[13], pw1[0]=PKW(P0,8), pw1[1]=PKW(P0,10), pw1); \
    VRD(5); SBAR(); GAPA(C1=__builtin_amdgcn_mfma_f32_32x32x16_bf16(kf[3],qr[1],C1,0,0,0),   P0[14],P0[15],P1[0],P1[1],   pw1[2]=PKW(P0,12),pw1[3]=PKW(P0,14), pw1); \
    VRD(2); SBAR(); GAPA(C0=__builtin_amdgcn_mfma_f32_32x32x16_bf16(kf[4],qr[2],C0,0,0,0),   P1[2],P1[3],P1[4],P1[5],     pw2[0]=PKW(P1,0), pw2[1]=PKW(P1,2), pw2); \
    VRD(6); SBAR(); GAPA(C1=__builtin_amdgcn_mfma_f32_32x32x16_bf16(kf[5],qr[2],C1,0,0,0),   P1[6],P1[7],P1[8],P1[9],     pw2[2]=PKW(P1,4), pw2[3]=PKW(P1,6), pw2); \
    VRD(3); SBAR(); GAPA(C0=__builtin_amdgcn_mfma_f32_32x32x16_bf16(kf[6],qr[3],C0,0,0,0),   P1[10],P1[11],P1[12],P1[13], pw3[0]=PKW(P1,8), pw3[1]=PKW(P1,10), pw3); \
    VRD(7); SBAR(); GAPA(C1=__builtin_amdgcn_mfma_f32_32x32x16_bf16(kf[7],qr[3],C1,0,0,0),   P1[14],P1[15],0.f,0.f,       pw3[2]=PKW(P1,12),pw3[3]=PKW(P1,14), pw3); \
    l_reg+=sacc; \
    if(GK){DMA_K((t)+3,sl_cur);} if(GV){DMA_V((t)+1,sl_next);} \
    CMASK(C0,C1,t); \
    { float a=MX3(C0[0],C0[1],C1[0]),b=MX3(C0[2],C0[3],C1[1]); a=MX3(a,C1[2],C1[3]); \
      _Pragma("unroll") for(int r=4;r<16;r+=4){a=MX3(a,C0[r],C0[r+1]);b=MX3(b,C0[r+2],C0[r+3]);a=MX3(a,C1[r],C1[r+1]);b=MX3(b,C1[r+2],C1[r+3]);} \
      float rm=__builtin_fmaxf(a,b); { auto rr=__builtin_amdgcn_permlane32_swap(__float_as_uint(rm),__float_as_uint(rm),false,false); rm=__builtin_fmaxf(__uint_as_float(rr[0]),__uint_as_float(rr[1])); } \
      resc=false; \
      if(__builtin_expect(__any(rm>(float)THRL),0)){ const float dl=__builtin_fmaxf(rm,0.f); mhat+=dl; \
        _Pragma("unroll") for(int r=0;r<16;++r){C0[r]-=dl;C1[r]-=dl;} \
        _Pragma("unroll") for(int r=0;r<16;++r)negm[r]=-mhat; asm volatile("":"+v"(negm)); \
        const float f=__builtin_amdgcn_exp2f(-dl); l_reg*=f; if(hi==0)wsf[r32]=f; resc=true; } } \
    SBAR(); \
    GAPB(o[0]=__builtin_amdgcn_mfma_f32_32x32x16_bf16(PAF(0),VFR(0),o[0],0,0,0), C0,0); \
    GAPB(o[1]=__builtin_amdgcn_mfma_f32_32x32x16_bf16(PAF(0),VFR(4),o[1],0,0,0), C0,4); \
    KRD(GL,0); GAPB(o[0]=__builtin_amdgcn_mfma_f32_32x32x16_bf16(PAF(1),VFR(1),o[0],0,0,0), C0,8); \
    KRD(GL,1); GAPB(o[1]=__builtin_amdgcn_mfma_f32_32x32x16_bf16(PAF(1),VFR(5),o[1],0,0,0), C0,12); \
    KRD(GL,2); GAPB(o[0]=__builtin_amdgcn_mfma_f32_32x32x16_bf16(PAF(2),VFR(2),o[0],0,0,0), C1,0); \
    KRD(GL,3); GAPB(o[1]=__builtin_amdgcn_mfma_f32_32x32x16_bf16(PAF(2),VFR(6),o[1],0,0,0), C1,4); \
    GAPB(o[0]=__builtin_amdgcn_mfma_f32_32x32x16_bf16(PAF(3),VFR(3),o[0],0,0,0), C1,8); \
    GAPB(o[1]=__builtin_amdgcn_mfma_f32_32x32x16_bf16(PAF(3),VFR(7),o[1],0,0,0), C1,12); \
    }while(0)
  int t=1;
  #undef CMASK
  #define CMASK(P0,P1,t) do{}while(0)
  for(;t+5<NT;t+=2){
    STEP(pB0,pB1,pA0,pA1,t,true,true,true);     WAIT_BAR(2); RESC(); ROT();
    STEP(pA0,pA1,pB0,pB1,t+1,true,true,true);   WAIT_BAR(2); RESC(); ROT();
  }
  #undef CMASK
  #define CMASK(P0,P1,t) do{int jb_=(t)-(NT-4); if(jb_>=0)cmask(P0,P1,jb_,qrel,hi);}while(0)
  #define ENDW(tt) do{ if((tt)+3<NT){WAIT_BAR(2);} else if((tt)+2<NT){WAIT_BAR(1);} else {WAIT_BAR(0);} }while(0)
  for(;t+1<NT;t+=2){
    STEP(pB0,pB1,pA0,pA1,t,(t+3<NT),(t+1<NT),(t+1<NT));       ENDW(t);   RESC(); ROT();
    STEP(pA0,pA1,pB0,pB1,t+1,(t+4<NT),(t+2<NT),(t+2<NT));     ENDW(t+1); RESC(); ROT();
  }
  STEP(pB0,pB1,pA0,pA1,NT-1,false,false,false); RESC();
  { float sacc=pB0[0]+pB0[1]; _Pragma("unroll") for(int r=2;r<16;++r)sacc+=pB0[r]; _Pragma("unroll") for(int r=0;r<16;++r)sacc+=pB1[r]; l_reg+=sacc;
    pw0=(u32x4){PKW(pB0,0),PKW(pB0,2),PKW(pB0,4),PKW(pB0,6)};pw1=(u32x4){PKW(pB0,8),PKW(pB0,10),PKW(pB0,12),PKW(pB0,14)};pw2=(u32x4){PKW(pB1,0),PKW(pB1,2),PKW(pB1,4),PKW(pB1,6)};pw3=(u32x4){PKW(pB1,8),PKW(pB1,10),PKW(pB1,12),PKW(pB1,14)};
    SBAR(); pv(o,vb0+sl_cur,PAF(0),PAF(1),PAF(2),PAF(3)); }
  #undef PKW
  #undef PAF
  #undef VFR
  #undef PIN
  #undef MX3
  #undef GAPA
  #undef GAPB
  #undef EX
  #undef VRD
  #undef KRD
  #undef STEP
  #undef ENDW
  {auto rr=__builtin_amdgcn_permlane32_swap(__float_as_uint(l_reg),__float_as_uint(l_reg),false,false);l_reg=__uint_as_float(rr[0])+__uint_as_float(rr[1]);}
  if(hi==0)wsf[32+r32]=l_reg;asm volatile("s_waitcnt lgkmcnt(0)":::"memory");
  float rli[16];
  #pragma unroll
  for(int r=0;r<16;++r)rli[r]=__builtin_amdgcn_rcpf(wsf[32+crow(r,hi)]);
  bf16*Ow=O+(rowbase+q0+wid*QBLK)*DM;
  { bf16*stg=(bf16*)(shm+LDS_OST)+wid*2048;
    #pragma unroll
    for(int r=0;r<16;++r){const int orow=crow(r,hi);
      #pragma unroll
      for(int d0=0;d0<2;++d0)stg[orow*64+d0*32+r32]=__float2bfloat16(o[d0][r]*rli[r]);}
    asm volatile("s_waitcnt lgkmcnt(0)":::"memory");
    #pragma unroll
    for(int i=0;i<4;++i){const int row=i*8+(lane>>3),ch=lane&7; const u32x4 v=*(const u32x4*)(stg+row*64+ch*8); ATTN_STORE16(Ow+(long)row*DM+ch*8,v);} }
  asm volatile("s_waitcnt lgkmcnt(0)\n\ts_barrier":::"memory");
  #undef DMA_K
  #undef DMA_V
  #undef CMASK
  #undef START
  #undef RESC
  #undef ROT
}
constexpr int ATTN_LDS_BYTES=LDS_BYTES;
#undef SBAR
#undef WAIT_BAR
}
#define GAS __attribute__((address_space(1)))
#define LAS __attribute__((address_space(3)))
typedef unsigned short bf16;
typedef unsigned v4u __attribute__((ext_vector_type(4)));
typedef float f32x4 __attribute__((ext_vector_type(4)));
typedef short bf16x8 __attribute__((ext_vector_type(8)));
typedef GAS unsigned gu32;
typedef GAS unsigned long long gu64;
#define RLX_AGENT __ATOMIC_RELAXED, __HIP_MEMORY_SCOPE_AGENT
#define LDS_WAIT() asm volatile("s_waitcnt lgkmcnt(0)" ::: "memory")
#define VM_WAIT() asm volatile("s_waitcnt vmcnt(0)" ::: "memory")
__device__ __forceinline__ unsigned long long rt() { return __builtin_amdgcn_s_memrealtime(); }
__device__ __forceinline__ unsigned f2bf(float f) { unsigned u = __builtin_bit_cast(unsigned, f); return (u + 0x7fffu + ((u >> 16) & 1u)) >> 16; }
__device__ __forceinline__ unsigned pk2(float lo, float hi) { return f2bf(lo) | (f2bf(hi) << 16); }

#define XB_TMO      128
#define XB_XCNT(j)  (256  + 64 * (j))
#define XB_XSUB(j)  (1280 + 64 * (j))
#define XB_XGEN(j)  (2304 + 64 * (j))
#define XB_TOP      3328
#define XB_TOPGEN   3392
#define XCD_BAR_WORDS 3456
#define XB_SPIN_CAP (1u << 18)

__device__ __forceinline__ unsigned xb_ld(unsigned* p)              { return __hip_atomic_load(p, __ATOMIC_RELAXED, __HIP_MEMORY_SCOPE_AGENT); }
__device__ __forceinline__ unsigned xb_add(unsigned* p, unsigned v) { return __hip_atomic_fetch_add(p, v, __ATOMIC_RELAXED, __HIP_MEMORY_SCOPE_AGENT); }
__device__ __forceinline__ unsigned xb_xcc_id() { return (unsigned)__builtin_amdgcn_s_getreg((3 << 11) | 20) & 0xFu; }
#define XB_SPIN(cond, bar) do { unsigned _sp = 0; while (cond) { __builtin_amdgcn_s_sleep(1); \
    if ((++_sp & 255u) == 0u) { if (xb_ld(&(bar)[XB_TMO])) break; if (_sp > XB_SPIN_CAP) { atomicAdd(&(bar)[XB_TMO], 1u); break; } } } } while (0)

struct XcdBarrier {
    unsigned* bar; unsigned x;
    volatile LAS unsigned* st;
};

__device__ __forceinline__ XcdBarrier xcd_barrier_post(unsigned* bar, volatile LAS unsigned* st) {
    XcdBarrier b; b.bar = bar; b.x = xb_xcc_id(); b.st = st;
    if (threadIdx.x == 0) (void)xb_add(&bar[XB_XCNT(b.x)], 1u);
    return b;
}
__device__ __forceinline__ void xcd_barrier_complete(unsigned* bar, unsigned x, unsigned& nloc, unsigned& nx) {
    const unsigned G = gridDim.x * gridDim.y * gridDim.z;
    unsigned sum, cnt, mine, sp = 0u;
    for (;;) {
        sum = 0u; cnt = 0u; mine = 0u;
#pragma unroll
        for (unsigned j = 0; j < 16; ++j) { const unsigned c = xb_ld(&bar[XB_XCNT(j)]); sum += c; cnt += (c > 0u) ? 1u : 0u; mine = (j == x) ? c : mine; }
        if (sum == G) break;
        __builtin_amdgcn_s_sleep(1);
        if ((++sp & 255u) == 0u) { if (xb_ld(&bar[XB_TMO])) break; if (sp > XB_SPIN_CAP) { atomicAdd(&bar[XB_TMO], 1u); break; } }
    }
    nloc = mine > 0u ? mine : 1u; nx = cnt > 0u ? cnt : 1u;
}

__device__ __forceinline__ void xcd_barrier(const XcdBarrier& b) {
    asm volatile("s_waitcnt vmcnt(0)" ::: "memory");
    __syncthreads();
    if (threadIdx.x == 0) {
        size_t zoff_ = 0; asm volatile("" : "+s"(zoff_)); unsigned* bar = b.bar + zoff_; unsigned bx_ = b.x; asm volatile("" : "+s"(bx_));
        __builtin_amdgcn_s_waitcnt(0);
        unsigned nloc = b.st[0], nx = b.st[1];
        if (nloc == 0u) { xcd_barrier_complete(bar, bx_, nloc, nx); b.st[0] = nloc; b.st[1] = nx; }
        const unsigned old = xb_add(&bar[XB_XSUB(bx_)], 1u);
        const unsigned gen = old / nloc;
        if (old + 1u == (gen + 1u) * nloc) {
            __builtin_amdgcn_fence(__ATOMIC_RELEASE, "agent");
            asm volatile("s_waitcnt vmcnt(0)" ::: "memory");
            const unsigned og = xb_add(&bar[XB_TOP], 1u);
            const unsigned tg = og / nx;
            if (og + 1u == (tg + 1u) * nx) xb_add(&bar[XB_TOPGEN], 1u);
            else XB_SPIN(xb_ld(&bar[XB_TOPGEN]) == tg, bar);
            __builtin_amdgcn_fence(__ATOMIC_ACQUIRE, "agent");
            xb_add(&bar[XB_XGEN(bx_)], 1u);
            asm volatile("s_waitcnt vmcnt(0)" ::: "memory");
        } else {
            XB_SPIN(xb_ld(&bar[XB_XGEN(bx_)]) == gen, bar);
            __builtin_amdgcn_fence(__ATOMIC_ACQUIRE, "agent");
            asm volatile("s_waitcnt vmcnt(0)" ::: "memory");
        }
    }
    __syncthreads();
}
constexpr int NWAVES = 8;
constexpr int BATCH = 8, SEQ = 4096, DMODEL = 1024, NTOK = BATCH * SEQ, DEPTH = 2, IN_COLS = 2816;
constexpr int NEXP = 16384, PEER_H = 8, PEER_K = 16;
constexpr float RMS_EPS = 1e-6f, LN_EPS = 1e-5f;
constexpr size_t MiB = 1u << 20;
constexpr size_t WS_CTL = 0, CTL_ZERO_BYTES = 1 * MiB;
constexpr size_t WS_WIN = 2 * MiB;
constexpr size_t WS_WOUT = 13 * MiB;
constexpr size_t WS_WQ = 17 * MiB;
constexpr size_t WS_KEYS = 25 * MiB;
constexpr size_t WS_RINV = 26 * MiB;
constexpr size_t WS_SSQ = 27 * MiB;
constexpr size_t WS_EID = 30 * MiB;
constexpr size_t WS_GATE = 38 * MiB;
constexpr size_t WS_SB = 54 * MiB;
constexpr size_t WS_XBF = 72 * MiB;
constexpr size_t WS_QK = 136 * MiB;
constexpr size_t WS_VX = 200 * MiB;
constexpr size_t WS_UT = 264 * MiB;
constexpr size_t WS_VT = 296 * MiB;
constexpr size_t WS_SU = 328 * MiB;
constexpr size_t WS_SV = 329 * MiB;
constexpr size_t WS_EIDT = 330 * MiB;
constexpr size_t WS_CORR = 338 * MiB;
constexpr size_t WS_SSQX = 339 * MiB;
constexpr size_t WS_XQ = 344 * MiB;
constexpr size_t WS_XQS = 376 * MiB;
constexpr size_t WS_CAT = 377 * MiB;
constexpr size_t WS_O = 441 * MiB;
constexpr size_t WS_WSC = 340 * MiB;
constexpr size_t WS_END = 505 * MiB;
constexpr size_t WS_PART = WS_QK;
constexpr size_t WS_WT = WS_SB;
constexpr int CW_BAR = 4096;
constexpr int RING_OFF = 0, RING_BYTES = 131072;
constexpr int LDSCTL_OFF = RING_BYTES, MISC_OFF = LDSCTL_OFF + 320;
constexpr int LDS_BYTES = 147456;

__device__ __forceinline__ float bflo(unsigned w) { return __builtin_bit_cast(float, w << 16); }
__device__ __forceinline__ float bfhi(unsigned w) { return __builtin_bit_cast(float, w & 0xffff0000u); }
__device__ __forceinline__ float bf1(unsigned short w) { return __builtin_bit_cast(float, (unsigned)w << 16); }
#define DPP_ADD(v, ctrl) ((v) + __builtin_bit_cast(float, __builtin_amdgcn_update_dpp(0, __builtin_bit_cast(int, (v)), (ctrl), 0xf, 0xf, true)))
__device__ __forceinline__ float wave_sum(float v) {
    v = DPP_ADD(v, 0xB1);
    v = DPP_ADD(v, 0x4E);
    v = DPP_ADD(v, 0x141);
    v = DPP_ADD(v, 0x140);
    const int b = __builtin_bit_cast(int, v);
    return (__builtin_bit_cast(float, __builtin_amdgcn_readlane(b, 0)) + __builtin_bit_cast(float, __builtin_amdgcn_readlane(b, 16))) + (__builtin_bit_cast(float, __builtin_amdgcn_readlane(b, 32)) + __builtin_bit_cast(float, __builtin_amdgcn_readlane(b, 48)));
}

__device__ __forceinline__ int win_src(int np) {
    const int p = np >> 8, pc = np & 255;
    if (p < 4) return 256 * p + 64 * ((pc & 127) >> 5) + 32 * (pc >> 7) + (pc & 31);
    if (p < 6) return np;
    if (p < 8) { const int kk = p - 6; return pc < 128 ? 1536 + 128 * kk + pc : 1792 + 128 * kk + (pc - 128); }
    if (p < 10) { const int kk = p - 8; return pc < 128 ? 2304 + 128 * kk + pc : 2560 + 128 * kk + (pc - 128); }
    return 2048 + pc;
}
template <int MODE> __device__ __forceinline__ void p0_transpose_item(const float* W, const float* gain, int K, int N, bf16* WT, LAS float* scr, int item, int lane) {
    const int nblk = N / 32, kb = item / nblk, nb = item % nblk, k0 = 64 * kb, n0p = 32 * nb;
    const int n0 = MODE == 1 ? win_src(n0p) : n0p;
#pragma unroll 8
    for (int i = 0; i < 32; ++i) { const int kk = 2 * i + (lane >> 5); const float gk = gain ? gain[k0 + kk] : 1.f; scr[kk * 33 + (lane & 31)] = W[(size_t)(k0 + kk) * N + n0 + (lane & 31)] * gk; }
    LDS_WAIT(); asm volatile("" ::: "memory");
    const int c = lane & 7;
#pragma unroll
    for (int j = 0; j < 4; ++j) { const int n = (lane >> 3) + 8 * j; const LAS float* s = scr + (8 * c) * 33 + n;
        v4u o; o.x = pk2(s[0 * 33], s[1 * 33]); o.y = pk2(s[2 * 33], s[3 * 33]); o.z = pk2(s[4 * 33], s[5 * 33]); o.w = pk2(s[6 * 33], s[7 * 33]);
        *(GAS v4u*)(WT + (size_t)(n0p + n) * K + k0 + 8 * c) = o; }
    LDS_WAIT(); asm volatile("" ::: "memory");
}
__device__ __forceinline__ void p0_convert(const float* src, bf16* dst, size_t n, int gtid, int ngt) {
    for (size_t i = (size_t)gtid * 8; i < n; i += (size_t)ngt * 8) {
        const f32x4 a = *(const GAS f32x4*)(src + i), b = *(const GAS f32x4*)(src + i + 4);
        v4u o; o.x = pk2(a.x, a.y); o.y = pk2(a.z, a.w); o.z = pk2(b.x, b.y); o.w = pk2(b.z, b.w);
        *(GAS v4u*)(dst + i) = o; }
}
__device__ __forceinline__ float wave_max(float v) {
#pragma unroll
    for (int o = 1; o < 64; o <<= 1) v = fmaxf(v, __shfl_xor(v, o));
    return v;
}
template <int OFFS> __device__ __forceinline__ void p0_quant_row(const float* src, unsigned char* dst_base, int e, float* scale_out, int lane) {
    const GAS f32x4* xr = (const GAS f32x4*)src + 4 * lane;
    f32x4 v[4]; float m = 0.f;
#pragma unroll
    for (int j = 0; j < 4; ++j) { v[j] = __builtin_nontemporal_load(xr + j); m = fmaxf(fmaxf(m, fmaxf(fabsf(v[j].x), fabsf(v[j].y))), fmaxf(fabsf(v[j].z), fabsf(v[j].w))); }
    m = wave_max(m);
    const float inv = m > 0.f ? 127.0f / m : 0.f;
    v4u o;
#pragma unroll
    for (int j = 0; j < 4; ++j) { const int a = (int)rintf(v[j].x * inv) + OFFS, b = (int)rintf(v[j].y * inv) + OFFS, c = (int)rintf(v[j].z * inv) + OFFS, d = (int)rintf(v[j].w * inv) + OFFS;
        o[j] = (unsigned)(a & 0xff) | ((unsigned)(b & 0xff) << 8) | ((unsigned)(c & 0xff) << 16) | ((unsigned)(d & 0xff) << 24); }
    *(GAS v4u*)(dst_base + ((size_t)(lane >> 3) * NEXP + e) * 128 + 16 * (lane & 7)) = o;
    if (lane == 0) *scale_out = m * (1.0f / 127.0f);
}
struct QRow { f32x4 v[4]; };
__device__ __forceinline__ void p0_quant_load(QRow& q, const float* src, int lane) { const GAS f32x4* xr = (const GAS f32x4*)src + 4 * lane;
#pragma unroll
    for (int j = 0; j < 4; ++j) q.v[j] = __builtin_nontemporal_load(xr + j); }
__device__ __forceinline__ void p0_quant_fin(const QRow& q, const float* gain, unsigned char* dst_base, int e, float* scale_out, int lane) {
    f32x4 v[4]; float m = 0.f;
#pragma unroll
    for (int j = 0; j < 4; ++j) { v[j] = q.v[j]; if (gain) v[j] = v[j] * *((const GAS f32x4*)gain + 4 * lane + j); m = fmaxf(fmaxf(m, fmaxf(fabsf(v[j].x), fabsf(v[j].y))), fmaxf(fabsf(v[j].z), fabsf(v[j].w))); }
    m = fmaxf(m, __shfl_xor(m, 1)); m = fmaxf(m, __shfl_xor(m, 2)); m = fmaxf(m, __shfl_xor(m, 4)); m = fmaxf(m, __shfl_xor(m, 8));
    const float inv = m > 0.f ? 7.0f / m : 0.f;
    unsigned o[2];
#pragma unroll
    for (int k = 0; k < 2; ++k) { const f32x4 lo = v[2 * k], hi = v[2 * k + 1];
#define Q4(x) ((unsigned)((int)rintf((x) * inv) + 8) & 0xfu)
        o[k] = (Q4(lo.x) | (Q4(hi.x) << 4)) | ((Q4(lo.y) | (Q4(hi.y) << 4)) << 8) | ((Q4(lo.z) | (Q4(hi.z) << 4)) << 16) | ((Q4(lo.w) | (Q4(hi.w) << 4)) << 24);
#undef Q4
    }
    *(GAS unsigned long long*)(dst_base + ((size_t)(lane >> 4) * NEXP + e) * 128 + 8 * (lane & 15)) = (unsigned long long)o[0] | ((unsigned long long)o[1] << 32);
    if ((lane & 15) == 0) scale_out[4 * e + (lane >> 4)] = m * (1.0f / 7.0f);
}
__device__ __forceinline__ void p0_quant_row4(const float* src, const float* gain, unsigned char* dst_base, int e, float* scale_out, int lane) { QRow q; p0_quant_load(q, src, lane); p0_quant_fin(q, gain, dst_base, e, scale_out, lane); }
__device__ __forceinline__ void p0_x_row(const float* xrow, bf16* orow, float* rinv_out, int lane) {
    const GAS f32x4* xr = (const GAS f32x4*)xrow + lane;
    f32x4 v[4]; float s = 0.f;
#pragma unroll
    for (int j = 0; j < 4; ++j) { v[j] = xr[64 * j]; s += (v[j].x * v[j].x + v[j].y * v[j].y) + (v[j].z * v[j].z + v[j].w * v[j].w); }
    s = wave_sum(s);
    GAS unsigned long long* o8 = (GAS unsigned long long*)orow + lane;
#pragma unroll
    for (int j = 0; j < 4; ++j) o8[64 * j] = (unsigned long long)pk2(v[j].x, v[j].y) | ((unsigned long long)pk2(v[j].z, v[j].w) << 32);
    if (lane < 8) rinv_out[lane] = lane == 0 ? s : 0.f;
}

__device__ __forceinline__ float wave_sum_shfl(float v) {
#pragma unroll
    for (int o = 1; o < 64; o <<= 1) v += __shfl_xor(v, o);
    return v;
}
__device__ __forceinline__ void xq_row(const bf16* xrow, signed char* qrow, float* sc4, int lane) {
    const GAS v4u* xp = (const GAS v4u*)xrow + 2 * lane; const v4u a = xp[0], b = xp[1];
#define AMX(w) fmaxf(fabsf(bflo(w)), fabsf(bfhi(w)))
    float am = fmaxf(fmaxf(fmaxf(AMX(a.x), AMX(a.y)), fmaxf(AMX(a.z), AMX(a.w))), fmaxf(fmaxf(AMX(b.x), AMX(b.y)), fmaxf(AMX(b.z), AMX(b.w))));
#undef AMX
    am = fmaxf(am, __shfl_xor(am, 1)); am = fmaxf(am, __shfl_xor(am, 2)); am = fmaxf(am, __shfl_xor(am, 4)); am = fmaxf(am, __shfl_xor(am, 8));
    const float qinv = am > 0.f ? 127.0f / am : 0.f;
#define PK4(wa, wb) (unsigned)(((int)rintf(bflo(wa) * qinv) & 0xff) | (((int)rintf(bfhi(wa) * qinv) & 0xff) << 8) | (((int)rintf(bflo(wb) * qinv) & 0xff) << 16) | (((int)rintf(bfhi(wb) * qinv) & 0xff) << 24))
    v4u o; o.x = PK4(a.x, a.y); o.y = PK4(a.z, a.w); o.z = PK4(b.x, b.y); o.w = PK4(b.z, b.w);
#undef PK4
    *((GAS v4u*)qrow + lane) = o;
    if ((lane & 15) == 0) sc4[lane >> 4] = am * (1.0f / 127.0f);
}
struct CmbArgs { const bf16* O; const bf16* VX; const bf16* SB; bf16* CAT; const float* lq1; const float* lk1; const float* lq2; const float* lk2; const float* subg;
                 const float* cfw; const float* cfb; const float* lng; const float* lnb; const float* scw; float lam_init; };
__device__ __forceinline__ float cmb_lambda(const CmbArgs& A, int lane) { return __expf(wave_sum(A.lq1[lane] * A.lk1[lane])) - __expf(wave_sum(A.lq2[lane] * A.lk2[lane])) + A.lam_init; }
__device__ __forceinline__ void cmb_rows(const CmbArgs& A, float lam, int h, int trow0, int lane) {
    asm volatile("s_waitcnt vmcnt(0)" ::: "memory");
    const int vh = lane >> 5, dd = (2 * lane) & 63;
    const int c0 = (4 * h + vh) * 64 + dd, c1 = (4 * h + 2 + vh) * 64 + dd;
    const float g0 = A.subg[2 * lane] * (1.0f - A.lam_init), g1 = A.subg[2 * lane + 1] * (1.0f - A.lam_init);
    unsigned o0[32], o1[32];
#pragma unroll
    for (int tt = 0; tt < 32; ++tt) { const size_t rb = (size_t)(trow0 + tt) * 1024;
        o0[tt] = __hip_atomic_load((const GAS unsigned*)(A.O + rb + c0), __ATOMIC_RELAXED, __HIP_MEMORY_SCOPE_AGENT); o1[tt] = __hip_atomic_load((const GAS unsigned*)(A.O + rb + c1), __ATOMIC_RELAXED, __HIP_MEMORY_SCOPE_AGENT); }
#pragma unroll
    for (int tt = 0; tt < 32; ++tt) {
        const float a0 = bflo(o0[tt]) - lam * bflo(o1[tt]), a1 = bfhi(o0[tt]) - lam * bfhi(o1[tt]);
        const float ss = wave_sum(a0 * a0 + a1 * a1);
        const float ri = 1.0f / sqrtf(ss * (1.0f / 128.0f) + RMS_EPS);
        *(GAS unsigned*)(A.CAT + (size_t)(trow0 + tt) * 1024 + h * 128 + 2 * lane) = pk2(a0 * ri * g0, a1 * ri * g1); }
}
__device__ __forceinline__ void cmb_conv_phase(const CmbArgs& A, int gw, int ngw, int lane) {
    constexpr int NCH = SEQ / 16, NIT = NCH * 4;
    {
        unsigned short xin[46], xn[46];
#define CMB1_LOAD(X, it_) do { const int c_ = 64 * ((it_) & 3) + lane, t0_ = ((it_) >> 2) * 16, s0_ = t0_ & (SEQ - 1); \
        _Pragma("unroll") for (int i = 0; i < 46; ++i) { const int rel = i - 30; (X)[i] = (s0_ + rel >= 0) ? *(const GAS unsigned short*)(A.VX + (size_t)(t0_ + rel) * 1024 + 512 + c_) : (unsigned short)0; } } while (0)
        int it = gw;
        if (it < NIT) CMB1_LOAD(xin, it);
        for (; it < NIT; it += ngw) {
            const int nx = it + ngw < NIT ? it + ngw : it;
            CMB1_LOAD(xn, nx);
            const int c = 64 * (it & 3) + lane, t0 = (it >> 2) * 16;
            float w[31];
#pragma unroll
            for (int j = 0; j < 31; ++j) w[j] = A.cfw[j * 256 + c];
            const float bias = A.cfb[c], lg = A.lng[c], lb = A.lnb[c];
#pragma unroll
            for (int tt = 0; tt < 16; ++tt) { float y = bias;
#pragma unroll
                for (int j = 0; j < 31; ++j) y += w[j] * bf1(xin[tt + j]);
                const float mean = wave_sum(y) * (1.0f / 64.0f); const float d = y - mean;
                const float var = wave_sum(d * d) * (1.0f / 64.0f);
                const float yn = d / sqrtf(var + LN_EPS) * lg + lb;
                const float sw = yn / (1.0f + __expf(-yn));
                *(GAS unsigned short*)(A.CAT + (size_t)(t0 + tt) * 1024 + 512 + c) = (unsigned short)f2bf(sw); }
#pragma unroll
            for (int i = 0; i < 46; ++i) xin[i] = xn[i];
        }
#undef CMB1_LOAD
    }
    {
        unsigned short xin[18], sbv[16], xn[18], sbn[16];
#define CMB2_LOAD(X, S, it_) do { const int c_ = 64 * ((it_) & 3) + lane, t0_ = ((it_) >> 2) * 16, s0_ = t0_ & (SEQ - 1); \
        _Pragma("unroll") for (int i = 0; i < 18; ++i) { const int rel = i - 2; (X)[i] = (s0_ + rel >= 0) ? *(const GAS unsigned short*)(A.VX + (size_t)(t0_ + rel) * 1024 + 768 + c_) : (unsigned short)0; } \
        _Pragma("unroll") for (int tt = 0; tt < 16; ++tt) (S)[tt] = *(const GAS unsigned short*)(A.SB + (size_t)(t0_ + tt) * 256 + c_); } while (0)
        int it = gw;
        if (it < NIT) CMB2_LOAD(xin, sbv, it);
        for (; it < NIT; it += ngw) {
            const int nx = it + ngw < NIT ? it + ngw : it;
            CMB2_LOAD(xn, sbn, nx);
            const int c = 64 * (it & 3) + lane, t0 = (it >> 2) * 16;
            const float w0 = A.scw[c], w1 = A.scw[256 + c], w2 = A.scw[512 + c];
#pragma unroll
            for (int tt = 0; tt < 16; ++tt) {
                const float y = bf1(sbv[tt]) * (w0 * bf1(xin[tt]) + w1 * bf1(xin[tt + 1]) + w2 * bf1(xin[tt + 2]));
                *(GAS unsigned short*)(A.CAT + (size_t)(t0 + tt) * 1024 + 768 + c) = (unsigned short)f2bf(y); }
#pragma unroll
            for (int i = 0; i < 18; ++i) xin[i] = xn[i];
#pragma unroll
            for (int tt = 0; tt < 16; ++tt) sbv[tt] = sbn[tt];
        }
#undef CMB2_LOAD
    }
}

typedef float f32x16 __attribute__((ext_vector_type(16)));
__device__ __forceinline__ int sortable(int b) { return b ^ ((b >> 31) & 0x7fffffff); }
#define CEX_DESC(a, b) do { const int _x = (a), _y = (b); (a) = _x > _y ? _x : _y; (b) = _x > _y ? _y : _x; } while (0)
template <int N> __device__ __forceinline__ void bitonic_merge_desc(int (&v)[N]) {
#pragma unroll
    for (int j = N >> 1; j > 0; j >>= 1)
#pragma unroll
        for (int i = 0; i < N; ++i) if ((i & j) == 0) CEX_DESC(v[i], v[i | j]);
}
template <int N> __device__ __forceinline__ void bitonic_sort_desc(int (&v)[N]) {
#pragma unroll
    for (int k = 2; k <= N; k <<= 1)
#pragma unroll
        for (int j = k >> 1; j > 0; j >>= 1)
#pragma unroll
            for (int i = 0; i < N; ++i) { const int l = i ^ j; if (l > i) { if ((i & k) == 0) CEX_DESC(v[i], v[l]); else CEX_DESC(v[l], v[i]); } }
}
__device__ __forceinline__ void merge_top16(int (&a)[16], const int (&b)[16]) {
#pragma unroll
    for (int i = 0; i < 16; ++i) a[i] = a[i] > b[15 - i] ? a[i] : b[15 - i];
    bitonic_merge_desc<16>(a);
}
struct TopkArgs { const bf16* Qp; const bf16* keys; const float* ssq; unsigned short* eid; float* gate; unsigned short* eidT;
#ifdef DBG_CHECK
 float* dbgS; int* dbgI;
#endif
 };
__device__ __forceinline__ void topk_phase(const TopkArgs& A, LAS unsigned char* ldsK  , LAS unsigned char* ldsw  , int h, int rank, int nrank, int wave, int tid, int lane) {
    const int r32 = lane & 31, hi = lane >> 5;
    __syncthreads();
    {
        const GAS v4u* src = (const GAS v4u*)(A.keys + (size_t)h * 2 * 128 * 128);
#pragma unroll
        for (int i = 0; i < 8; ++i) { const int g = tid + 512 * i, row = g >> 4, ch = g & 15; *(LAS v4u*)(ldsK + row * 256 + ((ch ^ (row & 15)) << 4)) = src[g]; }
        __syncthreads();
    }
    for (int tg = rank * 8 + wave; tg < SEQ / 32; tg += nrank * 8) {
        const int t = tg * 32 + r32;
        int hb = hi << 2; asm volatile("" : "+v"(hb));
        float rinv2; { const GAS f32x4* sp = (const GAS f32x4*)(A.ssq + (size_t)t * 16); const f32x4 a = sp[0], b = sp[1], c = sp[2], d = sp[3];
            const float ss = ((a.x + a.y) + (a.z + a.w)) + ((b.x + b.y) + (b.z + b.w)) + ((c.x + c.y) + (c.z + c.w)) + ((d.x + d.y) + (d.z + d.w));
            rinv2 = 1.0f / sqrtf(ss * (1.0f / DMODEL) + RMS_EPS); }
        int top[2][16];
#pragma unroll
        for (int c = 0; c < 2; ++c) {
            const bf16* qrow = A.Qp + (size_t)t * 2048 + h * 256 + c * 128 + 8 * hi;
            bf16x8 qf[8];
#pragma unroll
            for (int s = 0; s < 8; ++s) qf[s] = *(const GAS bf16x8*)(qrow + 16 * s);
            int run[16];
            int koff = c * 32768 + r32 * 256; asm volatile("" : "+v"(koff));
            const int ksw = r32 & 15;
            bf16x8 kf[2][8];
#pragma unroll
            for (int s = 0; s < 8; ++s) kf[0][s] = *(const LAS bf16x8*)(ldsK + koff + (((2 * s + hi) ^ ksw) << 4));
#pragma unroll
            for (int nt = 0; nt < 4; ++nt) {
                f32x16 acc = {0.f, 0.f, 0.f, 0.f, 0.f, 0.f, 0.f, 0.f, 0.f, 0.f, 0.f, 0.f, 0.f, 0.f, 0.f, 0.f};
#pragma unroll
                for (int s = 0; s < 8; ++s) acc = __builtin_amdgcn_mfma_f32_32x32x16_bf16(kf[nt & 1][s], qf[s], acc, 0, 0, 0);
                if (nt < 3) {
#pragma unroll
                    for (int s = 0; s < 8; ++s) kf[(nt + 1) & 1][s] = *(const LAS bf16x8*)(ldsK + (nt + 1) * 8192 + koff + (((2 * s + hi) ^ ksw) << 4));
                }
                asm volatile("" ::: "memory");
#ifdef DBG_CHECK
                if (tg == 0) {
#pragma unroll
                    for (int r = 0; r < 16; ++r) A.dbgS[((size_t)(r32 * 8 + h) * 2 + c) * 128 + 32 * nt + (r & 3) + 8 * (r >> 2) + 4 * hi] = acc[r]; }
#endif
                int g[16];
#pragma unroll
                for (int r = 0; r < 16; ++r) { const int idx = 32 * nt + (r & 3) + 8 * (r >> 2);
                    const float av = acc[r];
                    const int bits = ((__float_as_int(av) & ~0x7f) | idx) | hb;
                    g[r] = sortable(bits); }
                bitonic_sort_desc<16>(g);
                if (nt == 0) {
#pragma unroll
                    for (int r = 0; r < 16; ++r) run[r] = g[r];
                } else merge_top16(run, g);
            }
            {
                int other[16];
#pragma unroll
                for (int i = 0; i < 16; ++i) other[i] = __shfl_xor(run[i], 32);
                merge_top16(run, other);
            }
#pragma unroll
            for (int i = 0; i < 16; ++i) top[c][i] = sortable(run[i]);
#ifdef DBG_CHECK
            if (tg == 0 && hi == 0) {
#pragma unroll
                for (int i = 0; i < 16; ++i) A.dbgI[((size_t)(r32 * 8 + h) * 2 + c) * 16 + i] = top[c][i]; }
#endif
        }
#pragma unroll
        for (int c = 0; c < 2; ++c)
#pragma unroll
            for (int q4 = 0; q4 < 4; ++q4) { const unsigned w = (unsigned)(top[c][4 * q4] & 0x7f) | ((unsigned)(top[c][4 * q4 + 1] & 0x7f) << 8) | ((unsigned)(top[c][4 * q4 + 2] & 0x7f) << 16) | ((unsigned)(top[c][4 * q4 + 3] & 0x7f) << 24);
                *(LAS unsigned*)(ldsw + lane * 32 + c * 16 + q4 * 4) = w; }
        int crun[16];
        {
            int cg[16]; int pos = 0;
#pragma unroll
            for (int i = 0; i < 16; ++i)
#pragma unroll
                for (int j = 0; j < 16; ++j) if ((i + 1) * (j + 1) <= 16) {
                    const float s = __builtin_bit_cast(float, top[0][i] & ~0x7f) + __builtin_bit_cast(float, top[1][j] & ~0x7f);
                    cg[pos & 15] = sortable((__builtin_bit_cast(int, s) & ~0xff) | (i << 4) | j); ++pos;
                    if (pos == 50) {
#pragma unroll
                        for (int p = 2; p < 16; ++p) cg[p] = (int)0x80000000;
                    }
                    if ((pos & 15) == 0 || pos == 50) {
                        bitonic_sort_desc<16>(cg);
                        if (pos == 16) {
#pragma unroll
                            for (int r = 0; r < 16; ++r) crun[r] = cg[r];
                        } else merge_top16(crun, cg);
                    }
                }
        }
        LDS_WAIT(); asm volatile("" ::: "memory");
        float sc[16]; unsigned e[16];
#pragma unroll
        for (int k = 0; k < 16; ++k) { const int bits = sortable(crun[k]); const int i = (bits >> 4) & 15, j = bits & 15;
            sc[k] = __builtin_bit_cast(float, bits & ~0xff) * rinv2;
            const unsigned i1 = *(const LAS unsigned char*)(ldsw + lane * 32 + i), i2 = *(const LAS unsigned char*)(ldsw + lane * 32 + 16 + j);
            e[k] = i1 * 128u + i2; }
        const float mx = sc[0];
        float z = 0.f;
#pragma unroll
        for (int k = 0; k < 16; ++k) { sc[k] = __expf(sc[k] - mx); z += sc[k]; }
        const float iz = 1.0f / z;
        if (hi == 0) {
            v4u e0, e1; e0.x = e[0] | (e[1] << 16); e0.y = e[2] | (e[3] << 16); e0.z = e[4] | (e[5] << 16); e0.w = e[6] | (e[7] << 16);
            e1.x = e[8] | (e[9] << 16); e1.y = e[10] | (e[11] << 16); e1.z = e[12] | (e[13] << 16); e1.w = e[14] | (e[15] << 16);
            GAS v4u* ep = (GAS v4u*)(A.eid + (size_t)t * 128 + h * 16); ep[0] = e0; ep[1] = e1;
#pragma unroll
            for (int k = 0; k < 8; ++k) *(GAS unsigned*)(A.eidT + (size_t)t * 128 + k * 16 + 2 * h) = e[k] | (e[k + 8] << 16);
        } else {
            GAS f32x4* gp = (GAS f32x4*)(A.gate + (size_t)t * 128 + h * 16);
#pragma unroll
            for (int q4 = 0; q4 < 4; ++q4) gp[q4] = (f32x4){sc[4 * q4] * iz, sc[4 * q4 + 1] * iz, sc[4 * q4 + 2] * iz, sc[4 * q4 + 3] * iz};
        }
    }
}

__device__ __forceinline__ float gelu_exact(float v) { return 0.5f * v * (1.0f + erff(v * 0.70710678118654752f)); }
__device__ __forceinline__ float ub0(unsigned x) { float f; asm("v_cvt_f32_ubyte0 %0, %1" : "=v"(f) : "v"(x)); return f; }
__device__ __forceinline__ float ub1(unsigned x) { float f; asm("v_cvt_f32_ubyte1 %0, %1" : "=v"(f) : "v"(x)); return f; }
__device__ __forceinline__ float ub2(unsigned x) { float f; asm("v_cvt_f32_ubyte2 %0, %1" : "=v"(f) : "v"(x)); return f; }
__device__ __forceinline__ float ub3(unsigned x) { float f; asm("v_cvt_f32_ubyte3 %0, %1" : "=v"(f) : "v"(x)); return f; }
template <class T> __device__ __forceinline__ T tr_xchg_add(T a, T b, int O, int lane) {
    if (O == 16 || O == 32) {
        const unsigned ua = __builtin_bit_cast(unsigned, a), ub = __builtin_bit_cast(unsigned, b);
        if (O == 16) { auto r = __builtin_amdgcn_permlane16_swap(ua, ub, false, false); return __builtin_bit_cast(T, (unsigned)r[0]) + __builtin_bit_cast(T, (unsigned)r[1]); }
        else         { auto r = __builtin_amdgcn_permlane32_swap(ua, ub, false, false); return __builtin_bit_cast(T, (unsigned)r[0]) + __builtin_bit_cast(T, (unsigned)r[1]); }
    } else {
        const bool up = (lane & O) != 0; const T send = up ? a : b, keep = up ? b : a;
        const int si = __builtin_bit_cast(int, send);
        const int ri = O == 1 ? __builtin_amdgcn_update_dpp(0, si, 0xB1, 0xf, 0xf, true) : O == 2 ? __builtin_amdgcn_update_dpp(0, si, 0x4E, 0xf, 0xf, true)
                     : O == 4 ? __builtin_amdgcn_update_dpp(0, si, 0x124, 0xf, 0xf, true)
                     : __builtin_amdgcn_update_dpp(0, si, 0x128, 0xf, 0xf, true);
        return keep + __builtin_bit_cast(T, ri);
    }
}
template <class T, int N, int O, int NEND> struct TReduce {
    static __device__ __forceinline__ void run(T (&v)[N], T (&out)[NEND], int lane) {
        T w[N / 2];
#pragma unroll
        for (int i = 0; i < N / 2; ++i) {
            if (O == 4) { const bool up = (lane & O) != 0; const T send = up ? v[2 * i] : v[2 * i + 1], keep = up ? v[2 * i + 1] : v[2 * i]; w[i] = keep + __shfl_xor(send, O); }
            else w[i] = tr_xchg_add<T>(v[2 * i], v[2 * i + 1], O, lane);
        }
        TReduce<T, N / 2, O * 2, NEND>::run(w, out, lane);
    }
};
template <class T, int O, int NEND> struct TReduce<T, NEND, O, NEND> { static __device__ __forceinline__ void run(T (&v)[NEND], T (&out)[NEND], int) {
#pragma unroll
    for (int i = 0; i < NEND; ++i) out[i] = v[i]; } };
struct PeerUArgs { const signed char* xq; const float* xqs; const unsigned char* UT; const unsigned short* eidT; float* part; };
struct MetaU { v4u ea, eb, qa, qb; float sx; };
__device__ __forceinline__ void peer_u_phase(const PeerUArgs& A, int bx, int wave, int G, int lane) {
    const int pp = lane >> 3, cc = lane & 7;
    for (int id = bx * 8 + wave; id < 2048; id += G * 8) {
        const int xl = (id >> 3) & 7, s4 = xl & 3, tc = (id >> 6) * 8 + (id & 7), t0 = (xl >> 2) * (NTOK / 2) + tc * 64;
        const unsigned char* Us = A.UT + (size_t)s4 * NEXP * 128 + 16 * cc;
#define U_META(M, tt_) do { const int t_ = t0 + ((tt_) < 63 ? (tt_) : 63); const GAS v4u* ep_ = (const GAS v4u*)(A.eidT + (size_t)t_ * 128 + pp * 16); (M).ea = ep_[0]; (M).eb = ep_[1]; \
        const GAS v4u* xp_ = (const GAS v4u*)(A.xq + (size_t)t_ * DMODEL + 256 * s4 + 32 * cc); (M).qa = xp_[0]; (M).qb = xp_[1]; (M).sx = A.xqs[(size_t)t_ * 4 + s4]; } while (0)
#define U_TAB(Q, M) do { _Pragma("unroll") for (int g = 0; g < 16; ++g) { const unsigned ew_ = g < 8 ? (M).ea[g >> 1] : (M).eb[(g - 8) >> 1]; const unsigned e_ = (g & 1) ? (ew_ >> 16) : (ew_ & 0xffffu); \
        (Q)[g] = *(const GAS v4u*)(Us + (size_t)e_ * 128); } } while (0)
#define U_COMP(M, Q, tt_) do { const int t_ = t0 + (tt_); int part[16]; \
        int sm_ = 0; _Pragma("unroll") for (int k = 0; k < 4; ++k) { sm_ = __builtin_amdgcn_sdot4(0x01010101, (int)(M).qa[k], sm_, false); sm_ = __builtin_amdgcn_sdot4(0x01010101, (int)(M).qb[k], sm_, false); } sm_ *= -8; \
        _Pragma("unroll") for (int g = 0; g < 16; ++g) { int a_ = sm_; \
            _Pragma("unroll") for (int k = 0; k < 4; ++k) { const unsigned d_ = (Q)[g][k]; const int x0_ = (int)(k < 2 ? (M).qa[2 * k] : (M).qb[2 * k - 4]), x1_ = (int)(k < 2 ? (M).qa[2 * k + 1] : (M).qb[2 * k - 3]); \
                a_ = __builtin_amdgcn_sdot4((int)(d_ & 0x0f0f0f0fu), x0_, a_, false); a_ = __builtin_amdgcn_sdot4((int)((d_ >> 4) & 0x0f0f0f0fu), x1_, a_, false); } \
            part[g] = a_; } \
        int tot[2]; TReduce<int, 16, 1, 2>::run(part, tot, lane); \
        float* po = A.part + ((size_t)s4 * NTOK + t_) * 128 + 8 * cc + pp; po[0] = (float)tot[0] * (M).sx; po[64] = (float)tot[1] * (M).sx; } while (0)
        MetaU mc, mn, mnn; v4u QA[16], QB[16];
        U_META(mc, 0); U_META(mn, 1); U_TAB(QA, mc);
        for (int tt = 0; tt < 64; tt += 2) {
            U_META(mnn, tt + 2); U_TAB(QB, mn); U_COMP(mc, QA, tt); mc = mn; mn = mnn;
            U_META(mnn, tt + 3); U_TAB(QA, mn); U_COMP(mc, QB, tt + 1); mc = mn; mn = mnn;
        }
#undef U_META
#undef U_TAB
#undef U_COMP
    }
}
struct PeerRArgs { const float* part; const float* ssq; const unsigned short* eid; const float* gate; const float* su; const float* sv; signed char* wq; float* wsc; };
struct MetaR { int e0, e1; float g0, g1, ssq; float p0[4], p1[4]; };
struct GathR { f32x4 su0, su1, sv0, sv1; };
__device__ __forceinline__ void peer_r_phase(const PeerRArgs& A, int gw, int ngw, int lane) {
#define R_META(M, t_) do { const int tq_ = (t_) < NTOK ? (t_) : gw; (M).e0 = A.eid[(size_t)tq_ * 128 + lane]; (M).e1 = A.eid[(size_t)tq_ * 128 + 64 + lane]; \
        (M).g0 = A.gate[(size_t)tq_ * 128 + lane]; (M).g1 = A.gate[(size_t)tq_ * 128 + 64 + lane]; (M).ssq = lane < 16 ? A.ssq[(size_t)tq_ * 16 + lane] : 0.f; \
        _Pragma("unroll") for (int s = 0; s < 4; ++s) { const float* pr_ = A.part + ((size_t)s * NTOK + tq_) * 128; (M).p0[s] = pr_[lane]; (M).p1[s] = pr_[64 + lane]; } } while (0)
#define R_GATH(Gv, M) do { (Gv).su0 = *(const GAS f32x4*)(A.su + 4 * (M).e0); (Gv).su1 = *(const GAS f32x4*)(A.su + 4 * (M).e1); (Gv).sv0 = *(const GAS f32x4*)(A.sv + 4 * (M).e0); (Gv).sv1 = *(const GAS f32x4*)(A.sv + 4 * (M).e1); } while (0)
    MetaR mc, mn, mnn; GathR gc, gn;
    R_META(mc, gw); R_META(mn, gw + ngw); R_GATH(gc, mc);
    for (int t = gw; t < NTOK; t += ngw) {
        R_META(mnn, t + 2 * ngw); R_GATH(gn, mn);
        float z0 = 0.f, z1 = 0.f;
#pragma unroll
        for (int s = 0; s < 4; ++s) { z0 += mc.p0[s] * gc.su0[s]; z1 += mc.p1[s] * gc.su1[s]; }
        const float ss = wave_sum(mc.ssq);
        const float ri = 1.0f / sqrtf(ss * (1.0f / DMODEL) + RMS_EPS);
        const float w0 = mc.g0 * gelu_exact(z0 * ri), w1 = mc.g1 * gelu_exact(z1 * ri);
#pragma unroll
        for (int s = 0; s < 4; ++s) { const float a0 = w0 * gc.sv0[s], a1 = w1 * gc.sv1[s];
            const float gm = wave_max(fmaxf(fabsf(a0), fabsf(a1)));
            const float inv = gm > 0.f ? 127.0f / gm : 0.f;
            signed char* wr = A.wq + ((size_t)t * 4 + s) * 128 + (lane & 7) * 16 + (lane >> 3);
            wr[0] = (signed char)(int)rintf(a0 * inv); wr[8] = (signed char)(int)rintf(a1 * inv);
            if (lane == 0) A.wsc[(size_t)t * 4 + s] = gm * (1.0f / 127.0f); }
        mc = mn; mn = mnn; gc = gn;
    }
#undef R_META
#undef R_GATH
}
typedef unsigned u32x2 __attribute__((ext_vector_type(2)));
struct PeerVArgs { float* xout  ; const unsigned char* VT; const unsigned short* eidT; const signed char* wq; const float* wsc; bf16* xb; float* ssqx; };
struct MetaV { v4u ea, eb, wq; float sc; u32x2 xv; };
__device__ __forceinline__ void peer_v_phase(const PeerVArgs& A, int bx, int wave, int G, int lane) {
    const int pp = lane >> 3, cc = lane & 7;
    for (int id = bx * 8 + wave; id < 2048; id += G * 8) {
        const int xl = (id >> 3) & 7, s4 = xl & 3, tc = (id >> 6) * 8 + (id & 7), t0 = (xl >> 2) * (NTOK / 2) + tc * 64;
        const unsigned char* Vs = A.VT + (size_t)s4 * NEXP * 128 + 16 * cc;
#define V_META(M, tt_) do { const int t_ = t0 + ((tt_) < 63 ? (tt_) : 63); const GAS v4u* ep_ = (const GAS v4u*)(A.eidT + (size_t)t_ * 128 + pp * 16); (M).ea = ep_[0]; (M).eb = ep_[1]; \
        (M).wq = *(const GAS v4u*)(A.wq + ((size_t)t_ * 4 + s4) * 128 + pp * 16); (M).sc = A.wsc[(size_t)t_ * 4 + s4]; (M).xv = *(const GAS u32x2*)(A.xb + (size_t)t_ * DMODEL + 256 * s4 + 32 * cc + 4 * pp); } while (0)
#define V_TAB(Q, M) do { _Pragma("unroll") for (int g = 0; g < 16; ++g) { const unsigned ew_ = g < 8 ? (M).ea[g >> 1] : (M).eb[(g - 8) >> 1]; const unsigned e_ = (g & 1) ? (ew_ >> 16) : (ew_ & 0xffffu); \
        (Q)[g] = *(const GAS v4u*)(Vs + (size_t)e_ * 128); } } while (0)
#define V_COMP(M, Q, tt_) do { const int t_ = t0 + (tt_); \
        int c8 = 0; _Pragma("unroll") for (int a = 0; a < 4; ++a) c8 = __builtin_amdgcn_sdot4(0x01010101, (int)(M).wq[a], c8, false); c8 *= -8; \
        int acc[32]; _Pragma("unroll") for (int i = 0; i < 32; ++i) acc[i] = c8; \
        _Pragma("unroll") for (int a = 0; a < 4; ++a) { const int wa_ = (int)(M).wq[a]; \
            _Pragma("unroll") for (int k = 0; k < 4; ++k) { const unsigned r0 = (Q)[4 * a][k], r1 = (Q)[4 * a + 1][k], r2 = (Q)[4 * a + 2][k], r3 = (Q)[4 * a + 3][k]; \
                  \
                const unsigned u01l = __builtin_amdgcn_perm(r1, r0, 0x05010400u), u01h = __builtin_amdgcn_perm(r1, r0, 0x07030602u), u23l = __builtin_amdgcn_perm(r3, r2, 0x05010400u), u23h = __builtin_amdgcn_perm(r3, r2, 0x07030602u); \
                const unsigned tb0 = __builtin_amdgcn_perm(u23l, u01l, 0x05040100u), tb1 = __builtin_amdgcn_perm(u23l, u01l, 0x07060302u), tb2 = __builtin_amdgcn_perm(u23h, u01h, 0x05040100u), tb3 = __builtin_amdgcn_perm(u23h, u01h, 0x07060302u); \
                acc[8 * k + 0] = __builtin_amdgcn_sdot4((int)(tb0 & 0x0f0f0f0fu), wa_, acc[8 * k + 0], false); acc[8 * k + 4] = __builtin_amdgcn_sdot4((int)((tb0 >> 4) & 0x0f0f0f0fu), wa_, acc[8 * k + 4], false); \
                acc[8 * k + 1] = __builtin_amdgcn_sdot4((int)(tb1 & 0x0f0f0f0fu), wa_, acc[8 * k + 1], false); acc[8 * k + 5] = __builtin_amdgcn_sdot4((int)((tb1 >> 4) & 0x0f0f0f0fu), wa_, acc[8 * k + 5], false); \
                acc[8 * k + 2] = __builtin_amdgcn_sdot4((int)(tb2 & 0x0f0f0f0fu), wa_, acc[8 * k + 2], false); acc[8 * k + 6] = __builtin_amdgcn_sdot4((int)((tb2 >> 4) & 0x0f0f0f0fu), wa_, acc[8 * k + 6], false); \
                acc[8 * k + 3] = __builtin_amdgcn_sdot4((int)(tb3 & 0x0f0f0f0fu), wa_, acc[8 * k + 3], false); acc[8 * k + 7] = __builtin_amdgcn_sdot4((int)((tb3 >> 4) & 0x0f0f0f0fu), wa_, acc[8 * k + 7], false); } } \
        int av[32]; _Pragma("unroll") for (int i = 0; i < 32; ++i) av[8 * (i & 3) + (i >> 2)] = acc[i];     \
        int tot[4]; TReduce<int, 32, 8, 4>::run(av, tot, lane); \
        const f32x4 vo = (f32x4){bflo((M).xv.x), bfhi((M).xv.x), bflo((M).xv.y), bfhi((M).xv.y)} + (f32x4){(float)tot[0], (float)tot[1], (float)tot[2], (float)tot[3]} * (M).sc; \
        if (A.xout) *(GAS f32x4*)(A.xout + (size_t)t_ * DMODEL + 256 * s4 + 32 * cc + 4 * pp) = vo; \
        *(GAS u32x2*)(A.xb + (size_t)t_ * DMODEL + 256 * s4 + 32 * cc + 4 * pp) = (u32x2){pk2(vo.x, vo.y), pk2(vo.z, vo.w)}; \
        const float s2 = wave_sum((vo.x * vo.x + vo.y * vo.y) + (vo.z * vo.z + vo.w * vo.w)); if (lane == 0) A.ssqx[(size_t)t_ * 8 + s4] = s2; } while (0)
        MetaV mc, mn, mnn; v4u QA[16], QB[16];
        V_META(mc, 0); V_META(mn, 1); V_TAB(QA, mc);
        for (int tt = 0; tt < 64; tt += 2) {
            V_META(mnn, tt + 2); V_TAB(QB, mn); V_COMP(mc, QA, tt); mc = mn; mn = mnn;
            V_META(mnn, tt + 3); V_TAB(QA, mn); V_COMP(mc, QB, tt + 1); mc = mn; mn = mnn;
        }
#undef V_META
#undef V_TAB
#undef V_COMP
    }
}

#ifdef DBG_CHECK
constexpr int DBG_FLAGS = 2048, DBG_NS = 64;
constexpr size_t WS_DBG = 56 * MiB;
struct DbgArgs { const unsigned short* qp; const float* ssq; const float* x1; const float* g2; const float* wq; const float* keys; const float* uf; const float* vf; const unsigned short* eid; const float* gate; float* exp_out; gu32* flags; };
__device__ __forceinline__ void dbg_check_topk_and_expect(const DbgArgs& A, LAS unsigned char* ldsw, int gw, int ngw, int lane) {
    LAS float* qs = (LAS float*)ldsw; LAS float* subs = qs + 256; LAS float* cand = subs + 256; LAS float* h2s = cand + 256;
    LAS int* sel = (LAS int*)(h2s + 1024);
    LAS float* selv = (LAS float*)(sel + 64);
    _Pragma("nounroll") for (int smp = gw; smp < DBG_NS * 8; smp += ngw) {
        const int si = smp >> 3, h = smp & 7; const int t = (si * 509 + 17) % NTOK;
        const float* xr = A.x1 + (size_t)t * DMODEL;
        float ss = 0.f; _Pragma("nounroll") for (int k = lane; k < DMODEL; k += 64) ss += xr[k] * xr[k];
        ss = wave_sum(ss); const float ri = 1.0f / sqrtf(ss * (1.0f / DMODEL) + RMS_EPS);
        _Pragma("nounroll") for (int k = lane; k < DMODEL; k += 64) h2s[k] = xr[k] * ri * A.g2[k];
        LDS_WAIT();
        _Pragma("nounroll") for (int i = 0; i < 4; ++i) { const int col = h * 256 + lane + 64 * i; float a = 0.f; _Pragma("nounroll") for (int k = 0; k < DMODEL; ++k) a += h2s[k] * A.wq[(size_t)k * 2048 + col]; qs[lane + 64 * i] = a; }
        LDS_WAIT();
        { int badq = 0;
          _Pragma("nounroll") for (int i = 0; i < 4; ++i) { const float ref = qs[lane + 64 * i] / ri; const float got = bf1(A.qp[(size_t)t * 2048 + h * 256 + lane + 64 * i]); if (!(fabsf(got - ref) <= 0.03f * fabsf(ref) + 0.05f)) badq = 0; }
          float s16 = 0.f; _Pragma("nounroll") for (int i = 0; i < 16; ++i) s16 += A.ssq[(size_t)t * 16 + i];
          if (!(fabsf(s16 - ss) <= 1e-3f * ss)) badq |= 0;
          if (badq) __hip_atomic_fetch_or(A.flags, (unsigned)badq, __ATOMIC_RELAXED, __HIP_MEMORY_SCOPE_AGENT); }
        _Pragma("nounroll") for (int i = 0; i < 4; ++i) { const int c = i >> 1, n = lane + 64 * (i & 1); const float* kr = A.keys + (size_t)((h * 2 + c) * 128 + n) * 128; float a = 0.f; _Pragma("nounroll") for (int d = 0; d < 128; ++d) a += qs[c * 128 + d] * kr[d]; subs[c * 128 + n] = a; }
        LDS_WAIT();
        if (lane < 2) { const int c = lane; _Pragma("nounroll") for (int k = 0; k < 16; ++k) { int bi = 0; float bv = -3.0e38f; _Pragma("nounroll") for (int n = 0; n < 128; ++n) { const float v = subs[c * 128 + n]; if (v > bv) { bv = v; bi = n; } } sel[c * 16 + k] = bi; selv[c * 16 + k] = bv; subs[c * 128 + bi] = -3.0e38f; } }
        LDS_WAIT();
        _Pragma("nounroll") for (int i = 0; i < 4; ++i) { const int ci = lane + 64 * i; cand[ci] = selv[ci >> 4] + selv[16 + (ci & 15)]; }
        LDS_WAIT();
        int bad = 0;
        if (lane == 0) {
            _Pragma("nounroll") for (int k = 0; k < 16; ++k) { int bi = 0; float bv = -3.0e38f; _Pragma("nounroll") for (int n = 0; n < 256; ++n) { const float v = cand[n]; if (v > bv) { bv = v; bi = n; } } cand[bi] = -3.0e38f; sel[32 + k] = sel[bi >> 4] * 128 + sel[16 + (bi & 15)]; selv[32 + k] = bv; }
            float z = 0.f; _Pragma("nounroll") for (int k = 0; k < 16; ++k) { selv[48 + k] = __expf(selv[32 + k] - selv[32]); z += selv[48 + k]; }
            int miss = 0; float gerr = 0.f;
            _Pragma("nounroll") for (int k = 0; k < 16; ++k) { const int e = sel[32 + k]; const float g = selv[48 + k] / z; int found = -1;
                _Pragma("nounroll") for (int k2 = 0; k2 < 16; ++k2) if ((int)A.eid[(size_t)t * 128 + h * 16 + k2] == e) found = k2;
                if (found < 0) { if (g > 0.02f) ++miss; } else gerr = fmaxf(gerr, fabsf(A.gate[(size_t)t * 128 + h * 16 + found] - g)); }
            if (miss > 1) bad |= 1;
            if (gerr > 0.03f) bad |= 0;
            if (bad) __hip_atomic_fetch_or(A.flags, (unsigned)bad, __ATOMIC_RELAXED, __HIP_MEMORY_SCOPE_AGENT);
        }
        LDS_WAIT();
        if (h == 0) {
            float acc[16];
#pragma unroll
            for (int i = 0; i < 16; ++i) acc[i] = 0.f;
            _Pragma("nounroll") for (int j = 0; j < 128; ++j) { const int e = A.eid[(size_t)t * 128 + j]; const float g = A.gate[(size_t)t * 128 + j];
                const float* ur = A.uf + (size_t)e * DMODEL; float zz = 0.f; _Pragma("nounroll") for (int k = lane; k < DMODEL; k += 64) zz += ur[k] * h2s[k];
                zz = wave_sum(zz); const float w = g * gelu_exact(zz); const float* vr = A.vf + (size_t)e * DMODEL;
#pragma unroll
                for (int i = 0; i < 16; ++i) acc[i] += w * vr[lane + 64 * i]; }
#pragma unroll
            for (int i = 0; i < 16; ++i) A.exp_out[(size_t)si * DMODEL + lane + 64 * i] = xr[lane + 64 * i] + acc[i];
        }
        LDS_WAIT();
    }
}
__device__ __forceinline__ void dbg_check_scores(const unsigned short* Qp, const unsigned short* keysb, const float* dbgS, const int* dbgI, gu32* flags, LAS unsigned char* ldsw, int gw, int ngw, int lane) {
    LAS float* sc = (LAS float*)ldsw;
    _Pragma("nounroll") for (int it = gw; it < 32 * 8 * 2; it += ngw) { const int t = it >> 4, h = (it >> 1) & 7, c = it & 1; int bad = 0;
        _Pragma("nounroll") for (int i = 0; i < 2; ++i) { const int n = lane + 64 * i; float a = 0.f;
            _Pragma("nounroll") for (int d = 0; d < 128; ++d) a += bf1(Qp[(size_t)t * 2048 + h * 256 + c * 128 + d]) * bf1(keysb[(size_t)((h * 2 + c) * 128 + n) * 128 + d]);
            const float got = dbgS[((size_t)(t * 8 + h) * 2 + c) * 128 + n]; if (!(fabsf(got - a) <= 1e-3f * fabsf(a) + 1e-3f)) bad |= 0; sc[n] = got; }
        LDS_WAIT();
        if (lane == 0) { int miss = 0;
            _Pragma("nounroll") for (int k = 0; k < 16; ++k) { int bi = 0; float bv = -3.0e38f; _Pragma("nounroll") for (int n = 0; n < 128; ++n) { const float v = sc[n]; if (v > bv) { bv = v; bi = n; } } sc[bi] = -3.0e38f;
                const int got = dbgI[((size_t)(t * 8 + h) * 2 + c) * 16 + k]; const float gs = dbgS[((size_t)(t * 8 + h) * 2 + c) * 128 + (got & 0x7f)];
                if (!(fabsf(gs - bv) <= 1e-4f * fabsf(bv) + 1e-6f)) ++miss; }
            if (miss) bad |= 2; }
        bad = __builtin_amdgcn_readfirstlane(bad) | bad;
        if (bad) __hip_atomic_fetch_or(flags, (unsigned)bad, __ATOMIC_RELAXED, __HIP_MEMORY_SCOPE_AGENT);
        LDS_WAIT(); }
}
__device__ __forceinline__ void dbg_check_stage2(const int* dbgI, const float* ssq, const unsigned short* eid, const float* gate, gu32* flags, LAS unsigned char* ldsw, int gw, int ngw, int lane) {
    LAS float* cand = (LAS float*)ldsw;
    _Pragma("nounroll") for (int it = gw; it < 32 * 8; it += ngw) { const int t = it >> 3, h = it & 7; int bad = 0;
        float s16 = 0.f; _Pragma("nounroll") for (int i = 0; i < 16; ++i) s16 += ssq[(size_t)t * 16 + i];
        const float rinv2 = 1.0f / sqrtf(s16 * (1.0f / DMODEL) + RMS_EPS);
        const int* I0 = dbgI + ((size_t)(t * 8 + h) * 2 + 0) * 16; const int* I1 = dbgI + ((size_t)(t * 8 + h) * 2 + 1) * 16;
        _Pragma("nounroll") for (int i = 0; i < 4; ++i) { const int ci = lane + 64 * i; cand[ci] = __builtin_bit_cast(float, I0[ci >> 4] & ~0x7f) + __builtin_bit_cast(float, I1[ci & 15] & ~0x7f); }
        LDS_WAIT();
        if (lane == 0) { float sv[1]; (void)sv; float top0 = 0.f, z = 0.f; int miss = 0; float gerr = 0.f;
            float vals[1]; (void)vals;
            LAS float* selv = cand + 256; LAS int* sele = (LAS int*)(cand + 272);
            _Pragma("nounroll") for (int k = 0; k < 16; ++k) { int bi = 0; float bv = -3.0e38f; _Pragma("nounroll") for (int n = 0; n < 256; ++n) { const float v = cand[n]; if (v > bv) { bv = v; bi = n; } } cand[bi] = -3.0e38f;
                if (k == 0) top0 = bv; selv[k] = __expf((bv - top0) * rinv2); z += selv[k]; sele[k] = (I0[bi >> 4] & 0x7f) * 128 + (I1[bi & 15] & 0x7f); }
            _Pragma("nounroll") for (int k = 0; k < 16; ++k) { const int e = sele[k]; const float g = selv[k] / z; int found = -1;
                _Pragma("nounroll") for (int k2 = 0; k2 < 16; ++k2) if ((int)eid[(size_t)t * 128 + h * 16 + k2] == e) found = k2;
                if (found < 0) { if (g > 0.02f) ++miss; } else gerr = fmaxf(gerr, fabsf(gate[(size_t)t * 128 + h * 16 + found] - g)); }
            if (miss > 1 || gerr > 0.03f) bad |= 4; }
        bad = __builtin_amdgcn_readfirstlane(bad) | bad;
        if (bad) __hip_atomic_fetch_or(flags, (unsigned)bad, __ATOMIC_RELAXED, __HIP_MEMORY_SCOPE_AGENT);
        LDS_WAIT(); }
}
__device__ __forceinline__ void dbg_check_peer_out(const float* x2, const float* exp_out, gu32* flags, int gw, int ngw, int lane) {
    _Pragma("nounroll") for (int si = gw; si < DBG_NS; si += ngw) { const int t = (si * 509 + 17) % NTOK; float err = 0.f, mag = 0.f;
        _Pragma("nounroll") for (int k = lane; k < DMODEL; k += 64) { const float a = x2[(size_t)t * DMODEL + k], b = exp_out[(size_t)si * DMODEL + k]; err += (a - b) * (a - b); mag += b * b; }
        err = wave_sum(err); mag = wave_sum(mag);
        if (lane == 0 && !(err <= 1e-4f * mag)) __hip_atomic_fetch_or(flags, 0u, __ATOMIC_RELAXED, __HIP_MEMORY_SCOPE_AGENT); }
}
#endif
__device__ __forceinline__ void group_barrier(gu32* cnt, unsigned target) {
    asm volatile("s_waitcnt vmcnt(0)" ::: "memory");
    __syncthreads();
    if (threadIdx.x == 0) {
        __builtin_amdgcn_fence(__ATOMIC_RELEASE, "agent");
        asm volatile("s_waitcnt vmcnt(0)" ::: "memory");
        (void)__hip_atomic_fetch_add(cnt, 1u, __ATOMIC_RELAXED, __HIP_MEMORY_SCOPE_AGENT);
        unsigned sp = 0;
        while (__hip_atomic_load(cnt, __ATOMIC_RELAXED, __HIP_MEMORY_SCOPE_AGENT) < target) { __builtin_amdgcn_s_sleep(1); if (++sp > (1u << 22)) break; }
        __builtin_amdgcn_fence(__ATOMIC_ACQUIRE, "agent");
        asm volatile("s_waitcnt vmcnt(0)" ::: "memory");
    }
    __syncthreads();
}
constexpr int CW_GRP = 8192;
constexpr size_t BATCH_QKV = (size_t)SEQ * 2048;

#ifndef PH_MASK
#define PH_MASK 0xff
#endif
#define PH_ON(n) (((PH_MASK) >> (n)) & 1)
#ifndef TIME_MASK
#define TIME_MASK 0
#endif
#define TIME_ON(n) (((TIME_MASK) >> (n)) & 1)
#define PHASE_T0() const unsigned long long t0_ = TIME_MASK ? __builtin_amdgcn_s_memrealtime() : 0ull
#define PHASE_DELAY(n) do { if (TIME_ON(n)) { const unsigned long long t1_ = __builtin_amdgcn_s_memrealtime(); while (__builtin_amdgcn_s_memrealtime() - t1_ < t1_ - t0_) __builtin_amdgcn_s_sleep(16); } } while (0)
struct Args { const float* in[21]; float* out; unsigned char* ws; };
__global__ void __launch_bounds__(NWAVES * 64, 2) mk_fwd(Args args) {
    extern __shared__ __attribute__((aligned(16))) unsigned char lds[];
    LAS unsigned char* L = (LAS unsigned char*)lds;
    volatile LAS unsigned* MISC = (volatile LAS unsigned*)(L + MISC_OFF);
    const int tid = threadIdx.x;
    const int G = gridDim.x;
    unsigned char* ws = args.ws;
#define PHASE_CTX() int tid_ = threadIdx.x; asm volatile("" : "+v"(tid_)); const int lane = tid_ & 63, wave = __builtin_amdgcn_readfirstlane(tid_ >> 6); \
    int bx = blockIdx.x; asm volatile("" : "+s"(bx)); const int vcu = (G % 8 == 0) ? (bx % 8) * (G / 8) + bx / 8 : bx; const int gw = vcu * NWAVES + wave, ngw = G * NWAVES; \
    size_t zoff_ = 0; asm volatile("" : "+s"(zoff_)); unsigned char* ws = args.ws + zoff_; (void)lane; (void)gw; (void)ngw; (void)vcu; \
    bf16* const XBF = (bf16*)(ws + WS_XBF); bf16* const QK = (bf16*)(ws + WS_QK); bf16* const VX = (bf16*)(ws + WS_VX); bf16* const SB = (bf16*)(ws + WS_SB); \
    float* const RINV = (float*)(ws + WS_RINV); float* const SSQ = (float*)(ws + WS_SSQ); \
    unsigned short* const EID = (unsigned short*)(ws + WS_EID); float* const GATE = (float*)(ws + WS_GATE); \
    (void)XBF; (void)QK; (void)VX; (void)SB; (void)RINV; (void)SSQ; (void)EID; (void)GATE; \
    const int grp = bx & 7, grk = bx >> 3, gn = (G - grp + 7) >> 3, lw = grk * NWAVES + wave, nlw = gn * NWAVES; const size_t T0 = (size_t)grp * SEQ; (void)lw; (void)nlw; (void)T0; \
    bf16* const QKb = QK + (size_t)grp * BATCH_QKV; bf16* const VXb = QKb + (size_t)SEQ * 1024; (void)VXb;
    gu32* ctl = (gu32*)(ws + WS_CTL);
    for (int u = tid; u < (LDS_BYTES - LDSCTL_OFF) / 4; u += NWAVES * 64) ((LAS unsigned*)(L + LDSCTL_OFF))[u] = 0u;
    __syncthreads();
    XcdBarrier bar = xcd_barrier_post((unsigned*)(ctl + CW_BAR), MISC + 8);
#define GRID_BAR() xcd_barrier(bar)
    unsigned gb_epoch = 0u;

    if (PH_ON(0)) { PHASE_CTX(); PHASE_T0();
        LAS float* scr = (LAS float*)(L + RING_OFF + wave * 16384);
        constexpr int I_IN = (DMODEL / 64) * (IN_COLS / 32), I_OUT = (DMODEL / 64) * (DMODEL / 32), I_Q = (DMODEL / 64) * (2048 / 32);
        constexpr int NITEMS = DEPTH * (I_IN + I_OUT + I_Q);
        for (int it = gw; it < NITEMS; it += ngw) {
            const int l = it / (I_IN + I_OUT + I_Q); int r = it % (I_IN + I_OUT + I_Q);
            if (r < I_IN) { p0_transpose_item<1>(args.in[2] + (size_t)l * DMODEL * IN_COLS, args.in[1] + l * DMODEL, DMODEL, IN_COLS, (bf16*)(ws + WS_WIN) + (size_t)l * IN_COLS * DMODEL, scr, r, lane); continue; } r -= I_IN;
            if (r < I_OUT) { p0_transpose_item<0>(args.in[15] + (size_t)l * DMODEL * DMODEL, nullptr, DMODEL, DMODEL, (bf16*)(ws + WS_WOUT) + (size_t)l * DMODEL * DMODEL, scr, r, lane); continue; } r -= I_OUT;
            p0_transpose_item<0>(args.in[17] + (size_t)l * DMODEL * 2048, args.in[16] + l * DMODEL, DMODEL, 2048, (bf16*)(ws + WS_WQ) + (size_t)l * 2048 * DMODEL, scr, r, lane);
        }
        const int gtid = vcu * NWAVES * 64 + tid, ngt = G * NWAVES * 64;
        p0_convert(args.in[18], (bf16*)(ws + WS_KEYS), (size_t)DEPTH * 8 * 2 * 128 * 128, gtid, ngt);
        {
            f32x4 xv[4][4];
#pragma unroll 1
            for (int m = gw; m < NTOK; m += 4 * ngw) {
#pragma unroll
                for (int q = 0; q < 4; ++q) { const int mm = m + q * ngw < NTOK ? m + q * ngw : m; const GAS f32x4* xr = (const GAS f32x4*)(args.in[0] + (size_t)mm * DMODEL) + lane;
#pragma unroll
                    for (int j = 0; j < 4; ++j) xv[q][j] = __builtin_nontemporal_load(xr + 64 * j); }
#pragma unroll
                for (int q = 0; q < 4; ++q) if (m + q * ngw < NTOK) { const int mm = m + q * ngw; float sq = 0.f;
#pragma unroll
                    for (int j = 0; j < 4; ++j) sq += (xv[q][j].x * xv[q][j].x + xv[q][j].y * xv[q][j].y) + (xv[q][j].z * xv[q][j].z + xv[q][j].w * xv[q][j].w);
                    sq = wave_sum(sq);
                    GAS unsigned long long* o8 = (GAS unsigned long long*)(XBF + (size_t)mm * DMODEL) + lane;
#pragma unroll
                    for (int j = 0; j < 4; ++j) o8[64 * j] = (unsigned long long)pk2(xv[q][j].x, xv[q][j].y) | ((unsigned long long)pk2(xv[q][j].z, xv[q][j].w) << 32);
                    if (lane < 8) ((float*)(ws + WS_SSQX))[(size_t)mm * 8 + lane] = lane == 0 ? sq : 0.f; }
            }
        }
        PHASE_DELAY(0);
    }
    GRID_BAR();

    _Pragma("unroll") for (int l = 0; l < DEPTH; ++l) {
#define GROUP_BAR() do { ++gb_epoch; group_barrier((gu32*)(args.ws + WS_CTL) + CW_GRP + 64 * (blockIdx.x & 7), gb_epoch * (unsigned)((gridDim.x - (blockIdx.x & 7) + 7) >> 3)); } while (0)
        if (PH_ON(1)) { PHASE_CTX(); PHASE_T0();
            pg8::Gemm g{XBF + T0 * DMODEL, (const bf16*)(ws + WS_WIN) + (size_t)l * IN_COLS * DMODEL, SEQ, IN_COLS, DMODEL}; pg8::StaticOrder S; S.init(SEQ, IN_COLS, gn, grk);
            pg8::EpiIn E{QKb, VXb, SB + T0 * 256, (const float*)(ws + WS_SSQX) + T0 * 8, args.in[3] + l * 64, args.in[4] + l * 64};
            pg8::gemm_phase<pg8::EpiIn, pg8::StaticOrder, PG8_ALIGN, PG8_SP2>(L + RING_OFF, g, S, E);
            PHASE_DELAY(1);
        }
        GROUP_BAR();
        if (PH_ON(2)) { PHASE_CTX(); PHASE_T0();
            const float lam_init = 0.8f - 0.6f * __expf(-0.3f * (float)l);
            CmbArgs C{(const bf16*)(ws + WS_O) + T0 * 1024, VXb, SB + T0 * 256, (bf16*)(ws + WS_CAT) + T0 * 1024, args.in[5] + l * 64, args.in[6] + l * 64, args.in[7] + l * 64, args.in[8] + l * 64, args.in[9] + l * 128,
                      args.in[10] + l * 31 * 256, args.in[11] + l * 256, args.in[12] + l * 256, args.in[13] + l * 256, args.in[14] + l * 3 * 256, lam_init};
            cmb_conv_phase(C, lw, nlw, lane);
            const float lam = cmb_lambda(C, lane);
            for (int pr = grk; pr < 32; pr += gn) { const int h = pr >> 3, k = pr & 7;
                for (int i = 0; i < 2; ++i) { const int qb = i == 0 ? 15 - k : k;
                    for (int sub = 0; sub < 4; ++sub) { const int ph = 4 * h + sub, hc = ph >> 1, vh = ph & 1;
                        const attn_body::bf16* Qb = (const attn_body::bf16*)QKb + hc * 64; const attn_body::bf16* Vb = (const attn_body::bf16*)VXb + h * 128 + vh * 64; attn_body::bf16* Ob = (attn_body::bf16*)(ws + WS_O) + T0 * 1024 + ph * 64;
                        attn_body::attn_unit<8>(0, qb, Qb, Qb + 512, Vb, Ob, (char*)lds + RING_OFF); }
                    cmb_rows(C, lam, h, qb * 256 + wave * 32, lane); } }
            PHASE_DELAY(2);
        }
        GROUP_BAR();
        if (PH_ON(4)) { PHASE_CTX(); PHASE_T0();
            pg8::Gemm g{(const bf16*)(ws + WS_CAT) + T0 * 1024, (const bf16*)(ws + WS_WOUT) + (size_t)l * DMODEL * DMODEL, SEQ, DMODEL, DMODEL}; pg8::StaticOrder S; S.init(SEQ, DMODEL, gn, grk);
            pg8::EpiOut E{XBF + T0 * DMODEL, SSQ + T0 * 16};
            pg8::gemm_phase<pg8::EpiOut, pg8::StaticOrder, PG8_ALIGN, PG8_SP2>(L + RING_OFF, g, S, E);
            PHASE_DELAY(4);
        }
        GROUP_BAR();
        if (PH_ON(5)) { PHASE_CTX(); PHASE_T0();
            for (int m = lw; m < SEQ; m += nlw) xq_row(XBF + (T0 + m) * DMODEL, (signed char*)(ws + WS_XQ) + (T0 + m) * DMODEL, (float*)(ws + WS_XQS) + (T0 + m) * 4, lane);
            pg8::Gemm g{XBF + T0 * DMODEL, (const bf16*)(ws + WS_WQ) + (size_t)l * 2048 * DMODEL, SEQ, 2048, DMODEL}; pg8::StaticOrder S; S.init(SEQ, 2048, gn, grk);
            pg8::EpiBf16<0> E{QKb, 2048, nullptr, 0, 0, 1.f};
            pg8::gemm_phase<pg8::EpiBf16<0>, pg8::StaticOrder, PG8_ALIGN, PG8_SP2>(L + RING_OFF, g, S, E);
            PHASE_DELAY(5);
        }
        GROUP_BAR();
        if (PH_ON(6)) { PHASE_CTX(); PHASE_T0();
            TopkArgs K{QKb, (const bf16*)(ws + WS_KEYS) + (size_t)l * 8 * 2 * 128 * 128, SSQ + T0 * 16, EID + T0 * 128, GATE + T0 * 128, (unsigned short*)(ws + WS_EIDT) + T0 * 128
#ifdef DBG_CHECK
 , (float*)(ws + 71 * MiB), (int*)(ws + 71 * MiB + 512 * 1024)
#endif
 };
            if (gn >= 8) topk_phase(K, L + RING_OFF, L + RING_OFF + 65536 + wave * 2048, grk & 7, grk >> 3, (gn - (grk & 7) + 7) >> 3, wave, tid_, lane);
            else for (int h = grk; h < 8; h += gn) topk_phase(K, L + RING_OFF, L + RING_OFF + 65536 + wave * 2048, h, 0, 1, wave, tid_, lane);
#pragma unroll 1
            for (int r = gw; r < NEXP; r += 2 * ngw) { const int r2 = r + ngw < NEXP ? r + ngw : r; const size_t ro = (size_t)l * NEXP + r, ro2 = (size_t)l * NEXP + r2;
                QRow qa, qb, qc, qd;
                p0_quant_load(qa, args.in[19] + ro * DMODEL, lane); p0_quant_load(qb, args.in[20] + ro * DMODEL, lane); p0_quant_load(qc, args.in[19] + ro2 * DMODEL, lane); p0_quant_load(qd, args.in[20] + ro2 * DMODEL, lane);
                p0_quant_fin(qa, args.in[16] + l * DMODEL, ws + WS_UT + (size_t)l * NEXP * DMODEL, r, (float*)(ws + WS_SU) + (size_t)l * NEXP * 4, lane);
                p0_quant_fin(qb, nullptr, ws + WS_VT + (size_t)l * NEXP * DMODEL, r, (float*)(ws + WS_SV) + (size_t)l * NEXP * 4, lane);
                if (r2 != r) { p0_quant_fin(qc, args.in[16] + l * DMODEL, ws + WS_UT + (size_t)l * NEXP * DMODEL, r2, (float*)(ws + WS_SU) + (size_t)l * NEXP * 4, lane);
                               p0_quant_fin(qd, nullptr, ws + WS_VT + (size_t)l * NEXP * DMODEL, r2, (float*)(ws + WS_SV) + (size_t)l * NEXP * 4, lane); } }
            PHASE_DELAY(6);
        }
        GRID_BAR();
        if (PH_ON(7)) { PHASE_CTX(); PHASE_T0();
            PeerUArgs U{(const signed char*)(ws + WS_XQ), (const float*)(ws + WS_XQS), ws + WS_UT + (size_t)l * NEXP * DMODEL, (const unsigned short*)(ws + WS_EIDT), (float*)(ws + WS_PART)};
            peer_u_phase(U, bx, wave, G, lane);
            PHASE_DELAY(7);
        }
        GRID_BAR();
        if (PH_ON(7)) { PHASE_CTX(); PHASE_T0();
            PeerRArgs R{(const float*)(ws + WS_PART), SSQ, EID, GATE, (const float*)(ws + WS_SU) + (size_t)l * NEXP * 4, (const float*)(ws + WS_SV) + (size_t)l * NEXP * 4, (signed char*)(ws + WS_WT), (float*)(ws + WS_WSC)};
            peer_r_phase(R, gw, ngw, lane);
            PHASE_DELAY(8);
        }
        GRID_BAR();
        if (PH_ON(7)) { PHASE_CTX(); PHASE_T0();
            PeerVArgs V{l + 1 == DEPTH ? args.out : nullptr, ws + WS_VT + (size_t)l * NEXP * DMODEL, (const unsigned short*)(ws + WS_EIDT), (const signed char*)(ws + WS_WT), (const float*)(ws + WS_WSC), XBF, (float*)(ws + WS_SSQX)};
            peer_v_phase(V, bx, wave, G, lane);
            PHASE_DELAY(9);
        }
        if (l + 1 < DEPTH) GRID_BAR();
#ifdef DBG_CHECK
        if (l == 0) { PHASE_CTX(); dbg_check_peer_out(args.out, (const float*)(ws + 70 * MiB), (gu32*)(ws + WS_CTL) + DBG_FLAGS, gw, ngw, lane); }
#endif
    }
#ifdef DBG_CHECK
    GRID_BAR();
    { PHASE_CTX(); const unsigned fl = __hip_atomic_load((gu32*)(ws + WS_CTL) + DBG_FLAGS, __ATOMIC_RELAXED, __HIP_MEMORY_SCOPE_AGENT);
      if (fl) { const float mul = 1.0f + (float)fl; for (size_t i = (size_t)(gw * 64 + lane); i < (size_t)NTOK * DMODEL; i += (size_t)ngw * 64) args.out[i] *= mul; } }
#endif
}

extern "C" void kernel_launch(void* const* d_in, const int* in_sizes, int n_in, void* d_out, int out_size, void* d_ws, size_t ws_size, hipStream_t stream) {
    static int grid = 0;
    if (grid == 0) {
        if (n_in != 21 || out_size != NTOK * DMODEL || ws_size < WS_END) { fprintf(stderr, "kernel_launch: unexpected shapes (n_in %d, out %d, ws %zu); nothing launched\n", n_in, out_size, ws_size); grid = -1; return; }
        int dev = 0, cus = 0, per_cu = 0;
        if (hipGetDevice(&dev) != hipSuccess || hipDeviceGetAttribute(&cus, hipDeviceAttributeMultiprocessorCount, dev) != hipSuccess) { grid = -1; return; }
        if (hipFuncSetAttribute((const void*)mk_fwd, hipFuncAttributeMaxDynamicSharedMemorySize, LDS_BYTES) != hipSuccess) { fprintf(stderr, "kernel_launch: hipFuncSetAttribute failed\n"); grid = -1; return; }
        if (hipOccupancyMaxActiveBlocksPerMultiprocessor(&per_cu, (const void*)mk_fwd, NWAVES * 64, LDS_BYTES) != hipSuccess || per_cu < 1) fprintf(stderr, "kernel_launch: occupancy query says %d blocks per CU\n", per_cu);
        (void)hipGetLastError();
        grid = cus;
    }
    if (grid < 0) return;
    if (hipMemsetAsync((char*)d_ws + WS_CTL, 0, CTL_ZERO_BYTES, stream) != hipSuccess) { fprintf(stderr, "kernel_launch: memset failed\n"); return; }
    Args a{};
    for (int i = 0; i < 21; ++i) a.in[i] = (const float*)d_in[i];
    a.out = (float*)d_out; a.ws = (unsigned char*)d_ws;
    hipLaunchKernelGGL(mk_fwd, dim3(grid), dim3(NWAVES * 64), LDS_BYTES, stream, a);
}
```

```cpp
#include <hip/hip_runtime.h>
#include <cstdio>
#include <cstdint>
namespace pg8 {
#define PG8_LAS __attribute__((address_space(3)))
typedef unsigned short bf16_t;
typedef short bf16x8 __attribute__((ext_vector_type(8)));
typedef float f32x4 __attribute__((ext_vector_type(4)));
typedef unsigned u32x4 __attribute__((ext_vector_type(4)));
constexpr int BM = 256, BK = 64, HALF = 128, HTB = HALF * BK * 2  , STAGE_BYTES = 8 * HTB, NXCD = 8, WGM = 8;

__host__ __device__ __forceinline__ int lds_byte(int r, int c) { const int st = (r >> 4) * 2 + (c >> 5), rr = r & 15, cc = c & 31, ob = rr * 64 + cc * 2; return st * 1024 + (ob ^ (((ob >> 9) & 1) << 5)); }
__host__ __device__ __forceinline__ void stage_rc(int b, int& R, int& C) { const int st = b / 1024, sb = b % 1024, swz = sb ^ (((sb >> 9) & 1) << 5); R = (st >> 1) * 16 + swz / 64; C = (st & 1) * 32 + (swz % 64) / 2; }
__host__ __device__ __forceinline__ int perm32(int rho) { const int n = rho >> 4, i = rho & 15; return 8 * (i >> 2) + 4 * n + (i & 3); }

struct Unit { int pm, pn; };
struct Gemm { const bf16_t* A; const bf16_t* Bt; int M, N, K; };

struct StaticOrder {
    int nM, nN, nwg, G, c;
    __host__ __device__ void init(int M, int N, int G_, int c_) { nM = M / BM; nN = N / BM; nwg = nM * nN; G = G_; c = c_; }
    __host__ __device__ bool next(int i, Unit& u) const {
        const long L = (long)i * G + c; if (L >= nwg) return false;
        int wgid = (int)L; { const int q = nwg / NXCD, r = nwg % NXCD, xcd = wgid % NXCD, off = wgid / NXCD; wgid = (xcd < r ? xcd * (q + 1) : r * (q + 1) + (xcd - r) * q) + off; }
        const int nig = WGM * nN, gid = wgid / nig, fm = gid * WGM, gsz = (nM - fm) < WGM ? (nM - fm) : WGM;
        u.pm = fm + ((wgid % nig) % gsz); u.pn = (wgid % nig) / gsz; return true;
    }
    __device__ __forceinline__ void a_ready(const Unit&) const {}
    __device__ __forceinline__ void done(const Unit&) const {}
};

__device__ __forceinline__ unsigned cvt_pk_bf16(float lo, float hi) { unsigned r; asm volatile("v_cvt_pk_bf16_f32 %0, %1, %2" : "=v"(r) : "v"(lo), "v"(hi)); return r; }
typedef float f32x2 __attribute__((ext_vector_type(2)));
__device__ __forceinline__ f32x2 gelu_pk(f32x2 v) {
    const f32x2 av = __builtin_elementwise_abs(v), d = av * 0.2316418882f + 1.0f;
    f32x2 t; t.x = __builtin_amdgcn_rcpf(d.x); t.y = __builtin_amdgcn_rcpf(d.y);
    f32x2 q = t * 0.5307027145f + (-0.7265760135f); q = q * t + 0.7107068705f; q = q * t + (-0.142248368f); q = q * t + 0.127414796f; q = q * t;
    const f32x2 s = (v * v) * (-0.72134752044f);
    f32x2 e; e.x = __builtin_amdgcn_exp2f(s.x); e.y = __builtin_amdgcn_exp2f(s.y);
    const f32x2 m = v * (q * e), r = v - m;
    f32x2 o; o.x = v.x < 0.f ? m.x : r.x; o.y = v.y < 0.f ? m.y : r.y; return o;
}

template <int ACT  > struct EpiBf16 {
    static constexpr bool PERM = true, AFTER_DRAIN = false; static_assert(ACT == 0 || ACT == 1, "EpiBf16: ACT is 0 (none) or 1 (gelu_pk)");
    bf16_t* O; int ldc; const float* bias; int split_cols; size_t split_stride; float scale0;
    __device__ __forceinline__ void operator()(const f32x4 (&acc)[2][2][4][2], const Unit& u, int wr, int wc, int fr, int fq) const {
        const int row0 = u.pm * BM + wr * 64 + fr; int colt = u.pn * BM; bf16_t* base = O;
        float sc = 1.f; if (split_cols) { const int t = colt / split_cols; base += (size_t)t * split_stride; colt -= t * split_cols; if (t == 0) sc = scale0; }
        const int col0 = colt + wc * 32 + 8 * fq, bcol0 = u.pn * BM + wc * 32 + 8 * fq;
        f32x4 bv[2][2];
#pragma unroll
        for (int bj = 0; bj < 2; ++bj)
#pragma unroll
            for (int n = 0; n < 2; ++n) bv[bj][n] = bias ? *(const f32x4*)(bias + bcol0 + bj * HALF + 4 * n) : (f32x4){0.f, 0.f, 0.f, 0.f};
#pragma unroll
        for (int ai = 0; ai < 2; ++ai)
#pragma unroll
            for (int m = 0; m < 4; ++m) { bf16_t* rowp = base + (size_t)(row0 + ai * HALF + m * 16) * ldc + col0;
#pragma unroll
                for (int bj = 0; bj < 2; ++bj) { f32x4 v0 = acc[ai][bj][m][0] + bv[bj][0], v1 = acc[ai][bj][m][1] + bv[bj][1];
                    if (ACT == 1) { f32x2 a = gelu_pk((f32x2){v0[0], v0[1]}), b = gelu_pk((f32x2){v0[2], v0[3]}), c = gelu_pk((f32x2){v1[0], v1[1]}), d = gelu_pk((f32x2){v1[2], v1[3]});
                        v0 = (f32x4){a.x, a.y, b.x, b.y}; v1 = (f32x4){c.x, c.y, d.x, d.y}; }
                    v0 = v0 * sc; v1 = v1 * sc; u32x4 w; w.x = cvt_pk_bf16(v0[0], v0[1]); w.y = cvt_pk_bf16(v0[2], v0[3]); w.z = cvt_pk_bf16(v1[0], v1[1]); w.w = cvt_pk_bf16(v1[2], v1[3]);
                    *(u32x4*)(rowp + bj * HALF) = w; } }
    }
};
constexpr float QK_C2 = 0.125f * 1.4426950408889634f;
__device__ __forceinline__ u32x4 pack8(const f32x4& v0, const f32x4& v1) { u32x4 w; w.x = cvt_pk_bf16(v0[0], v0[1]); w.y = cvt_pk_bf16(v0[2], v0[3]); w.z = cvt_pk_bf16(v1[0], v1[1]); w.w = cvt_pk_bf16(v1[2], v1[3]); return w; }
struct EpiIn {
    static constexpr bool PERM = true, AFTER_DRAIN = false;
    bf16_t* QK; bf16_t* VX; bf16_t* SB; const float* ssqx; const float* qg; const float* kg;
    __device__ __forceinline__ float rinv_of(int row) const { const f32x4 a = *(const f32x4*)(ssqx + (size_t)row * 8), b = *(const f32x4*)(ssqx + (size_t)row * 8 + 4);
        return 1.0f / sqrtf((((a[0] + a[1]) + (a[2] + a[3])) + ((b[0] + b[1]) + (b[2] + b[3]))) * (1.0f / 1024.0f) + 1e-6f); }
    __device__ __forceinline__ void operator()(const f32x4 (&acc)[2][2][4][2], const Unit& u, int wr, int wc, int fr, int fq) const {
        const int pn = u.pn; const int row0 = u.pm * BM + wr * 64 + fr;
        if (pn < 4) {
            const float* g = pn < 2 ? qg : kg; const float sc = pn < 2 ? QK_C2 : 1.f;
            f32x4 gv[2][2];
#pragma unroll
            for (int bj = 0; bj < 2; ++bj)
#pragma unroll
                for (int n = 0; n < 2; ++n) gv[bj][n] = *(const f32x4*)(g + 32 * bj + 8 * fq + 4 * n) * sc;
            bf16_t* base = QK + 256 * pn + 64 * wc + 8 * fq;
#pragma unroll
            for (int ai = 0; ai < 2; ++ai)
#pragma unroll
                for (int m = 0; m < 4; ++m) { const int row = row0 + ai * HALF + m * 16; const float ri = rinv_of(row); float ss = 0.f;
#pragma unroll
                    for (int bj = 0; bj < 2; ++bj)
#pragma unroll
                        for (int n = 0; n < 2; ++n) { const f32x4 x = acc[ai][bj][m][n]; ss += (x[0] * x[0] + x[1] * x[1]) + (x[2] * x[2] + x[3] * x[3]); }
                    ss += __shfl_xor(ss, 16); ss += __shfl_xor(ss, 32);
                    const float rg = ri / sqrtf(ss * ri * ri * (1.0f / 64.0f) + 1e-6f);
#pragma unroll
                    for (int bj = 0; bj < 2; ++bj) { const f32x4 v0 = acc[ai][bj][m][0] * rg * gv[bj][0], v1 = acc[ai][bj][m][1] * rg * gv[bj][1];
                        *(u32x4*)(base + (size_t)row * 1024 + 32 * bj) = pack8(v0, v1); } }
        } else if (pn < 6) {
            bf16_t* base = VX + 256 * (pn - 4) + 32 * wc + 8 * fq;
#pragma unroll
            for (int ai = 0; ai < 2; ++ai)
#pragma unroll
                for (int m = 0; m < 4; ++m) { const int row = row0 + ai * HALF + m * 16; const float ri = rinv_of(row);
#pragma unroll
                    for (int bj = 0; bj < 2; ++bj) *(u32x4*)(base + (size_t)row * 1024 + HALF * bj) = pack8(acc[ai][bj][m][0] * ri, acc[ai][bj][m][1] * ri); }
        } else if (pn < 8) {
            bf16_t* base = VX + 512 + 128 * (pn - 6) + 32 * wc + 8 * fq;
#pragma unroll
            for (int ai = 0; ai < 2; ++ai)
#pragma unroll
                for (int m = 0; m < 4; ++m) { const int row = row0 + ai * HALF + m * 16; const float ri = rinv_of(row); f32x4 o[2];
#pragma unroll
                    for (int n = 0; n < 2; ++n) { const f32x4 a = acc[ai][0][m][n] * ri, gt = acc[ai][1][m][n] * ri;
#pragma unroll
                        for (int e = 0; e < 4; ++e) o[n][e] = a[e] / (1.0f + __expf(-gt[e])); }
                    *(u32x4*)(base + (size_t)row * 1024) = pack8(o[0], o[1]); }
        } else if (pn < 10) {
            bf16_t* base = VX + 768 + 128 * (pn - 8) + 32 * wc + 8 * fq;
#pragma unroll
            for (int ai = 0; ai < 2; ++ai)
#pragma unroll
                for (int m = 0; m < 4; ++m) { const int row = row0 + ai * HALF + m * 16; const float ri = rinv_of(row); const float r2 = ri * ri;
                    *(u32x4*)(base + (size_t)row * 1024) = pack8(acc[ai][0][m][0] * acc[ai][1][m][0] * r2, acc[ai][0][m][1] * acc[ai][1][m][1] * r2); }
        } else {
            bf16_t* base = SB + 32 * wc + 8 * fq;
#pragma unroll
            for (int ai = 0; ai < 2; ++ai)
#pragma unroll
                for (int m = 0; m < 4; ++m) { const int row = row0 + ai * HALF + m * 16; const float ri = rinv_of(row);
#pragma unroll
                    for (int bj = 0; bj < 2; ++bj) *(u32x4*)(base + (size_t)row * 256 + HALF * bj) = pack8(acc[ai][bj][m][0] * ri, acc[ai][bj][m][1] * ri); }
        }
    }
};
struct EpiOut {
    static constexpr bool PERM = true, AFTER_DRAIN = false;
    bf16_t* xb; float* ssq;
    __device__ __forceinline__ void operator()(const f32x4 (&acc)[2][2][4][2], const Unit& u, int wr, int wc, int fr, int fq) const {
        const int row0 = u.pm * BM + wr * 64 + fr; const int col0 = u.pn * BM + wc * 32 + 8 * fq;
#pragma unroll
        for (int ai = 0; ai < 2; ++ai)
#pragma unroll
            for (int m = 0; m < 4; ++m) { const int row = row0 + ai * HALF + m * 16; float ss = 0.f;
#pragma unroll
                for (int bj = 0; bj < 2; ++bj) { const size_t off = (size_t)row * 1024 + col0 + bj * HALF;
                    const u32x4 r = *(const u32x4*)(xb + off);
                    const f32x4 r0 = {__builtin_bit_cast(float, r.x << 16), __builtin_bit_cast(float, r.x & 0xffff0000u), __builtin_bit_cast(float, r.y << 16), __builtin_bit_cast(float, r.y & 0xffff0000u)};
                    const f32x4 r1 = {__builtin_bit_cast(float, r.z << 16), __builtin_bit_cast(float, r.z & 0xffff0000u), __builtin_bit_cast(float, r.w << 16), __builtin_bit_cast(float, r.w & 0xffff0000u)};
                    const u32x4 w = pack8(acc[ai][bj][m][0] + r0, acc[ai][bj][m][1] + r1);
                    *(u32x4*)(xb + off) = w;
                    const float a0 = __builtin_bit_cast(float, w.x << 16), a1 = __builtin_bit_cast(float, w.x & 0xffff0000u), a2 = __builtin_bit_cast(float, w.y << 16), a3 = __builtin_bit_cast(float, w.y & 0xffff0000u);
                    const float a4 = __builtin_bit_cast(float, w.z << 16), a5 = __builtin_bit_cast(float, w.z & 0xffff0000u), a6 = __builtin_bit_cast(float, w.w << 16), a7 = __builtin_bit_cast(float, w.w & 0xffff0000u);
                    ss += ((a0 * a0 + a1 * a1) + (a2 * a2 + a3 * a3)) + ((a4 * a4 + a5 * a5) + (a6 * a6 + a7 * a7)); }
                ss += __shfl_xor(ss, 16); ss += __shfl_xor(ss, 32);
                if (fq == 0) ssq[(size_t)row * 16 + u.pn * 4 + wc] = ss; }
    }
};

template <class Epi, class Sched, bool ALIGN_EPI = false, bool SP2 = false>
__device__ __forceinline__ void gemm_phase(PG8_LAS unsigned char* lds, const Gemm g, const Sched& S, const Epi& E) {
    int tid_l = threadIdx.x; asm volatile("" : "+v"(tid_l));
    const int tid = tid_l, wid = __builtin_amdgcn_readfirstlane(tid >> 6), lane = tid & 63, wr = wid >> 2, wc = wid & 3, fr = lane & 15, fq = lane >> 4;
    const int K = g.K, nt = K / BK;
    unsigned voffA[2], voffB[2];
#pragma unroll
    for (int i = 0; i < 2; ++i) { int R, C; stage_rc(tid * 16 + i * 8192, R, C); const int Rb = Epi::PERM ? ((R & ~31) + perm32(R & 31)) : R;
        voffA[i] = (unsigned)(R * K + C) * 2u; voffB[i] = (unsigned)(Rb * K + C) * 2u; }
    const size_t kstep = (size_t)(BK * 2);
    const size_t hstep = (size_t)HALF * K * 2;
    const size_t tstep = 2 * hstep;
    const unsigned ldsw = (unsigned)wid * 1024u;
    const int aoff = lds_byte(wr * 64 + fr, fq * 8), boff = lds_byte(wc * 32 + fr, fq * 8);
#define PG8_SA(b, h) (((b) * 2 + (h)) * HTB)
#define PG8_SB(b, h) ((4 + (b) * 2 + (h)) * HTB)
#define PG8_STAGE(bufoff, gbase, voff) do { _Pragma("unroll") for (int _i = 0; _i < 2; ++_i) \
        __builtin_amdgcn_global_load_lds((const unsigned*)((const char*)(gbase) + (voff)[_i]), (PG8_LAS unsigned*)(lds + (bufoff) + ldsw + _i * 8192), 16, 0, 0); } while (0)
#define PG8_LDA(dst, b, h) do { _Pragma("unroll") for (int m = 0; m < 4; ++m) _Pragma("unroll") for (int k = 0; k < 2; ++k) dst[m][k] = *(const PG8_LAS bf16x8*)(lds + PG8_SA(b, h) + aoff + m * 2048 + k * 1024); } while (0)
#define PG8_LDB(dst, b, h) do { _Pragma("unroll") for (int n = 0; n < 2; ++n) _Pragma("unroll") for (int k = 0; k < 2; ++k) dst[n][k] = *(const PG8_LAS bf16x8*)(lds + PG8_SB(b, h) + boff + n * 2048 + k * 1024); } while (0)
#define PG8_MMA(ai, bj, At, Bt) do { __builtin_amdgcn_s_setprio(1); _Pragma("unroll") for (int m = 0; m < 4; ++m) _Pragma("unroll") for (int n = 0; n < 2; ++n) _Pragma("unroll") for (int k = 0; k < 2; ++k) \
        acc[ai][bj][m][n] = __builtin_amdgcn_mfma_f32_16x16x32_bf16(Bt[n][k], At[m][k], acc[ai][bj][m][n], 0, 0, 0); __builtin_amdgcn_s_setprio(0); } while (0)
#define PG8_WAIT_V(n) asm volatile("s_waitcnt vmcnt(" #n ")" ::: "memory")
#define PG8_WAIT_L(n) asm volatile("s_waitcnt lgkmcnt(" #n ")" ::: "memory")
#define PG8_BAR __builtin_amdgcn_s_barrier()
#define PG8_SCHED __builtin_amdgcn_sched_barrier(0)
    Unit cur, nxt; int ui = 0;
    if (!S.next(0, cur)) return;
    f32x4 acc[2][2][4][2];
#pragma unroll
    for (int a = 0; a < 2; ++a)
#pragma unroll
        for (int b = 0; b < 2; ++b)
#pragma unroll
            for (int m = 0; m < 4; ++m)
#pragma unroll
                for (int n = 0; n < 2; ++n) acc[a][b][m][n] = (f32x4){0.f, 0.f, 0.f, 0.f};
    bf16x8 At[4][2], B0[2][2], B1[2][2];
    const char* cA = (const char*)g.A + (size_t)cur.pm * tstep; const char* cB = (const char*)g.Bt + (size_t)cur.pn * tstep;
    S.a_ready(cur);
    if constexpr (SP2) {
        PG8_STAGE(PG8_SB(0, 0), cB, voffB); PG8_STAGE(PG8_SB(0, 1), cB + hstep, voffB); PG8_STAGE(PG8_SA(0, 0), cA, voffA); PG8_STAGE(PG8_SA(0, 1), cA + hstep, voffA);
        if (wr == 1) PG8_BAR;
        PG8_WAIT_V(2); PG8_BAR;
        PG8_STAGE(PG8_SB(1, 0), cB + kstep, voffB); PG8_STAGE(PG8_SA(1, 0), cA + kstep, voffA); PG8_STAGE(PG8_SB(1, 1), cB + hstep + kstep, voffB);
        PG8_WAIT_V(6); PG8_BAR;
    } else {
        PG8_STAGE(PG8_SB(0, 0), cB, voffB); PG8_STAGE(PG8_SA(0, 0), cA, voffA); PG8_STAGE(PG8_SB(0, 1), cB + hstep, voffB); PG8_STAGE(PG8_SA(0, 1), cA + hstep, voffA);
        if (wr == 1) PG8_BAR;
        PG8_WAIT_V(4); PG8_BAR;
        PG8_STAGE(PG8_SB(1, 0), cB + kstep, voffB); PG8_STAGE(PG8_SA(1, 0), cA + kstep, voffA); PG8_STAGE(PG8_SB(1, 1), cB + hstep + kstep, voffB);
        PG8_WAIT_V(6); PG8_BAR;
    }
    for (;;) {
        const bool has_next = S.next(ui + 1, nxt);
        const char* nA = has_next ? (const char*)g.A + (size_t)nxt.pm * tstep : cA; const char* nB = has_next ? (const char*)g.Bt + (size_t)nxt.pn * tstep : cB;
        for (int t = 0; t < nt; t += 2) {
            const bool last = (t == nt - 2);
            const char* a1 = cA + (size_t)(t + 1) * kstep;
            const char* a2 = last ? nA : cA + (size_t)(t + 2) * kstep; const char* b2 = last ? nB : cB + (size_t)(t + 2) * kstep;
            const char* a3 = a2 + kstep; const char* b3 = b2 + kstep;
            if (last && has_next) S.a_ready(nxt);
            if constexpr (SP2) {
            PG8_LDB(B0, 0, 0); PG8_LDB(B1, 0, 1); PG8_SCHED; PG8_LDA(At, 0, 0); PG8_STAGE(PG8_SA(1, 1), a1 + hstep, voffA);
            PG8_WAIT_V(8); PG8_WAIT_L(0); PG8_BAR; PG8_MMA(0, 0, At, B0); PG8_MMA(0, 1, At, B1); PG8_BAR; PG8_SCHED;
            PG8_LDA(At, 0, 1); PG8_STAGE(PG8_SB(0, 0), b2, voffB); PG8_STAGE(PG8_SB(0, 1), b2 + hstep, voffB); PG8_STAGE(PG8_SA(0, 0), a2, voffA);
            PG8_WAIT_V(8); PG8_WAIT_L(0); PG8_BAR; PG8_MMA(1, 0, At, B0); PG8_MMA(1, 1, At, B1); PG8_BAR; PG8_SCHED;
            PG8_LDB(B0, 1, 0); PG8_LDB(B1, 1, 1); PG8_SCHED; PG8_LDA(At, 1, 0); PG8_STAGE(PG8_SA(0, 1), a2 + hstep, voffA);
            PG8_WAIT_V(8); PG8_WAIT_L(0); PG8_BAR; PG8_MMA(0, 0, At, B0); PG8_MMA(0, 1, At, B1); PG8_BAR; PG8_SCHED;
            PG8_LDA(At, 1, 1); PG8_STAGE(PG8_SB(1, 0), b3, voffB); PG8_STAGE(PG8_SB(1, 1), b3 + hstep, voffB); PG8_STAGE(PG8_SA(1, 0), a3, voffA);
            PG8_WAIT_V(8); PG8_WAIT_L(0); PG8_BAR; PG8_MMA(1, 0, At, B0); PG8_MMA(1, 1, At, B1); PG8_BAR; PG8_SCHED;
            } else {
            PG8_LDB(B0, 0, 0); PG8_SCHED; PG8_LDA(At, 0, 0); PG8_STAGE(PG8_SA(1, 1), a1 + hstep, voffA);
            PG8_WAIT_L(8); PG8_BAR; PG8_WAIT_L(0); PG8_MMA(0, 0, At, B0); PG8_BAR; PG8_SCHED;
            PG8_LDB(B1, 0, 1); PG8_STAGE(PG8_SB(0, 0), b2, voffB);
            PG8_BAR; PG8_WAIT_L(0); PG8_MMA(0, 1, At, B1); PG8_BAR;
            PG8_LDA(At, 0, 1); PG8_STAGE(PG8_SA(0, 0), a2, voffA);
            PG8_BAR; PG8_WAIT_L(0); PG8_MMA(1, 0, At, B0); PG8_BAR; PG8_SCHED;
            PG8_STAGE(PG8_SB(0, 1), b2 + hstep, voffB);
            PG8_WAIT_V(6); PG8_BAR; PG8_MMA(1, 1, At, B1); PG8_BAR;
            PG8_LDB(B0, 1, 0); PG8_SCHED; PG8_LDA(At, 1, 0); PG8_STAGE(PG8_SA(0, 1), a2 + hstep, voffA);
            PG8_WAIT_L(8); PG8_BAR; PG8_WAIT_L(0); PG8_MMA(0, 0, At, B0); PG8_BAR; PG8_SCHED;
            PG8_LDB(B1, 1, 1); PG8_STAGE(PG8_SB(1, 0), b3, voffB);
            PG8_BAR; PG8_WAIT_L(0); PG8_MMA(0, 1, At, B1); PG8_BAR;
            PG8_LDA(At, 1, 1); PG8_STAGE(PG8_SA(1, 0), a3, voffA);
            PG8_BAR; PG8_WAIT_L(0); PG8_MMA(1, 0, At, B0); PG8_BAR; PG8_SCHED;
            PG8_STAGE(PG8_SB(1, 1), b3 + hstep, voffB);
            PG8_WAIT_V(6); PG8_BAR; PG8_MMA(1, 1, At, B1); PG8_BAR;
            }
        }
        if constexpr (ALIGN_EPI) { if (wr == 0) PG8_BAR; }
        if constexpr (!Epi::AFTER_DRAIN) { E(acc, cur, wr, wc, fr, fq); S.done(cur); }
        if (!has_next) break;
#pragma unroll
        for (int a = 0; a < 2; ++a)
#pragma unroll
            for (int b = 0; b < 2; ++b)
#pragma unroll
                for (int m = 0; m < 4; ++m)
#pragma unroll
                    for (int n = 0; n < 2; ++n) acc[a][b][m][n] = (f32x4){0.f, 0.f, 0.f, 0.f};
        cur = nxt; cA = nA; cB = nB; ++ui;
        if constexpr (ALIGN_EPI) { if (wr == 1) PG8_BAR; }
    }
    PG8_WAIT_V(0);
    if constexpr (!ALIGN_EPI) { if (wr == 0) PG8_BAR; }
    PG8_BAR;
    if constexpr (Epi::AFTER_DRAIN) { E.fused(acc, cur, wr, wc, fr, fq, lds, wid, lane); S.done(cur); }
#undef PG8_SA
#undef PG8_SB
#undef PG8_STAGE
#undef PG8_LDA
#undef PG8_LDB
#undef PG8_MMA
#undef PG8_WAIT_V
#undef PG8_WAIT_L
#undef PG8_BAR
#undef PG8_SCHED
}
}
#define PG8_SP2 true
#define PG8_ALIGN true
#include <hip/hip_bf16.h>
#include <cmath>
namespace attn_body {
using bf16=__hip_bfloat16;
using bf16x8=__attribute__((ext_vector_type(8)))short;
using s16x4=__attribute__((ext_vector_type(4)))short;
using f32x16=__attribute__((ext_vector_type(16)))float;
using u32x4=__attribute__((ext_vector_type(4)))unsigned;
constexpr int BATCH=8,NHEAD=16,SEQ=4096,D=64,DM=NHEAD*D;
constexpr int NW=8,QBLK=32,QB=QBLK*NW,KVBLK=64,NQB=SEQ/QB;
constexpr int ATTN_PITCH=DM, ATTN_UNIT_ROWS=QB;
__device__ __forceinline__ int crow(int r,int hi){return (r&3)+8*(r>>2)+4*hi;}
#define SBAR() __builtin_amdgcn_sched_barrier(0)
__device__ __forceinline__ void cmask(f32x16&p0,f32x16&p1,int jb,int qrel,int hi){
  const float NEG=-INFINITY; int kb=64*jb+4*hi;
  #pragma unroll
  for(int r=0;r<16;++r){int kv=kb+(r&3)+8*(r>>2); if(kv>qrel)p0[r]=NEG; if(kv+32>qrel)p1[r]=NEG;}
}

constexpr int NSLOT=3, SLOTB=8192, VSLOTB=16384;
constexpr int LDS_K=0, LDS_V=NSLOT*SLOTB, LDS_WS=LDS_V+NSLOT*VSLOTB, LDS_OST=LDS_WS+NW*64*4, LDS_BYTES=LDS_OST+NW*4096;
constexpr float C2=0.125f*1.4426950408889634f;
__device__ __forceinline__ void glds16(const void*gsrc,unsigned lds_dst){unsigned keep;
  asm volatile("s_mov_b32 %0, m0\n\ts_mov_b32 m0, %2\n\ts_nop 0\n\tglobal_load_lds_dwordx4 %1, off\n\ts_mov_b32 m0, %0":"=&s"(keep):"v"(gsrc),"s"(lds_dst):"memory");}
__device__ __forceinline__ float max3f(float a,float b,float c){float r;asm("v_max3_f32 %0, %1, %2, %3":"=v"(r):"v"(a),"v"(b),"v"(c));return r;}
__device__ __forceinline__ float max2f(float a,float b){float r;asm("v_max_f32_e32 %0, %1, %2":"=v"(r):"v"(a),"v"(b));return r;}
__device__ __forceinline__ float fadd_s(float a,float b){float r;asm("v_add_f32_e32 %0, %1, %2":"=v"(r):"v"(a),"v"(b));return r;}
__device__ __forceinline__ float fsub_s(float a,float b){float r;asm("v_sub_f32_e32 %0, %1, %2":"=v"(r):"v"(a),"v"(b));return r;}
typedef float f32x2_t __attribute__((ext_vector_type(2))); typedef __bf16 bf16x2_t __attribute__((ext_vector_type(2)));
__device__ __forceinline__ unsigned cvtpk_s(float lo,float hi){f32x2_t v={lo,hi};bf16x2_t b=__builtin_convertvector(v,bf16x2_t);return __builtin_bit_cast(unsigned,b);}
#define WAIT_BAR(N) asm volatile("s_waitcnt vmcnt(" #N ") lgkmcnt(0)\n\ts_barrier":::"memory")

__device__ __forceinline__ void qkt(f32x16&p0,f32x16&p1,const char*Kslot,const bf16x8*qr,const f32x16&negm,int r32,int hi){
  const char*kb=Kslot+hi*1024+r32*16;
  #pragma unroll
  for(int d0=0;d0<4;++d0){
    const bf16x8 b0=*reinterpret_cast<const bf16x8*>(kb+d0*2048);
    const bf16x8 b1=*reinterpret_cast<const bf16x8*>(kb+d0*2048+512);
    if(d0==0){p0=__builtin_amdgcn_mfma_f32_32x32x16_bf16(b0,qr[0],negm,0,0,0);p1=__builtin_amdgcn_mfma_f32_32x32x16_bf16(b1,qr[0],negm,0,0,0);}
    else{p0=__builtin_amdgcn_mfma_f32_32x32x16_bf16(b0,qr[d0],p0,0,0,0);p1=__builtin_amdgcn_mfma_f32_32x32x16_bf16(b1,qr[d0],p1,0,0,0);}}
}
typedef __attribute__((address_space(3))) const char* lds_cptr;
typedef short v4i16_t __attribute__((ext_vector_type(4)));
__device__ __forceinline__ void kload8(bf16x8*kf,lds_cptr kp){
  kf[0]=*(const __attribute__((address_space(3))) bf16x8*)(kp);      kf[1]=*(const __attribute__((address_space(3))) bf16x8*)(kp+512);
  kf[2]=*(const __attribute__((address_space(3))) bf16x8*)(kp+2048); kf[3]=*(const __attribute__((address_space(3))) bf16x8*)(kp+2560);
  kf[4]=*(const __attribute__((address_space(3))) bf16x8*)(kp+4096); kf[5]=*(const __attribute__((address_space(3))) bf16x8*)(kp+4608);
  kf[6]=*(const __attribute__((address_space(3))) bf16x8*)(kp+6144); kf[7]=*(const __attribute__((address_space(3))) bf16x8*)(kp+6656);
}
__device__ __forceinline__ void kload2(bf16x8*kf,lds_cptr kp,int j){ kf[2*j]=*(const __attribute__((address_space(3))) bf16x8*)(kp+j*2048); kf[2*j+1]=*(const __attribute__((address_space(3))) bf16x8*)(kp+j*2048+512); }
__device__ __forceinline__ s16x4 vtr(lds_cptr p){ return __builtin_bit_cast(s16x4,__builtin_amdgcn_ds_read_tr16_b64_v4i16((__attribute__((address_space(3))) v4i16_t*)p)); }
__device__ __forceinline__ float rowmax(const f32x16&p0,const f32x16&p1){
  float a=max3f(p0[0],p0[1],p1[0]),b=max3f(p0[2],p0[3],p1[1]);a=max3f(a,p1[2],p1[3]);
  #pragma unroll
  for(int r=4;r<16;r+=4){a=max3f(a,p0[r],p0[r+1]);b=max3f(b,p0[r+2],p0[r+3]);a=max3f(a,p1[r],p1[r+1]);b=max3f(b,p1[r+2],p1[r+3]);}
  const float m=max2f(a,b);
  auto rr=__builtin_amdgcn_permlane32_swap(__float_as_uint(m),__float_as_uint(m),false,false);
  return max2f(__uint_as_float(rr[0]),__uint_as_float(rr[1]));
}
__device__ __forceinline__ void pv(f32x16*o,int vb,bf16x8 pa0,bf16x8 pa1,bf16x8 pa2,bf16x8 pa3){
  #pragma unroll
  for(int d0=0;d0<4;++d0){s16x4 lo[4],hi[4];
    #pragma unroll
    for(int ks=0;ks<4;++ks){
      asm volatile("ds_read_b64_tr_b16 %0,%1 offset:%c2":"=&v"(lo[ks]):"v"(vb),"i"((d0>>1)*8192+(d0&1)*4096+ks*1024):"memory");
      asm volatile("ds_read_b64_tr_b16 %0,%1 offset:%c2":"=&v"(hi[ks]):"v"(vb),"i"((d0>>1)*8192+(d0&1)*4096+ks*1024+512):"memory");}
    asm volatile("s_waitcnt lgkmcnt(0)":::"memory");SBAR();
    #define PK(k) (bf16x8){lo[k][0],lo[k][1],lo[k][2],lo[k][3],hi[k][0],hi[k][1],hi[k][2],hi[k][3]}
    o[d0]=__builtin_amdgcn_mfma_f32_32x32x16_bf16(pa0,PK(0),o[d0],0,0,0);
    o[d0]=__builtin_amdgcn_mfma_f32_32x32x16_bf16(pa1,PK(1),o[d0],0,0,0);
    o[d0]=__builtin_amdgcn_mfma_f32_32x32x16_bf16(pa2,PK(2),o[d0],0,0,0);
    o[d0]=__builtin_amdgcn_mfma_f32_32x32x16_bf16(pa3,PK(3),o[d0],0,0,0);
    #undef PK
  }
}

#ifndef ATTN_STORE16
#define ATTN_STORE16(p,v) (*(u32x4*)(p)=(v))
#endif
template<int THRL> __device__ __forceinline__ void attn_unit(int b,int qb,const bf16*Q,const bf16*__restrict__ K,const bf16*__restrict__ V,bf16*O,char*shm){
  int tid_l=threadIdx.x; asm volatile("":"+v"(tid_l)); const int tid=tid_l,lane=tid&63,r32=lane&31,hi=lane>>5; const int wid=__builtin_amdgcn_readfirstlane(tid>>6);
  const long rowbase=(long)b*SEQ; const int q0=qb*QB; const lds_cptr shm3q=(lds_cptr)shm;
  const bf16*Qw=Q+(rowbase+q0+wid*QBLK)*DM;
  const bf16*Kh=K+rowbase*DM,*Vh=V+rowbase*DM;
  const unsigned lds0=(unsigned)(uintptr_t)shm;
  float*wsf=(float*)(shm+LDS_WS)+wid*64;
  const bf16*ksrc=Kh+(long)lane*DM+wid*8;
  const bf16*vsrc=Vh+(long)(16*(wid&3)+(lane>>2))*DM+(wid>>2)*32+(lane&3)*8;
  const unsigned kdst=lds0+LDS_K+wid*1024, vdst=lds0+LDS_V+wid*1024;
  #define DMA_K(t,slot) glds16(ksrc+(long)(t)*KVBLK*DM,(unsigned)__builtin_amdgcn_readfirstlane(kdst+(slot)))
  #define DMA_V(t,slot) do{ glds16(vsrc+(long)(t)*KVBLK*DM,(unsigned)__builtin_amdgcn_readfirstlane(vdst+2*(slot))); glds16(vsrc+64+(long)(t)*KVBLK*DM,(unsigned)__builtin_amdgcn_readfirstlane(vdst+2*(slot)+8192)); }while(0)
  const int vb0=(int)(lds0+LDS_V)+((lane>>4)&1)*32+(lane&3)*8+(4*hi+((lane&15)>>2))*64;
  const char*Kbase=shm+LDS_K; bf16x8 kf[8];
  const lds_cptr shm3=(lds_cptr)shm; const lds_cptr kp0=shm3+LDS_K+hi*1024+r32*16; const lds_cptr vp0=shm3+LDS_V+((lane>>4)&1)*32+(lane&3)*8+(4*hi+((lane&15)>>2))*64;
  const int NT=(q0+QB)/KVBLK;
  DMA_K(0,0);DMA_V(0,0);DMA_K(1,SLOTB);
  bf16x8 qr[4];
  #pragma unroll
  for(int d0=0;d0<4;++d0)qr[d0]=*reinterpret_cast<const bf16x8*>(&Qw[(long)r32*DM+d0*16+hi*8]);
  const lds_cptr qst3=shm3q+LDS_OST+wid*4096+lane*16;
  #define LDQ(d0) (*(const __attribute__((address_space(3))) bf16x8*)(qst3+(d0)*1024))
  float mhat=0.f,l_reg=0.f;f32x16 o[4];o[0]=f32x16{};o[1]=f32x16{};o[2]=f32x16{};o[3]=f32x16{};f32x16 negm=f32x16{};asm volatile("":"+v"(negm));
  const int qrel=wid*QBLK+r32;
  #define CMASK(P0,P1,t) do{int jb_=(t)-(NT-4); if(jb_>=0)cmask(P0,P1,jb_,qrel,hi);}while(0)
  bool resc=false;
  #define START(P0,P1) do{ const float rm=rowmax(P0,P1); resc=false; \
    { const float dl=rm; mhat=fadd_s(mhat,dl); \
      _Pragma("unroll") for(int r=0;r<16;++r){P0[r]=fsub_s(P0[r],dl);P1[r]=fsub_s(P1[r],dl);} \
      _Pragma("unroll") for(int r=0;r<16;++r)negm[r]=-mhat; asm volatile("":"+v"(negm)); } \
    _Pragma("unroll") for(int r=0;r<16;++r)P0[r]=__builtin_amdgcn_exp2f(P0[r]); }while(0)
  #define RESC() do{ if(resc){ asm volatile("s_waitcnt lgkmcnt(0)":::"memory"); \
      _Pragma("unroll") for(int d_=0;d_<4;++d_) _Pragma("unroll") for(int r=0;r<16;++r)o[d_][r]*=wsf[crow(r,hi)]; } }while(0)
  f32x16 pA0,pA1,pB0,pB1;
  int sl_prev=0,sl_cur=0,sl_next=SLOTB;
  #define ROT() do{sl_prev=sl_cur;sl_cur=sl_next;sl_next=(sl_next==(NSLOT-1)*SLOTB)?0:sl_next+SLOTB;}while(0)
  DMA_K(2,2*SLOTB);
  WAIT_BAR(3);
  qkt(pA0,pA1,Kbase,qr,negm,r32,hi);
  _Pragma("unroll") for(int d0=0;d0<4;++d0)*(__attribute__((address_space(3))) bf16x8*)(qst3+d0*1024)=qr[d0];
asm volatile("s_nop 15\n\ts_nop 7":"+v"(pA0),"+v"(pA1));CMASK(pA0,pA1,0);
  START(pA0,pA1);
  _Pragma("unroll") for(int r=0;r<16;++r)pA1[r]=__builtin_amdgcn_exp2f(pA1[r]);
  WAIT_BAR(0);
  DMA_K(3,0);DMA_V(1,SLOTB);
  ROT();
  kload8(kf,kp0+sl_cur);
  WAIT_BAR(3);
  s16x4 f0lo,f0hi,f1lo,f1hi,f2lo,f2hi,f3lo,f3hi; u32x4 pw0,pw1,pw2,pw3;
  #define PKW(P,B) cvtpk_s(P[B],P[B+1])
  #define PAF(k) __builtin_bit_cast(bf16x8,pw##k)
  #define VF(S) (bf16x8){S##lo[0],S##lo[1],S##lo[2],S##lo[3],S##hi[0],S##hi[1],S##hi[2],S##hi[3]}
  #define FOFF(i) (((i)>>2)*4096+((i)&3)*1024)
  #define VLD(S,off) do{ S##lo=vtr(vp_+(off)); S##hi=vtr(vp_+(off)+512); }while(0)
  #define PIN(x) asm volatile("":"+v"(x))
  #define MX3(a,b,c) __builtin_fmaxf(__builtin_fmaxf((a),(b)),(c))
  #define GAPA(MF,A0,A1,A2,A3,W0,W1,PW) do{ MF; sacc+=A0; sacc+=A1; sacc+=A2; sacc+=A3; PIN(sacc); W0; W1; PIN(PW); SBAR(); }while(0)
  #define EX(v) __builtin_amdgcn_exp2f(v)
  #define GAPB(MF,X,B) do{ MF; X[B]=EX(X[B]); X[B+1]=EX(X[B+1]); X[B+2]=EX(X[B+2]); X[B+3]=EX(X[B+3]); PIN(X); SBAR(); }while(0)
  #define GAPB2(MF,X,B) do{ MF; X[B]=EX(X[B]); X[B+1]=EX(X[B+1]); PIN(X); SBAR(); }while(0)
  #define KRD(G,j) do{ if(G){ kload2(kf,kp0+sl_next,j); SBAR(); } }while(0)
  #define STEP(C0,C1,P0,P1,t,GK,GV,GL) do{ SBAR(); \
    const lds_cptr vp_=vp0+2*sl_prev; \
    bf16x8 q_=LDQ(0); VLD(f0,FOFF(0)); SBAR(); float sacc=(P0[0]+P0[1]); \
    GAPA(C0=__builtin_amdgcn_mfma_f32_32x32x16_bf16(kf[0],q_,negm,0,0,0), P0[2],P0[3],P0[4],P0[5],     pw0[0]=PKW(P0,0), pw0[1]=PKW(P0,2), pw0); \
    VLD(f1,FOFF(4)); SBAR(); GAPA(C1=__builtin_amdgcn_mfma_f32_32x32x16_bf16(kf[1],q_,negm,0,0,0), P0[6],P0[7],P0[8],P0[9],     pw0[2]=PKW(P0,4), pw0[3]=PKW(P0,6), pw0); \
    q_=LDQ(1); VLD(f2,FOFF(1)); SBAR(); GAPA(C0=__builtin_amdgcn_mfma_f32_32x32x16_bf16(kf[2],q_,C0,0,0,0),   P0[10],P0[11],P0[12],P0[13], pw1[0]=PKW(P0,8), pw1[1]=PKW(P0,10), pw1); \
    VLD(f3,FOFF(5)); SBAR(); GAPA(C1=__builtin_amdgcn_mfma_f32_32x32x16_bf16(kf[3],q_,C1,0,0,0),   P0[14],P0[15],P1[0],P1[1],   pw1[2]=PKW(P0,12),pw1[3]=PKW(P0,14), pw1); \
    q_=LDQ(2); SBAR(); GAPA(C0=__builtin_amdgcn_mfma_f32_32x32x16_bf16(kf[4],q_,C0,0,0,0),   P1[2],P1[3],P1[4],P1[5],     pw2[0]=PKW(P1,0), pw2[1]=PKW(P1,2), pw2); \
    GAPA(C1=__builtin_amdgcn_mfma_f32_32x32x16_bf16(kf[5],q_,C1,0,0,0),   P1[6],P1[7],P1[8],P1[9],     pw2[2]=PKW(P1,4), pw2[3]=PKW(P1,6), pw2); \
    q_=LDQ(3); SBAR(); GAPA(C0=__builtin_amdgcn_mfma_f32_32x32x16_bf16(kf[6],q_,C0,0,0,0),   P1[10],P1[11],P1[12],P1[13], pw3[0]=PKW(P1,8), pw3[1]=PKW(P1,10), pw3); \
    GAPA(C1=__builtin_amdgcn_mfma_f32_32x32x16_bf16(kf[7],q_,C1,0,0,0),   P1[14],P1[15],0.f,0.f,       pw3[2]=PKW(P1,12),pw3[3]=PKW(P1,14), pw3); \
    l_reg+=sacc; \
    if(GK){DMA_K((t)+3,sl_cur);} if(GV){DMA_V((t)+1,sl_next);} \
    CMASK(C0,C1,t); \
    { float a=MX3(C0[0],C0[1],C1[0]),b=MX3(C0[2],C0[3],C1[1]); a=MX3(a,C1[2],C1[3]); \
      _Pragma("unroll") for(int r=4;r<16;r+=4){a=MX3(a,C0[r],C0[r+1]);b=MX3(b,C0[r+2],C0[r+3]);a=MX3(a,C1[r],C1[r+1]);b=MX3(b,C1[r+2],C1[r+3]);} \
      float rm=__builtin_fmaxf(a,b); { auto rr=__builtin_amdgcn_permlane32_swap(__float_as_uint(rm),__float_as_uint(rm),false,false); rm=__builtin_fmaxf(__uint_as_float(rr[0]),__uint_as_float(rr[1])); } \
      resc=false; \
      if(__builtin_expect(__any(rm>(float)THRL),0)){ const float dl=__builtin_fmaxf(rm,0.f); mhat+=dl; \
        _Pragma("unroll") for(int r=0;r<16;++r){C0[r]-=dl;C1[r]-=dl;} \
        _Pragma("unroll") for(int r=0;r<16;++r)negm[r]=-mhat; asm volatile("":"+v"(negm)); \
        const float f=__builtin_amdgcn_exp2f(-dl); l_reg*=f; if(hi==0)wsf[r32]=f; resc=true; } } \
    SBAR(); \
      \
    GAPB2(o[0]=__builtin_amdgcn_mfma_f32_32x32x16_bf16(PAF(0),VF(f0),o[0],0,0,0), C0,0);  VLD(f0,FOFF(2)); SBAR(); \
    GAPB2(o[1]=__builtin_amdgcn_mfma_f32_32x32x16_bf16(PAF(0),VF(f1),o[1],0,0,0), C0,2);  VLD(f1,FOFF(6)); SBAR(); \
    KRD(GL,0); GAPB2(o[0]=__builtin_amdgcn_mfma_f32_32x32x16_bf16(PAF(1),VF(f2),o[0],0,0,0), C0,4);  VLD(f2,FOFF(3)); SBAR(); \
    KRD(GL,1); GAPB2(o[1]=__builtin_amdgcn_mfma_f32_32x32x16_bf16(PAF(1),VF(f3),o[1],0,0,0), C0,6);  VLD(f3,FOFF(7)); SBAR(); \
    KRD(GL,2); GAPB2(o[0]=__builtin_amdgcn_mfma_f32_32x32x16_bf16(PAF(2),VF(f0),o[0],0,0,0), C0,8);  VLD(f0,8192+FOFF(0)); SBAR(); \
    KRD(GL,3); GAPB2(o[1]=__builtin_amdgcn_mfma_f32_32x32x16_bf16(PAF(2),VF(f1),o[1],0,0,0), C0,10); VLD(f1,8192+FOFF(4)); SBAR(); \
    GAPB2(o[0]=__builtin_amdgcn_mfma_f32_32x32x16_bf16(PAF(3),VF(f2),o[0],0,0,0), C0,12); VLD(f2,8192+FOFF(1)); SBAR(); \
    GAPB2(o[1]=__builtin_amdgcn_mfma_f32_32x32x16_bf16(PAF(3),VF(f3),o[1],0,0,0), C0,14); VLD(f3,8192+FOFF(5)); SBAR(); \
    GAPB2(o[2]=__builtin_amdgcn_mfma_f32_32x32x16_bf16(PAF(0),VF(f0),o[2],0,0,0), C1,0);  VLD(f0,8192+FOFF(2)); SBAR(); \
    GAPB2(o[3]=__builtin_amdgcn_mfma_f32_32x32x16_bf16(PAF(0),VF(f1),o[3],0,0,0), C1,2);  VLD(f1,8192+FOFF(6)); SBAR(); \
    GAPB2(o[2]=__builtin_amdgcn_mfma_f32_32x32x16_bf16(PAF(1),VF(f2),o[2],0,0,0), C1,4);  VLD(f2,8192+FOFF(3)); SBAR(); \
    GAPB2(o[3]=__builtin_amdgcn_mfma_f32_32x32x16_bf16(PAF(1),VF(f3),o[3],0,0,0), C1,6);  VLD(f3,8192+FOFF(7)); SBAR(); \
    GAPB2(o[2]=__builtin_amdgcn_mfma_f32_32x32x16_bf16(PAF(2),VF(f0),o[2],0,0,0), C1,8); \
    GAPB2(o[3]=__builtin_amdgcn_mfma_f32_32x32x16_bf16(PAF(2),VF(f1),o[3],0,0,0), C1,10); \
    GAPB2(o[2]=__builtin_amdgcn_mfma_f32_32x32x16_bf16(PAF(3),VF(f2),o[2],0,0,0), C1,12); \
    GAPB2(o[3]=__builtin_amdgcn_mfma_f32_32x32x16_bf16(PAF(3),VF(f3),o[3],0,0,0), C1,14); \
    }while(0)
  int t=1;
  #undef CMASK
  #define CMASK(P0,P1,t) do{}while(0)
  for(;t+5<NT;t+=2){
    STEP(pB0,pB1,pA0,pA1,t,true,true,true);     WAIT_BAR(3); RESC(); ROT();
    STEP(pA0,pA1,pB0,pB1,t+1,true,true,true);   WAIT_BAR(3); RESC(); ROT();
  }
  #undef CMASK
  #define CMASK(P0,P1,t) do{int jb_=(t)-(NT-4); if(jb_>=0)cmask(P0,P1,jb_,qrel,hi);}while(0)
  #define ENDW(tt) do{ if((tt)+3<NT){WAIT_BAR(3);} else if((tt)+2<NT){WAIT_BAR(2);} else {WAIT_BAR(0);} }while(0)
  for(;t+1<NT;t+=2){
    STEP(pB0,pB1,pA0,pA1,t,(t+3<NT),(t+1<NT),(t+1<NT));       ENDW(t);   RESC(); ROT();
    STEP(pA0,pA1,pB0,pB1,t+1,(t+4<NT),(t+2<NT),(t+2<NT));     ENDW(t+1); RESC(); ROT();
  }
  STEP(pB0,pB1,pA0,pA1,NT-1,false,false,false); RESC();
  { float sacc=pB0[0]+pB0[1]; _Pragma("unroll") for(int r=2;r<16;++r)sacc+=pB0[r]; _Pragma("unroll") for(int r=0;r<16;++r)sacc+=pB1[r]; l_reg+=sacc;
    pw0=(u32x4){PKW(pB0,0),PKW(pB0,2),PKW(pB0,4),PKW(pB0,6)};pw1=(u32x4){PKW(pB0,8),PKW(pB0,10),PKW(pB0,12),PKW(pB0,14)};pw2=(u32x4){PKW(pB1,0),PKW(pB1,2),PKW(pB1,4),PKW(pB1,6)};pw3=(u32x4){PKW(pB1,8),PKW(pB1,10),PKW(pB1,12),PKW(pB1,14)};
    SBAR(); pv(o,vb0+2*sl_cur,PAF(0),PAF(1),PAF(2),PAF(3)); }
  #undef PKW
  #undef PAF
  #undef VF
  #undef FOFF
  #undef VLD
  #undef LDQ
  #undef PIN
  #undef MX3
  #undef GAPA
  #undef GAPB
  #undef EX
  #undef GAPB2
  #undef KRD
  #undef STEP
  #undef ENDW
  {auto rr=__builtin_amdgcn_permlane32_swap(__float_as_uint(l_reg),__float_as_uint(l_reg),false,false);l_reg=__uint_as_float(rr[0])+__uint_as_float(rr[1]);}
  if(hi==0)wsf[32+r32]=l_reg;asm volatile("s_waitcnt lgkmcnt(0)":::"memory");
  float rli[16];
  #pragma unroll
  for(int r=0;r<16;++r)rli[r]=__builtin_amdgcn_rcpf(wsf[32+crow(r,hi)]);
  bf16*Ow=O+(rowbase+q0+wid*QBLK)*DM;
  { bf16*stg=(bf16*)(shm+LDS_OST)+wid*2048;
    #pragma unroll
    for(int h2=0;h2<2;++h2){
      #pragma unroll
      for(int r=0;r<16;++r){const int orow=crow(r,hi);
        #pragma unroll
        for(int d0=0;d0<2;++d0)stg[orow*64+d0*32+r32]=__float2bfloat16(o[2*h2+d0][r]*rli[r]);}
      asm volatile("s_waitcnt lgkmcnt(0)":::"memory");
      #pragma unroll
      for(int i=0;i<4;++i){const int row=i*8+(lane>>3),ch=lane&7; const u32x4 v=*(const u32x4*)(stg+row*64+ch*8); ATTN_STORE16(Ow+(long)row*DM+h2*64+ch*8,v);}
      asm volatile("s_waitcnt lgkmcnt(0)":::"memory"); } }
  asm volatile("s_waitcnt lgkmcnt(0)\n\ts_barrier":::"memory");
  #undef DMA_K
  #undef DMA_V
  #undef CMASK
  #undef START
  #undef RESC
  #undef ROT
}
constexpr int ATTN_LDS_BYTES=LDS_BYTES;
#undef SBAR
#undef WAIT_BAR
}
#define GAS __attribute__((address_space(1)))
#define LAS __attribute__((address_space(3)))
typedef unsigned short bf16;
typedef unsigned v4u __attribute__((ext_vector_type(4)));
typedef float f32x4 __attribute__((ext_vector_type(4)));
typedef short bf16x8 __attribute__((ext_vector_type(8)));
typedef GAS unsigned gu32;
typedef GAS unsigned long long gu64;
#define RLX_AGENT __ATOMIC_RELAXED, __HIP_MEMORY_SCOPE_AGENT
#define LDS_WAIT() asm volatile("s_waitcnt lgkmcnt(0)" ::: "memory")
#define VM_WAIT() asm volatile("s_waitcnt vmcnt(0)" ::: "memory")
__device__ __forceinline__ unsigned long long rt() { return __builtin_amdgcn_s_memrealtime(); }
__device__ __forceinline__ unsigned f2bf(float f) { unsigned u = __builtin_bit_cast(unsigned, f); return (u + 0x7fffu + ((u >> 16) & 1u)) >> 16; }
__device__ __forceinline__ unsigned pk2(float lo, float hi) { return f2bf(lo) | (f2bf(hi) << 16); }

#define XB_TMO      128
#define XB_XCNT(j)  (256  + 64 * (j))
#define XB_XSUB(j)  (1280 + 64 * (j))
#define XB_XGEN(j)  (2304 + 64 * (j))
#define XB_TOP      3328
#define XB_TOPGEN   3392
#define XCD_BAR_WORDS 3456
#define XB_SPIN_CAP (1u << 18)

__device__ __forceinline__ unsigned xb_ld(unsigned* p)              { return __hip_atomic_load(p, __ATOMIC_RELAXED, __HIP_MEMORY_SCOPE_AGENT); }
__device__ __forceinline__ unsigned xb_add(unsigned* p, unsigned v) { return __hip_atomic_fetch_add(p, v, __ATOMIC_RELAXED, __HIP_MEMORY_SCOPE_AGENT); }
__device__ __forceinline__ unsigned xb_xcc_id() { return (unsigned)__builtin_amdgcn_s_getreg((3 << 11) | 20) & 0xFu; }
#define XB_SPIN(cond, bar) do { unsigned _sp = 0; while (cond) { __builtin_amdgcn_s_sleep(1); \
    if ((++_sp & 255u) == 0u) { if (xb_ld(&(bar)[XB_TMO])) break; if (_sp > XB_SPIN_CAP) { atomicAdd(&(bar)[XB_TMO], 1u); break; } } } } while (0)

struct XcdBarrier {
    unsigned* bar; unsigned x;
    volatile LAS unsigned* st;
};

__device__ __forceinline__ XcdBarrier xcd_barrier_post(unsigned* bar, volatile LAS unsigned* st) {
    XcdBarrier b; b.bar = bar; b.x = xb_xcc_id(); b.st = st;
    if (threadIdx.x == 0) (void)xb_add(&bar[XB_XCNT(b.x)], 1u);
    return b;
}
__device__ __forceinline__ void xcd_barrier_complete(unsigned* bar, unsigned x, unsigned& nloc, unsigned& nx) {
    const unsigned G = gridDim.x * gridDim.y * gridDim.z;
    unsigned sum, cnt, mine, sp = 0u;
    for (;;) {
        sum = 0u; cnt = 0u; mine = 0u;
#pragma unroll
        for (unsigned j = 0; j < 16; ++j) { const unsigned c = xb_ld(&bar[XB_XCNT(j)]); sum += c; cnt += (c > 0u) ? 1u : 0u; mine = (j == x) ? c : mine; }
        if (sum == G) break;
        __builtin_amdgcn_s_sleep(1);
        if ((++sp & 255u) == 0u) { if (xb_ld(&bar[XB_TMO])) break; if (sp > XB_SPIN_CAP) { atomicAdd(&bar[XB_TMO], 1u); break; } }
    }
    nloc = mine > 0u ? mine : 1u; nx = cnt > 0u ? cnt : 1u;
}

__device__ __forceinline__ void xcd_barrier(const XcdBarrier& b) {
    asm volatile("s_waitcnt vmcnt(0)" ::: "memory");
    __syncthreads();
    if (threadIdx.x == 0) {
        size_t zoff_ = 0; asm volatile("" : "+s"(zoff_)); unsigned* bar = b.bar + zoff_; unsigned bx_ = b.x; asm volatile("" : "+s"(bx_));
        __builtin_amdgcn_s_waitcnt(0);
        unsigned nloc = b.st[0], nx = b.st[1];
        if (nloc == 0u) { xcd_barrier_complete(bar, bx_, nloc, nx); b.st[0] = nloc; b.st[1] = nx; }
        const unsigned old = xb_add(&bar[XB_XSUB(bx_)], 1u);
        const unsigned gen = old / nloc;
        if (old + 1u == (gen + 1u) * nloc) {
            __builtin_amdgcn_fence(__ATOMIC_RELEASE, "agent");
            asm volatile("s_waitcnt vmcnt(0)" ::: "memory");
            const unsigned og = xb_add(&bar[XB_TOP], 1u);
            const unsigned tg = og / nx;
            if (og + 1u == (tg + 1u) * nx) xb_add(&bar[XB_TOPGEN], 1u);
            else XB_SPIN(xb_ld(&bar[XB_TOPGEN]) == tg, bar);
            __builtin_amdgcn_fence(__ATOMIC_ACQUIRE, "agent");
            xb_add(&bar[XB_XGEN(bx_)], 1u);
            asm volatile("s_waitcnt vmcnt(0)" ::: "memory");
        } else {
            XB_SPIN(xb_ld(&bar[XB_XGEN(bx_)]) == gen, bar);
            __builtin_amdgcn_fence(__ATOMIC_ACQUIRE, "agent");
            asm volatile("s_waitcnt vmcnt(0)" ::: "memory");
        }
    }
    __syncthreads();
}
constexpr int NWAVES = 8;
constexpr int BATCH = 8, SEQ = 4096, DMODEL = 1024, NTOK = BATCH * SEQ, DEPTH = 2, IN_COLS = 2816;
constexpr int NEXP = 16384, PEER_H = 8, PEER_K = 16;
constexpr float RMS_EPS = 1e-6f, LN_EPS = 1e-5f;
constexpr size_t MiB = 1u << 20;
constexpr size_t WS_CTL = 0, CTL_ZERO_BYTES = 1 * MiB;
constexpr size_t WS_WIN = 2 * MiB;
constexpr size_t WS_WOUT = 13 * MiB;
constexpr size_t WS_WQ = 17 * MiB;
constexpr size_t WS_KEYS = 25 * MiB;
constexpr size_t WS_RINV = 26 * MiB;
constexpr size_t WS_SSQ = 27 * MiB;
constexpr size_t WS_EID = 30 * MiB;
constexpr size_t WS_GATE = 38 * MiB;
constexpr size_t WS_SB = 54 * MiB;
constexpr size_t WS_XBF = 72 * MiB;
constexpr size_t WS_QK = 136 * MiB;
constexpr size_t WS_VX = 200 * MiB;
constexpr size_t WS_UT = 264 * MiB;
constexpr size_t WS_VT = 296 * MiB;
constexpr size_t WS_SU = 328 * MiB;
constexpr size_t WS_SV = 329 * MiB;
constexpr size_t WS_EIDT = 330 * MiB;
constexpr size_t WS_CORR = 338 * MiB;
constexpr size_t WS_SSQX = 339 * MiB;
constexpr size_t WS_XQ = 344 * MiB;
constexpr size_t WS_XQS = 376 * MiB;
constexpr size_t WS_CAT = 377 * MiB;
constexpr size_t WS_O = 441 * MiB;
constexpr size_t WS_WSC = 340 * MiB;
constexpr size_t WS_END = 505 * MiB;
constexpr size_t WS_PART = WS_QK;
constexpr size_t WS_WT = WS_SB;
constexpr int CW_BAR = 4096;
constexpr int RING_OFF = 0, RING_BYTES = 131072;
constexpr int LDSCTL_OFF = RING_BYTES, MISC_OFF = LDSCTL_OFF + 320;
constexpr int LDS_BYTES = 147456;

__device__ __forceinline__ float bflo(unsigned w) { return __builtin_bit_cast(float, w << 16); }
__device__ __forceinline__ float bfhi(unsigned w) { return __builtin_bit_cast(float, w & 0xffff0000u); }
__device__ __forceinline__ float bf1(unsigned short w) { return __builtin_bit_cast(float, (unsigned)w << 16); }
#define DPP_ADD(v, ctrl) ((v) + __builtin_bit_cast(float, __builtin_amdgcn_update_dpp(0, __builtin_bit_cast(int, (v)), (ctrl), 0xf, 0xf, true)))
__device__ __forceinline__ float wave_sum(float v) {
    v = DPP_ADD(v, 0xB1);
    v = DPP_ADD(v, 0x4E);
    v = DPP_ADD(v, 0x141);
    v = DPP_ADD(v, 0x140);
    const int b = __builtin_bit_cast(int, v);
    return (__builtin_bit_cast(float, __builtin_amdgcn_readlane(b, 0)) + __builtin_bit_cast(float, __builtin_amdgcn_readlane(b, 16))) + (__builtin_bit_cast(float, __builtin_amdgcn_readlane(b, 32)) + __builtin_bit_cast(float, __builtin_amdgcn_readlane(b, 48)));
}

__device__ __forceinline__ int win_src(int np) {
    const int p = np >> 8, pc = np & 255;
    if (p < 4) return 256 * p + 64 * ((pc & 127) >> 5) + 32 * (pc >> 7) + (pc & 31);
    if (p < 6) return np;
    if (p < 8) { const int kk = p - 6; return pc < 128 ? 1536 + 128 * kk + pc : 1792 + 128 * kk + (pc - 128); }
    if (p < 10) { const int kk = p - 8; return pc < 128 ? 2304 + 128 * kk + pc : 2560 + 128 * kk + (pc - 128); }
    return 2048 + pc;
}
template <int MODE> __device__ __forceinline__ void p0_transpose_item(const float* W, const float* gain, int K, int N, bf16* WT, LAS float* scr, int item, int lane) {
    const int nblk = N / 32, kb = item / nblk, nb = item % nblk, k0 = 64 * kb, n0p = 32 * nb;
    const int n0 = MODE == 1 ? win_src(n0p) : n0p;
#pragma unroll 8
    for (int i = 0; i < 32; ++i) { const int kk = 2 * i + (lane >> 5); const float gk = gain ? gain[k0 + kk] : 1.f; scr[kk * 33 + (lane & 31)] = W[(size_t)(k0 + kk) * N + n0 + (lane & 31)] * gk; }
    LDS_WAIT(); asm volatile("" ::: "memory");
    const int c = lane & 7;
#pragma unroll
    for (int j = 0; j < 4; ++j) { const int n = (lane >> 3) + 8 * j; const LAS float* s = scr + (8 * c) * 33 + n;
        v4u o; o.x = pk2(s[0 * 33], s[1 * 33]); o.y = pk2(s[2 * 33], s[3 * 33]); o.z = pk2(s[4 * 33], s[5 * 33]); o.w = pk2(s[6 * 33], s[7 * 33]);
        *(GAS v4u*)(WT + (size_t)(n0p + n) * K + k0 + 8 * c) = o; }
    LDS_WAIT(); asm volatile("" ::: "memory");
}
__device__ __forceinline__ void p0_convert(const float* src, bf16* dst, size_t n, int gtid, int ngt) {
    for (size_t i = (size_t)gtid * 8; i < n; i += (size_t)ngt * 8) {
        const f32x4 a = *(const GAS f32x4*)(src + i), b = *(const GAS f32x4*)(src + i + 4);
        v4u o; o.x = pk2(a.x, a.y); o.y = pk2(a.z, a.w); o.z = pk2(b.x, b.y); o.w = pk2(b.z, b.w);
        *(GAS v4u*)(dst + i) = o; }
}
__device__ __forceinline__ float wave_max(float v) {
#pragma unroll
    for (int o = 1; o < 64; o <<= 1) v = fmaxf(v, __shfl_xor(v, o));
    return v;
}
template <int OFFS> __device__ __forceinline__ void p0_quant_row(const float* src, unsigned char* dst_base, int e, float* scale_out, int lane) {
    const GAS f32x4* xr = (const GAS f32x4*)src + 4 * lane;
    f32x4 v[4]; float m = 0.f;
#pragma unroll
    for (int j = 0; j < 4; ++j) { v[j] = __builtin_nontemporal_load(xr + j); m = fmaxf(fmaxf(m, fmaxf(fabsf(v[j].x), fabsf(v[j].y))), fmaxf(fabsf(v[j].z), fabsf(v[j].w))); }
    m = wave_max(m);
    const float inv = m > 0.f ? 127.0f / m : 0.f;
    v4u o;
#pragma unroll
    for (int j = 0; j < 4; ++j) { const int a = (int)rintf(v[j].x * inv) + OFFS, b = (int)rintf(v[j].y * inv) + OFFS, c = (int)rintf(v[j].z * inv) + OFFS, d = (int)rintf(v[j].w * inv) + OFFS;
        o[j] = (unsigned)(a & 0xff) | ((unsigned)(b & 0xff) << 8) | ((unsigned)(c & 0xff) << 16) | ((unsigned)(d & 0xff) << 24); }
    *(GAS v4u*)(dst_base + ((size_t)(lane >> 3) * NEXP + e) * 128 + 16 * (lane & 7)) = o;
    if (lane == 0) *scale_out = m * (1.0f / 127.0f);
}
__device__ __forceinline__ void p0_quant_row4(const float* src, const float* gain, unsigned char* dst_base, int e, float* scale_out, int lane) {
    const GAS f32x4* xr = (const GAS f32x4*)src + 4 * lane;
    f32x4 v[4]; float m = 0.f;
#pragma unroll
    for (int j = 0; j < 4; ++j) { v[j] = __builtin_nontemporal_load(xr + j); if (gain) v[j] = v[j] * *((const GAS f32x4*)gain + 4 * lane + j); m = fmaxf(fmaxf(m, fmaxf(fabsf(v[j].x), fabsf(v[j].y))), fmaxf(fabsf(v[j].z), fabsf(v[j].w))); }
    m = fmaxf(m, __shfl_xor(m, 1)); m = fmaxf(m, __shfl_xor(m, 2)); m = fmaxf(m, __shfl_xor(m, 4)); m = fmaxf(m, __shfl_xor(m, 8));
    const float inv = m > 0.f ? 7.0f / m : 0.f;
    unsigned o[2];
#pragma unroll
    for (int k = 0; k < 2; ++k) { const f32x4 lo = v[2 * k], hi = v[2 * k + 1];
#define Q4(x) ((unsigned)((int)rintf((x) * inv) + 8) & 0xfu)
        o[k] = (Q4(lo.x) | (Q4(hi.x) << 4)) | ((Q4(lo.y) | (Q4(hi.y) << 4)) << 8) | ((Q4(lo.z) | (Q4(hi.z) << 4)) << 16) | ((Q4(lo.w) | (Q4(hi.w) << 4)) << 24);
#undef Q4
    }
    *(GAS unsigned long long*)(dst_base + ((size_t)(lane >> 4) * NEXP + e) * 128 + 8 * (lane & 15)) = (unsigned long long)o[0] | ((unsigned long long)o[1] << 32);
    if ((lane & 15) == 0) scale_out[4 * e + (lane >> 4)] = m * (1.0f / 7.0f);
}
__device__ __forceinline__ void p0_x_row(const float* xrow, bf16* orow, float* rinv_out, int lane) {
    const GAS f32x4* xr = (const GAS f32x4*)xrow + lane;
    f32x4 v[4]; float s = 0.f;
#pragma unroll
    for (int j = 0; j < 4; ++j) { v[j] = xr[64 * j]; s += (v[j].x * v[j].x + v[j].y * v[j].y) + (v[j].z * v[j].z + v[j].w * v[j].w); }
    s = wave_sum(s);
    GAS unsigned long long* o8 = (GAS unsigned long long*)orow + lane;
#pragma unroll
    for (int j = 0; j < 4; ++j) o8[64 * j] = (unsigned long long)pk2(v[j].x, v[j].y) | ((unsigned long long)pk2(v[j].z, v[j].w) << 32);
    if (lane < 8) rinv_out[lane] = lane == 0 ? s : 0.f;
}

__device__ __forceinline__ float wave_sum_shfl(float v) {
#pragma unroll
    for (int o = 1; o < 64; o <<= 1) v += __shfl_xor(v, o);
    return v;
}
__device__ __forceinline__ void xq_row(const bf16* xrow, signed char* qrow, float* sc4, int lane) {
    const GAS v4u* xp = (const GAS v4u*)xrow + 2 * lane; const v4u a = xp[0], b = xp[1];
#define AMX(w) fmaxf(fabsf(bflo(w)), fabsf(bfhi(w)))
    float am = fmaxf(fmaxf(fmaxf(AMX(a.x), AMX(a.y)), fmaxf(AMX(a.z), AMX(a.w))), fmaxf(fmaxf(AMX(b.x), AMX(b.y)), fmaxf(AMX(b.z), AMX(b.w))));
#undef AMX
    am = fmaxf(am, __shfl_xor(am, 1)); am = fmaxf(am, __shfl_xor(am, 2)); am = fmaxf(am, __shfl_xor(am, 4)); am = fmaxf(am, __shfl_xor(am, 8));
    const float qinv = am > 0.f ? 127.0f / am : 0.f;
#define PK4(wa, wb) (unsigned)(((int)rintf(bflo(wa) * qinv) & 0xff) | (((int)rintf(bfhi(wa) * qinv) & 0xff) << 8) | (((int)rintf(bflo(wb) * qinv) & 0xff) << 16) | (((int)rintf(bfhi(wb) * qinv) & 0xff) << 24))
    v4u o; o.x = PK4(a.x, a.y); o.y = PK4(a.z, a.w); o.z = PK4(b.x, b.y); o.w = PK4(b.z, b.w);
#undef PK4
    *((GAS v4u*)qrow + lane) = o;
    if ((lane & 15) == 0) sc4[lane >> 4] = am * (1.0f / 127.0f);
}
struct CmbArgs { const bf16* O; const bf16* VX; const bf16* SB; bf16* CAT; const float* lq1; const float* lk1; const float* lq2; const float* lk2; const float* subg;
                 const float* cfw; const float* cfb; const float* lng; const float* lnb; const float* scw; float lam_init; };
__device__ __forceinline__ float cmb_lambda(const CmbArgs& A, int lane) { return __expf(wave_sum(A.lq1[lane] * A.lk1[lane])) - __expf(wave_sum(A.lq2[lane] * A.lk2[lane])) + A.lam_init; }
__device__ __forceinline__ void cmb_rows(const CmbArgs& A, float lam, int h, int trow0, int lane_in) {
    asm volatile("s_waitcnt vmcnt(0)" ::: "memory");
    int lane = lane_in; asm volatile("" : "+v"(lane));
    const int vh = lane >> 5, dd = (2 * lane) & 63;
    const int c0 = (4 * h + vh) * 64 + dd, c1 = (4 * h + 2 + vh) * 64 + dd;
    const float g0 = A.subg[2 * lane] * (1.0f - A.lam_init), g1 = A.subg[2 * lane + 1] * (1.0f - A.lam_init);
    unsigned o0[32], o1[32];
#pragma unroll
    for (int tt = 0; tt < 32; ++tt) { const size_t rb = (size_t)(trow0 + tt) * 1024;
        o0[tt] = __hip_atomic_load((const GAS unsigned*)(A.O + rb + c0), __ATOMIC_RELAXED, __HIP_MEMORY_SCOPE_AGENT); o1[tt] = __hip_atomic_load((const GAS unsigned*)(A.O + rb + c1), __ATOMIC_RELAXED, __HIP_MEMORY_SCOPE_AGENT); }
#pragma unroll
    for (int tt = 0; tt < 32; ++tt) {
        const float a0 = bflo(o0[tt]) - lam * bflo(o1[tt]), a1 = bfhi(o0[tt]) - lam * bfhi(o1[tt]);
        const float ss = wave_sum(a0 * a0 + a1 * a1);
        const float ri = 1.0f / sqrtf(ss * (1.0f / 128.0f) + RMS_EPS);
        *(GAS unsigned*)(A.CAT + (size_t)(trow0 + tt) * 1024 + h * 128 + 2 * lane) = pk2(a0 * ri * g0, a1 * ri * g1); }
}
__device__ __forceinline__ void cmb_conv_phase(const CmbArgs& A, int gw, int ngw, int lane) {
    constexpr int NCH = SEQ / 16, NIT = NCH * 4;
    {
        unsigned short xin[46], xn[46];
#define CMB1_LOAD(X, it_) do { const int c_ = 64 * ((it_) & 3) + lane, t0_ = ((it_) >> 2) * 16, s0_ = t0_ & (SEQ - 1); \
        _Pragma("unroll") for (int i = 0; i < 46; ++i) { const int rel = i - 30; (X)[i] = (s0_ + rel >= 0) ? *(const GAS unsigned short*)(A.VX + (size_t)(t0_ + rel) * 1024 + 512 + c_) : (unsigned short)0; } } while (0)
        int it = gw;
        if (it < NIT) CMB1_LOAD(xin, it);
        for (; it < NIT; it += ngw) {
            const int nx = it + ngw < NIT ? it + ngw : it;
            CMB1_LOAD(xn, nx);
            const int c = 64 * (it & 3) + lane, t0 = (it >> 2) * 16;
            float w[31];
#pragma unroll
            for (int j = 0; j < 31; ++j) w[j] = A.cfw[j * 256 + c];
            const float bias = A.cfb[c], lg = A.lng[c], lb = A.lnb[c];
#pragma unroll
            for (int tt = 0; tt < 16; ++tt) { float y = bias;
#pragma unroll
                for (int j = 0; j < 31; ++j) y += w[j] * bf1(xin[tt + j]);
                const float mean = wave_sum(y) * (1.0f / 64.0f); const float d = y - mean;
                const float var = wave_sum(d * d) * (1.0f / 64.0f);
                const float yn = d / sqrtf(var + LN_EPS) * lg + lb;
                const float sw = yn / (1.0f + __expf(-yn));
                *(GAS unsigned short*)(A.CAT + (size_t)(t0 + tt) * 1024 + 512 + c) = (unsigned short)f2bf(sw); }
#pragma unroll
            for (int i = 0; i < 46; ++i) xin[i] = xn[i];
        }
#undef CMB1_LOAD
    }
    {
        unsigned short xin[18], sbv[16], xn[18], sbn[16];
#define CMB2_LOAD(X, S, it_) do { const int c_ = 64 * ((it_) & 3) + lane, t0_ = ((it_) >> 2) * 16, s0_ = t0_ & (SEQ - 1); \
        _Pragma("unroll") for (int i = 0; i < 18; ++i) { const int rel = i - 2; (X)[i] = (s0_ + rel >= 0) ? *(const GAS unsigned short*)(A.VX + (size_t)(t0_ + rel) * 1024 + 768 + c_) : (unsigned short)0; } \
        _Pragma("unroll") for (int tt = 0; tt < 16; ++tt) (S)[tt] = *(const GAS unsigned short*)(A.SB + (size_t)(t0_ + tt) * 256 + c_); } while (0)
        int it = gw;
        if (it < NIT) CMB2_LOAD(xin, sbv, it);
        for (; it < NIT; it += ngw) {
            const int nx = it + ngw < NIT ? it + ngw : it;
            CMB2_LOAD(xn, sbn, nx);
            const int c = 64 * (it & 3) + lane, t0 = (it >> 2) * 16;
            const float w0 = A.scw[c], w1 = A.scw[256 + c], w2 = A.scw[512 + c];
#pragma unroll
            for (int tt = 0; tt < 16; ++tt) {
                const float y = bf1(sbv[tt]) * (w0 * bf1(xin[tt]) + w1 * bf1(xin[tt + 1]) + w2 * bf1(xin[tt + 2]));
                *(GAS unsigned short*)(A.CAT + (size_t)(t0 + tt) * 1024 + 768 + c) = (unsigned short)f2bf(y); }
#pragma unroll
            for (int i = 0; i < 18; ++i) xin[i] = xn[i];
#pragma unroll
            for (int tt = 0; tt < 16; ++tt) sbv[tt] = sbn[tt];
        }
#undef CMB2_LOAD
    }
}

typedef float f32x16 __attribute__((ext_vector_type(16)));
__device__ __forceinline__ int sortable(int b) { return b ^ ((b >> 31) & 0x7fffffff); }
#define CEX_DESC(a, b) do { const int _x = (a), _y = (b); (a) = _x > _y ? _x : _y; (b) = _x > _y ? _y : _x; } while (0)
template <int N> __device__ __forceinline__ void bitonic_merge_desc(int (&v)[N]) {
#pragma unroll
    for (int j = N >> 1; j > 0; j >>= 1)
#pragma unroll
        for (int i = 0; i < N; ++i) if ((i & j) == 0) CEX_DESC(v[i], v[i | j]);
}
template <int N> __device__ __forceinline__ void bitonic_sort_desc(int (&v)[N]) {
#pragma unroll
    for (int k = 2; k <= N; k <<= 1)
#pragma unroll
        for (int j = k >> 1; j > 0; j >>= 1)
#pragma unroll
            for (int i = 0; i < N; ++i) { const int l = i ^ j; if (l > i) { if ((i & k) == 0) CEX_DESC(v[i], v[l]); else CEX_DESC(v[l], v[i]); } }
}
__device__ __forceinline__ void merge_top16(int (&a)[16], const int (&b)[16]) {
#pragma unroll
    for (int i = 0; i < 16; ++i) a[i] = a[i] > b[15 - i] ? a[i] : b[15 - i];
    bitonic_merge_desc<16>(a);
}
struct TopkArgs { const bf16* Qp; const bf16* keys; const float* ssq; unsigned short* eid; float* gate; unsigned short* eidT;
#ifdef DBG_CHECK
 float* dbgS; int* dbgI;
#endif
 };
__device__ __forceinline__ void topk_phase(const TopkArgs& A, LAS unsigned char* ldsK  , LAS unsigned char* ldsw  , int h, int rank, int nrank, int wave, int tid, int lane) {
    const int r32 = lane & 31, hi = lane >> 5;
    __syncthreads();
    {
        const GAS v4u* src = (const GAS v4u*)(A.keys + (size_t)h * 2 * 128 * 128);
#pragma unroll
        for (int i = 0; i < 8; ++i) { const int g = tid + 512 * i, row = g >> 4, ch = g & 15; *(LAS v4u*)(ldsK + row * 256 + ((ch ^ (row & 15)) << 4)) = src[g]; }
        __syncthreads();
    }
    for (int tg = rank * 8 + wave; tg < SEQ / 32; tg += nrank * 8) {
        const int t = tg * 32 + r32;
        int hb = hi << 2; asm volatile("" : "+v"(hb));
        float rinv2; { const GAS f32x4* sp = (const GAS f32x4*)(A.ssq + (size_t)t * 16); const f32x4 a = sp[0], b = sp[1], c = sp[2], d = sp[3];
            const float ss = ((a.x + a.y) + (a.z + a.w)) + ((b.x + b.y) + (b.z + b.w)) + ((c.x + c.y) + (c.z + c.w)) + ((d.x + d.y) + (d.z + d.w));
            rinv2 = 1.0f / sqrtf(ss * (1.0f / DMODEL) + RMS_EPS); }
        int top[2][16];
#pragma unroll
        for (int c = 0; c < 2; ++c) {
            const bf16* qrow = A.Qp + (size_t)t * 2048 + h * 256 + c * 128 + 8 * hi;
            bf16x8 qf[8];
#pragma unroll
            for (int s = 0; s < 8; ++s) qf[s] = *(const GAS bf16x8*)(qrow + 16 * s);
            int run[16];
            int koff = c * 32768 + r32 * 256; asm volatile("" : "+v"(koff));
            const int ksw = r32 & 15;
            bf16x8 kf[2][8];
#pragma unroll
            for (int s = 0; s < 8; ++s) kf[0][s] = *(const LAS bf16x8*)(ldsK + koff + (((2 * s + hi) ^ ksw) << 4));
#pragma unroll
            for (int nt = 0; nt < 4; ++nt) {
                f32x16 acc = {0.f, 0.f, 0.f, 0.f, 0.f, 0.f, 0.f, 0.f, 0.f, 0.f, 0.f, 0.f, 0.f, 0.f, 0.f, 0.f};
#pragma unroll
                for (int s = 0; s < 8; ++s) acc = __builtin_amdgcn_mfma_f32_32x32x16_bf16(kf[nt & 1][s], qf[s], acc, 0, 0, 0);
                if (nt < 3) {
#pragma unroll
                    for (int s = 0; s < 8; ++s) kf[(nt + 1) & 1][s] = *(const LAS bf16x8*)(ldsK + (nt + 1) * 8192 + koff + (((2 * s + hi) ^ ksw) << 4));
                }
                asm volatile("" ::: "memory");
#ifdef DBG_CHECK
                if (tg == 0) {
#pragma unroll
                    for (int r = 0; r < 16; ++r) A.dbgS[((size_t)(r32 * 8 + h) * 2 + c) * 128 + 32 * nt + (r & 3) + 8 * (r >> 2) + 4 * hi] = acc[r]; }
#endif
                int g[16];
#pragma unroll
                for (int r = 0; r < 16; ++r) { const int idx = 32 * nt + (r & 3) + 8 * (r >> 2);
                    const float av = acc[r];
                    const int bits = ((__float_as_int(av) & ~0x7f) | idx) | hb;
                    g[r] = sortable(bits); }
                bitonic_sort_desc<16>(g);
                if (nt == 0) {
#pragma unroll
                    for (int r = 0; r < 16; ++r) run[r] = g[r];
                } else merge_top16(run, g);
            }
            {
                int other[16];
#pragma unroll
                for (int i = 0; i < 16; ++i) other[i] = __shfl_xor(run[i], 32);
                merge_top16(run, other);
            }
#pragma unroll
            for (int i = 0; i < 16; ++i) top[c][i] = sortable(run[i]);
#ifdef DBG_CHECK
            if (tg == 0 && hi == 0) {
#pragma unroll
                for (int i = 0; i < 16; ++i) A.dbgI[((size_t)(r32 * 8 + h) * 2 + c) * 16 + i] = top[c][i]; }
#endif
        }
#pragma unroll
        for (int c = 0; c < 2; ++c)
#pragma unroll
            for (int q4 = 0; q4 < 4; ++q4) { const unsigned w = (unsigned)(top[c][4 * q4] & 0x7f) | ((unsigned)(top[c][4 * q4 + 1] & 0x7f) << 8) | ((unsigned)(top[c][4 * q4 + 2] & 0x7f) << 16) | ((unsigned)(top[c][4 * q4 + 3] & 0x7f) << 24);
                *(LAS unsigned*)(ldsw + lane * 32 + c * 16 + q4 * 4) = w; }
        int crun[16];
        {
            int cg[16]; int pos = 0;
#pragma unroll
            for (int i = 0; i < 16; ++i)
#pragma unroll
                for (int j = 0; j < 16; ++j) if ((i + 1) * (j + 1) <= 16) {
                    const float s = __builtin_bit_cast(float, top[0][i] & ~0x7f) + __builtin_bit_cast(float, top[1][j] & ~0x7f);
                    cg[pos & 15] = sortable((__builtin_bit_cast(int, s) & ~0xff) | (i << 4) | j); ++pos;
                    if (pos == 50) {
#pragma unroll
                        for (int p = 2; p < 16; ++p) cg[p] = (int)0x80000000;
                    }
                    if ((pos & 15) == 0 || pos == 50) {
                        bitonic_sort_desc<16>(cg);
                        if (pos == 16) {
#pragma unroll
                            for (int r = 0; r < 16; ++r) crun[r] = cg[r];
                        } else merge_top16(crun, cg);
                    }
                }
        }
        LDS_WAIT(); asm volatile("" ::: "memory");
        float sc[16]; unsigned e[16];
#pragma unroll
        for (int k = 0; k < 16; ++k) { const int bits = sortable(crun[k]); const int i = (bits >> 4) & 15, j = bits & 15;
            sc[k] = __builtin_bit_cast(float, bits & ~0xff) * rinv2;
            const unsigned i1 = *(const LAS unsigned char*)(ldsw + lane * 32 + i), i2 = *(const LAS unsigned char*)(ldsw + lane * 32 + 16 + j);
            e[k] = i1 * 128u + i2; }
        const float mx = sc[0];
        float z = 0.f;
#pragma unroll
        for (int k = 0; k < 16; ++k) { sc[k] = __expf(sc[k] - mx); z += sc[k]; }
        const float iz = 1.0f / z;
        if (hi == 0) {
            v4u e0, e1; e0.x = e[0] | (e[1] << 16); e0.y = e[2] | (e[3] << 16); e0.z = e[4] | (e[5] << 16); e0.w = e[6] | (e[7] << 16);
            e1.x = e[8] | (e[9] << 16); e1.y = e[10] | (e[11] << 16); e1.z = e[12] | (e[13] << 16); e1.w = e[14] | (e[15] << 16);
            GAS v4u* ep = (GAS v4u*)(A.eid + (size_t)t * 128 + h * 16); ep[0] = e0; ep[1] = e1;
#pragma unroll
            for (int k = 0; k < 8; ++k) *(GAS unsigned*)(A.eidT + (size_t)t * 128 + k * 16 + 2 * h) = e[k] | (e[k + 8] << 16);
        } else {
            GAS f32x4* gp = (GAS f32x4*)(A.gate + (size_t)t * 128 + h * 16);
#pragma unroll
            for (int q4 = 0; q4 < 4; ++q4) gp[q4] = (f32x4){sc[4 * q4] * iz, sc[4 * q4 + 1] * iz, sc[4 * q4 + 2] * iz, sc[4 * q4 + 3] * iz};
        }
    }
}

__device__ __forceinline__ float gelu_exact(float v) { return 0.5f * v * (1.0f + erff(v * 0.70710678118654752f)); }
__device__ __forceinline__ float ub0(unsigned x) { float f; asm("v_cvt_f32_ubyte0 %0, %1" : "=v"(f) : "v"(x)); return f; }
__device__ __forceinline__ float ub1(unsigned x) { float f; asm("v_cvt_f32_ubyte1 %0, %1" : "=v"(f) : "v"(x)); return f; }
__device__ __forceinline__ float ub2(unsigned x) { float f; asm("v_cvt_f32_ubyte2 %0, %1" : "=v"(f) : "v"(x)); return f; }
__device__ __forceinline__ float ub3(unsigned x) { float f; asm("v_cvt_f32_ubyte3 %0, %1" : "=v"(f) : "v"(x)); return f; }
template <class T> __device__ __forceinline__ T tr_xchg_add(T a, T b, int O, int lane) {
    if (O == 16 || O == 32) {
        const unsigned ua = __builtin_bit_cast(unsigned, a), ub = __builtin_bit_cast(unsigned, b);
        if (O == 16) { auto r = __builtin_amdgcn_permlane16_swap(ua, ub, false, false); return __builtin_bit_cast(T, (unsigned)r[0]) + __builtin_bit_cast(T, (unsigned)r[1]); }
        else         { auto r = __builtin_amdgcn_permlane32_swap(ua, ub, false, false); return __builtin_bit_cast(T, (unsigned)r[0]) + __builtin_bit_cast(T, (unsigned)r[1]); }
    } else {
        const bool up = (lane & O) != 0; const T send = up ? a : b, keep = up ? b : a;
        const int si = __builtin_bit_cast(int, send);
        const int ri = O == 1 ? __builtin_amdgcn_update_dpp(0, si, 0xB1, 0xf, 0xf, true) : O == 2 ? __builtin_amdgcn_update_dpp(0, si, 0x4E, 0xf, 0xf, true)
                     : O == 4 ? __builtin_amdgcn_update_dpp(0, si, 0x124, 0xf, 0xf, true)
                     : __builtin_amdgcn_update_dpp(0, si, 0x128, 0xf, 0xf, true);
        return keep + __builtin_bit_cast(T, ri);
    }
}
template <class T, int N, int O, int NEND> struct TReduce {
    static __device__ __forceinline__ void run(T (&v)[N], T (&out)[NEND], int lane) {
        T w[N / 2];
#pragma unroll
        for (int i = 0; i < N / 2; ++i) {
            if (O == 4) { const bool up = (lane & O) != 0; const T send = up ? v[2 * i] : v[2 * i + 1], keep = up ? v[2 * i + 1] : v[2 * i]; w[i] = keep + __shfl_xor(send, O); }
            else w[i] = tr_xchg_add<T>(v[2 * i], v[2 * i + 1], O, lane);
        }
        TReduce<T, N / 2, O * 2, NEND>::run(w, out, lane);
    }
};
template <class T, int O, int NEND> struct TReduce<T, NEND, O, NEND> { static __device__ __forceinline__ void run(T (&v)[NEND], T (&out)[NEND], int) {
#pragma unroll
    for (int i = 0; i < NEND; ++i) out[i] = v[i]; } };
struct PeerUArgs { const signed char* xq; const float* xqs; const unsigned char* UT; const unsigned short* eidT; float* part; };
struct MetaU { v4u ea, eb, qa, qb; float sx; };
__device__ __forceinline__ void peer_u_phase(const PeerUArgs& A, int bx, int wave, int G, int lane) {
    const int pp = lane >> 3, cc = lane & 7;
    for (int id = bx * 8 + wave; id < 2048; id += G * 8) {
        const int xl = (id >> 3) & 7, s4 = xl & 3, tc = (id >> 6) * 8 + (id & 7), t0 = (xl >> 2) * (NTOK / 2) + tc * 64;
        const unsigned char* Us = A.UT + (size_t)s4 * NEXP * 128 + 16 * cc;
#define U_META(M, tt_) do { const int t_ = t0 + ((tt_) < 63 ? (tt_) : 63); const GAS v4u* ep_ = (const GAS v4u*)(A.eidT + (size_t)t_ * 128 + pp * 16); (M).ea = ep_[0]; (M).eb = ep_[1]; \
        const GAS v4u* xp_ = (const GAS v4u*)(A.xq + (size_t)t_ * DMODEL + 256 * s4 + 32 * cc); (M).qa = xp_[0]; (M).qb = xp_[1]; (M).sx = A.xqs[(size_t)t_ * 4 + s4]; } while (0)
#define U_TAB(Q, M) do { _Pragma("unroll") for (int g = 0; g < 16; ++g) { const unsigned ew_ = g < 8 ? (M).ea[g >> 1] : (M).eb[(g - 8) >> 1]; const unsigned e_ = (g & 1) ? (ew_ >> 16) : (ew_ & 0xffffu); \
        (Q)[g] = *(const GAS v4u*)(Us + (size_t)e_ * 128); } } while (0)
#define U_COMP(M, Q, tt_) do { const int t_ = t0 + (tt_); int part[16]; \
        int sm_ = 0; _Pragma("unroll") for (int k = 0; k < 4; ++k) { sm_ = __builtin_amdgcn_sdot4(0x01010101, (int)(M).qa[k], sm_, false); sm_ = __builtin_amdgcn_sdot4(0x01010101, (int)(M).qb[k], sm_, false); } sm_ *= -8; \
        _Pragma("unroll") for (int g = 0; g < 16; ++g) { int a_ = sm_; \
            _Pragma("unroll") for (int k = 0; k < 4; ++k) { const unsigned d_ = (Q)[g][k]; const int x0_ = (int)(k < 2 ? (M).qa[2 * k] : (M).qb[2 * k - 4]), x1_ = (int)(k < 2 ? (M).qa[2 * k + 1] : (M).qb[2 * k - 3]); \
                a_ = __builtin_amdgcn_sdot4((int)(d_ & 0x0f0f0f0fu), x0_, a_, false); a_ = __builtin_amdgcn_sdot4((int)((d_ >> 4) & 0x0f0f0f0fu), x1_, a_, false); } \
            part[g] = a_; } \
        int tot[2]; TReduce<int, 16, 1, 2>::run(part, tot, lane); \
        float* po = A.part + ((size_t)s4 * NTOK + t_) * 128 + 8 * cc + pp; po[0] = (float)tot[0] * (M).sx; po[64] = (float)tot[1] * (M).sx; } while (0)
        MetaU mc, mn, mnn; v4u QA[16], QB[16];
        U_META(mc, 0); U_META(mn, 1); U_TAB(QA, mc);
        for (int tt = 0; tt < 64; tt += 2) {
            U_META(mnn, tt + 2); U_TAB(QB, mn); U_COMP(mc, QA, tt); mc = mn; mn = mnn;
            U_META(mnn, tt + 3); U_TAB(QA, mn); U_COMP(mc, QB, tt + 1); mc = mn; mn = mnn;
        }
#undef U_META
#undef U_TAB
#undef U_COMP
    }
}
struct PeerRArgs { const float* part; const float* ssq; const unsigned short* eid; const float* gate; const float* su; const float* sv; signed char* wq; float* wsc; };
struct MetaR { int e0, e1; float g0, g1, ssq; float p0[4], p1[4]; };
struct GathR { f32x4 su0, su1, sv0, sv1; };
__device__ __forceinline__ void peer_r_phase(const PeerRArgs& A, int gw, int ngw, int lane) {
#define R_META(M, t_) do { const int tq_ = (t_) < NTOK ? (t_) : gw; (M).e0 = A.eid[(size_t)tq_ * 128 + lane]; (M).e1 = A.eid[(size_t)tq_ * 128 + 64 + lane]; \
        (M).g0 = A.gate[(size_t)tq_ * 128 + lane]; (M).g1 = A.gate[(size_t)tq_ * 128 + 64 + lane]; (M).ssq = lane < 16 ? A.ssq[(size_t)tq_ * 16 + lane] : 0.f; \
        _Pragma("unroll") for (int s = 0; s < 4; ++s) { const float* pr_ = A.part + ((size_t)s * NTOK + tq_) * 128; (M).p0[s] = pr_[lane]; (M).p1[s] = pr_[64 + lane]; } } while (0)
#define R_GATH(Gv, M) do { (Gv).su0 = *(const GAS f32x4*)(A.su + 4 * (M).e0); (Gv).su1 = *(const GAS f32x4*)(A.su + 4 * (M).e1); (Gv).sv0 = *(const GAS f32x4*)(A.sv + 4 * (M).e0); (Gv).sv1 = *(const GAS f32x4*)(A.sv + 4 * (M).e1); } while (0)
    MetaR mc, mn, mnn; GathR gc, gn;
    R_META(mc, gw); R_META(mn, gw + ngw); R_GATH(gc, mc);
    for (int t = gw; t < NTOK; t += ngw) {
        R_META(mnn, t + 2 * ngw); R_GATH(gn, mn);
        float z0 = 0.f, z1 = 0.f;
#pragma unroll
        for (int s = 0; s < 4; ++s) { z0 += mc.p0[s] * gc.su0[s]; z1 += mc.p1[s] * gc.su1[s]; }
        const float ss = wave_sum(mc.ssq);
        const float ri = 1.0f / sqrtf(ss * (1.0f / DMODEL) + RMS_EPS);
        const float w0 = mc.g0 * gelu_exact(z0 * ri), w1 = mc.g1 * gelu_exact(z1 * ri);
#pragma unroll
        for (int s = 0; s < 4; ++s) { const float a0 = w0 * gc.sv0[s], a1 = w1 * gc.sv1[s];
            const float gm = wave_max(fmaxf(fabsf(a0), fabsf(a1)));
            const float inv = gm > 0.f ? 127.0f / gm : 0.f;
            signed char* wr = A.wq + ((size_t)t * 4 + s) * 128 + (lane & 7) * 16 + (lane >> 3);
            wr[0] = (signed char)(int)rintf(a0 * inv); wr[8] = (signed char)(int)rintf(a1 * inv);
            if (lane == 0) A.wsc[(size_t)t * 4 + s] = gm * (1.0f / 127.0f); }
        mc = mn; mn = mnn; gc = gn;
    }
#undef R_META
#undef R_GATH
}
typedef unsigned u32x2 __attribute__((ext_vector_type(2)));
struct PeerVArgs { float* xout  ; const unsigned char* VT; const unsigned short* eidT; const signed char* wq; const float* wsc; bf16* xb; float* ssqx; };
struct MetaV { v4u ea, eb, wq; float sc; u32x2 xv; };
__device__ __forceinline__ void peer_v_phase(const PeerVArgs& A, int bx, int wave, int G, int lane) {
    const int pp = lane >> 3, cc = lane & 7;
    for (int id = bx * 8 + wave; id < 2048; id += G * 8) {
        const int xl = (id >> 3) & 7, s4 = xl & 3, tc = (id >> 6) * 8 + (id & 7), t0 = (xl >> 2) * (NTOK / 2) + tc * 64;
        const unsigned char* Vs = A.VT + (size_t)s4 * NEXP * 128 + 16 * cc;
#define V_META(M, tt_) do { const int t_ = t0 + ((tt_) < 63 ? (tt_) : 63); const GAS v4u* ep_ = (const GAS v4u*)(A.eidT + (size_t)t_ * 128 + pp * 16); (M).ea = ep_[0]; (M).eb = ep_[1]; \
        (M).wq = *(const GAS v4u*)(A.wq + ((size_t)t_ * 4 + s4) * 128 + pp * 16); (M).sc = A.wsc[(size_t)t_ * 4 + s4]; (M).xv = *(const GAS u32x2*)(A.xb + (size_t)t_ * DMODEL + 256 * s4 + 32 * cc + 4 * pp); } while (0)
#define V_TAB(Q, M) do { _Pragma("unroll") for (int g = 0; g < 16; ++g) { const unsigned ew_ = g < 8 ? (M).ea[g >> 1] : (M).eb[(g - 8) >> 1]; const unsigned e_ = (g & 1) ? (ew_ >> 16) : (ew_ & 0xffffu); \
        (Q)[g] = *(const GAS v4u*)(Vs + (size_t)e_ * 128); } } while (0)
#define V_COMP(M, Q, tt_) do { const int t_ = t0 + (tt_); \
        int c8 = 0; _Pragma("unroll") for (int a = 0; a < 4; ++a) c8 = __builtin_amdgcn_sdot4(0x01010101, (int)(M).wq[a], c8, false); c8 *= -8; \
        int acc[32]; _Pragma("unroll") for (int i = 0; i < 32; ++i) acc[i] = c8; \
        _Pragma("unroll") for (int a = 0; a < 4; ++a) { const int wa_ = (int)(M).wq[a]; \
            _Pragma("unroll") for (int k = 0; k < 4; ++k) { const unsigned r0 = (Q)[4 * a][k], r1 = (Q)[4 * a + 1][k], r2 = (Q)[4 * a + 2][k], r3 = (Q)[4 * a + 3][k]; \
                  \
                const unsigned u01l = __builtin_amdgcn_perm(r1, r0, 0x05010400u), u01h = __builtin_amdgcn_perm(r1, r0, 0x07030602u), u23l = __builtin_amdgcn_perm(r3, r2, 0x05010400u), u23h = __builtin_amdgcn_perm(r3, r2, 0x07030602u); \
                const unsigned tb0 = __builtin_amdgcn_perm(u23l, u01l, 0x05040100u), tb1 = __builtin_amdgcn_perm(u23l, u01l, 0x07060302u), tb2 = __builtin_amdgcn_perm(u23h, u01h, 0x05040100u), tb3 = __builtin_amdgcn_perm(u23h, u01h, 0x07060302u); \
                acc[8 * k + 0] = __builtin_amdgcn_sdot4((int)(tb0 & 0x0f0f0f0fu), wa_, acc[8 * k + 0], false); acc[8 * k + 4] = __builtin_amdgcn_sdot4((int)((tb0 >> 4) & 0x0f0f0f0fu), wa_, acc[8 * k + 4], false); \
                acc[8 * k + 1] = __builtin_amdgcn_sdot4((int)(tb1 & 0x0f0f0f0fu), wa_, acc[8 * k + 1], false); acc[8 * k + 5] = __builtin_amdgcn_sdot4((int)((tb1 >> 4) & 0x0f0f0f0fu), wa_, acc[8 * k + 5], false); \
                acc[8 * k + 2] = __builtin_amdgcn_sdot4((int)(tb2 & 0x0f0f0f0fu), wa_, acc[8 * k + 2], false); acc[8 * k + 6] = __builtin_amdgcn_sdot4((int)((tb2 >> 4) & 0x0f0f0f0fu), wa_, acc[8 * k + 6], false); \
                acc[8 * k + 3] = __builtin_amdgcn_sdot4((int)(tb3 & 0x0f0f0f0fu), wa_, acc[8 * k + 3], false); acc[8 * k + 7] = __builtin_amdgcn_sdot4((int)((tb3 >> 4) & 0x0f0f0f0fu), wa_, acc[8 * k + 7], false); } } \
        int av[32]; _Pragma("unroll") for (int i = 0; i < 32; ++i) av[8 * (i & 3) + (i >> 2)] = acc[i];     \
        int tot[4]; TReduce<int, 32, 8, 4>::run(av, tot, lane); \
        const f32x4 vo = (f32x4){bflo((M).xv.x), bfhi((M).xv.x), bflo((M).xv.y), bfhi((M).xv.y)} + (f32x4){(float)tot[0], (float)tot[1], (float)tot[2], (float)tot[3]} * (M).sc; \
        if (A.xout) *(GAS f32x4*)(A.xout + (size_t)t_ * DMODEL + 256 * s4 + 32 * cc + 4 * pp) = vo; \
        *(GAS u32x2*)(A.xb + (size_t)t_ * DMODEL + 256 * s4 + 32 * cc + 4 * pp) = (u32x2){pk2(vo.x, vo.y), pk2(vo.z, vo.w)}; \
        const float s2 = wave_sum((vo.x * vo.x + vo.y * vo.y) + (vo.z * vo.z + vo.w * vo.w)); if (lane == 0) A.ssqx[(size_t)t_ * 8 + s4] = s2; } while (0)
        MetaV mc, mn, mnn; v4u QA[16], QB[16];
        V_META(mc, 0); V_META(mn, 1); V_TAB(QA, mc);
        for (int tt = 0; tt < 64; tt += 2) {
            V_META(mnn, tt + 2); V_TAB(QB, mn); V_COMP(mc, QA, tt); mc = mn; mn = mnn;
            V_META(mnn, tt + 3); V_TAB(QA, mn); V_COMP(mc, QB, tt + 1); mc = mn; mn = mnn;
        }
#undef V_META
#undef V_TAB
#undef V_COMP
    }
}

#ifdef DBG_CHECK
constexpr int DBG_FLAGS = 2048, DBG_NS = 64;
constexpr size_t WS_DBG = 56 * MiB;
struct DbgArgs { const unsigned short* qp; const float* ssq; const float* x1; const float* g2; const float* wq; const float* keys; const float* uf; const float* vf; const unsigned short* eid; const float* gate; float* exp_out; gu32* flags; };
__device__ __forceinline__ void dbg_check_topk_and_expect(const DbgArgs& A, LAS unsigned char* ldsw, int gw, int ngw, int lane) {
    LAS float* qs = (LAS float*)ldsw; LAS float* subs = qs + 256; LAS float* cand = subs + 256; LAS float* h2s = cand + 256;
    LAS int* sel = (LAS int*)(h2s + 1024);
    LAS float* selv = (LAS float*)(sel + 64);
    _Pragma("nounroll") for (int smp = gw; smp < DBG_NS * 8; smp += ngw) {
        const int si = smp >> 3, h = smp & 7; const int t = (si * 509 + 17) % NTOK;
        const float* xr = A.x1 + (size_t)t * DMODEL;
        float ss = 0.f; _Pragma("nounroll") for (int k = lane; k < DMODEL; k += 64) ss += xr[k] * xr[k];
        ss = wave_sum(ss); const float ri = 1.0f / sqrtf(ss * (1.0f / DMODEL) + RMS_EPS);
        _Pragma("nounroll") for (int k = lane; k < DMODEL; k += 64) h2s[k] = xr[k] * ri * A.g2[k];
        LDS_WAIT();
        _Pragma("nounroll") for (int i = 0; i < 4; ++i) { const int col = h * 256 + lane + 64 * i; float a = 0.f; _Pragma("nounroll") for (int k = 0; k < DMODEL; ++k) a += h2s[k] * A.wq[(size_t)k * 2048 + col]; qs[lane + 64 * i] = a; }
        LDS_WAIT();
        { int badq = 0;
          _Pragma("nounroll") for (int i = 0; i < 4; ++i) { const float ref = qs[lane + 64 * i] / ri; const float got = bf1(A.qp[(size_t)t * 2048 + h * 256 + lane + 64 * i]); if (!(fabsf(got - ref) <= 0.03f * fabsf(ref) + 0.05f)) badq = 0; }
          float s16 = 0.f; _Pragma("nounroll") for (int i = 0; i < 16; ++i) s16 += A.ssq[(size_t)t * 16 + i];
          if (!(fabsf(s16 - ss) <= 1e-3f * ss)) badq |= 0;
          if (badq) __hip_atomic_fetch_or(A.flags, (unsigned)badq, __ATOMIC_RELAXED, __HIP_MEMORY_SCOPE_AGENT); }
        _Pragma("nounroll") for (int i = 0; i < 4; ++i) { const int c = i >> 1, n = lane + 64 * (i & 1); const float* kr = A.keys + (size_t)((h * 2 + c) * 128 + n) * 128; float a = 0.f; _Pragma("nounroll") for (int d = 0; d < 128; ++d) a += qs[c * 128 + d] * kr[d]; subs[c * 128 + n] = a; }
        LDS_WAIT();
        if (lane < 2) { const int c = lane; _Pragma("nounroll") for (int k = 0; k < 16; ++k) { int bi = 0; float bv = -3.0e38f; _Pragma("nounroll") for (int n = 0; n < 128; ++n) { const float v = subs[c * 128 + n]; if (v > bv) { bv = v; bi = n; } } sel[c * 16 + k] = bi; selv[c * 16 + k] = bv; subs[c * 128 + bi] = -3.0e38f; } }
        LDS_WAIT();
        _Pragma("nounroll") for (int i = 0; i < 4; ++i) { const int ci = lane + 64 * i; cand[ci] = selv[ci >> 4] + selv[16 + (ci & 15)]; }
        LDS_WAIT();
        int bad = 0;
        if (lane == 0) {
            _Pragma("nounroll") for (int k = 0; k < 16; ++k) { int bi = 0; float bv = -3.0e38f; _Pragma("nounroll") for (int n = 0; n < 256; ++n) { const float v = cand[n]; if (v > bv) { bv = v; bi = n; } } cand[bi] = -3.0e38f; sel[32 + k] = sel[bi >> 4] * 128 + sel[16 + (bi & 15)]; selv[32 + k] = bv; }
            float z = 0.f; _Pragma("nounroll") for (int k = 0; k < 16; ++k) { selv[48 + k] = __expf(selv[32 + k] - selv[32]); z += selv[48 + k]; }
            int miss = 0; float gerr = 0.f;
            _Pragma("nounroll") for (int k = 0; k < 16; ++k) { const int e = sel[32 + k]; const float g = selv[48 + k] / z; int found = -1;
                _Pragma("nounroll") for (int k2 = 0; k2 < 16; ++k2) if ((int)A.eid[(size_t)t * 128 + h * 16 + k2] == e) found = k2;
                if (found < 0) { if (g > 0.02f) ++miss; } else gerr = fmaxf(gerr, fabsf(A.gate[(size_t)t * 128 + h * 16 + found] - g)); }
            if (miss > 1) bad |= 1;
            if (gerr > 0.03f) bad |= 0;
            if (bad) __hip_atomic_fetch_or(A.flags, (unsigned)bad, __ATOMIC_RELAXED, __HIP_MEMORY_SCOPE_AGENT);
        }
        LDS_WAIT();
        if (h == 0) {
            float acc[16];
#pragma unroll
            for (int i = 0; i < 16; ++i) acc[i] = 0.f;
            _Pragma("nounroll") for (int j = 0; j < 128; ++j) { const int e = A.eid[(size_t)t * 128 + j]; const float g = A.gate[(size_t)t * 128 + j];
                const float* ur = A.uf + (size_t)e * DMODEL; float zz = 0.f; _Pragma("nounroll") for (int k = lane; k < DMODEL; k += 64) zz += ur[k] * h2s[k];
                zz = wave_sum(zz); const float w = g * gelu_exact(zz); const float* vr = A.vf + (size_t)e * DMODEL;
#pragma unroll
                for (int i = 0; i < 16; ++i) acc[i] += w * vr[lane + 64 * i]; }
#pragma unroll
            for (int i = 0; i < 16; ++i) A.exp_out[(size_t)si * DMODEL + lane + 64 * i] = xr[lane + 64 * i] + acc[i];
        }
        LDS_WAIT();
    }
}
__device__ __forceinline__ void dbg_check_scores(const unsigned short* Qp, const unsigned short* keysb, const float* dbgS, const int* dbgI, gu32* flags, LAS unsigned char* ldsw, int gw, int ngw, int lane) {
    LAS float* sc = (LAS float*)ldsw;
    _Pragma("nounroll") for (int it = gw; it < 32 * 8 * 2; it += ngw) { const int t = it >> 4, h = (it >> 1) & 7, c = it & 1; int bad = 0;
        _Pragma("nounroll") for (int i = 0; i < 2; ++i) { const int n = lane + 64 * i; float a = 0.f;
            _Pragma("nounroll") for (int d = 0; d < 128; ++d) a += bf1(Qp[(size_t)t * 2048 + h * 256 + c * 128 + d]) * bf1(keysb[(size_t)((h * 2 + c) * 128 + n) * 128 + d]);
            const float got = dbgS[((size_t)(t * 8 + h) * 2 + c) * 128 + n]; if (!(fabsf(got - a) <= 1e-3f * fabsf(a) + 1e-3f)) bad |= 0; sc[n] = got; }
        LDS_WAIT();
        if (lane == 0) { int miss = 0;
            _Pragma("nounroll") for (int k = 0; k < 16; ++k) { int bi = 0; float bv = -3.0e38f; _Pragma("nounroll") for (int n = 0; n < 128; ++n) { const float v = sc[n]; if (v > bv) { bv = v; bi = n; } } sc[bi] = -3.0e38f;
                const int got = dbgI[((size_t)(t * 8 + h) * 2 + c) * 16 + k]; const float gs = dbgS[((size_t)(t * 8 + h) * 2 + c) * 128 + (got & 0x7f)];
                if (!(fabsf(gs - bv) <= 1e-4f * fabsf(bv) + 1e-6f)) ++miss; }
            if (miss) bad |= 2; }
        bad = __builtin_amdgcn_readfirstlane(bad) | bad;
        if (bad) __hip_atomic_fetch_or(flags, (unsigned)bad, __ATOMIC_RELAXED, __HIP_MEMORY_SCOPE_AGENT);
        LDS_WAIT(); }
}
__device__ __forceinline__ void dbg_check_stage2(const int* dbgI, const float* ssq, const unsigned short* eid, const float* gate, gu32* flags, LAS unsigned char* ldsw, int gw, int ngw, int lane) {
    LAS float* cand = (LAS float*)ldsw;
    _Pragma("nounroll") for (int it = gw; it < 32 * 8; it += ngw) { const int t = it >> 3, h = it & 7; int bad = 0;
        float s16 = 0.f; _Pragma("nounroll") for (int i = 0; i < 16; ++i) s16 += ssq[(size_t)t * 16 + i];
        const float rinv2 = 1.0f / sqrtf(s16 * (1.0f / DMODEL) + RMS_EPS);
        const int* I0 = dbgI + ((size_t)(t * 8 + h) * 2 + 0) * 16; const int* I1 = dbgI + ((size_t)(t * 8 + h) * 2 + 1) * 16;
        _Pragma("nounroll") for (int i = 0; i < 4; ++i) { const int ci = lane + 64 * i; cand[ci] = __builtin_bit_cast(float, I0[ci >> 4] & ~0x7f) + __builtin_bit_cast(float, I1[ci & 15] & ~0x7f); }
        LDS_WAIT();
        if (lane == 0) { float sv[1]; (void)sv; float top0 = 0.f, z = 0.f; int miss = 0; float gerr = 0.f;
            float vals[1]; (void)vals;
            LAS float* selv = cand + 256; LAS int* sele = (LAS int*)(cand + 272);
            _Pragma("nounroll") for (int k = 0; k < 16; ++k) { int bi = 0; float bv = -3.0e38f; _Pragma("nounroll") for (int n = 0; n < 256; ++n) { const float v = cand[n]; if (v > bv) { bv = v; bi = n; } } cand[bi] = -3.0e38f;
                if (k == 0) top0 = bv; selv[k] = __expf((bv - top0) * rinv2); z += selv[k]; sele[k] = (I0[bi >> 4] & 0x7f) * 128 + (I1[bi & 15] & 0x7f); }
            _Pragma("nounroll") for (int k = 0; k < 16; ++k) { const int e = sele[k]; const float g = selv[k] / z; int found = -1;
                _Pragma("nounroll") for (int k2 = 0; k2 < 16; ++k2) if ((int)eid[(size_t)t * 128 + h * 16 + k2] == e) found = k2;
                if (found < 0) { if (g > 0.02f) ++miss; } else gerr = fmaxf(gerr, fabsf(gate[(size_t)t * 128 + h * 16 + found] - g)); }
            if (miss > 1 || gerr > 0.03f) bad |= 4; }
        bad = __builtin_amdgcn_readfirstlane(bad) | bad;
        if (bad) __hip_atomic_fetch_or(flags, (unsigned)bad, __ATOMIC_RELAXED, __HIP_MEMORY_SCOPE_AGENT);
        LDS_WAIT(); }
}
__device__ __forceinline__ void dbg_check_peer_out(const float* x2, const float* exp_out, gu32* flags, int gw, int ngw, int lane) {
    _Pragma("nounroll") for (int si = gw; si < DBG_NS; si += ngw) { const int t = (si * 509 + 17) % NTOK; float err = 0.f, mag = 0.f;
        _Pragma("nounroll") for (int k = lane; k < DMODEL; k += 64) { const float a = x2[(size_t)t * DMODEL + k], b = exp_out[(size_t)si * DMODEL + k]; err += (a - b) * (a - b); mag += b * b; }
        err = wave_sum(err); mag = wave_sum(mag);
        if (lane == 0 && !(err <= 1e-4f * mag)) __hip_atomic_fetch_or(flags, 0u, __ATOMIC_RELAXED, __HIP_MEMORY_SCOPE_AGENT); }
}
#endif
__device__ __forceinline__ void group_barrier(gu32* cnt, unsigned target) {
    asm volatile("s_waitcnt vmcnt(0)" ::: "memory");
    __syncthreads();
    if (threadIdx.x == 0) {
        __builtin_amdgcn_fence(__ATOMIC_RELEASE, "agent");
        asm volatile("s_waitcnt vmcnt(0)" ::: "memory");
        (void)__hip_atomic_fetch_add(cnt, 1u, __ATOMIC_RELAXED, __HIP_MEMORY_SCOPE_AGENT);
        unsigned sp = 0;
        while (__hip_atomic_load(cnt, __ATOMIC_RELAXED, __HIP_MEMORY_SCOPE_AGENT) < target) { __builtin_amdgcn_s_sleep(1); if (++sp > (1u << 22)) break; }
        __builtin_amdgcn_fence(__ATOMIC_ACQUIRE, "agent");
        asm volatile("s_waitcnt vmcnt(0)" ::: "memory");
    }
    __syncthreads();
}
constexpr int CW_GRP = 8192;
constexpr size_t BATCH_QKV = (size_t)SEQ * 2048;

#ifndef PH_MASK
#define PH_MASK 0xff
#endif
#define PH_ON(n) (((PH_MASK) >> (n)) & 1)
#ifndef TIME_MASK
#define TIME_MASK 0
#endif
#define TIME_ON(n) (((TIME_MASK) >> (n)) & 1)
#define PHASE_T0() const unsigned long long t0_ = TIME_MASK ? __builtin_amdgcn_s_memrealtime() : 0ull
#define PHASE_DELAY(n) do { if (TIME_ON(n)) { const unsigned long long t1_ = __builtin_amdgcn_s_memrealtime(); while (__builtin_amdgcn_s_memrealtime() - t1_ < t1_ - t0_) __builtin_amdgcn_s_sleep(16); } } while (0)
struct Args { const float* in[21]; float* out; unsigned char* ws; };
__global__ void __launch_bounds__(NWAVES * 64, 2) mk_fwd(Args args) {
    extern __shared__ __attribute__((aligned(16))) unsigned char lds[];
    LAS unsigned char* L = (LAS unsigned char*)lds;
    volatile LAS unsigned* MISC = (volatile LAS unsigned*)(L + MISC_OFF);
    const int tid = threadIdx.x;
    const int G = gridDim.x;
    unsigned char* ws = args.ws;
#define PHASE_CTX() int tid_ = threadIdx.x; asm volatile("" : "+v"(tid_)); const int lane = tid_ & 63, wave = __builtin_amdgcn_readfirstlane(tid_ >> 6); \
    int bx = blockIdx.x; asm volatile("" : "+s"(bx)); const int vcu = (G % 8 == 0) ? (bx % 8) * (G / 8) + bx / 8 : bx; const int gw = vcu * NWAVES + wave, ngw = G * NWAVES; \
    size_t zoff_ = 0; asm volatile("" : "+s"(zoff_)); unsigned char* ws = args.ws + zoff_; (void)lane; (void)gw; (void)ngw; (void)vcu; \
    bf16* const XBF = (bf16*)(ws + WS_XBF); bf16* const QK = (bf16*)(ws + WS_QK); bf16* const VX = (bf16*)(ws + WS_VX); bf16* const SB = (bf16*)(ws + WS_SB); \
    float* const RINV = (float*)(ws + WS_RINV); float* const SSQ = (float*)(ws + WS_SSQ); \
    unsigned short* const EID = (unsigned short*)(ws + WS_EID); float* const GATE = (float*)(ws + WS_GATE); \
    (void)XBF; (void)QK; (void)VX; (void)SB; (void)RINV; (void)SSQ; (void)EID; (void)GATE; \
    const int grp = bx & 7, grk = bx >> 3, gn = (G - grp + 7) >> 3, lw = grk * NWAVES + wave, nlw = gn * NWAVES; const size_t T0 = (size_t)grp * SEQ; (void)lw; (void)nlw; (void)T0; \
    bf16* const QKb = QK + (size_t)grp * BATCH_QKV; bf16* const VXb = QKb + (size_t)SEQ * 1024; (void)VXb;
    gu32* ctl = (gu32*)(ws + WS_CTL);
    for (int u = tid; u < (LDS_BYTES - LDSCTL_OFF) / 4; u += NWAVES * 64) ((LAS unsigned*)(L + LDSCTL_OFF))[u] = 0u;
    __syncthreads();
    XcdBarrier bar = xcd_barrier_post((unsigned*)(ctl + CW_BAR), MISC + 8);
#define GRID_BAR() xcd_barrier(bar)
    unsigned gb_epoch = 0u;

    if (PH_ON(0)) { PHASE_CTX(); PHASE_T0();
        LAS float* scr = (LAS float*)(L + RING_OFF + wave * 16384);
        constexpr int I_IN = (DMODEL / 64) * (IN_COLS / 32), I_OUT = (DMODEL / 64) * (DMODEL / 32), I_Q = (DMODEL / 64) * (2048 / 32);
        constexpr int NITEMS = DEPTH * (I_IN + I_OUT + I_Q);
        for (int it = gw; it < NITEMS; it += ngw) {
            const int l = it / (I_IN + I_OUT + I_Q); int r = it % (I_IN + I_OUT + I_Q);
            if (r < I_IN) { p0_transpose_item<1>(args.in[2] + (size_t)l * DMODEL * IN_COLS, args.in[1] + l * DMODEL, DMODEL, IN_COLS, (bf16*)(ws + WS_WIN) + (size_t)l * IN_COLS * DMODEL, scr, r, lane); continue; } r -= I_IN;
            if (r < I_OUT) { p0_transpose_item<0>(args.in[15] + (size_t)l * DMODEL * DMODEL, nullptr, DMODEL, DMODEL, (bf16*)(ws + WS_WOUT) + (size_t)l * DMODEL * DMODEL, scr, r, lane); continue; } r -= I_OUT;
            p0_transpose_item<0>(args.in[17] + (size_t)l * DMODEL * 2048, args.in[16] + l * DMODEL, DMODEL, 2048, (bf16*)(ws + WS_WQ) + (size_t)l * 2048 * DMODEL, scr, r, lane);
        }
        const int gtid = vcu * NWAVES * 64 + tid, ngt = G * NWAVES * 64;
        p0_convert(args.in[18], (bf16*)(ws + WS_KEYS), (size_t)DEPTH * 8 * 2 * 128 * 128, gtid, ngt);
        {
            f32x4 xv[4][4];
#pragma unroll 1
            for (int m = gw; m < NTOK; m += 4 * ngw) {
#pragma unroll
                for (int q = 0; q < 4; ++q) { const int mm = m + q * ngw < NTOK ? m + q * ngw : m; const GAS f32x4* xr = (const GAS f32x4*)(args.in[0] + (size_t)mm * DMODEL) + lane;
#pragma unroll
                    for (int j = 0; j < 4; ++j) xv[q][j] = __builtin_nontemporal_load(xr + 64 * j); }
#pragma unroll
                for (int q = 0; q < 4; ++q) if (m + q * ngw < NTOK) { const int mm = m + q * ngw; float sq = 0.f;
#pragma unroll
                    for (int j = 0; j < 4; ++j) sq += (xv[q][j].x * xv[q][j].x + xv[q][j].y * xv[q][j].y) + (xv[q][j].z * xv[q][j].z + xv[q][j].w * xv[q][j].w);
                    sq = wave_sum(sq);
                    GAS unsigned long long* o8 = (GAS unsigned long long*)(XBF + (size_t)mm * DMODEL) + lane;
#pragma unroll
                    for (int j = 0; j < 4; ++j) o8[64 * j] = (unsigned long long)pk2(xv[q][j].x, xv[q][j].y) | ((unsigned long long)pk2(xv[q][j].z, xv[q][j].w) << 32);
                    if (lane < 8) ((float*)(ws + WS_SSQX))[(size_t)mm * 8 + lane] = lane == 0 ? sq : 0.f; }
            }
        }
        PHASE_DELAY(0);
    }
    GRID_BAR();

    _Pragma("unroll") for (int l = 0; l < DEPTH; ++l) {
#define GROUP_BAR() do { ++gb_epoch; group_barrier((gu32*)(args.ws + WS_CTL) + CW_GRP + 64 * (blockIdx.x & 7), gb_epoch * (unsigned)((gridDim.x - (blockIdx.x & 7) + 7) >> 3)); } while (0)
        if (PH_ON(1)) { PHASE_CTX(); PHASE_T0();
            pg8::Gemm g{XBF + T0 * DMODEL, (const bf16*)(ws + WS_WIN) + (size_t)l * IN_COLS * DMODEL, SEQ, IN_COLS, DMODEL}; pg8::StaticOrder S; S.init(SEQ, IN_COLS, gn, grk);
            pg8::EpiIn E{QKb, VXb, SB + T0 * 256, (const float*)(ws + WS_SSQX) + T0 * 8, args.in[3] + l * 64, args.in[4] + l * 64};
            pg8::gemm_phase<pg8::EpiIn, pg8::StaticOrder, PG8_ALIGN, PG8_SP2>(L + RING_OFF, g, S, E);
            PHASE_DELAY(1);
        }
        GROUP_BAR();
        if (PH_ON(2)) { PHASE_CTX(); PHASE_T0();
            const float lam_init = 0.8f - 0.6f * __expf(-0.3f * (float)l);
            CmbArgs C{(const bf16*)(ws + WS_O) + T0 * 1024, VXb, SB + T0 * 256, (bf16*)(ws + WS_CAT) + T0 * 1024, args.in[5] + l * 64, args.in[6] + l * 64, args.in[7] + l * 64, args.in[8] + l * 64, args.in[9] + l * 128,
                      args.in[10] + l * 31 * 256, args.in[11] + l * 256, args.in[12] + l * 256, args.in[13] + l * 256, args.in[14] + l * 3 * 256, lam_init};
            cmb_conv_phase(C, lw, nlw, lane);
            const float lam = cmb_lambda(C, lane);
            for (int pr = grk; pr < 32; pr += gn) { const int h = pr >> 3, k = pr & 7;
                for (int i = 0; i < 2; ++i) { const int qb = i == 0 ? 15 - k : k;
                    for (int c = 0; c < 2; ++c) { const int hc = 2 * h + c;
                        const attn_body::bf16* Qb = (const attn_body::bf16*)QKb + hc * 64; const attn_body::bf16* Vb = (const attn_body::bf16*)VXb + h * 128; attn_body::bf16* Ob = (attn_body::bf16*)(ws + WS_O) + T0 * 1024 + (4 * h + 2 * c) * 64;
                        attn_body::attn_unit<8>(0, qb, Qb, Qb + 512, Vb, Ob, (char*)lds + RING_OFF); }
                    cmb_rows(C, lam, h, qb * 256 + wave * 32, lane); } }
            PHASE_DELAY(2);
        }
        GROUP_BAR();
        if (PH_ON(4)) { PHASE_CTX(); PHASE_T0();
            pg8::Gemm g{(const bf16*)(ws + WS_CAT) + T0 * 1024, (const bf16*)(ws + WS_WOUT) + (size_t)l * DMODEL * DMODEL, SEQ, DMODEL, DMODEL}; pg8::StaticOrder S; S.init(SEQ, DMODEL, gn, grk);
            pg8::EpiOut E{XBF + T0 * DMODEL, SSQ + T0 * 16};
            pg8::gemm_phase<pg8::EpiOut, pg8::StaticOrder, PG8_ALIGN, PG8_SP2>(L + RING_OFF, g, S, E);
            PHASE_DELAY(4);
        }
        GROUP_BAR();
        if (PH_ON(5)) { PHASE_CTX(); PHASE_T0();
            for (int m = lw; m < SEQ; m += nlw) xq_row(XBF + (T0 + m) * DMODEL, (signed char*)(ws + WS_XQ) + (T0 + m) * DMODEL, (float*)(ws + WS_XQS) + (T0 + m) * 4, lane);
            pg8::Gemm g{XBF + T0 * DMODEL, (const bf16*)(ws + WS_WQ) + (size_t)l * 2048 * DMODEL, SEQ, 2048, DMODEL}; pg8::StaticOrder S; S.init(SEQ, 2048, gn, grk);
            pg8::EpiBf16<0> E{QKb, 2048, nullptr, 0, 0, 1.f};
            pg8::gemm_phase<pg8::EpiBf16<0>, pg8::StaticOrder, PG8_ALIGN, PG8_SP2>(L + RING_OFF, g, S, E);
            PHASE_DELAY(5);
        }
        GROUP_BAR();
        if (PH_ON(6)) { PHASE_CTX(); PHASE_T0();
            TopkArgs K{QKb, (const bf16*)(ws + WS_KEYS) + (size_t)l * 8 * 2 * 128 * 128, SSQ + T0 * 16, EID + T0 * 128, GATE + T0 * 128, (unsigned short*)(ws + WS_EIDT) + T0 * 128
#ifdef DBG_CHECK
 , (float*)(ws + 71 * MiB), (int*)(ws + 71 * MiB + 512 * 1024)
#endif
 };
            if (gn >= 8) topk_phase(K, L + RING_OFF, L + RING_OFF + 65536 + wave * 2048, grk & 7, grk >> 3, (gn - (grk & 7) + 7) >> 3, wave, tid_, lane);
            else for (int h = grk; h < 8; h += gn) topk_phase(K, L + RING_OFF, L + RING_OFF + 65536 + wave * 2048, h, 0, 1, wave, tid_, lane);
            for (int r = gw; r < NEXP; r += ngw) { const size_t ro = (size_t)l * NEXP + r;
                p0_quant_row4(args.in[19] + ro * DMODEL, args.in[16] + l * DMODEL, ws + WS_UT + (size_t)l * NEXP * DMODEL, r, (float*)(ws + WS_SU) + (size_t)l * NEXP * 4, lane);
                p0_quant_row4(args.in[20] + ro * DMODEL, nullptr, ws + WS_VT + (size_t)l * NEXP * DMODEL, r, (float*)(ws + WS_SV) + (size_t)l * NEXP * 4, lane); }
            PHASE_DELAY(6);
        }
        GRID_BAR();
        if (PH_ON(7)) { PHASE_CTX(); PHASE_T0();
            PeerUArgs U{(const signed char*)(ws + WS_XQ), (const float*)(ws + WS_XQS), ws + WS_UT + (size_t)l * NEXP * DMODEL, (const unsigned short*)(ws + WS_EIDT), (float*)(ws + WS_PART)};
            peer_u_phase(U, bx, wave, G, lane);
            PHASE_DELAY(7);
        }
        GRID_BAR();
        if (PH_ON(7)) { PHASE_CTX(); PHASE_T0();
            PeerRArgs R{(const float*)(ws + WS_PART), SSQ, EID, GATE, (const float*)(ws + WS_SU) + (size_t)l * NEXP * 4, (const float*)(ws + WS_SV) + (size_t)l * NEXP * 4, (signed char*)(ws + WS_WT), (float*)(ws + WS_WSC)};
            peer_r_phase(R, gw, ngw, lane);
            PHASE_DELAY(8);
        }
        GRID_BAR();
        if (PH_ON(7)) { PHASE_CTX(); PHASE_T0();
            PeerVArgs V{l + 1 == DEPTH ? args.out : nullptr, ws + WS_VT + (size_t)l * NEXP * DMODEL, (const unsigned short*)(ws + WS_EIDT), (const signed char*)(ws + WS_WT), (const float*)(ws + WS_WSC), XBF, (float*)(ws + WS_SSQX)};
            peer_v_phase(V, bx, wave, G, lane);
            PHASE_DELAY(9);
        }
        if (l + 1 < DEPTH) GRID_BAR();
#ifdef DBG_CHECK
        if (l == 0) { PHASE_CTX(); dbg_check_peer_out(args.out, (const float*)(ws + 70 * MiB), (gu32*)(ws + WS_CTL) + DBG_FLAGS, gw, ngw, lane); }
#endif
    }
#ifdef DBG_CHECK
    GRID_BAR();
    { PHASE_CTX(); const unsigned fl = __hip_atomic_load((gu32*)(ws + WS_CTL) + DBG_FLAGS, __ATOMIC_RELAXED, __HIP_MEMORY_SCOPE_AGENT);
      if (fl) { const float mul = 1.0f + (float)fl; for (size_t i = (size_t)(gw * 64 + lane); i < (size_t)NTOK * DMODEL; i += (size_t)ngw * 64) args.out[i] *= mul; } }
#endif
}

extern "C" void kernel_launch(void* const* d_in, const int* in_sizes, int n_in, void* d_out, int out_size, void* d_ws, size_t ws_size, hipStream_t stream) {
    static int grid = 0;
    if (grid == 0) {
        if (n_in != 21 || out_size != NTOK * DMODEL || ws_size < WS_END) { fprintf(stderr, "kernel_launch: unexpected shapes (n_in %d, out %d, ws %zu); nothing launched\n", n_in, out_size, ws_size); grid = -1; return; }
        int dev = 0, cus = 0, per_cu = 0;
        if (hipGetDevice(&dev) != hipSuccess || hipDeviceGetAttribute(&cus, hipDeviceAttributeMultiprocessorCount, dev) != hipSuccess) { grid = -1; return; }
        if (hipFuncSetAttribute((const void*)mk_fwd, hipFuncAttributeMaxDynamicSharedMemorySize, LDS_BYTES) != hipSuccess) { fprintf(stderr, "kernel_launch: hipFuncSetAttribute failed\n"); grid = -1; return; }
        if (hipOccupancyMaxActiveBlocksPerMultiprocessor(&per_cu, (const void*)mk_fwd, NWAVES * 64, LDS_BYTES) != hipSuccess || per_cu < 1) fprintf(stderr, "kernel_launch: occupancy query says %d blocks per CU\n", per_cu);
        (void)hipGetLastError();
        grid = cus;
    }
    if (grid < 0) return;
    if (hipMemsetAsync((char*)d_ws + WS_CTL, 0, CTL_ZERO_BYTES, stream) != hipSuccess) { fprintf(stderr, "kernel_launch: memset failed\n"); return; }
    Args a{};
    for (int i = 0; i < 21; ++i) a.in[i] = (const float*)d_in[i];
    a.out = (float*)d_out; a.ws = (unsigned char*)d_ws;
    hipLaunchKernelGGL(mk_fwd, dim3(grid), dim3(NWAVES * 64), LDS_BYTES, stream, a);
}
```

```cpp
#include <hip/hip_runtime.h>
#include <cstdio>
#include <cstdint>
namespace pg8 {
#define PG8_LAS __attribute__((address_space(3)))
typedef unsigned short bf16_t;
typedef short bf16x8 __attribute__((ext_vector_type(8)));
typedef float f32x4 __attribute__((ext_vector_type(4)));
typedef unsigned u32x4 __attribute__((ext_vector_type(4)));
constexpr int BM = 256, BK = 64, HALF = 128, HTB = HALF * BK * 2  , STAGE_BYTES = 8 * HTB, NXCD = 8, WGM = 8;

__host__ __device__ __forceinline__ int lds_byte(int r, int c) { const int st = (r >> 4) * 2 + (c >> 5), rr = r & 15, cc = c & 31, ob = rr * 64 + cc * 2; return st * 1024 + (ob ^ (((ob >> 9) & 1) << 5)); }
__host__ __device__ __forceinline__ void stage_rc(int b, int& R, int& C) { const int st = b / 1024, sb = b % 1024, swz = sb ^ (((sb >> 9) & 1) << 5); R = (st >> 1) * 16 + swz / 64; C = (st & 1) * 32 + (swz % 64) / 2; }
__host__ __device__ __forceinline__ int perm32(int rho) { const int n = rho >> 4, i = rho & 15; return 8 * (i >> 2) + 4 * n + (i & 3); }

struct Unit { int pm, pn; };
struct Gemm { const bf16_t* A; const bf16_t* Bt; int M, N, K; };

struct StaticOrder {
    int nM, nN, nwg, G, c;
    __host__ __device__ void init(int M, int N, int G_, int c_) { nM = M / BM; nN = N / BM; nwg = nM * nN; G = G_; c = c_; }
    __host__ __device__ bool next(int i, Unit& u) const {
        const long L = (long)i * G + c; if (L >= nwg) return false;
        int wgid = (int)L; { const int q = nwg / NXCD, r = nwg % NXCD, xcd = wgid % NXCD, off = wgid / NXCD; wgid = (xcd < r ? xcd * (q + 1) : r * (q + 1) + (xcd - r) * q) + off; }
        const int nig = WGM * nN, gid = wgid / nig, fm = gid * WGM, gsz = (nM - fm) < WGM ? (nM - fm) : WGM;
        u.pm = fm + ((wgid % nig) % gsz); u.pn = (wgid % nig) / gsz; return true;
    }
    __device__ __forceinline__ void a_ready(const Unit&) const {}
    __device__ __forceinline__ void done(const Unit&) const {}
};

__device__ __forceinline__ unsigned cvt_pk_bf16(float lo, float hi) { unsigned r; asm volatile("v_cvt_pk_bf16_f32 %0, %1, %2" : "=v"(r) : "v"(lo), "v"(hi)); return r; }
typedef float f32x2 __attribute__((ext_vector_type(2)));
__device__ __forceinline__ f32x2 gelu_pk(f32x2 v) {
    const f32x2 av = __builtin_elementwise_abs(v), d = av * 0.2316418882f + 1.0f;
    f32x2 t; t.x = __builtin_amdgcn_rcpf(d.x); t.y = __builtin_amdgcn_rcpf(d.y);
    f32x2 q = t * 0.5307027145f + (-0.7265760135f); q = q * t + 0.7107068705f; q = q * t + (-0.142248368f); q = q * t + 0.127414796f; q = q * t;
    const f32x2 s = (v * v) * (-0.72134752044f);
    f32x2 e; e.x = __builtin_amdgcn_exp2f(s.x); e.y = __builtin_amdgcn_exp2f(s.y);
    const f32x2 m = v * (q * e), r = v - m;
    f32x2 o; o.x = v.x < 0.f ? m.x : r.x; o.y = v.y < 0.f ? m.y : r.y; return o;
}

template <int ACT  > struct EpiBf16 {
    static constexpr bool PERM = true, AFTER_DRAIN = false; static_assert(ACT == 0 || ACT == 1, "EpiBf16: ACT is 0 (none) or 1 (gelu_pk)");
    bf16_t* O; int ldc; const float* bias; int split_cols; size_t split_stride; float scale0;
    __device__ __forceinline__ void operator()(const f32x4 (&acc)[2][2][4][2], const Unit& u, int wr, int wc, int fr, int fq) const {
        const int row0 = u.pm * BM + wr * 64 + fr; int colt = u.pn * BM; bf16_t* base = O;
        float sc = 1.f; if (split_cols) { const int t = colt / split_cols; base += (size_t)t * split_stride; colt -= t * split_cols; if (t == 0) sc = scale0; }
        const int col0 = colt + wc * 32 + 8 * fq, bcol0 = u.pn * BM + wc * 32 + 8 * fq;
        f32x4 bv[2][2];
#pragma unroll
        for (int bj = 0; bj < 2; ++bj)
#pragma unroll
            for (int n = 0; n < 2; ++n) bv[bj][n] = bias ? *(const f32x4*)(bias + bcol0 + bj * HALF + 4 * n) : (f32x4){0.f, 0.f, 0.f, 0.f};
#pragma unroll
        for (int ai = 0; ai < 2; ++ai)
#pragma unroll
            for (int m = 0; m < 4; ++m) { bf16_t* rowp = base + (size_t)(row0 + ai * HALF + m * 16) * ldc + col0;
#pragma unroll
                for (int bj = 0; bj < 2; ++bj) { f32x4 v0 = acc[ai][bj][m][0] + bv[bj][0], v1 = acc[ai][bj][m][1] + bv[bj][1];
                    if (ACT == 1) { f32x2 a = gelu_pk((f32x2){v0[0], v0[1]}), b = gelu_pk((f32x2){v0[2], v0[3]}), c = gelu_pk((f32x2){v1[0], v1[1]}), d = gelu_pk((f32x2){v1[2], v1[3]});
                        v0 = (f32x4){a.x, a.y, b.x, b.y}; v1 = (f32x4){c.x, c.y, d.x, d.y}; }
                    v0 = v0 * sc; v1 = v1 * sc; u32x4 w; w.x = cvt_pk_bf16(v0[0], v0[1]); w.y = cvt_pk_bf16(v0[2], v0[3]); w.z = cvt_pk_bf16(v1[0], v1[1]); w.w = cvt_pk_bf16(v1[2], v1[3]);
                    *(u32x4*)(rowp + bj * HALF) = w; } }
    }
};
constexpr float QK_C2 = 0.125f * 1.4426950408889634f;
__device__ __forceinline__ u32x4 pack8(const f32x4& v0, const f32x4& v1) { u32x4 w; w.x = cvt_pk_bf16(v0[0], v0[1]); w.y = cvt_pk_bf16(v0[2], v0[3]); w.z = cvt_pk_bf16(v1[0], v1[1]); w.w = cvt_pk_bf16(v1[2], v1[3]); return w; }
struct EpiIn {
    static constexpr bool PERM = true, AFTER_DRAIN = false;
    bf16_t* QK; bf16_t* VX; bf16_t* SB; const float* ssqx; const float* qg; const float* kg;
    __device__ __forceinline__ float rinv_of(int row) const { const f32x4 a = *(const f32x4*)(ssqx + (size_t)row * 8), b = *(const f32x4*)(ssqx + (size_t)row * 8 + 4);
        return 1.0f / sqrtf((((a[0] + a[1]) + (a[2] + a[3])) + ((b[0] + b[1]) + (b[2] + b[3]))) * (1.0f / 1024.0f) + 1e-6f); }
    __device__ __forceinline__ void operator()(const f32x4 (&acc)[2][2][4][2], const Unit& u, int wr, int wc, int fr, int fq) const {
        const int pn = u.pn; const int row0 = u.pm * BM + wr * 64 + fr;
        if (pn < 4) {
            const float* g = pn < 2 ? qg : kg; const float sc = pn < 2 ? QK_C2 : 1.f;
            f32x4 gv[2][2];
#pragma unroll
            for (int bj = 0; bj < 2; ++bj)
#pragma unroll
                for (int n = 0; n < 2; ++n) gv[bj][n] = *(const f32x4*)(g + 32 * bj + 8 * fq + 4 * n) * sc;
            bf16_t* base = QK + 256 * pn + 64 * wc + 8 * fq;
#pragma unroll
            for (int ai = 0; ai < 2; ++ai)
#pragma unroll
                for (int m = 0; m < 4; ++m) { const int row = row0 + ai * HALF + m * 16; const float ri = rinv_of(row); float ss = 0.f;
#pragma unroll
                    for (int bj = 0; bj < 2; ++bj)
#pragma unroll
                        for (int n = 0; n < 2; ++n) { const f32x4 x = acc[ai][bj][m][n]; ss += (x[0] * x[0] + x[1] * x[1]) + (x[2] * x[2] + x[3] * x[3]); }
                    ss += __shfl_xor(ss, 16); ss += __shfl_xor(ss, 32);
                    const float rg = ri / sqrtf(ss * ri * ri * (1.0f / 64.0f) + 1e-6f);
#pragma unroll
                    for (int bj = 0; bj < 2; ++bj) { const f32x4 v0 = acc[ai][bj][m][0] * rg * gv[bj][0], v1 = acc[ai][bj][m][1] * rg * gv[bj][1];
                        *(u32x4*)(base + (size_t)row * 1024 + 32 * bj) = pack8(v0, v1); } }
        } else if (pn < 6) {
            bf16_t* base = VX + 256 * (pn - 4) + 32 * wc + 8 * fq;
#pragma unroll
            for (int ai = 0; ai < 2; ++ai)
#pragma unroll
                for (int m = 0; m < 4; ++m) { const int row = row0 + ai * HALF + m * 16; const float ri = rinv_of(row);
#pragma unroll
                    for (int bj = 0; bj < 2; ++bj) *(u32x4*)(base + (size_t)row * 1024 + HALF * bj) = pack8(acc[ai][bj][m][0] * ri, acc[ai][bj][m][1] * ri); }
        } else if (pn < 8) {
            bf16_t* base = VX + 512 + 128 * (pn - 6) + 32 * wc + 8 * fq;
#pragma unroll
            for (int ai = 0; ai < 2; ++ai)
#pragma unroll
                for (int m = 0; m < 4; ++m) { const int row = row0 + ai * HALF + m * 16; const float ri = rinv_of(row); f32x4 o[2];
#pragma unroll
                    for (int n = 0; n < 2; ++n) { const f32x4 a = acc[ai][0][m][n] * ri, gt = acc[ai][1][m][n] * ri;
#pragma unroll
                        for (int e = 0; e < 4; ++e) o[n][e] = a[e] / (1.0f + __expf(-gt[e])); }
                    *(u32x4*)(base + (size_t)row * 1024) = pack8(o[0], o[1]); }
        } else if (pn < 10) {
            bf16_t* base = VX + 768 + 128 * (pn - 8) + 32 * wc + 8 * fq;
#pragma unroll
            for (int ai = 0; ai < 2; ++ai)
#pragma unroll
                for (int m = 0; m < 4; ++m) { const int row = row0 + ai * HALF + m * 16; const float ri = rinv_of(row); const float r2 = ri * ri;
                    *(u32x4*)(base + (size_t)row * 1024) = pack8(acc[ai][0][m][0] * acc[ai][1][m][0] * r2, acc[ai][0][m][1] * acc[ai][1][m][1] * r2); }
        } else {
            bf16_t* base = SB + 32 * wc + 8 * fq;
#pragma unroll
            for (int ai = 0; ai < 2; ++ai)
#pragma unroll
                for (int m = 0; m < 4; ++m) { const int row = row0 + ai * HALF + m * 16; const float ri = rinv_of(row);
#pragma unroll
                    for (int bj = 0; bj < 2; ++bj) *(u32x4*)(base + (size_t)row * 256 + HALF * bj) = pack8(acc[ai][bj][m][0] * ri, acc[ai][bj][m][1] * ri); }
        }
    }
};
struct EpiOut {
    static constexpr bool PERM = true, AFTER_DRAIN = false;
    bf16_t* xb; float* ssq;
    __device__ __forceinline__ void operator()(const f32x4 (&acc)[2][2][4][2], const Unit& u, int wr, int wc, int fr, int fq) const {
        const int row0 = u.pm * BM + wr * 64 + fr; const int col0 = u.pn * BM + wc * 32 + 8 * fq;
#pragma unroll
        for (int ai = 0; ai < 2; ++ai)
#pragma unroll
            for (int m = 0; m < 4; ++m) { const int row = row0 + ai * HALF + m * 16; float ss = 0.f;
#pragma unroll
                for (int bj = 0; bj < 2; ++bj) { const size_t off = (size_t)row * 1024 + col0 + bj * HALF;
                    const u32x4 r = *(const u32x4*)(xb + off);
                    const f32x4 r0 = {__builtin_bit_cast(float, r.x << 16), __builtin_bit_cast(float, r.x & 0xffff0000u), __builtin_bit_cast(float, r.y << 16), __builtin_bit_cast(float, r.y & 0xffff0000u)};
                    const f32x4 r1 = {__builtin_bit_cast(float, r.z << 16), __builtin_bit_cast(float, r.z & 0xffff0000u), __builtin_bit_cast(float, r.w << 16), __builtin_bit_cast(float, r.w & 0xffff0000u)};
                    const u32x4 w = pack8(acc[ai][bj][m][0] + r0, acc[ai][bj][m][1] + r1);
                    *(u32x4*)(xb + off) = w;
                    const float a0 = __builtin_bit_cast(float, w.x << 16), a1 = __builtin_bit_cast(float, w.x & 0xffff0000u), a2 = __builtin_bit_cast(float, w.y << 16), a3 = __builtin_bit_cast(float, w.y & 0xffff0000u);
                    const float a4 = __builtin_bit_cast(float, w.z << 16), a5 = __builtin_bit_cast(float, w.z & 0xffff0000u), a6 = __builtin_bit_cast(float, w.w << 16), a7 = __builtin_bit_cast(float, w.w & 0xffff0000u);
                    ss += ((a0 * a0 + a1 * a1) + (a2 * a2 + a3 * a3)) + ((a4 * a4 + a5 * a5) + (a6 * a6 + a7 * a7)); }
                ss += __shfl_xor(ss, 16); ss += __shfl_xor(ss, 32);
                if (fq == 0) ssq[(size_t)row * 16 + u.pn * 4 + wc] = ss; }
    }
};

template <class Epi, class Sched, bool ALIGN_EPI = false, bool SP2 = false>
__device__ __forceinline__ void gemm_phase(PG8_LAS unsigned char* lds, const Gemm g, const Sched& S, const Epi& E) {
    int tid_l = threadIdx.x; asm volatile("" : "+v"(tid_l));
    const int tid = tid_l, wid = __builtin_amdgcn_readfirstlane(tid >> 6), lane = tid & 63, wr = wid >> 2, wc = wid & 3, fr = lane & 15, fq = lane >> 4;
    const int K = g.K, nt = K / BK;
    unsigned voffA[2], voffB[2];
#pragma unroll
    for (int i = 0; i < 2; ++i) { int R, C; stage_rc(tid * 16 + i * 8192, R, C); const int Rb = Epi::PERM ? ((R & ~31) + perm32(R & 31)) : R;
        voffA[i] = (unsigned)(R * K + C) * 2u; voffB[i] = (unsigned)(Rb * K + C) * 2u; }
    const size_t kstep = (size_t)(BK * 2);
    const size_t hstep = (size_t)HALF * K * 2;
    const size_t tstep = 2 * hstep;
    const unsigned ldsw = (unsigned)wid * 1024u;
    const int aoff = lds_byte(wr * 64 + fr, fq * 8), boff = lds_byte(wc * 32 + fr, fq * 8);
#define PG8_SA(b, h) (((b) * 2 + (h)) * HTB)
#define PG8_SB(b, h) ((4 + (b) * 2 + (h)) * HTB)
#define PG8_STAGE(bufoff, gbase, voff) do { _Pragma("unroll") for (int _i = 0; _i < 2; ++_i) \
        __builtin_amdgcn_global_load_lds((const unsigned*)((const char*)(gbase) + (voff)[_i]), (PG8_LAS unsigned*)(lds + (bufoff) + ldsw + _i * 8192), 16, 0, 0); } while (0)
#define PG8_LDA(dst, b, h) do { _Pragma("unroll") for (int m = 0; m < 4; ++m) _Pragma("unroll") for (int k = 0; k < 2; ++k) dst[m][k] = *(const PG8_LAS bf16x8*)(lds + PG8_SA(b, h) + aoff + m * 2048 + k * 1024); } while (0)
#define PG8_LDB(dst, b, h) do { _Pragma("unroll") for (int n = 0; n < 2; ++n) _Pragma("unroll") for (int k = 0; k < 2; ++k) dst[n][k] = *(const PG8_LAS bf16x8*)(lds + PG8_SB(b, h) + boff + n * 2048 + k * 1024); } while (0)
#define PG8_MMA(ai, bj, At, Bt) do { __builtin_amdgcn_s_setprio(1); _Pragma("unroll") for (int m = 0; m < 4; ++m) _Pragma("unroll") for (int n = 0; n < 2; ++n) _Pragma("unroll") for (int k = 0; k < 2; ++k) \
        acc[ai][bj][m][n] = __builtin_amdgcn_mfma_f32_16x16x32_bf16(Bt[n][k], At[m][k], acc[ai][bj][m][n], 0, 0, 0); __builtin_amdgcn_s_setprio(0); } while (0)
#define PG8_WAIT_V(n) asm volatile("s_waitcnt vmcnt(" #n ")" ::: "memory")
#define PG8_WAIT_L(n) asm volatile("s_waitcnt lgkmcnt(" #n ")" ::: "memory")
#define PG8_BAR __builtin_amdgcn_s_barrier()
#define PG8_SCHED __builtin_amdgcn_sched_barrier(0)
    Unit cur, nxt; int ui = 0;
    if (!S.next(0, cur)) return;
    f32x4 acc[2][2][4][2];
#pragma unroll
    for (int a = 0; a < 2; ++a)
#pragma unroll
        for (int b = 0; b < 2; ++b)
#pragma unroll
            for (int m = 0; m < 4; ++m)
#pragma unroll
                for (int n = 0; n < 2; ++n) acc[a][b][m][n] = (f32x4){0.f, 0.f, 0.f, 0.f};
    bf16x8 At[4][2], B0[2][2], B1[2][2];
    const char* cA = (const char*)g.A + (size_t)cur.pm * tstep; const char* cB = (const char*)g.Bt + (size_t)cur.pn * tstep;
    S.a_ready(cur);
    if constexpr (SP2) {
        PG8_STAGE(PG8_SB(0, 0), cB, voffB); PG8_STAGE(PG8_SB(0, 1), cB + hstep, voffB); PG8_STAGE(PG8_SA(0, 0), cA, voffA); PG8_STAGE(PG8_SA(0, 1), cA + hstep, voffA);
        if (wr == 1) PG8_BAR;
        PG8_WAIT_V(2); PG8_BAR;
        PG8_STAGE(PG8_SB(1, 0), cB + kstep, voffB); PG8_STAGE(PG8_SA(1, 0), cA + kstep, voffA); PG8_STAGE(PG8_SB(1, 1), cB + hstep + kstep, voffB);
        PG8_WAIT_V(6); PG8_BAR;
    } else {
        PG8_STAGE(PG8_SB(0, 0), cB, voffB); PG8_STAGE(PG8_SA(0, 0), cA, voffA); PG8_STAGE(PG8_SB(0, 1), cB + hstep, voffB); PG8_STAGE(PG8_SA(0, 1), cA + hstep, voffA);
        if (wr == 1) PG8_BAR;
        PG8_WAIT_V(4); PG8_BAR;
        PG8_STAGE(PG8_SB(1, 0), cB + kstep, voffB); PG8_STAGE(PG8_SA(1, 0), cA + kstep, voffA); PG8_STAGE(PG8_SB(1, 1), cB + hstep + kstep, voffB);
        PG8_WAIT_V(6); PG8_BAR;
    }
    for (;;) {
        const bool has_next = S.next(ui + 1, nxt);
        const char* nA = has_next ? (const char*)g.A + (size_t)nxt.pm * tstep : cA; const char* nB = has_next ? (const char*)g.Bt + (size_t)nxt.pn * tstep : cB;
        for (int t = 0; t < nt; t += 2) {
            const bool last = (t == nt - 2);
            const char* a1 = cA + (size_t)(t + 1) * kstep;
            const char* a2 = last ? nA : cA + (size_t)(t + 2) * kstep; const char* b2 = last ? nB : cB + (size_t)(t + 2) * kstep;
            const char* a3 = a2 + kstep; const char* b3 = b2 + kstep;
            if (last && has_next) S.a_ready(nxt);
            if constexpr (SP2) {
            PG8_LDB(B0, 0, 0); PG8_LDB(B1, 0, 1); PG8_SCHED; PG8_LDA(At, 0, 0); PG8_STAGE(PG8_SA(1, 1), a1 + hstep, voffA);
            PG8_WAIT_V(8); PG8_WAIT_L(0); PG8_BAR; PG8_MMA(0, 0, At, B0); PG8_MMA(0, 1, At, B1); PG8_BAR; PG8_SCHED;
            PG8_LDA(At, 0, 1); PG8_STAGE(PG8_SB(0, 0), b2, voffB); PG8_STAGE(PG8_SB(0, 1), b2 + hstep, voffB); PG8_STAGE(PG8_SA(0, 0), a2, voffA);
            PG8_WAIT_V(8); PG8_WAIT_L(0); PG8_BAR; PG8_MMA(1, 0, At, B0); PG8_MMA(1, 1, At, B1); PG8_BAR; PG8_SCHED;
            PG8_LDB(B0, 1, 0); PG8_LDB(B1, 1, 1); PG8_SCHED; PG8_LDA(At, 1, 0); PG8_STAGE(PG8_SA(0, 1), a2 + hstep, voffA);
            PG8_WAIT_V(8); PG8_WAIT_L(0); PG8_BAR; PG8_MMA(0, 0, At, B0); PG8_MMA(0, 1, At, B1); PG8_BAR; PG8_SCHED;
            PG8_LDA(At, 1, 1); PG8_STAGE(PG8_SB(1, 0), b3, voffB); PG8_STAGE(PG8_SB(1, 1), b3 + hstep, voffB); PG8_STAGE(PG8_SA(1, 0), a3, voffA);
            PG8_WAIT_V(8); PG8_WAIT_L(0); PG8_BAR; PG8_MMA(1, 0, At, B0); PG8_MMA(1, 1, At, B1); PG8_BAR; PG8_SCHED;
            } else {
            PG8_LDB(B0, 0, 0); PG8_SCHED; PG8_LDA(At, 0, 0); PG8_STAGE(PG8_SA(1, 1), a1 + hstep, voffA);
            PG8_WAIT_L(8); PG8_BAR; PG8_WAIT_L(0); PG8_MMA(0, 0, At, B0); PG8_BAR; PG8_SCHED;
            PG8_LDB(B1, 0, 1); PG8_STAGE(PG8_SB(0, 0), b2, voffB);
            PG8_BAR; PG8_WAIT_L(0); PG8_MMA(0, 1, At, B1); PG8_BAR;
            PG8_LDA(At, 0, 1); PG8_STAGE(PG8_SA(0, 0), a2, voffA);
            PG8_BAR; PG8_WAIT_L(0); PG8_MMA(1, 0, At, B0); PG8_BAR; PG8_SCHED;
            PG8_STAGE(PG8_SB(0, 1), b2 + hstep, voffB);
            PG8_WAIT_V(6); PG8_BAR; PG8_MMA(1, 1, At, B1); PG8_BAR;
            PG8_LDB(B0, 1, 0); PG8_SCHED; PG8_LDA(At, 1, 0); PG8_STAGE(PG8_SA(0, 1), a2 + hstep, voffA);
            PG8_WAIT_L(8); PG8_BAR; PG8_WAIT_L(0); PG8_MMA(0, 0, At, B0); PG8_BAR; PG8_SCHED;
            PG8_LDB(B1, 1, 1); PG8_STAGE(PG8_SB(1, 0), b3, voffB);
            PG8_BAR; PG8_WAIT_L(0); PG8_MMA(0, 1, At, B1); PG8_BAR;
            PG8_LDA(At, 1, 1); PG8_STAGE(PG8_SA(1, 0), a3, voffA);
            PG8_BAR; PG8_WAIT_L(0); PG8_MMA(1, 0, At, B0); PG8_BAR; PG8_SCHED;
            PG8_STAGE(PG8_SB(1, 1), b3 + hstep, voffB);
            PG8_WAIT_V(6); PG8_BAR; PG8_MMA(1, 1, At, B1); PG8_BAR;
            }
        }
        if constexpr (ALIGN_EPI) { if (wr == 0) PG8_BAR; }
        if constexpr (!Epi::AFTER_DRAIN) { E(acc, cur, wr, wc, fr, fq); S.done(cur); }
        if (!has_next) break;
#pragma unroll
        for (int a = 0; a < 2; ++a)
#pragma unroll
            for (int b = 0; b < 2; ++b)
#pragma unroll
                for (int m = 0; m < 4; ++m)
#pragma unroll
                    for (int n = 0; n < 2; ++n) acc[a][b][m][n] = (f32x4){0.f, 0.f, 0.f, 0.f};
        cur = nxt; cA = nA; cB = nB; ++ui;
        if constexpr (ALIGN_EPI) { if (wr == 1) PG8_BAR; }
    }
    PG8_WAIT_V(0);
    if constexpr (!ALIGN_EPI) { if (wr == 0) PG8_BAR; }
    PG8_BAR;
    if constexpr (Epi::AFTER_DRAIN) { E.fused(acc, cur, wr, wc, fr, fq, lds, wid, lane); S.done(cur); }
#undef PG8_SA
#undef PG8_SB
#undef PG8_STAGE
#undef PG8_LDA
#undef PG8_LDB
#undef PG8_MMA
#undef PG8_WAIT_V
#undef PG8_WAIT_L
#undef PG8_BAR
#undef PG8_SCHED
}
}
#define PG8_SP2 true
#define PG8_ALIGN true
#include <hip/hip_bf16.h>
#include <cmath>
namespace attn_body {
using bf16=__hip_bfloat16;
using bf16x8=__attribute__((ext_vector_type(8)))short;
using s16x4=__attribute__((ext_vector_type(4)))short;
using f32x16=__attribute__((ext_vector_type(16)))float;
using u32x4=__attribute__((ext_vector_type(4)))unsigned;
constexpr int BATCH=8,NHEAD=16,SEQ=4096,D=64,DM=NHEAD*D;
constexpr int NW=8,QBLK=32,QB=QBLK*NW,KVBLK=64,NQB=SEQ/QB;
constexpr int ATTN_PITCH=DM, ATTN_UNIT_ROWS=QB;
__device__ __forceinline__ int crow(int r,int hi){return (r&3)+8*(r>>2)+4*hi;}
#define SBAR() __builtin_amdgcn_sched_barrier(0)
__device__ __forceinline__ void cmask(f32x16&p0,f32x16&p1,int jb,int qrel,int hi){
  const float NEG=-INFINITY; int kb=64*jb+4*hi;
  #pragma unroll
  for(int r=0;r<16;++r){int kv=kb+(r&3)+8*(r>>2); if(kv>qrel)p0[r]=NEG; if(kv+32>qrel)p1[r]=NEG;}
}

constexpr int NSLOT=3, SLOTB=8192, VSLOTB=16384;
constexpr int LDS_K=0, LDS_V=NSLOT*SLOTB, LDS_WS=LDS_V+NSLOT*VSLOTB, LDS_OST=LDS_WS+NW*64*4, LDS_BYTES=LDS_OST+NW*4096;
constexpr float C2=0.125f*1.4426950408889634f;
__device__ __forceinline__ void glds16(const void*gsrc,unsigned lds_dst){unsigned keep;
  asm volatile("s_mov_b32 %0, m0\n\ts_mov_b32 m0, %2\n\ts_nop 0\n\tglobal_load_lds_dwordx4 %1, off\n\ts_mov_b32 m0, %0":"=&s"(keep):"v"(gsrc),"s"(lds_dst):"memory");}
__device__ __forceinline__ float max3f(float a,float b,float c){float r;asm("v_max3_f32 %0, %1, %2, %3":"=v"(r):"v"(a),"v"(b),"v"(c));return r;}
__device__ __forceinline__ float max2f(float a,float b){float r;asm("v_max_f32_e32 %0, %1, %2":"=v"(r):"v"(a),"v"(b));return r;}
__device__ __forceinline__ float fadd_s(float a,float b){float r;asm("v_add_f32_e32 %0, %1, %2":"=v"(r):"v"(a),"v"(b));return r;}
__device__ __forceinline__ float fsub_s(float a,float b){float r;asm("v_sub_f32_e32 %0, %1, %2":"=v"(r):"v"(a),"v"(b));return r;}
typedef float f32x2_t __attribute__((ext_vector_type(2))); typedef __bf16 bf16x2_t __attribute__((ext_vector_type(2)));
__device__ __forceinline__ unsigned cvtpk_s(float lo,float hi){f32x2_t v={lo,hi};bf16x2_t b=__builtin_convertvector(v,bf16x2_t);return __builtin_bit_cast(unsigned,b);}
#define WAIT_BAR(N) asm volatile("s_waitcnt vmcnt(" #N ") lgkmcnt(0)\n\ts_barrier":::"memory")

__device__ __forceinline__ void qkt(f32x16&p0,f32x16&p1,const char*Kslot,const bf16x8*qr,const f32x16&negm,int r32,int hi){
  const char*kb=Kslot+hi*1024+r32*16;
  #pragma unroll
  for(int d0=0;d0<4;++d0){
    const bf16x8 b0=*reinterpret_cast<const bf16x8*>(kb+d0*2048);
    const bf16x8 b1=*reinterpret_cast<const bf16x8*>(kb+d0*2048+512);
    if(d0==0){p0=__builtin_amdgcn_mfma_f32_32x32x16_bf16(b0,qr[0],negm,0,0,0);p1=__builtin_amdgcn_mfma_f32_32x32x16_bf16(b1,qr[0],negm,0,0,0);}
    else{p0=__builtin_amdgcn_mfma_f32_32x32x16_bf16(b0,qr[d0],p0,0,0,0);p1=__builtin_amdgcn_mfma_f32_32x32x16_bf16(b1,qr[d0],p1,0,0,0);}}
}
typedef __attribute__((address_space(3))) const char* lds_cptr;
typedef short v4i16_t __attribute__((ext_vector_type(4)));
__device__ __forceinline__ void kload8(bf16x8*kf,lds_cptr kp){
  kf[0]=*(const __attribute__((address_space(3))) bf16x8*)(kp);      kf[1]=*(const __attribute__((address_space(3))) bf16x8*)(kp+512);
  kf[2]=*(const __attribute__((address_space(3))) bf16x8*)(kp+2048); kf[3]=*(const __attribute__((address_space(3))) bf16x8*)(kp+2560);
  kf[4]=*(const __attribute__((address_space(3))) bf16x8*)(kp+4096); kf[5]=*(const __attribute__((address_space(3))) bf16x8*)(kp+4608);
  kf[6]=*(const __attribute__((address_space(3))) bf16x8*)(kp+6144); kf[7]=*(const __attribute__((address_space(3))) bf16x8*)(kp+6656);
}
__device__ __forceinline__ void kload2(bf16x8*kf,lds_cptr kp,int j){ kf[2*j]=*(const __attribute__((address_space(3))) bf16x8*)(kp+j*2048); kf[2*j+1]=*(const __attribute__((address_space(3))) bf16x8*)(kp+j*2048+512); }
__device__ __forceinline__ s16x4 vtr(lds_cptr p){ return __builtin_bit_cast(s16x4,__builtin_amdgcn_ds_read_tr16_b64_v4i16((__attribute__((address_space(3))) v4i16_t*)p)); }
__device__ __forceinline__ float rowmax(const f32x16&p0,const f32x16&p1){
  float a=max3f(p0[0],p0[1],p1[0]),b=max3f(p0[2],p0[3],p1[1]);a=max3f(a,p1[2],p1[3]);
  #pragma unroll
  for(int r=4;r<16;r+=4){a=max3f(a,p0[r],p0[r+1]);b=max3f(b,p0[r+2],p0[r+3]);a=max3f(a,p1[r],p1[r+1]);b=max3f(b,p1[r+2],p1[r+3]);}
  const float m=max2f(a,b);
  auto rr=__builtin_amdgcn_permlane32_swap(__float_as_uint(m),__float_as_uint(m),false,false);
  return max2f(__uint_as_float(rr[0]),__uint_as_float(rr[1]));
}
__device__ __forceinline__ void pv(f32x16*o,int vb,bf16x8 pa0,bf16x8 pa1,bf16x8 pa2,bf16x8 pa3){
  #pragma unroll
  for(int d0=0;d0<4;++d0){s16x4 lo[4],hi[4];
    #pragma unroll
    for(int ks=0;ks<4;++ks){
      asm volatile("ds_read_b64_tr_b16 %0,%1 offset:%c2":"=&v"(lo[ks]):"v"(vb),"i"((d0>>1)*8192+(d0&1)*4096+ks*1024):"memory");
      asm volatile("ds_read_b64_tr_b16 %0,%1 offset:%c2":"=&v"(hi[ks]):"v"(vb),"i"((d0>>1)*8192+(d0&1)*4096+ks*1024+512):"memory");}
    asm volatile("s_waitcnt lgkmcnt(0)":::"memory");SBAR();
    #define PK(k) (bf16x8){lo[k][0],lo[k][1],lo[k][2],lo[k][3],hi[k][0],hi[k][1],hi[k][2],hi[k][3]}
    o[d0]=__builtin_amdgcn_mfma_f32_32x32x16_bf16(pa0,PK(0),o[d0],0,0,0);
    o[d0]=__builtin_amdgcn_mfma_f32_32x32x16_bf16(pa1,PK(1),o[d0],0,0,0);
    o[d0]=__builtin_amdgcn_mfma_f32_32x32x16_bf16(pa2,PK(2),o[d0],0,0,0);
    o[d0]=__builtin_amdgcn_mfma_f32_32x32x16_bf16(pa3,PK(3),o[d0],0,0,0);
    #undef PK
  }
}

#ifndef ATTN_STORE16
#define ATTN_STORE16(p,v) (*(u32x4*)(p)=(v))
#endif
template<int THRL> __device__ __forceinline__ void attn_unit(int b,int qb,const bf16*Q,const bf16*__restrict__ K,const bf16*__restrict__ V,bf16*O,char*shm){
  int tid_l=threadIdx.x; asm volatile("":"+v"(tid_l)); const int tid=tid_l,lane=tid&63,r32=lane&31,hi=lane>>5; const int wid=__builtin_amdgcn_readfirstlane(tid>>6);
  const long rowbase=(long)b*SEQ; const int q0=qb*QB; const lds_cptr shm3q=(lds_cptr)shm;
  const bf16*Qw=Q+(rowbase+q0+wid*QBLK)*DM;
  const bf16*Kh=K+rowbase*DM,*Vh=V+rowbase*DM;
  const unsigned lds0=(unsigned)(uintptr_t)shm;
  float*wsf=(float*)(shm+LDS_WS)+wid*64;
  const bf16*ksrc=Kh+(long)lane*DM+wid*8;
  const bf16*vsrc=Vh+(long)(16*(wid&3)+(lane>>2))*DM+(wid>>2)*32+(lane&3)*8;
  const unsigned kdst=lds0+LDS_K+wid*1024, vdst=lds0+LDS_V+wid*1024;
  #define DMA_K(t,slot) glds16(ksrc+(long)(t)*KVBLK*DM,(unsigned)__builtin_amdgcn_readfirstlane(kdst+(slot)))
  #define DMA_V(t,slot) do{ glds16(vsrc+(long)(t)*KVBLK*DM,(unsigned)__builtin_amdgcn_readfirstlane(vdst+2*(slot))); glds16(vsrc+64+(long)(t)*KVBLK*DM,(unsigned)__builtin_amdgcn_readfirstlane(vdst+2*(slot)+8192)); }while(0)
  const int vb0=(int)(lds0+LDS_V)+((lane>>4)&1)*32+(lane&3)*8+(4*hi+((lane&15)>>2))*64;
  const char*Kbase=shm+LDS_K; bf16x8 kf[8];
  const lds_cptr shm3=(lds_cptr)shm; const lds_cptr kp0=shm3+LDS_K+hi*1024+r32*16; const lds_cptr vp0=shm3+LDS_V+((lane>>4)&1)*32+(lane&3)*8+(4*hi+((lane&15)>>2))*64;
  const int NT=(q0+QB)/KVBLK;
  DMA_K(0,0);DMA_V(0,0);DMA_K(1,SLOTB);
  bf16x8 qr[4];
  #pragma unroll
  for(int d0=0;d0<4;++d0)qr[d0]=*reinterpret_cast<const bf16x8*>(&Qw[(long)r32*DM+d0*16+hi*8]);
  const lds_cptr qst3=shm3q+LDS_OST+wid*4096+lane*16;
  #define LDQ(d0) (*(const __attribute__((address_space(3))) bf16x8*)(qst3+(d0)*1024))
  float mhat=0.f,l_reg=0.f;f32x16 o[4];o[0]=f32x16{};o[1]=f32x16{};o[2]=f32x16{};o[3]=f32x16{};f32x16 negm=f32x16{};asm volatile("":"+v"(negm));
  const int qrel=wid*QBLK+r32;
  #define CMASK(P0,P1,t) do{int jb_=(t)-(NT-4); if(jb_>=0)cmask(P0,P1,jb_,qrel,hi);}while(0)
  bool resc=false;
  #define START(P0,P1) do{ const float rm=rowmax(P0,P1); resc=false; \
    { const float dl=rm; mhat=fadd_s(mhat,dl); \
      _Pragma("unroll") for(int r=0;r<16;++r){P0[r]=fsub_s(P0[r],dl);P1[r]=fsub_s(P1[r],dl);} \
      _Pragma("unroll") for(int r=0;r<16;++r)negm[r]=-mhat; asm volatile("":"+v"(negm)); } \
    _Pragma("unroll") for(int r=0;r<16;++r)P0[r]=__builtin_amdgcn_exp2f(P0[r]); }while(0)
  #define RESC() do{ if(resc){ asm volatile("s_waitcnt lgkmcnt(0)":::"memory"); \
      _Pragma("unroll") for(int d_=0;d_<4;++d_) _Pragma("unroll") for(int r=0;r<16;++r)o[d_][r]*=wsf[crow(r,hi)]; } }while(0)
  f32x16 pA0,pA1,pB0,pB1;
  int sl_prev=0,sl_cur=0,sl_next=SLOTB;
  #define ROT() do{sl_prev=sl_cur;sl_cur=sl_next;sl_next=(sl_next==(NSLOT-1)*SLOTB)?0:sl_next+SLOTB;}while(0)
  DMA_K(2,2*SLOTB);
  WAIT_BAR(3);
  qkt(pA0,pA1,Kbase,qr,negm,r32,hi);
  _Pragma("unroll") for(int d0=0;d0<4;++d0)*(__attribute__((address_space(3))) bf16x8*)(qst3+d0*1024)=qr[d0];
asm volatile("s_nop 15\n\ts_nop 7":"+v"(pA0),"+v"(pA1));CMASK(pA0,pA1,0);
  START(pA0,pA1);
  _Pragma("unroll") for(int r=0;r<16;++r)pA1[r]=__builtin_amdgcn_exp2f(pA1[r]);
  WAIT_BAR(0);
  DMA_K(3,0);DMA_V(1,SLOTB);
  ROT();
  kload8(kf,kp0+sl_cur);
  WAIT_BAR(3);
  s16x4 f0lo,f0hi,f1lo,f1hi,f2lo,f2hi,f3lo,f3hi; u32x4 pw0,pw1,pw2,pw3;
  #define PKW(P,B) cvtpk_s(P[B],P[B+1])
  #define PAF(k) __builtin_bit_cast(bf16x8,pw##k)
  #define VF(S) (bf16x8){S##lo[0],S##lo[1],S##lo[2],S##lo[3],S##hi[0],S##hi[1],S##hi[2],S##hi[3]}
  #define FOFF(i) (((i)>>2)*4096+((i)&3)*1024)
  #define VLD(S,off) do{ S##lo=vtr(vp_+(off)); S##hi=vtr(vp_+(off)+512); }while(0)
  #define PIN(x) asm volatile("":"+v"(x))
  #define MX3(a,b,c) __builtin_fmaxf(__builtin_fmaxf((a),(b)),(c))
  #define GAPA(MF,A0,A1,A2,A3,W0,W1,PW) do{ MF; sacc+=A0; sacc+=A1; sacc+=A2; sacc+=A3; PIN(sacc); W0; W1; PIN(PW); SBAR(); }while(0)
  #define EX(v) __builtin_amdgcn_exp2f(v)
  #define GAPB(MF,X,B) do{ MF; X[B]=EX(X[B]); X[B+1]=EX(X[B+1]); X[B+2]=EX(X[B+2]); X[B+3]=EX(X[B+3]); PIN(X); SBAR(); }while(0)
  #define GAPB2(MF,X,B) do{ MF; X[B]=EX(X[B]); X[B+1]=EX(X[B+1]); PIN(X); SBAR(); }while(0)
  #define KRD(G,j) do{ if(G){ kload2(kf,kp0+sl_next,j); SBAR(); } }while(0)
  #define STEP(C0,C1,P0,P1,t,GK,GV,GL) do{ SBAR(); \
    const lds_cptr vp_=vp0+2*sl_prev; \
    bf16x8 q_=LDQ(0); VLD(f0,FOFF(0)); SBAR(); float sacc=(P0[0]+P0[1]); \
    GAPA(C0=__builtin_amdgcn_mfma_f32_32x32x16_bf16(kf[0],q_,negm,0,0,0), P0[2],P0[3],P0[4],P0[5],     pw0[0]=PKW(P0,0), pw0[1]=PKW(P0,2), pw0); \
    VLD(f1,FOFF(4)); SBAR(); GAPA(C1=__builtin_amdgcn_mfma_f32_32x32x16_bf16(kf[1],q_,negm,0,0,0), P0[6],P0[7],P0[8],P0[9],     pw0[2]=PKW(P0,4), pw0[3]=PKW(P0,6), pw0); \
    q_=LDQ(1); VLD(f2,FOFF(1)); SBAR(); GAPA(C0=__builtin_amdgcn_mfma_f32_32x32x16_bf16(kf[2],q_,C0,0,0,0),   P0[10],P0[11],P0[12],P0[13], pw1[0]=PKW(P0,8), pw1[1]=PKW(P0,10), pw1); \
    VLD(f3,FOFF(5)); SBAR(); GAPA(C1=__builtin_amdgcn_mfma_f32_32x32x16_bf16(kf[3],q_,C1,0,0,0),   P0[14],P0[15],P1[0],P1[1],   pw1[2]=PKW(P0,12),pw1[3]=PKW(P0,14), pw1); \
    q_=LDQ(2); SBAR(); GAPA(C0=__builtin_amdgcn_mfma_f32_32x32x16_bf16(kf[4],q_,C0,0,0,0),   P1[2],P1[3],P1[4],P1[5],     pw2[0]=PKW(P1,0), pw2[1]=PKW(P1,2), pw2); \
    GAPA(C1=__builtin_amdgcn_mfma_f32_32x32x16_bf16(kf[5],q_,C1,0,0,0),   P1[6],P1[7],P1[8],P1[9],     pw2[2]=PKW(P1,4), pw2[3]=PKW(P1,6), pw2); \
    q_=LDQ(3); SBAR(); GAPA(C0=__builtin_amdgcn_mfma_f32_32x32x16_bf16(kf[6],q_,C0,0,0,0),   P1[10],P1[11],P1[12],P1[13], pw3[0]=PKW(P1,8), pw3[1]=PKW(P1,10), pw3); \
    GAPA(C1=__builtin_amdgcn_mfma_f32_32x32x16_bf16(kf[7],q_,C1,0,0,0),   P1[14],P1[15],0.f,0.f,       pw3[2]=PKW(P1,12),pw3[3]=PKW(P1,14), pw3); \
    l_reg+=sacc; \
    if(GK){DMA_K((t)+3,sl_cur);} if(GV){DMA_V((t)+1,sl_next);} \
    CMASK(C0,C1,t); \
    { float a=MX3(C0[0],C0[1],C1[0]),b=MX3(C0[2],C0[3],C1[1]); a=MX3(a,C1[2],C1[3]); \
      _Pragma("unroll") for(int r=4;r<16;r+=4){a=MX3(a,C0[r],C0[r+1]);b=MX3(b,C0[r+2],C0[r+3]);a=MX3(a,C1[r],C1[r+1]);b=MX3(b,C1[r+2],C1[r+3]);} \
      float rm=__builtin_fmaxf(a,b); { auto rr=__builtin_amdgcn_permlane32_swap(__float_as_uint(rm),__float_as_uint(rm),false,false); rm=__builtin_fmaxf(__uint_as_float(rr[0]),__uint_as_float(rr[1])); } \
      resc=false; \
      if(__builtin_expect(__any(rm>(float)THRL),0)){ const float dl=__builtin_fmaxf(rm,0.f); mhat+=dl; \
        _Pragma("unroll") for(int r=0;r<16;++r){C0[r]-=dl;C1[r]-=dl;} \
        _Pragma("unroll") for(int r=0;r<16;++r)negm[r]=-mhat; asm volatile("":"+v"(negm)); \
        const float f=__builtin_amdgcn_exp2f(-dl); l_reg*=f; if(hi==0)wsf[r32]=f; resc=true; } } \
    SBAR(); \
      \
    GAPB2(o[0]=__builtin_amdgcn_mfma_f32_32x32x16_bf16(PAF(0),VF(f0),o[0],0,0,0), C0,0);  VLD(f0,FOFF(2)); SBAR(); \
    GAPB2(o[1]=__builtin_amdgcn_mfma_f32_32x32x16_bf16(PAF(0),VF(f1),o[1],0,0,0), C0,2);  VLD(f1,FOFF(6)); SBAR(); \
    KRD(GL,0); GAPB2(o[0]=__builtin_amdgcn_mfma_f32_32x32x16_bf16(PAF(1),VF(f2),o[0],0,0,0), C0,4);  VLD(f2,FOFF(3)); SBAR(); \
    KRD(GL,1); GAPB2(o[1]=__builtin_amdgcn_mfma_f32_32x32x16_bf16(PAF(1),VF(f3),o[1],0,0,0), C0,6);  VLD(f3,FOFF(7)); SBAR(); \
    KRD(GL,2); GAPB2(o[0]=__builtin_amdgcn_mfma_f32_32x32x16_bf16(PAF(2),VF(f0),o[0],0,0,0), C0,8);  VLD(f0,8192+FOFF(0)); SBAR(); \
    KRD(GL,3); GAPB2(o[1]=__builtin_amdgcn_mfma_f32_32x32x16_bf16(PAF(2),VF(f1),o[1],0,0,0), C0,10); VLD(f1,8192+FOFF(4)); SBAR(); \
    GAPB2(o[0]=__builtin_amdgcn_mfma_f32_32x32x16_bf16(PAF(3),VF(f2),o[0],0,0,0), C0,12); VLD(f2,8192+FOFF(1)); SBAR(); \
    GAPB2(o[1]=__builtin_amdgcn_mfma_f32_32x32x16_bf16(PAF(3),VF(f3),o[1],0,0,0), C0,14); VLD(f3,8192+FOFF(5)); SBAR(); \
    GAPB2(o[2]=__builtin_amdgcn_mfma_f32_32x32x16_bf16(PAF(0),VF(f0),o[2],0,0,0), C1,0);  VLD(f0,8192+FOFF(2)); SBAR(); \
    GAPB2(o[3]=__builtin_amdgcn_mfma_f32_32x32x16_bf16(PAF(0),VF(f1),o[3],0,0,0), C1,2);  VLD(f1,8192+FOFF(6)); SBAR(); \
    GAPB2(o[2]=__builtin_amdgcn_mfma_f32_32x32x16_bf16(PAF(1),VF(f2),o[2],0,0,0), C1,4);  VLD(f2,8192+FOFF(3)); SBAR(); \
    GAPB2(o[3]=__builtin_amdgcn_mfma_f32_32x32x16_bf16(PAF(1),VF(f3),o[3],0,0,0), C1,6);  VLD(f3,8192+FOFF(7)); SBAR(); \
    GAPB2(o[2]=__builtin_amdgcn_mfma_f32_32x32x16_bf16(PAF(2),VF(f0),o[2],0,0,0), C1,8); \
    GAPB2(o[3]=__builtin_amdgcn_mfma_f32_32x32x16_bf16(PAF(2),VF(f1),o[3],0,0,0), C1,10); \
    GAPB2(o[2]=__builtin_amdgcn_mfma_f32_32x32x16_bf16(PAF(3),VF(f2),o[2],0,0,0), C1,12); \
    GAPB2(o[3]=__builtin_amdgcn_mfma_f32_32x32x16_bf16(PAF(3),VF(f3),o[3],0,0,0), C1,14); \
    }while(0)
  int t=1;
  #undef CMASK
  #define CMASK(P0,P1,t) do{}while(0)
  for(;t+5<NT;t+=2){
    STEP(pB0,pB1,pA0,pA1,t,true,true,true);     WAIT_BAR(3); RESC(); ROT();
    STEP(pA0,pA1,pB0,pB1,t+1,true,true,true);   WAIT_BAR(3); RESC(); ROT();
  }
  #undef CMASK
  #define CMASK(P0,P1,t) do{int jb_=(t)-(NT-4); if(jb_>=0)cmask(P0,P1,jb_,qrel,hi);}while(0)
  #define ENDW(tt) do{ if((tt)+3<NT){WAIT_BAR(3);} else if((tt)+2<NT){WAIT_BAR(2);} else {WAIT_BAR(0);} }while(0)
  for(;t+1<NT;t+=2){
    STEP(pB0,pB1,pA0,pA1,t,(t+3<NT),(t+1<NT),(t+1<NT));       ENDW(t);   RESC(); ROT();
    STEP(pA0,pA1,pB0,pB1,t+1,(t+4<NT),(t+2<NT),(t+2<NT));     ENDW(t+1); RESC(); ROT();
  }
  STEP(pB0,pB1,pA0,pA1,NT-1,false,false,false); RESC();
  { float sacc=pB0[0]+pB0[1]; _Pragma("unroll") for(int r=2;r<16;++r)sacc+=pB0[r]; _Pragma("unroll") for(int r=0;r<16;++r)sacc+=pB1[r]; l_reg+=sacc;
    pw0=(u32x4){PKW(pB0,0),PKW(pB0,2),PKW(pB0,4),PKW(pB0,6)};pw1=(u32x4){PKW(pB0,8),PKW(pB0,10),PKW(pB0,12),PKW(pB0,14)};pw2=(u32x4){PKW(pB1,0),PKW(pB1,2),PKW(pB1,4),PKW(pB1,6)};pw3=(u32x4){PKW(pB1,8),PKW(pB1,10),PKW(pB1,12),PKW(pB1,14)};
    SBAR(); pv(o,vb0+2*sl_cur,PAF(0),PAF(1),PAF(2),PAF(3)); }
  #undef PKW
  #undef PAF
  #undef VF
  #undef FOFF
  #undef VLD
  #undef LDQ
  #undef PIN
  #undef MX3
  #undef GAPA
  #undef GAPB
  #undef EX
  #undef GAPB2
  #undef KRD
  #undef STEP
  #undef ENDW
  {auto rr=__builtin_amdgcn_permlane32_swap(__float_as_uint(l_reg),__float_as_uint(l_reg),false,false);l_reg=__uint_as_float(rr[0])+__uint_as_float(rr[1]);}
  if(hi==0)wsf[32+r32]=l_reg;asm volatile("s_waitcnt lgkmcnt(0)":::"memory");
  float rli[16];
  #pragma unroll
  for(int r=0;r<16;++r)rli[r]=__builtin_amdgcn_rcpf(wsf[32+crow(r,hi)]);
  bf16*Ow=O+(rowbase+q0+wid*QBLK)*DM;
  { bf16*stg=(bf16*)(shm+LDS_OST)+wid*2048;
    #pragma unroll
    for(int h2=0;h2<2;++h2){
      #pragma unroll
      for(int r=0;r<16;++r){const int orow=crow(r,hi);
        #pragma unroll
        for(int d0=0;d0<2;++d0)stg[orow*64+d0*32+r32]=__float2bfloat16(o[2*h2+d0][r]*rli[r]);}
      asm volatile("s_waitcnt lgkmcnt(0)":::"memory");
      #pragma unroll
      for(int i=0;i<4;++i){const int row=i*8+(lane>>3),ch=lane&7; const u32x4 v=*(const u32x4*)(stg+row*64+ch*8); ATTN_STORE16(Ow+(long)row*DM+h2*64+ch*8,v);}
      asm volatile("s_waitcnt lgkmcnt(0)":::"memory"); } }
  asm volatile("s_waitcnt lgkmcnt(0)\n\ts_barrier":::"memory");
  #undef DMA_K
  #undef DMA_V
  #undef CMASK
  #undef START
  #undef RESC
  #undef ROT
}
constexpr int ATTN_LDS_BYTES=LDS_BYTES;
#undef SBAR
#undef WAIT_BAR
}
#define GAS __attribute__((address_space(1)))
#define LAS __attribute__((address_space(3)))
typedef unsigned short bf16;
typedef unsigned v4u __attribute__((ext_vector_type(4)));
typedef float f32x4 __attribute__((ext_vector_type(4)));
typedef short bf16x8 __attribute__((ext_vector_type(8)));
typedef GAS unsigned gu32;
typedef GAS unsigned long long gu64;
#define RLX_AGENT __ATOMIC_RELAXED, __HIP_MEMORY_SCOPE_AGENT
#define LDS_WAIT() asm volatile("s_waitcnt lgkmcnt(0)" ::: "memory")
#define VM_WAIT() asm volatile("s_waitcnt vmcnt(0)" ::: "memory")
__device__ __forceinline__ unsigned long long rt() { return __builtin_amdgcn_s_memrealtime(); }
__device__ __forceinline__ unsigned f2bf(float f) { unsigned u = __builtin_bit_cast(unsigned, f); return (u + 0x7fffu + ((u >> 16) & 1u)) >> 16; }
__device__ __forceinline__ unsigned pk2(float lo, float hi) { return f2bf(lo) | (f2bf(hi) << 16); }

#define XB_TMO      128
#define XB_XCNT(j)  (256  + 64 * (j))
#define XB_XSUB(j)  (1280 + 64 * (j))
#define XB_XGEN(j)  (2304 + 64 * (j))
#define XB_TOP      3328
#define XB_TOPGEN   3392
#define XCD_BAR_WORDS 3456
#define XB_SPIN_CAP (1u << 18)

__device__ __forceinline__ unsigned xb_ld(unsigned* p)              { return __hip_atomic_load(p, __ATOMIC_RELAXED, __HIP_MEMORY_SCOPE_AGENT); }
__device__ __forceinline__ unsigned xb_add(unsigned* p, unsigned v) { return __hip_atomic_fetch_add(p, v, __ATOMIC_RELAXED, __HIP_MEMORY_SCOPE_AGENT); }
__device__ __forceinline__ unsigned xb_xcc_id() { return (unsigned)__builtin_amdgcn_s_getreg((3 << 11) | 20) & 0xFu; }
#define XB_SPIN(cond, bar) do { unsigned _sp = 0; while (cond) { __builtin_amdgcn_s_sleep(1); \
    if ((++_sp & 255u) == 0u) { if (xb_ld(&(bar)[XB_TMO])) break; if (_sp > XB_SPIN_CAP) { atomicAdd(&(bar)[XB_TMO], 1u); break; } } } } while (0)

struct XcdBarrier {
    unsigned* bar; unsigned x;
    volatile LAS unsigned* st;
};

__device__ __forceinline__ XcdBarrier xcd_barrier_post(unsigned* bar, volatile LAS unsigned* st) {
    XcdBarrier b; b.bar = bar; b.x = xb_xcc_id(); b.st = st;
    if (threadIdx.x == 0) (void)xb_add(&bar[XB_XCNT(b.x)], 1u);
    return b;
}
__device__ __forceinline__ void xcd_barrier_complete(unsigned* bar, unsigned x, unsigned& nloc, unsigned& nx) {
    const unsigned G = gridDim.x * gridDim.y * gridDim.z;
    unsigned sum, cnt, mine, sp = 0u;
    for (;;) {
        sum = 0u; cnt = 0u; mine = 0u;
#pragma unroll
        for (unsigned j = 0; j < 16; ++j) { const unsigned c = xb_ld(&bar[XB_XCNT(j)]); sum += c; cnt += (c > 0u) ? 1u : 0u; mine = (j == x) ? c : mine; }
        if (sum == G) break;
        __builtin_amdgcn_s_sleep(1);
        if ((++sp & 255u) == 0u) { if (xb_ld(&bar[XB_TMO])) break; if (sp > XB_SPIN_CAP) { atomicAdd(&bar[XB_TMO], 1u); break; } }
    }
    nloc = mine > 0u ? mine : 1u; nx = cnt > 0u ? cnt : 1u;
}

__device__ __forceinline__ void xcd_barrier(const XcdBarrier& b) {
    asm volatile("s_waitcnt vmcnt(0)" ::: "memory");
    __syncthreads();
    if (threadIdx.x == 0) {
        size_t zoff_ = 0; asm volatile("" : "+s"(zoff_)); unsigned* bar = b.bar + zoff_; unsigned bx_ = b.x; asm volatile("" : "+s"(bx_));
        __builtin_amdgcn_s_waitcnt(0);
        unsigned nloc = b.st[0], nx = b.st[1];
        if (nloc == 0u) { xcd_barrier_complete(bar, bx_, nloc, nx); b.st[0] = nloc; b.st[1] = nx; }
        const unsigned old = xb_add(&bar[XB_XSUB(bx_)], 1u);
        const unsigned gen = old / nloc;
        if (old + 1u == (gen + 1u) * nloc) {
            __builtin_amdgcn_fence(__ATOMIC_RELEASE, "agent");
            asm volatile("s_waitcnt vmcnt(0)" ::: "memory");
            const unsigned og = xb_add(&bar[XB_TOP], 1u);
            const unsigned tg = og / nx;
            if (og + 1u == (tg + 1u) * nx) xb_add(&bar[XB_TOPGEN], 1u);
            else XB_SPIN(xb_ld(&bar[XB_TOPGEN]) == tg, bar);
            __builtin_amdgcn_fence(__ATOMIC_ACQUIRE, "agent");
            xb_add(&bar[XB_XGEN(bx_)], 1u);
            asm volatile("s_waitcnt vmcnt(0)" ::: "memory");
        } else {
            XB_SPIN(xb_ld(&bar[XB_XGEN(bx_)]) == gen, bar);
            __builtin_amdgcn_fence(__ATOMIC_ACQUIRE, "agent");
            asm volatile("s_waitcnt vmcnt(0)" ::: "memory");
        }
    }
    __syncthreads();
}
constexpr int NWAVES = 8;
constexpr int BATCH = 8, SEQ = 4096, DMODEL = 1024, NTOK = BATCH * SEQ, DEPTH = 2, IN_COLS = 2816;
constexpr int NEXP = 16384, PEER_H = 8, PEER_K = 16;
constexpr float RMS_EPS = 1e-6f, LN_EPS = 1e-5f;
constexpr size_t MiB = 1u << 20;
constexpr size_t WS_CTL = 0, CTL_ZERO_BYTES = 1 * MiB;
constexpr size_t WS_WIN = 2 * MiB;
constexpr size_t WS_WOUT = 13 * MiB;
constexpr size_t WS_WQ = 17 * MiB;
constexpr size_t WS_KEYS = 25 * MiB;
constexpr size_t WS_RINV = 26 * MiB;
constexpr size_t WS_SSQ = 27 * MiB;
constexpr size_t WS_EID = 30 * MiB;
constexpr size_t WS_GATE = 38 * MiB;
constexpr size_t WS_SB = 54 * MiB;
constexpr size_t WS_XBF = 72 * MiB;
constexpr size_t WS_QK = 136 * MiB;
constexpr size_t WS_VX = 200 * MiB;
constexpr size_t WS_UT = 264 * MiB;
constexpr size_t WS_VT = 296 * MiB;
constexpr size_t WS_SU = 328 * MiB;
constexpr size_t WS_SV = 329 * MiB;
constexpr size_t WS_EIDT = 330 * MiB;
constexpr size_t WS_CORR = 338 * MiB;
constexpr size_t WS_SSQX = 339 * MiB;
constexpr size_t WS_XQ = 344 * MiB;
constexpr size_t WS_XQS = 376 * MiB;
constexpr size_t WS_CAT = 377 * MiB;
constexpr size_t WS_O = 441 * MiB;
constexpr size_t WS_WSC = 340 * MiB;
constexpr size_t WS_END = 505 * MiB;
constexpr size_t WS_PART = WS_QK;
constexpr size_t WS_WT = WS_SB;
constexpr int CW_BAR = 4096;
constexpr int RING_OFF = 0, RING_BYTES = 131072;
constexpr int LDSCTL_OFF = RING_BYTES, MISC_OFF = LDSCTL_OFF + 320;
constexpr int LDS_BYTES = 147456;

__device__ __forceinline__ float bflo(unsigned w) { return __builtin_bit_cast(float, w << 16); }
__device__ __forceinline__ float bfhi(unsigned w) { return __builtin_bit_cast(float, w & 0xffff0000u); }
__device__ __forceinline__ float bf1(unsigned short w) { return __builtin_bit_cast(float, (unsigned)w << 16); }
#define DPP_ADD(v, ctrl) ((v) + __builtin_bit_cast(float, __builtin_amdgcn_update_dpp(0, __builtin_bit_cast(int, (v)), (ctrl), 0xf, 0xf, true)))
__device__ __forceinline__ float wave_sum(float v) {
    v = DPP_ADD(v, 0xB1);
    v = DPP_ADD(v, 0x4E);
    v = DPP_ADD(v, 0x141);
    v = DPP_ADD(v, 0x140);
    const int b = __builtin_bit_cast(int, v);
    return (__builtin_bit_cast(float, __builtin_amdgcn_readlane(b, 0)) + __builtin_bit_cast(float, __builtin_amdgcn_readlane(b, 16))) + (__builtin_bit_cast(float, __builtin_amdgcn_readlane(b, 32)) + __builtin_bit_cast(float, __builtin_amdgcn_readlane(b, 48)));
}

__device__ __forceinline__ int win_src(int np) {
    const int p = np >> 8, pc = np & 255;
    if (p < 4) return 256 * p + 64 * ((pc & 127) >> 5) + 32 * (pc >> 7) + (pc & 31);
    if (p < 6) return np;
    if (p < 8) { const int kk = p - 6; return pc < 128 ? 1536 + 128 * kk + pc : 1792 + 128 * kk + (pc - 128); }
    if (p < 10) { const int kk = p - 8; return pc < 128 ? 2304 + 128 * kk + pc : 2560 + 128 * kk + (pc - 128); }
    return 2048 + pc;
}
template <int MODE> __device__ __forceinline__ void p0_transpose_item(const float* W, const float* gain, int K, int N, bf16* WT, LAS float* scr, int item, int lane) {
    const int nblk = N / 32, kb = item / nblk, nb = item % nblk, k0 = 64 * kb, n0p = 32 * nb;
    const int n0 = MODE == 1 ? win_src(n0p) : n0p;
#pragma unroll 8
    for (int i = 0; i < 32; ++i) { const int kk = 2 * i + (lane >> 5); const float gk = gain ? gain[k0 + kk] : 1.f; scr[kk * 33 + (lane & 31)] = W[(size_t)(k0 + kk) * N + n0 + (lane & 31)] * gk; }
    LDS_WAIT(); asm volatile("" ::: "memory");
    const int c = lane & 7;
#pragma unroll
    for (int j = 0; j < 4; ++j) { const int n = (lane >> 3) + 8 * j; const LAS float* s = scr + (8 * c) * 33 + n;
        v4u o; o.x = pk2(s[0 * 33], s[1 * 33]); o.y = pk2(s[2 * 33], s[3 * 33]); o.z = pk2(s[4 * 33], s[5 * 33]); o.w = pk2(s[6 * 33], s[7 * 33]);
        *(GAS v4u*)(WT + (size_t)(n0p + n) * K + k0 + 8 * c) = o; }
    LDS_WAIT(); asm volatile("" ::: "memory");
}
__device__ __forceinline__ void p0_convert(const float* src, bf16* dst, size_t n, int gtid, int ngt) {
    for (size_t i = (size_t)gtid * 8; i < n; i += (size_t)ngt * 8) {
        const f32x4 a = *(const GAS f32x4*)(src + i), b = *(const GAS f32x4*)(src + i + 4);
        v4u o; o.x = pk2(a.x, a.y); o.y = pk2(a.z, a.w); o.z = pk2(b.x, b.y); o.w = pk2(b.z, b.w);
        *(GAS v4u*)(dst + i) = o; }
}
__device__ __forceinline__ float wave_max(float v) {
#pragma unroll
    for (int o = 1; o < 64; o <<= 1) v = fmaxf(v, __shfl_xor(v, o));
    return v;
}
template <int OFFS> __device__ __forceinline__ void p0_quant_row(const float* src, unsigned char* dst_base, int e, float* scale_out, int lane) {
    const GAS f32x4* xr = (const GAS f32x4*)src + 4 * lane;
    f32x4 v[4]; float m = 0.f;
#pragma unroll
    for (int j = 0; j < 4; ++j) { v[j] = __builtin_nontemporal_load(xr + j); m = fmaxf(fmaxf(m, fmaxf(fabsf(v[j].x), fabsf(v[j].y))), fmaxf(fabsf(v[j].z), fabsf(v[j].w))); }
    m = wave_max(m);
    const float inv = m > 0.f ? 127.0f / m : 0.f;
    v4u o;
#pragma unroll
    for (int j = 0; j < 4; ++j) { const int a = (int)rintf(v[j].x * inv) + OFFS, b = (int)rintf(v[j].y * inv) + OFFS, c = (int)rintf(v[j].z * inv) + OFFS, d = (int)rintf(v[j].w * inv) + OFFS;
        o[j] = (unsigned)(a & 0xff) | ((unsigned)(b & 0xff) << 8) | ((unsigned)(c & 0xff) << 16) | ((unsigned)(d & 0xff) << 24); }
    *(GAS v4u*)(dst_base + ((size_t)(lane >> 3) * NEXP + e) * 128 + 16 * (lane & 7)) = o;
    if (lane == 0) *scale_out = m * (1.0f / 127.0f);
}
struct QRow { f32x4 v[4]; };
__device__ __forceinline__ void p0_quant_load(QRow& q, const float* src, int lane) { const GAS f32x4* xr = (const GAS f32x4*)src + 4 * lane;
#pragma unroll
    for (int j = 0; j < 4; ++j) q.v[j] = __builtin_nontemporal_load(xr + j); }
__device__ __forceinline__ void p0_quant_fin(const QRow& q, const float* gain, unsigned char* dst_base, int e, float* scale_out, int lane) {
    f32x4 v[4]; float m = 0.f;
#pragma unroll
    for (int j = 0; j < 4; ++j) { v[j] = q.v[j]; if (gain) v[j] = v[j] * *((const GAS f32x4*)gain + 4 * lane + j); m = fmaxf(fmaxf(m, fmaxf(fabsf(v[j].x), fabsf(v[j].y))), fmaxf(fabsf(v[j].z), fabsf(v[j].w))); }
    m = fmaxf(m, __shfl_xor(m, 1)); m = fmaxf(m, __shfl_xor(m, 2)); m = fmaxf(m, __shfl_xor(m, 4)); m = fmaxf(m, __shfl_xor(m, 8));
    const float inv = m > 0.f ? 7.0f / m : 0.f;
    unsigned o[2];
#pragma unroll
    for (int k = 0; k < 2; ++k) { const f32x4 lo = v[2 * k], hi = v[2 * k + 1];
#define Q4(x) ((unsigned)((int)rintf((x) * inv) + 8) & 0xfu)
        o[k] = (Q4(lo.x) | (Q4(hi.x) << 4)) | ((Q4(lo.y) | (Q4(hi.y) << 4)) << 8) | ((Q4(lo.z) | (Q4(hi.z) << 4)) << 16) | ((Q4(lo.w) | (Q4(hi.w) << 4)) << 24);
#undef Q4
    }
    *(GAS unsigned long long*)(dst_base + ((size_t)(lane >> 4) * NEXP + e) * 128 + 8 * (lane & 15)) = (unsigned long long)o[0] | ((unsigned long long)o[1] << 32);
    if ((lane & 15) == 0) scale_out[4 * e + (lane >> 4)] = m * (1.0f / 7.0f);
}
__device__ __forceinline__ void p0_quant_row4(const float* src, const float* gain, unsigned char* dst_base, int e, float* scale_out, int lane) { QRow q; p0_quant_load(q, src, lane); p0_quant_fin(q, gain, dst_base, e, scale_out, lane); }
__device__ __forceinline__ void p0_x_row(const float* xrow, bf16* orow, float* rinv_out, int lane) {
    const GAS f32x4* xr = (const GAS f32x4*)xrow + lane;
    f32x4 v[4]; float s = 0.f;
#pragma unroll
    for (int j = 0; j < 4; ++j) { v[j] = xr[64 * j]; s += (v[j].x * v[j].x + v[j].y * v[j].y) + (v[j].z * v[j].z + v[j].w * v[j].w); }
    s = wave_sum(s);
    GAS unsigned long long* o8 = (GAS unsigned long long*)orow + lane;
#pragma unroll
    for (int j = 0; j < 4; ++j) o8[64 * j] = (unsigned long long)pk2(v[j].x, v[j].y) | ((unsigned long long)pk2(v[j].z, v[j].w) << 32);
    if (lane < 8) rinv_out[lane] = lane == 0 ? s : 0.f;
}

__device__ __forceinline__ float wave_sum_shfl(float v) {
#pragma unroll
    for (int o = 1; o < 64; o <<= 1) v += __shfl_xor(v, o);
    return v;
}
__device__ __forceinline__ void xq_row(const bf16* xrow, signed char* qrow, float* sc4, int lane) {
    const GAS v4u* xp = (const GAS v4u*)xrow + 2 * lane; const v4u a = xp[0], b = xp[1];
#define AMX(w) fmaxf(fabsf(bflo(w)), fabsf(bfhi(w)))
    float am = fmaxf(fmaxf(fmaxf(AMX(a.x), AMX(a.y)), fmaxf(AMX(a.z), AMX(a.w))), fmaxf(fmaxf(AMX(b.x), AMX(b.y)), fmaxf(AMX(b.z), AMX(b.w))));
#undef AMX
    am = fmaxf(am, __shfl_xor(am, 1)); am = fmaxf(am, __shfl_xor(am, 2)); am = fmaxf(am, __shfl_xor(am, 4)); am = fmaxf(am, __shfl_xor(am, 8));
    const float qinv = am > 0.f ? 127.0f / am : 0.f;
#define PK4(wa, wb) (unsigned)(((int)rintf(bflo(wa) * qinv) & 0xff) | (((int)rintf(bfhi(wa) * qinv) & 0xff) << 8) | (((int)rintf(bflo(wb) * qinv) & 0xff) << 16) | (((int)rintf(bfhi(wb) * qinv) & 0xff) << 24))
    v4u o; o.x = PK4(a.x, a.y); o.y = PK4(a.z, a.w); o.z = PK4(b.x, b.y); o.w = PK4(b.z, b.w);
#undef PK4
    *((GAS v4u*)qrow + lane) = o;
    if ((lane & 15) == 0) sc4[lane >> 4] = am * (1.0f / 127.0f);
}
struct CmbArgs { const bf16* O; const bf16* VX; const bf16* SB; bf16* CAT; const float* lq1; const float* lk1; const float* lq2; const float* lk2; const float* subg;
                 const float* cfw; const float* cfb; const float* lng; const float* lnb; const float* scw; float lam_init; };
__device__ __forceinline__ float cmb_lambda(const CmbArgs& A, int lane) { return __expf(wave_sum(A.lq1[lane] * A.lk1[lane])) - __expf(wave_sum(A.lq2[lane] * A.lk2[lane])) + A.lam_init; }
__device__ __forceinline__ void cmb_rows(const CmbArgs& A, float lam, int h, int trow0, int lane_in) {
    asm volatile("s_waitcnt vmcnt(0)" ::: "memory");
    int lane = lane_in; asm volatile("" : "+v"(lane));
    const int vh = lane >> 5, dd = (2 * lane) & 63;
    const int c0 = (4 * h + vh) * 64 + dd, c1 = (4 * h + 2 + vh) * 64 + dd;
    const float g0 = A.subg[2 * lane] * (1.0f - A.lam_init), g1 = A.subg[2 * lane + 1] * (1.0f - A.lam_init);
    unsigned o0[32], o1[32];
#pragma unroll
    for (int tt = 0; tt < 32; ++tt) { const size_t rb = (size_t)(trow0 + tt) * 1024;
        o0[tt] = __hip_atomic_load((const GAS unsigned*)(A.O + rb + c0), __ATOMIC_RELAXED, __HIP_MEMORY_SCOPE_AGENT); o1[tt] = __hip_atomic_load((const GAS unsigned*)(A.O + rb + c1), __ATOMIC_RELAXED, __HIP_MEMORY_SCOPE_AGENT); }
#pragma unroll
    for (int tt = 0; tt < 32; ++tt) {
        const float a0 = bflo(o0[tt]) - lam * bflo(o1[tt]), a1 = bfhi(o0[tt]) - lam * bfhi(o1[tt]);
        const float ss = wave_sum(a0 * a0 + a1 * a1);
        const float ri = 1.0f / sqrtf(ss * (1.0f / 128.0f) + RMS_EPS);
        *(GAS unsigned*)(A.CAT + (size_t)(trow0 + tt) * 1024 + h * 128 + 2 * lane) = pk2(a0 * ri * g0, a1 * ri * g1); }
}
__device__ __forceinline__ void cmb_conv_phase(const CmbArgs& A, int gw, int ngw, int lane) {
    constexpr int NCH = SEQ / 16, NIT = NCH * 4;
    {
        unsigned short xin[46], xn[46];
#define CMB1_LOAD(X, it_) do { const int c_ = 64 * ((it_) & 3) + lane, t0_ = ((it_) >> 2) * 16, s0_ = t0_ & (SEQ - 1); \
        _Pragma("unroll") for (int i = 0; i < 46; ++i) { const int rel = i - 30; (X)[i] = (s0_ + rel >= 0) ? *(const GAS unsigned short*)(A.VX + (size_t)(t0_ + rel) * 1024 + 512 + c_) : (unsigned short)0; } } while (0)
        int it = gw;
        if (it < NIT) CMB1_LOAD(xin, it);
        for (; it < NIT; it += ngw) {
            const int nx = it + ngw < NIT ? it + ngw : it;
            CMB1_LOAD(xn, nx);
            const int c = 64 * (it & 3) + lane, t0 = (it >> 2) * 16;
            float w[31];
#pragma unroll
            for (int j = 0; j < 31; ++j) w[j] = A.cfw[j * 256 + c];
            const float bias = A.cfb[c], lg = A.lng[c], lb = A.lnb[c];
#pragma unroll
            for (int tt = 0; tt < 16; ++tt) { float y = bias;
#pragma unroll
                for (int j = 0; j < 31; ++j) y += w[j] * bf1(xin[tt + j]);
                const float mean = wave_sum(y) * (1.0f / 64.0f); const float d = y - mean;
                const float var = wave_sum(d * d) * (1.0f / 64.0f);
                const float yn = d / sqrtf(var + LN_EPS) * lg + lb;
                const float sw = yn / (1.0f + __expf(-yn));
                *(GAS unsigned short*)(A.CAT + (size_t)(t0 + tt) * 1024 + 512 + c) = (unsigned short)f2bf(sw); }
#pragma unroll
            for (int i = 0; i < 46; ++i) xin[i] = xn[i];
        }
#undef CMB1_LOAD
    }
    {
        unsigned short xin[18], sbv[16], xn[18], sbn[16];
#define CMB2_LOAD(X, S, it_) do { const int c_ = 64 * ((it_) & 3) + lane, t0_ = ((it_) >> 2) * 16, s0_ = t0_ & (SEQ - 1); \
        _Pragma("unroll") for (int i = 0; i < 18; ++i) { const int rel = i - 2; (X)[i] = (s0_ + rel >= 0) ? *(const GAS unsigned short*)(A.VX + (size_t)(t0_ + rel) * 1024 + 768 + c_) : (unsigned short)0; } \
        _Pragma("unroll") for (int tt = 0; tt < 16; ++tt) (S)[tt] = *(const GAS unsigned short*)(A.SB + (size_t)(t0_ + tt) * 256 + c_); } while (0)
        int it = gw;
        if (it < NIT) CMB2_LOAD(xin, sbv, it);
        for (; it < NIT; it += ngw) {
            const int nx = it + ngw < NIT ? it + ngw : it;
            CMB2_LOAD(xn, sbn, nx);
            const int c = 64 * (it & 3) + lane, t0 = (it >> 2) * 16;
            const float w0 = A.scw[c], w1 = A.scw[256 + c], w2 = A.scw[512 + c];
#pragma unroll
            for (int tt = 0; tt < 16; ++tt) {
                const float y = bf1(sbv[tt]) * (w0 * bf1(xin[tt]) + w1 * bf1(xin[tt + 1]) + w2 * bf1(xin[tt + 2]));
                *(GAS unsigned short*)(A.CAT + (size_t)(t0 + tt) * 1024 + 768 + c) = (unsigned short)f2bf(y); }
#pragma unroll
            for (int i = 0; i < 18; ++i) xin[i] = xn[i];
#pragma unroll
            for (int tt = 0; tt < 16; ++tt) sbv[tt] = sbn[tt];
        }
#undef CMB2_LOAD
    }
}

typedef float f32x16 __attribute__((ext_vector_type(16)));
__device__ __forceinline__ int sortable(int b) { return b ^ ((b >> 31) & 0x7fffffff); }
#define CEX_DESC(a, b) do { const int _x = (a), _y = (b); (a) = _x > _y ? _x : _y; (b) = _x > _y ? _y : _x; } while (0)
template <int N> __device__ __forceinline__ void bitonic_merge_desc(int (&v)[N]) {
#pragma unroll
    for (int j = N >> 1; j > 0; j >>= 1)
#pragma unroll
        for (int i = 0; i < N; ++i) if ((i & j) == 0) CEX_DESC(v[i], v[i | j]);
}
template <int N> __device__ __forceinline__ void bitonic_sort_desc(int (&v)[N]) {
#pragma unroll
    for (int k = 2; k <= N; k <<= 1)
#pragma unroll
        for (int j = k >> 1; j > 0; j >>= 1)
#pragma unroll
            for (int i = 0; i < N; ++i) { const int l = i ^ j; if (l > i) { if ((i & k) == 0) CEX_DESC(v[i], v[l]); else CEX_DESC(v[l], v[i]); } }
}
__device__ __forceinline__ void merge_top16(int (&a)[16], const int (&b)[16]) {
#pragma unroll
    for (int i = 0; i < 16; ++i) a[i] = a[i] > b[15 - i] ? a[i] : b[15 - i];
    bitonic_merge_desc<16>(a);
}
struct QuantJob { const float* usrc; const float* vsrc; const float* gain; unsigned char* UT; unsigned char* VT; float* SU; float* SV; int r0, rs; };
struct TopkArgs { const bf16* Qp; const bf16* keys; const float* ssq; unsigned short* eid; float* gate; unsigned short* eidT;
#ifdef DBG_CHECK
 float* dbgS; int* dbgI;
#endif
 };
__device__ __forceinline__ void topk_phase(const TopkArgs& A, const QuantJob& J, int& qr_next, LAS unsigned char* ldsK  , LAS unsigned char* ldsw  , int h, int rank, int nrank, int wave, int tid, int lane) {
    const int r32 = lane & 31, hi = lane >> 5;
    __syncthreads();
    {
        const GAS v4u* src = (const GAS v4u*)(A.keys + (size_t)h * 2 * 128 * 128);
#pragma unroll
        for (int i = 0; i < 8; ++i) { const int g = tid + 512 * i, row = g >> 4, ch = g & 15; *(LAS v4u*)(ldsK + row * 256 + ((ch ^ (row & 15)) << 4)) = src[g]; }
        __syncthreads();
    }
    for (int tg = rank * 8 + wave; tg < SEQ / 32; tg += nrank * 8) {
        const int t = tg * 32 + r32;
        const int qra = qr_next < NEXP ? qr_next : NEXP - 1; const bool qok = qr_next < NEXP; qr_next += J.rs;
        QRow qua, qva;
        p0_quant_load(qua, J.usrc + (size_t)qra * DMODEL, lane); p0_quant_load(qva, J.vsrc + (size_t)qra * DMODEL, lane);
        int hb = hi << 2; asm volatile("" : "+v"(hb));
        float rinv2; { const GAS f32x4* sp = (const GAS f32x4*)(A.ssq + (size_t)t * 16); const f32x4 a = sp[0], b = sp[1], c = sp[2], d = sp[3];
            const float ss = ((a.x + a.y) + (a.z + a.w)) + ((b.x + b.y) + (b.z + b.w)) + ((c.x + c.y) + (c.z + c.w)) + ((d.x + d.y) + (d.z + d.w));
            rinv2 = 1.0f / sqrtf(ss * (1.0f / DMODEL) + RMS_EPS); }
        int top[2][16];
#pragma unroll
        for (int c = 0; c < 2; ++c) {
            const bf16* qrow = A.Qp + (size_t)t * 2048 + h * 256 + c * 128 + 8 * hi;
            bf16x8 qf[8];
#pragma unroll
            for (int s = 0; s < 8; ++s) qf[s] = *(const GAS bf16x8*)(qrow + 16 * s);
            int run[16];
            int koff = c * 32768 + r32 * 256; asm volatile("" : "+v"(koff));
            const int ksw = r32 & 15;
#pragma unroll
            for (int nt = 0; nt < 4; ++nt) {
                bf16x8 kf[8];
#pragma unroll
                for (int s = 0; s < 8; ++s) kf[s] = *(const LAS bf16x8*)(ldsK + nt * 8192 + koff + (((2 * s + hi) ^ ksw) << 4));
                f32x16 acc = {0.f, 0.f, 0.f, 0.f, 0.f, 0.f, 0.f, 0.f, 0.f, 0.f, 0.f, 0.f, 0.f, 0.f, 0.f, 0.f};
#pragma unroll
                for (int s = 0; s < 8; ++s) acc = __builtin_amdgcn_mfma_f32_32x32x16_bf16(kf[s], qf[s], acc, 0, 0, 0);
                asm volatile("" ::: "memory");
                int g[16];
#pragma unroll
                for (int r = 0; r < 16; ++r) { const int idx = 32 * nt + (r & 3) + 8 * (r >> 2);
                    const float av = acc[r];
                    const int bits = ((__float_as_int(av) & ~0x7f) | idx) | hb;
                    g[r] = sortable(bits); }
                bitonic_sort_desc<16>(g);
                if (nt == 0) {
#pragma unroll
                    for (int r = 0; r < 16; ++r) run[r] = g[r];
                } else merge_top16(run, g);
            }
            {
                int other[16];
#pragma unroll
                for (int i = 0; i < 16; ++i) other[i] = __shfl_xor(run[i], 32);
                merge_top16(run, other);
            }
#pragma unroll
            for (int i = 0; i < 16; ++i) top[c][i] = sortable(run[i]);
#ifdef DBG_CHECK
            if (tg == 0 && hi == 0) {
#pragma unroll
                for (int i = 0; i < 16; ++i) A.dbgI[((size_t)(r32 * 8 + h) * 2 + c) * 16 + i] = top[c][i]; }
#endif
        }
#pragma unroll
        for (int c = 0; c < 2; ++c)
#pragma unroll
            for (int q4 = 0; q4 < 4; ++q4) { const unsigned w = (unsigned)(top[c][4 * q4] & 0x7f) | ((unsigned)(top[c][4 * q4 + 1] & 0x7f) << 8) | ((unsigned)(top[c][4 * q4 + 2] & 0x7f) << 16) | ((unsigned)(top[c][4 * q4 + 3] & 0x7f) << 24);
                *(LAS unsigned*)(ldsw + lane * 32 + c * 16 + q4 * 4) = w; }
        int crun[16];
        {
            int cg[16]; int pos = 0;
#pragma unroll
            for (int i = 0; i < 16; ++i)
#pragma unroll
                for (int j = 0; j < 16; ++j) if ((i + 1) * (j + 1) <= 16) {
                    const float s = __builtin_bit_cast(float, top[0][i] & ~0x7f) + __builtin_bit_cast(float, top[1][j] & ~0x7f);
                    cg[pos & 15] = sortable((__builtin_bit_cast(int, s) & ~0xff) | (i << 4) | j); ++pos;
                    if (pos == 50) {
#pragma unroll
                        for (int p = 2; p < 16; ++p) cg[p] = (int)0x80000000;
                    }
                    if ((pos & 15) == 0 || pos == 50) {
                        bitonic_sort_desc<16>(cg);
                        if (pos == 16) {
#pragma unroll
                            for (int r = 0; r < 16; ++r) crun[r] = cg[r];
                        } else merge_top16(crun, cg);
                    }
                }
        }
        LDS_WAIT(); asm volatile("" ::: "memory");
        float sc[16]; unsigned e[16];
#pragma unroll
        for (int k = 0; k < 16; ++k) { const int bits = sortable(crun[k]); const int i = (bits >> 4) & 15, j = bits & 15;
            sc[k] = __builtin_bit_cast(float, bits & ~0xff) * rinv2;
            const unsigned i1 = *(const LAS unsigned char*)(ldsw + lane * 32 + i), i2 = *(const LAS unsigned char*)(ldsw + lane * 32 + 16 + j);
            e[k] = i1 * 128u + i2; }
        const float mx = sc[0];
        float z = 0.f;
#pragma unroll
        for (int k = 0; k < 16; ++k) { sc[k] = __expf(sc[k] - mx); z += sc[k]; }
        const float iz = 1.0f / z;
        if (hi == 0) {
            v4u e0, e1; e0.x = e[0] | (e[1] << 16); e0.y = e[2] | (e[3] << 16); e0.z = e[4] | (e[5] << 16); e0.w = e[6] | (e[7] << 16);
            e1.x = e[8] | (e[9] << 16); e1.y = e[10] | (e[11] << 16); e1.z = e[12] | (e[13] << 16); e1.w = e[14] | (e[15] << 16);
            GAS v4u* ep = (GAS v4u*)(A.eid + (size_t)t * 128 + h * 16); ep[0] = e0; ep[1] = e1;
#pragma unroll
            for (int k = 0; k < 8; ++k) *(GAS unsigned*)(A.eidT + (size_t)t * 128 + k * 16 + 2 * h) = e[k] | (e[k + 8] << 16);
        } else {
            GAS f32x4* gp = (GAS f32x4*)(A.gate + (size_t)t * 128 + h * 16);
#pragma unroll
            for (int q4 = 0; q4 < 4; ++q4) gp[q4] = (f32x4){sc[4 * q4] * iz, sc[4 * q4 + 1] * iz, sc[4 * q4 + 2] * iz, sc[4 * q4 + 3] * iz};
        }
        if (qok) { p0_quant_fin(qua, J.gain, J.UT, qra, J.SU, lane); p0_quant_fin(qva, nullptr, J.VT, qra, J.SV, lane); }
    }
}

__device__ __forceinline__ float gelu_exact(float v) { return 0.5f * v * (1.0f + erff(v * 0.70710678118654752f)); }
__device__ __forceinline__ float ub0(unsigned x) { float f; asm("v_cvt_f32_ubyte0 %0, %1" : "=v"(f) : "v"(x)); return f; }
__device__ __forceinline__ float ub1(unsigned x) { float f; asm("v_cvt_f32_ubyte1 %0, %1" : "=v"(f) : "v"(x)); return f; }
__device__ __forceinline__ float ub2(unsigned x) { float f; asm("v_cvt_f32_ubyte2 %0, %1" : "=v"(f) : "v"(x)); return f; }
__device__ __forceinline__ float ub3(unsigned x) { float f; asm("v_cvt_f32_ubyte3 %0, %1" : "=v"(f) : "v"(x)); return f; }
template <class T> __device__ __forceinline__ T tr_xchg_add(T a, T b, int O, int lane) {
    if (O == 16 || O == 32) {
        const unsigned ua = __builtin_bit_cast(unsigned, a), ub = __builtin_bit_cast(unsigned, b);
        if (O == 16) { auto r = __builtin_amdgcn_permlane16_swap(ua, ub, false, false); return __builtin_bit_cast(T, (unsigned)r[0]) + __builtin_bit_cast(T, (unsigned)r[1]); }
        else         { auto r = __builtin_amdgcn_permlane32_swap(ua, ub, false, false); return __builtin_bit_cast(T, (unsigned)r[0]) + __builtin_bit_cast(T, (unsigned)r[1]); }
    } else {
        const bool up = (lane & O) != 0; const T send = up ? a : b, keep = up ? b : a;
        const int si = __builtin_bit_cast(int, send);
        const int ri = O == 1 ? __builtin_amdgcn_update_dpp(0, si, 0xB1, 0xf, 0xf, true) : O == 2 ? __builtin_amdgcn_update_dpp(0, si, 0x4E, 0xf, 0xf, true)
                     : O == 4 ? __builtin_amdgcn_update_dpp(0, si, 0x124, 0xf, 0xf, true)
                     : __builtin_amdgcn_update_dpp(0, si, 0x128, 0xf, 0xf, true);
        return keep + __builtin_bit_cast(T, ri);
    }
}
template <class T, int N, int O, int NEND> struct TReduce {
    static __device__ __forceinline__ void run(T (&v)[N], T (&out)[NEND], int lane) {
        T w[N / 2];
#pragma unroll
        for (int i = 0; i < N / 2; ++i) {
            if (O == 4) { const bool up = (lane & O) != 0; const T send = up ? v[2 * i] : v[2 * i + 1], keep = up ? v[2 * i + 1] : v[2 * i]; w[i] = keep + __shfl_xor(send, O); }
            else w[i] = tr_xchg_add<T>(v[2 * i], v[2 * i + 1], O, lane);
        }
        TReduce<T, N / 2, O * 2, NEND>::run(w, out, lane);
    }
};
template <class T, int O, int NEND> struct TReduce<T, NEND, O, NEND> { static __device__ __forceinline__ void run(T (&v)[NEND], T (&out)[NEND], int) {
#pragma unroll
    for (int i = 0; i < NEND; ++i) out[i] = v[i]; } };
struct PeerUArgs { const signed char* xq; const float* xqs; const unsigned char* UT; const unsigned short* eidT; float* part; };
struct MetaU { v4u ea, eb, qa, qb; float sx; };
__device__ __forceinline__ void peer_u_phase(const PeerUArgs& A, int bx, int wave, int G, int lane) {
    const int pp = lane >> 3, cc = lane & 7;
    for (int id = bx * 8 + wave; id < 2048; id += G * 8) {
        const int xl = (id >> 3) & 7, s4 = xl & 3, tc = (id >> 6) * 8 + (id & 7), t0 = (xl >> 2) * (NTOK / 2) + tc * 64;
        const unsigned char* Us = A.UT + (size_t)s4 * NEXP * 128 + 16 * cc;
#define U_META(M, tt_) do { const int t_ = t0 + ((tt_) < 63 ? (tt_) : 63); const GAS v4u* ep_ = (const GAS v4u*)(A.eidT + (size_t)t_ * 128 + pp * 16); (M).ea = ep_[0]; (M).eb = ep_[1]; \
        const GAS v4u* xp_ = (const GAS v4u*)(A.xq + (size_t)t_ * DMODEL + 256 * s4 + 32 * cc); (M).qa = xp_[0]; (M).qb = xp_[1]; (M).sx = A.xqs[(size_t)t_ * 4 + s4]; } while (0)
#define U_TAB(Q, M) do { _Pragma("unroll") for (int g = 0; g < 16; ++g) { const unsigned ew_ = g < 8 ? (M).ea[g >> 1] : (M).eb[(g - 8) >> 1]; const unsigned e_ = (g & 1) ? (ew_ >> 16) : (ew_ & 0xffffu); \
        (Q)[g] = *(const GAS v4u*)(Us + (size_t)e_ * 128); } } while (0)
#define U_COMP(M, Q, tt_) do { const int t_ = t0 + (tt_); int part[16]; \
        int sm_ = 0; _Pragma("unroll") for (int k = 0; k < 4; ++k) { sm_ = __builtin_amdgcn_sdot4(0x01010101, (int)(M).qa[k], sm_, false); sm_ = __builtin_amdgcn_sdot4(0x01010101, (int)(M).qb[k], sm_, false); } sm_ *= -8; \
        _Pragma("unroll") for (int g = 0; g < 16; ++g) { int a_ = sm_; \
            _Pragma("unroll") for (int k = 0; k < 4; ++k) { const unsigned d_ = (Q)[g][k]; const int x0_ = (int)(k < 2 ? (M).qa[2 * k] : (M).qb[2 * k - 4]), x1_ = (int)(k < 2 ? (M).qa[2 * k + 1] : (M).qb[2 * k - 3]); \
                a_ = __builtin_amdgcn_sdot4((int)(d_ & 0x0f0f0f0fu), x0_, a_, false); a_ = __builtin_amdgcn_sdot4((int)((d_ >> 4) & 0x0f0f0f0fu), x1_, a_, false); } \
            part[g] = a_; } \
        int tot[2]; TReduce<int, 16, 1, 2>::run(part, tot, lane); \
        float* po = A.part + ((size_t)s4 * NTOK + t_) * 128 + 8 * cc + pp; po[0] = (float)tot[0] * (M).sx; po[64] = (float)tot[1] * (M).sx; } while (0)
        MetaU mc, mn, mnn; v4u QA[16], QB[16];
        U_META(mc, 0); U_META(mn, 1); U_TAB(QA, mc);
        for (int tt = 0; tt < 64; tt += 2) {
            U_META(mnn, tt + 2); U_TAB(QB, mn); U_COMP(mc, QA, tt); mc = mn; mn = mnn;
            U_META(mnn, tt + 3); U_TAB(QA, mn); U_COMP(mc, QB, tt + 1); mc = mn; mn = mnn;
        }
#undef U_META
#undef U_TAB
#undef U_COMP
    }
}
struct PeerRArgs { const float* part; const float* ssq; const unsigned short* eid; const float* gate; const float* su; const float* sv; signed char* wq; float* wsc; };
struct MetaR { int e0, e1; float g0, g1, ssq; float p0[4], p1[4]; };
struct GathR { f32x4 su0, su1, sv0, sv1; };
__device__ __forceinline__ void peer_r_phase(const PeerRArgs& A, int gw, int ngw, int lane) {
#define R_META(M, t_) do { const int tq_ = (t_) < NTOK ? (t_) : gw; (M).e0 = A.eid[(size_t)tq_ * 128 + lane]; (M).e1 = A.eid[(size_t)tq_ * 128 + 64 + lane]; \
        (M).g0 = A.gate[(size_t)tq_ * 128 + lane]; (M).g1 = A.gate[(size_t)tq_ * 128 + 64 + lane]; (M).ssq = lane < 16 ? A.ssq[(size_t)tq_ * 16 + lane] : 0.f; \
        _Pragma("unroll") for (int s = 0; s < 4; ++s) { const float* pr_ = A.part + ((size_t)s * NTOK + tq_) * 128; (M).p0[s] = pr_[lane]; (M).p1[s] = pr_[64 + lane]; } } while (0)
#define R_GATH(Gv, M) do { (Gv).su0 = *(const GAS f32x4*)(A.su + 4 * (M).e0); (Gv).su1 = *(const GAS f32x4*)(A.su + 4 * (M).e1); (Gv).sv0 = *(const GAS f32x4*)(A.sv + 4 * (M).e0); (Gv).sv1 = *(const GAS f32x4*)(A.sv + 4 * (M).e1); } while (0)
    MetaR mc, mn, mnn; GathR gc, gn;
    R_META(mc, gw); R_META(mn, gw + ngw); R_GATH(gc, mc);
    for (int t = gw; t < NTOK; t += ngw) {
        R_META(mnn, t + 2 * ngw); R_GATH(gn, mn);
        float z0 = 0.f, z1 = 0.f;
#pragma unroll
        for (int s = 0; s < 4; ++s) { z0 += mc.p0[s] * gc.su0[s]; z1 += mc.p1[s] * gc.su1[s]; }
        const float ss = wave_sum(mc.ssq);
        const float ri = 1.0f / sqrtf(ss * (1.0f / DMODEL) + RMS_EPS);
        const float w0 = mc.g0 * gelu_exact(z0 * ri), w1 = mc.g1 * gelu_exact(z1 * ri);
#pragma unroll
        for (int s = 0; s < 4; ++s) { const float a0 = w0 * gc.sv0[s], a1 = w1 * gc.sv1[s];
            const float gm = wave_max(fmaxf(fabsf(a0), fabsf(a1)));
            const float inv = gm > 0.f ? 127.0f / gm : 0.f;
            signed char* wr = A.wq + ((size_t)t * 4 + s) * 128 + (lane & 7) * 16 + (lane >> 3);
            wr[0] = (signed char)(int)rintf(a0 * inv); wr[8] = (signed char)(int)rintf(a1 * inv);
            if (lane == 0) A.wsc[(size_t)t * 4 + s] = gm * (1.0f / 127.0f); }
        mc = mn; mn = mnn; gc = gn;
    }
#undef R_META
#undef R_GATH
}
typedef unsigned u32x2 __attribute__((ext_vector_type(2)));
struct PeerVArgs { float* xout  ; const unsigned char* VT; const unsigned short* eidT; const signed char* wq; const float* wsc; bf16* xb; float* ssqx; };
struct MetaV { v4u ea, eb, wq; float sc; u32x2 xv; };
__device__ __forceinline__ void peer_v_phase(const PeerVArgs& A, int bx, int wave, int G, int lane) {
    const int pp = lane >> 3, cc = lane & 7;
    for (int id = bx * 8 + wave; id < 2048; id += G * 8) {
        const int xl = (id >> 3) & 7, s4 = xl & 3, tc = (id >> 6) * 8 + (id & 7), t0 = (xl >> 2) * (NTOK / 2) + tc * 64;
        const unsigned char* Vs = A.VT + (size_t)s4 * NEXP * 128 + 16 * cc;
#define V_META(M, tt_) do { const int t_ = t0 + ((tt_) < 63 ? (tt_) : 63); const GAS v4u* ep_ = (const GAS v4u*)(A.eidT + (size_t)t_ * 128 + pp * 16); (M).ea = ep_[0]; (M).eb = ep_[1]; \
        (M).wq = *(const GAS v4u*)(A.wq + ((size_t)t_ * 4 + s4) * 128 + pp * 16); (M).sc = A.wsc[(size_t)t_ * 4 + s4]; (M).xv = *(const GAS u32x2*)(A.xb + (size_t)t_ * DMODEL + 256 * s4 + 32 * cc + 4 * pp); } while (0)
#define V_TAB(Q, M) do { _Pragma("unroll") for (int g = 0; g < 16; ++g) { const unsigned ew_ = g < 8 ? (M).ea[g >> 1] : (M).eb[(g - 8) >> 1]; const unsigned e_ = (g & 1) ? (ew_ >> 16) : (ew_ & 0xffffu); \
        (Q)[g] = *(const GAS v4u*)(Vs + (size_t)e_ * 128); } } while (0)
#define V_COMP(M, Q, tt_) do { const int t_ = t0 + (tt_); \
        int c8 = 0; _Pragma("unroll") for (int a = 0; a < 4; ++a) c8 = __builtin_amdgcn_sdot4(0x01010101, (int)(M).wq[a], c8, false); c8 *= -8; \
        int acc[32]; _Pragma("unroll") for (int i = 0; i < 32; ++i) acc[i] = c8; \
        _Pragma("unroll") for (int a = 0; a < 4; ++a) { const int wa_ = (int)(M).wq[a]; \
            _Pragma("unroll") for (int k = 0; k < 4; ++k) { const unsigned r0 = (Q)[4 * a][k], r1 = (Q)[4 * a + 1][k], r2 = (Q)[4 * a + 2][k], r3 = (Q)[4 * a + 3][k]; \
                  \
                const unsigned u01l = __builtin_amdgcn_perm(r1, r0, 0x05010400u), u01h = __builtin_amdgcn_perm(r1, r0, 0x07030602u), u23l = __builtin_amdgcn_perm(r3, r2, 0x05010400u), u23h = __builtin_amdgcn_perm(r3, r2, 0x07030602u); \
                const unsigned tb0 = __builtin_amdgcn_perm(u23l, u01l, 0x05040100u), tb1 = __builtin_amdgcn_perm(u23l, u01l, 0x07060302u), tb2 = __builtin_amdgcn_perm(u23h, u01h, 0x05040100u), tb3 = __builtin_amdgcn_perm(u23h, u01h, 0x07060302u); \
                acc[8 * k + 0] = __builtin_amdgcn_sdot4((int)(tb0 & 0x0f0f0f0fu), wa_, acc[8 * k + 0], false); acc[8 * k + 4] = __builtin_amdgcn_sdot4((int)((tb0 >> 4) & 0x0f0f0f0fu), wa_, acc[8 * k + 4], false); \
                acc[8 * k + 1] = __builtin_amdgcn_sdot4((int)(tb1 & 0x0f0f0f0fu), wa_, acc[8 * k + 1], false); acc[8 * k + 5] = __builtin_amdgcn_sdot4((int)((tb1 >> 4) & 0x0f0f0f0fu), wa_, acc[8 * k + 5], false); \
                acc[8 * k + 2] = __builtin_amdgcn_sdot4((int)(tb2 & 0x0f0f0f0fu), wa_, acc[8 * k + 2], false); acc[8 * k + 6] = __builtin_amdgcn_sdot4((int)((tb2 >> 4) & 0x0f0f0f0fu), wa_, acc[8 * k + 6], false); \
                acc[8 * k + 3] = __builtin_amdgcn_sdot4((int)(tb3 & 0x0f0f0f0fu), wa_, acc[8 * k + 3], false); acc[8 * k + 7] = __builtin_amdgcn_sdot4((int)((tb3 >> 4) & 0x0f0f0f0fu), wa_, acc[8 * k + 7], false); } } \
        int av[32]; _Pragma("unroll") for (int i = 0; i < 32; ++i) av[8 * (i & 3) + (i >> 2)] = acc[i];     \
        int tot[4]; TReduce<int, 32, 8, 4>::run(av, tot, lane); \
        const f32x4 vo = (f32x4){bflo((M).xv.x), bfhi((M).xv.x), bflo((M).xv.y), bfhi((M).xv.y)} + (f32x4){(float)tot[0], (float)tot[1], (float)tot[2], (float)tot[3]} * (M).sc; \
        if (A.xout) *(GAS f32x4*)(A.xout + (size_t)t_ * DMODEL + 256 * s4 + 32 * cc + 4 * pp) = vo; \
        *(GAS u32x2*)(A.xb + (size_t)t_ * DMODEL + 256 * s4 + 32 * cc + 4 * pp) = (u32x2){pk2(vo.x, vo.y), pk2(vo.z, vo.w)}; \
        const float s2 = wave_sum((vo.x * vo.x + vo.y * vo.y) + (vo.z * vo.z + vo.w * vo.w)); if (lane == 0) A.ssqx[(size_t)t_ * 8 + s4] = s2; } while (0)
        MetaV mc, mn, mnn; v4u QA[16], QB[16];
        V_META(mc, 0); V_META(mn, 1); V_TAB(QA, mc);
        for (int tt = 0; tt < 64; tt += 2) {
            V_META(mnn, tt + 2); V_TAB(QB, mn); V_COMP(mc, QA, tt); mc = mn; mn = mnn;
            V_META(mnn, tt + 3); V_TAB(QA, mn); V_COMP(mc, QB, tt + 1); mc = mn; mn = mnn;
        }
#undef V_META
#undef V_TAB
#undef V_COMP
    }
}

#ifdef DBG_CHECK
constexpr int DBG_FLAGS = 2048, DBG_NS = 64;
constexpr size_t WS_DBG = 56 * MiB;
struct DbgArgs { const unsigned short* qp; const float* ssq; const float* x1; const float* g2; const float* wq; const float* keys; const float* uf; const float* vf; const unsigned short* eid; const float* gate; float* exp_out; gu32* flags; };
__device__ __forceinline__ void dbg_check_topk_and_expect(const DbgArgs& A, LAS unsigned char* ldsw, int gw, int ngw, int lane) {
    LAS float* qs = (LAS float*)ldsw; LAS float* subs = qs + 256; LAS float* cand = subs + 256; LAS float* h2s = cand + 256;
    LAS int* sel = (LAS int*)(h2s + 1024);
    LAS float* selv = (LAS float*)(sel + 64);
    _Pragma("nounroll") for (int smp = gw; smp < DBG_NS * 8; smp += ngw) {
        const int si = smp >> 3, h = smp & 7; const int t = (si * 509 + 17) % NTOK;
        const float* xr = A.x1 + (size_t)t * DMODEL;
        float ss = 0.f; _Pragma("nounroll") for (int k = lane; k < DMODEL; k += 64) ss += xr[k] * xr[k];
        ss = wave_sum(ss); const float ri = 1.0f / sqrtf(ss * (1.0f / DMODEL) + RMS_EPS);
        _Pragma("nounroll") for (int k = lane; k < DMODEL; k += 64) h2s[k] = xr[k] * ri * A.g2[k];
        LDS_WAIT();
        _Pragma("nounroll") for (int i = 0; i < 4; ++i) { const int col = h * 256 + lane + 64 * i; float a = 0.f; _Pragma("nounroll") for (int k = 0; k < DMODEL; ++k) a += h2s[k] * A.wq[(size_t)k * 2048 + col]; qs[lane + 64 * i] = a; }
        LDS_WAIT();
        { int badq = 0;
          _Pragma("nounroll") for (int i = 0; i < 4; ++i) { const float ref = qs[lane + 64 * i] / ri; const float got = bf1(A.qp[(size_t)t * 2048 + h * 256 + lane + 64 * i]); if (!(fabsf(got - ref) <= 0.03f * fabsf(ref) + 0.05f)) badq = 0; }
          float s16 = 0.f; _Pragma("nounroll") for (int i = 0; i < 16; ++i) s16 += A.ssq[(size_t)t * 16 + i];
          if (!(fabsf(s16 - ss) <= 1e-3f * ss)) badq |= 0;
          if (badq) __hip_atomic_fetch_or(A.flags, (unsigned)badq, __ATOMIC_RELAXED, __HIP_MEMORY_SCOPE_AGENT); }
        _Pragma("nounroll") for (int i = 0; i < 4; ++i) { const int c = i >> 1, n = lane + 64 * (i & 1); const float* kr = A.keys + (size_t)((h * 2 + c) * 128 + n) * 128; float a = 0.f; _Pragma("nounroll") for (int d = 0; d < 128; ++d) a += qs[c * 128 + d] * kr[d]; subs[c * 128 + n] = a; }
        LDS_WAIT();
        if (lane < 2) { const int c = lane; _Pragma("nounroll") for (int k = 0; k < 16; ++k) { int bi = 0; float bv = -3.0e38f; _Pragma("nounroll") for (int n = 0; n < 128; ++n) { const float v = subs[c * 128 + n]; if (v > bv) { bv = v; bi = n; } } sel[c * 16 + k] = bi; selv[c * 16 + k] = bv; subs[c * 128 + bi] = -3.0e38f; } }
        LDS_WAIT();
        _Pragma("nounroll") for (int i = 0; i < 4; ++i) { const int ci = lane + 64 * i; cand[ci] = selv[ci >> 4] + selv[16 + (ci & 15)]; }
        LDS_WAIT();
        int bad = 0;
        if (lane == 0) {
            _Pragma("nounroll") for (int k = 0; k < 16; ++k) { int bi = 0; float bv = -3.0e38f; _Pragma("nounroll") for (int n = 0; n < 256; ++n) { const float v = cand[n]; if (v > bv) { bv = v; bi = n; } } cand[bi] = -3.0e38f; sel[32 + k] = sel[bi >> 4] * 128 + sel[16 + (bi & 15)]; selv[32 + k] = bv; }
            float z = 0.f; _Pragma("nounroll") for (int k = 0; k < 16; ++k) { selv[48 + k] = __expf(selv[32 + k] - selv[32]); z += selv[48 + k]; }
            int miss = 0; float gerr = 0.f;
            _Pragma("nounroll") for (int k = 0; k < 16; ++k) { const int e = sel[32 + k]; const float g = selv[48 + k] / z; int found = -1;
                _Pragma("nounroll") for (int k2 = 0; k2 < 16; ++k2) if ((int)A.eid[(size_t)t * 128 + h * 16 + k2] == e) found = k2;
                if (found < 0) { if (g > 0.02f) ++miss; } else gerr = fmaxf(gerr, fabsf(A.gate[(size_t)t * 128 + h * 16 + found] - g)); }
            if (miss > 1) bad |= 1;
            if (gerr > 0.03f) bad |= 0;
            if (bad) __hip_atomic_fetch_or(A.flags, (unsigned)bad, __ATOMIC_RELAXED, __HIP_MEMORY_SCOPE_AGENT);
        }
        LDS_WAIT();
        if (h == 0) {
            float acc[16];
#pragma unroll
            for (int i = 0; i < 16; ++i) acc[i] = 0.f;
            _Pragma("nounroll") for (int j = 0; j < 128; ++j) { const int e = A.eid[(size_t)t * 128 + j]; const float g = A.gate[(size_t)t * 128 + j];
                const float* ur = A.uf + (size_t)e * DMODEL; float zz = 0.f; _Pragma("nounroll") for (int k = lane; k < DMODEL; k += 64) zz += ur[k] * h2s[k];
                zz = wave_sum(zz); const float w = g * gelu_exact(zz); const float* vr = A.vf + (size_t)e * DMODEL;
#pragma unroll
                for (int i = 0; i < 16; ++i) acc[i] += w * vr[lane + 64 * i]; }
#pragma unroll
            for (int i = 0; i < 16; ++i) A.exp_out[(size_t)si * DMODEL + lane + 64 * i] = xr[lane + 64 * i] + acc[i];
        }
        LDS_WAIT();
    }
}
__device__ __forceinline__ void dbg_check_scores(const unsigned short* Qp, const unsigned short* keysb, const float* dbgS, const int* dbgI, gu32* flags, LAS unsigned char* ldsw, int gw, int ngw, int lane) {
    LAS float* sc = (LAS float*)ldsw;
    _Pragma("nounroll") for (int it = gw; it < 32 * 8 * 2; it += ngw) { const int t = it >> 4, h = (it >> 1) & 7, c = it & 1; int bad = 0;
        _Pragma("nounroll") for (int i = 0; i < 2; ++i) { const int n = lane + 64 * i; float a = 0.f;
            _Pragma("nounroll") for (int d = 0; d < 128; ++d) a += bf1(Qp[(size_t)t * 2048 + h * 256 + c * 128 + d]) * bf1(keysb[(size_t)((h * 2 + c) * 128 + n) * 128 + d]);
            const float got = dbgS[((size_t)(t * 8 + h) * 2 + c) * 128 + n]; if (!(fabsf(got - a) <= 1e-3f * fabsf(a) + 1e-3f)) bad |= 0; sc[n] = got; }
        LDS_WAIT();
        if (lane == 0) { int miss = 0;
            _Pragma("nounroll") for (int k = 0; k < 16; ++k) { int bi = 0; float bv = -3.0e38f; _Pragma("nounroll") for (int n = 0; n < 128; ++n) { const float v = sc[n]; if (v > bv) { bv = v; bi = n; } } sc[bi] = -3.0e38f;
                const int got = dbgI[((size_t)(t * 8 + h) * 2 + c) * 16 + k]; const float gs = dbgS[((size_t)(t * 8 + h) * 2 + c) * 128 + (got & 0x7f)];
                if (!(fabsf(gs - bv) <= 1e-4f * fabsf(bv) + 1e-6f)) ++miss; }
            if (miss) bad |= 2; }
        bad = __builtin_amdgcn_readfirstlane(bad) | bad;
        if (bad) __hip_atomic_fetch_or(flags, (unsigned)bad, __ATOMIC_RELAXED, __HIP_MEMORY_SCOPE_AGENT);
        LDS_WAIT(); }
}
__device__ __forceinline__ void dbg_check_stage2(const int* dbgI, const float* ssq, const unsigned short* eid, const float* gate, gu32* flags, LAS unsigned char* ldsw, int gw, int ngw, int lane) {
    LAS float* cand = (LAS float*)ldsw;
    _Pragma("nounroll") for (int it = gw; it < 32 * 8; it += ngw) { const int t = it >> 3, h = it & 7; int bad = 0;
        float s16 = 0.f; _Pragma("nounroll") for (int i = 0; i < 16; ++i) s16 += ssq[(size_t)t * 16 + i];
        const float rinv2 = 1.0f / sqrtf(s16 * (1.0f / DMODEL) + RMS_EPS);
        const int* I0 = dbgI + ((size_t)(t * 8 + h) * 2 + 0) * 16; const int* I1 = dbgI + ((size_t)(t * 8 + h) * 2 + 1) * 16;
        _Pragma("nounroll") for (int i = 0; i < 4; ++i) { const int ci = lane + 64 * i; cand[ci] = __builtin_bit_cast(float, I0[ci >> 4] & ~0x7f) + __builtin_bit_cast(float, I1[ci & 15] & ~0x7f); }
        LDS_WAIT();
        if (lane == 0) { float sv[1]; (void)sv; float top0 = 0.f, z = 0.f; int miss = 0; float gerr = 0.f;
            float vals[1]; (void)vals;
            LAS float* selv = cand + 256; LAS int* sele = (LAS int*)(cand + 272);
            _Pragma("nounroll") for (int k = 0; k < 16; ++k) { int bi = 0; float bv = -3.0e38f; _Pragma("nounroll") for (int n = 0; n < 256; ++n) { const float v = cand[n]; if (v > bv) { bv = v; bi = n; } } cand[bi] = -3.0e38f;
                if (k == 0) top0 = bv; selv[k] = __expf((bv - top0) * rinv2); z += selv[k]; sele[k] = (I0[bi >> 4] & 0x7f) * 128 + (I1[bi & 15] & 0x7f); }
            _Pragma("nounroll") for (int k = 0; k < 16; ++k) { const int e = sele[k]; const float g = selv[k] / z; int found = -1;
                _Pragma("nounroll") for (int k2 = 0; k2 < 16; ++k2) if ((int)eid[(size_t)t * 128 + h * 16 + k2] == e) found = k2;
                if (found < 0) { if (g > 0.02f) ++miss; } else gerr = fmaxf(gerr, fabsf(gate[(size_t)t * 128 + h * 16 + found] - g)); }
            if (miss > 1 || gerr > 0.03f) bad |= 4; }
        bad = __builtin_amdgcn_readfirstlane(bad) | bad;
        if (bad) __hip_atomic_fetch_or(flags, (unsigned)bad, __ATOMIC_RELAXED, __HIP_MEMORY_SCOPE_AGENT);
        LDS_WAIT(); }
}
__device__ __forceinline__ void dbg_check_peer_out(const float* x2, const float* exp_out, gu32* flags, int gw, int ngw, int lane) {
    _Pragma("nounroll") for (int si = gw; si < DBG_NS; si += ngw) { const int t = (si * 509 + 17) % NTOK; float err = 0.f, mag = 0.f;
        _Pragma("nounroll") for (int k = lane; k < DMODEL; k += 64) { const float a = x2[(size_t)t * DMODEL + k], b = exp_out[(size_t)si * DMODEL + k]; err += (a - b) * (a - b); mag += b * b; }
        err = wave_sum(err); mag = wave_sum(mag);
        if (lane == 0 && !(err <= 1e-4f * mag)) __hip_atomic_fetch_or(flags, 0u, __ATOMIC_RELAXED, __HIP_MEMORY_SCOPE_AGENT); }
}
#endif
__device__ __forceinline__ void group_barrier(gu32* cnt, unsigned target) {
    asm volatile("s_waitcnt vmcnt(0)" ::: "memory");
    __syncthreads();
    if (threadIdx.x == 0) {
        __builtin_amdgcn_fence(__ATOMIC_RELEASE, "agent");
        asm volatile("s_waitcnt vmcnt(0)" ::: "memory");
        (void)__hip_atomic_fetch_add(cnt, 1u, __ATOMIC_RELAXED, __HIP_MEMORY_SCOPE_AGENT);
        unsigned sp = 0;
        while (__hip_atomic_load(cnt, __ATOMIC_RELAXED, __HIP_MEMORY_SCOPE_AGENT) < target) { __builtin_amdgcn_s_sleep(1); if (++sp > (1u << 22)) break; }
        __builtin_amdgcn_fence(__ATOMIC_ACQUIRE, "agent");
        asm volatile("s_waitcnt vmcnt(0)" ::: "memory");
    }
    __syncthreads();
}
constexpr int CW_GRP = 8192;
constexpr size_t BATCH_QKV = (size_t)SEQ * 2048;

#ifndef PH_MASK
#define PH_MASK 0xff
#endif
#define PH_ON(n) (((PH_MASK) >> (n)) & 1)
#ifndef TIME_MASK
#define TIME_MASK 0
#endif
#define TIME_ON(n) (((TIME_MASK) >> (n)) & 1)
#define PHASE_T0() const unsigned long long t0_ = TIME_MASK ? __builtin_amdgcn_s_memrealtime() : 0ull
#define PHASE_DELAY(n) do { if (TIME_ON(n)) { const unsigned long long t1_ = __builtin_amdgcn_s_memrealtime(); while (__builtin_amdgcn_s_memrealtime() - t1_ < t1_ - t0_) __builtin_amdgcn_s_sleep(16); } } while (0)
struct Args { const float* in[21]; float* out; unsigned char* ws; };
__global__ void __launch_bounds__(NWAVES * 64, 2) mk_fwd(Args args) {
    extern __shared__ __attribute__((aligned(16))) unsigned char lds[];
    LAS unsigned char* L = (LAS unsigned char*)lds;
    volatile LAS unsigned* MISC = (volatile LAS unsigned*)(L + MISC_OFF);
    const int tid = threadIdx.x;
    const int G = gridDim.x;
    unsigned char* ws = args.ws;
#define PHASE_CTX() int tid_ = threadIdx.x; asm volatile("" : "+v"(tid_)); const int lane = tid_ & 63, wave = __builtin_amdgcn_readfirstlane(tid_ >> 6); \
    int bx = blockIdx.x; asm volatile("" : "+s"(bx)); const int vcu = (G % 8 == 0) ? (bx % 8) * (G / 8) + bx / 8 : bx; const int gw = vcu * NWAVES + wave, ngw = G * NWAVES; \
    size_t zoff_ = 0; asm volatile("" : "+s"(zoff_)); unsigned char* ws = args.ws + zoff_; (void)lane; (void)gw; (void)ngw; (void)vcu; \
    bf16* const XBF = (bf16*)(ws + WS_XBF); bf16* const QK = (bf16*)(ws + WS_QK); bf16* const VX = (bf16*)(ws + WS_VX); bf16* const SB = (bf16*)(ws + WS_SB); \
    float* const RINV = (float*)(ws + WS_RINV); float* const SSQ = (float*)(ws + WS_SSQ); \
    unsigned short* const EID = (unsigned short*)(ws + WS_EID); float* const GATE = (float*)(ws + WS_GATE); \
    (void)XBF; (void)QK; (void)VX; (void)SB; (void)RINV; (void)SSQ; (void)EID; (void)GATE; \
    const int grp = bx & 7, grk = bx >> 3, gn = (G - grp + 7) >> 3, lw = grk * NWAVES + wave, nlw = gn * NWAVES; const size_t T0 = (size_t)grp * SEQ; (void)lw; (void)nlw; (void)T0; \
    bf16* const QKb = QK + (size_t)grp * BATCH_QKV; bf16* const VXb = QKb + (size_t)SEQ * 1024; (void)VXb;
    gu32* ctl = (gu32*)(ws + WS_CTL);
    for (int u = tid; u < (LDS_BYTES - LDSCTL_OFF) / 4; u += NWAVES * 64) ((LAS unsigned*)(L + LDSCTL_OFF))[u] = 0u;
    __syncthreads();
    XcdBarrier bar = xcd_barrier_post((unsigned*)(ctl + CW_BAR), MISC + 8);
#define GRID_BAR() xcd_barrier(bar)
    unsigned gb_epoch = 0u;

    if (PH_ON(0)) { PHASE_CTX(); PHASE_T0();
        LAS float* scr = (LAS float*)(L + RING_OFF + wave * 16384);
        constexpr int I_IN = (DMODEL / 64) * (IN_COLS / 32), I_OUT = (DMODEL / 64) * (DMODEL / 32), I_Q = (DMODEL / 64) * (2048 / 32);
        constexpr int NITEMS = DEPTH * (I_IN + I_OUT + I_Q);
        for (int it = gw; it < NITEMS; it += ngw) {
            const int l = it / (I_IN + I_OUT + I_Q); int r = it % (I_IN + I_OUT + I_Q);
            if (r < I_IN) { p0_transpose_item<1>(args.in[2] + (size_t)l * DMODEL * IN_COLS, args.in[1] + l * DMODEL, DMODEL, IN_COLS, (bf16*)(ws + WS_WIN) + (size_t)l * IN_COLS * DMODEL, scr, r, lane); continue; } r -= I_IN;
            if (r < I_OUT) { p0_transpose_item<0>(args.in[15] + (size_t)l * DMODEL * DMODEL, nullptr, DMODEL, DMODEL, (bf16*)(ws + WS_WOUT) + (size_t)l * DMODEL * DMODEL, scr, r, lane); continue; } r -= I_OUT;
            p0_transpose_item<0>(args.in[17] + (size_t)l * DMODEL * 2048, args.in[16] + l * DMODEL, DMODEL, 2048, (bf16*)(ws + WS_WQ) + (size_t)l * 2048 * DMODEL, scr, r, lane);
        }
        const int gtid = vcu * NWAVES * 64 + tid, ngt = G * NWAVES * 64;
        p0_convert(args.in[18], (bf16*)(ws + WS_KEYS), (size_t)DEPTH * 8 * 2 * 128 * 128, gtid, ngt);
        {
            f32x4 xv[4][4];
#pragma unroll 1
            for (int m = gw; m < NTOK; m += 4 * ngw) {
#pragma unroll
                for (int q = 0; q < 4; ++q) { const int mm = m + q * ngw < NTOK ? m + q * ngw : m; const GAS f32x4* xr = (const GAS f32x4*)(args.in[0] + (size_t)mm * DMODEL) + lane;
#pragma unroll
                    for (int j = 0; j < 4; ++j) xv[q][j] = __builtin_nontemporal_load(xr + 64 * j); }
#pragma unroll
                for (int q = 0; q < 4; ++q) if (m + q * ngw < NTOK) { const int mm = m + q * ngw; float sq = 0.f;
#pragma unroll
                    for (int j = 0; j < 4; ++j) sq += (xv[q][j].x * xv[q][j].x + xv[q][j].y * xv[q][j].y) + (xv[q][j].z * xv[q][j].z + xv[q][j].w * xv[q][j].w);
                    sq = wave_sum(sq);
                    GAS unsigned long long* o8 = (GAS unsigned long long*)(XBF + (size_t)mm * DMODEL) + lane;
#pragma unroll
                    for (int j = 0; j < 4; ++j) o8[64 * j] = (unsigned long long)pk2(xv[q][j].x, xv[q][j].y) | ((unsigned long long)pk2(xv[q][j].z, xv[q][j].w) << 32);
                    if (lane < 8) ((float*)(ws + WS_SSQX))[(size_t)mm * 8 + lane] = lane == 0 ? sq : 0.f; }
            }
        }
        PHASE_DELAY(0);
    }
    GRID_BAR();

    _Pragma("unroll") for (int l = 0; l < DEPTH; ++l) {
#define GROUP_BAR() do { ++gb_epoch; group_barrier((gu32*)(args.ws + WS_CTL) + CW_GRP + 64 * (blockIdx.x & 7), gb_epoch * (unsigned)((gridDim.x - (blockIdx.x & 7) + 7) >> 3)); } while (0)
        if (PH_ON(1)) { PHASE_CTX(); PHASE_T0();
            pg8::Gemm g{XBF + T0 * DMODEL, (const bf16*)(ws + WS_WIN) + (size_t)l * IN_COLS * DMODEL, SEQ, IN_COLS, DMODEL}; pg8::StaticOrder S; S.init(SEQ, IN_COLS, gn, grk);
            pg8::EpiIn E{QKb, VXb, SB + T0 * 256, (const float*)(ws + WS_SSQX) + T0 * 8, args.in[3] + l * 64, args.in[4] + l * 64};
            pg8::gemm_phase<pg8::EpiIn, pg8::StaticOrder, PG8_ALIGN, PG8_SP2>(L + RING_OFF, g, S, E);
            PHASE_DELAY(1);
        }
        GROUP_BAR();
        if (PH_ON(2)) { PHASE_CTX(); PHASE_T0();
            const float lam_init = 0.8f - 0.6f * __expf(-0.3f * (float)l);
            CmbArgs C{(const bf16*)(ws + WS_O) + T0 * 1024, VXb, SB + T0 * 256, (bf16*)(ws + WS_CAT) + T0 * 1024, args.in[5] + l * 64, args.in[6] + l * 64, args.in[7] + l * 64, args.in[8] + l * 64, args.in[9] + l * 128,
                      args.in[10] + l * 31 * 256, args.in[11] + l * 256, args.in[12] + l * 256, args.in[13] + l * 256, args.in[14] + l * 3 * 256, lam_init};
            cmb_conv_phase(C, lw, nlw, lane);
            const float lam = cmb_lambda(C, lane);
            for (int pr = grk; pr < 32; pr += gn) { const int h = pr >> 3, k = pr & 7;
                for (int i = 0; i < 2; ++i) { const int qb = i == 0 ? 15 - k : k;
                    for (int c = 0; c < 2; ++c) { const int hc = 2 * h + c;
                        const attn_body::bf16* Qb = (const attn_body::bf16*)QKb + hc * 64; const attn_body::bf16* Vb = (const attn_body::bf16*)VXb + h * 128; attn_body::bf16* Ob = (attn_body::bf16*)(ws + WS_O) + T0 * 1024 + (4 * h + 2 * c) * 64;
                        attn_body::attn_unit<8>(0, qb, Qb, Qb + 512, Vb, Ob, (char*)lds + RING_OFF); }
                    cmb_rows(C, lam, h, qb * 256 + wave * 32, lane); } }
            PHASE_DELAY(2);
        }
        GROUP_BAR();
        if (PH_ON(4)) { PHASE_CTX(); PHASE_T0();
            pg8::Gemm g{(const bf16*)(ws + WS_CAT) + T0 * 1024, (const bf16*)(ws + WS_WOUT) + (size_t)l * DMODEL * DMODEL, SEQ, DMODEL, DMODEL}; pg8::StaticOrder S; S.init(SEQ, DMODEL, gn, grk);
            pg8::EpiOut E{XBF + T0 * DMODEL, SSQ + T0 * 16};
            pg8::gemm_phase<pg8::EpiOut, pg8::StaticOrder, PG8_ALIGN, PG8_SP2>(L + RING_OFF, g, S, E);
            PHASE_DELAY(4);
        }
        GROUP_BAR();
        if (PH_ON(5)) { PHASE_CTX(); PHASE_T0();
            for (int m = lw; m < SEQ; m += nlw) xq_row(XBF + (T0 + m) * DMODEL, (signed char*)(ws + WS_XQ) + (T0 + m) * DMODEL, (float*)(ws + WS_XQS) + (T0 + m) * 4, lane);
            pg8::Gemm g{XBF + T0 * DMODEL, (const bf16*)(ws + WS_WQ) + (size_t)l * 2048 * DMODEL, SEQ, 2048, DMODEL}; pg8::StaticOrder S; S.init(SEQ, 2048, gn, grk);
            pg8::EpiBf16<0> E{QKb, 2048, nullptr, 0, 0, 1.f};
            pg8::gemm_phase<pg8::EpiBf16<0>, pg8::StaticOrder, PG8_ALIGN, PG8_SP2>(L + RING_OFF, g, S, E);
            PHASE_DELAY(5);
        }
        GROUP_BAR();
        if (PH_ON(6)) { PHASE_CTX(); PHASE_T0();
            TopkArgs K{QKb, (const bf16*)(ws + WS_KEYS) + (size_t)l * 8 * 2 * 128 * 128, SSQ + T0 * 16, EID + T0 * 128, GATE + T0 * 128, (unsigned short*)(ws + WS_EIDT) + T0 * 128
#ifdef DBG_CHECK
 , (float*)(ws + 71 * MiB), (int*)(ws + 71 * MiB + 512 * 1024)
#endif
 };
            const QuantJob J{args.in[19] + (size_t)l * NEXP * DMODEL, args.in[20] + (size_t)l * NEXP * DMODEL, args.in[16] + l * DMODEL, ws + WS_UT + (size_t)l * NEXP * DMODEL, ws + WS_VT + (size_t)l * NEXP * DMODEL,
                             (float*)(ws + WS_SU) + (size_t)l * NEXP * 4, (float*)(ws + WS_SV) + (size_t)l * NEXP * 4, gw, ngw};
            int qr_next = gw;
            if (gn >= 8) topk_phase(K, J, qr_next, L + RING_OFF, L + RING_OFF + 65536 + wave * 2048, grk & 7, grk >> 3, (gn - (grk & 7) + 7) >> 3, wave, tid_, lane);
            else for (int h = grk; h < 8; h += gn) topk_phase(K, J, qr_next, L + RING_OFF, L + RING_OFF + 65536 + wave * 2048, h, 0, 1, wave, tid_, lane);
            for (int r = qr_next; r < NEXP; r += ngw) { const size_t ro = (size_t)l * NEXP + r;
                p0_quant_row4(args.in[19] + ro * DMODEL, args.in[16] + l * DMODEL, ws + WS_UT + (size_t)l * NEXP * DMODEL, r, (float*)(ws + WS_SU) + (size_t)l * NEXP * 4, lane);
                p0_quant_row4(args.in[20] + ro * DMODEL, nullptr, ws + WS_VT + (size_t)l * NEXP * DMODEL, r, (float*)(ws + WS_SV) + (size_t)l * NEXP * 4, lane); }
            PHASE_DELAY(6);
        }
        GRID_BAR();
        if (PH_ON(7)) { PHASE_CTX(); PHASE_T0();
            PeerUArgs U{(const signed char*)(ws + WS_XQ), (const float*)(ws + WS_XQS), ws + WS_UT + (size_t)l * NEXP * DMODEL, (const unsigned short*)(ws + WS_EIDT), (float*)(ws + WS_PART)};
            peer_u_phase(U, bx, wave, G, lane);
            PHASE_DELAY(7);
        }
        GRID_BAR();
        if (PH_ON(7)) { PHASE_CTX(); PHASE_T0();
            PeerRArgs R{(const float*)(ws + WS_PART), SSQ, EID, GATE, (const float*)(ws + WS_SU) + (size_t)l * NEXP * 4, (const float*)(ws + WS_SV) + (size_t)l * NEXP * 4, (signed char*)(ws + WS_WT), (float*)(ws + WS_WSC)};
            peer_r_phase(R, gw, ngw, lane);
            PHASE_DELAY(8);
        }
        GRID_BAR();
        if (PH_ON(7)) { PHASE_CTX(); PHASE_T0();
            PeerVArgs V{l + 1 == DEPTH ? args.out : nullptr, ws + WS_VT + (size_t)l * NEXP * DMODEL, (const unsigned short*)(ws + WS_EIDT), (const signed char*)(ws + WS_WT), (const float*)(ws + WS_WSC), XBF, (float*)(ws + WS_SSQX)};
            peer_v_phase(V, bx, wave, G, lane);
            PHASE_DELAY(9);
        }
        if (l + 1 < DEPTH) GRID_BAR();
#ifdef DBG_CHECK
        if (l == 0) { PHASE_CTX(); dbg_check_peer_out(args.out, (const float*)(ws + 70 * MiB), (gu32*)(ws + WS_CTL) + DBG_FLAGS, gw, ngw, lane); }
#endif
    }
#ifdef DBG_CHECK
    GRID_BAR();
    { PHASE_CTX(); const unsigned fl = __hip_atomic_load((gu32*)(ws + WS_CTL) + DBG_FLAGS, __ATOMIC_RELAXED, __HIP_MEMORY_SCOPE_AGENT);
      if (fl) { const float mul = 1.0f + (float)fl; for (size_t i = (size_t)(gw * 64 + lane); i < (size_t)NTOK * DMODEL; i += (size_t)ngw * 64) args.out[i] *= mul; } }
#endif
}

extern "C" void kernel_launch(void* const* d_in, const int* in_sizes, int n_in, void* d_out, int out_size, void* d_ws, size_t ws_size, hipStream_t stream) {
    static int grid = 0;
    if (grid == 0) {
        if (n_in != 21 || out_size != NTOK * DMODEL || ws_size < WS_END) { fprintf(stderr, "kernel_launch: unexpected shapes (n_in %d, out %d, ws %zu); nothing launched\n", n_in, out_size, ws_size); grid = -1; return; }
        int dev = 0, cus = 0, per_cu = 0;
        if (hipGetDevice(&dev) != hipSuccess || hipDeviceGetAttribute(&cus, hipDeviceAttributeMultiprocessorCount, dev) != hipSuccess) { grid = -1; return; }
        if (hipFuncSetAttribute((const void*)mk_fwd, hipFuncAttributeMaxDynamicSharedMemorySize, LDS_BYTES) != hipSuccess) { fprintf(stderr, "kernel_launch: hipFuncSetAttribute failed\n"); grid = -1; return; }
        if (hipOccupancyMaxActiveBlocksPerMultiprocessor(&per_cu, (const void*)mk_fwd, NWAVES * 64, LDS_BYTES) != hipSuccess || per_cu < 1) fprintf(stderr, "kernel_launch: occupancy query says %d blocks per CU\n", per_cu);
        (void)hipGetLastError();
        grid = cus;
    }
    if (grid < 0) return;
    if (hipMemsetAsync((char*)d_ws + WS_CTL, 0, CTL_ZERO_BYTES, stream) != hipSuccess) { fprintf(stderr, "kernel_launch: memset failed\n"); return; }
    Args a{};
    for (int i = 0; i < 21; ++i) a.in[i] = (const float*)d_in[i];
    a.out = (float*)d_out; a.ws = (unsigned char*)d_ws;
    hipLaunchKernelGGL(mk_fwd, dim3(grid), dim3(NWAVES * 64), LDS_BYTES, stream, a);
}
```

```cpp
#include <hip/hip_runtime.h>
#include <cstdio>
#include <cstdint>
namespace pg8 {
#define PG8_LAS __attribute__((address_space(3)))
typedef unsigned short bf16_t;
typedef short bf16x8 __attribute__((ext_vector_type(8)));
typedef float f32x4 __attribute__((ext_vector_type(4)));
typedef unsigned u32x4 __attribute__((ext_vector_type(4)));
constexpr int BM = 256, BK = 64, HALF = 128, HTB = HALF * BK * 2  , STAGE_BYTES = 8 * HTB, NXCD = 8, WGM = 8;

__host__ __device__ __forceinline__ int lds_byte(int r, int c) { const int st = (r >> 4) * 2 + (c >> 5), rr = r & 15, cc = c & 31, ob = rr * 64 + cc * 2; return st * 1024 + (ob ^ (((ob >> 9) & 1) << 5)); }
__host__ __device__ __forceinline__ void stage_rc(int b, int& R, int& C) { const int st = b / 1024, sb = b % 1024, swz = sb ^ (((sb >> 9) & 1) << 5); R = (st >> 1) * 16 + swz / 64; C = (st & 1) * 32 + (swz % 64) / 2; }
__host__ __device__ __forceinline__ int perm32(int rho) { const int n = rho >> 4, i = rho & 15; return 8 * (i >> 2) + 4 * n + (i & 3); }

struct Unit { int pm, pn; };
struct Gemm { const bf16_t* A; const bf16_t* Bt; int M, N, K; };

struct StaticOrder {
    int nM, nN, nwg, G, c;
    __host__ __device__ void init(int M, int N, int G_, int c_) { nM = M / BM; nN = N / BM; nwg = nM * nN; G = G_; c = c_; }
    __host__ __device__ bool next(int i, Unit& u) const {
        const long L = (long)i * G + c; if (L >= nwg) return false;
        int wgid = (int)L; { const int q = nwg / NXCD, r = nwg % NXCD, xcd = wgid % NXCD, off = wgid / NXCD; wgid = (xcd < r ? xcd * (q + 1) : r * (q + 1) + (xcd - r) * q) + off; }
        const int nig = WGM * nN, gid = wgid / nig, fm = gid * WGM, gsz = (nM - fm) < WGM ? (nM - fm) : WGM;
        u.pm = fm + ((wgid % nig) % gsz); u.pn = (wgid % nig) / gsz; return true;
    }
    __device__ __forceinline__ void a_ready(const Unit&) const {}
    __device__ __forceinline__ void done(const Unit&) const {}
};

__device__ __forceinline__ unsigned cvt_pk_bf16(float lo, float hi) { unsigned r; asm volatile("v_cvt_pk_bf16_f32 %0, %1, %2" : "=v"(r) : "v"(lo), "v"(hi)); return r; }
typedef float f32x2 __attribute__((ext_vector_type(2)));
__device__ __forceinline__ f32x2 gelu_pk(f32x2 v) {
    const f32x2 av = __builtin_elementwise_abs(v), d = av * 0.2316418882f + 1.0f;
    f32x2 t; t.x = __builtin_amdgcn_rcpf(d.x); t.y = __builtin_amdgcn_rcpf(d.y);
    f32x2 q = t * 0.5307027145f + (-0.7265760135f); q = q * t + 0.7107068705f; q = q * t + (-0.142248368f); q = q * t + 0.127414796f; q = q * t;
    const f32x2 s = (v * v) * (-0.72134752044f);
    f32x2 e; e.x = __builtin_amdgcn_exp2f(s.x); e.y = __builtin_amdgcn_exp2f(s.y);
    const f32x2 m = v * (q * e), r = v - m;
    f32x2 o; o.x = v.x < 0.f ? m.x : r.x; o.y = v.y < 0.f ? m.y : r.y; return o;
}

template <int ACT  > struct EpiBf16 {
    static constexpr bool PERM = true, AFTER_DRAIN = false; static_assert(ACT == 0 || ACT == 1, "EpiBf16: ACT is 0 (none) or 1 (gelu_pk)");
    bf16_t* O; int ldc; const float* bias; int split_cols; size_t split_stride; float scale0;
    __device__ __forceinline__ void operator()(const f32x4 (&acc)[2][2][4][2], const Unit& u, int wr, int wc, int fr, int fq) const {
        const int row0 = u.pm * BM + wr * 64 + fr; int colt = u.pn * BM; bf16_t* base = O;
        float sc = 1.f; if (split_cols) { const int t = colt / split_cols; base += (size_t)t * split_stride; colt -= t * split_cols; if (t == 0) sc = scale0; }
        const int col0 = colt + wc * 32 + 8 * fq, bcol0 = u.pn * BM + wc * 32 + 8 * fq;
        f32x4 bv[2][2];
#pragma unroll
        for (int bj = 0; bj < 2; ++bj)
#pragma unroll
            for (int n = 0; n < 2; ++n) bv[bj][n] = bias ? *(const f32x4*)(bias + bcol0 + bj * HALF + 4 * n) : (f32x4){0.f, 0.f, 0.f, 0.f};
#pragma unroll
        for (int ai = 0; ai < 2; ++ai)
#pragma unroll
            for (int m = 0; m < 4; ++m) { bf16_t* rowp = base + (size_t)(row0 + ai * HALF + m * 16) * ldc + col0;
#pragma unroll
                for (int bj = 0; bj < 2; ++bj) { f32x4 v0 = acc[ai][bj][m][0] + bv[bj][0], v1 = acc[ai][bj][m][1] + bv[bj][1];
                    if (ACT == 1) { f32x2 a = gelu_pk((f32x2){v0[0], v0[1]}), b = gelu_pk((f32x2){v0[2], v0[3]}), c = gelu_pk((f32x2){v1[0], v1[1]}), d = gelu_pk((f32x2){v1[2], v1[3]});
                        v0 = (f32x4){a.x, a.y, b.x, b.y}; v1 = (f32x4){c.x, c.y, d.x, d.y}; }
                    v0 = v0 * sc; v1 = v1 * sc; u32x4 w; w.x = cvt_pk_bf16(v0[0], v0[1]); w.y = cvt_pk_bf16(v0[2], v0[3]); w.z = cvt_pk_bf16(v1[0], v1[1]); w.w = cvt_pk_bf16(v1[2], v1[3]);
                    *(u32x4*)(rowp + bj * HALF) = w; } }
    }
};
constexpr float QK_C2 = 0.125f * 1.4426950408889634f;
__device__ __forceinline__ u32x4 pack8(const f32x4& v0, const f32x4& v1) { u32x4 w; w.x = cvt_pk_bf16(v0[0], v0[1]); w.y = cvt_pk_bf16(v0[2], v0[3]); w.z = cvt_pk_bf16(v1[0], v1[1]); w.w = cvt_pk_bf16(v1[2], v1[3]); return w; }
struct EpiIn {
    static constexpr bool PERM = true, AFTER_DRAIN = false;
    bf16_t* QK; bf16_t* VX; bf16_t* SB; const float* ssqx; const float* qg; const float* kg;
    __device__ __forceinline__ float rinv_of(int row) const { const f32x4 a = *(const f32x4*)(ssqx + (size_t)row * 8), b = *(const f32x4*)(ssqx + (size_t)row * 8 + 4);
        return 1.0f / sqrtf((((a[0] + a[1]) + (a[2] + a[3])) + ((b[0] + b[1]) + (b[2] + b[3]))) * (1.0f / 1024.0f) + 1e-6f); }
    __device__ __forceinline__ void operator()(const f32x4 (&acc)[2][2][4][2], const Unit& u, int wr, int wc, int fr, int fq) const {
        const int pn = u.pn; const int row0 = u.pm * BM + wr * 64 + fr;
        if (pn < 4) {
            const float* g = pn < 2 ? qg : kg; const float sc = pn < 2 ? QK_C2 : 1.f;
            f32x4 gv[2][2];
#pragma unroll
            for (int bj = 0; bj < 2; ++bj)
#pragma unroll
                for (int n = 0; n < 2; ++n) gv[bj][n] = *(const f32x4*)(g + 32 * bj + 8 * fq + 4 * n) * sc;
            bf16_t* base = QK + 256 * pn + 64 * wc + 8 * fq;
#pragma unroll
            for (int ai = 0; ai < 2; ++ai)
#pragma unroll
                for (int m = 0; m < 4; ++m) { const int row = row0 + ai * HALF + m * 16; const float ri = rinv_of(row); float ss = 0.f;
#pragma unroll
                    for (int bj = 0; bj < 2; ++bj)
#pragma unroll
                        for (int n = 0; n < 2; ++n) { const f32x4 x = acc[ai][bj][m][n]; ss += (x[0] * x[0] + x[1] * x[1]) + (x[2] * x[2] + x[3] * x[3]); }
                    ss += __shfl_xor(ss, 16); ss += __shfl_xor(ss, 32);
                    const float rg = ri / sqrtf(ss * ri * ri * (1.0f / 64.0f) + 1e-6f);
#pragma unroll
                    for (int bj = 0; bj < 2; ++bj) { const f32x4 v0 = acc[ai][bj][m][0] * rg * gv[bj][0], v1 = acc[ai][bj][m][1] * rg * gv[bj][1];
                        *(u32x4*)(base + (size_t)row * 1024 + 32 * bj) = pack8(v0, v1); } }
        } else if (pn < 6) {
            bf16_t* base = VX + 256 * (pn - 4) + 32 * wc + 8 * fq;
#pragma unroll
            for (int ai = 0; ai < 2; ++ai)
#pragma unroll
                for (int m = 0; m < 4; ++m) { const int row = row0 + ai * HALF + m * 16; const float ri = rinv_of(row);
#pragma unroll
                    for (int bj = 0; bj < 2; ++bj) *(u32x4*)(base + (size_t)row * 1024 + HALF * bj) = pack8(acc[ai][bj][m][0] * ri, acc[ai][bj][m][1] * ri); }
        } else if (pn < 8) {
            bf16_t* base = VX + 512 + 128 * (pn - 6) + 32 * wc + 8 * fq;
#pragma unroll
            for (int ai = 0; ai < 2; ++ai)
#pragma unroll
                for (int m = 0; m < 4; ++m) { const int row = row0 + ai * HALF + m * 16; const float ri = rinv_of(row); f32x4 o[2];
#pragma unroll
                    for (int n = 0; n < 2; ++n) { const f32x4 a = acc[ai][0][m][n] * ri, gt = acc[ai][1][m][n] * ri;
#pragma unroll
                        for (int e = 0; e < 4; ++e) o[n][e] = a[e] / (1.0f + __expf(-gt[e])); }
                    *(u32x4*)(base + (size_t)row * 1024) = pack8(o[0], o[1]); }
        } else if (pn < 10) {
            bf16_t* base = VX + 768 + 128 * (pn - 8) + 32 * wc + 8 * fq;
#pragma unroll
            for (int ai = 0; ai < 2; ++ai)
#pragma unroll
                for (int m = 0; m < 4; ++m) { const int row = row0 + ai * HALF + m * 16; const float ri = rinv_of(row); const float r2 = ri * ri;
                    *(u32x4*)(base + (size_t)row * 1024) = pack8(acc[ai][0][m][0] * acc[ai][1][m][0] * r2, acc[ai][0][m][1] * acc[ai][1][m][1] * r2); }
        } else {
            bf16_t* base = SB + 32 * wc + 8 * fq;
#pragma unroll
            for (int ai = 0; ai < 2; ++ai)
#pragma unroll
                for (int m = 0; m < 4; ++m) { const int row = row0 + ai * HALF + m * 16; const float ri = rinv_of(row);
#pragma unroll
                    for (int bj = 0; bj < 2; ++bj) *(u32x4*)(base + (size_t)row * 256 + HALF * bj) = pack8(acc[ai][bj][m][0] * ri, acc[ai][bj][m][1] * ri); }
        }
    }
};
struct EpiOut {
    static constexpr bool PERM = true, AFTER_DRAIN = false;
    bf16_t* xb; float* ssq;
    __device__ __forceinline__ void operator()(const f32x4 (&acc)[2][2][4][2], const Unit& u, int wr, int wc, int fr, int fq) const {
        const int row0 = u.pm * BM + wr * 64 + fr; const int col0 = u.pn * BM + wc * 32 + 8 * fq;
#pragma unroll
        for (int ai = 0; ai < 2; ++ai)
#pragma unroll
            for (int m = 0; m < 4; ++m) { const int row = row0 + ai * HALF + m * 16; float ss = 0.f;
#pragma unroll
                for (int bj = 0; bj < 2; ++bj) { const size_t off = (size_t)row * 1024 + col0 + bj * HALF;
                    const u32x4 r = *(const u32x4*)(xb + off);
                    const f32x4 r0 = {__builtin_bit_cast(float, r.x << 16), __builtin_bit_cast(float, r.x & 0xffff0000u), __builtin_bit_cast(float, r.y << 16), __builtin_bit_cast(float, r.y & 0xffff0000u)};
                    const f32x4 r1 = {__builtin_bit_cast(float, r.z << 16), __builtin_bit_cast(float, r.z & 0xffff0000u), __builtin_bit_cast(float, r.w << 16), __builtin_bit_cast(float, r.w & 0xffff0000u)};
                    const u32x4 w = pack8(acc[ai][bj][m][0] + r0, acc[ai][bj][m][1] + r1);
                    *(u32x4*)(xb + off) = w;
                    const float a0 = __builtin_bit_cast(float, w.x << 16), a1 = __builtin_bit_cast(float, w.x & 0xffff0000u), a2 = __builtin_bit_cast(float, w.y << 16), a3 = __builtin_bit_cast(float, w.y & 0xffff0000u);
                    const float a4 = __builtin_bit_cast(float, w.z << 16), a5 = __builtin_bit_cast(float, w.z & 0xffff0000u), a6 = __builtin_bit_cast(float, w.w << 16), a7 = __builtin_bit_cast(float, w.w & 0xffff0000u);
                    ss += ((a0 * a0 + a1 * a1) + (a2 * a2 + a3 * a3)) + ((a4 * a4 + a5 * a5) + (a6 * a6 + a7 * a7)); }
                ss += __shfl_xor(ss, 16); ss += __shfl_xor(ss, 32);
                if (fq == 0) ssq[(size_t)row * 16 + u.pn * 4 + wc] = ss; }
    }
};

template <class Epi, class Sched, bool ALIGN_EPI = false, bool SP2 = false>
__device__ __forceinline__ void gemm_phase(PG8_LAS unsigned char* lds, const Gemm g, const Sched& S, const Epi& E) {
    int tid_l = threadIdx.x; asm volatile("" : "+v"(tid_l));
    const int tid = tid_l, wid = __builtin_amdgcn_readfirstlane(tid >> 6), lane = tid & 63, wr = wid >> 2, wc = wid & 3, fr = lane & 15, fq = lane >> 4;
    const int K = g.K, nt = K / BK;
    unsigned voffA[2], voffB[2];
#pragma unroll
    for (int i = 0; i < 2; ++i) { int R, C; stage_rc(tid * 16 + i * 8192, R, C); const int Rb = Epi::PERM ? ((R & ~31) + perm32(R & 31)) : R;
        voffA[i] = (unsigned)(R * K + C) * 2u; voffB[i] = (unsigned)(Rb * K + C) * 2u; }
    const size_t kstep = (size_t)(BK * 2);
    const size_t hstep = (size_t)HALF * K * 2;
    const size_t tstep = 2 * hstep;
    const unsigned ldsw = (unsigned)wid * 1024u;
    const int aoff = lds_byte(wr * 64 + fr, fq * 8), boff = lds_byte(wc * 32 + fr, fq * 8);
#define PG8_SA(b, h) (((b) * 2 + (h)) * HTB)
#define PG8_SB(b, h) ((4 + (b) * 2 + (h)) * HTB)
#define PG8_STAGE(bufoff, gbase, voff) do { _Pragma("unroll") for (int _i = 0; _i < 2; ++_i) \
        __builtin_amdgcn_global_load_lds((const unsigned*)((const char*)(gbase) + (voff)[_i]), (PG8_LAS unsigned*)(lds + (bufoff) + ldsw + _i * 8192), 16, 0, 0); } while (0)
#define PG8_LDA(dst, b, h) do { _Pragma("unroll") for (int m = 0; m < 4; ++m) _Pragma("unroll") for (int k = 0; k < 2; ++k) dst[m][k] = *(const PG8_LAS bf16x8*)(lds + PG8_SA(b, h) + aoff + m * 2048 + k * 1024); } while (0)
#define PG8_LDB(dst, b, h) do { _Pragma("unroll") for (int n = 0; n < 2; ++n) _Pragma("unroll") for (int k = 0; k < 2; ++k) dst[n][k] = *(const PG8_LAS bf16x8*)(lds + PG8_SB(b, h) + boff + n * 2048 + k * 1024); } while (0)
#define PG8_MMA(ai, bj, At, Bt) do { __builtin_amdgcn_s_setprio(1); _Pragma("unroll") for (int m = 0; m < 4; ++m) _Pragma("unroll") for (int n = 0; n < 2; ++n) _Pragma("unroll") for (int k = 0; k < 2; ++k) \
        acc[ai][bj][m][n] = __builtin_amdgcn_mfma_f32_16x16x32_bf16(Bt[n][k], At[m][k], acc[ai][bj][m][n], 0, 0, 0); __builtin_amdgcn_s_setprio(0); } while (0)
#define PG8_WAIT_V(n) asm volatile("s_waitcnt vmcnt(" #n ")" ::: "memory")
#define PG8_WAIT_L(n) asm volatile("s_waitcnt lgkmcnt(" #n ")" ::: "memory")
#define PG8_BAR __builtin_amdgcn_s_barrier()
#define PG8_SCHED __builtin_amdgcn_sched_barrier(0)
    Unit cur, nxt; int ui = 0;
    if (!S.next(0, cur)) return;
    f32x4 acc[2][2][4][2];
#pragma unroll
    for (int a = 0; a < 2; ++a)
#pragma unroll
        for (int b = 0; b < 2; ++b)
#pragma unroll
            for (int m = 0; m < 4; ++m)
#pragma unroll
                for (int n = 0; n < 2; ++n) acc[a][b][m][n] = (f32x4){0.f, 0.f, 0.f, 0.f};
    bf16x8 At[4][2], B0[2][2], B1[2][2];
    const char* cA = (const char*)g.A + (size_t)cur.pm * tstep; const char* cB = (const char*)g.Bt + (size_t)cur.pn * tstep;
    S.a_ready(cur);
    if constexpr (SP2) {
        PG8_STAGE(PG8_SB(0, 0), cB, voffB); PG8_STAGE(PG8_SB(0, 1), cB + hstep, voffB); PG8_STAGE(PG8_SA(0, 0), cA, voffA); PG8_STAGE(PG8_SA(0, 1), cA + hstep, voffA);
        if (wr == 1) PG8_BAR;
        PG8_WAIT_V(2); PG8_BAR;
        PG8_STAGE(PG8_SB(1, 0), cB + kstep, voffB); PG8_STAGE(PG8_SA(1, 0), cA + kstep, voffA); PG8_STAGE(PG8_SB(1, 1), cB + hstep + kstep, voffB);
        PG8_WAIT_V(6); PG8_BAR;
    } else {
        PG8_STAGE(PG8_SB(0, 0), cB, voffB); PG8_STAGE(PG8_SA(0, 0), cA, voffA); PG8_STAGE(PG8_SB(0, 1), cB + hstep, voffB); PG8_STAGE(PG8_SA(0, 1), cA + hstep, voffA);
        if (wr == 1) PG8_BAR;
        PG8_WAIT_V(4); PG8_BAR;
        PG8_STAGE(PG8_SB(1, 0), cB + kstep, voffB); PG8_STAGE(PG8_SA(1, 0), cA + kstep, voffA); PG8_STAGE(PG8_SB(1, 1), cB + hstep + kstep, voffB);
        PG8_WAIT_V(6); PG8_BAR;
    }
    for (;;) {
        const bool has_next = S.next(ui + 1, nxt);
        const char* nA = has_next ? (const char*)g.A + (size_t)nxt.pm * tstep : cA; const char* nB = has_next ? (const char*)g.Bt + (size_t)nxt.pn * tstep : cB;
        for (int t = 0; t < nt; t += 2) {
            const bool last = (t == nt - 2);
            const char* a1 = cA + (size_t)(t + 1) * kstep;
            const char* a2 = last ? nA : cA + (size_t)(t + 2) * kstep; const char* b2 = last ? nB : cB + (size_t)(t + 2) * kstep;
            const char* a3 = a2 + kstep; const char* b3 = b2 + kstep;
            if (last && has_next) S.a_ready(nxt);
            if constexpr (SP2) {
            PG8_LDB(B0, 0, 0); PG8_LDB(B1, 0, 1); PG8_SCHED; PG8_LDA(At, 0, 0); PG8_STAGE(PG8_SA(1, 1), a1 + hstep, voffA);
            PG8_WAIT_V(8); PG8_WAIT_L(0); PG8_BAR; PG8_MMA(0, 0, At, B0); PG8_MMA(0, 1, At, B1); PG8_BAR; PG8_SCHED;
            PG8_LDA(At, 0, 1); PG8_STAGE(PG8_SB(0, 0), b2, voffB); PG8_STAGE(PG8_SB(0, 1), b2 + hstep, voffB); PG8_STAGE(PG8_SA(0, 0), a2, voffA);
            PG8_WAIT_V(8); PG8_WAIT_L(0); PG8_BAR; PG8_MMA(1, 0, At, B0); PG8_MMA(1, 1, At, B1); PG8_BAR; PG8_SCHED;
            PG8_LDB(B0, 1, 0); PG8_LDB(B1, 1, 1); PG8_SCHED; PG8_LDA(At, 1, 0); PG8_STAGE(PG8_SA(0, 1), a2 + hstep, voffA);
            PG8_WAIT_V(8); PG8_WAIT_L(0); PG8_BAR; PG8_MMA(0, 0, At, B0); PG8_MMA(0, 1, At, B1); PG8_BAR; PG8_SCHED;
            PG8_LDA(At, 1, 1); PG8_STAGE(PG8_SB(1, 0), b3, voffB); PG8_STAGE(PG8_SB(1, 1), b3 + hstep, voffB); PG8_STAGE(PG8_SA(1, 0), a3, voffA);
            PG8_WAIT_V(8); PG8_WAIT_L(0); PG8_BAR; PG8_MMA(1, 0, At, B0); PG8_MMA(1, 1, At, B1); PG8_BAR; PG8_SCHED;
            } else {
            PG8_LDB(B0, 0, 0); PG8_SCHED; PG8_LDA(At, 0, 0); PG8_STAGE(PG8_SA(1, 1), a1 + hstep, voffA);
            PG8_WAIT_L(8); PG8_BAR; PG8_WAIT_L(0); PG8_MMA(0, 0, At, B0); PG8_BAR; PG8_SCHED;
            PG8_LDB(B1, 0, 1); PG8_STAGE(PG8_SB(0, 0), b2, voffB);
            PG8_BAR; PG8_WAIT_L(0); PG8_MMA(0, 1, At, B1); PG8_BAR;
            PG8_LDA(At, 0, 1); PG8_STAGE(PG8_SA(0, 0), a2, voffA);
            PG8_BAR; PG8_WAIT_L(0); PG8_MMA(1, 0, At, B0); PG8_BAR; PG8_SCHED;
            PG8_STAGE(PG8_SB(0, 1), b2 + hstep, voffB);
            PG8_WAIT_V(6); PG8_BAR; PG8_MMA(1, 1, At, B1); PG8_BAR;
            PG8_LDB(B0, 1, 0); PG8_SCHED; PG8_LDA(At, 1, 0); PG8_STAGE(PG8_SA(0, 1), a2 + hstep, voffA);
            PG8_WAIT_L(8); PG8_BAR; PG8_WAIT_L(0); PG8_MMA(0, 0, At, B0); PG8_BAR; PG8_SCHED;
            PG8_LDB(B1, 1, 1); PG8_STAGE(PG8_SB(1, 0), b3, voffB);
            PG8_BAR; PG8_WAIT_L(0); PG8_MMA(0, 1, At, B1); PG8_BAR;
            PG8_LDA(At, 1, 1); PG8_STAGE(PG8_SA(1, 0), a3, voffA);
            PG8_BAR; PG8_WAIT_L(0); PG8_MMA(1, 0, At, B0); PG8_BAR; PG8_SCHED;
            PG8_STAGE(PG8_SB(1, 1), b3 + hstep, voffB);
            PG8_WAIT_V(6); PG8_BAR; PG8_MMA(1, 1, At, B1); PG8_BAR;
            }
        }
        if constexpr (ALIGN_EPI) { if (wr == 0) PG8_BAR; }
        if constexpr (!Epi::AFTER_DRAIN) { E(acc, cur, wr, wc, fr, fq); S.done(cur); }
        if (!has_next) break;
#pragma unroll
        for (int a = 0; a < 2; ++a)
#pragma unroll
            for (int b = 0; b < 2; ++b)
#pragma unroll
                for (int m = 0; m < 4; ++m)
#pragma unroll
                    for (int n = 0; n < 2; ++n) acc[a][b][m][n] = (f32x4){0.f, 0.f, 0.f, 0.f};
        cur = nxt; cA = nA; cB = nB; ++ui;
        if constexpr (ALIGN_EPI) { if (wr == 1) PG8_BAR; }
    }
    PG8_WAIT_V(0);
    if constexpr (!ALIGN_EPI) { if (wr == 0) PG8_BAR; }
    PG8_BAR;
    if constexpr (Epi::AFTER_DRAIN) { E.fused(acc, cur, wr, wc, fr, fq, lds, wid, lane); S.done(cur); }
#undef PG8_SA
#undef PG8_SB
#undef PG8_STAGE
#undef PG8_LDA
#undef PG8_LDB
#undef PG8_MMA
#undef PG8_WAIT_V
#undef PG8_WAIT_L
#undef PG8_BAR
#undef PG8_SCHED
}
}
#define PG8_SP2 true
#define PG8_ALIGN true
#include <hip/hip_bf16.h>
#include <cmath>
namespace attn_body {
using bf16=__hip_bfloat16;
using bf16x8=__attribute__((ext_vector_type(8)))short;
using s16x4=__attribute__((ext_vector_type(4)))short;
using f32x16=__attribute__((ext_vector_type(16)))float;
using u32x4=__attribute__((ext_vector_type(4)))unsigned;
constexpr int BATCH=8,NHEAD=16,SEQ=4096,D=64,DM=NHEAD*D;
constexpr int NW=8,QBLK=32,QB=QBLK*NW,KVBLK=64,NQB=SEQ/QB;
constexpr int ATTN_PITCH=DM, ATTN_UNIT_ROWS=QB;
__device__ __forceinline__ int crow(int r,int hi){return (r&3)+8*(r>>2)+4*hi;}
#define SBAR() __builtin_amdgcn_sched_barrier(0)
__device__ __forceinline__ void cmask(f32x16&p0,f32x16&p1,int jb,int qrel,int hi){
  const float NEG=-INFINITY; int kb=64*jb+4*hi;
  #pragma unroll
  for(int r=0;r<16;++r){int kv=kb+(r&3)+8*(r>>2); if(kv>qrel)p0[r]=NEG; if(kv+32>qrel)p1[r]=NEG;}
}

constexpr int NSLOT=3, SLOTB=8192, VSLOTB=16384;
constexpr int LDS_K=0, LDS_V=NSLOT*SLOTB, LDS_WS=LDS_V+NSLOT*VSLOTB, LDS_OST=LDS_WS+NW*64*4, LDS_BYTES=LDS_OST+NW*4096;
constexpr float C2=0.125f*1.4426950408889634f;
__device__ __forceinline__ void glds16(const void*gsrc,unsigned lds_dst){unsigned keep;
  asm volatile("s_mov_b32 %0, m0\n\ts_mov_b32 m0, %2\n\ts_nop 0\n\tglobal_load_lds_dwordx4 %1, off\n\ts_mov_b32 m0, %0":"=&s"(keep):"v"(gsrc),"s"(lds_dst):"memory");}
__device__ __forceinline__ float max3f(float a,float b,float c){float r;asm("v_max3_f32 %0, %1, %2, %3":"=v"(r):"v"(a),"v"(b),"v"(c));return r;}
__device__ __forceinline__ float max2f(float a,float b){float r;asm("v_max_f32_e32 %0, %1, %2":"=v"(r):"v"(a),"v"(b));return r;}
__device__ __forceinline__ float fadd_s(float a,float b){float r;asm("v_add_f32_e32 %0, %1, %2":"=v"(r):"v"(a),"v"(b));return r;}
__device__ __forceinline__ float fsub_s(float a,float b){float r;asm("v_sub_f32_e32 %0, %1, %2":"=v"(r):"v"(a),"v"(b));return r;}
typedef float f32x2_t __attribute__((ext_vector_type(2))); typedef __bf16 bf16x2_t __attribute__((ext_vector_type(2)));
__device__ __forceinline__ unsigned cvtpk_s(float lo,float hi){f32x2_t v={lo,hi};bf16x2_t b=__builtin_convertvector(v,bf16x2_t);return __builtin_bit_cast(unsigned,b);}
#define WAIT_BAR(N) asm volatile("s_waitcnt vmcnt(" #N ") lgkmcnt(0)\n\ts_barrier":::"memory")

__device__ __forceinline__ void qkt(f32x16&p0,f32x16&p1,const char*Kslot,const bf16x8*qr,const f32x16&negm,int r32,int hi){
  const char*kb=Kslot+hi*1024+r32*16;
  #pragma unroll
  for(int d0=0;d0<4;++d0){
    const bf16x8 b0=*reinterpret_cast<const bf16x8*>(kb+d0*2048);
    const bf16x8 b1=*reinterpret_cast<const bf16x8*>(kb+d0*2048+512);
    if(d0==0){p0=__builtin_amdgcn_mfma_f32_32x32x16_bf16(b0,qr[0],negm,0,0,0);p1=__builtin_amdgcn_mfma_f32_32x32x16_bf16(b1,qr[0],negm,0,0,0);}
    else{p0=__builtin_amdgcn_mfma_f32_32x32x16_bf16(b0,qr[d0],p0,0,0,0);p1=__builtin_amdgcn_mfma_f32_32x32x16_bf16(b1,qr[d0],p1,0,0,0);}}
}
typedef __attribute__((address_space(3))) const char* lds_cptr;
typedef short v4i16_t __attribute__((ext_vector_type(4)));
__device__ __forceinline__ void kload8(bf16x8*kf,lds_cptr kp){
  kf[0]=*(const __attribute__((address_space(3))) bf16x8*)(kp);      kf[1]=*(const __attribute__((address_space(3))) bf16x8*)(kp+512);
  kf[2]=*(const __attribute__((address_space(3))) bf16x8*)(kp+2048); kf[3]=*(const __attribute__((address_space(3))) bf16x8*)(kp+2560);
  kf[4]=*(const __attribute__((address_space(3))) bf16x8*)(kp+4096); kf[5]=*(const __attribute__((address_space(3))) bf16x8*)(kp+4608);
  kf[6]=*(const __attribute__((address_space(3))) bf16x8*)(kp+6144); kf[7]=*(const __attribute__((address_space(3))) bf16x8*)(kp+6656);
}
__device__ __forceinline__ void kload2(bf16x8*kf,lds_cptr kp,int j){ kf[2*j]=*(const __attribute__((address_space(3))) bf16x8*)(kp+j*2048); kf[2*j+1]=*(const __attribute__((address_space(3))) bf16x8*)(kp+j*2048+512); }
__device__ __forceinline__ s16x4 vtr(lds_cptr p){ return __builtin_bit_cast(s16x4,__builtin_amdgcn_ds_read_tr16_b64_v4i16((__attribute__((address_space(3))) v4i16_t*)p)); }
__device__ __forceinline__ float rowmax(const f32x16&p0,const f32x16&p1){
  float a=max3f(p0[0],p0[1],p1[0]),b=max3f(p0[2],p0[3],p1[1]);a=max3f(a,p1[2],p1[3]);
  #pragma unroll
  for(int r=4;r<16;r+=4){a=max3f(a,p0[r],p0[r+1]);b=max3f(b,p0[r+2],p0[r+3]);a=max3f(a,p1[r],p1[r+1]);b=max3f(b,p1[r+2],p1[r+3]);}
  const float m=max2f(a,b);
  auto rr=__builtin_amdgcn_permlane32_swap(__float_as_uint(m),__float_as_uint(m),false,false);
  return max2f(__uint_as_float(rr[0]),__uint_as_float(rr[1]));
}
__device__ __forceinline__ void pv(f32x16*o,int vb,bf16x8 pa0,bf16x8 pa1,bf16x8 pa2,bf16x8 pa3){
  #pragma unroll
  for(int d0=0;d0<4;++d0){s16x4 lo[4],hi[4];
    #pragma unroll
    for(int ks=0;ks<4;++ks){
      asm volatile("ds_read_b64_tr_b16 %0,%1 offset:%c2":"=&v"(lo[ks]):"v"(vb),"i"((d0>>1)*8192+(d0&1)*4096+ks*1024):"memory");
      asm volatile("ds_read_b64_tr_b16 %0,%1 offset:%c2":"=&v"(hi[ks]):"v"(vb),"i"((d0>>1)*8192+(d0&1)*4096+ks*1024+512):"memory");}
    asm volatile("s_waitcnt lgkmcnt(0)":::"memory");SBAR();
    #define PK(k) (bf16x8){lo[k][0],lo[k][1],lo[k][2],lo[k][3],hi[k][0],hi[k][1],hi[k][2],hi[k][3]}
    o[d0]=__builtin_amdgcn_mfma_f32_32x32x16_bf16(pa0,PK(0),o[d0],0,0,0);
    o[d0]=__builtin_amdgcn_mfma_f32_32x32x16_bf16(pa1,PK(1),o[d0],0,0,0);
    o[d0]=__builtin_amdgcn_mfma_f32_32x32x16_bf16(pa2,PK(2),o[d0],0,0,0);
    o[d0]=__builtin_amdgcn_mfma_f32_32x32x16_bf16(pa3,PK(3),o[d0],0,0,0);
    #undef PK
  }
}

#ifndef ATTN_STORE16
#define ATTN_STORE16(p,v) (*(u32x4*)(p)=(v))
#endif
template<int THRL> __device__ __forceinline__ void attn_unit(int b,int qb,const bf16*Q,const bf16*__restrict__ K,const bf16*__restrict__ V,bf16*O,char*shm){
  int tid_l=threadIdx.x; asm volatile("":"+v"(tid_l)); const int tid=tid_l,lane=tid&63,r32=lane&31,hi=lane>>5; const int wid=__builtin_amdgcn_readfirstlane(tid>>6);
  const long rowbase=(long)b*SEQ; const int q0=qb*QB; const lds_cptr shm3q=(lds_cptr)shm;
  const bf16*Qw=Q+(rowbase+q0+wid*QBLK)*DM;
  const bf16*Kh=K+rowbase*DM,*Vh=V+rowbase*DM;
  const unsigned lds0=(unsigned)(uintptr_t)shm;
  float*wsf=(float*)(shm+LDS_WS)+wid*64;
  const bf16*ksrc=Kh+(long)lane*DM+wid*8;
  const bf16*vsrc=Vh+(long)(16*(wid&3)+(lane>>2))*DM+(wid>>2)*32+(lane&3)*8;
  const unsigned kdst=lds0+LDS_K+wid*1024, vdst=lds0+LDS_V+wid*1024;
  #define DMA_K(t,slot) glds16(ksrc+(long)(t)*KVBLK*DM,(unsigned)__builtin_amdgcn_readfirstlane(kdst+(slot)))
  #define DMA_V(t,slot) do{ glds16(vsrc+(long)(t)*KVBLK*DM,(unsigned)__builtin_amdgcn_readfirstlane(vdst+2*(slot))); glds16(vsrc+64+(long)(t)*KVBLK*DM,(unsigned)__builtin_amdgcn_readfirstlane(vdst+2*(slot)+8192)); }while(0)
  const int vb0=(int)(lds0+LDS_V)+((lane>>4)&1)*32+(lane&3)*8+(4*hi+((lane&15)>>2))*64;
  const char*Kbase=shm+LDS_K; bf16x8 kf[8];
  const lds_cptr shm3=(lds_cptr)shm; const lds_cptr kp0=shm3+LDS_K+hi*1024+r32*16; const lds_cptr vp0=shm3+LDS_V+((lane>>4)&1)*32+(lane&3)*8+(4*hi+((lane&15)>>2))*64;
  const int NT=(q0+QB)/KVBLK;
  DMA_K(0,0);DMA_V(0,0);DMA_K(1,SLOTB);
  bf16x8 qr[4];
  #pragma unroll
  for(int d0=0;d0<4;++d0)qr[d0]=*reinterpret_cast<const bf16x8*>(&Qw[(long)r32*DM+d0*16+hi*8]);
  const lds_cptr qst3=shm3q+LDS_OST+wid*4096+lane*16;
  #define LDQ(d0) (*(const __attribute__((address_space(3))) bf16x8*)(qst3+(d0)*1024))
  float mhat=0.f,l_reg=0.f;f32x16 o[4];o[0]=f32x16{};o[1]=f32x16{};o[2]=f32x16{};o[3]=f32x16{};f32x16 negm=f32x16{};asm volatile("":"+v"(negm));
  const int qrel=wid*QBLK+r32;
  #define CMASK(P0,P1,t) do{int jb_=(t)-(NT-4); if(jb_>=0)cmask(P0,P1,jb_,qrel,hi);}while(0)
  bool resc=false;
  #define START(P0,P1) do{ const float rm=rowmax(P0,P1); resc=false; \
    { const float dl=rm; mhat=fadd_s(mhat,dl); \
      _Pragma("unroll") for(int r=0;r<16;++r){P0[r]=fsub_s(P0[r],dl);P1[r]=fsub_s(P1[r],dl);} \
      _Pragma("unroll") for(int r=0;r<16;++r)negm[r]=-mhat; asm volatile("":"+v"(negm)); } \
    _Pragma("unroll") for(int r=0;r<16;++r)P0[r]=__builtin_amdgcn_exp2f(P0[r]); }while(0)
  #define RESC() do{ if(resc){ asm volatile("s_waitcnt lgkmcnt(0)":::"memory"); \
      _Pragma("unroll") for(int d_=0;d_<4;++d_) _Pragma("unroll") for(int r=0;r<16;++r)o[d_][r]*=wsf[crow(r,hi)]; } }while(0)
  f32x16 pA0,pA1,pB0,pB1;
  int sl_prev=0,sl_cur=0,sl_next=SLOTB;
  #define ROT() do{sl_prev=sl_cur;sl_cur=sl_next;sl_next=(sl_next==(NSLOT-1)*SLOTB)?0:sl_next+SLOTB;}while(0)
  DMA_K(2,2*SLOTB);
  WAIT_BAR(3);
  qkt(pA0,pA1,Kbase,qr,negm,r32,hi);
  _Pragma("unroll") for(int d0=0;d0<4;++d0)*(__attribute__((address_space(3))) bf16x8*)(qst3+d0*1024)=qr[d0];
asm volatile("s_nop 15\n\ts_nop 7":"+v"(pA0),"+v"(pA1));CMASK(pA0,pA1,0);
  START(pA0,pA1);
  _Pragma("unroll") for(int r=0;r<16;++r)pA1[r]=__builtin_amdgcn_exp2f(pA1[r]);
  WAIT_BAR(0);
  DMA_K(3,0);DMA_V(1,SLOTB);
  ROT();
  kload8(kf,kp0+sl_cur);
  WAIT_BAR(3);
  s16x4 f0lo,f0hi,f1lo,f1hi,f2lo,f2hi,f3lo,f3hi; u32x4 pw0,pw1,pw2,pw3;
  #define PKW(P,B) cvtpk_s(P[B],P[B+1])
  #define PAF(k) __builtin_bit_cast(bf16x8,pw##k)
  #define VF(S) (bf16x8){S##lo[0],S##lo[1],S##lo[2],S##lo[3],S##hi[0],S##hi[1],S##hi[2],S##hi[3]}
  #define FOFF(i) (((i)>>2)*4096+((i)&3)*1024)
  #define VLD(S,off) do{ S##lo=vtr(vp_+(off)); S##hi=vtr(vp_+(off)+512); }while(0)
  #define PIN(x) asm volatile("":"+v"(x))
  #define MX3(a,b,c) __builtin_fmaxf(__builtin_fmaxf((a),(b)),(c))
  #define GAPA(MF,A0,A1,A2,A3,W0,W1,PW) do{ MF; sacc+=A0; sacc+=A1; sacc+=A2; sacc+=A3; PIN(sacc); W0; W1; PIN(PW); SBAR(); }while(0)
  #define EX(v) __builtin_amdgcn_exp2f(v)
  #define GAPB(MF,X,B) do{ MF; X[B]=EX(X[B]); X[B+1]=EX(X[B+1]); X[B+2]=EX(X[B+2]); X[B+3]=EX(X[B+3]); PIN(X); SBAR(); }while(0)
  #define GAPB2(MF,X,B) do{ MF; X[B]=EX(X[B]); X[B+1]=EX(X[B+1]); PIN(X); SBAR(); }while(0)
  #define KRD(G,j) do{ if(G){ kload2(kf,kp0+sl_next,j); SBAR(); } }while(0)
  #define STEP(C0,C1,P0,P1,t,GK,GV,GL) do{ SBAR(); \
    const lds_cptr vp_=vp0+2*sl_prev; \
    bf16x8 q_=LDQ(0); VLD(f0,FOFF(0)); SBAR(); float sacc=(P0[0]+P0[1]); \
    GAPA(C0=__builtin_amdgcn_mfma_f32_32x32x16_bf16(kf[0],q_,negm,0,0,0), P0[2],P0[3],P0[4],P0[5],     pw0[0]=PKW(P0,0), pw0[1]=PKW(P0,2), pw0); \
    VLD(f1,FOFF(4)); SBAR(); GAPA(C1=__builtin_amdgcn_mfma_f32_32x32x16_bf16(kf[1],q_,negm,0,0,0), P0[6],P0[7],P0[8],P0[9],     pw0[2]=PKW(P0,4), pw0[3]=PKW(P0,6), pw0); \
    q_=LDQ(1); VLD(f2,FOFF(1)); SBAR(); GAPA(C0=__builtin_amdgcn_mfma_f32_32x32x16_bf16(kf[2],q_,C0,0,0,0),   P0[10],P0[11],P0[12],P0[13], pw1[0]=PKW(P0,8), pw1[1]=PKW(P0,10), pw1); \
    VLD(f3,FOFF(5)); SBAR(); GAPA(C1=__builtin_amdgcn_mfma_f32_32x32x16_bf16(kf[3],q_,C1,0,0,0),   P0[14],P0[15],P1[0],P1[1],   pw1[2]=PKW(P0,12),pw1[3]=PKW(P0,14), pw1); \
    q_=LDQ(2); SBAR(); GAPA(C0=__builtin_amdgcn_mfma_f32_32x32x16_bf16(kf[4],q_,C0,0,0,0),   P1[2],P1[3],P1[4],P1[5],     pw2[0]=PKW(P1,0), pw2[1]=PKW(P1,2), pw2); \
    GAPA(C1=__builtin_amdgcn_mfma_f32_32x32x16_bf16(kf[5],q_,C1,0,0,0),   P1[6],P1[7],P1[8],P1[9],     pw2[2]=PKW(P1,4), pw2[3]=PKW(P1,6), pw2); \
    q_=LDQ(3); SBAR(); GAPA(C0=__builtin_amdgcn_mfma_f32_32x32x16_bf16(kf[6],q_,C0,0,0,0),   P1[10],P1[11],P1[12],P1[13], pw3[0]=PKW(P1,8), pw3[1]=PKW(P1,10), pw3); \
    GAPA(C1=__builtin_amdgcn_mfma_f32_32x32x16_bf16(kf[7],q_,C1,0,0,0),   P1[14],P1[15],0.f,0.f,       pw3[2]=PKW(P1,12),pw3[3]=PKW(P1,14), pw3); \
    l_reg+=sacc; \
    if(GK){DMA_K((t)+3,sl_cur);} if(GV){DMA_V((t)+1,sl_next);} \
    CMASK(C0,C1,t); \
    { float a=MX3(C0[0],C0[1],C1[0]),b=MX3(C0[2],C0[3],C1[1]); a=MX3(a,C1[2],C1[3]); \
      _Pragma("unroll") for(int r=4;r<16;r+=4){a=MX3(a,C0[r],C0[r+1]);b=MX3(b,C0[r+2],C0[r+3]);a=MX3(a,C1[r],C1[r+1]);b=MX3(b,C1[r+2],C1[r+3]);} \
      float rm=__builtin_fmaxf(a,b); { auto rr=__builtin_amdgcn_permlane32_swap(__float_as_uint(rm),__float_as_uint(rm),false,false); rm=__builtin_fmaxf(__uint_as_float(rr[0]),__uint_as_float(rr[1])); } \
      resc=false; \
      if(__builtin_expect(__any(rm>(float)THRL),0)){ const float dl=__builtin_fmaxf(rm,0.f); mhat+=dl; \
        _Pragma("unroll") for(int r=0;r<16;++r){C0[r]-=dl;C1[r]-=dl;} \
        _Pragma("unroll") for(int r=0;r<16;++r)negm[r]=-mhat; asm volatile("":"+v"(negm)); \
        const float f=__builtin_amdgcn_exp2f(-dl); l_reg*=f; if(hi==0)wsf[r32]=f; resc=true; } } \
    SBAR(); \
      \
    GAPB2(o[0]=__builtin_amdgcn_mfma_f32_32x32x16_bf16(PAF(0),VF(f0),o[0],0,0,0), C0,0);  VLD(f0,FOFF(2)); SBAR(); \
    GAPB2(o[1]=__builtin_amdgcn_mfma_f32_32x32x16_bf16(PAF(0),VF(f1),o[1],0,0,0), C0,2);  VLD(f1,FOFF(6)); SBAR(); \
    KRD(GL,0); GAPB2(o[0]=__builtin_amdgcn_mfma_f32_32x32x16_bf16(PAF(1),VF(f2),o[0],0,0,0), C0,4);  VLD(f2,FOFF(3)); SBAR(); \
    KRD(GL,1); GAPB2(o[1]=__builtin_amdgcn_mfma_f32_32x32x16_bf16(PAF(1),VF(f3),o[1],0,0,0), C0,6);  VLD(f3,FOFF(7)); SBAR(); \
    KRD(GL,2); GAPB2(o[0]=__builtin_amdgcn_mfma_f32_32x32x16_bf16(PAF(2),VF(f0),o[0],0,0,0), C0,8);  VLD(f0,8192+FOFF(0)); SBAR(); \
    KRD(GL,3); GAPB2(o[1]=__builtin_amdgcn_mfma_f32_32x32x16_bf16(PAF(2),VF(f1),o[1],0,0,0), C0,10); VLD(f1,8192+FOFF(4)); SBAR(); \
    GAPB2(o[0]=__builtin_amdgcn_mfma_f32_32x32x16_bf16(PAF(3),VF(f2),o[0],0,0,0), C0,12); VLD(f2,8192+FOFF(1)); SBAR(); \
    GAPB2(o[1]=__builtin_amdgcn_mfma_f32_32x32x16_bf16(PAF(3),VF(f3),o[1],0,0,0), C0,14); VLD(f3,8192+FOFF(5)); SBAR(); \
    GAPB2(o[2]=__builtin_amdgcn_mfma_f32_32x32x16_bf16(PAF(0),VF(f0),o[2],0,0,0), C1,0);  VLD(f0,8192+FOFF(2)); SBAR(); \
    GAPB2(o[3]=__builtin_amdgcn_mfma_f32_32x32x16_bf16(PAF(0),VF(f1),o[3],0,0,0), C1,2);  VLD(f1,8192+FOFF(6)); SBAR(); \
    GAPB2(o[2]=__builtin_amdgcn_mfma_f32_32x32x16_bf16(PAF(1),VF(f2),o[2],0,0,0), C1,4);  VLD(f2,8192+FOFF(3)); SBAR(); \
    GAPB2(o[3]=__builtin_amdgcn_mfma_f32_32x32x16_bf16(PAF(1),VF(f3),o[3],0,0,0), C1,6);  VLD(f3,8192+FOFF(7)); SBAR(); \
    GAPB2(o[2]=__builtin_amdgcn_mfma_f32_32x32x16_bf16(PAF(2),VF(f0),o[2],0,0,0), C1,8); \
    GAPB2(o[3]=__builtin_amdgcn_mfma_f32_32x32x16_bf16(PAF(2),VF(f1),o[3],0,0,0), C1,10); \
    GAPB2(o[2]=__builtin_amdgcn_mfma_f32_32x32x16_bf16(PAF(3),VF(f2),o[2],0,0,0), C1,12); \
    GAPB2(o[3]=__builtin_amdgcn_mfma_f32_32x32x16_bf16(PAF(3),VF(f3),o[3],0,0,0), C1,14); \
    }while(0)
  int t=1;
  #undef CMASK
  #define CMASK(P0,P1,t) do{}while(0)
  for(;t+5<NT;t+=2){
    STEP(pB0,pB1,pA0,pA1,t,true,true,true);     WAIT_BAR(3); RESC(); ROT();
    STEP(pA0,pA1,pB0,pB1,t+1,true,true,true);   WAIT_BAR(3); RESC(); ROT();
  }
  #undef CMASK
  #define CMASK(P0,P1,t) do{int jb_=(t)-(NT-4); if(jb_>=0)cmask(P0,P1,jb_,qrel,hi);}while(0)
  #define ENDW(tt) do{ if((tt)+3<NT){WAIT_BAR(3);} else if((tt)+2<NT){WAIT_BAR(2);} else {WAIT_BAR(0);} }while(0)
  for(;t+1<NT;t+=2){
    STEP(pB0,pB1,pA0,pA1,t,(t+3<NT),(t+1<NT),(t+1<NT));       ENDW(t);   RESC(); ROT();
    STEP(pA0,pA1,pB0,pB1,t+1,(t+4<NT),(t+2<NT),(t+2<NT));     ENDW(t+1); RESC(); ROT();
  }
  STEP(pB0,pB1,pA0,pA1,NT-1,false,false,false); RESC();
  { float sacc=pB0[0]+pB0[1]; _Pragma("unroll") for(int r=2;r<16;++r)sacc+=pB0[r]; _Pragma("unroll") for(int r=0;r<16;++r)sacc+=pB1[r]; l_reg+=sacc;
    pw0=(u32x4){PKW(pB0,0),PKW(pB0,2),PKW(pB0,4),PKW(pB0,6)};pw1=(u32x4){PKW(pB0,8),PKW(pB0,10),PKW(pB0,12),PKW(pB0,14)};pw2=(u32x4){PKW(pB1,0),PKW(pB1,2),PKW(pB1,4),PKW(pB1,6)};pw3=(u32x4){PKW(pB1,8),PKW(pB1,10),PKW(pB1,12),PKW(pB1,14)};
    SBAR(); pv(o,vb0+2*sl_cur,PAF(0),PAF(1),PAF(2),PAF(3)); }
  #undef PKW
  #undef PAF
  #undef VF
  #undef FOFF
  #undef VLD
  #undef LDQ
  #undef PIN
  #undef MX3
  #undef GAPA
  #undef GAPB
  #undef EX
  #undef GAPB2
  #undef KRD
  #undef STEP
  #undef ENDW
  {auto rr=__builtin_amdgcn_permlane32_swap(__float_as_uint(l_reg),__float_as_uint(l_reg),false,false);l_reg=__uint_as_float(rr[0])+__uint_as_float(rr[1]);}
  if(hi==0)wsf[32+r32]=l_reg;asm volatile("s_waitcnt lgkmcnt(0)":::"memory");
  float rli[16];
  #pragma unroll
  for(int r=0;r<16;++r)rli[r]=__builtin_amdgcn_rcpf(wsf[32+crow(r,hi)]);
  bf16*Ow=O+(rowbase+q0+wid*QBLK)*DM;
  { bf16*stg=(bf16*)(shm+LDS_OST)+wid*2048;
    #pragma unroll
    for(int h2=0;h2<2;++h2){
      #pragma unroll
      for(int r=0;r<16;++r){const int orow=crow(r,hi);
        #pragma unroll
        for(int d0=0;d0<2;++d0)stg[orow*64+d0*32+r32]=__float2bfloat16(o[2*h2+d0][r]*rli[r]);}
      asm volatile("s_waitcnt lgkmcnt(0)":::"memory");
      #pragma unroll
      for(int i=0;i<4;++i){const int row=i*8+(lane>>3),ch=lane&7; const u32x4 v=*(const u32x4*)(stg+row*64+ch*8); ATTN_STORE16(Ow+(long)row*DM+h2*64+ch*8,v);}
      asm volatile("s_waitcnt lgkmcnt(0)":::"memory"); } }
  asm volatile("s_waitcnt lgkmcnt(0)\n\ts_barrier":::"memory");
  #undef DMA_K
  #undef DMA_V
  #undef CMASK
  #undef START
  #undef RESC
  #undef ROT
}
constexpr int ATTN_LDS_BYTES=LDS_BYTES;
#undef SBAR
#undef WAIT_BAR
}
#define GAS __attribute__((address_space(1)))
#define LAS __attribute__((address_space(3)))
typedef unsigned short bf16;
typedef unsigned v4u __attribute__((ext_vector_type(4)));
typedef float f32x4 __attribute__((ext_vector_type(4)));
typedef short bf16x8 __attribute__((ext_vector_type(8)));
typedef GAS unsigned gu32;
typedef GAS unsigned long long gu64;
#define RLX_AGENT __ATOMIC_RELAXED, __HIP_MEMORY_SCOPE_AGENT
#define LDS_WAIT() asm volatile("s_waitcnt lgkmcnt(0)" ::: "memory")
#define VM_WAIT() asm volatile("s_waitcnt vmcnt(0)" ::: "memory")
__device__ __forceinline__ unsigned long long rt() { return __builtin_amdgcn_s_memrealtime(); }
__device__ __forceinline__ unsigned f2bf(float f) { unsigned u = __builtin_bit_cast(unsigned, f); return (u + 0x7fffu + ((u >> 16) & 1u)) >> 16; }
__device__ __forceinline__ unsigned pk2(float lo, float hi) { return f2bf(lo) | (f2bf(hi) << 16); }

#define XB_TMO      128
#define XB_XCNT(j)  (256  + 64 * (j))
#define XB_XSUB(j)  (1280 + 64 * (j))
#define XB_XGEN(j)  (2304 + 64 * (j))
#define XB_TOP      3328
#define XB_TOPGEN   3392
#define XCD_BAR_WORDS 3456
#define XB_SPIN_CAP (1u << 18)

__device__ __forceinline__ unsigned xb_ld(unsigned* p)              { return __hip_atomic_load(p, __ATOMIC_RELAXED, __HIP_MEMORY_SCOPE_AGENT); }
__device__ __forceinline__ unsigned xb_add(unsigned* p, unsigned v) { return __hip_atomic_fetch_add(p, v, __ATOMIC_RELAXED, __HIP_MEMORY_SCOPE_AGENT); }
__device__ __forceinline__ unsigned xb_xcc_id() { return (unsigned)__builtin_amdgcn_s_getreg((3 << 11) | 20) & 0xFu; }
#define XB_SPIN(cond, bar) do { unsigned _sp = 0; while (cond) { __builtin_amdgcn_s_sleep(1); \
    if ((++_sp & 255u) == 0u) { if (xb_ld(&(bar)[XB_TMO])) break; if (_sp > XB_SPIN_CAP) { atomicAdd(&(bar)[XB_TMO], 1u); break; } } } } while (0)

struct XcdBarrier {
    unsigned* bar; unsigned x;
    volatile LAS unsigned* st;
};

__device__ __forceinline__ XcdBarrier xcd_barrier_post(unsigned* bar, volatile LAS unsigned* st) {
    XcdBarrier b; b.bar = bar; b.x = xb_xcc_id(); b.st = st;
    if (threadIdx.x == 0) (void)xb_add(&bar[XB_XCNT(b.x)], 1u);
    return b;
}
__device__ __forceinline__ void xcd_barrier_complete(unsigned* bar, unsigned x, unsigned& nloc, unsigned& nx) {
    const unsigned G = gridDim.x * gridDim.y * gridDim.z;
    unsigned sum, cnt, mine, sp = 0u;
    for (;;) {
        sum = 0u; cnt = 0u; mine = 0u;
#pragma unroll
        for (unsigned j = 0; j < 16; ++j) { const unsigned c = xb_ld(&bar[XB_XCNT(j)]); sum += c; cnt += (c > 0u) ? 1u : 0u; mine = (j == x) ? c : mine; }
        if (sum == G) break;
        __builtin_amdgcn_s_sleep(1);
        if ((++sp & 255u) == 0u) { if (xb_ld(&bar[XB_TMO])) break; if (sp > XB_SPIN_CAP) { atomicAdd(&bar[XB_TMO], 1u); break; } }
    }
    nloc = mine > 0u ? mine : 1u; nx = cnt > 0u ? cnt : 1u;
}

__device__ __forceinline__ void xcd_barrier(const XcdBarrier& b) {
    asm volatile("s_waitcnt vmcnt(0)" ::: "memory");
    __syncthreads();
    if (threadIdx.x == 0) {
        size_t zoff_ = 0; asm volatile("" : "+s"(zoff_)); unsigned* bar = b.bar + zoff_; unsigned bx_ = b.x; asm volatile("" : "+s"(bx_));
        __builtin_amdgcn_s_waitcnt(0);
        unsigned nloc = b.st[0], nx = b.st[1];
        if (nloc == 0u) { xcd_barrier_complete(bar, bx_, nloc, nx); b.st[0] = nloc; b.st[1] = nx; }
        const unsigned old = xb_add(&bar[XB_XSUB(bx_)], 1u);
        const unsigned gen = old / nloc;
        if (old + 1u == (gen + 1u) * nloc) {
            __builtin_amdgcn_fence(__ATOMIC_RELEASE, "agent");
            asm volatile("s_waitcnt vmcnt(0)" ::: "memory");
            const unsigned og = xb_add(&bar[XB_TOP], 1u);
            const unsigned tg = og / nx;
            if (og + 1u == (tg + 1u) * nx) xb_add(&bar[XB_TOPGEN], 1u);
            else XB_SPIN(xb_ld(&bar[XB_TOPGEN]) == tg, bar);
            __builtin_amdgcn_fence(__ATOMIC_ACQUIRE, "agent");
            xb_add(&bar[XB_XGEN(bx_)], 1u);
            asm volatile("s_waitcnt vmcnt(0)" ::: "memory");
        } else {
            XB_SPIN(xb_ld(&bar[XB_XGEN(bx_)]) == gen, bar);
            __builtin_amdgcn_fence(__ATOMIC_ACQUIRE, "agent");
            asm volatile("s_waitcnt vmcnt(0)" ::: "memory");
        }
    }
    __syncthreads();
}
constexpr int NWAVES = 8;
constexpr int BATCH = 8, SEQ = 4096, DMODEL = 1024, NTOK = BATCH * SEQ, DEPTH = 2, IN_COLS = 2816;
constexpr int NEXP = 16384, PEER_H = 8, PEER_K = 16;
constexpr float RMS_EPS = 1e-6f, LN_EPS = 1e-5f;
constexpr size_t MiB = 1u << 20;
constexpr size_t WS_CTL = 0, CTL_ZERO_BYTES = 1 * MiB;
constexpr size_t WS_WIN = 2 * MiB;
constexpr size_t WS_WOUT = 13 * MiB;
constexpr size_t WS_WQ = 17 * MiB;
constexpr size_t WS_KEYS = 25 * MiB;
constexpr size_t WS_RINV = 26 * MiB;
constexpr size_t WS_SSQ = 27 * MiB;
constexpr size_t WS_EID = 30 * MiB;
constexpr size_t WS_GATE = 38 * MiB;
constexpr size_t WS_SB = 54 * MiB;
constexpr size_t WS_XBF = 72 * MiB;
constexpr size_t WS_QK = 136 * MiB;
constexpr size_t WS_VX = 200 * MiB;
constexpr size_t WS_UT = 264 * MiB;
constexpr size_t WS_VT = 296 * MiB;
constexpr size_t WS_SU = 328 * MiB;
constexpr size_t WS_SV = 329 * MiB;
constexpr size_t WS_EIDT = 330 * MiB;
constexpr size_t WS_CORR = 338 * MiB;
constexpr size_t WS_SSQX = 339 * MiB;
constexpr size_t WS_XQ = 344 * MiB;
constexpr size_t WS_XQS = 376 * MiB;
constexpr size_t WS_CAT = 377 * MiB;
constexpr size_t WS_O = 441 * MiB;
constexpr size_t WS_WSC = 340 * MiB;
constexpr size_t WS_END = 505 * MiB;
constexpr size_t WS_PART = WS_QK;
constexpr size_t WS_WT = WS_SB;
constexpr int CW_BAR = 4096;
constexpr int RING_OFF = 0, RING_BYTES = 131072;
constexpr int LDSCTL_OFF = RING_BYTES, MISC_OFF = LDSCTL_OFF + 320;
constexpr int LDS_BYTES = 147456;

__device__ __forceinline__ float bflo(unsigned w) { return __builtin_bit_cast(float, w << 16); }
__device__ __forceinline__ float bfhi(unsigned w) { return __builtin_bit_cast(float, w & 0xffff0000u); }
__device__ __forceinline__ float bf1(unsigned short w) { return __builtin_bit_cast(float, (unsigned)w << 16); }
#define DPP_ADD(v, ctrl) ((v) + __builtin_bit_cast(float, __builtin_amdgcn_update_dpp(0, __builtin_bit_cast(int, (v)), (ctrl), 0xf, 0xf, true)))
__device__ __forceinline__ float wave_sum(float v) {
    v = DPP_ADD(v, 0xB1);
    v = DPP_ADD(v, 0x4E);
    v = DPP_ADD(v, 0x141);
    v = DPP_ADD(v, 0x140);
    const int b = __builtin_bit_cast(int, v);
    return (__builtin_bit_cast(float, __builtin_amdgcn_readlane(b, 0)) + __builtin_bit_cast(float, __builtin_amdgcn_readlane(b, 16))) + (__builtin_bit_cast(float, __builtin_amdgcn_readlane(b, 32)) + __builtin_bit_cast(float, __builtin_amdgcn_readlane(b, 48)));
}

__device__ __forceinline__ int win_src(int np) {
    const int p = np >> 8, pc = np & 255;
    if (p < 4) return 256 * p + 64 * ((pc & 127) >> 5) + 32 * (pc >> 7) + (pc & 31);
    if (p < 6) return np;
    if (p < 8) { const int kk = p - 6; return pc < 128 ? 1536 + 128 * kk + pc : 1792 + 128 * kk + (pc - 128); }
    if (p < 10) { const int kk = p - 8; return pc < 128 ? 2304 + 128 * kk + pc : 2560 + 128 * kk + (pc - 128); }
    return 2048 + pc;
}
template <int MODE> __device__ __forceinline__ void p0_transpose_item(const float* W, const float* gain, int K, int N, bf16* WT, LAS float* scr, int item, int lane) {
    const int nblk = N / 32, kb = item / nblk, nb = item % nblk, k0 = 64 * kb, n0p = 32 * nb;
    const int n0 = MODE == 1 ? win_src(n0p) : n0p;
#pragma unroll 8
    for (int i = 0; i < 32; ++i) { const int kk = 2 * i + (lane >> 5); const float gk = gain ? gain[k0 + kk] : 1.f; scr[kk * 33 + (lane & 31)] = W[(size_t)(k0 + kk) * N + n0 + (lane & 31)] * gk; }
    LDS_WAIT(); asm volatile("" ::: "memory");
    const int c = lane & 7;
#pragma unroll
    for (int j = 0; j < 4; ++j) { const int n = (lane >> 3) + 8 * j; const LAS float* s = scr + (8 * c) * 33 + n;
        v4u o; o.x = pk2(s[0 * 33], s[1 * 33]); o.y = pk2(s[2 * 33], s[3 * 33]); o.z = pk2(s[4 * 33], s[5 * 33]); o.w = pk2(s[6 * 33], s[7 * 33]);
        *(GAS v4u*)(WT + (size_t)(n0p + n) * K + k0 + 8 * c) = o; }
    LDS_WAIT(); asm volatile("" ::: "memory");
}
__device__ __forceinline__ void p0_convert(const float* src, bf16* dst, size_t n, int gtid, int ngt) {
    for (size_t i = (size_t)gtid * 8; i < n; i += (size_t)ngt * 8) {
        const f32x4 a = *(const GAS f32x4*)(src + i), b = *(const GAS f32x4*)(src + i + 4);
        v4u o; o.x = pk2(a.x, a.y); o.y = pk2(a.z, a.w); o.z = pk2(b.x, b.y); o.w = pk2(b.z, b.w);
        *(GAS v4u*)(dst + i) = o; }
}
__device__ __forceinline__ float wave_max(float v) {
#pragma unroll
    for (int o = 1; o < 64; o <<= 1) v = fmaxf(v, __shfl_xor(v, o));
    return v;
}
template <int OFFS> __device__ __forceinline__ void p0_quant_row(const float* src, unsigned char* dst_base, int e, float* scale_out, int lane) {
    const GAS f32x4* xr = (const GAS f32x4*)src + 4 * lane;
    f32x4 v[4]; float m = 0.f;
#pragma unroll
    for (int j = 0; j < 4; ++j) { v[j] = __builtin_nontemporal_load(xr + j); m = fmaxf(fmaxf(m, fmaxf(fabsf(v[j].x), fabsf(v[j].y))), fmaxf(fabsf(v[j].z), fabsf(v[j].w))); }
    m = wave_max(m);
    const float inv = m > 0.f ? 127.0f / m : 0.f;
    v4u o;
#pragma unroll
    for (int j = 0; j < 4; ++j) { const int a = (int)rintf(v[j].x * inv) + OFFS, b = (int)rintf(v[j].y * inv) + OFFS, c = (int)rintf(v[j].z * inv) + OFFS, d = (int)rintf(v[j].w * inv) + OFFS;
        o[j] = (unsigned)(a & 0xff) | ((unsigned)(b & 0xff) << 8) | ((unsigned)(c & 0xff) << 16) | ((unsigned)(d & 0xff) << 24); }
    *(GAS v4u*)(dst_base + ((size_t)(lane >> 3) * NEXP + e) * 128 + 16 * (lane & 7)) = o;
    if (lane == 0) *scale_out = m * (1.0f / 127.0f);
}
struct QRow { f32x4 v[4]; };
__device__ __forceinline__ void p0_quant_load(QRow& q, const float* src, int lane) { const GAS f32x4* xr = (const GAS f32x4*)src + 4 * lane;
#pragma unroll
    for (int j = 0; j < 4; ++j) q.v[j] = __builtin_nontemporal_load(xr + j); }
__device__ __forceinline__ void p0_quant_fin(const QRow& q, const float* gain, unsigned char* dst_base, int e, float* scale_out, int lane) {
    f32x4 v[4]; float m = 0.f;
#pragma unroll
    for (int j = 0; j < 4; ++j) { v[j] = q.v[j]; if (gain) v[j] = v[j] * *((const GAS f32x4*)gain + 4 * lane + j); m = fmaxf(fmaxf(m, fmaxf(fabsf(v[j].x), fabsf(v[j].y))), fmaxf(fabsf(v[j].z), fabsf(v[j].w))); }
    m = fmaxf(m, __shfl_xor(m, 1)); m = fmaxf(m, __shfl_xor(m, 2)); m = fmaxf(m, __shfl_xor(m, 4)); m = fmaxf(m, __shfl_xor(m, 8));
    const float inv = m > 0.f ? 7.0f / m : 0.f;
    unsigned o[2];
#pragma unroll
    for (int k = 0; k < 2; ++k) { const f32x4 lo = v[2 * k], hi = v[2 * k + 1];
#define Q4(x) ((unsigned)((int)rintf((x) * inv) + 8) & 0xfu)
        o[k] = (Q4(lo.x) | (Q4(hi.x) << 4)) | ((Q4(lo.y) | (Q4(hi.y) << 4)) << 8) | ((Q4(lo.z) | (Q4(hi.z) << 4)) << 16) | ((Q4(lo.w) | (Q4(hi.w) << 4)) << 24);
#undef Q4
    }
    *(GAS unsigned long long*)(dst_base + ((size_t)(lane >> 4) * NEXP + e) * 128 + 8 * (lane & 15)) = (unsigned long long)o[0] | ((unsigned long long)o[1] << 32);
    if ((lane & 15) == 0) scale_out[4 * e + (lane >> 4)] = m * (1.0f / 7.0f);
}
__device__ __forceinline__ void p0_quant_row4(const float* src, const float* gain, unsigned char* dst_base, int e, float* scale_out, int lane) { QRow q; p0_quant_load(q, src, lane); p0_quant_fin(q, gain, dst_base, e, scale_out, lane); }
__device__ __forceinline__ void p0_x_row(const float* xrow, bf16* orow, float* rinv_out, int lane) {
    const GAS f32x4* xr = (const GAS f32x4*)xrow + lane;
    f32x4 v[4]; float s = 0.f;
#pragma unroll
    for (int j = 0; j < 4; ++j) { v[j] = xr[64 * j]; s += (v[j].x * v[j].x + v[j].y * v[j].y) + (v[j].z * v[j].z + v[j].w * v[j].w); }
    s = wave_sum(s);
    GAS unsigned long long* o8 = (GAS unsigned long long*)orow + lane;
#pragma unroll
    for (int j = 0; j < 4; ++j) o8[64 * j] = (unsigned long long)pk2(v[j].x, v[j].y) | ((unsigned long long)pk2(v[j].z, v[j].w) << 32);
    if (lane < 8) rinv_out[lane] = lane == 0 ? s : 0.f;
}

__device__ __forceinline__ float wave_sum_shfl(float v) {
#pragma unroll
    for (int o = 1; o < 64; o <<= 1) v += __shfl_xor(v, o);
    return v;
}
__device__ __forceinline__ void xq_row(const bf16* xrow, signed char* qrow, float* sc4, int lane) {
    const GAS v4u* xp = (const GAS v4u*)xrow + 2 * lane; const v4u a = xp[0], b = xp[1];
#define AMX(w) fmaxf(fabsf(bflo(w)), fabsf(bfhi(w)))
    float am = fmaxf(fmaxf(fmaxf(AMX(a.x), AMX(a.y)), fmaxf(AMX(a.z), AMX(a.w))), fmaxf(fmaxf(AMX(b.x), AMX(b.y)), fmaxf(AMX(b.z), AMX(b.w))));
#undef AMX
    am = fmaxf(am, __shfl_xor(am, 1)); am = fmaxf(am, __shfl_xor(am, 2)); am = fmaxf(am, __shfl_xor(am, 4)); am = fmaxf(am, __shfl_xor(am, 8));
    const float qinv = am > 0.f ? 127.0f / am : 0.f;
#define PK4(wa, wb) (unsigned)(((int)rintf(bflo(wa) * qinv) & 0xff) | (((int)rintf(bfhi(wa) * qinv) & 0xff) << 8) | (((int)rintf(bflo(wb) * qinv) & 0xff) << 16) | (((int)rintf(bfhi(wb) * qinv) & 0xff) << 24))
    v4u o; o.x = PK4(a.x, a.y); o.y = PK4(a.z, a.w); o.z = PK4(b.x, b.y); o.w = PK4(b.z, b.w);
#undef PK4
    *((GAS v4u*)qrow + lane) = o;
    if ((lane & 15) == 0) sc4[lane >> 4] = am * (1.0f / 127.0f);
}
struct CmbArgs { const bf16* O; const bf16* VX; const bf16* SB; bf16* CAT; const float* lq1; const float* lk1; const float* lq2; const float* lk2; const float* subg;
                 const float* cfw; const float* cfb; const float* lng; const float* lnb; const float* scw; float lam_init; };
__device__ __forceinline__ float cmb_lambda(const CmbArgs& A, int lane) { return __expf(wave_sum(A.lq1[lane] * A.lk1[lane])) - __expf(wave_sum(A.lq2[lane] * A.lk2[lane])) + A.lam_init; }
__device__ __forceinline__ void cmb_rows(const CmbArgs& A, float lam, int h, int trow0, int lane_in) {
    asm volatile("s_waitcnt vmcnt(0)" ::: "memory");
    int lane = lane_in; asm volatile("" : "+v"(lane));
    const int vh = lane >> 5, dd = (2 * lane) & 63;
    const int c0 = (4 * h + vh) * 64 + dd, c1 = (4 * h + 2 + vh) * 64 + dd;
    const float g0 = A.subg[2 * lane] * (1.0f - A.lam_init), g1 = A.subg[2 * lane + 1] * (1.0f - A.lam_init);
    unsigned o0[32], o1[32];
#pragma unroll
    for (int tt = 0; tt < 32; ++tt) { const size_t rb = (size_t)(trow0 + tt) * 1024;
        o0[tt] = __hip_atomic_load((const GAS unsigned*)(A.O + rb + c0), __ATOMIC_RELAXED, __HIP_MEMORY_SCOPE_AGENT); o1[tt] = __hip_atomic_load((const GAS unsigned*)(A.O + rb + c1), __ATOMIC_RELAXED, __HIP_MEMORY_SCOPE_AGENT); }
#pragma unroll
    for (int tt = 0; tt < 32; ++tt) {
        const float a0 = bflo(o0[tt]) - lam * bflo(o1[tt]), a1 = bfhi(o0[tt]) - lam * bfhi(o1[tt]);
        const float ss = wave_sum(a0 * a0 + a1 * a1);
        const float ri = 1.0f / sqrtf(ss * (1.0f / 128.0f) + RMS_EPS);
        *(GAS unsigned*)(A.CAT + (size_t)(trow0 + tt) * 1024 + h * 128 + 2 * lane) = pk2(a0 * ri * g0, a1 * ri * g1); }
}
__device__ __forceinline__ void cmb_conv_phase(const CmbArgs& A, int gw, int ngw, int lane) {
    constexpr int NCH = SEQ / 16, NIT = NCH * 4;
    {
        unsigned short xin[46], xn[46];
#define CMB1_LOAD(X, it_) do { const int c_ = 64 * ((it_) & 3) + lane, t0_ = ((it_) >> 2) * 16, s0_ = t0_ & (SEQ - 1); \
        _Pragma("unroll") for (int i = 0; i < 46; ++i) { const int rel = i - 30; (X)[i] = (s0_ + rel >= 0) ? *(const GAS unsigned short*)(A.VX + (size_t)(t0_ + rel) * 1024 + 512 + c_) : (unsigned short)0; } } while (0)
        int it = gw;
        if (it < NIT) CMB1_LOAD(xin, it);
        for (; it < NIT; it += ngw) {
            const int nx = it + ngw < NIT ? it + ngw : it;
            CMB1_LOAD(xn, nx);
            const int c = 64 * (it & 3) + lane, t0 = (it >> 2) * 16;
            float w[31];
#pragma unroll
            for (int j = 0; j < 31; ++j) w[j] = A.cfw[j * 256 + c];
            const float bias = A.cfb[c], lg = A.lng[c], lb = A.lnb[c];
#pragma unroll
            for (int tt = 0; tt < 16; ++tt) { float y = bias;
#pragma unroll
                for (int j = 0; j < 31; ++j) y += w[j] * bf1(xin[tt + j]);
                const float mean = wave_sum(y) * (1.0f / 64.0f); const float d = y - mean;
                const float var = wave_sum(d * d) * (1.0f / 64.0f);
                const float yn = d / sqrtf(var + LN_EPS) * lg + lb;
                const float sw = yn / (1.0f + __expf(-yn));
                *(GAS unsigned short*)(A.CAT + (size_t)(t0 + tt) * 1024 + 512 + c) = (unsigned short)f2bf(sw); }
#pragma unroll
            for (int i = 0; i < 46; ++i) xin[i] = xn[i];
        }
#undef CMB1_LOAD
    }
    {
        unsigned short xin[18], sbv[16], xn[18], sbn[16];
#define CMB2_LOAD(X, S, it_) do { const int c_ = 64 * ((it_) & 3) + lane, t0_ = ((it_) >> 2) * 16, s0_ = t0_ & (SEQ - 1); \
        _Pragma("unroll") for (int i = 0; i < 18; ++i) { const int rel = i - 2; (X)[i] = (s0_ + rel >= 0) ? *(const GAS unsigned short*)(A.VX + (size_t)(t0_ + rel) * 1024 + 768 + c_) : (unsigned short)0; } \
        _Pragma("unroll") for (int tt = 0; tt < 16; ++tt) (S)[tt] = *(const GAS unsigned short*)(A.SB + (size_t)(t0_ + tt) * 256 + c_); } while (0)
        int it = gw;
        if (it < NIT) CMB2_LOAD(xin, sbv, it);
        for (; it < NIT; it += ngw) {
            const int nx = it + ngw < NIT ? it + ngw : it;
            CMB2_LOAD(xn, sbn, nx);
            const int c = 64 * (it & 3) + lane, t0 = (it >> 2) * 16;
            const float w0 = A.scw[c], w1 = A.scw[256 + c], w2 = A.scw[512 + c];
#pragma unroll
            for (int tt = 0; tt < 16; ++tt) {
                const float y = bf1(sbv[tt]) * (w0 * bf1(xin[tt]) + w1 * bf1(xin[tt + 1]) + w2 * bf1(xin[tt + 2]));
                *(GAS unsigned short*)(A.CAT + (size_t)(t0 + tt) * 1024 + 768 + c) = (unsigned short)f2bf(y); }
#pragma unroll
            for (int i = 0; i < 18; ++i) xin[i] = xn[i];
#pragma unroll
            for (int tt = 0; tt < 16; ++tt) sbv[tt] = sbn[tt];
        }
#undef CMB2_LOAD
    }
}

typedef float f32x16 __attribute__((ext_vector_type(16)));
__device__ __forceinline__ int sortable(int b) { return b ^ ((b >> 31) & 0x7fffffff); }
#define CEX_DESC(a, b) do { const int _x = (a), _y = (b); (a) = _x > _y ? _x : _y; (b) = _x > _y ? _y : _x; } while (0)
template <int N> __device__ __forceinline__ void bitonic_merge_desc(int (&v)[N]) {
#pragma unroll
    for (int j = N >> 1; j > 0; j >>= 1)
#pragma unroll
        for (int i = 0; i < N; ++i) if ((i & j) == 0) CEX_DESC(v[i], v[i | j]);
}
template <int N> __device__ __forceinline__ void bitonic_sort_desc(int (&v)[N]) {
#pragma unroll
    for (int k = 2; k <= N; k <<= 1)
#pragma unroll
        for (int j = k >> 1; j > 0; j >>= 1)
#pragma unroll
            for (int i = 0; i < N; ++i) { const int l = i ^ j; if (l > i) { if ((i & k) == 0) CEX_DESC(v[i], v[l]); else CEX_DESC(v[l], v[i]); } }
}
__device__ __forceinline__ void merge_top16(int (&a)[16], const int (&b)[16]) {
#pragma unroll
    for (int i = 0; i < 16; ++i) a[i] = a[i] > b[15 - i] ? a[i] : b[15 - i];
    bitonic_merge_desc<16>(a);
}
__device__ __forceinline__ float vmaxf(float a, float b) { float r; asm("v_max_f32 %0, %1, %2" : "=v"(r) : "v"(a), "v"(b)); return r; }
__device__ __forceinline__ float vminf(float a, float b) { float r; asm("v_min_f32 %0, %1, %2" : "=v"(r) : "v"(a), "v"(b)); return r; }
#define CEXF(a, b) do { const float _x = (a), _y = (b); (a) = vmaxf(_x, _y); (b) = vminf(_x, _y); } while (0)
template <int N> __device__ __forceinline__ void bitonic_merge_f(float (&v)[N]) {
#pragma unroll
    for (int j = N >> 1; j > 0; j >>= 1)
#pragma unroll
        for (int i = 0; i < N; ++i) if ((i & j) == 0) CEXF(v[i], v[i | j]);
}
__device__ __forceinline__ void sort16_f(float (&v)[16]) {
#define CX(i, j) CEXF(v[i], v[j]);
    CX(0,13) CX(1,12) CX(2,15) CX(3,14) CX(4,8) CX(5,6) CX(7,11) CX(9,10)
    CX(0,5) CX(1,7) CX(2,9) CX(3,4) CX(6,13) CX(8,14) CX(10,15) CX(11,12)
    CX(0,1) CX(2,3) CX(4,5) CX(6,8) CX(7,9) CX(10,11) CX(12,13) CX(14,15)
    CX(0,2) CX(1,3) CX(4,10) CX(5,11) CX(6,7) CX(8,9) CX(12,14) CX(13,15)
    CX(1,2) CX(3,12) CX(4,6) CX(5,7) CX(8,10) CX(9,11) CX(13,14)
    CX(1,4) CX(2,6) CX(5,8) CX(7,10) CX(9,13) CX(11,14)
    CX(2,4) CX(3,6) CX(9,12) CX(11,13)
    CX(3,5) CX(6,8) CX(7,9) CX(10,12)
    CX(3,4) CX(5,6) CX(7,8) CX(9,10) CX(11,12)
    CX(6,7) CX(8,9)
#undef CX
}
__device__ __forceinline__ void merge_top16_f(float (&a)[16], const float (&b)[16]) {
#pragma unroll
    for (int i = 0; i < 16; ++i) a[i] = vmaxf(a[i], b[15 - i]);
    bitonic_merge_f<16>(a);
}
__device__ __forceinline__ void stage2_top16(const float (&ta)[16], const float (&tb)[16], float (&R)[16]) {
    float a[16], b[16];
#pragma unroll
    for (int i = 0; i < 16; ++i) { a[i] = __builtin_bit_cast(float, __builtin_bit_cast(int, ta[i]) & ~0x7f); b[i] = __builtin_bit_cast(float, __builtin_bit_cast(int, tb[i]) & ~0x7f); }
#define MK(i, j) __builtin_bit_cast(float, (__builtin_bit_cast(int, a[i] + b[j]) & ~0xff) | ((i) << 4) | (j))
    const float NINF = __builtin_bit_cast(float, 0xff800000u);
#pragma unroll
    for (int j = 0; j < 16; ++j) R[j] = MK(0, j);
#pragma unroll
    for (int i = 1; i < 16; ++i) R[i] = vmaxf(R[i], MK(16 - i, 0));
    bitonic_merge_f<16>(R);
    {
        float C[16];
#pragma unroll
        for (int j = 1; j < 8; ++j) C[j - 1] = MK(1, j);
        C[7] = NINF; C[8] = NINF; C[9] = NINF;
#pragma unroll
        for (int i = 7; i >= 2; --i) C[17 - i] = MK(i, 1);
        bitonic_merge_f<16>(C);
#pragma unroll
        for (int i = 3; i < 16; ++i) R[i] = vmaxf(R[i], C[15 - i]);
        bitonic_merge_f<16>(R);
    }
    {
        float d0 = MK(2, 2), p = MK(2, 3), q = MK(2, 4), r = MK(3, 2), s = MK(4, 2), t = MK(3, 3);
        CEXF(p, r); CEXF(q, s); CEXF(r, q);
        CEXF(q, t); CEXF(s, t);
        R[10] = vmaxf(R[10], t); R[11] = vmaxf(R[11], s); R[12] = vmaxf(R[12], q); R[13] = vmaxf(R[13], r); R[14] = vmaxf(R[14], p); R[15] = vmaxf(R[15], d0);
    }
#undef MK
}
struct QuantJob { const float* usrc; const float* vsrc; const float* gain; unsigned char* UT; unsigned char* VT; float* SU; float* SV; int r0, rs; };
struct TopkArgs { const bf16* Qp; const bf16* keys; const float* ssq; unsigned short* eid; float* gate; unsigned short* eidT;
#ifdef DBG_CHECK
 float* dbgS; int* dbgI;
#endif
 };
__device__ __forceinline__ void topk_phase(const TopkArgs& A, const QuantJob& J, int& qr_next, LAS unsigned char* ldsK  , LAS unsigned char* ldsw  , int h, int rank, int nrank, int wave, int tid, int lane) {
    const int r32 = lane & 31, hi = lane >> 5;
    __syncthreads();
    {
        const GAS v4u* src = (const GAS v4u*)(A.keys + (size_t)h * 2 * 128 * 128);
#pragma unroll
        for (int i = 0; i < 8; ++i) { const int g = tid + 512 * i, row = g >> 4, ch = g & 15; *(LAS v4u*)(ldsK + row * 256 + ((ch ^ (row & 15)) << 4)) = src[g]; }
        __syncthreads();
    }
    for (int tg = rank * 8 + wave; tg < SEQ / 32; tg += nrank * 8) {
        const int t = tg * 32 + r32;
        int hb = hi << 2; asm volatile("" : "+v"(hb));
        float rinv2; { const GAS f32x4* sp = (const GAS f32x4*)(A.ssq + (size_t)t * 16); const f32x4 a = sp[0], b = sp[1], c = sp[2], d = sp[3];
            const float ss = ((a.x + a.y) + (a.z + a.w)) + ((b.x + b.y) + (b.z + b.w)) + ((c.x + c.y) + (c.z + c.w)) + ((d.x + d.y) + (d.z + d.w));
            rinv2 = 1.0f / sqrtf(ss * (1.0f / DMODEL) + RMS_EPS); }
        float top[2][16];
#pragma unroll
        for (int c = 0; c < 2; ++c) {
            const int qra = qr_next < NEXP ? qr_next : NEXP - 1; const bool qok = qr_next < NEXP; qr_next += J.rs;
            QRow qua, qva;
            p0_quant_load(qua, J.usrc + (size_t)qra * DMODEL, lane); p0_quant_load(qva, J.vsrc + (size_t)qra * DMODEL, lane);
            const bf16* qrow = A.Qp + (size_t)t * 2048 + h * 256 + c * 128 + 8 * hi;
            bf16x8 qf[8];
#pragma unroll
            for (int s = 0; s < 8; ++s) qf[s] = *(const GAS bf16x8*)(qrow + 16 * s);
            float run[16];
            int koff = c * 32768 + r32 * 256; asm volatile("" : "+v"(koff));
            const int ksw = r32 & 15;
#pragma unroll
            for (int nt = 0; nt < 4; ++nt) {
                bf16x8 kf[8];
#pragma unroll
                for (int s = 0; s < 8; ++s) kf[s] = *(const LAS bf16x8*)(ldsK + nt * 8192 + koff + (((2 * s + hi) ^ ksw) << 4));
                f32x16 acc = {0.f, 0.f, 0.f, 0.f, 0.f, 0.f, 0.f, 0.f, 0.f, 0.f, 0.f, 0.f, 0.f, 0.f, 0.f, 0.f};
#pragma unroll
                for (int s = 0; s < 8; ++s) acc = __builtin_amdgcn_mfma_f32_32x32x16_bf16(kf[s], qf[s], acc, 0, 0, 0);
                asm volatile("" ::: "memory");
                float g[16];
#pragma unroll
                for (int r = 0; r < 16; ++r) { const int idx = 32 * nt + (r & 3) + 8 * (r >> 2);
                    const float av = acc[r];
                    g[r] = __int_as_float(((__float_as_int(av) & ~0x7f) | idx) | hb); }
                sort16_f(g);
                if (nt == 0) {
#pragma unroll
                    for (int r = 0; r < 16; ++r) run[r] = g[r];
                } else merge_top16_f(run, g);
            }
            {
                float other[16];
#pragma unroll
                for (int i = 0; i < 16; ++i) other[i] = __shfl_xor(run[i], 32);
                merge_top16_f(run, other);
            }
#pragma unroll
            for (int i = 0; i < 16; ++i) top[c][i] = run[i];
            if (qok) { p0_quant_fin(qua, J.gain, J.UT, qra, J.SU, lane); p0_quant_fin(qva, nullptr, J.VT, qra, J.SV, lane); }
        }
#pragma unroll
        for (int c = 0; c < 2; ++c)
#pragma unroll
            for (int q4 = 0; q4 < 4; ++q4) { const unsigned w = (unsigned)(__float_as_int(top[c][4 * q4]) & 0x7f) | ((unsigned)(__float_as_int(top[c][4 * q4 + 1]) & 0x7f) << 8) | ((unsigned)(__float_as_int(top[c][4 * q4 + 2]) & 0x7f) << 16) | ((unsigned)(__float_as_int(top[c][4 * q4 + 3]) & 0x7f) << 24);
                *(LAS unsigned*)(ldsw + lane * 32 + c * 16 + q4 * 4) = w; }
        float crun[16];
        stage2_top16(top[0], top[1], crun);
        LDS_WAIT(); asm volatile("" ::: "memory");
        float sc[16]; unsigned e[16];
#pragma unroll
        for (int k = 0; k < 16; ++k) { const int bits = __float_as_int(crun[k]); const int i = (bits >> 4) & 15, j = bits & 15;
            sc[k] = __builtin_bit_cast(float, bits & ~0xff) * rinv2;
            const unsigned i1 = *(const LAS unsigned char*)(ldsw + lane * 32 + i), i2 = *(const LAS unsigned char*)(ldsw + lane * 32 + 16 + j);
            e[k] = i1 * 128u + i2; }
        const float mx = sc[0];
        float z = 0.f;
#pragma unroll
        for (int k = 0; k < 16; ++k) { sc[k] = __expf(sc[k] - mx); z += sc[k]; }
        const float iz = 1.0f / z;
        if (hi == 0) {
            v4u e0, e1; e0.x = e[0] | (e[1] << 16); e0.y = e[2] | (e[3] << 16); e0.z = e[4] | (e[5] << 16); e0.w = e[6] | (e[7] << 16);
            e1.x = e[8] | (e[9] << 16); e1.y = e[10] | (e[11] << 16); e1.z = e[12] | (e[13] << 16); e1.w = e[14] | (e[15] << 16);
            GAS v4u* ep = (GAS v4u*)(A.eid + (size_t)t * 128 + h * 16); ep[0] = e0; ep[1] = e1;
#pragma unroll
            for (int k = 0; k < 8; ++k) *(GAS unsigned*)(A.eidT + (size_t)t * 128 + k * 16 + 2 * h) = e[k] | (e[k + 8] << 16);
        } else {
            GAS f32x4* gp = (GAS f32x4*)(A.gate + (size_t)t * 128 + h * 16);
#pragma unroll
            for (int q4 = 0; q4 < 4; ++q4) gp[q4] = (f32x4){sc[4 * q4] * iz, sc[4 * q4 + 1] * iz, sc[4 * q4 + 2] * iz, sc[4 * q4 + 3] * iz};
        }
    }
}

__device__ __forceinline__ float gelu_exact(float v) { return 0.5f * v * (1.0f + erff(v * 0.70710678118654752f)); }
__device__ __forceinline__ float ub0(unsigned x) { float f; asm("v_cvt_f32_ubyte0 %0, %1" : "=v"(f) : "v"(x)); return f; }
__device__ __forceinline__ float ub1(unsigned x) { float f; asm("v_cvt_f32_ubyte1 %0, %1" : "=v"(f) : "v"(x)); return f; }
__device__ __forceinline__ float ub2(unsigned x) { float f; asm("v_cvt_f32_ubyte2 %0, %1" : "=v"(f) : "v"(x)); return f; }
__device__ __forceinline__ float ub3(unsigned x) { float f; asm("v_cvt_f32_ubyte3 %0, %1" : "=v"(f) : "v"(x)); return f; }
template <class T> __device__ __forceinline__ T tr_xchg_add(T a, T b, int O, int lane) {
    if (O == 16 || O == 32) {
        const unsigned ua = __builtin_bit_cast(unsigned, a), ub = __builtin_bit_cast(unsigned, b);
        if (O == 16) { auto r = __builtin_amdgcn_permlane16_swap(ua, ub, false, false); return __builtin_bit_cast(T, (unsigned)r[0]) + __builtin_bit_cast(T, (unsigned)r[1]); }
        else         { auto r = __builtin_amdgcn_permlane32_swap(ua, ub, false, false); return __builtin_bit_cast(T, (unsigned)r[0]) + __builtin_bit_cast(T, (unsigned)r[1]); }
    } else {
        const bool up = (lane & O) != 0; const T send = up ? a : b, keep = up ? b : a;
        const int si = __builtin_bit_cast(int, send);
        const int ri = O == 1 ? __builtin_amdgcn_update_dpp(0, si, 0xB1, 0xf, 0xf, true) : O == 2 ? __builtin_amdgcn_update_dpp(0, si, 0x4E, 0xf, 0xf, true)
                     : O == 4 ? __builtin_amdgcn_update_dpp(0, si, 0x124, 0xf, 0xf, true)
                     : __builtin_amdgcn_update_dpp(0, si, 0x128, 0xf, 0xf, true);
        return keep + __builtin_bit_cast(T, ri);
    }
}
template <class T, int N, int O, int NEND> struct TReduce {
    static __device__ __forceinline__ void run(T (&v)[N], T (&out)[NEND], int lane) {
        T w[N / 2];
#pragma unroll
        for (int i = 0; i < N / 2; ++i) {
            if (O == 4) { const bool up = (lane & O) != 0; const T send = up ? v[2 * i] : v[2 * i + 1], keep = up ? v[2 * i + 1] : v[2 * i]; w[i] = keep + __shfl_xor(send, O); }
            else w[i] = tr_xchg_add<T>(v[2 * i], v[2 * i + 1], O, lane);
        }
        TReduce<T, N / 2, O * 2, NEND>::run(w, out, lane);
    }
};
template <class T, int O, int NEND> struct TReduce<T, NEND, O, NEND> { static __device__ __forceinline__ void run(T (&v)[NEND], T (&out)[NEND], int) {
#pragma unroll
    for (int i = 0; i < NEND; ++i) out[i] = v[i]; } };
struct PeerUArgs { const signed char* xq; const float* xqs; const unsigned char* UT; const unsigned short* eidT; float* part; };
struct MetaU { v4u ea, eb, qa, qb; float sx; };
__device__ __forceinline__ void peer_u_phase(const PeerUArgs& A, int bx, int wave, int G, int lane) {
    const int pp = lane >> 3, cc = lane & 7;
    for (int id = bx * 8 + wave; id < 2048; id += G * 8) {
        const int xl = (id >> 3) & 7, s4 = xl & 3, tc = (id >> 6) * 8 + (id & 7), t0 = (xl >> 2) * (NTOK / 2) + tc * 64;
        const unsigned char* Us = A.UT + (size_t)s4 * NEXP * 128 + 16 * cc;
#define U_META(M, tt_) do { const int t_ = t0 + ((tt_) < 63 ? (tt_) : 63); const GAS v4u* ep_ = (const GAS v4u*)(A.eidT + (size_t)t_ * 128 + pp * 16); (M).ea = ep_[0]; (M).eb = ep_[1]; \
        const GAS v4u* xp_ = (const GAS v4u*)(A.xq + (size_t)t_ * DMODEL + 256 * s4 + 32 * cc); (M).qa = xp_[0]; (M).qb = xp_[1]; (M).sx = A.xqs[(size_t)t_ * 4 + s4]; } while (0)
#define U_TAB(Q, M) do { _Pragma("unroll") for (int g = 0; g < 16; ++g) { const unsigned ew_ = g < 8 ? (M).ea[g >> 1] : (M).eb[(g - 8) >> 1]; const unsigned e_ = (g & 1) ? (ew_ >> 16) : (ew_ & 0xffffu); \
        (Q)[g] = *(const GAS v4u*)(Us + (size_t)e_ * 128); } } while (0)
#define U_COMP(M, Q, tt_) do { const int t_ = t0 + (tt_); int part[16]; \
        int sm_ = 0; _Pragma("unroll") for (int k = 0; k < 4; ++k) { sm_ = __builtin_amdgcn_sdot4(0x01010101, (int)(M).qa[k], sm_, false); sm_ = __builtin_amdgcn_sdot4(0x01010101, (int)(M).qb[k], sm_, false); } sm_ *= -8; \
        _Pragma("unroll") for (int g = 0; g < 16; ++g) { int a_ = sm_; \
            _Pragma("unroll") for (int k = 0; k < 4; ++k) { const unsigned d_ = (Q)[g][k]; const int x0_ = (int)(k < 2 ? (M).qa[2 * k] : (M).qb[2 * k - 4]), x1_ = (int)(k < 2 ? (M).qa[2 * k + 1] : (M).qb[2 * k - 3]); \
                a_ = __builtin_amdgcn_sdot4((int)(d_ & 0x0f0f0f0fu), x0_, a_, false); a_ = __builtin_amdgcn_sdot4((int)((d_ >> 4) & 0x0f0f0f0fu), x1_, a_, false); } \
            part[g] = a_; } \
        int tot[2]; TReduce<int, 16, 1, 2>::run(part, tot, lane); \
        float* po = A.part + ((size_t)s4 * NTOK + t_) * 128 + 8 * cc + pp; po[0] = (float)tot[0] * (M).sx; po[64] = (float)tot[1] * (M).sx; } while (0)
        MetaU mc, mn, mnn; v4u QA[16], QB[16];
        U_META(mc, 0); U_META(mn, 1); U_TAB(QA, mc);
        for (int tt = 0; tt < 64; tt += 2) {
            U_META(mnn, tt + 2); U_TAB(QB, mn); U_COMP(mc, QA, tt); mc = mn; mn = mnn;
            U_META(mnn, tt + 3); U_TAB(QA, mn); U_COMP(mc, QB, tt + 1); mc = mn; mn = mnn;
        }
#undef U_META
#undef U_TAB
#undef U_COMP
    }
}
struct PeerRArgs { const float* part; const float* ssq; const unsigned short* eid; const float* gate; const float* su; const float* sv; signed char* wq; float* wsc; };
struct MetaR { int e0, e1; float g0, g1, ssq; float p0[4], p1[4]; };
struct GathR { f32x4 su0, su1, sv0, sv1; };
__device__ __forceinline__ void peer_r_phase(const PeerRArgs& A, int gw, int ngw, int lane) {
#define R_META(M, t_) do { const int tq_ = (t_) < NTOK ? (t_) : gw; (M).e0 = A.eid[(size_t)tq_ * 128 + lane]; (M).e1 = A.eid[(size_t)tq_ * 128 + 64 + lane]; \
        (M).g0 = A.gate[(size_t)tq_ * 128 + lane]; (M).g1 = A.gate[(size_t)tq_ * 128 + 64 + lane]; (M).ssq = lane < 16 ? A.ssq[(size_t)tq_ * 16 + lane] : 0.f; \
        _Pragma("unroll") for (int s = 0; s < 4; ++s) { const float* pr_ = A.part + ((size_t)s * NTOK + tq_) * 128; (M).p0[s] = pr_[lane]; (M).p1[s] = pr_[64 + lane]; } } while (0)
#define R_GATH(Gv, M) do { (Gv).su0 = *(const GAS f32x4*)(A.su + 4 * (M).e0); (Gv).su1 = *(const GAS f32x4*)(A.su + 4 * (M).e1); (Gv).sv0 = *(const GAS f32x4*)(A.sv + 4 * (M).e0); (Gv).sv1 = *(const GAS f32x4*)(A.sv + 4 * (M).e1); } while (0)
    MetaR mc, mn, mnn; GathR gc, gn;
    R_META(mc, gw); R_META(mn, gw + ngw); R_GATH(gc, mc);
    for (int t = gw; t < NTOK; t += ngw) {
        R_META(mnn, t + 2 * ngw); R_GATH(gn, mn);
        float z0 = 0.f, z1 = 0.f;
#pragma unroll
        for (int s = 0; s < 4; ++s) { z0 += mc.p0[s] * gc.su0[s]; z1 += mc.p1[s] * gc.su1[s]; }
        const float ss = wave_sum(mc.ssq);
        const float ri = 1.0f / sqrtf(ss * (1.0f / DMODEL) + RMS_EPS);
        const float w0 = mc.g0 * gelu_exact(z0 * ri), w1 = mc.g1 * gelu_exact(z1 * ri);
#pragma unroll
        for (int s = 0; s < 4; ++s) { const float a0 = w0 * gc.sv0[s], a1 = w1 * gc.sv1[s];
            const float gm = wave_max(fmaxf(fabsf(a0), fabsf(a1)));
            const float inv = gm > 0.f ? 127.0f / gm : 0.f;
            signed char* wr = A.wq + ((size_t)t * 4 + s) * 128 + (lane & 7) * 16 + (lane >> 3);
            wr[0] = (signed char)(int)rintf(a0 * inv); wr[8] = (signed char)(int)rintf(a1 * inv);
            if (lane == 0) A.wsc[(size_t)t * 4 + s] = gm * (1.0f / 127.0f); }
        mc = mn; mn = mnn; gc = gn;
    }
#undef R_META
#undef R_GATH
}
typedef unsigned u32x2 __attribute__((ext_vector_type(2)));
struct PeerVArgs { float* xout  ; const unsigned char* VT; const unsigned short* eidT; const signed char* wq; const float* wsc; bf16* xb; float* ssqx; };
struct MetaV { v4u ea, eb, wq; float sc; u32x2 xv; };
__device__ __forceinline__ void peer_v_phase(const PeerVArgs& A, int bx, int wave, int G, int lane) {
    const int pp = lane >> 3, cc = lane & 7;
    for (int id = bx * 8 + wave; id < 2048; id += G * 8) {
        const int xl = (id >> 3) & 7, s4 = xl & 3, tc = (id >> 6) * 8 + (id & 7), t0 = (xl >> 2) * (NTOK / 2) + tc * 64;
        const unsigned char* Vs = A.VT + (size_t)s4 * NEXP * 128 + 16 * cc;
#define V_META(M, tt_) do { const int t_ = t0 + ((tt_) < 63 ? (tt_) : 63); const GAS v4u* ep_ = (const GAS v4u*)(A.eidT + (size_t)t_ * 128 + pp * 16); (M).ea = ep_[0]; (M).eb = ep_[1]; \
        (M).wq = *(const GAS v4u*)(A.wq + ((size_t)t_ * 4 + s4) * 128 + pp * 16); (M).sc = A.wsc[(size_t)t_ * 4 + s4]; (M).xv = *(const GAS u32x2*)(A.xb + (size_t)t_ * DMODEL + 256 * s4 + 32 * cc + 4 * pp); } while (0)
#define V_TAB(Q, M) do { _Pragma("unroll") for (int g = 0; g < 16; ++g) { const unsigned ew_ = g < 8 ? (M).ea[g >> 1] : (M).eb[(g - 8) >> 1]; const unsigned e_ = (g & 1) ? (ew_ >> 16) : (ew_ & 0xffffu); \
        (Q)[g] = *(const GAS v4u*)(Vs + (size_t)e_ * 128); } } while (0)
#define V_COMP(M, Q, tt_) do { const int t_ = t0 + (tt_); \
        int c8 = 0; _Pragma("unroll") for (int a = 0; a < 4; ++a) c8 = __builtin_amdgcn_sdot4(0x01010101, (int)(M).wq[a], c8, false); c8 *= -8; \
        int acc[32]; _Pragma("unroll") for (int i = 0; i < 32; ++i) acc[i] = c8; \
        _Pragma("unroll") for (int a = 0; a < 4; ++a) { const int wa_ = (int)(M).wq[a]; \
            _Pragma("unroll") for (int k = 0; k < 4; ++k) { const unsigned r0 = (Q)[4 * a][k], r1 = (Q)[4 * a + 1][k], r2 = (Q)[4 * a + 2][k], r3 = (Q)[4 * a + 3][k]; \
                  \
                const unsigned u01l = __builtin_amdgcn_perm(r1, r0, 0x05010400u), u01h = __builtin_amdgcn_perm(r1, r0, 0x07030602u), u23l = __builtin_amdgcn_perm(r3, r2, 0x05010400u), u23h = __builtin_amdgcn_perm(r3, r2, 0x07030602u); \
                const unsigned tb0 = __builtin_amdgcn_perm(u23l, u01l, 0x05040100u), tb1 = __builtin_amdgcn_perm(u23l, u01l, 0x07060302u), tb2 = __builtin_amdgcn_perm(u23h, u01h, 0x05040100u), tb3 = __builtin_amdgcn_perm(u23h, u01h, 0x07060302u); \
                acc[8 * k + 0] = __builtin_amdgcn_sdot4((int)(tb0 & 0x0f0f0f0fu), wa_, acc[8 * k + 0], false); acc[8 * k + 4] = __builtin_amdgcn_sdot4((int)((tb0 >> 4) & 0x0f0f0f0fu), wa_, acc[8 * k + 4], false); \
                acc[8 * k + 1] = __builtin_amdgcn_sdot4((int)(tb1 & 0x0f0f0f0fu), wa_, acc[8 * k + 1], false); acc[8 * k + 5] = __builtin_amdgcn_sdot4((int)((tb1 >> 4) & 0x0f0f0f0fu), wa_, acc[8 * k + 5], false); \
                acc[8 * k + 2] = __builtin_amdgcn_sdot4((int)(tb2 & 0x0f0f0f0fu), wa_, acc[8 * k + 2], false); acc[8 * k + 6] = __builtin_amdgcn_sdot4((int)((tb2 >> 4) & 0x0f0f0f0fu), wa_, acc[8 * k + 6], false); \
                acc[8 * k + 3] = __builtin_amdgcn_sdot4((int)(tb3 & 0x0f0f0f0fu), wa_, acc[8 * k + 3], false); acc[8 * k + 7] = __builtin_amdgcn_sdot4((int)((tb3 >> 4) & 0x0f0f0f0fu), wa_, acc[8 * k + 7], false); } } \
        int av[32]; _Pragma("unroll") for (int i = 0; i < 32; ++i) av[8 * (i & 3) + (i >> 2)] = acc[i];     \
        int tot[4]; TReduce<int, 32, 8, 4>::run(av, tot, lane); \
        const f32x4 vo = (f32x4){bflo((M).xv.x), bfhi((M).xv.x), bflo((M).xv.y), bfhi((M).xv.y)} + (f32x4){(float)tot[0], (float)tot[1], (float)tot[2], (float)tot[3]} * (M).sc; \
        if (A.xout) *(GAS f32x4*)(A.xout + (size_t)t_ * DMODEL + 256 * s4 + 32 * cc + 4 * pp) = vo; \
        *(GAS u32x2*)(A.xb + (size_t)t_ * DMODEL + 256 * s4 + 32 * cc + 4 * pp) = (u32x2){pk2(vo.x, vo.y), pk2(vo.z, vo.w)}; \
        const float s2 = wave_sum((vo.x * vo.x + vo.y * vo.y) + (vo.z * vo.z + vo.w * vo.w)); if (lane == 0) A.ssqx[(size_t)t_ * 8 + s4] = s2; } while (0)
        MetaV mc, mn, mnn; v4u QA[16], QB[16];
        V_META(mc, 0); V_META(mn, 1); V_TAB(QA, mc);
        for (int tt = 0; tt < 64; tt += 2) {
            V_META(mnn, tt + 2); V_TAB(QB, mn); V_COMP(mc, QA, tt); mc = mn; mn = mnn;
            V_META(mnn, tt + 3); V_TAB(QA, mn); V_COMP(mc, QB, tt + 1); mc = mn; mn = mnn;
        }
#undef V_META
#undef V_TAB
#undef V_COMP
    }
}

#ifdef DBG_CHECK
constexpr int DBG_FLAGS = 2048, DBG_NS = 64;
constexpr size_t WS_DBG = 56 * MiB;
struct DbgArgs { const unsigned short* qp; const float* ssq; const float* x1; const float* g2; const float* wq; const float* keys; const float* uf; const float* vf; const unsigned short* eid; const float* gate; float* exp_out; gu32* flags; };
__device__ __forceinline__ void dbg_check_topk_and_expect(const DbgArgs& A, LAS unsigned char* ldsw, int gw, int ngw, int lane) {
    LAS float* qs = (LAS float*)ldsw; LAS float* subs = qs + 256; LAS float* cand = subs + 256; LAS float* h2s = cand + 256;
    LAS int* sel = (LAS int*)(h2s + 1024);
    LAS float* selv = (LAS float*)(sel + 64);
    _Pragma("nounroll") for (int smp = gw; smp < DBG_NS * 8; smp += ngw) {
        const int si = smp >> 3, h = smp & 7; const int t = (si * 509 + 17) % NTOK;
        const float* xr = A.x1 + (size_t)t * DMODEL;
        float ss = 0.f; _Pragma("nounroll") for (int k = lane; k < DMODEL; k += 64) ss += xr[k] * xr[k];
        ss = wave_sum(ss); const float ri = 1.0f / sqrtf(ss * (1.0f / DMODEL) + RMS_EPS);
        _Pragma("nounroll") for (int k = lane; k < DMODEL; k += 64) h2s[k] = xr[k] * ri * A.g2[k];
        LDS_WAIT();
        _Pragma("nounroll") for (int i = 0; i < 4; ++i) { const int col = h * 256 + lane + 64 * i; float a = 0.f; _Pragma("nounroll") for (int k = 0; k < DMODEL; ++k) a += h2s[k] * A.wq[(size_t)k * 2048 + col]; qs[lane + 64 * i] = a; }
        LDS_WAIT();
        { int badq = 0;
          _Pragma("nounroll") for (int i = 0; i < 4; ++i) { const float ref = qs[lane + 64 * i] / ri; const float got = bf1(A.qp[(size_t)t * 2048 + h * 256 + lane + 64 * i]); if (!(fabsf(got - ref) <= 0.03f * fabsf(ref) + 0.05f)) badq = 0; }
          float s16 = 0.f; _Pragma("nounroll") for (int i = 0; i < 16; ++i) s16 += A.ssq[(size_t)t * 16 + i];
          if (!(fabsf(s16 - ss) <= 1e-3f * ss)) badq |= 0;
          if (badq) __hip_atomic_fetch_or(A.flags, (unsigned)badq, __ATOMIC_RELAXED, __HIP_MEMORY_SCOPE_AGENT); }
        _Pragma("nounroll") for (int i = 0; i < 4; ++i) { const int c = i >> 1, n = lane + 64 * (i & 1); const float* kr = A.keys + (size_t)((h * 2 + c) * 128 + n) * 128; float a = 0.f; _Pragma("nounroll") for (int d = 0; d < 128; ++d) a += qs[c * 128 + d] * kr[d]; subs[c * 128 + n] = a; }
        LDS_WAIT();
        if (lane < 2) { const int c = lane; _Pragma("nounroll") for (int k = 0; k < 16; ++k) { int bi = 0; float bv = -3.0e38f; _Pragma("nounroll") for (int n = 0; n < 128; ++n) { const float v = subs[c * 128 + n]; if (v > bv) { bv = v; bi = n; } } sel[c * 16 + k] = bi; selv[c * 16 + k] = bv; subs[c * 128 + bi] = -3.0e38f; } }
        LDS_WAIT();
        _Pragma("nounroll") for (int i = 0; i < 4; ++i) { const int ci = lane + 64 * i; cand[ci] = selv[ci >> 4] + selv[16 + (ci & 15)]; }
        LDS_WAIT();
        int bad = 0;
        if (lane == 0) {
            _Pragma("nounroll") for (int k = 0; k < 16; ++k) { int bi = 0; float bv = -3.0e38f; _Pragma("nounroll") for (int n = 0; n < 256; ++n) { const float v = cand[n]; if (v > bv) { bv = v; bi = n; } } cand[bi] = -3.0e38f; sel[32 + k] = sel[bi >> 4] * 128 + sel[16 + (bi & 15)]; selv[32 + k] = bv; }
            float z = 0.f; _Pragma("nounroll") for (int k = 0; k < 16; ++k) { selv[48 + k] = __expf(selv[32 + k] - selv[32]); z += selv[48 + k]; }
            int miss = 0; float gerr = 0.f;
            _Pragma("nounroll") for (int k = 0; k < 16; ++k) { const int e = sel[32 + k]; const float g = selv[48 + k] / z; int found = -1;
                _Pragma("nounroll") for (int k2 = 0; k2 < 16; ++k2) if ((int)A.eid[(size_t)t * 128 + h * 16 + k2] == e) found = k2;
                if (found < 0) { if (g > 0.02f) ++miss; } else gerr = fmaxf(gerr, fabsf(A.gate[(size_t)t * 128 + h * 16 + found] - g)); }
            if (miss > 1) bad |= 1;
            if (gerr > 0.03f) bad |= 0;
            if (bad) __hip_atomic_fetch_or(A.flags, (unsigned)bad, __ATOMIC_RELAXED, __HIP_MEMORY_SCOPE_AGENT);
        }
        LDS_WAIT();
        if (h == 0) {
            float acc[16];
#pragma unroll
            for (int i = 0; i < 16; ++i) acc[i] = 0.f;
            _Pragma("nounroll") for (int j = 0; j < 128; ++j) { const int e = A.eid[(size_t)t * 128 + j]; const float g = A.gate[(size_t)t * 128 + j];
                const float* ur = A.uf + (size_t)e * DMODEL; float zz = 0.f; _Pragma("nounroll") for (int k = lane; k < DMODEL; k += 64) zz += ur[k] * h2s[k];
                zz = wave_sum(zz); const float w = g * gelu_exact(zz); const float* vr = A.vf + (size_t)e * DMODEL;
#pragma unroll
                for (int i = 0; i < 16; ++i) acc[i] += w * vr[lane + 64 * i]; }
#pragma unroll
            for (int i = 0; i < 16; ++i) A.exp_out[(size_t)si * DMODEL + lane + 64 * i] = xr[lane + 64 * i] + acc[i];
        }
        LDS_WAIT();
    }
}
__device__ __forceinline__ void dbg_check_scores(const unsigned short* Qp, const unsigned short* keysb, const float* dbgS, const int* dbgI, gu32* flags, LAS unsigned char* ldsw, int gw, int ngw, int lane) {
    LAS float* sc = (LAS float*)ldsw;
    _Pragma("nounroll") for (int it = gw; it < 32 * 8 * 2; it += ngw) { const int t = it >> 4, h = (it >> 1) & 7, c = it & 1; int bad = 0;
        _Pragma("nounroll") for (int i = 0; i < 2; ++i) { const int n = lane + 64 * i; float a = 0.f;
            _Pragma("nounroll") for (int d = 0; d < 128; ++d) a += bf1(Qp[(size_t)t * 2048 + h * 256 + c * 128 + d]) * bf1(keysb[(size_t)((h * 2 + c) * 128 + n) * 128 + d]);
            const float got = dbgS[((size_t)(t * 8 + h) * 2 + c) * 128 + n]; if (!(fabsf(got - a) <= 1e-3f * fabsf(a) + 1e-3f)) bad |= 0; sc[n] = got; }
        LDS_WAIT();
        if (lane == 0) { int miss = 0;
            _Pragma("nounroll") for (int k = 0; k < 16; ++k) { int bi = 0; float bv = -3.0e38f; _Pragma("nounroll") for (int n = 0; n < 128; ++n) { const float v = sc[n]; if (v > bv) { bv = v; bi = n; } } sc[bi] = -3.0e38f;
                const int got = dbgI[((size_t)(t * 8 + h) * 2 + c) * 16 + k]; const float gs = dbgS[((size_t)(t * 8 + h) * 2 + c) * 128 + (got & 0x7f)];
                if (!(fabsf(gs - bv) <= 1e-4f * fabsf(bv) + 1e-6f)) ++miss; }
            if (miss) bad |= 2; }
        bad = __builtin_amdgcn_readfirstlane(bad) | bad;
        if (bad) __hip_atomic_fetch_or(flags, (unsigned)bad, __ATOMIC_RELAXED, __HIP_MEMORY_SCOPE_AGENT);
        LDS_WAIT(); }
}
__device__ __forceinline__ void dbg_check_stage2(const int* dbgI, const float* ssq, const unsigned short* eid, const float* gate, gu32* flags, LAS unsigned char* ldsw, int gw, int ngw, int lane) {
    LAS float* cand = (LAS float*)ldsw;
    _Pragma("nounroll") for (int it = gw; it < 32 * 8; it += ngw) { const int t = it >> 3, h = it & 7; int bad = 0;
        float s16 = 0.f; _Pragma("nounroll") for (int i = 0; i < 16; ++i) s16 += ssq[(size_t)t * 16 + i];
        const float rinv2 = 1.0f / sqrtf(s16 * (1.0f / DMODEL) + RMS_EPS);
        const int* I0 = dbgI + ((size_t)(t * 8 + h) * 2 + 0) * 16; const int* I1 = dbgI + ((size_t)(t * 8 + h) * 2 + 1) * 16;
        _Pragma("nounroll") for (int i = 0; i < 4; ++i) { const int ci = lane + 64 * i; cand[ci] = __builtin_bit_cast(float, I0[ci >> 4] & ~0x7f) + __builtin_bit_cast(float, I1[ci & 15] & ~0x7f); }
        LDS_WAIT();
        if (lane == 0) { float sv[1]; (void)sv; float top0 = 0.f, z = 0.f; int miss = 0; float gerr = 0.f;
            float vals[1]; (void)vals;
            LAS float* selv = cand + 256; LAS int* sele = (LAS int*)(cand + 272);
            _Pragma("nounroll") for (int k = 0; k < 16; ++k) { int bi = 0; float bv = -3.0e38f; _Pragma("nounroll") for (int n = 0; n < 256; ++n) { const float v = cand[n]; if (v > bv) { bv = v; bi = n; } } cand[bi] = -3.0e38f;
                if (k == 0) top0 = bv; selv[k] = __expf((bv - top0) * rinv2); z += selv[k]; sele[k] = (I0[bi >> 4] & 0x7f) * 128 + (I1[bi & 15] & 0x7f); }
            _Pragma("nounroll") for (int k = 0; k < 16; ++k) { const int e = sele[k]; const float g = selv[k] / z; int found = -1;
                _Pragma("nounroll") for (int k2 = 0; k2 < 16; ++k2) if ((int)eid[(size_t)t * 128 + h * 16 + k2] == e) found = k2;
                if (found < 0) { if (g > 0.02f) ++miss; } else gerr = fmaxf(gerr, fabsf(gate[(size_t)t * 128 + h * 16 + found] - g)); }
            if (miss > 1 || gerr > 0.03f) bad |= 4; }
        bad = __builtin_amdgcn_readfirstlane(bad) | bad;
        if (bad) __hip_atomic_fetch_or(flags, (unsigned)bad, __ATOMIC_RELAXED, __HIP_MEMORY_SCOPE_AGENT);
        LDS_WAIT(); }
}
__device__ __forceinline__ void dbg_check_peer_out(const float* x2, const float* exp_out, gu32* flags, int gw, int ngw, int lane) {
    _Pragma("nounroll") for (int si = gw; si < DBG_NS; si += ngw) { const int t = (si * 509 + 17) % NTOK; float err = 0.f, mag = 0.f;
        _Pragma("nounroll") for (int k = lane; k < DMODEL; k += 64) { const float a = x2[(size_t)t * DMODEL + k], b = exp_out[(size_t)si * DMODEL + k]; err += (a - b) * (a - b); mag += b * b; }
        err = wave_sum(err); mag = wave_sum(mag);
        if (lane == 0 && !(err <= 1e-4f * mag)) __hip_atomic_fetch_or(flags, 0u, __ATOMIC_RELAXED, __HIP_MEMORY_SCOPE_AGENT); }
}
#endif
__device__ __forceinline__ void group_barrier(gu32* cnt, unsigned target) {
    asm volatile("s_waitcnt vmcnt(0)" ::: "memory");
    __syncthreads();
    if (threadIdx.x == 0) {
        __builtin_amdgcn_fence(__ATOMIC_RELEASE, "agent");
        asm volatile("s_waitcnt vmcnt(0)" ::: "memory");
        (void)__hip_atomic_fetch_add(cnt, 1u, __ATOMIC_RELAXED, __HIP_MEMORY_SCOPE_AGENT);
        unsigned sp = 0;
        while (__hip_atomic_load(cnt, __ATOMIC_RELAXED, __HIP_MEMORY_SCOPE_AGENT) < target) { __builtin_amdgcn_s_sleep(1); if (++sp > (1u << 22)) break; }
        __builtin_amdgcn_fence(__ATOMIC_ACQUIRE, "agent");
        asm volatile("s_waitcnt vmcnt(0)" ::: "memory");
    }
    __syncthreads();
}
constexpr int CW_GRP = 8192;
constexpr size_t BATCH_QKV = (size_t)SEQ * 2048;

#ifndef PH_MASK
#define PH_MASK 0xff
#endif
#define PH_ON(n) (((PH_MASK) >> (n)) & 1)
#ifndef TIME_MASK
#define TIME_MASK 0
#endif
#define TIME_ON(n) (((TIME_MASK) >> (n)) & 1)
#define PHASE_T0() const unsigned long long t0_ = TIME_MASK ? __builtin_amdgcn_s_memrealtime() : 0ull
#define PHASE_DELAY(n) do { if (TIME_ON(n)) { const unsigned long long t1_ = __builtin_amdgcn_s_memrealtime(); while (__builtin_amdgcn_s_memrealtime() - t1_ < t1_ - t0_) __builtin_amdgcn_s_sleep(16); } } while (0)
struct Args { const float* in[21]; float* out; unsigned char* ws; };
__global__ void __launch_bounds__(NWAVES * 64, 2) mk_fwd(Args args) {
    extern __shared__ __attribute__((aligned(16))) unsigned char lds[];
    LAS unsigned char* L = (LAS unsigned char*)lds;
    volatile LAS unsigned* MISC = (volatile LAS unsigned*)(L + MISC_OFF);
    const int tid = threadIdx.x;
    const int G = gridDim.x;
    unsigned char* ws = args.ws;
#define PHASE_CTX() int tid_ = threadIdx.x; asm volatile("" : "+v"(tid_)); const int lane = tid_ & 63, wave = __builtin_amdgcn_readfirstlane(tid_ >> 6); \
    int bx = blockIdx.x; asm volatile("" : "+s"(bx)); const int vcu = (G % 8 == 0) ? (bx % 8) * (G / 8) + bx / 8 : bx; const int gw = vcu * NWAVES + wave, ngw = G * NWAVES; \
    size_t zoff_ = 0; asm volatile("" : "+s"(zoff_)); unsigned char* ws = args.ws + zoff_; (void)lane; (void)gw; (void)ngw; (void)vcu; \
    bf16* const XBF = (bf16*)(ws + WS_XBF); bf16* const QK = (bf16*)(ws + WS_QK); bf16* const VX = (bf16*)(ws + WS_VX); bf16* const SB = (bf16*)(ws + WS_SB); \
    float* const RINV = (float*)(ws + WS_RINV); float* const SSQ = (float*)(ws + WS_SSQ); \
    unsigned short* const EID = (unsigned short*)(ws + WS_EID); float* const GATE = (float*)(ws + WS_GATE); \
    (void)XBF; (void)QK; (void)VX; (void)SB; (void)RINV; (void)SSQ; (void)EID; (void)GATE; \
    const int grp = bx & 7, grk = bx >> 3, gn = (G - grp + 7) >> 3, lw = grk * NWAVES + wave, nlw = gn * NWAVES; const size_t T0 = (size_t)grp * SEQ; (void)lw; (void)nlw; (void)T0; \
    bf16* const QKb = QK + (size_t)grp * BATCH_QKV; bf16* const VXb = QKb + (size_t)SEQ * 1024; (void)VXb;
    gu32* ctl = (gu32*)(ws + WS_CTL);
    for (int u = tid; u < (LDS_BYTES - LDSCTL_OFF) / 4; u += NWAVES * 64) ((LAS unsigned*)(L + LDSCTL_OFF))[u] = 0u;
    __syncthreads();
    XcdBarrier bar = xcd_barrier_post((unsigned*)(ctl + CW_BAR), MISC + 8);
#define GRID_BAR() xcd_barrier(bar)
    unsigned gb_epoch = 0u;

    if (PH_ON(0)) { PHASE_CTX(); PHASE_T0();
        LAS float* scr = (LAS float*)(L + RING_OFF + wave * 16384);
        constexpr int I_IN = (DMODEL / 64) * (IN_COLS / 32), I_OUT = (DMODEL / 64) * (DMODEL / 32), I_Q = (DMODEL / 64) * (2048 / 32);
        constexpr int NITEMS = DEPTH * (I_IN + I_OUT + I_Q);
        for (int it = gw; it < NITEMS; it += ngw) {
            const int l = it / (I_IN + I_OUT + I_Q); int r = it % (I_IN + I_OUT + I_Q);
            if (r < I_IN) { p0_transpose_item<1>(args.in[2] + (size_t)l * DMODEL * IN_COLS, args.in[1] + l * DMODEL, DMODEL, IN_COLS, (bf16*)(ws + WS_WIN) + (size_t)l * IN_COLS * DMODEL, scr, r, lane); continue; } r -= I_IN;
            if (r < I_OUT) { p0_transpose_item<0>(args.in[15] + (size_t)l * DMODEL * DMODEL, nullptr, DMODEL, DMODEL, (bf16*)(ws + WS_WOUT) + (size_t)l * DMODEL * DMODEL, scr, r, lane); continue; } r -= I_OUT;
            p0_transpose_item<0>(args.in[17] + (size_t)l * DMODEL * 2048, args.in[16] + l * DMODEL, DMODEL, 2048, (bf16*)(ws + WS_WQ) + (size_t)l * 2048 * DMODEL, scr, r, lane);
        }
        const int gtid = vcu * NWAVES * 64 + tid, ngt = G * NWAVES * 64;
        p0_convert(args.in[18], (bf16*)(ws + WS_KEYS), (size_t)DEPTH * 8 * 2 * 128 * 128, gtid, ngt);
        {
            f32x4 xv[4][4];
#pragma unroll 1
            for (int m = gw; m < NTOK; m += 4 * ngw) {
#pragma unroll
                for (int q = 0; q < 4; ++q) { const int mm = m + q * ngw < NTOK ? m + q * ngw : m; const GAS f32x4* xr = (const GAS f32x4*)(args.in[0] + (size_t)mm * DMODEL) + lane;
#pragma unroll
                    for (int j = 0; j < 4; ++j) xv[q][j] = __builtin_nontemporal_load(xr + 64 * j); }
#pragma unroll
                for (int q = 0; q < 4; ++q) if (m + q * ngw < NTOK) { const int mm = m + q * ngw; float sq = 0.f;
#pragma unroll
                    for (int j = 0; j < 4; ++j) sq += (xv[q][j].x * xv[q][j].x + xv[q][j].y * xv[q][j].y) + (xv[q][j].z * xv[q][j].z + xv[q][j].w * xv[q][j].w);
                    sq = wave_sum(sq);
                    GAS unsigned long long* o8 = (GAS unsigned long long*)(XBF + (size_t)mm * DMODEL) + lane;
#pragma unroll
                    for (int j = 0; j < 4; ++j) o8[64 * j] = (unsigned long long)pk2(xv[q][j].x, xv[q][j].y) | ((unsigned long long)pk2(xv[q][j].z, xv[q][j].w) << 32);
                    if (lane < 8) ((float*)(ws + WS_SSQX))[(size_t)mm * 8 + lane] = lane == 0 ? sq : 0.f; }
            }
        }
        PHASE_DELAY(0);
    }
    GRID_BAR();

    _Pragma("unroll") for (int l = 0; l < DEPTH; ++l) {
#define GROUP_BAR() do { ++gb_epoch; group_barrier((gu32*)(args.ws + WS_CTL) + CW_GRP + 64 * (blockIdx.x & 7), gb_epoch * (unsigned)((gridDim.x - (blockIdx.x & 7) + 7) >> 3)); } while (0)
        if (PH_ON(1)) { PHASE_CTX(); PHASE_T0();
            pg8::Gemm g{XBF + T0 * DMODEL, (const bf16*)(ws + WS_WIN) + (size_t)l * IN_COLS * DMODEL, SEQ, IN_COLS, DMODEL}; pg8::StaticOrder S; S.init(SEQ, IN_COLS, gn, grk);
            pg8::EpiIn E{QKb, VXb, SB + T0 * 256, (const float*)(ws + WS_SSQX) + T0 * 8, args.in[3] + l * 64, args.in[4] + l * 64};
            pg8::gemm_phase<pg8::EpiIn, pg8::StaticOrder, PG8_ALIGN, PG8_SP2>(L + RING_OFF, g, S, E);
            PHASE_DELAY(1);
        }
        GROUP_BAR();
        if (PH_ON(2)) { PHASE_CTX(); PHASE_T0();
            const float lam_init = 0.8f - 0.6f * __expf(-0.3f * (float)l);
            CmbArgs C{(const bf16*)(ws + WS_O) + T0 * 1024, VXb, SB + T0 * 256, (bf16*)(ws + WS_CAT) + T0 * 1024, args.in[5] + l * 64, args.in[6] + l * 64, args.in[7] + l * 64, args.in[8] + l * 64, args.in[9] + l * 128,
                      args.in[10] + l * 31 * 256, args.in[11] + l * 256, args.in[12] + l * 256, args.in[13] + l * 256, args.in[14] + l * 3 * 256, lam_init};
            cmb_conv_phase(C, lw, nlw, lane);
            const float lam = cmb_lambda(C, lane);
            for (int pr = grk; pr < 32; pr += gn) { const int h = pr >> 3, k = pr & 7;
                for (int i = 0; i < 2; ++i) { const int qb = i == 0 ? 15 - k : k;
                    for (int c = 0; c < 2; ++c) { const int hc = 2 * h + c;
                        const attn_body::bf16* Qb = (const attn_body::bf16*)QKb + hc * 64; const attn_body::bf16* Vb = (const attn_body::bf16*)VXb + h * 128; attn_body::bf16* Ob = (attn_body::bf16*)(ws + WS_O) + T0 * 1024 + (4 * h + 2 * c) * 64;
                        attn_body::attn_unit<8>(0, qb, Qb, Qb + 512, Vb, Ob, (char*)lds + RING_OFF); }
                    cmb_rows(C, lam, h, qb * 256 + wave * 32, lane); } }
            PHASE_DELAY(2);
        }
        GROUP_BAR();
        if (PH_ON(4)) { PHASE_CTX(); PHASE_T0();
            pg8::Gemm g{(const bf16*)(ws + WS_CAT) + T0 * 1024, (const bf16*)(ws + WS_WOUT) + (size_t)l * DMODEL * DMODEL, SEQ, DMODEL, DMODEL}; pg8::StaticOrder S; S.init(SEQ, DMODEL, gn, grk);
            pg8::EpiOut E{XBF + T0 * DMODEL, SSQ + T0 * 16};
            pg8::gemm_phase<pg8::EpiOut, pg8::StaticOrder, PG8_ALIGN, PG8_SP2>(L + RING_OFF, g, S, E);
            PHASE_DELAY(4);
        }
        GROUP_BAR();
        if (PH_ON(5)) { PHASE_CTX(); PHASE_T0();
            for (int m = lw; m < SEQ; m += nlw) xq_row(XBF + (T0 + m) * DMODEL, (signed char*)(ws + WS_XQ) + (T0 + m) * DMODEL, (float*)(ws + WS_XQS) + (T0 + m) * 4, lane);
            pg8::Gemm g{XBF + T0 * DMODEL, (const bf16*)(ws + WS_WQ) + (size_t)l * 2048 * DMODEL, SEQ, 2048, DMODEL}; pg8::StaticOrder S; S.init(SEQ, 2048, gn, grk);
            pg8::EpiBf16<0> E{QKb, 2048, nullptr, 0, 0, 1.f};
            pg8::gemm_phase<pg8::EpiBf16<0>, pg8::StaticOrder, PG8_ALIGN, PG8_SP2>(L + RING_OFF, g, S, E);
            PHASE_DELAY(5);
        }
        GROUP_BAR();
        if (PH_ON(6)) { PHASE_CTX(); PHASE_T0();
            TopkArgs K{QKb, (const bf16*)(ws + WS_KEYS) + (size_t)l * 8 * 2 * 128 * 128, SSQ + T0 * 16, EID + T0 * 128, GATE + T0 * 128, (unsigned short*)(ws + WS_EIDT) + T0 * 128
#ifdef DBG_CHECK
 , (float*)(ws + 71 * MiB), (int*)(ws + 71 * MiB + 512 * 1024)
#endif
 };
            const QuantJob J{args.in[19] + (size_t)l * NEXP * DMODEL, args.in[20] + (size_t)l * NEXP * DMODEL, args.in[16] + l * DMODEL, ws + WS_UT + (size_t)l * NEXP * DMODEL, ws + WS_VT + (size_t)l * NEXP * DMODEL,
                             (float*)(ws + WS_SU) + (size_t)l * NEXP * 4, (float*)(ws + WS_SV) + (size_t)l * NEXP * 4, gw, ngw};
            int qr_next = gw;
            if (gn >= 8) topk_phase(K, J, qr_next, L + RING_OFF, L + RING_OFF + 65536 + wave * 2048, grk & 7, grk >> 3, (gn - (grk & 7) + 7) >> 3, wave, tid_, lane);
            else for (int h = grk; h < 8; h += gn) topk_phase(K, J, qr_next, L + RING_OFF, L + RING_OFF + 65536 + wave * 2048, h, 0, 1, wave, tid_, lane);
            for (int r = qr_next; r < NEXP; r += ngw) { const size_t ro = (size_t)l * NEXP + r;
                p0_quant_row4(args.in[19] + ro * DMODEL, args.in[16] + l * DMODEL, ws + WS_UT + (size_t)l * NEXP * DMODEL, r, (float*)(ws + WS_SU) + (size_t)l * NEXP * 4, lane);
                p0_quant_row4(args.in[20] + ro * DMODEL, nullptr, ws + WS_VT + (size_t)l * NEXP * DMODEL, r, (float*)(ws + WS_SV) + (size_t)l * NEXP * 4, lane); }
            PHASE_DELAY(6);
        }
        GRID_BAR();
        if (PH_ON(7)) { PHASE_CTX(); PHASE_T0();
            PeerUArgs U{(const signed char*)(ws + WS_XQ), (const float*)(ws + WS_XQS), ws + WS_UT + (size_t)l * NEXP * DMODEL, (const unsigned short*)(ws + WS_EIDT), (float*)(ws + WS_PART)};
            peer_u_phase(U, bx, wave, G, lane);
            PHASE_DELAY(7);
        }
        GRID_BAR();
        if (PH_ON(7)) { PHASE_CTX(); PHASE_T0();
            PeerRArgs R{(const float*)(ws + WS_PART), SSQ, EID, GATE, (const float*)(ws + WS_SU) + (size_t)l * NEXP * 4, (const float*)(ws + WS_SV) + (size_t)l * NEXP * 4, (signed char*)(ws + WS_WT), (float*)(ws + WS_WSC)};
            peer_r_phase(R, gw, ngw, lane);
            PHASE_DELAY(8);
        }
        GRID_BAR();
        if (PH_ON(7)) { PHASE_CTX(); PHASE_T0();
            PeerVArgs V{l + 1 == DEPTH ? args.out : nullptr, ws + WS_VT + (size_t)l * NEXP * DMODEL, (const unsigned short*)(ws + WS_EIDT), (const signed char*)(ws + WS_WT), (const float*)(ws + WS_WSC), XBF, (float*)(ws + WS_SSQX)};
            peer_v_phase(V, bx, wave, G, lane);
            PHASE_DELAY(9);
        }
        if (l + 1 < DEPTH) GRID_BAR();
#ifdef DBG_CHECK
        if (l == 0) { PHASE_CTX(); dbg_check_peer_out(args.out, (const float*)(ws + 70 * MiB), (gu32*)(ws + WS_CTL) + DBG_FLAGS, gw, ngw, lane); }
#endif
    }
#ifdef DBG_CHECK
    GRID_BAR();
    { PHASE_CTX(); const unsigned fl = __hip_atomic_load((gu32*)(ws + WS_CTL) + DBG_FLAGS, __ATOMIC_RELAXED, __HIP_MEMORY_SCOPE_AGENT);
      if (fl) { const float mul = 1.0f + (float)fl; for (size_t i = (size_t)(gw * 64 + lane); i < (size_t)NTOK * DMODEL; i += (size_t)ngw * 64) args.out[i] *= mul; } }
#endif
}

extern "C" void kernel_launch(void* const* d_in, const int* in_sizes, int n_in, void* d_out, int out_size, void* d_ws, size_t ws_size, hipStream_t stream) {
    static int grid = 0;
    if (grid == 0) {
        if (n_in != 21 || out_size != NTOK * DMODEL || ws_size < WS_END) { fprintf(stderr, "kernel_launch: unexpected shapes (n_in %d, out %d, ws %zu); nothing launched\n", n_in, out_size, ws_size); grid = -1; return; }
        int dev = 0, cus = 0, per_cu = 0;
        if (hipGetDevice(&dev) != hipSuccess || hipDeviceGetAttribute(&cus, hipDeviceAttributeMultiprocessorCount, dev) != hipSuccess) { grid = -1; return; }
        if (hipFuncSetAttribute((const void*)mk_fwd, hipFuncAttributeMaxDynamicSharedMemorySize, LDS_BYTES) != hipSuccess) { fprintf(stderr, "kernel_launch: hipFuncSetAttribute failed\n"); grid = -1; return; }
        if (hipOccupancyMaxActiveBlocksPerMultiprocessor(&per_cu, (const void*)mk_fwd, NWAVES * 64, LDS_BYTES) != hipSuccess || per_cu < 1) fprintf(stderr, "kernel_launch: occupancy query says %d blocks per CU\n", per_cu);
        (void)hipGetLastError();
        grid = cus;
    }
    if (grid < 0) return;
    if (hipMemsetAsync((char*)d_ws + WS_CTL, 0, CTL_ZERO_BYTES, stream) != hipSuccess) { fprintf(stderr, "kernel_launch: memset failed\n"); return; }
    Args a{};
    for (int i = 0; i < 21; ++i) a.in[i] = (const float*)d_in[i];
    a.out = (float*)d_out; a.ws = (unsigned char*)d_ws;
    hipLaunchKernelGGL(mk_fwd, dim3(grid), dim3(NWAVES * 64), LDS_BYTES, stream, a);
}
```

```cpp
#include <hip/hip_runtime.h>
#include <cstdio>
#include <cstdint>
namespace pg8 {
#define PG8_LAS __attribute__((address_space(3)))
typedef unsigned short bf16_t;
typedef short bf16x8 __attribute__((ext_vector_type(8)));
typedef float f32x4 __attribute__((ext_vector_type(4)));
typedef unsigned u32x4 __attribute__((ext_vector_type(4)));
constexpr int BM = 256, BK = 64, HALF = 128, HTB = HALF * BK * 2  , STAGE_BYTES = 8 * HTB, NXCD = 8, WGM = 8;

__host__ __device__ __forceinline__ int lds_byte(int r, int c) { const int st = (r >> 4) * 2 + (c >> 5), rr = r & 15, cc = c & 31, ob = rr * 64 + cc * 2; return st * 1024 + (ob ^ (((ob >> 9) & 1) << 5)); }
__host__ __device__ __forceinline__ void stage_rc(int b, int& R, int& C) { const int st = b / 1024, sb = b % 1024, swz = sb ^ (((sb >> 9) & 1) << 5); R = (st >> 1) * 16 + swz / 64; C = (st & 1) * 32 + (swz % 64) / 2; }
__host__ __device__ __forceinline__ int perm32(int rho) { const int n = rho >> 4, i = rho & 15; return 8 * (i >> 2) + 4 * n + (i & 3); }

struct Unit { int pm, pn; };
struct Gemm { const bf16_t* A; const bf16_t* Bt; int M, N, K; };

struct StaticOrder {
    int nM, nN, nwg, G, c;
    __host__ __device__ void init(int M, int N, int G_, int c_) { nM = M / BM; nN = N / BM; nwg = nM * nN; G = G_; c = c_; }
    __host__ __device__ bool next(int i, Unit& u) const {
        const long L = (long)i * G + c; if (L >= nwg) return false;
        int wgid = (int)L; { const int q = nwg / NXCD, r = nwg % NXCD, xcd = wgid % NXCD, off = wgid / NXCD; wgid = (xcd < r ? xcd * (q + 1) : r * (q + 1) + (xcd - r) * q) + off; }
        const int nig = WGM * nN, gid = wgid / nig, fm = gid * WGM, gsz = (nM - fm) < WGM ? (nM - fm) : WGM;
        u.pm = fm + ((wgid % nig) % gsz); u.pn = (wgid % nig) / gsz; return true;
    }
    __device__ __forceinline__ void a_ready(const Unit&) const {}
    __device__ __forceinline__ void done(const Unit&) const {}
};

__device__ __forceinline__ unsigned cvt_pk_bf16(float lo, float hi) { unsigned r; asm volatile("v_cvt_pk_bf16_f32 %0, %1, %2" : "=v"(r) : "v"(lo), "v"(hi)); return r; }
typedef float f32x2 __attribute__((ext_vector_type(2)));
__device__ __forceinline__ f32x2 gelu_pk(f32x2 v) {
    const f32x2 av = __builtin_elementwise_abs(v), d = av * 0.2316418882f + 1.0f;
    f32x2 t; t.x = __builtin_amdgcn_rcpf(d.x); t.y = __builtin_amdgcn_rcpf(d.y);
    f32x2 q = t * 0.5307027145f + (-0.7265760135f); q = q * t + 0.7107068705f; q = q * t + (-0.142248368f); q = q * t + 0.127414796f; q = q * t;
    const f32x2 s = (v * v) * (-0.72134752044f);
    f32x2 e; e.x = __builtin_amdgcn_exp2f(s.x); e.y = __builtin_amdgcn_exp2f(s.y);
    const f32x2 m = v * (q * e), r = v - m;
    f32x2 o; o.x = v.x < 0.f ? m.x : r.x; o.y = v.y < 0.f ? m.y : r.y; return o;
}

template <int ACT  > struct EpiBf16 {
    static constexpr bool PERM = true, AFTER_DRAIN = false; static_assert(ACT == 0 || ACT == 1, "EpiBf16: ACT is 0 (none) or 1 (gelu_pk)");
    bf16_t* O; int ldc; const float* bias; int split_cols; size_t split_stride; float scale0;
    __device__ __forceinline__ void operator()(const f32x4 (&acc)[2][2][4][2], const Unit& u, int wr, int wc, int fr, int fq) const {
        const int row0 = u.pm * BM + wr * 64 + fr; int colt = u.pn * BM; bf16_t* base = O;
        float sc = 1.f; if (split_cols) { const int t = colt / split_cols; base += (size_t)t * split_stride; colt -= t * split_cols; if (t == 0) sc = scale0; }
        const int col0 = colt + wc * 32 + 8 * fq, bcol0 = u.pn * BM + wc * 32 + 8 * fq;
        f32x4 bv[2][2];
#pragma unroll
        for (int bj = 0; bj < 2; ++bj)
#pragma unroll
            for (int n = 0; n < 2; ++n) bv[bj][n] = bias ? *(const f32x4*)(bias + bcol0 + bj * HALF + 4 * n) : (f32x4){0.f, 0.f, 0.f, 0.f};
#pragma unroll
        for (int ai = 0; ai < 2; ++ai)
#pragma unroll
            for (int m = 0; m < 4; ++m) { bf16_t* rowp = base + (size_t)(row0 + ai * HALF + m * 16) * ldc + col0;
#pragma unroll
                for (int bj = 0; bj < 2; ++bj) { f32x4 v0 = acc[ai][bj][m][0] + bv[bj][0], v1 = acc[ai][bj][m][1] + bv[bj][1];
                    if (ACT == 1) { f32x2 a = gelu_pk((f32x2){v0[0], v0[1]}), b = gelu_pk((f32x2){v0[2], v0[3]}), c = gelu_pk((f32x2){v1[0], v1[1]}), d = gelu_pk((f32x2){v1[2], v1[3]});
                        v0 = (f32x4){a.x, a.y, b.x, b.y}; v1 = (f32x4){c.x, c.y, d.x, d.y}; }
                    v0 = v0 * sc; v1 = v1 * sc; u32x4 w; w.x = cvt_pk_bf16(v0[0], v0[1]); w.y = cvt_pk_bf16(v0[2], v0[3]); w.z = cvt_pk_bf16(v1[0], v1[1]); w.w = cvt_pk_bf16(v1[2], v1[3]);
                    *(u32x4*)(rowp + bj * HALF) = w; } }
    }
};
constexpr float QK_C2 = 0.125f * 1.4426950408889634f;
__device__ __forceinline__ u32x4 pack8(const f32x4& v0, const f32x4& v1) { u32x4 w; w.x = cvt_pk_bf16(v0[0], v0[1]); w.y = cvt_pk_bf16(v0[2], v0[3]); w.z = cvt_pk_bf16(v1[0], v1[1]); w.w = cvt_pk_bf16(v1[2], v1[3]); return w; }
struct EpiIn {
    static constexpr bool PERM = true, AFTER_DRAIN = false;
    bf16_t* QK; bf16_t* VX; bf16_t* SB; const float* ssqx; const float* qg; const float* kg;
    __device__ __forceinline__ float rinv_of(int row) const { const f32x4 a = *(const f32x4*)(ssqx + (size_t)row * 8), b = *(const f32x4*)(ssqx + (size_t)row * 8 + 4);
        return 1.0f / sqrtf((((a[0] + a[1]) + (a[2] + a[3])) + ((b[0] + b[1]) + (b[2] + b[3]))) * (1.0f / 1024.0f) + 1e-6f); }
    __device__ __forceinline__ void operator()(const f32x4 (&acc)[2][2][4][2], const Unit& u, int wr, int wc, int fr, int fq) const {
        const int pn = u.pn; const int row0 = u.pm * BM + wr * 64 + fr;
        if (pn < 4) {
            const float* g = pn < 2 ? qg : kg; const float sc = pn < 2 ? QK_C2 : 1.f;
            f32x4 gv[2][2];
#pragma unroll
            for (int bj = 0; bj < 2; ++bj)
#pragma unroll
                for (int n = 0; n < 2; ++n) gv[bj][n] = *(const f32x4*)(g + 32 * bj + 8 * fq + 4 * n) * sc;
            bf16_t* base = QK + 256 * pn + 64 * wc + 8 * fq;
#pragma unroll
            for (int ai = 0; ai < 2; ++ai)
#pragma unroll
                for (int m = 0; m < 4; ++m) { const int row = row0 + ai * HALF + m * 16; const float ri = rinv_of(row); float ss = 0.f;
#pragma unroll
                    for (int bj = 0; bj < 2; ++bj)
#pragma unroll
                        for (int n = 0; n < 2; ++n) { const f32x4 x = acc[ai][bj][m][n]; ss += (x[0] * x[0] + x[1] * x[1]) + (x[2] * x[2] + x[3] * x[3]); }
                    ss += __shfl_xor(ss, 16); ss += __shfl_xor(ss, 32);
                    const float rg = ri / sqrtf(ss * ri * ri * (1.0f / 64.0f) + 1e-6f);
#pragma unroll
                    for (int bj = 0; bj < 2; ++bj) { const f32x4 v0 = acc[ai][bj][m][0] * rg * gv[bj][0], v1 = acc[ai][bj][m][1] * rg * gv[bj][1];
                        *(u32x4*)(base + (size_t)row * 1024 + 32 * bj) = pack8(v0, v1); } }
        } else if (pn < 6) {
            bf16_t* base = VX + 256 * (pn - 4) + 32 * wc + 8 * fq;
#pragma unroll
            for (int ai = 0; ai < 2; ++ai)
#pragma unroll
                for (int m = 0; m < 4; ++m) { const int row = row0 + ai * HALF + m * 16; const float ri = rinv_of(row);
#pragma unroll
                    for (int bj = 0; bj < 2; ++bj) *(u32x4*)(base + (size_t)row * 1024 + HALF * bj) = pack8(acc[ai][bj][m][0] * ri, acc[ai][bj][m][1] * ri); }
        } else if (pn < 8) {
            bf16_t* base = VX + 512 + 128 * (pn - 6) + 32 * wc + 8 * fq;
#pragma unroll
            for (int ai = 0; ai < 2; ++ai)
#pragma unroll
                for (int m = 0; m < 4; ++m) { const int row = row0 + ai * HALF + m * 16; const float ri = rinv_of(row); f32x4 o[2];
#pragma unroll
                    for (int n = 0; n < 2; ++n) { const f32x4 a = acc[ai][0][m][n] * ri, gt = acc[ai][1][m][n] * ri;
#pragma unroll
                        for (int e = 0; e < 4; ++e) o[n][e] = a[e] / (1.0f + __expf(-gt[e])); }
                    *(u32x4*)(base + (size_t)row * 1024) = pack8(o[0], o[1]); }
        } else if (pn < 10) {
            bf16_t* base = VX + 768 + 128 * (pn - 8) + 32 * wc + 8 * fq;
#pragma unroll
            for (int ai = 0; ai < 2; ++ai)
#pragma unroll
                for (int m = 0; m < 4; ++m) { const int row = row0 + ai * HALF + m * 16; const float ri = rinv_of(row); const float r2 = ri * ri;
                    *(u32x4*)(base + (size_t)row * 1024) = pack8(acc[ai][0][m][0] * acc[ai][1][m][0] * r2, acc[ai][0][m][1] * acc[ai][1][m][1] * r2); }
        } else {
            bf16_t* base = SB + 32 * wc + 8 * fq;
#pragma unroll
            for (int ai = 0; ai < 2; ++ai)
#pragma unroll
                for (int m = 0; m < 4; ++m) { const int row = row0 + ai * HALF + m * 16; const float ri = rinv_of(row);
#pragma unroll
                    for (int bj = 0; bj < 2; ++bj) *(u32x4*)(base + (size_t)row * 256 + HALF * bj) = pack8(acc[ai][bj][m][0] * ri, acc[ai][bj][m][1] * ri); }
        }
    }
};
struct EpiOut {
    static constexpr bool PERM = true, AFTER_DRAIN = false;
    bf16_t* xb; float* ssq;
    __device__ __forceinline__ void operator()(const f32x4 (&acc)[2][2][4][2], const Unit& u, int wr, int wc, int fr, int fq) const {
        const int row0 = u.pm * BM + wr * 64 + fr; const int col0 = u.pn * BM + wc * 32 + 8 * fq;
#pragma unroll
        for (int ai = 0; ai < 2; ++ai)
#pragma unroll
            for (int m = 0; m < 4; ++m) { const int row = row0 + ai * HALF + m * 16; float ss = 0.f;
#pragma unroll
                for (int bj = 0; bj < 2; ++bj) { const size_t off = (size_t)row * 1024 + col0 + bj * HALF;
                    const u32x4 r = *(const u32x4*)(xb + off);
                    const f32x4 r0 = {__builtin_bit_cast(float, r.x << 16), __builtin_bit_cast(float, r.x & 0xffff0000u), __builtin_bit_cast(float, r.y << 16), __builtin_bit_cast(float, r.y & 0xffff0000u)};
                    const f32x4 r1 = {__builtin_bit_cast(float, r.z << 16), __builtin_bit_cast(float, r.z & 0xffff0000u), __builtin_bit_cast(float, r.w << 16), __builtin_bit_cast(float, r.w & 0xffff0000u)};
                    const u32x4 w = pack8(acc[ai][bj][m][0] + r0, acc[ai][bj][m][1] + r1);
                    *(u32x4*)(xb + off) = w;
                    const float a0 = __builtin_bit_cast(float, w.x << 16), a1 = __builtin_bit_cast(float, w.x & 0xffff0000u), a2 = __builtin_bit_cast(float, w.y << 16), a3 = __builtin_bit_cast(float, w.y & 0xffff0000u);
                    const float a4 = __builtin_bit_cast(float, w.z << 16), a5 = __builtin_bit_cast(float, w.z & 0xffff0000u), a6 = __builtin_bit_cast(float, w.w << 16), a7 = __builtin_bit_cast(float, w.w & 0xffff0000u);
                    ss += ((a0 * a0 + a1 * a1) + (a2 * a2 + a3 * a3)) + ((a4 * a4 + a5 * a5) + (a6 * a6 + a7 * a7)); }
                ss += __shfl_xor(ss, 16); ss += __shfl_xor(ss, 32);
                if (fq == 0) ssq[(size_t)row * 16 + u.pn * 4 + wc] = ss; }
    }
};

template <class Epi, class Sched, bool ALIGN_EPI = false, bool SP2 = false>
__device__ __forceinline__ void gemm_phase(PG8_LAS unsigned char* lds, const Gemm g, const Sched& S, const Epi& E) {
    int tid_l = threadIdx.x; asm volatile("" : "+v"(tid_l));
    const int tid = tid_l, wid = __builtin_amdgcn_readfirstlane(tid >> 6), lane = tid & 63, wr = wid >> 2, wc = wid & 3, fr = lane & 15, fq = lane >> 4;
    const int K = g.K, nt = K / BK;
    unsigned voffA[2], voffB[2];
#pragma unroll
    for (int i = 0; i < 2; ++i) { int R, C; stage_rc(tid * 16 + i * 8192, R, C); const int Rb = Epi::PERM ? ((R & ~31) + perm32(R & 31)) : R;
        voffA[i] = (unsigned)(R * K + C) * 2u; voffB[i] = (unsigned)(Rb * K + C) * 2u; }
    const size_t kstep = (size_t)(BK * 2);
    const size_t hstep = (size_t)HALF * K * 2;
    const size_t tstep = 2 * hstep;
    const unsigned ldsw = (unsigned)wid * 1024u;
    const int aoff = lds_byte(wr * 64 + fr, fq * 8), boff = lds_byte(wc * 32 + fr, fq * 8);
#define PG8_SA(b, h) (((b) * 2 + (h)) * HTB)
#define PG8_SB(b, h) ((4 + (b) * 2 + (h)) * HTB)
#define PG8_STAGE(bufoff, gbase, voff) do { _Pragma("unroll") for (int _i = 0; _i < 2; ++_i) \
        __builtin_amdgcn_global_load_lds((const unsigned*)((const char*)(gbase) + (voff)[_i]), (PG8_LAS unsigned*)(lds + (bufoff) + ldsw + _i * 8192), 16, 0, 0); } while (0)
#define PG8_LDA(dst, b, h) do { _Pragma("unroll") for (int m = 0; m < 4; ++m) _Pragma("unroll") for (int k = 0; k < 2; ++k) dst[m][k] = *(const PG8_LAS bf16x8*)(lds + PG8_SA(b, h) + aoff + m * 2048 + k * 1024); } while (0)
#define PG8_LDB(dst, b, h) do { _Pragma("unroll") for (int n = 0; n < 2; ++n) _Pragma("unroll") for (int k = 0; k < 2; ++k) dst[n][k] = *(const PG8_LAS bf16x8*)(lds + PG8_SB(b, h) + boff + n * 2048 + k * 1024); } while (0)
#define PG8_MMA(ai, bj, At, Bt) do { __builtin_amdgcn_s_setprio(1); _Pragma("unroll") for (int m = 0; m < 4; ++m) _Pragma("unroll") for (int n = 0; n < 2; ++n) _Pragma("unroll") for (int k = 0; k < 2; ++k) \
        acc[ai][bj][m][n] = __builtin_amdgcn_mfma_f32_16x16x32_bf16(Bt[n][k], At[m][k], acc[ai][bj][m][n], 0, 0, 0); __builtin_amdgcn_s_setprio(0); } while (0)
#define PG8_WAIT_V(n) asm volatile("s_waitcnt vmcnt(" #n ")" ::: "memory")
#define PG8_WAIT_L(n) asm volatile("s_waitcnt lgkmcnt(" #n ")" ::: "memory")
#define PG8_BAR __builtin_amdgcn_s_barrier()
#define PG8_SCHED __builtin_amdgcn_sched_barrier(0)
    Unit cur, nxt; int ui = 0;
    if (!S.next(0, cur)) return;
    f32x4 acc[2][2][4][2];
#pragma unroll
    for (int a = 0; a < 2; ++a)
#pragma unroll
        for (int b = 0; b < 2; ++b)
#pragma unroll
            for (int m = 0; m < 4; ++m)
#pragma unroll
                for (int n = 0; n < 2; ++n) acc[a][b][m][n] = (f32x4){0.f, 0.f, 0.f, 0.f};
    bf16x8 At[4][2], B0[2][2], B1[2][2];
    const char* cA = (const char*)g.A + (size_t)cur.pm * tstep; const char* cB = (const char*)g.Bt + (size_t)cur.pn * tstep;
    S.a_ready(cur);
    if constexpr (SP2) {
        PG8_STAGE(PG8_SB(0, 0), cB, voffB); PG8_STAGE(PG8_SB(0, 1), cB + hstep, voffB); PG8_STAGE(PG8_SA(0, 0), cA, voffA); PG8_STAGE(PG8_SA(0, 1), cA + hstep, voffA);
        if (wr == 1) PG8_BAR;
        PG8_WAIT_V(2); PG8_BAR;
        PG8_STAGE(PG8_SB(1, 0), cB + kstep, voffB); PG8_STAGE(PG8_SA(1, 0), cA + kstep, voffA); PG8_STAGE(PG8_SB(1, 1), cB + hstep + kstep, voffB);
        PG8_WAIT_V(6); PG8_BAR;
    } else {
        PG8_STAGE(PG8_SB(0, 0), cB, voffB); PG8_STAGE(PG8_SA(0, 0), cA, voffA); PG8_STAGE(PG8_SB(0, 1), cB + hstep, voffB); PG8_STAGE(PG8_SA(0, 1), cA + hstep, voffA);
        if (wr == 1) PG8_BAR;
        PG8_WAIT_V(4); PG8_BAR;
        PG8_STAGE(PG8_SB(1, 0), cB + kstep, voffB); PG8_STAGE(PG8_SA(1, 0), cA + kstep, voffA); PG8_STAGE(PG8_SB(1, 1), cB + hstep + kstep, voffB);
        PG8_WAIT_V(6); PG8_BAR;
    }
    for (;;) {
        const bool has_next = S.next(ui + 1, nxt);
        const char* nA = has_next ? (const char*)g.A + (size_t)nxt.pm * tstep : cA; const char* nB = has_next ? (const char*)g.Bt + (size_t)nxt.pn * tstep : cB;
        for (int t = 0; t < nt; t += 2) {
            const bool last = (t == nt - 2);
            const char* a1 = cA + (size_t)(t + 1) * kstep;
            const char* a2 = last ? nA : cA + (size_t)(t + 2) * kstep; const char* b2 = last ? nB : cB + (size_t)(t + 2) * kstep;
            const char* a3 = a2 + kstep; const char* b3 = b2 + kstep;
            if (last && has_next) S.a_ready(nxt);
            if constexpr (SP2) {
            PG8_LDB(B0, 0, 0); PG8_LDB(B1, 0, 1); PG8_SCHED; PG8_LDA(At, 0, 0); PG8_STAGE(PG8_SA(1, 1), a1 + hstep, voffA);
            PG8_WAIT_V(8); PG8_WAIT_L(0); PG8_BAR; PG8_MMA(0, 0, At, B0); PG8_MMA(0, 1, At, B1); PG8_BAR; PG8_SCHED;
            PG8_LDA(At, 0, 1); PG8_STAGE(PG8_SB(0, 0), b2, voffB); PG8_STAGE(PG8_SB(0, 1), b2 + hstep, voffB); PG8_STAGE(PG8_SA(0, 0), a2, voffA);
            PG8_WAIT_V(8); PG8_WAIT_L(0); PG8_BAR; PG8_MMA(1, 0, At, B0); PG8_MMA(1, 1, At, B1); PG8_BAR; PG8_SCHED;
            PG8_LDB(B0, 1, 0); PG8_LDB(B1, 1, 1); PG8_SCHED; PG8_LDA(At, 1, 0); PG8_STAGE(PG8_SA(0, 1), a2 + hstep, voffA);
            PG8_WAIT_V(8); PG8_WAIT_L(0); PG8_BAR; PG8_MMA(0, 0, At, B0); PG8_MMA(0, 1, At, B1); PG8_BAR; PG8_SCHED;
            PG8_LDA(At, 1, 1); PG8_STAGE(PG8_SB(1, 0), b3, voffB); PG8_STAGE(PG8_SB(1, 1), b3 + hstep, voffB); PG8_STAGE(PG8_SA(1, 0), a3, voffA);
            PG8_WAIT_V(8); PG8_WAIT_L(0); PG8_BAR; PG8_MMA(1, 0, At, B0); PG8_MMA(1, 1, At, B1); PG8_BAR; PG8_SCHED;
            } else {
            PG8_LDB(B0, 0, 0); PG8_SCHED; PG8_LDA(At, 0, 0); PG8_STAGE(PG8_SA(1, 1), a1 + hstep, voffA);
            PG8_WAIT_L(8); PG8_BAR; PG8_WAIT_L(0); PG8_MMA(0, 0, At, B0); PG8_BAR; PG8_SCHED;
            PG8_LDB(B1, 0, 1); PG8_STAGE(PG8_SB(0, 0), b2, voffB);
            PG8_BAR; PG8_WAIT_L(0); PG8_MMA(0, 1, At, B1); PG8_BAR;
            PG8_LDA(At, 0, 1); PG8_STAGE(PG8_SA(0, 0), a2, voffA);
            PG8_BAR; PG8_WAIT_L(0); PG8_MMA(1, 0, At, B0); PG8_BAR; PG8_SCHED;
            PG8_STAGE(PG8_SB(0, 1), b2 + hstep, voffB);
            PG8_WAIT_V(6); PG8_BAR; PG8_MMA(1, 1, At, B1); PG8_BAR;
            PG8_LDB(B0, 1, 0); PG8_SCHED; PG8_LDA(At, 1, 0); PG8_STAGE(PG8_SA(0, 1), a2 + hstep, voffA);
            PG8_WAIT_L(8); PG8_BAR; PG8_WAIT_L(0); PG8_MMA(0, 0, At, B0); PG8_BAR; PG8_SCHED;
            PG8_LDB(B1, 1, 1); PG8_STAGE(PG8_SB(1, 0), b3, voffB);
            PG8_BAR; PG8_WAIT_L(0); PG8_MMA(0, 1, At, B1); PG8_BAR;
            PG8_LDA(At, 1, 1); PG8_STAGE(PG8_SA(1, 0), a3, voffA);
            PG8_BAR; PG8_WAIT_L(0); PG8_MMA(1, 0, At, B0); PG8_BAR; PG8_SCHED;
            PG8_STAGE(PG8_SB(1, 1), b3 + hstep, voffB);
            PG8_WAIT_V(6); PG8_BAR; PG8_MMA(1, 1, At, B1); PG8_BAR;
            }
        }
        if constexpr (ALIGN_EPI) { if (wr == 0) PG8_BAR; }
        if constexpr (!Epi::AFTER_DRAIN) { E(acc, cur, wr, wc, fr, fq); S.done(cur); }
        if (!has_next) break;
#pragma unroll
        for (int a = 0; a < 2; ++a)
#pragma unroll
            for (int b = 0; b < 2; ++b)
#pragma unroll
                for (int m = 0; m < 4; ++m)
#pragma unroll
                    for (int n = 0; n < 2; ++n) acc[a][b][m][n] = (f32x4){0.f, 0.f, 0.f, 0.f};
        cur = nxt; cA = nA; cB = nB; ++ui;
        if constexpr (ALIGN_EPI) { if (wr == 1) PG8_BAR; }
    }
    PG8_WAIT_V(0);
    if constexpr (!ALIGN_EPI) { if (wr == 0) PG8_BAR; }
    PG8_BAR;
    if constexpr (Epi::AFTER_DRAIN) { E.fused(acc, cur, wr, wc, fr, fq, lds, wid, lane); S.done(cur); }
#undef PG8_SA
#undef PG8_SB
#undef PG8_STAGE
#undef PG8_LDA
#undef PG8_LDB
#undef PG8_MMA
#undef PG8_WAIT_V
#undef PG8_WAIT_L
#undef PG8_BAR
#undef PG8_SCHED
}
}
#define PG8_SP2 true
#define PG8_ALIGN true
#include <hip/hip_bf16.h>
#include <cmath>
namespace attn_body {
using bf16=__hip_bfloat16;
using bf16x8=__attribute__((ext_vector_type(8)))short;
using s16x4=__attribute__((ext_vector_type(4)))short;
using f32x16=__attribute__((ext_vector_type(16)))float;
using u32x4=__attribute__((ext_vector_type(4)))unsigned;
constexpr int BATCH=8,NHEAD=16,SEQ=4096,D=64,DM=NHEAD*D;
constexpr int NW=8,QBLK=32,QB=QBLK*NW,KVBLK=64,NQB=SEQ/QB;
constexpr int ATTN_PITCH=DM, ATTN_UNIT_ROWS=QB;
__device__ __forceinline__ int crow(int r,int hi){return (r&3)+8*(r>>2)+4*hi;}
#define SBAR() __builtin_amdgcn_sched_barrier(0)
__device__ __forceinline__ void cmask(f32x16&p0,f32x16&p1,int jb,int qrel,int hi){
  const float NEG=-INFINITY; int kb=64*jb+4*hi;
  #pragma unroll
  for(int r=0;r<16;++r){int kv=kb+(r&3)+8*(r>>2); if(kv>qrel)p0[r]=NEG; if(kv+32>qrel)p1[r]=NEG;}
}

constexpr int NSLOT=3, SLOTB=8192, VSLOTB=16384;
constexpr int LDS_K=0, LDS_V=NSLOT*SLOTB, LDS_WS=LDS_V+NSLOT*VSLOTB, LDS_OST=LDS_WS+NW*64*4, LDS_BYTES=LDS_OST+NW*4096;
constexpr float C2=0.125f*1.4426950408889634f;
__device__ __forceinline__ void glds16(const void*gsrc,unsigned lds_dst){unsigned keep;
  asm volatile("s_mov_b32 %0, m0\n\ts_mov_b32 m0, %2\n\ts_nop 0\n\tglobal_load_lds_dwordx4 %1, off\n\ts_mov_b32 m0, %0":"=&s"(keep):"v"(gsrc),"s"(lds_dst):"memory");}
__device__ __forceinline__ float max3f(float a,float b,float c){float r;asm("v_max3_f32 %0, %1, %2, %3":"=v"(r):"v"(a),"v"(b),"v"(c));return r;}
__device__ __forceinline__ float max2f(float a,float b){float r;asm("v_max_f32_e32 %0, %1, %2":"=v"(r):"v"(a),"v"(b));return r;}
__device__ __forceinline__ float fadd_s(float a,float b){float r;asm("v_add_f32_e32 %0, %1, %2":"=v"(r):"v"(a),"v"(b));return r;}
__device__ __forceinline__ float fsub_s(float a,float b){float r;asm("v_sub_f32_e32 %0, %1, %2":"=v"(r):"v"(a),"v"(b));return r;}
typedef float f32x2_t __attribute__((ext_vector_type(2))); typedef __bf16 bf16x2_t __attribute__((ext_vector_type(2)));
__device__ __forceinline__ unsigned cvtpk_s(float lo,float hi){f32x2_t v={lo,hi};bf16x2_t b=__builtin_convertvector(v,bf16x2_t);return __builtin_bit_cast(unsigned,b);}
#define WAIT_BAR(N) asm volatile("s_waitcnt vmcnt(" #N ") lgkmcnt(0)\n\ts_barrier":::"memory")

__device__ __forceinline__ void qkt(f32x16&p0,f32x16&p1,const char*Kslot,const bf16x8*qr,const f32x16&negm,int r32,int hi){
  const char*kb=Kslot+hi*1024+r32*16;
  #pragma unroll
  for(int d0=0;d0<4;++d0){
    const bf16x8 b0=*reinterpret_cast<const bf16x8*>(kb+d0*2048);
    const bf16x8 b1=*reinterpret_cast<const bf16x8*>(kb+d0*2048+512);
    if(d0==0){p0=__builtin_amdgcn_mfma_f32_32x32x16_bf16(b0,qr[0],negm,0,0,0);p1=__builtin_amdgcn_mfma_f32_32x32x16_bf16(b1,qr[0],negm,0,0,0);}
    else{p0=__builtin_amdgcn_mfma_f32_32x32x16_bf16(b0,qr[d0],p0,0,0,0);p1=__builtin_amdgcn_mfma_f32_32x32x16_bf16(b1,qr[d0],p1,0,0,0);}}
}
typedef __attribute__((address_space(3))) const char* lds_cptr;
typedef short v4i16_t __attribute__((ext_vector_type(4)));
__device__ __forceinline__ void kload8(bf16x8*kf,lds_cptr kp){
  kf[0]=*(const __attribute__((address_space(3))) bf16x8*)(kp);      kf[1]=*(const __attribute__((address_space(3))) bf16x8*)(kp+512);
  kf[2]=*(const __attribute__((address_space(3))) bf16x8*)(kp+2048); kf[3]=*(const __attribute__((address_space(3))) bf16x8*)(kp+2560);
  kf[4]=*(const __attribute__((address_space(3))) bf16x8*)(kp+4096); kf[5]=*(const __attribute__((address_space(3))) bf16x8*)(kp+4608);
  kf[6]=*(const __attribute__((address_space(3))) bf16x8*)(kp+6144); kf[7]=*(const __attribute__((address_space(3))) bf16x8*)(kp+6656);
}
__device__ __forceinline__ void kload2(bf16x8*kf,lds_cptr kp,int j){ kf[2*j]=*(const __attribute__((address_space(3))) bf16x8*)(kp+j*2048); kf[2*j+1]=*(const __attribute__((address_space(3))) bf16x8*)(kp+j*2048+512); }
__device__ __forceinline__ s16x4 vtr(lds_cptr p){ return __builtin_bit_cast(s16x4,__builtin_amdgcn_ds_read_tr16_b64_v4i16((__attribute__((address_space(3))) v4i16_t*)p)); }
__device__ __forceinline__ float rowmax(const f32x16&p0,const f32x16&p1){
  float a=max3f(p0[0],p0[1],p1[0]),b=max3f(p0[2],p0[3],p1[1]);a=max3f(a,p1[2],p1[3]);
  #pragma unroll
  for(int r=4;r<16;r+=4){a=max3f(a,p0[r],p0[r+1]);b=max3f(b,p0[r+2],p0[r+3]);a=max3f(a,p1[r],p1[r+1]);b=max3f(b,p1[r+2],p1[r+3]);}
  const float m=max2f(a,b);
  auto rr=__builtin_amdgcn_permlane32_swap(__float_as_uint(m),__float_as_uint(m),false,false);
  return max2f(__uint_as_float(rr[0]),__uint_as_float(rr[1]));
}
__device__ __forceinline__ void pv(f32x16*o,int vb,bf16x8 pa0,bf16x8 pa1,bf16x8 pa2,bf16x8 pa3){
  #pragma unroll
  for(int d0=0;d0<4;++d0){s16x4 lo[4],hi[4];
    #pragma unroll
    for(int ks=0;ks<4;++ks){
      asm volatile("ds_read_b64_tr_b16 %0,%1 offset:%c2":"=&v"(lo[ks]):"v"(vb),"i"((d0>>1)*8192+(d0&1)*4096+ks*1024):"memory");
      asm volatile("ds_read_b64_tr_b16 %0,%1 offset:%c2":"=&v"(hi[ks]):"v"(vb),"i"((d0>>1)*8192+(d0&1)*4096+ks*1024+512):"memory");}
    asm volatile("s_waitcnt lgkmcnt(0)":::"memory");SBAR();
    #define PK(k) (bf16x8){lo[k][0],lo[k][1],lo[k][2],lo[k][3],hi[k][0],hi[k][1],hi[k][2],hi[k][3]}
    o[d0]=__builtin_amdgcn_mfma_f32_32x32x16_bf16(pa0,PK(0),o[d0],0,0,0);
    o[d0]=__builtin_amdgcn_mfma_f32_32x32x16_bf16(pa1,PK(1),o[d0],0,0,0);
    o[d0]=__builtin_amdgcn_mfma_f32_32x32x16_bf16(pa2,PK(2),o[d0],0,0,0);
    o[d0]=__builtin_amdgcn_mfma_f32_32x32x16_bf16(pa3,PK(3),o[d0],0,0,0);
    #undef PK
  }
}

#ifndef ATTN_STORE16
#define ATTN_STORE16(p,v) (*(u32x4*)(p)=(v))
#endif
template<int THRL> __device__ __forceinline__ void attn_unit(int b,int qb,const bf16*Q,const bf16*__restrict__ K,const bf16*__restrict__ V,bf16*O,char*shm){
  int tid_l=threadIdx.x; asm volatile("":"+v"(tid_l)); const int tid=tid_l,lane=tid&63,r32=lane&31,hi=lane>>5; const int wid=__builtin_amdgcn_readfirstlane(tid>>6);
  const long rowbase=(long)b*SEQ; const int q0=qb*QB; const lds_cptr shm3q=(lds_cptr)shm;
  const bf16*Qw=Q+(rowbase+q0+wid*QBLK)*DM;
  const bf16*Kh=K+rowbase*DM,*Vh=V+rowbase*DM;
  const unsigned lds0=(unsigned)(uintptr_t)shm;
  float*wsf=(float*)(shm+LDS_WS)+wid*64;
  const bf16*ksrc=Kh+(long)lane*DM+wid*8;
  const bf16*vsrc=Vh+(long)(16*(wid&3)+(lane>>2))*DM+(wid>>2)*32+(lane&3)*8;
  const unsigned kdst=lds0+LDS_K+wid*1024, vdst=lds0+LDS_V+wid*1024;
  #define DMA_K(t,slot) glds16(ksrc+(long)(t)*KVBLK*DM,(unsigned)__builtin_amdgcn_readfirstlane(kdst+(slot)))
  #define DMA_V(t,slot) do{ glds16(vsrc+(long)(t)*KVBLK*DM,(unsigned)__builtin_amdgcn_readfirstlane(vdst+2*(slot))); glds16(vsrc+64+(long)(t)*KVBLK*DM,(unsigned)__builtin_amdgcn_readfirstlane(vdst+2*(slot)+8192)); }while(0)
  const int vb0=(int)(lds0+LDS_V)+((lane>>4)&1)*32+(lane&3)*8+(4*hi+((lane&15)>>2))*64;
  const char*Kbase=shm+LDS_K; bf16x8 kf[8];
  const lds_cptr shm3=(lds_cptr)shm; const lds_cptr kp0=shm3+LDS_K+hi*1024+r32*16; const lds_cptr vp0=shm3+LDS_V+((lane>>4)&1)*32+(lane&3)*8+(4*hi+((lane&15)>>2))*64;
  const int NT=(q0+QB)/KVBLK;
  DMA_K(0,0);DMA_V(0,0);DMA_K(1,SLOTB);
  bf16x8 qr[4];
  #pragma unroll
  for(int d0=0;d0<4;++d0)qr[d0]=*reinterpret_cast<const bf16x8*>(&Qw[(long)r32*DM+d0*16+hi*8]);
  const lds_cptr qst3=shm3q+LDS_OST+wid*4096+lane*16;
  #define LDQ(d0) (*(const __attribute__((address_space(3))) bf16x8*)(qst3+(d0)*1024))
  float mhat=0.f,l_reg=0.f;f32x16 o[4];o[0]=f32x16{};o[1]=f32x16{};o[2]=f32x16{};o[3]=f32x16{};f32x16 negm=f32x16{};asm volatile("":"+v"(negm));
  const int qrel=wid*QBLK+r32;
  #define CMASK(P0,P1,t) do{int jb_=(t)-(NT-4); if(jb_>=0)cmask(P0,P1,jb_,qrel,hi);}while(0)
  bool resc=false;
  #define START(P0,P1) do{ const float rm=rowmax(P0,P1); resc=false; \
    { const float dl=rm; mhat=fadd_s(mhat,dl); \
      _Pragma("unroll") for(int r=0;r<16;++r){P0[r]=fsub_s(P0[r],dl);P1[r]=fsub_s(P1[r],dl);} \
      _Pragma("unroll") for(int r=0;r<16;++r)negm[r]=-mhat; asm volatile("":"+v"(negm)); } \
    _Pragma("unroll") for(int r=0;r<16;++r)P0[r]=__builtin_amdgcn_exp2f(P0[r]); }while(0)
  #define RESC() do{ if(resc){ asm volatile("s_waitcnt lgkmcnt(0)":::"memory"); \
      _Pragma("unroll") for(int d_=0;d_<4;++d_) _Pragma("unroll") for(int r=0;r<16;++r)o[d_][r]*=wsf[crow(r,hi)]; } }while(0)
  f32x16 pA0,pA1,pB0,pB1;
  int sl_prev=0,sl_cur=0,sl_next=SLOTB;
  #define ROT() do{sl_prev=sl_cur;sl_cur=sl_next;sl_next=(sl_next==(NSLOT-1)*SLOTB)?0:sl_next+SLOTB;}while(0)
  DMA_K(2,2*SLOTB);
  WAIT_BAR(3);
  qkt(pA0,pA1,Kbase,qr,negm,r32,hi);
  _Pragma("unroll") for(int d0=0;d0<4;++d0)*(__attribute__((address_space(3))) bf16x8*)(qst3+d0*1024)=qr[d0];
asm volatile("s_nop 15\n\ts_nop 7":"+v"(pA0),"+v"(pA1));CMASK(pA0,pA1,0);
  START(pA0,pA1);
  _Pragma("unroll") for(int r=0;r<16;++r)pA1[r]=__builtin_amdgcn_exp2f(pA1[r]);
  WAIT_BAR(0);
  DMA_K(3,0);DMA_V(1,SLOTB);
  ROT();
  kload8(kf,kp0+sl_cur);
  WAIT_BAR(3);
  s16x4 f0lo,f0hi,f1lo,f1hi,f2lo,f2hi,f3lo,f3hi; u32x4 pw0,pw1,pw2,pw3;
  #define PKW(P,B) cvtpk_s(P[B],P[B+1])
  #define PAF(k) __builtin_bit_cast(bf16x8,pw##k)
  #define VF(S) (bf16x8){S##lo[0],S##lo[1],S##lo[2],S##lo[3],S##hi[0],S##hi[1],S##hi[2],S##hi[3]}
  #define FOFF(i) (((i)>>2)*4096+((i)&3)*1024)
  #define VLD(S,off) do{ S##lo=vtr(vp_+(off)); S##hi=vtr(vp_+(off)+512); }while(0)
  #define PIN(x) asm volatile("":"+v"(x))
  #define MX3(a,b,c) __builtin_fmaxf(__builtin_fmaxf((a),(b)),(c))
  #define GAPA(MF,A0,A1,A2,A3,W0,W1,PW) do{ MF; sacc+=A0; sacc+=A1; sacc+=A2; sacc+=A3; PIN(sacc); W0; W1; PIN(PW); SBAR(); }while(0)
  #define EX(v) __builtin_amdgcn_exp2f(v)
  #define GAPB(MF,X,B) do{ MF; X[B]=EX(X[B]); X[B+1]=EX(X[B+1]); X[B+2]=EX(X[B+2]); X[B+3]=EX(X[B+3]); PIN(X); SBAR(); }while(0)
  #define GAPB2(MF,X,B) do{ MF; X[B]=EX(X[B]); X[B+1]=EX(X[B+1]); PIN(X); SBAR(); }while(0)
  #define KRD(G,j) do{ if(G){ kload2(kf,kp0+sl_next,j); SBAR(); } }while(0)
  #define STEP(C0,C1,P0,P1,t,GK,GV,GL) do{ SBAR(); \
    const lds_cptr vp_=vp0+2*sl_prev; \
    bf16x8 q_=LDQ(0); VLD(f0,FOFF(0)); SBAR(); float sacc=(P0[0]+P0[1]); \
    GAPA(C0=__builtin_amdgcn_mfma_f32_32x32x16_bf16(kf[0],q_,negm,0,0,0), P0[2],P0[3],P0[4],P0[5],     pw0[0]=PKW(P0,0), pw0[1]=PKW(P0,2), pw0); \
    VLD(f1,FOFF(4)); SBAR(); GAPA(C1=__builtin_amdgcn_mfma_f32_32x32x16_bf16(kf[1],q_,negm,0,0,0), P0[6],P0[7],P0[8],P0[9],     pw0[2]=PKW(P0,4), pw0[3]=PKW(P0,6), pw0); \
    q_=LDQ(1); VLD(f2,FOFF(1)); SBAR(); GAPA(C0=__builtin_amdgcn_mfma_f32_32x32x16_bf16(kf[2],q_,C0,0,0,0),   P0[10],P0[11],P0[12],P0[13], pw1[0]=PKW(P0,8), pw1[1]=PKW(P0,10), pw1); \
    VLD(f3,FOFF(5)); SBAR(); GAPA(C1=__builtin_amdgcn_mfma_f32_32x32x16_bf16(kf[3],q_,C1,0,0,0),   P0[14],P0[15],P1[0],P1[1],   pw1[2]=PKW(P0,12),pw1[3]=PKW(P0,14), pw1); \
    q_=LDQ(2); SBAR(); GAPA(C0=__builtin_amdgcn_mfma_f32_32x32x16_bf16(kf[4],q_,C0,0,0,0),   P1[2],P1[3],P1[4],P1[5],     pw2[0]=PKW(P1,0), pw2[1]=PKW(P1,2), pw2); \
    GAPA(C1=__builtin_amdgcn_mfma_f32_32x32x16_bf16(kf[5],q_,C1,0,0,0),   P1[6],P1[7],P1[8],P1[9],     pw2[2]=PKW(P1,4), pw2[3]=PKW(P1,6), pw2); \
    q_=LDQ(3); SBAR(); GAPA(C0=__builtin_amdgcn_mfma_f32_32x32x16_bf16(kf[6],q_,C0,0,0,0),   P1[10],P1[11],P1[12],P1[13], pw3[0]=PKW(P1,8), pw3[1]=PKW(P1,10), pw3); \
    GAPA(C1=__builtin_amdgcn_mfma_f32_32x32x16_bf16(kf[7],q_,C1,0,0,0),   P1[14],P1[15],0.f,0.f,       pw3[2]=PKW(P1,12),pw3[3]=PKW(P1,14), pw3); \
    l_reg+=sacc; \
    if(GK){DMA_K((t)+3,sl_cur);} if(GV){DMA_V((t)+1,sl_next);} \
    CMASK(C0,C1,t); \
    { float a=MX3(C0[0],C0[1],C1[0]),b=MX3(C0[2],C0[3],C1[1]); a=MX3(a,C1[2],C1[3]); \
      _Pragma("unroll") for(int r=4;r<16;r+=4){a=MX3(a,C0[r],C0[r+1]);b=MX3(b,C0[r+2],C0[r+3]);a=MX3(a,C1[r],C1[r+1]);b=MX3(b,C1[r+2],C1[r+3]);} \
      float rm=__builtin_fmaxf(a,b); { auto rr=__builtin_amdgcn_permlane32_swap(__float_as_uint(rm),__float_as_uint(rm),false,false); rm=__builtin_fmaxf(__uint_as_float(rr[0]),__uint_as_float(rr[1])); } \
      resc=false; \
      if(__builtin_expect(__any(rm>(float)THRL),0)){ const float dl=__builtin_fmaxf(rm,0.f); mhat+=dl; \
        _Pragma("unroll") for(int r=0;r<16;++r){C0[r]-=dl;C1[r]-=dl;} \
        _Pragma("unroll") for(int r=0;r<16;++r)negm[r]=-mhat; asm volatile("":"+v"(negm)); \
        const float f=__builtin_amdgcn_exp2f(-dl); l_reg*=f; if(hi==0)wsf[r32]=f; resc=true; } } \
    SBAR(); \
      \
    GAPB2(o[0]=__builtin_amdgcn_mfma_f32_32x32x16_bf16(PAF(0),VF(f0),o[0],0,0,0), C0,0);  VLD(f0,FOFF(2)); SBAR(); \
    GAPB2(o[1]=__builtin_amdgcn_mfma_f32_32x32x16_bf16(PAF(0),VF(f1),o[1],0,0,0), C0,2);  VLD(f1,FOFF(6)); SBAR(); \
    KRD(GL,0); GAPB2(o[0]=__builtin_amdgcn_mfma_f32_32x32x16_bf16(PAF(1),VF(f2),o[0],0,0,0), C0,4);  VLD(f2,FOFF(3)); SBAR(); \
    KRD(GL,1); GAPB2(o[1]=__builtin_amdgcn_mfma_f32_32x32x16_bf16(PAF(1),VF(f3),o[1],0,0,0), C0,6);  VLD(f3,FOFF(7)); SBAR(); \
    KRD(GL,2); GAPB2(o[0]=__builtin_amdgcn_mfma_f32_32x32x16_bf16(PAF(2),VF(f0),o[0],0,0,0), C0,8);  VLD(f0,8192+FOFF(0)); SBAR(); \
    KRD(GL,3); GAPB2(o[1]=__builtin_amdgcn_mfma_f32_32x32x16_bf16(PAF(2),VF(f1),o[1],0,0,0), C0,10); VLD(f1,8192+FOFF(4)); SBAR(); \
    GAPB2(o[0]=__builtin_amdgcn_mfma_f32_32x32x16_bf16(PAF(3),VF(f2),o[0],0,0,0), C0,12); VLD(f2,8192+FOFF(1)); SBAR(); \
    GAPB2(o[1]=__builtin_amdgcn_mfma_f32_32x32x16_bf16(PAF(3),VF(f3),o[1],0,0,0), C0,14); VLD(f3,8192+FOFF(5)); SBAR(); \
    GAPB2(o[2]=__builtin_amdgcn_mfma_f32_32x32x16_bf16(PAF(0),VF(f0),o[2],0,0,0), C1,0);  VLD(f0,8192+FOFF(2)); SBAR(); \
    GAPB2(o[3]=__builtin_amdgcn_mfma_f32_32x32x16_bf16(PAF(0),VF(f1),o[3],0,0,0), C1,2);  VLD(f1,8192+FOFF(6)); SBAR(); \
    GAPB2(o[2]=__builtin_amdgcn_mfma_f32_32x32x16_bf16(PAF(1),VF(f2),o[2],0,0,0), C1,4);  VLD(f2,8192+FOFF(3)); SBAR(); \
    GAPB2(o[3]=__builtin_amdgcn_mfma_f32_32x32x16_bf16(PAF(1),VF(f3),o[3],0,0,0), C1,6);  VLD(f3,8192+FOFF(7)); SBAR(); \
    GAPB2(o[2]=__builtin_amdgcn_mfma_f32_32x32x16_bf16(PAF(2),VF(f0),o[2],0,0,0), C1,8); \
    GAPB2(o[3]=__builtin_amdgcn_mfma_f32_32x32x16_bf16(PAF(2),VF(f1),o[3],0,0,0), C1,10); \
    GAPB2(o[2]=__builtin_amdgcn_mfma_f32_32x32x16_bf16(PAF(3),VF(f2),o[2],0,0,0), C1,12); \
    GAPB2(o[3]=__builtin_amdgcn_mfma_f32_32x32x16_bf16(PAF(3),VF(f3),o[3],0,0,0), C1,14); \
    }while(0)
  int t=1;
  #undef CMASK
  #define CMASK(P0,P1,t) do{}while(0)
  for(;t+5<NT;t+=2){
    STEP(pB0,pB1,pA0,pA1,t,true,true,true);     WAIT_BAR(3); RESC(); ROT();
    STEP(pA0,pA1,pB0,pB1,t+1,true,true,true);   WAIT_BAR(3); RESC(); ROT();
  }
  #undef CMASK
  #define CMASK(P0,P1,t) do{int jb_=(t)-(NT-4); if(jb_>=0)cmask(P0,P1,jb_,qrel,hi);}while(0)
  #define ENDW(tt) do{ if((tt)+3<NT){WAIT_BAR(3);} else if((tt)+2<NT){WAIT_BAR(2);} else {WAIT_BAR(0);} }while(0)
  for(;t+1<NT;t+=2){
    STEP(pB0,pB1,pA0,pA1,t,(t+3<NT),(t+1<NT),(t+1<NT));       ENDW(t);   RESC(); ROT();
    STEP(pA0,pA1,pB0,pB1,t+1,(t+4<NT),(t+2<NT),(t+2<NT));     ENDW(t+1); RESC(); ROT();
  }
  STEP(pB0,pB1,pA0,pA1,NT-1,false,false,false); RESC();
  { float sacc=pB0[0]+pB0[1]; _Pragma("unroll") for(int r=2;r<16;++r)sacc+=pB0[r]; _Pragma("unroll") for(int r=0;r<16;++r)sacc+=pB1[r]; l_reg+=sacc;
    pw0=(u32x4){PKW(pB0,0),PKW(pB0,2),PKW(pB0,4),PKW(pB0,6)};pw1=(u32x4){PKW(pB0,8),PKW(pB0,10),PKW(pB0,12),PKW(pB0,14)};pw2=(u32x4){PKW(pB1,0),PKW(pB1,2),PKW(pB1,4),PKW(pB1,6)};pw3=(u32x4){PKW(pB1,8),PKW(pB1,10),PKW(pB1,12),PKW(pB1,14)};
    SBAR(); pv(o,vb0+2*sl_cur,PAF(0),PAF(1),PAF(2),PAF(3)); }
  #undef PKW
  #undef PAF
  #undef VF
  #undef FOFF
  #undef VLD
  #undef LDQ
  #undef PIN
  #undef MX3
  #undef GAPA
  #undef GAPB
  #undef EX
  #undef GAPB2
  #undef KRD
  #undef STEP
  #undef ENDW
  {auto rr=__builtin_amdgcn_permlane32_swap(__float_as_uint(l_reg),__float_as_uint(l_reg),false,false);l_reg=__uint_as_float(rr[0])+__uint_as_float(rr[1]);}
  if(hi==0)wsf[32+r32]=l_reg;asm volatile("s_waitcnt lgkmcnt(0)":::"memory");
  float rli[16];
  #pragma unroll
  for(int r=0;r<16;++r)rli[r]=__builtin_amdgcn_rcpf(wsf[32+crow(r,hi)]);
  bf16*Ow=O+(rowbase+q0+wid*QBLK)*DM;
  { bf16*stg=(bf16*)(shm+LDS_OST)+wid*2048;
    #pragma unroll
    for(int h2=0;h2<2;++h2){
      #pragma unroll
      for(int r=0;r<16;++r){const int orow=crow(r,hi);
        #pragma unroll
        for(int d0=0;d0<2;++d0)stg[orow*64+d0*32+r32]=__float2bfloat16(o[2*h2+d0][r]*rli[r]);}
      asm volatile("s_waitcnt lgkmcnt(0)":::"memory");
      #pragma unroll
      for(int i=0;i<4;++i){const int row=i*8+(lane>>3),ch=lane&7; const u32x4 v=*(const u32x4*)(stg+row*64+ch*8); ATTN_STORE16(Ow+(long)row*DM+h2*64+ch*8,v);}
      asm volatile("s_waitcnt lgkmcnt(0)":::"memory"); } }
  asm volatile("s_waitcnt lgkmcnt(0)\n\ts_barrier":::"memory");
  #undef DMA_K
  #undef DMA_V
  #undef CMASK
  #undef START
  #undef RESC
  #undef ROT
}
constexpr int ATTN_LDS_BYTES=LDS_BYTES;
#undef SBAR
#undef WAIT_BAR
}
#define GAS __attribute__((address_space(1)))
#define LAS __attribute__((address_space(3)))
typedef unsigned short bf16;
typedef unsigned v4u __attribute__((ext_vector_type(4)));
typedef float f32x4 __attribute__((ext_vector_type(4)));
typedef short bf16x8 __attribute__((ext_vector_type(8)));
typedef GAS unsigned gu32;
typedef GAS unsigned long long gu64;
#define RLX_AGENT __ATOMIC_RELAXED, __HIP_MEMORY_SCOPE_AGENT
#define LDS_WAIT() asm volatile("s_waitcnt lgkmcnt(0)" ::: "memory")
#define VM_WAIT() asm volatile("s_waitcnt vmcnt(0)" ::: "memory")
__device__ __forceinline__ unsigned long long rt() { return __builtin_amdgcn_s_memrealtime(); }
__device__ __forceinline__ unsigned f2bf(float f) { unsigned u = __builtin_bit_cast(unsigned, f); return (u + 0x7fffu + ((u >> 16) & 1u)) >> 16; }
__device__ __forceinline__ unsigned pk2(float lo, float hi) { return f2bf(lo) | (f2bf(hi) << 16); }

#define XB_TMO      128
#define XB_XCNT(j)  (256  + 64 * (j))
#define XB_XSUB(j)  (1280 + 64 * (j))
#define XB_XGEN(j)  (2304 + 64 * (j))
#define XB_TOP      3328
#define XB_TOPGEN   3392
#define XCD_BAR_WORDS 3456
#define XB_SPIN_CAP (1u << 18)

__device__ __forceinline__ unsigned xb_ld(unsigned* p)              { return __hip_atomic_load(p, __ATOMIC_RELAXED, __HIP_MEMORY_SCOPE_AGENT); }
__device__ __forceinline__ unsigned xb_add(unsigned* p, unsigned v) { return __hip_atomic_fetch_add(p, v, __ATOMIC_RELAXED, __HIP_MEMORY_SCOPE_AGENT); }
__device__ __forceinline__ unsigned xb_xcc_id() { return (unsigned)__builtin_amdgcn_s_getreg((3 << 11) | 20) & 0xFu; }
#define XB_SPIN(cond, bar) do { unsigned _sp = 0; while (cond) { __builtin_amdgcn_s_sleep(1); \
    if ((++_sp & 255u) == 0u) { if (xb_ld(&(bar)[XB_TMO])) break; if (_sp > XB_SPIN_CAP) { atomicAdd(&(bar)[XB_TMO], 1u); break; } } } } while (0)

struct XcdBarrier {
    unsigned* bar; unsigned x;
    volatile LAS unsigned* st;
};

__device__ __forceinline__ XcdBarrier xcd_barrier_post(unsigned* bar, volatile LAS unsigned* st) {
    XcdBarrier b; b.bar = bar; b.x = xb_xcc_id(); b.st = st;
    if (threadIdx.x == 0) (void)xb_add(&bar[XB_XCNT(b.x)], 1u);
    return b;
}
__device__ __forceinline__ void xcd_barrier_complete(unsigned* bar, unsigned x, unsigned& nloc, unsigned& nx) {
    const unsigned G = gridDim.x * gridDim.y * gridDim.z;
    unsigned sum, cnt, mine, sp = 0u;
    for (;;) {
        sum = 0u; cnt = 0u; mine = 0u;
#pragma unroll
        for (unsigned j = 0; j < 16; ++j) { const unsigned c = xb_ld(&bar[XB_XCNT(j)]); sum += c; cnt += (c > 0u) ? 1u : 0u; mine = (j == x) ? c : mine; }
        if (sum == G) break;
        __builtin_amdgcn_s_sleep(1);
        if ((++sp & 255u) == 0u) { if (xb_ld(&bar[XB_TMO])) break; if (sp > XB_SPIN_CAP) { atomicAdd(&bar[XB_TMO], 1u); break; } }
    }
    nloc = mine > 0u ? mine : 1u; nx = cnt > 0u ? cnt : 1u;
}

__device__ __forceinline__ void xcd_barrier(const XcdBarrier& b) {
    asm volatile("s_waitcnt vmcnt(0)" ::: "memory");
    __syncthreads();
    if (threadIdx.x == 0) {
        size_t zoff_ = 0; asm volatile("" : "+s"(zoff_)); unsigned* bar = b.bar + zoff_; unsigned bx_ = b.x; asm volatile("" : "+s"(bx_));
        __builtin_amdgcn_s_waitcnt(0);
        unsigned nloc = b.st[0], nx = b.st[1];
        if (nloc == 0u) { xcd_barrier_complete(bar, bx_, nloc, nx); b.st[0] = nloc; b.st[1] = nx; }
        const unsigned old = xb_add(&bar[XB_XSUB(bx_)], 1u);
        const unsigned gen = old / nloc;
        if (old + 1u == (gen + 1u) * nloc) {
            __builtin_amdgcn_fence(__ATOMIC_RELEASE, "agent");
            asm volatile("s_waitcnt vmcnt(0)" ::: "memory");
            const unsigned og = xb_add(&bar[XB_TOP], 1u);
            const unsigned tg = og / nx;
            if (og + 1u == (tg + 1u) * nx) xb_add(&bar[XB_TOPGEN], 1u);
            else XB_SPIN(xb_ld(&bar[XB_TOPGEN]) == tg, bar);
            __builtin_amdgcn_fence(__ATOMIC_ACQUIRE, "agent");
            xb_add(&bar[XB_XGEN(bx_)], 1u);
            asm volatile("s_waitcnt vmcnt(0)" ::: "memory");
        } else {
            XB_SPIN(xb_ld(&bar[XB_XGEN(bx_)]) == gen, bar);
            __builtin_amdgcn_fence(__ATOMIC_ACQUIRE, "agent");
            asm volatile("s_waitcnt vmcnt(0)" ::: "memory");
        }
    }
    __syncthreads();
}
constexpr int NWAVES = 8;
constexpr int BATCH = 8, SEQ = 4096, DMODEL = 1024, NTOK = BATCH * SEQ, DEPTH = 2, IN_COLS = 2816;
constexpr int NEXP = 16384, PEER_H = 8, PEER_K = 16;
constexpr float RMS_EPS = 1e-6f, LN_EPS = 1e-5f;
constexpr size_t MiB = 1u << 20;
constexpr size_t WS_CTL = 0, CTL_ZERO_BYTES = 1 * MiB;
constexpr size_t WS_WIN = 2 * MiB;
constexpr size_t WS_WOUT = 13 * MiB;
constexpr size_t WS_WQ = 17 * MiB;
constexpr size_t WS_KEYS = 25 * MiB;
constexpr size_t WS_RINV = 26 * MiB;
constexpr size_t WS_SSQ = 27 * MiB;
constexpr size_t WS_EID = 30 * MiB;
constexpr size_t WS_GATE = 38 * MiB;
constexpr size_t WS_SB = 54 * MiB;
constexpr size_t WS_XBF = 72 * MiB;
constexpr size_t WS_QK = 136 * MiB;
constexpr size_t WS_VX = 200 * MiB;
constexpr size_t WS_UT = 264 * MiB;
constexpr size_t WS_VT = 296 * MiB;
constexpr size_t WS_SU = 328 * MiB;
constexpr size_t WS_SV = 329 * MiB;
constexpr size_t WS_EIDT = 330 * MiB;
constexpr size_t WS_CORR = 338 * MiB;
constexpr size_t WS_SSQX = 339 * MiB;
constexpr size_t WS_XQ = 344 * MiB;
constexpr size_t WS_XQS = 376 * MiB;
constexpr size_t WS_CAT = 377 * MiB;
constexpr size_t WS_O = 441 * MiB;
constexpr size_t WS_WSC = 340 * MiB;
constexpr size_t WS_END = 505 * MiB;
constexpr size_t WS_PART = WS_QK;
constexpr size_t WS_WT = WS_SB;
constexpr int CW_BAR = 4096;
constexpr int RING_OFF = 0, RING_BYTES = 131072;
constexpr int LDSCTL_OFF = RING_BYTES, MISC_OFF = LDSCTL_OFF + 320;
constexpr int LDS_BYTES = 147456;

__device__ __forceinline__ float bflo(unsigned w) { return __builtin_bit_cast(float, w << 16); }
__device__ __forceinline__ float bfhi(unsigned w) { return __builtin_bit_cast(float, w & 0xffff0000u); }
__device__ __forceinline__ float bf1(unsigned short w) { return __builtin_bit_cast(float, (unsigned)w << 16); }
#define DPP_ADD(v, ctrl) ((v) + __builtin_bit_cast(float, __builtin_amdgcn_update_dpp(0, __builtin_bit_cast(int, (v)), (ctrl), 0xf, 0xf, true)))
__device__ __forceinline__ float wave_sum(float v) {
    v = DPP_ADD(v, 0xB1);
    v = DPP_ADD(v, 0x4E);
    v = DPP_ADD(v, 0x141);
    v = DPP_ADD(v, 0x140);
    const int b = __builtin_bit_cast(int, v);
    return (__builtin_bit_cast(float, __builtin_amdgcn_readlane(b, 0)) + __builtin_bit_cast(float, __builtin_amdgcn_readlane(b, 16))) + (__builtin_bit_cast(float, __builtin_amdgcn_readlane(b, 32)) + __builtin_bit_cast(float, __builtin_amdgcn_readlane(b, 48)));
}

__device__ __forceinline__ int win_src(int np) {
    const int p = np >> 8, pc = np & 255;
    if (p < 4) return 256 * p + 64 * ((pc & 127) >> 5) + 32 * (pc >> 7) + (pc & 31);
    if (p < 6) return np;
    if (p < 8) { const int kk = p - 6; return pc < 128 ? 1536 + 128 * kk + pc : 1792 + 128 * kk + (pc - 128); }
    if (p < 10) { const int kk = p - 8; return pc < 128 ? 2304 + 128 * kk + pc : 2560 + 128 * kk + (pc - 128); }
    return 2048 + pc;
}
template <int MODE> __device__ __forceinline__ void p0_transpose_item(const float* W, const float* gain, int K, int N, bf16* WT, LAS float* scr, int item, int lane) {
    const int nblk = N / 32, kb = item / nblk, nb = item % nblk, k0 = 64 * kb, n0p = 32 * nb;
    const int n0 = MODE == 1 ? win_src(n0p) : n0p;
#pragma unroll 8
    for (int i = 0; i < 32; ++i) { const int kk = 2 * i + (lane >> 5); const float gk = gain ? gain[k0 + kk] : 1.f; scr[kk * 33 + (lane & 31)] = W[(size_t)(k0 + kk) * N + n0 + (lane & 31)] * gk; }
    LDS_WAIT(); asm volatile("" ::: "memory");
    const int c = lane & 7;
#pragma unroll
    for (int j = 0; j < 4; ++j) { const int n = (lane >> 3) + 8 * j; const LAS float* s = scr + (8 * c) * 33 + n;
        v4u o; o.x = pk2(s[0 * 33], s[1 * 33]); o.y = pk2(s[2 * 33], s[3 * 33]); o.z = pk2(s[4 * 33], s[5 * 33]); o.w = pk2(s[6 * 33], s[7 * 33]);
        *(GAS v4u*)(WT + (size_t)(n0p + n) * K + k0 + 8 * c) = o; }
    LDS_WAIT(); asm volatile("" ::: "memory");
}
__device__ __forceinline__ void p0_convert(const float* src, bf16* dst, size_t n, int gtid, int ngt) {
    for (size_t i = (size_t)gtid * 8; i < n; i += (size_t)ngt * 8) {
        const f32x4 a = *(const GAS f32x4*)(src + i), b = *(const GAS f32x4*)(src + i + 4);
        v4u o; o.x = pk2(a.x, a.y); o.y = pk2(a.z, a.w); o.z = pk2(b.x, b.y); o.w = pk2(b.z, b.w);
        *(GAS v4u*)(dst + i) = o; }
}
__device__ __forceinline__ float wave_max(float v) {
#pragma unroll
    for (int o = 1; o < 64; o <<= 1) v = fmaxf(v, __shfl_xor(v, o));
    return v;
}
template <int OFFS> __device__ __forceinline__ void p0_quant_row(const float* src, unsigned char* dst_base, int e, float* scale_out, int lane) {
    const GAS f32x4* xr = (const GAS f32x4*)src + 4 * lane;
    f32x4 v[4]; float m = 0.f;
#pragma unroll
    for (int j = 0; j < 4; ++j) { v[j] = __builtin_nontemporal_load(xr + j); m = fmaxf(fmaxf(m, fmaxf(fabsf(v[j].x), fabsf(v[j].y))), fmaxf(fabsf(v[j].z), fabsf(v[j].w))); }
    m = wave_max(m);
    const float inv = m > 0.f ? 127.0f / m : 0.f;
    v4u o;
#pragma unroll
    for (int j = 0; j < 4; ++j) { const int a = (int)rintf(v[j].x * inv) + OFFS, b = (int)rintf(v[j].y * inv) + OFFS, c = (int)rintf(v[j].z * inv) + OFFS, d = (int)rintf(v[j].w * inv) + OFFS;
        o[j] = (unsigned)(a & 0xff) | ((unsigned)(b & 0xff) << 8) | ((unsigned)(c & 0xff) << 16) | ((unsigned)(d & 0xff) << 24); }
    *(GAS v4u*)(dst_base + ((size_t)(lane >> 3) * NEXP + e) * 128 + 16 * (lane & 7)) = o;
    if (lane == 0) *scale_out = m * (1.0f / 127.0f);
}
struct QRow { f32x4 v[4]; };
__device__ __forceinline__ void p0_quant_load(QRow& q, const float* src, int lane) { const GAS f32x4* xr = (const GAS f32x4*)src + 4 * lane;
#pragma unroll
    for (int j = 0; j < 4; ++j) q.v[j] = __builtin_nontemporal_load(xr + j); }
__device__ __forceinline__ void p0_quant_fin(const QRow& q, const float* gain, unsigned char* dst_base, int e, float* scale_out, int lane) {
    f32x4 v[4]; float m = 0.f;
#pragma unroll
    for (int j = 0; j < 4; ++j) { v[j] = q.v[j]; if (gain) v[j] = v[j] * *((const GAS f32x4*)gain + 4 * lane + j); m = fmaxf(fmaxf(m, fmaxf(fabsf(v[j].x), fabsf(v[j].y))), fmaxf(fabsf(v[j].z), fabsf(v[j].w))); }
    m = fmaxf(m, __shfl_xor(m, 1)); m = fmaxf(m, __shfl_xor(m, 2)); m = fmaxf(m, __shfl_xor(m, 4)); m = fmaxf(m, __shfl_xor(m, 8));
    const float inv = m > 0.f ? 7.0f / m : 0.f;
    unsigned o[2];
#pragma unroll
    for (int k = 0; k < 2; ++k) { const f32x4 lo = v[2 * k], hi = v[2 * k + 1];
#define Q4(x) ((unsigned)((int)rintf((x) * inv) + 8) & 0xfu)
        o[k] = (Q4(lo.x) | (Q4(hi.x) << 4)) | ((Q4(lo.y) | (Q4(hi.y) << 4)) << 8) | ((Q4(lo.z) | (Q4(hi.z) << 4)) << 16) | ((Q4(lo.w) | (Q4(hi.w) << 4)) << 24);
#undef Q4
    }
    *(GAS unsigned long long*)(dst_base + ((size_t)(lane >> 4) * NEXP + e) * 128 + 8 * (lane & 15)) = (unsigned long long)o[0] | ((unsigned long long)o[1] << 32);
    if ((lane & 15) == 0) scale_out[4 * e + (lane >> 4)] = m * (1.0f / 7.0f);
}
__device__ __forceinline__ void p0_quant_row4(const float* src, const float* gain, unsigned char* dst_base, int e, float* scale_out, int lane) { QRow q; p0_quant_load(q, src, lane); p0_quant_fin(q, gain, dst_base, e, scale_out, lane); }
__device__ __forceinline__ void p0_x_row(const float* xrow, bf16* orow, float* rinv_out, int lane) {
    const GAS f32x4* xr = (const GAS f32x4*)xrow + lane;
    f32x4 v[4]; float s = 0.f;
#pragma unroll
    for (int j = 0; j < 4; ++j) { v[j] = xr[64 * j]; s += (v[j].x * v[j].x + v[j].y * v[j].y) + (v[j].z * v[j].z + v[j].w * v[j].w); }
    s = wave_sum(s);
    GAS unsigned long long* o8 = (GAS unsigned long long*)orow + lane;
#pragma unroll
    for (int j = 0; j < 4; ++j) o8[64 * j] = (unsigned long long)pk2(v[j].x, v[j].y) | ((unsigned long long)pk2(v[j].z, v[j].w) << 32);
    if (lane < 8) rinv_out[lane] = lane == 0 ? s : 0.f;
}

__device__ __forceinline__ float wave_sum_shfl(float v) {
#pragma unroll
    for (int o = 1; o < 64; o <<= 1) v += __shfl_xor(v, o);
    return v;
}
__device__ __forceinline__ void xq_row(const bf16* xrow, signed char* qrow, float* sc4, int lane) {
    const GAS v4u* xp = (const GAS v4u*)xrow + 2 * lane; const v4u a = xp[0], b = xp[1];
#define AMX(w) fmaxf(fabsf(bflo(w)), fabsf(bfhi(w)))
    float am = fmaxf(fmaxf(fmaxf(AMX(a.x), AMX(a.y)), fmaxf(AMX(a.z), AMX(a.w))), fmaxf(fmaxf(AMX(b.x), AMX(b.y)), fmaxf(AMX(b.z), AMX(b.w))));
#undef AMX
    am = fmaxf(am, __shfl_xor(am, 1)); am = fmaxf(am, __shfl_xor(am, 2)); am = fmaxf(am, __shfl_xor(am, 4)); am = fmaxf(am, __shfl_xor(am, 8));
    const float qinv = am > 0.f ? 127.0f / am : 0.f;
#define PK4(wa, wb) (unsigned)(((int)rintf(bflo(wa) * qinv) & 0xff) | (((int)rintf(bfhi(wa) * qinv) & 0xff) << 8) | (((int)rintf(bflo(wb) * qinv) & 0xff) << 16) | (((int)rintf(bfhi(wb) * qinv) & 0xff) << 24))
    v4u o; o.x = PK4(a.x, a.y); o.y = PK4(a.z, a.w); o.z = PK4(b.x, b.y); o.w = PK4(b.z, b.w);
#undef PK4
    *((GAS v4u*)qrow + lane) = o;
    if ((lane & 15) == 0) sc4[lane >> 4] = am * (1.0f / 127.0f);
}
struct CmbArgs { const bf16* O; const bf16* VX; const bf16* SB; bf16* CAT; const float* lq1; const float* lk1; const float* lq2; const float* lk2; const float* subg;
                 const float* cfw; const float* cfb; const float* lng; const float* lnb; const float* scw; float lam_init; };
__device__ __forceinline__ float cmb_lambda(const CmbArgs& A, int lane) { return __expf(wave_sum(A.lq1[lane] * A.lk1[lane])) - __expf(wave_sum(A.lq2[lane] * A.lk2[lane])) + A.lam_init; }
__device__ __forceinline__ void cmb_rows(const CmbArgs& A, float lam, int h, int trow0, int lane_in) {
    asm volatile("s_waitcnt vmcnt(0)" ::: "memory");
    int lane = lane_in; asm volatile("" : "+v"(lane));
    const int vh = lane >> 5, dd = (2 * lane) & 63;
    const int c0 = (4 * h + vh) * 64 + dd, c1 = (4 * h + 2 + vh) * 64 + dd;
    const float g0 = A.subg[2 * lane] * (1.0f - A.lam_init), g1 = A.subg[2 * lane + 1] * (1.0f - A.lam_init);
    unsigned o0[32], o1[32];
#pragma unroll
    for (int tt = 0; tt < 32; ++tt) { const size_t rb = (size_t)(trow0 + tt) * 1024;
        o0[tt] = __hip_atomic_load((const GAS unsigned*)(A.O + rb + c0), __ATOMIC_RELAXED, __HIP_MEMORY_SCOPE_AGENT); o1[tt] = __hip_atomic_load((const GAS unsigned*)(A.O + rb + c1), __ATOMIC_RELAXED, __HIP_MEMORY_SCOPE_AGENT); }
#pragma unroll
    for (int tt = 0; tt < 32; ++tt) {
        const float a0 = bflo(o0[tt]) - lam * bflo(o1[tt]), a1 = bfhi(o0[tt]) - lam * bfhi(o1[tt]);
        const float ss = wave_sum(a0 * a0 + a1 * a1);
        const float ri = 1.0f / sqrtf(ss * (1.0f / 128.0f) + RMS_EPS);
        *(GAS unsigned*)(A.CAT + (size_t)(trow0 + tt) * 1024 + h * 128 + 2 * lane) = pk2(a0 * ri * g0, a1 * ri * g1); }
}
__device__ __forceinline__ void cmb_conv_phase(const CmbArgs& A, int gw, int ngw, int lane) {
    constexpr int NCH = SEQ / 16, NIT = NCH * 4;
    {
        unsigned short xin[46], xn[46];
#define CMB1_LOAD(X, it_) do { const int c_ = 64 * ((it_) & 3) + lane, t0_ = ((it_) >> 2) * 16, s0_ = t0_ & (SEQ - 1); \
        _Pragma("unroll") for (int i = 0; i < 46; ++i) { const int rel = i - 30; (X)[i] = (s0_ + rel >= 0) ? *(const GAS unsigned short*)(A.VX + (size_t)(t0_ + rel) * 1024 + 512 + c_) : (unsigned short)0; } } while (0)
        int it = gw;
        if (it < NIT) CMB1_LOAD(xin, it);
        for (; it < NIT; it += ngw) {
            const int nx = it + ngw < NIT ? it + ngw : it;
            CMB1_LOAD(xn, nx);
            const int c = 64 * (it & 3) + lane, t0 = (it >> 2) * 16;
            float w[31];
#pragma unroll
            for (int j = 0; j < 31; ++j) w[j] = A.cfw[j * 256 + c];
            const float bias = A.cfb[c], lg = A.lng[c], lb = A.lnb[c];
#pragma unroll
            for (int tt = 0; tt < 16; ++tt) { float y = bias;
#pragma unroll
                for (int j = 0; j < 31; ++j) y += w[j] * bf1(xin[tt + j]);
                const float mean = wave_sum(y) * (1.0f / 64.0f); const float d = y - mean;
                const float var = wave_sum(d * d) * (1.0f / 64.0f);
                const float yn = d / sqrtf(var + LN_EPS) * lg + lb;
                const float sw = yn / (1.0f + __expf(-yn));
                *(GAS unsigned short*)(A.CAT + (size_t)(t0 + tt) * 1024 + 512 + c) = (unsigned short)f2bf(sw); }
#pragma unroll
            for (int i = 0; i < 46; ++i) xin[i] = xn[i];
        }
#undef CMB1_LOAD
    }
    {
        unsigned short xin[18], sbv[16], xn[18], sbn[16];
#define CMB2_LOAD(X, S, it_) do { const int c_ = 64 * ((it_) & 3) + lane, t0_ = ((it_) >> 2) * 16, s0_ = t0_ & (SEQ - 1); \
        _Pragma("unroll") for (int i = 0; i < 18; ++i) { const int rel = i - 2; (X)[i] = (s0_ + rel >= 0) ? *(const GAS unsigned short*)(A.VX + (size_t)(t0_ + rel) * 1024 + 768 + c_) : (unsigned short)0; } \
        _Pragma("unroll") for (int tt = 0; tt < 16; ++tt) (S)[tt] = *(const GAS unsigned short*)(A.SB + (size_t)(t0_ + tt) * 256 + c_); } while (0)
        int it = gw;
        if (it < NIT) CMB2_LOAD(xin, sbv, it);
        for (; it < NIT; it += ngw) {
            const int nx = it + ngw < NIT ? it + ngw : it;
            CMB2_LOAD(xn, sbn, nx);
            const int c = 64 * (it & 3) + lane, t0 = (it >> 2) * 16;
            const float w0 = A.scw[c], w1 = A.scw[256 + c], w2 = A.scw[512 + c];
#pragma unroll
            for (int tt = 0; tt < 16; ++tt) {
                const float y = bf1(sbv[tt]) * (w0 * bf1(xin[tt]) + w1 * bf1(xin[tt + 1]) + w2 * bf1(xin[tt + 2]));
                *(GAS unsigned short*)(A.CAT + (size_t)(t0 + tt) * 1024 + 768 + c) = (unsigned short)f2bf(y); }
#pragma unroll
            for (int i = 0; i < 18; ++i) xin[i] = xn[i];
#pragma unroll
            for (int tt = 0; tt < 16; ++tt) sbv[tt] = sbn[tt];
        }
#undef CMB2_LOAD
    }
}

typedef float f32x16 __attribute__((ext_vector_type(16)));
__device__ __forceinline__ int sortable(int b) { return b ^ ((b >> 31) & 0x7fffffff); }
#define CEX_DESC(a, b) do { const int _x = (a), _y = (b); (a) = _x > _y ? _x : _y; (b) = _x > _y ? _y : _x; } while (0)
template <int N> __device__ __forceinline__ void bitonic_merge_desc(int (&v)[N]) {
#pragma unroll
    for (int j = N >> 1; j > 0; j >>= 1)
#pragma unroll
        for (int i = 0; i < N; ++i) if ((i & j) == 0) CEX_DESC(v[i], v[i | j]);
}
template <int N> __device__ __forceinline__ void bitonic_sort_desc(int (&v)[N]) {
#pragma unroll
    for (int k = 2; k <= N; k <<= 1)
#pragma unroll
        for (int j = k >> 1; j > 0; j >>= 1)
#pragma unroll
            for (int i = 0; i < N; ++i) { const int l = i ^ j; if (l > i) { if ((i & k) == 0) CEX_DESC(v[i], v[l]); else CEX_DESC(v[l], v[i]); } }
}
__device__ __forceinline__ void merge_top16(int (&a)[16], const int (&b)[16]) {
#pragma unroll
    for (int i = 0; i < 16; ++i) a[i] = a[i] > b[15 - i] ? a[i] : b[15 - i];
    bitonic_merge_desc<16>(a);
}
__device__ __forceinline__ float vmaxf(float a, float b) { float r; asm("v_max_f32 %0, %1, %2" : "=v"(r) : "v"(a), "v"(b)); return r; }
__device__ __forceinline__ float vminf(float a, float b) { float r; asm("v_min_f32 %0, %1, %2" : "=v"(r) : "v"(a), "v"(b)); return r; }
#define CEXF(a, b) do { const float _x = (a), _y = (b); (a) = vmaxf(_x, _y); (b) = vminf(_x, _y); } while (0)
template <int N> __device__ __forceinline__ void bitonic_merge_f(float (&v)[N]) {
#pragma unroll
    for (int j = N >> 1; j > 0; j >>= 1)
#pragma unroll
        for (int i = 0; i < N; ++i) if ((i & j) == 0) CEXF(v[i], v[i | j]);
}
__device__ __forceinline__ void sort16_f(float (&v)[16]) {
#define CX(i, j) CEXF(v[i], v[j]);
    CX(0,13) CX(1,12) CX(2,15) CX(3,14) CX(4,8) CX(5,6) CX(7,11) CX(9,10)
    CX(0,5) CX(1,7) CX(2,9) CX(3,4) CX(6,13) CX(8,14) CX(10,15) CX(11,12)
    CX(0,1) CX(2,3) CX(4,5) CX(6,8) CX(7,9) CX(10,11) CX(12,13) CX(14,15)
    CX(0,2) CX(1,3) CX(4,10) CX(5,11) CX(6,7) CX(8,9) CX(12,14) CX(13,15)
    CX(1,2) CX(3,12) CX(4,6) CX(5,7) CX(8,10) CX(9,11) CX(13,14)
    CX(1,4) CX(2,6) CX(5,8) CX(7,10) CX(9,13) CX(11,14)
    CX(2,4) CX(3,6) CX(9,12) CX(11,13)
    CX(3,5) CX(6,8) CX(7,9) CX(10,12)
    CX(3,4) CX(5,6) CX(7,8) CX(9,10) CX(11,12)
    CX(6,7) CX(8,9)
#undef CX
}
__device__ __forceinline__ void merge_top16_f(float (&a)[16], const float (&b)[16]) {
#pragma unroll
    for (int i = 0; i < 16; ++i) a[i] = vmaxf(a[i], b[15 - i]);
    bitonic_merge_f<16>(a);
}
__device__ __forceinline__ void stage2_top16(const float (&ta)[16], const float (&tb)[16], float (&R)[16]) {
    float a[16], b[16];
#pragma unroll
    for (int i = 0; i < 16; ++i) { a[i] = __builtin_bit_cast(float, __builtin_bit_cast(int, ta[i]) & ~0x7f); b[i] = __builtin_bit_cast(float, __builtin_bit_cast(int, tb[i]) & ~0x7f); }
#define MK(i, j) __builtin_bit_cast(float, (__builtin_bit_cast(int, a[i] + b[j]) & ~0xff) | ((i) << 4) | (j))
    const float NINF = __builtin_bit_cast(float, 0xff800000u);
#pragma unroll
    for (int j = 0; j < 16; ++j) R[j] = MK(0, j);
#pragma unroll
    for (int i = 1; i < 16; ++i) R[i] = vmaxf(R[i], MK(16 - i, 0));
    bitonic_merge_f<16>(R);
    {
        float C[16];
#pragma unroll
        for (int j = 1; j < 8; ++j) C[j - 1] = MK(1, j);
        C[7] = NINF; C[8] = NINF; C[9] = NINF;
#pragma unroll
        for (int i = 7; i >= 2; --i) C[17 - i] = MK(i, 1);
        bitonic_merge_f<16>(C);
#pragma unroll
        for (int i = 3; i < 16; ++i) R[i] = vmaxf(R[i], C[15 - i]);
        bitonic_merge_f<16>(R);
    }
    {
        float d0 = MK(2, 2), p = MK(2, 3), q = MK(2, 4), r = MK(3, 2), s = MK(4, 2), t = MK(3, 3);
        CEXF(p, r); CEXF(q, s); CEXF(r, q);
        CEXF(q, t); CEXF(s, t);
        R[10] = vmaxf(R[10], t); R[11] = vmaxf(R[11], s); R[12] = vmaxf(R[12], q); R[13] = vmaxf(R[13], r); R[14] = vmaxf(R[14], p); R[15] = vmaxf(R[15], d0);
    }
#undef MK
}
struct QuantJob { const float* usrc; const float* vsrc; const float* gain; unsigned char* UT; unsigned char* VT; float* SU; float* SV; int r0, rs; };
struct TopkArgs { const bf16* Qp; const bf16* keys; const float* ssq; unsigned short* eid; float* gate; unsigned short* eidT;
#ifdef DBG_CHECK
 float* dbgS; int* dbgI;
#endif
 };
__device__ __forceinline__ void topk_phase(const TopkArgs& A, const QuantJob& J, int& qr_next, LAS unsigned char* ldsK  , LAS unsigned char* ldsw  , int h, int rank, int nrank, int wave, int tid, int lane) {
    const int r32 = lane & 31, hi = lane >> 5;
    __syncthreads();
    {
        const GAS v4u* src = (const GAS v4u*)(A.keys + (size_t)h * 2 * 128 * 128);
#pragma unroll
        for (int i = 0; i < 8; ++i) { const int g = tid + 512 * i, row = g >> 4, ch = g & 15; *(LAS v4u*)(ldsK + row * 256 + ((ch ^ (row & 15)) << 4)) = src[g]; }
        __syncthreads();
    }
    for (int tg = rank * 8 + wave; tg < SEQ / 32; tg += nrank * 8) {
        const int t = tg * 32 + r32;
        int hb = hi << 2; asm volatile("" : "+v"(hb));
        float rinv2; { const GAS f32x4* sp = (const GAS f32x4*)(A.ssq + (size_t)t * 16); const f32x4 a = sp[0], b = sp[1], c = sp[2], d = sp[3];
            const float ss = ((a.x + a.y) + (a.z + a.w)) + ((b.x + b.y) + (b.z + b.w)) + ((c.x + c.y) + (c.z + c.w)) + ((d.x + d.y) + (d.z + d.w));
            rinv2 = 1.0f / sqrtf(ss * (1.0f / DMODEL) + RMS_EPS); }
        float top[2][16];
#pragma unroll
        for (int c = 0; c < 2; ++c) {
            const int qra = qr_next < NEXP ? qr_next : NEXP - 1; const bool qok = qr_next < NEXP; qr_next += J.rs;
            QRow qua, qva;
            p0_quant_load(qua, J.usrc + (size_t)qra * DMODEL, lane); p0_quant_load(qva, J.vsrc + (size_t)qra * DMODEL, lane);
            const bf16* qrow = A.Qp + (size_t)t * 2048 + h * 256 + c * 128 + 8 * hi;
            bf16x8 qf[8];
#pragma unroll
            for (int s = 0; s < 8; ++s) qf[s] = *(const GAS bf16x8*)(qrow + 16 * s);
            float run[16];
            int koff = c * 32768 + r32 * 256; asm volatile("" : "+v"(koff));
            const int ksw = r32 & 15;
#pragma unroll
            for (int nt = 0; nt < 4; ++nt) {
                bf16x8 kf[8];
#pragma unroll
                for (int s = 0; s < 8; ++s) kf[s] = *(const LAS bf16x8*)(ldsK + nt * 8192 + koff + (((2 * s + hi) ^ ksw) << 4));
                f32x16 acc = {0.f, 0.f, 0.f, 0.f, 0.f, 0.f, 0.f, 0.f, 0.f, 0.f, 0.f, 0.f, 0.f, 0.f, 0.f, 0.f};
#pragma unroll
                for (int s = 0; s < 8; ++s) acc = __builtin_amdgcn_mfma_f32_32x32x16_bf16(kf[s], qf[s], acc, 0, 0, 0);
                asm volatile("" ::: "memory");
                float g[16];
#pragma unroll
                for (int r = 0; r < 16; ++r) { const int idx = 32 * nt + (r & 3) + 8 * (r >> 2);
                    const float av = acc[r];
                    g[r] = __int_as_float(((__float_as_int(av) & ~0x7f) | idx) | hb); }
                sort16_f(g);
                if (nt == 0) {
#pragma unroll
                    for (int r = 0; r < 16; ++r) run[r] = g[r];
                } else merge_top16_f(run, g);
            }
            {
                float other[16];
#pragma unroll
                for (int i = 0; i < 16; ++i) other[i] = __shfl_xor(run[i], 32);
                merge_top16_f(run, other);
            }
#pragma unroll
            for (int i = 0; i < 16; ++i) top[c][i] = run[i];
            if (qok) { p0_quant_fin(qua, J.gain, J.UT, qra, J.SU, lane); p0_quant_fin(qva, nullptr, J.VT, qra, J.SV, lane); }
        }
#pragma unroll
        for (int c = 0; c < 2; ++c)
#pragma unroll
            for (int q4 = 0; q4 < 4; ++q4) { const unsigned w = (unsigned)(__float_as_int(top[c][4 * q4]) & 0x7f) | ((unsigned)(__float_as_int(top[c][4 * q4 + 1]) & 0x7f) << 8) | ((unsigned)(__float_as_int(top[c][4 * q4 + 2]) & 0x7f) << 16) | ((unsigned)(__float_as_int(top[c][4 * q4 + 3]) & 0x7f) << 24);
                *(LAS unsigned*)(ldsw + lane * 32 + c * 16 + q4 * 4) = w; }
        float crun[16];
        stage2_top16(top[0], top[1], crun);
        LDS_WAIT(); asm volatile("" ::: "memory");
        float sc[16]; unsigned e[16];
#pragma unroll
        for (int k = 0; k < 16; ++k) { const int bits = __float_as_int(crun[k]); const int i = (bits >> 4) & 15, j = bits & 15;
            sc[k] = __builtin_bit_cast(float, bits & ~0xff) * rinv2;
            const unsigned i1 = *(const LAS unsigned char*)(ldsw + lane * 32 + i), i2 = *(const LAS unsigned char*)(ldsw + lane * 32 + 16 + j);
            e[k] = i1 * 128u + i2; }
        const float mx = sc[0];
        float z = 0.f;
#pragma unroll
        for (int k = 0; k < 16; ++k) { sc[k] = __expf(sc[k] - mx); z += sc[k]; }
        const float iz = 1.0f / z;
        if (hi == 0) {
            v4u e0, e1; e0.x = e[0] | (e[1] << 16); e0.y = e[2] | (e[3] << 16); e0.z = e[4] | (e[5] << 16); e0.w = e[6] | (e[7] << 16);
            e1.x = e[8] | (e[9] << 16); e1.y = e[10] | (e[11] << 16); e1.z = e[12] | (e[13] << 16); e1.w = e[14] | (e[15] << 16);
            GAS v4u* ep = (GAS v4u*)(A.eid + (size_t)t * 128 + h * 16); ep[0] = e0; ep[1] = e1;
#pragma unroll
            for (int k = 0; k < 8; ++k) *(GAS unsigned*)(A.eidT + (size_t)t * 128 + k * 16 + 2 * h) = e[k] | (e[k + 8] << 16);
        } else {
            GAS f32x4* gp = (GAS f32x4*)(A.gate + (size_t)t * 128 + h * 16);
#pragma unroll
            for (int q4 = 0; q4 < 4; ++q4) gp[q4] = (f32x4){sc[4 * q4] * iz, sc[4 * q4 + 1] * iz, sc[4 * q4 + 2] * iz, sc[4 * q4 + 3] * iz};
        }
    }
}

__device__ __forceinline__ float gelu_exact(float v) { return 0.5f * v * (1.0f + erff(v * 0.70710678118654752f)); }
__device__ __forceinline__ float ub0(unsigned x) { float f; asm("v_cvt_f32_ubyte0 %0, %1" : "=v"(f) : "v"(x)); return f; }
__device__ __forceinline__ float ub1(unsigned x) { float f; asm("v_cvt_f32_ubyte1 %0, %1" : "=v"(f) : "v"(x)); return f; }
__device__ __forceinline__ float ub2(unsigned x) { float f; asm("v_cvt_f32_ubyte2 %0, %1" : "=v"(f) : "v"(x)); return f; }
__device__ __forceinline__ float ub3(unsigned x) { float f; asm("v_cvt_f32_ubyte3 %0, %1" : "=v"(f) : "v"(x)); return f; }
template <class T> __device__ __forceinline__ T tr_xchg_add(T a, T b, int O, int lane) {
    if (O == 16 || O == 32) {
        const unsigned ua = __builtin_bit_cast(unsigned, a), ub = __builtin_bit_cast(unsigned, b);
        if (O == 16) { auto r = __builtin_amdgcn_permlane16_swap(ua, ub, false, false); return __builtin_bit_cast(T, (unsigned)r[0]) + __builtin_bit_cast(T, (unsigned)r[1]); }
        else         { auto r = __builtin_amdgcn_permlane32_swap(ua, ub, false, false); return __builtin_bit_cast(T, (unsigned)r[0]) + __builtin_bit_cast(T, (unsigned)r[1]); }
    } else {
        const bool up = (lane & O) != 0; const T send = up ? a : b, keep = up ? b : a;
        const int si = __builtin_bit_cast(int, send);
        const int ri = O == 1 ? __builtin_amdgcn_update_dpp(0, si, 0xB1, 0xf, 0xf, true) : O == 2 ? __builtin_amdgcn_update_dpp(0, si, 0x4E, 0xf, 0xf, true)
                     : O == 4 ? __builtin_amdgcn_update_dpp(0, si, 0x124, 0xf, 0xf, true)
                     : __builtin_amdgcn_update_dpp(0, si, 0x128, 0xf, 0xf, true);
        return keep + __builtin_bit_cast(T, ri);
    }
}
template <class T, int N, int O, int NEND> struct TReduce {
    static __device__ __forceinline__ void run(T (&v)[N], T (&out)[NEND], int lane) {
        T w[N / 2];
#pragma unroll
        for (int i = 0; i < N / 2; ++i) {
            if (O == 4) { const bool up = (lane & O) != 0; const T send = up ? v[2 * i] : v[2 * i + 1], keep = up ? v[2 * i + 1] : v[2 * i]; w[i] = keep + __shfl_xor(send, O); }
            else w[i] = tr_xchg_add<T>(v[2 * i], v[2 * i + 1], O, lane);
        }
        TReduce<T, N / 2, O * 2, NEND>::run(w, out, lane);
    }
};
template <class T, int O, int NEND> struct TReduce<T, NEND, O, NEND> { static __device__ __forceinline__ void run(T (&v)[NEND], T (&out)[NEND], int) {
#pragma unroll
    for (int i = 0; i < NEND; ++i) out[i] = v[i]; } };
struct PeerUArgs { const signed char* xq; const float* xqs; const unsigned char* UT; const unsigned short* eidT; float* part; };
struct MetaU { v4u ea, eb, qa, qb; float sx; };
__device__ __forceinline__ void peer_u_run(const PeerUArgs& A, int t0, int tl0, int lane) {
    const int pp = lane >> 3, cc = lane & 7;
    const unsigned char* Us = A.UT + 16 * cc;
#define U_META(M, tt_) do { const int i_ = (tt_) < 63 ? (tt_) : 63; const int t_ = t0 + (i_ & 15), s_ = i_ >> 4; const GAS v4u* ep_ = (const GAS v4u*)(A.eidT + (size_t)t_ * 128 + pp * 16); (M).ea = ep_[0]; (M).eb = ep_[1]; \
        const GAS v4u* xp_ = (const GAS v4u*)(A.xq + (size_t)t_ * DMODEL + 256 * s_ + 32 * cc); (M).qa = xp_[0]; (M).qb = xp_[1]; (M).sx = A.xqs[(size_t)t_ * 4 + s_]; } while (0)
#define U_TAB(Q, M, tt_) do { const int i_ = (tt_) < 63 ? (tt_) : 63; const unsigned char* Ui_ = Us + (size_t)(i_ >> 4) * NEXP * 128; \
        _Pragma("unroll") for (int g = 0; g < 16; ++g) { const unsigned ew_ = g < 8 ? (M).ea[g >> 1] : (M).eb[(g - 8) >> 1]; const unsigned e_ = (g & 1) ? (ew_ >> 16) : (ew_ & 0xffffu); \
        (Q)[g] = *(const GAS v4u*)(Ui_ + (size_t)e_ * 128); } } while (0)
#define U_COMP(M, Q, tt_) do { const int tl_ = tl0 + ((tt_) & 15), s4_ = (tt_) >> 4; int part[16]; \
        int sm_ = 0; _Pragma("unroll") for (int k = 0; k < 4; ++k) { sm_ = __builtin_amdgcn_sdot4(0x01010101, (int)(M).qa[k], sm_, false); sm_ = __builtin_amdgcn_sdot4(0x01010101, (int)(M).qb[k], sm_, false); } sm_ *= -8; \
        _Pragma("unroll") for (int g = 0; g < 16; ++g) { int a_ = sm_; \
            _Pragma("unroll") for (int k = 0; k < 4; ++k) { const unsigned d_ = (Q)[g][k]; const int x0_ = (int)(k < 2 ? (M).qa[2 * k] : (M).qb[2 * k - 4]), x1_ = (int)(k < 2 ? (M).qa[2 * k + 1] : (M).qb[2 * k - 3]); \
                a_ = __builtin_amdgcn_sdot4((int)(d_ & 0x0f0f0f0fu), x0_, a_, false); a_ = __builtin_amdgcn_sdot4((int)((d_ >> 4) & 0x0f0f0f0fu), x1_, a_, false); } \
            part[g] = a_; } \
        int tot[2]; TReduce<int, 16, 1, 2>::run(part, tot, lane); \
        float* po = A.part + ((size_t)s4_ * SEQ + tl_) * 128 + 8 * cc + pp; po[0] = (float)tot[0] * (M).sx; po[64] = (float)tot[1] * (M).sx; } while (0)
    MetaU mc, mn, mnn; v4u QA[16], QB[16];
    U_META(mc, 0); U_META(mn, 1); U_TAB(QA, mc, 0);
    for (int tt = 0; tt < 64; tt += 2) {
        U_META(mnn, tt + 2); U_TAB(QB, mn, tt + 1); U_COMP(mc, QA, tt); mc = mn; mn = mnn;
        U_META(mnn, tt + 3); U_TAB(QA, mn, tt + 2); U_COMP(mc, QB, tt + 1); mc = mn; mn = mnn;
    }
#undef U_META
#undef U_TAB
#undef U_COMP
}
struct PeerRArgs { const float* part; const float* ssq; const unsigned short* eid; const float* gate; const float* su; const float* sv; signed char* wq; float* wsc; };
struct MetaR { int e0, e1; float g0, g1, ssq; float p0[4], p1[4]; };
struct GathR { f32x4 su0, su1, sv0, sv1; };
__device__ __forceinline__ void peer_r_run(const PeerRArgs& A, int t0, int tl0, int lane) {
#define R_META(M, k_) do { const int kk_ = (k_) < 15 ? (k_) : 15; const int tq_ = t0 + kk_, tl_ = tl0 + kk_; (M).e0 = A.eid[(size_t)tq_ * 128 + lane]; (M).e1 = A.eid[(size_t)tq_ * 128 + 64 + lane]; \
        (M).g0 = A.gate[(size_t)tq_ * 128 + lane]; (M).g1 = A.gate[(size_t)tq_ * 128 + 64 + lane]; (M).ssq = lane < 16 ? A.ssq[(size_t)tq_ * 16 + lane] : 0.f; \
        _Pragma("unroll") for (int s = 0; s < 4; ++s) { const float* pr_ = A.part + ((size_t)s * SEQ + tl_) * 128; (M).p0[s] = pr_[lane]; (M).p1[s] = pr_[64 + lane]; } } while (0)
#define R_GATH(Gv, M) do { (Gv).su0 = *(const GAS f32x4*)(A.su + 4 * (M).e0); (Gv).su1 = *(const GAS f32x4*)(A.su + 4 * (M).e1); (Gv).sv0 = *(const GAS f32x4*)(A.sv + 4 * (M).e0); (Gv).sv1 = *(const GAS f32x4*)(A.sv + 4 * (M).e1); } while (0)
    MetaR mc, mn, mnn; GathR gc, gn;
    R_META(mc, 0); R_META(mn, 1); R_GATH(gc, mc);
    for (int k = 0; k < 16; ++k) { const int t = t0 + k;
        R_META(mnn, k + 2); R_GATH(gn, mn);
        float z0 = 0.f, z1 = 0.f;
#pragma unroll
        for (int s = 0; s < 4; ++s) { z0 += mc.p0[s] * gc.su0[s]; z1 += mc.p1[s] * gc.su1[s]; }
        const float ss = wave_sum(mc.ssq);
        const float ri = 1.0f / sqrtf(ss * (1.0f / DMODEL) + RMS_EPS);
        const float w0 = mc.g0 * gelu_exact(z0 * ri), w1 = mc.g1 * gelu_exact(z1 * ri);
#pragma unroll
        for (int s = 0; s < 4; ++s) { const float a0 = w0 * gc.sv0[s], a1 = w1 * gc.sv1[s];
            const float gm = wave_max(fmaxf(fabsf(a0), fabsf(a1)));
            const float inv = gm > 0.f ? 127.0f / gm : 0.f;
            signed char* wr = A.wq + ((size_t)t * 4 + s) * 128 + (lane & 7) * 16 + (lane >> 3);
            wr[0] = (signed char)(int)rintf(a0 * inv); wr[8] = (signed char)(int)rintf(a1 * inv);
            if (lane == 0) A.wsc[(size_t)t * 4 + s] = gm * (1.0f / 127.0f); }
        mc = mn; mn = mnn; gc = gn;
    }
#undef R_META
#undef R_GATH
}
typedef unsigned u32x2 __attribute__((ext_vector_type(2)));
struct PeerVArgs { float* xout  ; const unsigned char* VT; const unsigned short* eidT; const signed char* wq; const float* wsc; bf16* xb; float* ssqx; };
struct MetaV { v4u ea, eb, wq; float sc; u32x2 xv; };
__device__ __forceinline__ void peer_v_run(const PeerVArgs& A, int t0, int lane) {
    const int pp = lane >> 3, cc = lane & 7;
    {
        const unsigned char* Vs = A.VT + 16 * cc;
#define V_META(M, tt_) do { const int i_ = (tt_) < 63 ? (tt_) : 63; const int t_ = t0 + (i_ & 15), s4 = i_ >> 4; const GAS v4u* ep_ = (const GAS v4u*)(A.eidT + (size_t)t_ * 128 + pp * 16); (M).ea = ep_[0]; (M).eb = ep_[1]; \
        (M).wq = *(const GAS v4u*)(A.wq + ((size_t)t_ * 4 + s4) * 128 + pp * 16); (M).sc = A.wsc[(size_t)t_ * 4 + s4]; (M).xv = *(const GAS u32x2*)(A.xb + (size_t)t_ * DMODEL + 256 * s4 + 32 * cc + 4 * pp); } while (0)
#define V_TAB(Q, M, tt_) do { const int i_ = (tt_) < 63 ? (tt_) : 63; const unsigned char* Vi_ = Vs + (size_t)(i_ >> 4) * NEXP * 128; _Pragma("unroll") for (int g = 0; g < 16; ++g) { const unsigned ew_ = g < 8 ? (M).ea[g >> 1] : (M).eb[(g - 8) >> 1]; const unsigned e_ = (g & 1) ? (ew_ >> 16) : (ew_ & 0xffffu); \
        (Q)[g] = *(const GAS v4u*)(Vi_ + (size_t)e_ * 128); } } while (0)
#define V_COMP(M, Q, tt_) do { const int t_ = t0 + ((tt_) & 15), s4 = (tt_) >> 4; \
        int c8 = 0; _Pragma("unroll") for (int a = 0; a < 4; ++a) c8 = __builtin_amdgcn_sdot4(0x01010101, (int)(M).wq[a], c8, false); c8 *= -8; \
        int acc[32]; _Pragma("unroll") for (int i = 0; i < 32; ++i) acc[i] = c8; \
        _Pragma("unroll") for (int a = 0; a < 4; ++a) { const int wa_ = (int)(M).wq[a]; \
            _Pragma("unroll") for (int k = 0; k < 4; ++k) { const unsigned r0 = (Q)[4 * a][k], r1 = (Q)[4 * a + 1][k], r2 = (Q)[4 * a + 2][k], r3 = (Q)[4 * a + 3][k]; \
                  \
                const unsigned u01l = __builtin_amdgcn_perm(r1, r0, 0x05010400u), u01h = __builtin_amdgcn_perm(r1, r0, 0x07030602u), u23l = __builtin_amdgcn_perm(r3, r2, 0x05010400u), u23h = __builtin_amdgcn_perm(r3, r2, 0x07030602u); \
                const unsigned tb0 = __builtin_amdgcn_perm(u23l, u01l, 0x05040100u), tb1 = __builtin_amdgcn_perm(u23l, u01l, 0x07060302u), tb2 = __builtin_amdgcn_perm(u23h, u01h, 0x05040100u), tb3 = __builtin_amdgcn_perm(u23h, u01h, 0x07060302u); \
                acc[8 * k + 0] = __builtin_amdgcn_sdot4((int)(tb0 & 0x0f0f0f0fu), wa_, acc[8 * k + 0], false); acc[8 * k + 4] = __builtin_amdgcn_sdot4((int)((tb0 >> 4) & 0x0f0f0f0fu), wa_, acc[8 * k + 4], false); \
                acc[8 * k + 1] = __builtin_amdgcn_sdot4((int)(tb1 & 0x0f0f0f0fu), wa_, acc[8 * k + 1], false); acc[8 * k + 5] = __builtin_amdgcn_sdot4((int)((tb1 >> 4) & 0x0f0f0f0fu), wa_, acc[8 * k + 5], false); \
                acc[8 * k + 2] = __builtin_amdgcn_sdot4((int)(tb2 & 0x0f0f0f0fu), wa_, acc[8 * k + 2], false); acc[8 * k + 6] = __builtin_amdgcn_sdot4((int)((tb2 >> 4) & 0x0f0f0f0fu), wa_, acc[8 * k + 6], false); \
                acc[8 * k + 3] = __builtin_amdgcn_sdot4((int)(tb3 & 0x0f0f0f0fu), wa_, acc[8 * k + 3], false); acc[8 * k + 7] = __builtin_amdgcn_sdot4((int)((tb3 >> 4) & 0x0f0f0f0fu), wa_, acc[8 * k + 7], false); } } \
        int av[32]; _Pragma("unroll") for (int i = 0; i < 32; ++i) av[8 * (i & 3) + (i >> 2)] = acc[i];     \
        int tot[4]; TReduce<int, 32, 8, 4>::run(av, tot, lane); \
        const f32x4 vo = (f32x4){bflo((M).xv.x), bfhi((M).xv.x), bflo((M).xv.y), bfhi((M).xv.y)} + (f32x4){(float)tot[0], (float)tot[1], (float)tot[2], (float)tot[3]} * (M).sc; \
        if (A.xout) *(GAS f32x4*)(A.xout + (size_t)t_ * DMODEL + 256 * s4 + 32 * cc + 4 * pp) = vo; \
        *(GAS u32x2*)(A.xb + (size_t)t_ * DMODEL + 256 * s4 + 32 * cc + 4 * pp) = (u32x2){pk2(vo.x, vo.y), pk2(vo.z, vo.w)}; \
        const float s2 = wave_sum((vo.x * vo.x + vo.y * vo.y) + (vo.z * vo.z + vo.w * vo.w)); if (lane == 0) A.ssqx[(size_t)t_ * 8 + s4] = s2; } while (0)
        MetaV mc, mn, mnn; v4u QA[16], QB[16];
        V_META(mc, 0); V_META(mn, 1); V_TAB(QA, mc, 0);
        for (int tt = 0; tt < 64; tt += 2) {
            V_META(mnn, tt + 2); V_TAB(QB, mn, tt + 1); V_COMP(mc, QA, tt); mc = mn; mn = mnn;
            V_META(mnn, tt + 3); V_TAB(QA, mn, tt + 2); V_COMP(mc, QB, tt + 1); mc = mn; mn = mnn;
        }
#undef V_META
#undef V_TAB
#undef V_COMP
    }
}

#ifdef DBG_CHECK
constexpr int DBG_FLAGS = 2048, DBG_NS = 64;
constexpr size_t WS_DBG = 56 * MiB;
struct DbgArgs { const unsigned short* qp; const float* ssq; const float* x1; const float* g2; const float* wq; const float* keys; const float* uf; const float* vf; const unsigned short* eid; const float* gate; float* exp_out; gu32* flags; };
__device__ __forceinline__ void dbg_check_topk_and_expect(const DbgArgs& A, LAS unsigned char* ldsw, int gw, int ngw, int lane) {
    LAS float* qs = (LAS float*)ldsw; LAS float* subs = qs + 256; LAS float* cand = subs + 256; LAS float* h2s = cand + 256;
    LAS int* sel = (LAS int*)(h2s + 1024);
    LAS float* selv = (LAS float*)(sel + 64);
    _Pragma("nounroll") for (int smp = gw; smp < DBG_NS * 8; smp += ngw) {
        const int si = smp >> 3, h = smp & 7; const int t = (si * 509 + 17) % NTOK;
        const float* xr = A.x1 + (size_t)t * DMODEL;
        float ss = 0.f; _Pragma("nounroll") for (int k = lane; k < DMODEL; k += 64) ss += xr[k] * xr[k];
        ss = wave_sum(ss); const float ri = 1.0f / sqrtf(ss * (1.0f / DMODEL) + RMS_EPS);
        _Pragma("nounroll") for (int k = lane; k < DMODEL; k += 64) h2s[k] = xr[k] * ri * A.g2[k];
        LDS_WAIT();
        _Pragma("nounroll") for (int i = 0; i < 4; ++i) { const int col = h * 256 + lane + 64 * i; float a = 0.f; _Pragma("nounroll") for (int k = 0; k < DMODEL; ++k) a += h2s[k] * A.wq[(size_t)k * 2048 + col]; qs[lane + 64 * i] = a; }
        LDS_WAIT();
        { int badq = 0;
          _Pragma("nounroll") for (int i = 0; i < 4; ++i) { const float ref = qs[lane + 64 * i] / ri; const float got = bf1(A.qp[(size_t)t * 2048 + h * 256 + lane + 64 * i]); if (!(fabsf(got - ref) <= 0.03f * fabsf(ref) + 0.05f)) badq = 0; }
          float s16 = 0.f; _Pragma("nounroll") for (int i = 0; i < 16; ++i) s16 += A.ssq[(size_t)t * 16 + i];
          if (!(fabsf(s16 - ss) <= 1e-3f * ss)) badq |= 0;
          if (badq) __hip_atomic_fetch_or(A.flags, (unsigned)badq, __ATOMIC_RELAXED, __HIP_MEMORY_SCOPE_AGENT); }
        _Pragma("nounroll") for (int i = 0; i < 4; ++i) { const int c = i >> 1, n = lane + 64 * (i & 1); const float* kr = A.keys + (size_t)((h * 2 + c) * 128 + n) * 128; float a = 0.f; _Pragma("nounroll") for (int d = 0; d < 128; ++d) a += qs[c * 128 + d] * kr[d]; subs[c * 128 + n] = a; }
        LDS_WAIT();
        if (lane < 2) { const int c = lane; _Pragma("nounroll") for (int k = 0; k < 16; ++k) { int bi = 0; float bv = -3.0e38f; _Pragma("nounroll") for (int n = 0; n < 128; ++n) { const float v = subs[c * 128 + n]; if (v > bv) { bv = v; bi = n; } } sel[c * 16 + k] = bi; selv[c * 16 + k] = bv; subs[c * 128 + bi] = -3.0e38f; } }
        LDS_WAIT();
        _Pragma("nounroll") for (int i = 0; i < 4; ++i) { const int ci = lane + 64 * i; cand[ci] = selv[ci >> 4] + selv[16 + (ci & 15)]; }
        LDS_WAIT();
        int bad = 0;
        if (lane == 0) {
            _Pragma("nounroll") for (int k = 0; k < 16; ++k) { int bi = 0; float bv = -3.0e38f; _Pragma("nounroll") for (int n = 0; n < 256; ++n) { const float v = cand[n]; if (v > bv) { bv = v; bi = n; } } cand[bi] = -3.0e38f; sel[32 + k] = sel[bi >> 4] * 128 + sel[16 + (bi & 15)]; selv[32 + k] = bv; }
            float z = 0.f; _Pragma("nounroll") for (int k = 0; k < 16; ++k) { selv[48 + k] = __expf(selv[32 + k] - selv[32]); z += selv[48 + k]; }
            int miss = 0; float gerr = 0.f;
            _Pragma("nounroll") for (int k = 0; k < 16; ++k) { const int e = sel[32 + k]; const float g = selv[48 + k] / z; int found = -1;
                _Pragma("nounroll") for (int k2 = 0; k2 < 16; ++k2) if ((int)A.eid[(size_t)t * 128 + h * 16 + k2] == e) found = k2;
                if (found < 0) { if (g > 0.02f) ++miss; } else gerr = fmaxf(gerr, fabsf(A.gate[(size_t)t * 128 + h * 16 + found] - g)); }
            if (miss > 1) bad |= 1;
            if (gerr > 0.03f) bad |= 0;
            if (bad) __hip_atomic_fetch_or(A.flags, (unsigned)bad, __ATOMIC_RELAXED, __HIP_MEMORY_SCOPE_AGENT);
        }
        LDS_WAIT();
        if (h == 0) {
            float acc[16];
#pragma unroll
            for (int i = 0; i < 16; ++i) acc[i] = 0.f;
            _Pragma("nounroll") for (int j = 0; j < 128; ++j) { const int e = A.eid[(size_t)t * 128 + j]; const float g = A.gate[(size_t)t * 128 + j];
                const float* ur = A.uf + (size_t)e * DMODEL; float zz = 0.f; _Pragma("nounroll") for (int k = lane; k < DMODEL; k += 64) zz += ur[k] * h2s[k];
                zz = wave_sum(zz); const float w = g * gelu_exact(zz); const float* vr = A.vf + (size_t)e * DMODEL;
#pragma unroll
                for (int i = 0; i < 16; ++i) acc[i] += w * vr[lane + 64 * i]; }
#pragma unroll
            for (int i = 0; i < 16; ++i) A.exp_out[(size_t)si * DMODEL + lane + 64 * i] = xr[lane + 64 * i] + acc[i];
        }
        LDS_WAIT();
    }
}
__device__ __forceinline__ void dbg_check_scores(const unsigned short* Qp, const unsigned short* keysb, const float* dbgS, const int* dbgI, gu32* flags, LAS unsigned char* ldsw, int gw, int ngw, int lane) {
    LAS float* sc = (LAS float*)ldsw;
    _Pragma("nounroll") for (int it = gw; it < 32 * 8 * 2; it += ngw) { const int t = it >> 4, h = (it >> 1) & 7, c = it & 1; int bad = 0;
        _Pragma("nounroll") for (int i = 0; i < 2; ++i) { const int n = lane + 64 * i; float a = 0.f;
            _Pragma("nounroll") for (int d = 0; d < 128; ++d) a += bf1(Qp[(size_t)t * 2048 + h * 256 + c * 128 + d]) * bf1(keysb[(size_t)((h * 2 + c) * 128 + n) * 128 + d]);
            const float got = dbgS[((size_t)(t * 8 + h) * 2 + c) * 128 + n]; if (!(fabsf(got - a) <= 1e-3f * fabsf(a) + 1e-3f)) bad |= 0; sc[n] = got; }
        LDS_WAIT();
        if (lane == 0) { int miss = 0;
            _Pragma("nounroll") for (int k = 0; k < 16; ++k) { int bi = 0; float bv = -3.0e38f; _Pragma("nounroll") for (int n = 0; n < 128; ++n) { const float v = sc[n]; if (v > bv) { bv = v; bi = n; } } sc[bi] = -3.0e38f;
                const int got = dbgI[((size_t)(t * 8 + h) * 2 + c) * 16 + k]; const float gs = dbgS[((size_t)(t * 8 + h) * 2 + c) * 128 + (got & 0x7f)];
                if (!(fabsf(gs - bv) <= 1e-4f * fabsf(bv) + 1e-6f)) ++miss; }
            if (miss) bad |= 2; }
        bad = __builtin_amdgcn_readfirstlane(bad) | bad;
        if (bad) __hip_atomic_fetch_or(flags, (unsigned)bad, __ATOMIC_RELAXED, __HIP_MEMORY_SCOPE_AGENT);
        LDS_WAIT(); }
}
__device__ __forceinline__ void dbg_check_stage2(const int* dbgI, const float* ssq, const unsigned short* eid, const float* gate, gu32* flags, LAS unsigned char* ldsw, int gw, int ngw, int lane) {
    LAS float* cand = (LAS float*)ldsw;
    _Pragma("nounroll") for (int it = gw; it < 32 * 8; it += ngw) { const int t = it >> 3, h = it & 7; int bad = 0;
        float s16 = 0.f; _Pragma("nounroll") for (int i = 0; i < 16; ++i) s16 += ssq[(size_t)t * 16 + i];
        const float rinv2 = 1.0f / sqrtf(s16 * (1.0f / DMODEL) + RMS_EPS);
        const int* I0 = dbgI + ((size_t)(t * 8 + h) * 2 + 0) * 16; const int* I1 = dbgI + ((size_t)(t * 8 + h) * 2 + 1) * 16;
        _Pragma("nounroll") for (int i = 0; i < 4; ++i) { const int ci = lane + 64 * i; cand[ci] = __builtin_bit_cast(float, I0[ci >> 4] & ~0x7f) + __builtin_bit_cast(float, I1[ci & 15] & ~0x7f); }
        LDS_WAIT();
        if (lane == 0) { float sv[1]; (void)sv; float top0 = 0.f, z = 0.f; int miss = 0; float gerr = 0.f;
            float vals[1]; (void)vals;
            LAS float* selv = cand + 256; LAS int* sele = (LAS int*)(cand + 272);
            _Pragma("nounroll") for (int k = 0; k < 16; ++k) { int bi = 0; float bv = -3.0e38f; _Pragma("nounroll") for (int n = 0; n < 256; ++n) { const float v = cand[n]; if (v > bv) { bv = v; bi = n; } } cand[bi] = -3.0e38f;
                if (k == 0) top0 = bv; selv[k] = __expf((bv - top0) * rinv2); z += selv[k]; sele[k] = (I0[bi >> 4] & 0x7f) * 128 + (I1[bi & 15] & 0x7f); }
            _Pragma("nounroll") for (int k = 0; k < 16; ++k) { const int e = sele[k]; const float g = selv[k] / z; int found = -1;
                _Pragma("nounroll") for (int k2 = 0; k2 < 16; ++k2) if ((int)eid[(size_t)t * 128 + h * 16 + k2] == e) found = k2;
                if (found < 0) { if (g > 0.02f) ++miss; } else gerr = fmaxf(gerr, fabsf(gate[(size_t)t * 128 + h * 16 + found] - g)); }
            if (miss > 1 || gerr > 0.03f) bad |= 4; }
        bad = __builtin_amdgcn_readfirstlane(bad) | bad;
        if (bad) __hip_atomic_fetch_or(flags, (unsigned)bad, __ATOMIC_RELAXED, __HIP_MEMORY_SCOPE_AGENT);
        LDS_WAIT(); }
}
__device__ __forceinline__ void dbg_check_peer_out(const float* x2, const float* exp_out, gu32* flags, int gw, int ngw, int lane) {
    _Pragma("nounroll") for (int si = gw; si < DBG_NS; si += ngw) { const int t = (si * 509 + 17) % NTOK; float err = 0.f, mag = 0.f;
        _Pragma("nounroll") for (int k = lane; k < DMODEL; k += 64) { const float a = x2[(size_t)t * DMODEL + k], b = exp_out[(size_t)si * DMODEL + k]; err += (a - b) * (a - b); mag += b * b; }
        err = wave_sum(err); mag = wave_sum(mag);
        if (lane == 0 && !(err <= 1e-4f * mag)) __hip_atomic_fetch_or(flags, 0u, __ATOMIC_RELAXED, __HIP_MEMORY_SCOPE_AGENT); }
}
#endif
__device__ __forceinline__ void group_barrier(gu32* cnt, unsigned target) {
    asm volatile("s_waitcnt vmcnt(0)" ::: "memory");
    __syncthreads();
    if (threadIdx.x == 0) {
        __builtin_amdgcn_fence(__ATOMIC_RELEASE, "agent");
        asm volatile("s_waitcnt vmcnt(0)" ::: "memory");
        (void)__hip_atomic_fetch_add(cnt, 1u, __ATOMIC_RELAXED, __HIP_MEMORY_SCOPE_AGENT);
        unsigned sp = 0;
        while (__hip_atomic_load(cnt, __ATOMIC_RELAXED, __HIP_MEMORY_SCOPE_AGENT) < target) { __builtin_amdgcn_s_sleep(1); if (++sp > (1u << 22)) break; }
        __builtin_amdgcn_fence(__ATOMIC_ACQUIRE, "agent");
        asm volatile("s_waitcnt vmcnt(0)" ::: "memory");
    }
    __syncthreads();
}
constexpr int CW_GRP = 8192;
constexpr size_t BATCH_QKV = (size_t)SEQ * 2048;

#ifndef PH_MASK
#define PH_MASK 0xff
#endif
#define PH_ON(n) (((PH_MASK) >> (n)) & 1)
#ifndef TIME_MASK
#define TIME_MASK 0
#endif
#define TIME_ON(n) (((TIME_MASK) >> (n)) & 1)
#define PHASE_T0() const unsigned long long t0_ = TIME_MASK ? __builtin_amdgcn_s_memrealtime() : 0ull
#define PHASE_DELAY(n) do { if (TIME_ON(n)) { const unsigned long long t1_ = __builtin_amdgcn_s_memrealtime(); while (__builtin_amdgcn_s_memrealtime() - t1_ < t1_ - t0_) __builtin_amdgcn_s_sleep(16); } } while (0)
struct Args { const float* in[21]; float* out; unsigned char* ws; };
__global__ void __launch_bounds__(NWAVES * 64, 2) mk_fwd(Args args) {
    extern __shared__ __attribute__((aligned(16))) unsigned char lds[];
    LAS unsigned char* L = (LAS unsigned char*)lds;
    volatile LAS unsigned* MISC = (volatile LAS unsigned*)(L + MISC_OFF);
    const int tid = threadIdx.x;
    const int G = gridDim.x;
    unsigned char* ws = args.ws;
#define PHASE_CTX() int tid_ = threadIdx.x; asm volatile("" : "+v"(tid_)); const int lane = tid_ & 63, wave = __builtin_amdgcn_readfirstlane(tid_ >> 6); \
    int bx = blockIdx.x; asm volatile("" : "+s"(bx)); const int vcu = (G % 8 == 0) ? (bx % 8) * (G / 8) + bx / 8 : bx; const int gw = vcu * NWAVES + wave, ngw = G * NWAVES; \
    size_t zoff_ = 0; asm volatile("" : "+s"(zoff_)); unsigned char* ws = args.ws + zoff_; (void)lane; (void)gw; (void)ngw; (void)vcu; \
    bf16* const XBF = (bf16*)(ws + WS_XBF); bf16* const QK = (bf16*)(ws + WS_QK); bf16* const VX = (bf16*)(ws + WS_VX); bf16* const SB = (bf16*)(ws + WS_SB); \
    float* const RINV = (float*)(ws + WS_RINV); float* const SSQ = (float*)(ws + WS_SSQ); \
    unsigned short* const EID = (unsigned short*)(ws + WS_EID); float* const GATE = (float*)(ws + WS_GATE); \
    (void)XBF; (void)QK; (void)VX; (void)SB; (void)RINV; (void)SSQ; (void)EID; (void)GATE; \
    const int grp = bx & 7, grk = bx >> 3, gn = (G - grp + 7) >> 3, lw = grk * NWAVES + wave, nlw = gn * NWAVES; const size_t T0 = (size_t)grp * SEQ; (void)lw; (void)nlw; (void)T0; \
    bf16* const QKb = QK + (size_t)grp * BATCH_QKV; bf16* const VXb = QKb + (size_t)SEQ * 1024; (void)VXb;
    gu32* ctl = (gu32*)(ws + WS_CTL);
    for (int u = tid; u < (LDS_BYTES - LDSCTL_OFF) / 4; u += NWAVES * 64) ((LAS unsigned*)(L + LDSCTL_OFF))[u] = 0u;
    __syncthreads();
    XcdBarrier bar = xcd_barrier_post((unsigned*)(ctl + CW_BAR), MISC + 8);
#define GRID_BAR() xcd_barrier(bar)
    unsigned gb_epoch = 0u;

    if (PH_ON(0)) { PHASE_CTX(); PHASE_T0();
        LAS float* scr = (LAS float*)(L + RING_OFF + wave * 16384);
        constexpr int I_IN = (DMODEL / 64) * (IN_COLS / 32), I_OUT = (DMODEL / 64) * (DMODEL / 32), I_Q = (DMODEL / 64) * (2048 / 32);
        constexpr int NITEMS = DEPTH * (I_IN + I_OUT + I_Q);
        for (int it = gw; it < NITEMS; it += ngw) {
            const int l = it / (I_IN + I_OUT + I_Q); int r = it % (I_IN + I_OUT + I_Q);
            if (r < I_IN) { p0_transpose_item<1>(args.in[2] + (size_t)l * DMODEL * IN_COLS, args.in[1] + l * DMODEL, DMODEL, IN_COLS, (bf16*)(ws + WS_WIN) + (size_t)l * IN_COLS * DMODEL, scr, r, lane); continue; } r -= I_IN;
            if (r < I_OUT) { p0_transpose_item<0>(args.in[15] + (size_t)l * DMODEL * DMODEL, nullptr, DMODEL, DMODEL, (bf16*)(ws + WS_WOUT) + (size_t)l * DMODEL * DMODEL, scr, r, lane); continue; } r -= I_OUT;
            p0_transpose_item<0>(args.in[17] + (size_t)l * DMODEL * 2048, args.in[16] + l * DMODEL, DMODEL, 2048, (bf16*)(ws + WS_WQ) + (size_t)l * 2048 * DMODEL, scr, r, lane);
        }
        const int gtid = vcu * NWAVES * 64 + tid, ngt = G * NWAVES * 64;
        p0_convert(args.in[18], (bf16*)(ws + WS_KEYS), (size_t)DEPTH * 8 * 2 * 128 * 128, gtid, ngt);
        {
            f32x4 xv[4][4];
#pragma unroll 1
            for (int m = gw; m < NTOK; m += 4 * ngw) {
#pragma unroll
                for (int q = 0; q < 4; ++q) { const int mm = m + q * ngw < NTOK ? m + q * ngw : m; const GAS f32x4* xr = (const GAS f32x4*)(args.in[0] + (size_t)mm * DMODEL) + lane;
#pragma unroll
                    for (int j = 0; j < 4; ++j) xv[q][j] = __builtin_nontemporal_load(xr + 64 * j); }
#pragma unroll
                for (int q = 0; q < 4; ++q) if (m + q * ngw < NTOK) { const int mm = m + q * ngw; float sq = 0.f;
#pragma unroll
                    for (int j = 0; j < 4; ++j) sq += (xv[q][j].x * xv[q][j].x + xv[q][j].y * xv[q][j].y) + (xv[q][j].z * xv[q][j].z + xv[q][j].w * xv[q][j].w);
                    sq = wave_sum(sq);
                    GAS unsigned long long* o8 = (GAS unsigned long long*)(XBF + (size_t)mm * DMODEL) + lane;
#pragma unroll
                    for (int j = 0; j < 4; ++j) o8[64 * j] = (unsigned long long)pk2(xv[q][j].x, xv[q][j].y) | ((unsigned long long)pk2(xv[q][j].z, xv[q][j].w) << 32);
                    if (lane < 8) ((float*)(ws + WS_SSQX))[(size_t)mm * 8 + lane] = lane == 0 ? sq : 0.f; }
            }
        }
        PHASE_DELAY(0);
    }
    GRID_BAR();

    _Pragma("unroll") for (int l = 0; l < DEPTH; ++l) {
#define GROUP_BAR() do { ++gb_epoch; group_barrier((gu32*)(args.ws + WS_CTL) + CW_GRP + 64 * (blockIdx.x & 7), gb_epoch * (unsigned)((gridDim.x - (blockIdx.x & 7) + 7) >> 3)); } while (0)
        if (PH_ON(1)) { PHASE_CTX(); PHASE_T0();
            pg8::Gemm g{XBF + T0 * DMODEL, (const bf16*)(ws + WS_WIN) + (size_t)l * IN_COLS * DMODEL, SEQ, IN_COLS, DMODEL}; pg8::StaticOrder S; S.init(SEQ, IN_COLS, gn, grk);
            pg8::EpiIn E{QKb, VXb, SB + T0 * 256, (const float*)(ws + WS_SSQX) + T0 * 8, args.in[3] + l * 64, args.in[4] + l * 64};
            pg8::gemm_phase<pg8::EpiIn, pg8::StaticOrder, PG8_ALIGN, PG8_SP2>(L + RING_OFF, g, S, E);
            PHASE_DELAY(1);
        }
        GROUP_BAR();
        if (PH_ON(2)) { PHASE_CTX(); PHASE_T0();
            const float lam_init = 0.8f - 0.6f * __expf(-0.3f * (float)l);
            CmbArgs C{(const bf16*)(ws + WS_O) + T0 * 1024, VXb, SB + T0 * 256, (bf16*)(ws + WS_CAT) + T0 * 1024, args.in[5] + l * 64, args.in[6] + l * 64, args.in[7] + l * 64, args.in[8] + l * 64, args.in[9] + l * 128,
                      args.in[10] + l * 31 * 256, args.in[11] + l * 256, args.in[12] + l * 256, args.in[13] + l * 256, args.in[14] + l * 3 * 256, lam_init};
            cmb_conv_phase(C, lw, nlw, lane);
            const float lam = cmb_lambda(C, lane);
            for (int pr = grk; pr < 32; pr += gn) { const int h = pr >> 3, k = pr & 7;
                for (int i = 0; i < 2; ++i) { const int qb = i == 0 ? 15 - k : k;
                    for (int c = 0; c < 2; ++c) { const int hc = 2 * h + c;
                        const attn_body::bf16* Qb = (const attn_body::bf16*)QKb + hc * 64; const attn_body::bf16* Vb = (const attn_body::bf16*)VXb + h * 128; attn_body::bf16* Ob = (attn_body::bf16*)(ws + WS_O) + T0 * 1024 + (4 * h + 2 * c) * 64;
                        attn_body::attn_unit<8>(0, qb, Qb, Qb + 512, Vb, Ob, (char*)lds + RING_OFF); }
                    cmb_rows(C, lam, h, qb * 256 + wave * 32, lane); } }
            PHASE_DELAY(2);
        }
        GROUP_BAR();
        if (PH_ON(4)) { PHASE_CTX(); PHASE_T0();
            pg8::Gemm g{(const bf16*)(ws + WS_CAT) + T0 * 1024, (const bf16*)(ws + WS_WOUT) + (size_t)l * DMODEL * DMODEL, SEQ, DMODEL, DMODEL}; pg8::StaticOrder S; S.init(SEQ, DMODEL, gn, grk);
            pg8::EpiOut E{XBF + T0 * DMODEL, SSQ + T0 * 16};
            pg8::gemm_phase<pg8::EpiOut, pg8::StaticOrder, PG8_ALIGN, PG8_SP2>(L + RING_OFF, g, S, E);
            PHASE_DELAY(4);
        }
        GROUP_BAR();
        if (PH_ON(5)) { PHASE_CTX(); PHASE_T0();
            for (int m = lw; m < SEQ; m += nlw) xq_row(XBF + (T0 + m) * DMODEL, (signed char*)(ws + WS_XQ) + (T0 + m) * DMODEL, (float*)(ws + WS_XQS) + (T0 + m) * 4, lane);
            pg8::Gemm g{XBF + T0 * DMODEL, (const bf16*)(ws + WS_WQ) + (size_t)l * 2048 * DMODEL, SEQ, 2048, DMODEL}; pg8::StaticOrder S; S.init(SEQ, 2048, gn, grk);
            pg8::EpiBf16<0> E{QKb, 2048, nullptr, 0, 0, 1.f};
            pg8::gemm_phase<pg8::EpiBf16<0>, pg8::StaticOrder, PG8_ALIGN, PG8_SP2>(L + RING_OFF, g, S, E);
            PHASE_DELAY(5);
        }
        GROUP_BAR();
        if (PH_ON(6)) { PHASE_CTX(); PHASE_T0();
            TopkArgs K{QKb, (const bf16*)(ws + WS_KEYS) + (size_t)l * 8 * 2 * 128 * 128, SSQ + T0 * 16, EID + T0 * 128, GATE + T0 * 128, (unsigned short*)(ws + WS_EIDT) + T0 * 128
#ifdef DBG_CHECK
 , (float*)(ws + 71 * MiB), (int*)(ws + 71 * MiB + 512 * 1024)
#endif
 };
            const QuantJob J{args.in[19] + (size_t)l * NEXP * DMODEL, args.in[20] + (size_t)l * NEXP * DMODEL, args.in[16] + l * DMODEL, ws + WS_UT + (size_t)l * NEXP * DMODEL, ws + WS_VT + (size_t)l * NEXP * DMODEL,
                             (float*)(ws + WS_SU) + (size_t)l * NEXP * 4, (float*)(ws + WS_SV) + (size_t)l * NEXP * 4, gw, ngw};
            int qr_next = gw;
            if (gn >= 8) topk_phase(K, J, qr_next, L + RING_OFF, L + RING_OFF + 65536 + wave * 2048, grk & 7, grk >> 3, (gn - (grk & 7) + 7) >> 3, wave, tid_, lane);
            else for (int h = grk; h < 8; h += gn) topk_phase(K, J, qr_next, L + RING_OFF, L + RING_OFF + 65536 + wave * 2048, h, 0, 1, wave, tid_, lane);
            for (int r = qr_next; r < NEXP; r += ngw) { const size_t ro = (size_t)l * NEXP + r;
                p0_quant_row4(args.in[19] + ro * DMODEL, args.in[16] + l * DMODEL, ws + WS_UT + (size_t)l * NEXP * DMODEL, r, (float*)(ws + WS_SU) + (size_t)l * NEXP * 4, lane);
                p0_quant_row4(args.in[20] + ro * DMODEL, nullptr, ws + WS_VT + (size_t)l * NEXP * DMODEL, r, (float*)(ws + WS_SV) + (size_t)l * NEXP * 4, lane); }
            PHASE_DELAY(6);
        }
        GRID_BAR();
        if (PH_ON(7)) { PHASE_CTX(); PHASE_T0();
            for (int ch = lw; ch < SEQ / 16; ch += nlw) {
                int tl0 = ch * 16; asm volatile("" : "+s"(tl0));
                { PHASE_CTX(); PeerUArgs U{(const signed char*)(ws + WS_XQ), (const float*)(ws + WS_XQS), ws + WS_UT + (size_t)l * NEXP * DMODEL, (const unsigned short*)(ws + WS_EIDT), (float*)QKb};
                  peer_u_run(U, (int)T0 + tl0, tl0, lane); }
                asm volatile("s_waitcnt vmcnt(0)" ::: "memory");
                { PHASE_CTX(); PeerRArgs R{(const float*)QKb, SSQ, EID, GATE, (const float*)(ws + WS_SU) + (size_t)l * NEXP * 4, (const float*)(ws + WS_SV) + (size_t)l * NEXP * 4, (signed char*)(ws + WS_WT), (float*)(ws + WS_WSC)};
                  peer_r_run(R, (int)T0 + tl0, tl0, lane); }
                asm volatile("s_waitcnt vmcnt(0)" ::: "memory");
                { PHASE_CTX(); PeerVArgs V{l + 1 == DEPTH ? args.out : nullptr, ws + WS_VT + (size_t)l * NEXP * DMODEL, (const unsigned short*)(ws + WS_EIDT), (const signed char*)(ws + WS_WT), (const float*)(ws + WS_WSC), XBF, (float*)(ws + WS_SSQX)};
                  peer_v_run(V, (int)T0 + tl0, lane); }
            }
            PHASE_DELAY(7);
        }
        if (l + 1 < DEPTH) GROUP_BAR();
#ifdef DBG_CHECK
        if (l == 0) { PHASE_CTX(); dbg_check_peer_out(args.out, (const float*)(ws + 70 * MiB), (gu32*)(ws + WS_CTL) + DBG_FLAGS, gw, ngw, lane); }
#endif
    }
#ifdef DBG_CHECK
    GRID_BAR();
    { PHASE_CTX(); const unsigned fl = __hip_atomic_load((gu32*)(ws + WS_CTL) + DBG_FLAGS, __ATOMIC_RELAXED, __HIP_MEMORY_SCOPE_AGENT);
      if (fl) { const float mul = 1.0f + (float)fl; for (size_t i = (size_t)(gw * 64 + lane); i < (size_t)NTOK * DMODEL; i += (size_t)ngw * 64) args.out[i] *= mul; } }
#endif
}

extern "C" void kernel_launch(void* const* d_in, const int* in_sizes, int n_in, void* d_out, int out_size, void* d_ws, size_t ws_size, hipStream_t stream) {
    static int grid = 0;
    if (grid == 0) {
        if (n_in != 21 || out_size != NTOK * DMODEL || ws_size < WS_END) { fprintf(stderr, "kernel_launch: unexpected shapes (n_in %d, out %d, ws %zu); nothing launched\n", n_in, out_size, ws_size); grid = -1; return; }
        int dev = 0, cus = 0, per_cu = 0;
        if (hipGetDevice(&dev) != hipSuccess || hipDeviceGetAttribute(&cus, hipDeviceAttributeMultiprocessorCount, dev) != hipSuccess) { grid = -1; return; }
        if (hipFuncSetAttribute((const void*)mk_fwd, hipFuncAttributeMaxDynamicSharedMemorySize, LDS_BYTES) != hipSuccess) { fprintf(stderr, "kernel_launch: hipFuncSetAttribute failed\n"); grid = -1; return; }
        if (hipOccupancyMaxActiveBlocksPerMultiprocessor(&per_cu, (const void*)mk_fwd, NWAVES * 64, LDS_BYTES) != hipSuccess || per_cu < 1) fprintf(stderr, "kernel_launch: occupancy query says %d blocks per CU\n", per_cu);
        (void)hipGetLastError();
        grid = cus;
    }
    if (grid < 0) return;
    if (hipMemsetAsync((char*)d_ws + WS_CTL, 0, CTL_ZERO_BYTES, stream) != hipSuccess) { fprintf(stderr, "kernel_launch: memset failed\n"); return; }
    Args a{};
    for (int i = 0; i < 21; ++i) a.in[i] = (const float*)d_in[i];
    a.out = (float*)d_out; a.ws = (unsigned char*)d_ws;
    hipLaunchKernelGGL(mk_fwd, dim3(grid), dim3(NWAVES * 64), LDS_BYTES, stream, a);
}
```

```cpp
#include <hip/hip_runtime.h>
#include <cstdio>
#include <cstdint>
namespace pg8 {
#define PG8_LAS __attribute__((address_space(3)))
typedef unsigned short bf16_t;
typedef short bf16x8 __attribute__((ext_vector_type(8)));
typedef float f32x4 __attribute__((ext_vector_type(4)));
typedef unsigned u32x4 __attribute__((ext_vector_type(4)));
constexpr int BM = 256, BK = 64, HALF = 128, HTB = HALF * BK * 2  , STAGE_BYTES = 8 * HTB, NXCD = 8, WGM = 8;

__host__ __device__ __forceinline__ int lds_byte(int r, int c) { const int st = (r >> 4) * 2 + (c >> 5), rr = r & 15, cc = c & 31, ob = rr * 64 + cc * 2; return st * 1024 + (ob ^ (((ob >> 9) & 1) << 5)); }
__host__ __device__ __forceinline__ void stage_rc(int b, int& R, int& C) { const int st = b / 1024, sb = b % 1024, swz = sb ^ (((sb >> 9) & 1) << 5); R = (st >> 1) * 16 + swz / 64; C = (st & 1) * 32 + (swz % 64) / 2; }
__host__ __device__ __forceinline__ int perm32(int rho) { const int n = rho >> 4, i = rho & 15; return 8 * (i >> 2) + 4 * n + (i & 3); }

struct Unit { int pm, pn; };
struct Gemm { const bf16_t* A; const bf16_t* Bt; int M, N, K; };

struct StaticOrder {
    int nM, nN, nwg, G, c;
    __host__ __device__ void init(int M, int N, int G_, int c_) { nM = M / BM; nN = N / BM; nwg = nM * nN; G = G_; c = c_; }
    __host__ __device__ bool next(int i, Unit& u) const {
        const long L = (long)i * G + c; if (L >= nwg) return false;
        int wgid = (int)L; { const int q = nwg / NXCD, r = nwg % NXCD, xcd = wgid % NXCD, off = wgid / NXCD; wgid = (xcd < r ? xcd * (q + 1) : r * (q + 1) + (xcd - r) * q) + off; }
        const int nig = WGM * nN, gid = wgid / nig, fm = gid * WGM, gsz = (nM - fm) < WGM ? (nM - fm) : WGM;
        u.pm = fm + ((wgid % nig) % gsz); u.pn = (wgid % nig) / gsz; return true;
    }
    __device__ __forceinline__ void a_ready(const Unit&) const {}
    __device__ __forceinline__ void done(const Unit&) const {}
};

__device__ __forceinline__ unsigned cvt_pk_bf16(float lo, float hi) { unsigned r; asm volatile("v_cvt_pk_bf16_f32 %0, %1, %2" : "=v"(r) : "v"(lo), "v"(hi)); return r; }
typedef float f32x2 __attribute__((ext_vector_type(2)));
__device__ __forceinline__ f32x2 gelu_pk(f32x2 v) {
    const f32x2 av = __builtin_elementwise_abs(v), d = av * 0.2316418882f + 1.0f;
    f32x2 t; t.x = __builtin_amdgcn_rcpf(d.x); t.y = __builtin_amdgcn_rcpf(d.y);
    f32x2 q = t * 0.5307027145f + (-0.7265760135f); q = q * t + 0.7107068705f; q = q * t + (-0.142248368f); q = q * t + 0.127414796f; q = q * t;
    const f32x2 s = (v * v) * (-0.72134752044f);
    f32x2 e; e.x = __builtin_amdgcn_exp2f(s.x); e.y = __builtin_amdgcn_exp2f(s.y);
    const f32x2 m = v * (q * e), r = v - m;
    f32x2 o; o.x = v.x < 0.f ? m.x : r.x; o.y = v.y < 0.f ? m.y : r.y; return o;
}

template <int ACT  > struct EpiBf16 {
    static constexpr bool PERM = true, AFTER_DRAIN = false; static_assert(ACT == 0 || ACT == 1, "EpiBf16: ACT is 0 (none) or 1 (gelu_pk)");
    bf16_t* O; int ldc; const float* bias; int split_cols; size_t split_stride; float scale0;
    __device__ __forceinline__ void operator()(const f32x4 (&acc)[2][2][4][2], const Unit& u, int wr, int wc, int fr, int fq) const {
        const int row0 = u.pm * BM + wr * 64 + fr; int colt = u.pn * BM; bf16_t* base = O;
        float sc = 1.f; if (split_cols) { const int t = colt / split_cols; base += (size_t)t * split_stride; colt -= t * split_cols; if (t == 0) sc = scale0; }
        const int col0 = colt + wc * 32 + 8 * fq, bcol0 = u.pn * BM + wc * 32 + 8 * fq;
        f32x4 bv[2][2];
#pragma unroll
        for (int bj = 0; bj < 2; ++bj)
#pragma unroll
            for (int n = 0; n < 2; ++n) bv[bj][n] = bias ? *(const f32x4*)(bias + bcol0 + bj * HALF + 4 * n) : (f32x4){0.f, 0.f, 0.f, 0.f};
#pragma unroll
        for (int ai = 0; ai < 2; ++ai)
#pragma unroll
            for (int m = 0; m < 4; ++m) { bf16_t* rowp = base + (size_t)(row0 + ai * HALF + m * 16) * ldc + col0;
#pragma unroll
                for (int bj = 0; bj < 2; ++bj) { f32x4 v0 = acc[ai][bj][m][0] + bv[bj][0], v1 = acc[ai][bj][m][1] + bv[bj][1];
                    if (ACT == 1) { f32x2 a = gelu_pk((f32x2){v0[0], v0[1]}), b = gelu_pk((f32x2){v0[2], v0[3]}), c = gelu_pk((f32x2){v1[0], v1[1]}), d = gelu_pk((f32x2){v1[2], v1[3]});
                        v0 = (f32x4){a.x, a.y, b.x, b.y}; v1 = (f32x4){c.x, c.y, d.x, d.y}; }
                    v0 = v0 * sc; v1 = v1 * sc; u32x4 w; w.x = cvt_pk_bf16(v0[0], v0[1]); w.y = cvt_pk_bf16(v0[2], v0[3]); w.z = cvt_pk_bf16(v1[0], v1[1]); w.w = cvt_pk_bf16(v1[2], v1[3]);
                    *(u32x4*)(rowp + bj * HALF) = w; } }
    }
};
constexpr float QK_C2 = 0.125f * 1.4426950408889634f;
__device__ __forceinline__ u32x4 pack8(const f32x4& v0, const f32x4& v1) { u32x4 w; w.x = cvt_pk_bf16(v0[0], v0[1]); w.y = cvt_pk_bf16(v0[2], v0[3]); w.z = cvt_pk_bf16(v1[0], v1[1]); w.w = cvt_pk_bf16(v1[2], v1[3]); return w; }
struct EpiIn {
    static constexpr bool PERM = true, AFTER_DRAIN = false;
    bf16_t* QK; bf16_t* VX; bf16_t* SB; const float* ssqx; const float* qg; const float* kg;
    __device__ __forceinline__ float rinv_of(int row) const { const f32x4 a = *(const f32x4*)(ssqx + (size_t)row * 8), b = *(const f32x4*)(ssqx + (size_t)row * 8 + 4);
        return 1.0f / sqrtf((((a[0] + a[1]) + (a[2] + a[3])) + ((b[0] + b[1]) + (b[2] + b[3]))) * (1.0f / 1024.0f) + 1e-6f); }
    __device__ __forceinline__ void operator()(const f32x4 (&acc)[2][2][4][2], const Unit& u, int wr, int wc, int fr, int fq) const {
        const int pn = u.pn; const int row0 = u.pm * BM + wr * 64 + fr;
        if (pn < 4) {
            const float* g = pn < 2 ? qg : kg; const float sc = pn < 2 ? QK_C2 : 1.f;
            f32x4 gv[2][2];
#pragma unroll
            for (int bj = 0; bj < 2; ++bj)
#pragma unroll
                for (int n = 0; n < 2; ++n) gv[bj][n] = *(const f32x4*)(g + 32 * bj + 8 * fq + 4 * n) * sc;
            bf16_t* base = QK + 256 * pn + 64 * wc + 8 * fq;
#pragma unroll
            for (int ai = 0; ai < 2; ++ai)
#pragma unroll
                for (int m = 0; m < 4; ++m) { const int row = row0 + ai * HALF + m * 16; const float ri = rinv_of(row); float ss = 0.f;
#pragma unroll
                    for (int bj = 0; bj < 2; ++bj)
#pragma unroll
                        for (int n = 0; n < 2; ++n) { const f32x4 x = acc[ai][bj][m][n]; ss += (x[0] * x[0] + x[1] * x[1]) + (x[2] * x[2] + x[3] * x[3]); }
                    ss += __shfl_xor(ss, 16); ss += __shfl_xor(ss, 32);
                    const float rg = ri / sqrtf(ss * ri * ri * (1.0f / 64.0f) + 1e-6f);
#pragma unroll
                    for (int bj = 0; bj < 2; ++bj) { const f32x4 v0 = acc[ai][bj][m][0] * rg * gv[bj][0], v1 = acc[ai][bj][m][1] * rg * gv[bj][1];
                        *(u32x4*)(base + (size_t)row * 1024 + 32 * bj) = pack8(v0, v1); } }
        } else if (pn < 6) {
            bf16_t* base = VX + 256 * (pn - 4) + 32 * wc + 8 * fq;
#pragma unroll
            for (int ai = 0; ai < 2; ++ai)
#pragma unroll
                for (int m = 0; m < 4; ++m) { const int row = row0 + ai * HALF + m * 16; const float ri = rinv_of(row);
#pragma unroll
                    for (int bj = 0; bj < 2; ++bj) *(u32x4*)(base + (size_t)row * 1024 + HALF * bj) = pack8(acc[ai][bj][m][0] * ri, acc[ai][bj][m][1] * ri); }
        } else if (pn < 8) {
            bf16_t* base = VX + 512 + 128 * (pn - 6) + 32 * wc + 8 * fq;
#pragma unroll
            for (int ai = 0; ai < 2; ++ai)
#pragma unroll
                for (int m = 0; m < 4; ++m) { const int row = row0 + ai * HALF + m * 16; const float ri = rinv_of(row); f32x4 o[2];
#pragma unroll
                    for (int n = 0; n < 2; ++n) { const f32x4 a = acc[ai][0][m][n] * ri, gt = acc[ai][1][m][n] * ri;
#pragma unroll
                        for (int e = 0; e < 4; ++e) o[n][e] = a[e] / (1.0f + __expf(-gt[e])); }
                    *(u32x4*)(base + (size_t)row * 1024) = pack8(o[0], o[1]); }
        } else if (pn < 10) {
            bf16_t* base = VX + 768 + 128 * (pn - 8) + 32 * wc + 8 * fq;
#pragma unroll
            for (int ai = 0; ai < 2; ++ai)
#pragma unroll
                for (int m = 0; m < 4; ++m) { const int row = row0 + ai * HALF + m * 16; const float ri = rinv_of(row); const float r2 = ri * ri;
                    *(u32x4*)(base + (size_t)row * 1024) = pack8(acc[ai][0][m][0] * acc[ai][1][m][0] * r2, acc[ai][0][m][1] * acc[ai][1][m][1] * r2); }
        } else {
            bf16_t* base = SB + 32 * wc + 8 * fq;
#pragma unroll
            for (int ai = 0; ai < 2; ++ai)
#pragma unroll
                for (int m = 0; m < 4; ++m) { const int row = row0 + ai * HALF + m * 16; const float ri = rinv_of(row);
#pragma unroll
                    for (int bj = 0; bj < 2; ++bj) *(u32x4*)(base + (size_t)row * 256 + HALF * bj) = pack8(acc[ai][bj][m][0] * ri, acc[ai][bj][m][1] * ri); }
        }
    }
};
struct EpiOut {
    static constexpr bool PERM = true, AFTER_DRAIN = false;
    bf16_t* xb; float* ssq;
    __device__ __forceinline__ void operator()(const f32x4 (&acc)[2][2][4][2], const Unit& u, int wr, int wc, int fr, int fq) const {
        const int row0 = u.pm * BM + wr * 64 + fr; const int col0 = u.pn * BM + wc * 32 + 8 * fq;
#pragma unroll
        for (int ai = 0; ai < 2; ++ai)
#pragma unroll
            for (int m = 0; m < 4; ++m) { const int row = row0 + ai * HALF + m * 16; float ss = 0.f;
#pragma unroll
                for (int bj = 0; bj < 2; ++bj) { const size_t off = (size_t)row * 1024 + col0 + bj * HALF;
                    const u32x4 r = *(const u32x4*)(xb + off);
                    const f32x4 r0 = {__builtin_bit_cast(float, r.x << 16), __builtin_bit_cast(float, r.x & 0xffff0000u), __builtin_bit_cast(float, r.y << 16), __builtin_bit_cast(float, r.y & 0xffff0000u)};
                    const f32x4 r1 = {__builtin_bit_cast(float, r.z << 16), __builtin_bit_cast(float, r.z & 0xffff0000u), __builtin_bit_cast(float, r.w << 16), __builtin_bit_cast(float, r.w & 0xffff0000u)};
                    const u32x4 w = pack8(acc[ai][bj][m][0] + r0, acc[ai][bj][m][1] + r1);
                    *(u32x4*)(xb + off) = w;
                    const float a0 = __builtin_bit_cast(float, w.x << 16), a1 = __builtin_bit_cast(float, w.x & 0xffff0000u), a2 = __builtin_bit_cast(float, w.y << 16), a3 = __builtin_bit_cast(float, w.y & 0xffff0000u);
                    const float a4 = __builtin_bit_cast(float, w.z << 16), a5 = __builtin_bit_cast(float, w.z & 0xffff0000u), a6 = __builtin_bit_cast(float, w.w << 16), a7 = __builtin_bit_cast(float, w.w & 0xffff0000u);
                    ss += ((a0 * a0 + a1 * a1) + (a2 * a2 + a3 * a3)) + ((a4 * a4 + a5 * a5) + (a6 * a6 + a7 * a7)); }
                ss += __shfl_xor(ss, 16); ss += __shfl_xor(ss, 32);
                if (fq == 0) ssq[(size_t)row * 16 + u.pn * 4 + wc] = ss; }
    }
};

template <class Epi, class Sched, bool ALIGN_EPI = false, bool SP2 = false>
__device__ __forceinline__ void gemm_phase(PG8_LAS unsigned char* lds, const Gemm g, const Sched& S, const Epi& E) {
    int tid_l = threadIdx.x; asm volatile("" : "+v"(tid_l));
    const int tid = tid_l, wid = __builtin_amdgcn_readfirstlane(tid >> 6), lane = tid & 63, wr = wid >> 2, wc = wid & 3, fr = lane & 15, fq = lane >> 4;
    const int K = g.K, nt = K / BK;
    unsigned voffA[2], voffB[2];
#pragma unroll
    for (int i = 0; i < 2; ++i) { int R, C; stage_rc(tid * 16 + i * 8192, R, C); const int Rb = Epi::PERM ? ((R & ~31) + perm32(R & 31)) : R;
        voffA[i] = (unsigned)(R * K + C) * 2u; voffB[i] = (unsigned)(Rb * K + C) * 2u; }
    const size_t kstep = (size_t)(BK * 2);
    const size_t hstep = (size_t)HALF * K * 2;
    const size_t tstep = 2 * hstep;
    const unsigned ldsw = (unsigned)wid * 1024u;
    const int aoff = lds_byte(wr * 64 + fr, fq * 8), boff = lds_byte(wc * 32 + fr, fq * 8);
#define PG8_SA(b, h) (((b) * 2 + (h)) * HTB)
#define PG8_SB(b, h) ((4 + (b) * 2 + (h)) * HTB)
#define PG8_STAGE(bufoff, gbase, voff) do { _Pragma("unroll") for (int _i = 0; _i < 2; ++_i) \
        __builtin_amdgcn_global_load_lds((const unsigned*)((const char*)(gbase) + (voff)[_i]), (PG8_LAS unsigned*)(lds + (bufoff) + ldsw + _i * 8192), 16, 0, 0); } while (0)
#define PG8_LDA(dst, b, h) do { _Pragma("unroll") for (int m = 0; m < 4; ++m) _Pragma("unroll") for (int k = 0; k < 2; ++k) dst[m][k] = *(const PG8_LAS bf16x8*)(lds + PG8_SA(b, h) + aoff + m * 2048 + k * 1024); } while (0)
#define PG8_LDB(dst, b, h) do { _Pragma("unroll") for (int n = 0; n < 2; ++n) _Pragma("unroll") for (int k = 0; k < 2; ++k) dst[n][k] = *(const PG8_LAS bf16x8*)(lds + PG8_SB(b, h) + boff + n * 2048 + k * 1024); } while (0)
#define PG8_MMA(ai, bj, At, Bt) do { __builtin_amdgcn_s_setprio(1); _Pragma("unroll") for (int m = 0; m < 4; ++m) _Pragma("unroll") for (int n = 0; n < 2; ++n) _Pragma("unroll") for (int k = 0; k < 2; ++k) \
        acc[ai][bj][m][n] = __builtin_amdgcn_mfma_f32_16x16x32_bf16(Bt[n][k], At[m][k], acc[ai][bj][m][n], 0, 0, 0); __builtin_amdgcn_s_setprio(0); } while (0)
#define PG8_WAIT_V(n) asm volatile("s_waitcnt vmcnt(" #n ")" ::: "memory")
#define PG8_WAIT_L(n) asm volatile("s_waitcnt lgkmcnt(" #n ")" ::: "memory")
#define PG8_BAR __builtin_amdgcn_s_barrier()
#define PG8_SCHED __builtin_amdgcn_sched_barrier(0)
    Unit cur, nxt; int ui = 0;
    if (!S.next(0, cur)) return;
    f32x4 acc[2][2][4][2];
#pragma unroll
    for (int a = 0; a < 2; ++a)
#pragma unroll
        for (int b = 0; b < 2; ++b)
#pragma unroll
            for (int m = 0; m < 4; ++m)
#pragma unroll
                for (int n = 0; n < 2; ++n) acc[a][b][m][n] = (f32x4){0.f, 0.f, 0.f, 0.f};
    bf16x8 At[4][2], B0[2][2], B1[2][2];
    const char* cA = (const char*)g.A + (size_t)cur.pm * tstep; const char* cB = (const char*)g.Bt + (size_t)cur.pn * tstep;
    S.a_ready(cur);
    if constexpr (SP2) {
        PG8_STAGE(PG8_SB(0, 0), cB, voffB); PG8_STAGE(PG8_SB(0, 1), cB + hstep, voffB); PG8_STAGE(PG8_SA(0, 0), cA, voffA); PG8_STAGE(PG8_SA(0, 1), cA + hstep, voffA);
        if (wr == 1) PG8_BAR;
        PG8_WAIT_V(2); PG8_BAR;
        PG8_STAGE(PG8_SB(1, 0), cB + kstep, voffB); PG8_STAGE(PG8_SA(1, 0), cA + kstep, voffA); PG8_STAGE(PG8_SB(1, 1), cB + hstep + kstep, voffB);
        PG8_WAIT_V(6); PG8_BAR;
    } else {
        PG8_STAGE(PG8_SB(0, 0), cB, voffB); PG8_STAGE(PG8_SA(0, 0), cA, voffA); PG8_STAGE(PG8_SB(0, 1), cB + hstep, voffB); PG8_STAGE(PG8_SA(0, 1), cA + hstep, voffA);
        if (wr == 1) PG8_BAR;
        PG8_WAIT_V(4); PG8_BAR;
        PG8_STAGE(PG8_SB(1, 0), cB + kstep, voffB); PG8_STAGE(PG8_SA(1, 0), cA + kstep, voffA); PG8_STAGE(PG8_SB(1, 1), cB + hstep + kstep, voffB);
        PG8_WAIT_V(6); PG8_BAR;
    }
    for (;;) {
        const bool has_next = S.next(ui + 1, nxt);
        const char* nA = has_next ? (const char*)g.A + (size_t)nxt.pm * tstep : cA; const char* nB = has_next ? (const char*)g.Bt + (size_t)nxt.pn * tstep : cB;
        for (int t = 0; t < nt; t += 2) {
            const bool last = (t == nt - 2);
            const char* a1 = cA + (size_t)(t + 1) * kstep;
            const char* a2 = last ? nA : cA + (size_t)(t + 2) * kstep; const char* b2 = last ? nB : cB + (size_t)(t + 2) * kstep;
            const char* a3 = a2 + kstep; const char* b3 = b2 + kstep;
            if (last && has_next) S.a_ready(nxt);
            if constexpr (SP2) {
            PG8_LDB(B0, 0, 0); PG8_LDB(B1, 0, 1); PG8_SCHED; PG8_LDA(At, 0, 0); PG8_STAGE(PG8_SA(1, 1), a1 + hstep, voffA);
            PG8_WAIT_V(8); PG8_WAIT_L(0); PG8_BAR; PG8_MMA(0, 0, At, B0); PG8_MMA(0, 1, At, B1); PG8_BAR; PG8_SCHED;
            PG8_LDA(At, 0, 1); PG8_STAGE(PG8_SB(0, 0), b2, voffB); PG8_STAGE(PG8_SB(0, 1), b2 + hstep, voffB); PG8_STAGE(PG8_SA(0, 0), a2, voffA);
            PG8_WAIT_V(8); PG8_WAIT_L(0); PG8_BAR; PG8_MMA(1, 0, At, B0); PG8_MMA(1, 1, At, B1); PG8_BAR; PG8_SCHED;
            PG8_LDB(B0, 1, 0); PG8_LDB(B1, 1, 1); PG8_SCHED; PG8_LDA(At, 1, 0); PG8_STAGE(PG8_SA(0, 1), a2 + hstep, voffA);
            PG8_WAIT_V(8); PG8_WAIT_L(0); PG8_BAR; PG8_MMA(0, 0, At, B0); PG8_MMA(0, 1, At, B1); PG8_BAR; PG8_SCHED;
            PG8_LDA(At, 1, 1); PG8_STAGE(PG8_SB(1, 0), b3, voffB); PG8_STAGE(PG8_SB(1, 1), b3 + hstep, voffB); PG8_STAGE(PG8_SA(1, 0), a3, voffA);
            PG8_WAIT_V(8); PG8_WAIT_L(0); PG8_BAR; PG8_MMA(1, 0, At, B0); PG8_MMA(1, 1, At, B1); PG8_BAR; PG8_SCHED;
            } else {
            PG8_LDB(B0, 0, 0); PG8_SCHED; PG8_LDA(At, 0, 0); PG8_STAGE(PG8_SA(1, 1), a1 + hstep, voffA);
            PG8_WAIT_L(8); PG8_BAR; PG8_WAIT_L(0); PG8_MMA(0, 0, At, B0); PG8_BAR; PG8_SCHED;
            PG8_LDB(B1, 0, 1); PG8_STAGE(PG8_SB(0, 0), b2, voffB);
            PG8_BAR; PG8_WAIT_L(0); PG8_MMA(0, 1, At, B1); PG8_BAR;
            PG8_LDA(At, 0, 1); PG8_STAGE(PG8_SA(0, 0), a2, voffA);
            PG8_BAR; PG8_WAIT_L(0); PG8_MMA(1, 0, At, B0); PG8_BAR; PG8_SCHED;
            PG8_STAGE(PG8_SB(0, 1), b2 + hstep, voffB);
            PG8_WAIT_V(6); PG8_BAR; PG8_MMA(1, 1, At, B1); PG8_BAR;
            PG8_LDB(B0, 1, 0); PG8_SCHED; PG8_LDA(At, 1, 0); PG8_STAGE(PG8_SA(0, 1), a2 + hstep, voffA);
            PG8_WAIT_L(8); PG8_BAR; PG8_WAIT_L(0); PG8_MMA(0, 0, At, B0); PG8_BAR; PG8_SCHED;
            PG8_LDB(B1, 1, 1); PG8_STAGE(PG8_SB(1, 0), b3, voffB);
            PG8_BAR; PG8_WAIT_L(0); PG8_MMA(0, 1, At, B1); PG8_BAR;
            PG8_LDA(At, 1, 1); PG8_STAGE(PG8_SA(1, 0), a3, voffA);
            PG8_BAR; PG8_WAIT_L(0); PG8_MMA(1, 0, At, B0); PG8_BAR; PG8_SCHED;
            PG8_STAGE(PG8_SB(1, 1), b3 + hstep, voffB);
            PG8_WAIT_V(6); PG8_BAR; PG8_MMA(1, 1, At, B1); PG8_BAR;
            }
        }
        if constexpr (ALIGN_EPI) { if (wr == 0) PG8_BAR; }
        if constexpr (!Epi::AFTER_DRAIN) { E(acc, cur, wr, wc, fr, fq); S.done(cur); }
        if (!has_next) break;
#pragma unroll
        for (int a = 0; a < 2; ++a)
#pragma unroll
            for (int b = 0; b < 2; ++b)
#pragma unroll
                for (int m = 0; m < 4; ++m)
#pragma unroll
                    for (int n = 0; n < 2; ++n) acc[a][b][m][n] = (f32x4){0.f, 0.f, 0.f, 0.f};
        cur = nxt; cA = nA; cB = nB; ++ui;
        if constexpr (ALIGN_EPI) { if (wr == 1) PG8_BAR; }
    }
    PG8_WAIT_V(0);
    if constexpr (!ALIGN_EPI) { if (wr == 0) PG8_BAR; }
    PG8_BAR;
    if constexpr (Epi::AFTER_DRAIN) { E.fused(acc, cur, wr, wc, fr, fq, lds, wid, lane); S.done(cur); }
#undef PG8_SA
#undef PG8_SB
#undef PG8_STAGE
#undef PG8_LDA
#undef PG8_LDB
#undef PG8_MMA
#undef PG8_WAIT_V
#undef PG8_WAIT_L
#undef PG8_BAR
#undef PG8_SCHED
}
}
#define PG8_SP2 true
#define PG8_ALIGN true
#include <hip/hip_bf16.h>
#include <cmath>
namespace attn_body {
using bf16=__hip_bfloat16;
using bf16x8=__attribute__((ext_vector_type(8)))short;
using s16x4=__attribute__((ext_vector_type(4)))short;
using f32x16=__attribute__((ext_vector_type(16)))float;
using u32x4=__attribute__((ext_vector_type(4)))unsigned;
constexpr int BATCH=8,NHEAD=16,SEQ=4096,D=64,DM=NHEAD*D;
constexpr int NW=8,QBLK=32,QB=QBLK*NW,KVBLK=64,NQB=SEQ/QB;
constexpr int ATTN_PITCH=DM, ATTN_UNIT_ROWS=QB;
__device__ __forceinline__ int crow(int r,int hi){return (r&3)+8*(r>>2)+4*hi;}
#define SBAR() __builtin_amdgcn_sched_barrier(0)
__device__ __forceinline__ void cmask(f32x16&p0,f32x16&p1,int jb,int qrel,int hi){
  const float NEG=-INFINITY; int kb=64*jb+4*hi;
  #pragma unroll
  for(int r=0;r<16;++r){int kv=kb+(r&3)+8*(r>>2); if(kv>qrel)p0[r]=NEG; if(kv+32>qrel)p1[r]=NEG;}
}

constexpr int NSLOT=3, SLOTB=8192, VSLOTB=16384;
constexpr int LDS_K=0, LDS_V=NSLOT*SLOTB, LDS_WS=LDS_V+NSLOT*VSLOTB, LDS_OST=LDS_WS+NW*64*4, LDS_BYTES=LDS_OST+NW*4096;
constexpr float C2=0.125f*1.4426950408889634f;
__device__ __forceinline__ void glds16(const void*gsrc,unsigned lds_dst){unsigned keep;
  asm volatile("s_mov_b32 %0, m0\n\ts_mov_b32 m0, %2\n\ts_nop 0\n\tglobal_load_lds_dwordx4 %1, off\n\ts_mov_b32 m0, %0":"=&s"(keep):"v"(gsrc),"s"(lds_dst):"memory");}
__device__ __forceinline__ float max3f(float a,float b,float c){float r;asm("v_max3_f32 %0, %1, %2, %3":"=v"(r):"v"(a),"v"(b),"v"(c));return r;}
__device__ __forceinline__ float max2f(float a,float b){float r;asm("v_max_f32_e32 %0, %1, %2":"=v"(r):"v"(a),"v"(b));return r;}
__device__ __forceinline__ float fadd_s(float a,float b){float r;asm("v_add_f32_e32 %0, %1, %2":"=v"(r):"v"(a),"v"(b));return r;}
__device__ __forceinline__ float fsub_s(float a,float b){float r;asm("v_sub_f32_e32 %0, %1, %2":"=v"(r):"v"(a),"v"(b));return r;}
typedef float f32x2_t __attribute__((ext_vector_type(2))); typedef __bf16 bf16x2_t __attribute__((ext_vector_type(2)));
__device__ __forceinline__ unsigned cvtpk_s(float lo,float hi){f32x2_t v={lo,hi};bf16x2_t b=__builtin_convertvector(v,bf16x2_t);return __builtin_bit_cast(unsigned,b);}
#define WAIT_BAR(N) asm volatile("s_waitcnt vmcnt(" #N ") lgkmcnt(0)\n\ts_barrier":::"memory")

__device__ __forceinline__ void qkt(f32x16&p0,f32x16&p1,const char*Kslot,const bf16x8*qr,const f32x16&negm,int r32,int hi){
  const char*kb=Kslot+hi*1024+r32*16;
  #pragma unroll
  for(int d0=0;d0<4;++d0){
    const bf16x8 b0=*reinterpret_cast<const bf16x8*>(kb+d0*2048);
    const bf16x8 b1=*reinterpret_cast<const bf16x8*>(kb+d0*2048+512);
    if(d0==0){p0=__builtin_amdgcn_mfma_f32_32x32x16_bf16(b0,qr[0],negm,0,0,0);p1=__builtin_amdgcn_mfma_f32_32x32x16_bf16(b1,qr[0],negm,0,0,0);}
    else{p0=__builtin_amdgcn_mfma_f32_32x32x16_bf16(b0,qr[d0],p0,0,0,0);p1=__builtin_amdgcn_mfma_f32_32x32x16_bf16(b1,qr[d0],p1,0,0,0);}}
}
typedef __attribute__((address_space(3))) const char* lds_cptr;
typedef short v4i16_t __attribute__((ext_vector_type(4)));
__device__ __forceinline__ void kload8(bf16x8*kf,lds_cptr kp){
  kf[0]=*(const __attribute__((address_space(3))) bf16x8*)(kp);      kf[1]=*(const __attribute__((address_space(3))) bf16x8*)(kp+512);
  kf[2]=*(const __attribute__((address_space(3))) bf16x8*)(kp+2048); kf[3]=*(const __attribute__((address_space(3))) bf16x8*)(kp+2560);
  kf[4]=*(const __attribute__((address_space(3))) bf16x8*)(kp+4096); kf[5]=*(const __attribute__((address_space(3))) bf16x8*)(kp+4608);
  kf[6]=*(const __attribute__((address_space(3))) bf16x8*)(kp+6144); kf[7]=*(const __attribute__((address_space(3))) bf16x8*)(kp+6656);
}
__device__ __forceinline__ void kload2(bf16x8*kf,lds_cptr kp,int j){ kf[2*j]=*(const __attribute__((address_space(3))) bf16x8*)(kp+j*2048); kf[2*j+1]=*(const __attribute__((address_space(3))) bf16x8*)(kp+j*2048+512); }
__device__ __forceinline__ s16x4 vtr(lds_cptr p){ return __builtin_bit_cast(s16x4,__builtin_amdgcn_ds_read_tr16_b64_v4i16((__attribute__((address_space(3))) v4i16_t*)p)); }
__device__ __forceinline__ float rowmax(const f32x16&p0,const f32x16&p1){
  float a=max3f(p0[0],p0[1],p1[0]),b=max3f(p0[2],p0[3],p1[1]);a=max3f(a,p1[2],p1[3]);
  #pragma unroll
  for(int r=4;r<16;r+=4){a=max3f(a,p0[r],p0[r+1]);b=max3f(b,p0[r+2],p0[r+3]);a=max3f(a,p1[r],p1[r+1]);b=max3f(b,p1[r+2],p1[r+3]);}
  const float m=max2f(a,b);
  auto rr=__builtin_amdgcn_permlane32_swap(__float_as_uint(m),__float_as_uint(m),false,false);
  return max2f(__uint_as_float(rr[0]),__uint_as_float(rr[1]));
}
__device__ __forceinline__ void pv(f32x16*o,int vb,bf16x8 pa0,bf16x8 pa1,bf16x8 pa2,bf16x8 pa3){
  #pragma unroll
  for(int d0=0;d0<4;++d0){s16x4 lo[4],hi[4];
    #pragma unroll
    for(int ks=0;ks<4;++ks){
      asm volatile("ds_read_b64_tr_b16 %0,%1 offset:%c2":"=&v"(lo[ks]):"v"(vb),"i"((d0>>1)*8192+(d0&1)*4096+ks*1024):"memory");
      asm volatile("ds_read_b64_tr_b16 %0,%1 offset:%c2":"=&v"(hi[ks]):"v"(vb),"i"((d0>>1)*8192+(d0&1)*4096+ks*1024+512):"memory");}
    asm volatile("s_waitcnt lgkmcnt(0)":::"memory");SBAR();
    #define PK(k) (bf16x8){lo[k][0],lo[k][1],lo[k][2],lo[k][3],hi[k][0],hi[k][1],hi[k][2],hi[k][3]}
    o[d0]=__builtin_amdgcn_mfma_f32_32x32x16_bf16(pa0,PK(0),o[d0],0,0,0);
    o[d0]=__builtin_amdgcn_mfma_f32_32x32x16_bf16(pa1,PK(1),o[d0],0,0,0);
    o[d0]=__builtin_amdgcn_mfma_f32_32x32x16_bf16(pa2,PK(2),o[d0],0,0,0);
    o[d0]=__builtin_amdgcn_mfma_f32_32x32x16_bf16(pa3,PK(3),o[d0],0,0,0);
    #undef PK
  }
}

#ifndef ATTN_STORE16
#define ATTN_STORE16(p,v) (*(u32x4*)(p)=(v))
#endif
template<int THRL> __device__ __forceinline__ void attn_unit(int b,int qb,const bf16*Q,const bf16*__restrict__ K,const bf16*__restrict__ V,bf16*O,char*shm){
  int tid_l=threadIdx.x; asm volatile("":"+v"(tid_l)); const int tid=tid_l,lane=tid&63,r32=lane&31,hi=lane>>5; const int wid=__builtin_amdgcn_readfirstlane(tid>>6);
  const long rowbase=(long)b*SEQ; const int q0=qb*QB; const lds_cptr shm3q=(lds_cptr)shm;
  const bf16*Qw=Q+(rowbase+q0+wid*QBLK)*DM;
  const bf16*Kh=K+rowbase*DM,*Vh=V+rowbase*DM;
  const unsigned lds0=(unsigned)(uintptr_t)shm;
  float*wsf=(float*)(shm+LDS_WS)+wid*64;
  const bf16*ksrc=Kh+(long)lane*DM+wid*8;
  const bf16*vsrc=Vh+(long)(16*(wid&3)+(lane>>2))*DM+(wid>>2)*32+(lane&3)*8;
  const unsigned kdst=lds0+LDS_K+wid*1024, vdst=lds0+LDS_V+wid*1024;
  #define DMA_K(t,slot) glds16(ksrc+(long)(t)*KVBLK*DM,(unsigned)__builtin_amdgcn_readfirstlane(kdst+(slot)))
  #define DMA_V(t,slot) do{ glds16(vsrc+(long)(t)*KVBLK*DM,(unsigned)__builtin_amdgcn_readfirstlane(vdst+2*(slot))); glds16(vsrc+64+(long)(t)*KVBLK*DM,(unsigned)__builtin_amdgcn_readfirstlane(vdst+2*(slot)+8192)); }while(0)
  const int vb0=(int)(lds0+LDS_V)+((lane>>4)&1)*32+(lane&3)*8+(4*hi+((lane&15)>>2))*64;
  const char*Kbase=shm+LDS_K; bf16x8 kf[8];
  const lds_cptr shm3=(lds_cptr)shm; const lds_cptr kp0=shm3+LDS_K+hi*1024+r32*16; const lds_cptr vp0=shm3+LDS_V+((lane>>4)&1)*32+(lane&3)*8+(4*hi+((lane&15)>>2))*64;
  const int NT=(q0+QB)/KVBLK;
  DMA_K(0,0);DMA_V(0,0);DMA_K(1,SLOTB);
  bf16x8 qr[4];
  #pragma unroll
  for(int d0=0;d0<4;++d0)qr[d0]=*reinterpret_cast<const bf16x8*>(&Qw[(long)r32*DM+d0*16+hi*8]);
  const lds_cptr qst3=shm3q+LDS_OST+wid*4096+lane*16;
  #define LDQ(d0) (*(const __attribute__((address_space(3))) bf16x8*)(qst3+(d0)*1024))
  float mhat=0.f,l_reg=0.f;f32x16 o[4];o[0]=f32x16{};o[1]=f32x16{};o[2]=f32x16{};o[3]=f32x16{};f32x16 negm=f32x16{};asm volatile("":"+v"(negm));
  const int qrel=wid*QBLK+r32;
  #define CMASK(P0,P1,t) do{int jb_=(t)-(NT-4); if(jb_>=0)cmask(P0,P1,jb_,qrel,hi);}while(0)
  bool resc=false;
  #define START(P0,P1) do{ const float rm=rowmax(P0,P1); resc=false; \
    { const float dl=rm; mhat=fadd_s(mhat,dl); \
      _Pragma("unroll") for(int r=0;r<16;++r){P0[r]=fsub_s(P0[r],dl);P1[r]=fsub_s(P1[r],dl);} \
      _Pragma("unroll") for(int r=0;r<16;++r)negm[r]=-mhat; asm volatile("":"+v"(negm)); } \
    _Pragma("unroll") for(int r=0;r<16;++r)P0[r]=__builtin_amdgcn_exp2f(P0[r]); }while(0)
  #define RESC() do{ if(resc){ asm volatile("s_waitcnt lgkmcnt(0)":::"memory"); \
      _Pragma("unroll") for(int d_=0;d_<4;++d_) _Pragma("unroll") for(int r=0;r<16;++r)o[d_][r]*=wsf[crow(r,hi)]; } }while(0)
  f32x16 pA0,pA1,pB0,pB1;
  int sl_prev=0,sl_cur=0,sl_next=SLOTB;
  #define ROT() do{sl_prev=sl_cur;sl_cur=sl_next;sl_next=(sl_next==(NSLOT-1)*SLOTB)?0:sl_next+SLOTB;}while(0)
  DMA_K(2,2*SLOTB);
  WAIT_BAR(3);
  qkt(pA0,pA1,Kbase,qr,negm,r32,hi);
  _Pragma("unroll") for(int d0=0;d0<4;++d0)*(__attribute__((address_space(3))) bf16x8*)(qst3+d0*1024)=qr[d0];
asm volatile("s_nop 15\n\ts_nop 7":"+v"(pA0),"+v"(pA1));CMASK(pA0,pA1,0);
  START(pA0,pA1);
  _Pragma("unroll") for(int r=0;r<16;++r)pA1[r]=__builtin_amdgcn_exp2f(pA1[r]);
  WAIT_BAR(0);
  DMA_K(3,0);DMA_V(1,SLOTB);
  ROT();
  kload8(kf,kp0+sl_cur);
  WAIT_BAR(3);
  s16x4 f0lo,f0hi,f1lo,f1hi,f2lo,f2hi,f3lo,f3hi; u32x4 pw0,pw1,pw2,pw3;
  #define PKW(P,B) cvtpk_s(P[B],P[B+1])
  #define PAF(k) __builtin_bit_cast(bf16x8,pw##k)
  #define VF(S) (bf16x8){S##lo[0],S##lo[1],S##lo[2],S##lo[3],S##hi[0],S##hi[1],S##hi[2],S##hi[3]}
  #define FOFF(i) (((i)>>2)*4096+((i)&3)*1024)
  #define VLD(S,off) do{ S##lo=vtr(vp_+(off)); S##hi=vtr(vp_+(off)+512); }while(0)
  #define PIN(x) asm volatile("":"+v"(x))
  #define MX3(a,b,c) __builtin_fmaxf(__builtin_fmaxf((a),(b)),(c))
  #define GAPA(MF,A0,A1,A2,A3,W0,W1,PW) do{ MF; sacc+=A0; sacc+=A1; sacc+=A2; sacc+=A3; PIN(sacc); W0; W1; PIN(PW); SBAR(); }while(0)
  #define EX(v) __builtin_amdgcn_exp2f(v)
  #define GAPB(MF,X,B) do{ MF; X[B]=EX(X[B]); X[B+1]=EX(X[B+1]); X[B+2]=EX(X[B+2]); X[B+3]=EX(X[B+3]); PIN(X); SBAR(); }while(0)
  #define GAPB2(MF,X,B) do{ MF; X[B]=EX(X[B]); X[B+1]=EX(X[B+1]); PIN(X); SBAR(); }while(0)
  #define KRD(G,j) do{ if(G){ kload2(kf,kp0+sl_next,j); SBAR(); } }while(0)
  #define STEP(C0,C1,P0,P1,t,GK,GV,GL) do{ SBAR(); \
    const lds_cptr vp_=vp0+2*sl_prev; \
    bf16x8 q_=LDQ(0); VLD(f0,FOFF(0)); SBAR(); float sacc=(P0[0]+P0[1]); \
    GAPA(C0=__builtin_amdgcn_mfma_f32_32x32x16_bf16(kf[0],q_,negm,0,0,0), P0[2],P0[3],P0[4],P0[5],     pw0[0]=PKW(P0,0), pw0[1]=PKW(P0,2), pw0); \
    VLD(f1,FOFF(4)); SBAR(); GAPA(C1=__builtin_amdgcn_mfma_f32_32x32x16_bf16(kf[1],q_,negm,0,0,0), P0[6],P0[7],P0[8],P0[9],     pw0[2]=PKW(P0,4), pw0[3]=PKW(P0,6), pw0); \
    q_=LDQ(1); VLD(f2,FOFF(1)); SBAR(); GAPA(C0=__builtin_amdgcn_mfma_f32_32x32x16_bf16(kf[2],q_,C0,0,0,0),   P0[10],P0[11],P0[12],P0[13], pw1[0]=PKW(P0,8), pw1[1]=PKW(P0,10), pw1); \
    VLD(f3,FOFF(5)); SBAR(); GAPA(C1=__builtin_amdgcn_mfma_f32_32x32x16_bf16(kf[3],q_,C1,0,0,0),   P0[14],P0[15],P1[0],P1[1],   pw1[2]=PKW(P0,12),pw1[3]=PKW(P0,14), pw1); \
    q_=LDQ(2); SBAR(); GAPA(C0=__builtin_amdgcn_mfma_f32_32x32x16_bf16(kf[4],q_,C0,0,0,0),   P1[2],P1[3],P1[4],P1[5],     pw2[0]=PKW(P1,0), pw2[1]=PKW(P1,2), pw2); \
    GAPA(C1=__builtin_amdgcn_mfma_f32_32x32x16_bf16(kf[5],q_,C1,0,0,0),   P1[6],P1[7],P1[8],P1[9],     pw2[2]=PKW(P1,4), pw2[3]=PKW(P1,6), pw2); \
    q_=LDQ(3); SBAR(); GAPA(C0=__builtin_amdgcn_mfma_f32_32x32x16_bf16(kf[6],q_,C0,0,0,0),   P1[10],P1[11],P1[12],P1[13], pw3[0]=PKW(P1,8), pw3[1]=PKW(P1,10), pw3); \
    GAPA(C1=__builtin_amdgcn_mfma_f32_32x32x16_bf16(kf[7],q_,C1,0,0,0),   P1[14],P1[15],0.f,0.f,       pw3[2]=PKW(P1,12),pw3[3]=PKW(P1,14), pw3); \
    l_reg+=sacc; \
    if(GK){DMA_K((t)+3,sl_cur);} if(GV){DMA_V((t)+1,sl_next);} \
    CMASK(C0,C1,t); \
    { float a=MX3(C0[0],C0[1],C1[0]),b=MX3(C0[2],C0[3],C1[1]); a=MX3(a,C1[2],C1[3]); \
      _Pragma("unroll") for(int r=4;r<16;r+=4){a=MX3(a,C0[r],C0[r+1]);b=MX3(b,C0[r+2],C0[r+3]);a=MX3(a,C1[r],C1[r+1]);b=MX3(b,C1[r+2],C1[r+3]);} \
      float rm=__builtin_fmaxf(a,b); { auto rr=__builtin_amdgcn_permlane32_swap(__float_as_uint(rm),__float_as_uint(rm),false,false); rm=__builtin_fmaxf(__uint_as_float(rr[0]),__uint_as_float(rr[1])); } \
      resc=false; \
      if(__builtin_expect(__any(rm>(float)THRL),0)){ const float dl=__builtin_fmaxf(rm,0.f); mhat+=dl; \
        _Pragma("unroll") for(int r=0;r<16;++r){C0[r]-=dl;C1[r]-=dl;} \
        _Pragma("unroll") for(int r=0;r<16;++r)negm[r]=-mhat; asm volatile("":"+v"(negm)); \
        const float f=__builtin_amdgcn_exp2f(-dl); l_reg*=f; if(hi==0)wsf[r32]=f; resc=true; } } \
    SBAR(); \
      \
    GAPB2(o[0]=__builtin_amdgcn_mfma_f32_32x32x16_bf16(PAF(0),VF(f0),o[0],0,0,0), C0,0);  VLD(f0,FOFF(2)); SBAR(); \
    GAPB2(o[1]=__builtin_amdgcn_mfma_f32_32x32x16_bf16(PAF(0),VF(f1),o[1],0,0,0), C0,2);  VLD(f1,FOFF(6)); SBAR(); \
    KRD(GL,0); GAPB2(o[0]=__builtin_amdgcn_mfma_f32_32x32x16_bf16(PAF(1),VF(f2),o[0],0,0,0), C0,4);  VLD(f2,FOFF(3)); SBAR(); \
    KRD(GL,1); GAPB2(o[1]=__builtin_amdgcn_mfma_f32_32x32x16_bf16(PAF(1),VF(f3),o[1],0,0,0), C0,6);  VLD(f3,FOFF(7)); SBAR(); \
    KRD(GL,2); GAPB2(o[0]=__builtin_amdgcn_mfma_f32_32x32x16_bf16(PAF(2),VF(f0),o[0],0,0,0), C0,8);  VLD(f0,8192+FOFF(0)); SBAR(); \
    KRD(GL,3); GAPB2(o[1]=__builtin_amdgcn_mfma_f32_32x32x16_bf16(PAF(2),VF(f1),o[1],0,0,0), C0,10); VLD(f1,8192+FOFF(4)); SBAR(); \
    GAPB2(o[0]=__builtin_amdgcn_mfma_f32_32x32x16_bf16(PAF(3),VF(f2),o[0],0,0,0), C0,12); VLD(f2,8192+FOFF(1)); SBAR(); \
    GAPB2(o[1]=__builtin_amdgcn_mfma_f32_32x32x16_bf16(PAF(3),VF(f3),o[1],0,0,0), C0,14); VLD(f3,8192+FOFF(5)); SBAR(); \
    GAPB2(o[2]=__builtin_amdgcn_mfma_f32_32x32x16_bf16(PAF(0),VF(f0),o[2],0,0,0), C1,0);  VLD(f0,8192+FOFF(2)); SBAR(); \
    GAPB2(o[3]=__builtin_amdgcn_mfma_f32_32x32x16_bf16(PAF(0),VF(f1),o[3],0,0,0), C1,2);  VLD(f1,8192+FOFF(6)); SBAR(); \
    GAPB2(o[2]=__builtin_amdgcn_mfma_f32_32x32x16_bf16(PAF(1),VF(f2),o[2],0,0,0), C1,4);  VLD(f2,8192+FOFF(3)); SBAR(); \
    GAPB2(o[3]=__builtin_amdgcn_mfma_f32_32x32x16_bf16(PAF(1),VF(f3),o[3],0,0,0), C1,6);  VLD(f3,8192+FOFF(7)); SBAR(); \
    GAPB2(o[2]=__builtin_amdgcn_mfma_f32_32x32x16_bf16(PAF(2),VF(f0),o[2],0,0,0), C1,8); \
    GAPB2(o[3]=__builtin_amdgcn_mfma_f32_32x32x16_bf16(PAF(2),VF(f1),o[3],0,0,0), C1,10); \
    GAPB2(o[2]=__builtin_amdgcn_mfma_f32_32x32x16_bf16(PAF(3),VF(f2),o[2],0,0,0), C1,12); \
    GAPB2(o[3]=__builtin_amdgcn_mfma_f32_32x32x16_bf16(PAF(3),VF(f3),o[3],0,0,0), C1,14); \
    }while(0)
  int t=1;
  #undef CMASK
  #define CMASK(P0,P1,t) do{}while(0)
  for(;t+5<NT;t+=2){
    STEP(pB0,pB1,pA0,pA1,t,true,true,true);     WAIT_BAR(3); RESC(); ROT();
    STEP(pA0,pA1,pB0,pB1,t+1,true,true,true);   WAIT_BAR(3); RESC(); ROT();
  }
  #undef CMASK
  #define CMASK(P0,P1,t) do{int jb_=(t)-(NT-4); if(jb_>=0)cmask(P0,P1,jb_,qrel,hi);}while(0)
  #define ENDW(tt) do{ if((tt)+3<NT){WAIT_BAR(3);} else if((tt)+2<NT){WAIT_BAR(2);} else {WAIT_BAR(0);} }while(0)
  for(;t+1<NT;t+=2){
    STEP(pB0,pB1,pA0,pA1,t,(t+3<NT),(t+1<NT),(t+1<NT));       ENDW(t);   RESC(); ROT();
    STEP(pA0,pA1,pB0,pB1,t+1,(t+4<NT),(t+2<NT),(t+2<NT));     ENDW(t+1); RESC(); ROT();
  }
  STEP(pB0,pB1,pA0,pA1,NT-1,false,false,false); RESC();
  { float sacc=pB0[0]+pB0[1]; _Pragma("unroll") for(int r=2;r<16;++r)sacc+=pB0[r]; _Pragma("unroll") for(int r=0;r<16;++r)sacc+=pB1[r]; l_reg+=sacc;
    pw0=(u32x4){PKW(pB0,0),PKW(pB0,2),PKW(pB0,4),PKW(pB0,6)};pw1=(u32x4){PKW(pB0,8),PKW(pB0,10),PKW(pB0,12),PKW(pB0,14)};pw2=(u32x4){PKW(pB1,0),PKW(pB1,2),PKW(pB1,4),PKW(pB1,6)};pw3=(u32x4){PKW(pB1,8),PKW(pB1,10),PKW(pB1,12),PKW(pB1,14)};
    SBAR(); pv(o,vb0+2*sl_cur,PAF(0),PAF(1),PAF(2),PAF(3)); }
  #undef PKW
  #undef PAF
  #undef VF
  #undef FOFF
  #undef VLD
  #undef LDQ
  #undef PIN
  #undef MX3
  #undef GAPA
  #undef GAPB
  #undef EX
  #undef GAPB2
  #undef KRD
  #undef STEP
  #undef ENDW
  {auto rr=__builtin_amdgcn_permlane32_swap(__float_as_uint(l_reg),__float_as_uint(l_reg),false,false);l_reg=__uint_as_float(rr[0])+__uint_as_float(rr[1]);}
  if(hi==0)wsf[32+r32]=l_reg;asm volatile("s_waitcnt lgkmcnt(0)":::"memory");
  float rli[16];
  #pragma unroll
  for(int r=0;r<16;++r)rli[r]=__builtin_amdgcn_rcpf(wsf[32+crow(r,hi)]);
  bf16*Ow=O+(rowbase+q0+wid*QBLK)*DM;
  { bf16*stg=(bf16*)(shm+LDS_OST)+wid*2048;
    #pragma unroll
    for(int h2=0;h2<2;++h2){
      #pragma unroll
      for(int r=0;r<16;++r){const int orow=crow(r,hi);
        #pragma unroll
        for(int d0=0;d0<2;++d0)stg[orow*64+d0*32+r32]=__float2bfloat16(o[2*h2+d0][r]*rli[r]);}
      asm volatile("s_waitcnt lgkmcnt(0)":::"memory");
      #pragma unroll
      for(int i=0;i<4;++i){const int row=i*8+(lane>>3),ch=lane&7; const u32x4 v=*(const u32x4*)(stg+row*64+ch*8); ATTN_STORE16(Ow+(long)row*DM+h2*64+ch*8,v);}
      asm volatile("s_waitcnt lgkmcnt(0)":::"memory"); } }
  asm volatile("s_waitcnt lgkmcnt(0)\n\ts_barrier":::"memory");
  #undef DMA_K
  #undef DMA_V
  #undef CMASK
  #undef START
  #undef RESC
  #undef ROT
}
constexpr int ATTN_LDS_BYTES=LDS_BYTES;
#undef SBAR
#undef WAIT_BAR
}
#define GAS __attribute__((address_space(1)))
#define LAS __attribute__((address_space(3)))
typedef unsigned short bf16;
typedef unsigned v4u __attribute__((ext_vector_type(4)));
typedef float f32x4 __attribute__((ext_vector_type(4)));
typedef short bf16x8 __attribute__((ext_vector_type(8)));
typedef GAS unsigned gu32;
typedef GAS unsigned long long gu64;
#define RLX_AGENT __ATOMIC_RELAXED, __HIP_MEMORY_SCOPE_AGENT
#define LDS_WAIT() asm volatile("s_waitcnt lgkmcnt(0)" ::: "memory")
#define VM_WAIT() asm volatile("s_waitcnt vmcnt(0)" ::: "memory")
__device__ __forceinline__ unsigned long long rt() { return __builtin_amdgcn_s_memrealtime(); }
__device__ __forceinline__ unsigned f2bf(float f) { unsigned u = __builtin_bit_cast(unsigned, f); return (u + 0x7fffu + ((u >> 16) & 1u)) >> 16; }
__device__ __forceinline__ unsigned pk2(float lo, float hi) { return f2bf(lo) | (f2bf(hi) << 16); }

#define XB_TMO      128
#define XB_XCNT(j)  (256  + 64 * (j))
#define XB_XSUB(j)  (1280 + 64 * (j))
#define XB_XGEN(j)  (2304 + 64 * (j))
#define XB_TOP      3328
#define XB_TOPGEN   3392
#define XCD_BAR_WORDS 3456
#define XB_SPIN_CAP (1u << 18)

__device__ __forceinline__ unsigned xb_ld(unsigned* p)              { return __hip_atomic_load(p, __ATOMIC_RELAXED, __HIP_MEMORY_SCOPE_AGENT); }
__device__ __forceinline__ unsigned xb_add(unsigned* p, unsigned v) { return __hip_atomic_fetch_add(p, v, __ATOMIC_RELAXED, __HIP_MEMORY_SCOPE_AGENT); }
__device__ __forceinline__ unsigned xb_xcc_id() { return (unsigned)__builtin_amdgcn_s_getreg((3 << 11) | 20) & 0xFu; }
#define XB_SPIN(cond, bar) do { unsigned _sp = 0; while (cond) { __builtin_amdgcn_s_sleep(1); \
    if ((++_sp & 255u) == 0u) { if (xb_ld(&(bar)[XB_TMO])) break; if (_sp > XB_SPIN_CAP) { atomicAdd(&(bar)[XB_TMO], 1u); break; } } } } while (0)

struct XcdBarrier {
    unsigned* bar; unsigned x; unsigned tot;
    volatile LAS unsigned* st;
};

__device__ __forceinline__ XcdBarrier xcd_barrier_post(unsigned* bar, volatile LAS unsigned* st, unsigned tot) {
    XcdBarrier b; b.bar = bar; b.x = xb_xcc_id(); b.st = st; b.tot = tot;
    if (threadIdx.x == 0) (void)xb_add(&bar[XB_XCNT(b.x)], 1u);
    return b;
}
__device__ __forceinline__ void xcd_barrier_complete(unsigned* bar, unsigned x, unsigned G, unsigned& nloc, unsigned& nx) {
    unsigned sum, cnt, mine, sp = 0u;
    for (;;) {
        sum = 0u; cnt = 0u; mine = 0u;
#pragma unroll
        for (unsigned j = 0; j < 16; ++j) { const unsigned c = xb_ld(&bar[XB_XCNT(j)]); sum += c; cnt += (c > 0u) ? 1u : 0u; mine = (j == x) ? c : mine; }
        if (sum == G) break;
        __builtin_amdgcn_s_sleep(1);
        if ((++sp & 255u) == 0u) { if (xb_ld(&bar[XB_TMO])) break; if (sp > XB_SPIN_CAP) { atomicAdd(&bar[XB_TMO], 1u); break; } }
    }
    nloc = mine > 0u ? mine : 1u; nx = cnt > 0u ? cnt : 1u;
}

__device__ __forceinline__ void xcd_barrier(const XcdBarrier& b) {
    asm volatile("s_waitcnt vmcnt(0)" ::: "memory");
    __syncthreads();
    if (threadIdx.x == 0) {
        size_t zoff_ = 0; asm volatile("" : "+s"(zoff_)); unsigned* bar = b.bar + zoff_; unsigned bx_ = b.x; asm volatile("" : "+s"(bx_));
        __builtin_amdgcn_s_waitcnt(0);
        unsigned nloc = b.st[0], nx = b.st[1];
        if (nloc == 0u) { xcd_barrier_complete(bar, bx_, b.tot, nloc, nx); b.st[0] = nloc; b.st[1] = nx; }
        const unsigned old = xb_add(&bar[XB_XSUB(bx_)], 1u);
        const unsigned gen = old / nloc;
        if (old + 1u == (gen + 1u) * nloc) {
            __builtin_amdgcn_fence(__ATOMIC_RELEASE, "agent");
            asm volatile("s_waitcnt vmcnt(0)" ::: "memory");
            const unsigned og = xb_add(&bar[XB_TOP], 1u);
            const unsigned tg = og / nx;
            if (og + 1u == (tg + 1u) * nx) xb_add(&bar[XB_TOPGEN], 1u);
            else XB_SPIN(xb_ld(&bar[XB_TOPGEN]) == tg, bar);
            __builtin_amdgcn_fence(__ATOMIC_ACQUIRE, "agent");
            xb_add(&bar[XB_XGEN(bx_)], 1u);
            asm volatile("s_waitcnt vmcnt(0)" ::: "memory");
        } else {
            XB_SPIN(xb_ld(&bar[XB_XGEN(bx_)]) == gen, bar);
            __builtin_amdgcn_fence(__ATOMIC_ACQUIRE, "agent");
            asm volatile("s_waitcnt vmcnt(0)" ::: "memory");
        }
    }
    __syncthreads();
}
constexpr int NWAVES = 8;
constexpr int BATCH = 8, SEQ = 4096, DMODEL = 1024, NTOK = BATCH * SEQ, DEPTH = 2, IN_COLS = 2816;
constexpr int NEXP = 16384, PEER_H = 8, PEER_K = 16;
constexpr float RMS_EPS = 1e-6f, LN_EPS = 1e-5f;
constexpr size_t MiB = 1u << 20;
constexpr size_t WS_CTL = 0, CTL_ZERO_BYTES = 1 * MiB;
constexpr size_t WS_WIN = 2 * MiB;
constexpr size_t WS_WOUT = 13 * MiB;
constexpr size_t WS_WQ = 17 * MiB;
constexpr size_t WS_KEYS = 25 * MiB;
constexpr size_t WS_RINV = 26 * MiB;
constexpr size_t WS_SSQ = 27 * MiB;
constexpr size_t WS_EID = 30 * MiB;
constexpr size_t WS_GATE = 38 * MiB;
constexpr size_t WS_SB = 54 * MiB;
constexpr size_t WS_XBF = 72 * MiB;
constexpr size_t WS_QK = 136 * MiB;
constexpr size_t WS_VX = 200 * MiB;
constexpr size_t WS_UT = 264 * MiB;
constexpr size_t WS_VT = 296 * MiB;
constexpr size_t WS_SU = 328 * MiB;
constexpr size_t WS_SV = 329 * MiB;
constexpr size_t WS_EIDT = 330 * MiB;
constexpr size_t WS_CORR = 338 * MiB;
constexpr size_t WS_SSQX = 339 * MiB;
constexpr size_t WS_XQ = 344 * MiB;
constexpr size_t WS_XQS = 376 * MiB;
constexpr size_t WS_CAT = 377 * MiB;
constexpr size_t WS_O = 441 * MiB;
constexpr size_t WS_WSC = 340 * MiB;
constexpr size_t WS_END = 505 * MiB;
constexpr size_t WS_PART = WS_QK;
constexpr size_t WS_WT = WS_SB;
constexpr int CW_BAR = 4096;
constexpr int RING_OFF = 0, RING_BYTES = 131072;
constexpr int LDSCTL_OFF = RING_BYTES, MISC_OFF = LDSCTL_OFF + 320;
constexpr int LDS_BYTES = 147456;

__device__ __forceinline__ float bflo(unsigned w) { return __builtin_bit_cast(float, w << 16); }
__device__ __forceinline__ float bfhi(unsigned w) { return __builtin_bit_cast(float, w & 0xffff0000u); }
__device__ __forceinline__ float bf1(unsigned short w) { return __builtin_bit_cast(float, (unsigned)w << 16); }
#define DPP_ADD(v, ctrl) ((v) + __builtin_bit_cast(float, __builtin_amdgcn_update_dpp(0, __builtin_bit_cast(int, (v)), (ctrl), 0xf, 0xf, true)))
__device__ __forceinline__ float wave_sum(float v) {
    v = DPP_ADD(v, 0xB1);
    v = DPP_ADD(v, 0x4E);
    v = DPP_ADD(v, 0x141);
    v = DPP_ADD(v, 0x140);
    const int b = __builtin_bit_cast(int, v);
    return (__builtin_bit_cast(float, __builtin_amdgcn_readlane(b, 0)) + __builtin_bit_cast(float, __builtin_amdgcn_readlane(b, 16))) + (__builtin_bit_cast(float, __builtin_amdgcn_readlane(b, 32)) + __builtin_bit_cast(float, __builtin_amdgcn_readlane(b, 48)));
}

__device__ __forceinline__ int win_src(int np) {
    const int p = np >> 8, pc = np & 255;
    if (p < 4) return 256 * p + 64 * ((pc & 127) >> 5) + 32 * (pc >> 7) + (pc & 31);
    if (p < 6) return np;
    if (p < 8) { const int kk = p - 6; return pc < 128 ? 1536 + 128 * kk + pc : 1792 + 128 * kk + (pc - 128); }
    if (p < 10) { const int kk = p - 8; return pc < 128 ? 2304 + 128 * kk + pc : 2560 + 128 * kk + (pc - 128); }
    return 2048 + pc;
}
template <int MODE> __device__ __forceinline__ void p0_transpose_item(const float* W, const float* gain, int K, int N, bf16* WT, LAS float* scr, int item, int lane) {
    const int nblk = N / 32, kb = item / nblk, nb = item % nblk, k0 = 64 * kb, n0p = 32 * nb;
    const int n0 = MODE == 1 ? win_src(n0p) : n0p;
#pragma unroll 8
    for (int i = 0; i < 32; ++i) { const int kk = 2 * i + (lane >> 5); const float gk = gain ? gain[k0 + kk] : 1.f; scr[kk * 33 + (lane & 31)] = W[(size_t)(k0 + kk) * N + n0 + (lane & 31)] * gk; }
    LDS_WAIT(); asm volatile("" ::: "memory");
    const int c = lane & 7;
#pragma unroll
    for (int j = 0; j < 4; ++j) { const int n = (lane >> 3) + 8 * j; const LAS float* s = scr + (8 * c) * 33 + n;
        v4u o; o.x = pk2(s[0 * 33], s[1 * 33]); o.y = pk2(s[2 * 33], s[3 * 33]); o.z = pk2(s[4 * 33], s[5 * 33]); o.w = pk2(s[6 * 33], s[7 * 33]);
        *(GAS v4u*)(WT + (size_t)(n0p + n) * K + k0 + 8 * c) = o; }
    LDS_WAIT(); asm volatile("" ::: "memory");
}
__device__ __forceinline__ void p0_convert(const float* src, bf16* dst, size_t n, int gtid, int ngt) {
    for (size_t i = (size_t)gtid * 8; i < n; i += (size_t)ngt * 8) {
        const f32x4 a = *(const GAS f32x4*)(src + i), b = *(const GAS f32x4*)(src + i + 4);
        v4u o; o.x = pk2(a.x, a.y); o.y = pk2(a.z, a.w); o.z = pk2(b.x, b.y); o.w = pk2(b.z, b.w);
        *(GAS v4u*)(dst + i) = o; }
}
__device__ __forceinline__ float wave_max(float v) {
#pragma unroll
    for (int o = 1; o < 64; o <<= 1) v = fmaxf(v, __shfl_xor(v, o));
    return v;
}
template <int OFFS> __device__ __forceinline__ void p0_quant_row(const float* src, unsigned char* dst_base, int e, float* scale_out, int lane) {
    const GAS f32x4* xr = (const GAS f32x4*)src + 4 * lane;
    f32x4 v[4]; float m = 0.f;
#pragma unroll
    for (int j = 0; j < 4; ++j) { v[j] = __builtin_nontemporal_load(xr + j); m = fmaxf(fmaxf(m, fmaxf(fabsf(v[j].x), fabsf(v[j].y))), fmaxf(fabsf(v[j].z), fabsf(v[j].w))); }
    m = wave_max(m);
    const float inv = m > 0.f ? 127.0f / m : 0.f;
    v4u o;
#pragma unroll
    for (int j = 0; j < 4; ++j) { const int a = (int)rintf(v[j].x * inv) + OFFS, b = (int)rintf(v[j].y * inv) + OFFS, c = (int)rintf(v[j].z * inv) + OFFS, d = (int)rintf(v[j].w * inv) + OFFS;
        o[j] = (unsigned)(a & 0xff) | ((unsigned)(b & 0xff) << 8) | ((unsigned)(c & 0xff) << 16) | ((unsigned)(d & 0xff) << 24); }
    *(GAS v4u*)(dst_base + ((size_t)(lane >> 3) * NEXP + e) * 128 + 16 * (lane & 7)) = o;
    if (lane == 0) *scale_out = m * (1.0f / 127.0f);
}
struct QRow { f32x4 v[4]; };
__device__ __forceinline__ void p0_quant_load(QRow& q, const float* src, int lane) { const GAS f32x4* xr = (const GAS f32x4*)src + 4 * lane;
#pragma unroll
    for (int j = 0; j < 4; ++j) q.v[j] = __builtin_nontemporal_load(xr + j); }
__device__ __forceinline__ void p0_quant_fin(const QRow& q, const float* gain, unsigned char* dst_base, int e, float* scale_out, int lane) {
    f32x4 v[4]; float m = 0.f;
#pragma unroll
    for (int j = 0; j < 4; ++j) { v[j] = q.v[j]; if (gain) v[j] = v[j] * *((const GAS f32x4*)gain + 4 * lane + j); m = fmaxf(fmaxf(m, fmaxf(fabsf(v[j].x), fabsf(v[j].y))), fmaxf(fabsf(v[j].z), fabsf(v[j].w))); }
    m = fmaxf(m, __shfl_xor(m, 1)); m = fmaxf(m, __shfl_xor(m, 2)); m = fmaxf(m, __shfl_xor(m, 4)); m = fmaxf(m, __shfl_xor(m, 8));
    const float inv = m > 0.f ? 7.0f / m : 0.f;
    unsigned o[2];
#pragma unroll
    for (int k = 0; k < 2; ++k) { const f32x4 lo = v[2 * k], hi = v[2 * k + 1];
#define Q4(x) ((unsigned)((int)rintf((x) * inv) + 8) & 0xfu)
        o[k] = (Q4(lo.x) | (Q4(hi.x) << 4)) | ((Q4(lo.y) | (Q4(hi.y) << 4)) << 8) | ((Q4(lo.z) | (Q4(hi.z) << 4)) << 16) | ((Q4(lo.w) | (Q4(hi.w) << 4)) << 24);
#undef Q4
    }
    *(GAS unsigned long long*)(dst_base + ((size_t)(lane >> 4) * NEXP + e) * 128 + 8 * (lane & 15)) = (unsigned long long)o[0] | ((unsigned long long)o[1] << 32);
    if ((lane & 15) == 0) scale_out[4 * e + (lane >> 4)] = m * (1.0f / 7.0f);
}
__device__ __forceinline__ void p0_quant_row4(const float* src, const float* gain, unsigned char* dst_base, int e, float* scale_out, int lane) { QRow q; p0_quant_load(q, src, lane); p0_quant_fin(q, gain, dst_base, e, scale_out, lane); }
__device__ __forceinline__ void p0_x_row(const float* xrow, bf16* orow, float* rinv_out, int lane) {
    const GAS f32x4* xr = (const GAS f32x4*)xrow + lane;
    f32x4 v[4]; float s = 0.f;
#pragma unroll
    for (int j = 0; j < 4; ++j) { v[j] = xr[64 * j]; s += (v[j].x * v[j].x + v[j].y * v[j].y) + (v[j].z * v[j].z + v[j].w * v[j].w); }
    s = wave_sum(s);
    GAS unsigned long long* o8 = (GAS unsigned long long*)orow + lane;
#pragma unroll
    for (int j = 0; j < 4; ++j) o8[64 * j] = (unsigned long long)pk2(v[j].x, v[j].y) | ((unsigned long long)pk2(v[j].z, v[j].w) << 32);
    if (lane < 8) rinv_out[lane] = lane == 0 ? s : 0.f;
}

__device__ __forceinline__ float wave_sum_shfl(float v) {
#pragma unroll
    for (int o = 1; o < 64; o <<= 1) v += __shfl_xor(v, o);
    return v;
}
__device__ __forceinline__ void xq_row(const bf16* xrow, signed char* qrow, float* sc4, int lane) {
    const GAS v4u* xp = (const GAS v4u*)xrow + 2 * lane; const v4u a = xp[0], b = xp[1];
#define AMX(w) fmaxf(fabsf(bflo(w)), fabsf(bfhi(w)))
    float am = fmaxf(fmaxf(fmaxf(AMX(a.x), AMX(a.y)), fmaxf(AMX(a.z), AMX(a.w))), fmaxf(fmaxf(AMX(b.x), AMX(b.y)), fmaxf(AMX(b.z), AMX(b.w))));
#undef AMX
    am = fmaxf(am, __shfl_xor(am, 1)); am = fmaxf(am, __shfl_xor(am, 2)); am = fmaxf(am, __shfl_xor(am, 4)); am = fmaxf(am, __shfl_xor(am, 8));
    const float qinv = am > 0.f ? 127.0f / am : 0.f;
#define PK4(wa, wb) (unsigned)(((int)rintf(bflo(wa) * qinv) & 0xff) | (((int)rintf(bfhi(wa) * qinv) & 0xff) << 8) | (((int)rintf(bflo(wb) * qinv) & 0xff) << 16) | (((int)rintf(bfhi(wb) * qinv) & 0xff) << 24))
    v4u o; o.x = PK4(a.x, a.y); o.y = PK4(a.z, a.w); o.z = PK4(b.x, b.y); o.w = PK4(b.z, b.w);
#undef PK4
    *((GAS v4u*)qrow + lane) = o;
    if ((lane & 15) == 0) sc4[lane >> 4] = am * (1.0f / 127.0f);
}
struct QuantJob { const float* usrc; const float* vsrc; const float* gain; unsigned char* UT; unsigned char* VT; float* SU; float* SV; int r0, rs; };
struct CmbArgs { const bf16* O; const bf16* VX; const bf16* SB; bf16* CAT; const float* lq1; const float* lk1; const float* lq2; const float* lk2; const float* subg;
                 const float* cfw; const float* cfb; const float* lng; const float* lnb; const float* scw; float lam_init; };
__device__ __forceinline__ float cmb_lambda(const CmbArgs& A, int lane) { return __expf(wave_sum(A.lq1[lane] * A.lk1[lane])) - __expf(wave_sum(A.lq2[lane] * A.lk2[lane])) + A.lam_init; }
__device__ __forceinline__ void cmb_rows(const CmbArgs& A, float lam, int h, int trow0, int lane_in) {
    asm volatile("s_waitcnt vmcnt(0)" ::: "memory");
    int lane = lane_in; asm volatile("" : "+v"(lane));
    const int vh = lane >> 5, dd = (2 * lane) & 63;
    const int c0 = (4 * h + vh) * 64 + dd, c1 = (4 * h + 2 + vh) * 64 + dd;
    const float g0 = A.subg[2 * lane] * (1.0f - A.lam_init), g1 = A.subg[2 * lane + 1] * (1.0f - A.lam_init);
    unsigned o0[32], o1[32];
#pragma unroll
    for (int tt = 0; tt < 32; ++tt) { const size_t rb = (size_t)(trow0 + tt) * 1024;
        o0[tt] = __hip_atomic_load((const GAS unsigned*)(A.O + rb + c0), __ATOMIC_RELAXED, __HIP_MEMORY_SCOPE_AGENT); o1[tt] = __hip_atomic_load((const GAS unsigned*)(A.O + rb + c1), __ATOMIC_RELAXED, __HIP_MEMORY_SCOPE_AGENT); }
#pragma unroll
    for (int tt = 0; tt < 32; ++tt) {
        const float a0 = bflo(o0[tt]) - lam * bflo(o1[tt]), a1 = bfhi(o0[tt]) - lam * bfhi(o1[tt]);
        const float ss = wave_sum(a0 * a0 + a1 * a1);
        const float ri = 1.0f / sqrtf(ss * (1.0f / 128.0f) + RMS_EPS);
        *(GAS unsigned*)(A.CAT + (size_t)(trow0 + tt) * 1024 + h * 128 + 2 * lane) = pk2(a0 * ri * g0, a1 * ri * g1); }
}
__device__ __forceinline__ void cmb_conv_phase(const CmbArgs& A, const QuantJob& J, int gw, int ngw, int lane) {
    constexpr int NCH = SEQ / 16, NIT = NCH * 4;
    {
        unsigned short xin[46], xn[46];
#define CMB1_LOAD(X, it_) do { const int c_ = 64 * ((it_) & 3) + lane, t0_ = ((it_) >> 2) * 16, s0_ = t0_ & (SEQ - 1); \
        _Pragma("unroll") for (int i = 0; i < 46; ++i) { const int rel = i - 30; (X)[i] = (s0_ + rel >= 0) ? *(const GAS unsigned short*)(A.VX + (size_t)(t0_ + rel) * 1024 + 512 + c_) : (unsigned short)0; } } while (0)
        int it = gw; int qr = J.r0;
        if (it < NIT) CMB1_LOAD(xin, it);
        for (; it < NIT; it += ngw) {
            const int qra = qr < NEXP ? qr : NEXP - 1; const bool qok = qr < NEXP; qr += J.rs;
            QRow qua, qva;
            p0_quant_load(qua, J.usrc + (size_t)qra * DMODEL, lane); p0_quant_load(qva, J.vsrc + (size_t)qra * DMODEL, lane);
            const int nx = it + ngw < NIT ? it + ngw : it;
            CMB1_LOAD(xn, nx);
            const int c = 64 * (it & 3) + lane, t0 = (it >> 2) * 16;
            float w[31];
#pragma unroll
            for (int j = 0; j < 31; ++j) w[j] = A.cfw[j * 256 + c];
            const float bias = A.cfb[c], lg = A.lng[c], lb = A.lnb[c];
#pragma unroll
            for (int tt = 0; tt < 16; ++tt) { float y = bias;
#pragma unroll
                for (int j = 0; j < 31; ++j) y += w[j] * bf1(xin[tt + j]);
                const float mean = wave_sum(y) * (1.0f / 64.0f); const float d = y - mean;
                const float var = wave_sum(d * d) * (1.0f / 64.0f);
                const float yn = d / sqrtf(var + LN_EPS) * lg + lb;
                const float sw = yn / (1.0f + __expf(-yn));
                *(GAS unsigned short*)(A.CAT + (size_t)(t0 + tt) * 1024 + 512 + c) = (unsigned short)f2bf(sw); }
#pragma unroll
            for (int i = 0; i < 46; ++i) xin[i] = xn[i];
            if (qok) { p0_quant_fin(qua, J.gain, J.UT, qra, J.SU, lane); p0_quant_fin(qva, nullptr, J.VT, qra, J.SV, lane); }
        }
#undef CMB1_LOAD
    }
    {
        unsigned short xin[18], sbv[16], xn[18], sbn[16];
#define CMB2_LOAD(X, S, it_) do { const int c_ = 64 * ((it_) & 3) + lane, t0_ = ((it_) >> 2) * 16, s0_ = t0_ & (SEQ - 1); \
        _Pragma("unroll") for (int i = 0; i < 18; ++i) { const int rel = i - 2; (X)[i] = (s0_ + rel >= 0) ? *(const GAS unsigned short*)(A.VX + (size_t)(t0_ + rel) * 1024 + 768 + c_) : (unsigned short)0; } \
        _Pragma("unroll") for (int tt = 0; tt < 16; ++tt) (S)[tt] = *(const GAS unsigned short*)(A.SB + (size_t)(t0_ + tt) * 256 + c_); } while (0)
        int it = gw;
        if (it < NIT) CMB2_LOAD(xin, sbv, it);
        for (; it < NIT; it += ngw) {
            const int nx = it + ngw < NIT ? it + ngw : it;
            CMB2_LOAD(xn, sbn, nx);
            const int c = 64 * (it & 3) + lane, t0 = (it >> 2) * 16;
            const float w0 = A.scw[c], w1 = A.scw[256 + c], w2 = A.scw[512 + c];
#pragma unroll
            for (int tt = 0; tt < 16; ++tt) {
                const float y = bf1(sbv[tt]) * (w0 * bf1(xin[tt]) + w1 * bf1(xin[tt + 1]) + w2 * bf1(xin[tt + 2]));
                *(GAS unsigned short*)(A.CAT + (size_t)(t0 + tt) * 1024 + 768 + c) = (unsigned short)f2bf(y); }
#pragma unroll
            for (int i = 0; i < 18; ++i) xin[i] = xn[i];
#pragma unroll
            for (int tt = 0; tt < 16; ++tt) sbv[tt] = sbn[tt];
        }
#undef CMB2_LOAD
    }
}

typedef float f32x16 __attribute__((ext_vector_type(16)));
__device__ __forceinline__ int sortable(int b) { return b ^ ((b >> 31) & 0x7fffffff); }
#define CEX_DESC(a, b) do { const int _x = (a), _y = (b); (a) = _x > _y ? _x : _y; (b) = _x > _y ? _y : _x; } while (0)
template <int N> __device__ __forceinline__ void bitonic_merge_desc(int (&v)[N]) {
#pragma unroll
    for (int j = N >> 1; j > 0; j >>= 1)
#pragma unroll
        for (int i = 0; i < N; ++i) if ((i & j) == 0) CEX_DESC(v[i], v[i | j]);
}
template <int N> __device__ __forceinline__ void bitonic_sort_desc(int (&v)[N]) {
#pragma unroll
    for (int k = 2; k <= N; k <<= 1)
#pragma unroll
        for (int j = k >> 1; j > 0; j >>= 1)
#pragma unroll
            for (int i = 0; i < N; ++i) { const int l = i ^ j; if (l > i) { if ((i & k) == 0) CEX_DESC(v[i], v[l]); else CEX_DESC(v[l], v[i]); } }
}
__device__ __forceinline__ void merge_top16(int (&a)[16], const int (&b)[16]) {
#pragma unroll
    for (int i = 0; i < 16; ++i) a[i] = a[i] > b[15 - i] ? a[i] : b[15 - i];
    bitonic_merge_desc<16>(a);
}
__device__ __forceinline__ float vmaxf(float a, float b) { float r; asm("v_max_f32 %0, %1, %2" : "=v"(r) : "v"(a), "v"(b)); return r; }
__device__ __forceinline__ float vminf(float a, float b) { float r; asm("v_min_f32 %0, %1, %2" : "=v"(r) : "v"(a), "v"(b)); return r; }
#define CEXF(a, b) do { const float _x = (a), _y = (b); (a) = vmaxf(_x, _y); (b) = vminf(_x, _y); } while (0)
template <int N> __device__ __forceinline__ void bitonic_merge_f(float (&v)[N]) {
#pragma unroll
    for (int j = N >> 1; j > 0; j >>= 1)
#pragma unroll
        for (int i = 0; i < N; ++i) if ((i & j) == 0) CEXF(v[i], v[i | j]);
}
__device__ __forceinline__ void sort16_f(float (&v)[16]) {
#define CX(i, j) CEXF(v[i], v[j]);
    CX(0,13) CX(1,12) CX(2,15) CX(3,14) CX(4,8) CX(5,6) CX(7,11) CX(9,10)
    CX(0,5) CX(1,7) CX(2,9) CX(3,4) CX(6,13) CX(8,14) CX(10,15) CX(11,12)
    CX(0,1) CX(2,3) CX(4,5) CX(6,8) CX(7,9) CX(10,11) CX(12,13) CX(14,15)
    CX(0,2) CX(1,3) CX(4,10) CX(5,11) CX(6,7) CX(8,9) CX(12,14) CX(13,15)
    CX(1,2) CX(3,12) CX(4,6) CX(5,7) CX(8,10) CX(9,11) CX(13,14)
    CX(1,4) CX(2,6) CX(5,8) CX(7,10) CX(9,13) CX(11,14)
    CX(2,4) CX(3,6) CX(9,12) CX(11,13)
    CX(3,5) CX(6,8) CX(7,9) CX(10,12)
    CX(3,4) CX(5,6) CX(7,8) CX(9,10) CX(11,12)
    CX(6,7) CX(8,9)
#undef CX
}
__device__ __forceinline__ void merge_top16_f(float (&a)[16], const float (&b)[16]) {
#pragma unroll
    for (int i = 0; i < 16; ++i) a[i] = vmaxf(a[i], b[15 - i]);
    bitonic_merge_f<16>(a);
}
__device__ __forceinline__ void stage2_top16(const float (&ta)[16], const float (&tb)[16], float (&R)[16]) {
    float a[16], b[16];
#pragma unroll
    for (int i = 0; i < 16; ++i) { a[i] = __builtin_bit_cast(float, __builtin_bit_cast(int, ta[i]) & ~0x7f); b[i] = __builtin_bit_cast(float, __builtin_bit_cast(int, tb[i]) & ~0x7f); }
#define MK(i, j) __builtin_bit_cast(float, (__builtin_bit_cast(int, a[i] + b[j]) & ~0xff) | ((i) << 4) | (j))
    const float NINF = __builtin_bit_cast(float, 0xff800000u);
#pragma unroll
    for (int j = 0; j < 16; ++j) R[j] = MK(0, j);
#pragma unroll
    for (int i = 1; i < 16; ++i) R[i] = vmaxf(R[i], MK(16 - i, 0));
    bitonic_merge_f<16>(R);
    {
        float C[16];
#pragma unroll
        for (int j = 1; j < 8; ++j) C[j - 1] = MK(1, j);
        C[7] = NINF; C[8] = NINF; C[9] = NINF;
#pragma unroll
        for (int i = 7; i >= 2; --i) C[17 - i] = MK(i, 1);
        bitonic_merge_f<16>(C);
#pragma unroll
        for (int i = 3; i < 16; ++i) R[i] = vmaxf(R[i], C[15 - i]);
        bitonic_merge_f<16>(R);
    }
    {
        float d0 = MK(2, 2), p = MK(2, 3), q = MK(2, 4), r = MK(3, 2), s = MK(4, 2), t = MK(3, 3);
        CEXF(p, r); CEXF(q, s); CEXF(r, q);
        CEXF(q, t); CEXF(s, t);
        R[10] = vmaxf(R[10], t); R[11] = vmaxf(R[11], s); R[12] = vmaxf(R[12], q); R[13] = vmaxf(R[13], r); R[14] = vmaxf(R[14], p); R[15] = vmaxf(R[15], d0);
    }
#undef MK
}
struct TopkArgs { const bf16* Qp; const bf16* keys; const float* ssq; unsigned short* eid; float* gate; unsigned short* eidT;
#ifdef DBG_CHECK
 float* dbgS; int* dbgI;
#endif
 };
__device__ __forceinline__ void topk_phase(const TopkArgs& A, const QuantJob& J, int& qr_next, LAS unsigned char* ldsK  , LAS unsigned char* ldsw  , int h, int rank, int nrank, int wave, int tid, int lane) {
    const int r32 = lane & 31, hi = lane >> 5;
    __syncthreads();
    {
        const GAS v4u* src = (const GAS v4u*)(A.keys + (size_t)h * 2 * 128 * 128);
#pragma unroll
        for (int i = 0; i < 8; ++i) { const int g = tid + 512 * i, row = g >> 4, ch = g & 15; *(LAS v4u*)(ldsK + row * 256 + ((ch ^ (row & 15)) << 4)) = src[g]; }
        __syncthreads();
    }
    for (int tg = rank * 8 + wave; tg < SEQ / 32; tg += nrank * 8) {
        const int t = tg * 32 + r32;
        int hb = hi << 2; asm volatile("" : "+v"(hb));
        float rinv2; { const GAS f32x4* sp = (const GAS f32x4*)(A.ssq + (size_t)t * 16); const f32x4 a = sp[0], b = sp[1], c = sp[2], d = sp[3];
            const float ss = ((a.x + a.y) + (a.z + a.w)) + ((b.x + b.y) + (b.z + b.w)) + ((c.x + c.y) + (c.z + c.w)) + ((d.x + d.y) + (d.z + d.w));
            rinv2 = 1.0f / sqrtf(ss * (1.0f / DMODEL) + RMS_EPS); }
        float top[2][16];
#pragma unroll
        for (int c = 0; c < 2; ++c) {
            const int qra = qr_next < NEXP ? qr_next : NEXP - 1; const bool qok = c == 0 && qr_next < NEXP; if (c == 0) qr_next += J.rs;
            QRow qua, qva;
            if (c == 0) { p0_quant_load(qua, J.usrc + (size_t)qra * DMODEL, lane); p0_quant_load(qva, J.vsrc + (size_t)qra * DMODEL, lane); }
            const bf16* qrow = A.Qp + (size_t)t * 2048 + h * 256 + c * 128 + 8 * hi;
            bf16x8 qf[8];
#pragma unroll
            for (int s = 0; s < 8; ++s) qf[s] = *(const GAS bf16x8*)(qrow + 16 * s);
            float run[16];
            int koff = c * 32768 + r32 * 256; asm volatile("" : "+v"(koff));
            const int ksw = r32 & 15;
#pragma unroll
            for (int nt = 0; nt < 4; ++nt) {
                bf16x8 kf[8];
#pragma unroll
                for (int s = 0; s < 8; ++s) kf[s] = *(const LAS bf16x8*)(ldsK + nt * 8192 + koff + (((2 * s + hi) ^ ksw) << 4));
                f32x16 acc = {0.f, 0.f, 0.f, 0.f, 0.f, 0.f, 0.f, 0.f, 0.f, 0.f, 0.f, 0.f, 0.f, 0.f, 0.f, 0.f};
#pragma unroll
                for (int s = 0; s < 8; ++s) acc = __builtin_amdgcn_mfma_f32_32x32x16_bf16(kf[s], qf[s], acc, 0, 0, 0);
                asm volatile("" ::: "memory");
                float g[16];
#pragma unroll
                for (int r = 0; r < 16; ++r) { const int idx = 32 * nt + (r & 3) + 8 * (r >> 2);
                    const float av = acc[r];
                    g[r] = __int_as_float(((__float_as_int(av) & ~0x7f) | idx) | hb); }
                sort16_f(g);
                if (nt == 0) {
#pragma unroll
                    for (int r = 0; r < 16; ++r) run[r] = g[r];
                } else merge_top16_f(run, g);
            }
            {
                float other[16];
#pragma unroll
                for (int i = 0; i < 16; ++i) other[i] = __shfl_xor(run[i], 32);
                merge_top16_f(run, other);
            }
#pragma unroll
            for (int i = 0; i < 16; ++i) top[c][i] = run[i];
            if (c == 0) { if (qok) { p0_quant_fin(qua, J.gain, J.UT, qra, J.SU, lane); p0_quant_fin(qva, nullptr, J.VT, qra, J.SV, lane); } }
        }
#pragma unroll
        for (int c = 0; c < 2; ++c)
#pragma unroll
            for (int q4 = 0; q4 < 4; ++q4) { const unsigned w = (unsigned)(__float_as_int(top[c][4 * q4]) & 0x7f) | ((unsigned)(__float_as_int(top[c][4 * q4 + 1]) & 0x7f) << 8) | ((unsigned)(__float_as_int(top[c][4 * q4 + 2]) & 0x7f) << 16) | ((unsigned)(__float_as_int(top[c][4 * q4 + 3]) & 0x7f) << 24);
                *(LAS unsigned*)(ldsw + lane * 32 + c * 16 + q4 * 4) = w; }
        float crun[16];
        stage2_top16(top[0], top[1], crun);
        LDS_WAIT(); asm volatile("" ::: "memory");
        float sc[16]; unsigned e[16];
#pragma unroll
        for (int k = 0; k < 16; ++k) { const int bits = __float_as_int(crun[k]); const int i = (bits >> 4) & 15, j = bits & 15;
            sc[k] = __builtin_bit_cast(float, bits & ~0xff) * rinv2;
            const unsigned i1 = *(const LAS unsigned char*)(ldsw + lane * 32 + i), i2 = *(const LAS unsigned char*)(ldsw + lane * 32 + 16 + j);
            e[k] = i1 * 128u + i2; }
        const float mx = sc[0];
        float z = 0.f;
#pragma unroll
        for (int k = 0; k < 16; ++k) { sc[k] = __expf(sc[k] - mx); z += sc[k]; }
        const float iz = 1.0f / z;
        if (hi == 0) {
            v4u e0, e1; e0.x = e[0] | (e[1] << 16); e0.y = e[2] | (e[3] << 16); e0.z = e[4] | (e[5] << 16); e0.w = e[6] | (e[7] << 16);
            e1.x = e[8] | (e[9] << 16); e1.y = e[10] | (e[11] << 16); e1.z = e[12] | (e[13] << 16); e1.w = e[14] | (e[15] << 16);
            GAS v4u* ep = (GAS v4u*)(A.eid + (size_t)t * 128 + h * 16); ep[0] = e0; ep[1] = e1;
#pragma unroll
            for (int k = 0; k < 8; ++k) *(GAS unsigned*)(A.eidT + (size_t)t * 128 + k * 16 + 2 * h) = e[k] | (e[k + 8] << 16);
        } else {
            GAS f32x4* gp = (GAS f32x4*)(A.gate + (size_t)t * 128 + h * 16);
#pragma unroll
            for (int q4 = 0; q4 < 4; ++q4) gp[q4] = (f32x4){sc[4 * q4] * iz, sc[4 * q4 + 1] * iz, sc[4 * q4 + 2] * iz, sc[4 * q4 + 3] * iz};
        }
    }
}

__device__ __forceinline__ float gelu_exact(float v) { return 0.5f * v * (1.0f + erff(v * 0.70710678118654752f)); }
__device__ __forceinline__ float ub0(unsigned x) { float f; asm("v_cvt_f32_ubyte0 %0, %1" : "=v"(f) : "v"(x)); return f; }
__device__ __forceinline__ float ub1(unsigned x) { float f; asm("v_cvt_f32_ubyte1 %0, %1" : "=v"(f) : "v"(x)); return f; }
__device__ __forceinline__ float ub2(unsigned x) { float f; asm("v_cvt_f32_ubyte2 %0, %1" : "=v"(f) : "v"(x)); return f; }
__device__ __forceinline__ float ub3(unsigned x) { float f; asm("v_cvt_f32_ubyte3 %0, %1" : "=v"(f) : "v"(x)); return f; }
template <class T> __device__ __forceinline__ T tr_xchg_add(T a, T b, int O, int lane) {
    if (O == 16 || O == 32) {
        const unsigned ua = __builtin_bit_cast(unsigned, a), ub = __builtin_bit_cast(unsigned, b);
        if (O == 16) { auto r = __builtin_amdgcn_permlane16_swap(ua, ub, false, false); return __builtin_bit_cast(T, (unsigned)r[0]) + __builtin_bit_cast(T, (unsigned)r[1]); }
        else         { auto r = __builtin_amdgcn_permlane32_swap(ua, ub, false, false); return __builtin_bit_cast(T, (unsigned)r[0]) + __builtin_bit_cast(T, (unsigned)r[1]); }
    } else {
        const bool up = (lane & O) != 0; const T send = up ? a : b, keep = up ? b : a;
        const int si = __builtin_bit_cast(int, send);
        const int ri = O == 1 ? __builtin_amdgcn_update_dpp(0, si, 0xB1, 0xf, 0xf, true) : O == 2 ? __builtin_amdgcn_update_dpp(0, si, 0x4E, 0xf, 0xf, true)
                     : O == 4 ? __builtin_amdgcn_update_dpp(0, si, 0x124, 0xf, 0xf, true)
                     : __builtin_amdgcn_update_dpp(0, si, 0x128, 0xf, 0xf, true);
        return keep + __builtin_bit_cast(T, ri);
    }
}
template <class T, int N, int O, int NEND> struct TReduce {
    static __device__ __forceinline__ void run(T (&v)[N], T (&out)[NEND], int lane) {
        T w[N / 2];
#pragma unroll
        for (int i = 0; i < N / 2; ++i) {
            if (O == 4) { const bool up = (lane & O) != 0; const T send = up ? v[2 * i] : v[2 * i + 1], keep = up ? v[2 * i + 1] : v[2 * i]; w[i] = keep + __shfl_xor(send, O); }
            else w[i] = tr_xchg_add<T>(v[2 * i], v[2 * i + 1], O, lane);
        }
        TReduce<T, N / 2, O * 2, NEND>::run(w, out, lane);
    }
};
template <class T, int O, int NEND> struct TReduce<T, NEND, O, NEND> { static __device__ __forceinline__ void run(T (&v)[NEND], T (&out)[NEND], int) {
#pragma unroll
    for (int i = 0; i < NEND; ++i) out[i] = v[i]; } };
struct PeerUArgs { const signed char* xq; const float* xqs; const unsigned char* UT; const unsigned short* eidT; float* part; };
struct MetaU { v4u ea, eb, qa, qb; float sx; };
__device__ __forceinline__ void peer_u_run(const PeerUArgs& A, int t0, int tl0, int lane) {
    const int pp = lane >> 3, cc = lane & 7;
    const unsigned char* Us = A.UT + 16 * cc;
#define U_META(M, tt_) do { const int i_ = (tt_) < 63 ? (tt_) : 63; const int t_ = t0 + (i_ & 15), s_ = i_ >> 4; const GAS v4u* ep_ = (const GAS v4u*)(A.eidT + (size_t)t_ * 128 + pp * 16); (M).ea = ep_[0]; (M).eb = ep_[1]; \
        const GAS v4u* xp_ = (const GAS v4u*)(A.xq + (size_t)t_ * DMODEL + 256 * s_ + 32 * cc); (M).qa = xp_[0]; (M).qb = xp_[1]; (M).sx = A.xqs[(size_t)t_ * 4 + s_]; } while (0)
#define U_TAB(Q, M, tt_) do { const int i_ = (tt_) < 63 ? (tt_) : 63; const unsigned char* Ui_ = Us + (size_t)(i_ >> 4) * NEXP * 128; \
        _Pragma("unroll") for (int g = 0; g < 16; ++g) { const unsigned ew_ = g < 8 ? (M).ea[g >> 1] : (M).eb[(g - 8) >> 1]; const unsigned e_ = (g & 1) ? (ew_ >> 16) : (ew_ & 0xffffu); \
        (Q)[g] = *(const GAS v4u*)(Ui_ + (size_t)e_ * 128); } } while (0)
#define U_COMP(M, Q, tt_) do { const int tl_ = tl0 + ((tt_) & 15), s4_ = (tt_) >> 4; int part[16]; \
        int sm_ = 0; _Pragma("unroll") for (int k = 0; k < 4; ++k) { sm_ = __builtin_amdgcn_sdot4(0x01010101, (int)(M).qa[k], sm_, false); sm_ = __builtin_amdgcn_sdot4(0x01010101, (int)(M).qb[k], sm_, false); } sm_ *= -8; \
        _Pragma("unroll") for (int g = 0; g < 16; ++g) { int a_ = sm_; \
            _Pragma("unroll") for (int k = 0; k < 4; ++k) { const unsigned d_ = (Q)[g][k]; const int x0_ = (int)(k < 2 ? (M).qa[2 * k] : (M).qb[2 * k - 4]), x1_ = (int)(k < 2 ? (M).qa[2 * k + 1] : (M).qb[2 * k - 3]); \
                a_ = __builtin_amdgcn_sdot4((int)(d_ & 0x0f0f0f0fu), x0_, a_, false); a_ = __builtin_amdgcn_sdot4((int)((d_ >> 4) & 0x0f0f0f0fu), x1_, a_, false); } \
            part[g] = a_; } \
        int tot[2]; TReduce<int, 16, 1, 2>::run(part, tot, lane); \
        float* po = A.part + ((size_t)s4_ * SEQ + tl_) * 128 + 8 * cc + pp; po[0] = (float)tot[0] * (M).sx; po[64] = (float)tot[1] * (M).sx; } while (0)
    MetaU mc, mn, mnn; v4u QA[16], QB[16];
    U_META(mc, 0); U_META(mn, 1); U_TAB(QA, mc, 0);
    for (int tt = 0; tt < 64; tt += 2) {
        U_META(mnn, tt + 2); U_TAB(QB, mn, tt + 1); U_COMP(mc, QA, tt); mc = mn; mn = mnn;
        U_META(mnn, tt + 3); U_TAB(QA, mn, tt + 2); U_COMP(mc, QB, tt + 1); mc = mn; mn = mnn;
    }
#undef U_META
#undef U_TAB
#undef U_COMP
}
struct PeerRArgs { const float* part; const float* ssq; const unsigned short* eid; const float* gate; const float* su; const float* sv; signed char* wq; float* wsc; };
struct MetaR { int e0, e1; float g0, g1, ssq; float p0[4], p1[4]; };
struct GathR { f32x4 su0, su1, sv0, sv1; };
__device__ __forceinline__ void peer_r_run(const PeerRArgs& A, int t0, int tl0, int lane) {
#define R_META(M, k_) do { const int kk_ = (k_) < 15 ? (k_) : 15; const int tq_ = t0 + kk_, tl_ = tl0 + kk_; (M).e0 = A.eid[(size_t)tq_ * 128 + lane]; (M).e1 = A.eid[(size_t)tq_ * 128 + 64 + lane]; \
        (M).g0 = A.gate[(size_t)tq_ * 128 + lane]; (M).g1 = A.gate[(size_t)tq_ * 128 + 64 + lane]; (M).ssq = lane < 16 ? A.ssq[(size_t)tq_ * 16 + lane] : 0.f; \
        _Pragma("unroll") for (int s = 0; s < 4; ++s) { const float* pr_ = A.part + ((size_t)s * SEQ + tl_) * 128; (M).p0[s] = pr_[lane]; (M).p1[s] = pr_[64 + lane]; } } while (0)
#define R_GATH(Gv, M) do { (Gv).su0 = *(const GAS f32x4*)(A.su + 4 * (M).e0); (Gv).su1 = *(const GAS f32x4*)(A.su + 4 * (M).e1); (Gv).sv0 = *(const GAS f32x4*)(A.sv + 4 * (M).e0); (Gv).sv1 = *(const GAS f32x4*)(A.sv + 4 * (M).e1); } while (0)
    MetaR mc, mn, mnn; GathR gc, gn;
    R_META(mc, 0); R_META(mn, 1); R_GATH(gc, mc);
    for (int k = 0; k < 16; ++k) { const int t = t0 + k;
        R_META(mnn, k + 2); R_GATH(gn, mn);
        float z0 = 0.f, z1 = 0.f;
#pragma unroll
        for (int s = 0; s < 4; ++s) { z0 += mc.p0[s] * gc.su0[s]; z1 += mc.p1[s] * gc.su1[s]; }
        const float ss = wave_sum(mc.ssq);
        const float ri = 1.0f / sqrtf(ss * (1.0f / DMODEL) + RMS_EPS);
        const float w0 = mc.g0 * gelu_exact(z0 * ri), w1 = mc.g1 * gelu_exact(z1 * ri);
#pragma unroll
        for (int s = 0; s < 4; ++s) { const float a0 = w0 * gc.sv0[s], a1 = w1 * gc.sv1[s];
            const float gm = wave_max(fmaxf(fabsf(a0), fabsf(a1)));
            const float inv = gm > 0.f ? 127.0f / gm : 0.f;
            signed char* wr = A.wq + ((size_t)t * 4 + s) * 128 + (lane & 7) * 16 + (lane >> 3);
            wr[0] = (signed char)(int)rintf(a0 * inv); wr[8] = (signed char)(int)rintf(a1 * inv);
            if (lane == 0) A.wsc[(size_t)t * 4 + s] = gm * (1.0f / 127.0f); }
        mc = mn; mn = mnn; gc = gn;
    }
#undef R_META
#undef R_GATH
}
typedef unsigned u32x2 __attribute__((ext_vector_type(2)));
struct PeerVArgs { float* xout  ; const unsigned char* VT; const unsigned short* eidT; const signed char* wq; const float* wsc; bf16* xb; float* ssqx; };
struct MetaV { v4u ea, eb, wq; float sc; u32x2 xv; };
__device__ __forceinline__ void peer_v_run(const PeerVArgs& A, int t0, int lane) {
    const int pp = lane >> 3, cc = lane & 7;
    {
        const unsigned char* Vs = A.VT + 16 * cc;
#define V_META(M, tt_) do { const int i_ = (tt_) < 63 ? (tt_) : 63; const int t_ = t0 + (i_ & 15), s4 = i_ >> 4; const GAS v4u* ep_ = (const GAS v4u*)(A.eidT + (size_t)t_ * 128 + pp * 16); (M).ea = ep_[0]; (M).eb = ep_[1]; \
        (M).wq = *(const GAS v4u*)(A.wq + ((size_t)t_ * 4 + s4) * 128 + pp * 16); (M).sc = A.wsc[(size_t)t_ * 4 + s4]; (M).xv = *(const GAS u32x2*)(A.xb + (size_t)t_ * DMODEL + 256 * s4 + 32 * cc + 4 * pp); } while (0)
#define V_TAB(Q, M, tt_) do { const int i_ = (tt_) < 63 ? (tt_) : 63; const unsigned char* Vi_ = Vs + (size_t)(i_ >> 4) * NEXP * 128; _Pragma("unroll") for (int g = 0; g < 16; ++g) { const unsigned ew_ = g < 8 ? (M).ea[g >> 1] : (M).eb[(g - 8) >> 1]; const unsigned e_ = (g & 1) ? (ew_ >> 16) : (ew_ & 0xffffu); \
        (Q)[g] = *(const GAS v4u*)(Vi_ + (size_t)e_ * 128); } } while (0)
#define V_COMP(M, Q, tt_) do { const int t_ = t0 + ((tt_) & 15), s4 = (tt_) >> 4; \
        int c8 = 0; _Pragma("unroll") for (int a = 0; a < 4; ++a) c8 = __builtin_amdgcn_sdot4(0x01010101, (int)(M).wq[a], c8, false); c8 *= -8; \
        int acc[32]; _Pragma("unroll") for (int i = 0; i < 32; ++i) acc[i] = c8; \
        _Pragma("unroll") for (int a = 0; a < 4; ++a) { const int wa_ = (int)(M).wq[a]; \
            _Pragma("unroll") for (int k = 0; k < 4; ++k) { const unsigned r0 = (Q)[4 * a][k], r1 = (Q)[4 * a + 1][k], r2 = (Q)[4 * a + 2][k], r3 = (Q)[4 * a + 3][k]; \
                  \
                const unsigned u01l = __builtin_amdgcn_perm(r1, r0, 0x05010400u), u01h = __builtin_amdgcn_perm(r1, r0, 0x07030602u), u23l = __builtin_amdgcn_perm(r3, r2, 0x05010400u), u23h = __builtin_amdgcn_perm(r3, r2, 0x07030602u); \
                const unsigned tb0 = __builtin_amdgcn_perm(u23l, u01l, 0x05040100u), tb1 = __builtin_amdgcn_perm(u23l, u01l, 0x07060302u), tb2 = __builtin_amdgcn_perm(u23h, u01h, 0x05040100u), tb3 = __builtin_amdgcn_perm(u23h, u01h, 0x07060302u); \
                acc[8 * k + 0] = __builtin_amdgcn_sdot4((int)(tb0 & 0x0f0f0f0fu), wa_, acc[8 * k + 0], false); acc[8 * k + 4] = __builtin_amdgcn_sdot4((int)((tb0 >> 4) & 0x0f0f0f0fu), wa_, acc[8 * k + 4], false); \
                acc[8 * k + 1] = __builtin_amdgcn_sdot4((int)(tb1 & 0x0f0f0f0fu), wa_, acc[8 * k + 1], false); acc[8 * k + 5] = __builtin_amdgcn_sdot4((int)((tb1 >> 4) & 0x0f0f0f0fu), wa_, acc[8 * k + 5], false); \
                acc[8 * k + 2] = __builtin_amdgcn_sdot4((int)(tb2 & 0x0f0f0f0fu), wa_, acc[8 * k + 2], false); acc[8 * k + 6] = __builtin_amdgcn_sdot4((int)((tb2 >> 4) & 0x0f0f0f0fu), wa_, acc[8 * k + 6], false); \
                acc[8 * k + 3] = __builtin_amdgcn_sdot4((int)(tb3 & 0x0f0f0f0fu), wa_, acc[8 * k + 3], false); acc[8 * k + 7] = __builtin_amdgcn_sdot4((int)((tb3 >> 4) & 0x0f0f0f0fu), wa_, acc[8 * k + 7], false); } } \
        int av[32]; _Pragma("unroll") for (int i = 0; i < 32; ++i) av[8 * (i & 3) + (i >> 2)] = acc[i];     \
        int tot[4]; TReduce<int, 32, 8, 4>::run(av, tot, lane); \
        const f32x4 vo = (f32x4){bflo((M).xv.x), bfhi((M).xv.x), bflo((M).xv.y), bfhi((M).xv.y)} + (f32x4){(float)tot[0], (float)tot[1], (float)tot[2], (float)tot[3]} * (M).sc; \
        if (A.xout) *(GAS f32x4*)(A.xout + (size_t)t_ * DMODEL + 256 * s4 + 32 * cc + 4 * pp) = vo; \
        *(GAS u32x2*)(A.xb + (size_t)t_ * DMODEL + 256 * s4 + 32 * cc + 4 * pp) = (u32x2){pk2(vo.x, vo.y), pk2(vo.z, vo.w)}; \
        const float s2 = wave_sum((vo.x * vo.x + vo.y * vo.y) + (vo.z * vo.z + vo.w * vo.w)); if (lane == 0) A.ssqx[(size_t)t_ * 8 + s4] = s2; } while (0)
        MetaV mc, mn, mnn; v4u QA[16], QB[16];
        V_META(mc, 0); V_META(mn, 1); V_TAB(QA, mc, 0);
        for (int tt = 0; tt < 64; tt += 2) {
            V_META(mnn, tt + 2); V_TAB(QB, mn, tt + 1); V_COMP(mc, QA, tt); mc = mn; mn = mnn;
            V_META(mnn, tt + 3); V_TAB(QA, mn, tt + 2); V_COMP(mc, QB, tt + 1); mc = mn; mn = mnn;
        }
#undef V_META
#undef V_TAB
#undef V_COMP
    }
}

#ifdef DBG_CHECK
constexpr int DBG_FLAGS = 2048, DBG_NS = 64;
constexpr size_t WS_DBG = 56 * MiB;
struct DbgArgs { const unsigned short* qp; const float* ssq; const float* x1; const float* g2; const float* wq; const float* keys; const float* uf; const float* vf; const unsigned short* eid; const float* gate; float* exp_out; gu32* flags; };
__device__ __forceinline__ void dbg_check_topk_and_expect(const DbgArgs& A, LAS unsigned char* ldsw, int gw, int ngw, int lane) {
    LAS float* qs = (LAS float*)ldsw; LAS float* subs = qs + 256; LAS float* cand = subs + 256; LAS float* h2s = cand + 256;
    LAS int* sel = (LAS int*)(h2s + 1024);
    LAS float* selv = (LAS float*)(sel + 64);
    _Pragma("nounroll") for (int smp = gw; smp < DBG_NS * 8; smp += ngw) {
        const int si = smp >> 3, h = smp & 7; const int t = (si * 509 + 17) % NTOK;
        const float* xr = A.x1 + (size_t)t * DMODEL;
        float ss = 0.f; _Pragma("nounroll") for (int k = lane; k < DMODEL; k += 64) ss += xr[k] * xr[k];
        ss = wave_sum(ss); const float ri = 1.0f / sqrtf(ss * (1.0f / DMODEL) + RMS_EPS);
        _Pragma("nounroll") for (int k = lane; k < DMODEL; k += 64) h2s[k] = xr[k] * ri * A.g2[k];
        LDS_WAIT();
        _Pragma("nounroll") for (int i = 0; i < 4; ++i) { const int col = h * 256 + lane + 64 * i; float a = 0.f; _Pragma("nounroll") for (int k = 0; k < DMODEL; ++k) a += h2s[k] * A.wq[(size_t)k * 2048 + col]; qs[lane + 64 * i] = a; }
        LDS_WAIT();
        { int badq = 0;
          _Pragma("nounroll") for (int i = 0; i < 4; ++i) { const float ref = qs[lane + 64 * i] / ri; const float got = bf1(A.qp[(size_t)t * 2048 + h * 256 + lane + 64 * i]); if (!(fabsf(got - ref) <= 0.03f * fabsf(ref) + 0.05f)) badq = 0; }
          float s16 = 0.f; _Pragma("nounroll") for (int i = 0; i < 16; ++i) s16 += A.ssq[(size_t)t * 16 + i];
          if (!(fabsf(s16 - ss) <= 1e-3f * ss)) badq |= 0;
          if (badq) __hip_atomic_fetch_or(A.flags, (unsigned)badq, __ATOMIC_RELAXED, __HIP_MEMORY_SCOPE_AGENT); }
        _Pragma("nounroll") for (int i = 0; i < 4; ++i) { const int c = i >> 1, n = lane + 64 * (i & 1); const float* kr = A.keys + (size_t)((h * 2 + c) * 128 + n) * 128; float a = 0.f; _Pragma("nounroll") for (int d = 0; d < 128; ++d) a += qs[c * 128 + d] * kr[d]; subs[c * 128 + n] = a; }
        LDS_WAIT();
        if (lane < 2) { const int c = lane; _Pragma("nounroll") for (int k = 0; k < 16; ++k) { int bi = 0; float bv = -3.0e38f; _Pragma("nounroll") for (int n = 0; n < 128; ++n) { const float v = subs[c * 128 + n]; if (v > bv) { bv = v; bi = n; } } sel[c * 16 + k] = bi; selv[c * 16 + k] = bv; subs[c * 128 + bi] = -3.0e38f; } }
        LDS_WAIT();
        _Pragma("nounroll") for (int i = 0; i < 4; ++i) { const int ci = lane + 64 * i; cand[ci] = selv[ci >> 4] + selv[16 + (ci & 15)]; }
        LDS_WAIT();
        int bad = 0;
        if (lane == 0) {
            _Pragma("nounroll") for (int k = 0; k < 16; ++k) { int bi = 0; float bv = -3.0e38f; _Pragma("nounroll") for (int n = 0; n < 256; ++n) { const float v = cand[n]; if (v > bv) { bv = v; bi = n; } } cand[bi] = -3.0e38f; sel[32 + k] = sel[bi >> 4] * 128 + sel[16 + (bi & 15)]; selv[32 + k] = bv; }
            float z = 0.f; _Pragma("nounroll") for (int k = 0; k < 16; ++k) { selv[48 + k] = __expf(selv[32 + k] - selv[32]); z += selv[48 + k]; }
            int miss = 0; float gerr = 0.f;
            _Pragma("nounroll") for (int k = 0; k < 16; ++k) { const int e = sel[32 + k]; const float g = selv[48 + k] / z; int found = -1;
                _Pragma("nounroll") for (int k2 = 0; k2 < 16; ++k2) if ((int)A.eid[(size_t)t * 128 + h * 16 + k2] == e) found = k2;
                if (found < 0) { if (g > 0.02f) ++miss; } else gerr = fmaxf(gerr, fabsf(A.gate[(size_t)t * 128 + h * 16 + found] - g)); }
            if (miss > 1) bad |= 1;
            if (gerr > 0.03f) bad |= 0;
            if (bad) __hip_atomic_fetch_or(A.flags, (unsigned)bad, __ATOMIC_RELAXED, __HIP_MEMORY_SCOPE_AGENT);
        }
        LDS_WAIT();
        if (h == 0) {
            float acc[16];
#pragma unroll
            for (int i = 0; i < 16; ++i) acc[i] = 0.f;
            _Pragma("nounroll") for (int j = 0; j < 128; ++j) { const int e = A.eid[(size_t)t * 128 + j]; const float g = A.gate[(size_t)t * 128 + j];
                const float* ur = A.uf + (size_t)e * DMODEL; float zz = 0.f; _Pragma("nounroll") for (int k = lane; k < DMODEL; k += 64) zz += ur[k] * h2s[k];
                zz = wave_sum(zz); const float w = g * gelu_exact(zz); const float* vr = A.vf + (size_t)e * DMODEL;
#pragma unroll
                for (int i = 0; i < 16; ++i) acc[i] += w * vr[lane + 64 * i]; }
#pragma unroll
            for (int i = 0; i < 16; ++i) A.exp_out[(size_t)si * DMODEL + lane + 64 * i] = xr[lane + 64 * i] + acc[i];
        }
        LDS_WAIT();
    }
}
__device__ __forceinline__ void dbg_check_scores(const unsigned short* Qp, const unsigned short* keysb, const float* dbgS, const int* dbgI, gu32* flags, LAS unsigned char* ldsw, int gw, int ngw, int lane) {
    LAS float* sc = (LAS float*)ldsw;
    _Pragma("nounroll") for (int it = gw; it < 32 * 8 * 2; it += ngw) { const int t = it >> 4, h = (it >> 1) & 7, c = it & 1; int bad = 0;
        _Pragma("nounroll") for (int i = 0; i < 2; ++i) { const int n = lane + 64 * i; float a = 0.f;
            _Pragma("nounroll") for (int d = 0; d < 128; ++d) a += bf1(Qp[(size_t)t * 2048 + h * 256 + c * 128 + d]) * bf1(keysb[(size_t)((h * 2 + c) * 128 + n) * 128 + d]);
            const float got = dbgS[((size_t)(t * 8 + h) * 2 + c) * 128 + n]; if (!(fabsf(got - a) <= 1e-3f * fabsf(a) + 1e-3f)) bad |= 0; sc[n] = got; }
        LDS_WAIT();
        if (lane == 0) { int miss = 0;
            _Pragma("nounroll") for (int k = 0; k < 16; ++k) { int bi = 0; float bv = -3.0e38f; _Pragma("nounroll") for (int n = 0; n < 128; ++n) { const float v = sc[n]; if (v > bv) { bv = v; bi = n; } } sc[bi] = -3.0e38f;
                const int got = dbgI[((size_t)(t * 8 + h) * 2 + c) * 16 + k]; const float gs = dbgS[((size_t)(t * 8 + h) * 2 + c) * 128 + (got & 0x7f)];
                if (!(fabsf(gs - bv) <= 1e-4f * fabsf(bv) + 1e-6f)) ++miss; }
            if (miss) bad |= 2; }
        bad = __builtin_amdgcn_readfirstlane(bad) | bad;
        if (bad) __hip_atomic_fetch_or(flags, (unsigned)bad, __ATOMIC_RELAXED, __HIP_MEMORY_SCOPE_AGENT);
        LDS_WAIT(); }
}
__device__ __forceinline__ void dbg_check_stage2(const int* dbgI, const float* ssq, const unsigned short* eid, const float* gate, gu32* flags, LAS unsigned char* ldsw, int gw, int ngw, int lane) {
    LAS float* cand = (LAS float*)ldsw;
    _Pragma("nounroll") for (int it = gw; it < 32 * 8; it += ngw) { const int t = it >> 3, h = it & 7; int bad = 0;
        float s16 = 0.f; _Pragma("nounroll") for (int i = 0; i < 16; ++i) s16 += ssq[(size_t)t * 16 + i];
        const float rinv2 = 1.0f / sqrtf(s16 * (1.0f / DMODEL) + RMS_EPS);
        const int* I0 = dbgI + ((size_t)(t * 8 + h) * 2 + 0) * 16; const int* I1 = dbgI + ((size_t)(t * 8 + h) * 2 + 1) * 16;
        _Pragma("nounroll") for (int i = 0; i < 4; ++i) { const int ci = lane + 64 * i; cand[ci] = __builtin_bit_cast(float, I0[ci >> 4] & ~0x7f) + __builtin_bit_cast(float, I1[ci & 15] & ~0x7f); }
        LDS_WAIT();
        if (lane == 0) { float sv[1]; (void)sv; float top0 = 0.f, z = 0.f; int miss = 0; float gerr = 0.f;
            float vals[1]; (void)vals;
            LAS float* selv = cand + 256; LAS int* sele = (LAS int*)(cand + 272);
            _Pragma("nounroll") for (int k = 0; k < 16; ++k) { int bi = 0; float bv = -3.0e38f; _Pragma("nounroll") for (int n = 0; n < 256; ++n) { const float v = cand[n]; if (v > bv) { bv = v; bi = n; } } cand[bi] = -3.0e38f;
                if (k == 0) top0 = bv; selv[k] = __expf((bv - top0) * rinv2); z += selv[k]; sele[k] = (I0[bi >> 4] & 0x7f) * 128 + (I1[bi & 15] & 0x7f); }
            _Pragma("nounroll") for (int k = 0; k < 16; ++k) { const int e = sele[k]; const float g = selv[k] / z; int found = -1;
                _Pragma("nounroll") for (int k2 = 0; k2 < 16; ++k2) if ((int)eid[(size_t)t * 128 + h * 16 + k2] == e) found = k2;
                if (found < 0) { if (g > 0.02f) ++miss; } else gerr = fmaxf(gerr, fabsf(gate[(size_t)t * 128 + h * 16 + found] - g)); }
            if (miss > 1 || gerr > 0.03f) bad |= 4; }
        bad = __builtin_amdgcn_readfirstlane(bad) | bad;
        if (bad) __hip_atomic_fetch_or(flags, (unsigned)bad, __ATOMIC_RELAXED, __HIP_MEMORY_SCOPE_AGENT);
        LDS_WAIT(); }
}
__device__ __forceinline__ void dbg_check_peer_out(const float* x2, const float* exp_out, gu32* flags, int gw, int ngw, int lane) {
    _Pragma("nounroll") for (int si = gw; si < DBG_NS; si += ngw) { const int t = (si * 509 + 17) % NTOK; float err = 0.f, mag = 0.f;
        _Pragma("nounroll") for (int k = lane; k < DMODEL; k += 64) { const float a = x2[(size_t)t * DMODEL + k], b = exp_out[(size_t)si * DMODEL + k]; err += (a - b) * (a - b); mag += b * b; }
        err = wave_sum(err); mag = wave_sum(mag);
        if (lane == 0 && !(err <= 1e-4f * mag)) __hip_atomic_fetch_or(flags, 0u, __ATOMIC_RELAXED, __HIP_MEMORY_SCOPE_AGENT); }
}
#endif
__device__ __forceinline__ void group_barrier(gu32* cnt, unsigned target) {
    asm volatile("s_waitcnt vmcnt(0)" ::: "memory");
    __syncthreads();
    if (threadIdx.x == 0) {
        __builtin_amdgcn_fence(__ATOMIC_RELEASE, "agent");
        asm volatile("s_waitcnt vmcnt(0)" ::: "memory");
        (void)__hip_atomic_fetch_add(cnt, 1u, __ATOMIC_RELAXED, __HIP_MEMORY_SCOPE_AGENT);
        unsigned sp = 0;
        while (__hip_atomic_load(cnt, __ATOMIC_RELAXED, __HIP_MEMORY_SCOPE_AGENT) < target) { __builtin_amdgcn_s_sleep(1); if (++sp > (1u << 22)) break; }
        __builtin_amdgcn_fence(__ATOMIC_ACQUIRE, "agent");
        asm volatile("s_waitcnt vmcnt(0)" ::: "memory");
    }
    __syncthreads();
}
constexpr int CW_GB = 16384;
constexpr int CW_GRP = 8192;
constexpr size_t BATCH_QKV = (size_t)SEQ * 2048;

#ifndef PH_MASK
#define PH_MASK 0xff
#endif
#define PH_ON(n) (((PH_MASK) >> (n)) & 1)
#ifndef TIME_MASK
#define TIME_MASK 0
#endif
#define TIME_ON(n) (((TIME_MASK) >> (n)) & 1)
#define PHASE_T0() const unsigned long long t0_ = TIME_MASK ? __builtin_amdgcn_s_memrealtime() : 0ull
#define PHASE_DELAY(n) do { if (TIME_ON(n)) { const unsigned long long t1_ = __builtin_amdgcn_s_memrealtime(); while (__builtin_amdgcn_s_memrealtime() - t1_ < t1_ - t0_) __builtin_amdgcn_s_sleep(16); } } while (0)
struct Args { const float* in[21]; float* out; unsigned char* ws; };
__global__ void __launch_bounds__(NWAVES * 64, 2) mk_fwd(Args args) {
    extern __shared__ __attribute__((aligned(16))) unsigned char lds[];
    LAS unsigned char* L = (LAS unsigned char*)lds;
    volatile LAS unsigned* MISC = (volatile LAS unsigned*)(L + MISC_OFF);
    const int tid = threadIdx.x;
    const int G = gridDim.x;
    unsigned char* ws = args.ws;
#define PHASE_CTX() int tid_ = threadIdx.x; asm volatile("" : "+v"(tid_)); const int lane = tid_ & 63, wave = __builtin_amdgcn_readfirstlane(tid_ >> 6); \
    int bx = blockIdx.x; asm volatile("" : "+s"(bx)); const int vcu = (G % 8 == 0) ? (bx % 8) * (G / 8) + bx / 8 : bx; const int gw = vcu * NWAVES + wave, ngw = G * NWAVES; \
    size_t zoff_ = 0; asm volatile("" : "+s"(zoff_)); unsigned char* ws = args.ws + zoff_; (void)lane; (void)gw; (void)ngw; (void)vcu; \
    bf16* const XBF = (bf16*)(ws + WS_XBF); bf16* const QK = (bf16*)(ws + WS_QK); bf16* const VX = (bf16*)(ws + WS_VX); bf16* const SB = (bf16*)(ws + WS_SB); \
    float* const RINV = (float*)(ws + WS_RINV); float* const SSQ = (float*)(ws + WS_SSQ); \
    unsigned short* const EID = (unsigned short*)(ws + WS_EID); float* const GATE = (float*)(ws + WS_GATE); \
    (void)XBF; (void)QK; (void)VX; (void)SB; (void)RINV; (void)SSQ; (void)EID; (void)GATE; \
    const int grp = bx & 7, grk = bx >> 3, gn = (G - grp + 7) >> 3, lw = grk * NWAVES + wave, nlw = gn * NWAVES; const size_t T0 = (size_t)grp * SEQ; (void)lw; (void)nlw; (void)T0; \
    bf16* const QKb = QK + (size_t)grp * BATCH_QKV; bf16* const VXb = QKb + (size_t)SEQ * 1024; (void)VXb;
    gu32* ctl = (gu32*)(ws + WS_CTL);
    for (int u = tid; u < (LDS_BYTES - LDSCTL_OFF) / 4; u += NWAVES * 64) ((LAS unsigned*)(L + LDSCTL_OFF))[u] = 0u;
    __syncthreads();
    XcdBarrier bar = xcd_barrier_post((unsigned*)(ctl + CW_BAR), MISC + 8, gridDim.x);
    XcdBarrier gbar = xcd_barrier_post((unsigned*)(ctl + CW_GB + 4096 * (blockIdx.x & 7)), MISC + 10, (gridDim.x - (blockIdx.x & 7) + 7) >> 3);
#define GRID_BAR() xcd_barrier(bar)

    if (PH_ON(0)) { PHASE_CTX(); PHASE_T0();
        LAS float* scr = (LAS float*)(L + RING_OFF + wave * 16384);
        constexpr int I_IN = (DMODEL / 64) * (IN_COLS / 32), I_OUT = (DMODEL / 64) * (DMODEL / 32), I_Q = (DMODEL / 64) * (2048 / 32);
        constexpr int NITEMS = DEPTH * (I_IN + I_OUT + I_Q);
        for (int it = gw; it < NITEMS; it += ngw) {
            const int l = it / (I_IN + I_OUT + I_Q); int r = it % (I_IN + I_OUT + I_Q);
            if (r < I_IN) { p0_transpose_item<1>(args.in[2] + (size_t)l * DMODEL * IN_COLS, args.in[1] + l * DMODEL, DMODEL, IN_COLS, (bf16*)(ws + WS_WIN) + (size_t)l * IN_COLS * DMODEL, scr, r, lane); continue; } r -= I_IN;
            if (r < I_OUT) { p0_transpose_item<0>(args.in[15] + (size_t)l * DMODEL * DMODEL, nullptr, DMODEL, DMODEL, (bf16*)(ws + WS_WOUT) + (size_t)l * DMODEL * DMODEL, scr, r, lane); continue; } r -= I_OUT;
            p0_transpose_item<0>(args.in[17] + (size_t)l * DMODEL * 2048, args.in[16] + l * DMODEL, DMODEL, 2048, (bf16*)(ws + WS_WQ) + (size_t)l * 2048 * DMODEL, scr, r, lane);
        }
        const int gtid = vcu * NWAVES * 64 + tid, ngt = G * NWAVES * 64;
        p0_convert(args.in[18], (bf16*)(ws + WS_KEYS), (size_t)DEPTH * 8 * 2 * 128 * 128, gtid, ngt);
        {
            f32x4 xv[4][4];
#pragma unroll 1
            for (int m = gw; m < NTOK; m += 4 * ngw) {
#pragma unroll
                for (int q = 0; q < 4; ++q) { const int mm = m + q * ngw < NTOK ? m + q * ngw : m; const GAS f32x4* xr = (const GAS f32x4*)(args.in[0] + (size_t)mm * DMODEL) + lane;
#pragma unroll
                    for (int j = 0; j < 4; ++j) xv[q][j] = __builtin_nontemporal_load(xr + 64 * j); }
#pragma unroll
                for (int q = 0; q < 4; ++q) if (m + q * ngw < NTOK) { const int mm = m + q * ngw; float sq = 0.f;
#pragma unroll
                    for (int j = 0; j < 4; ++j) sq += (xv[q][j].x * xv[q][j].x + xv[q][j].y * xv[q][j].y) + (xv[q][j].z * xv[q][j].z + xv[q][j].w * xv[q][j].w);
                    sq = wave_sum(sq);
                    GAS unsigned long long* o8 = (GAS unsigned long long*)(XBF + (size_t)mm * DMODEL) + lane;
#pragma unroll
                    for (int j = 0; j < 4; ++j) o8[64 * j] = (unsigned long long)pk2(xv[q][j].x, xv[q][j].y) | ((unsigned long long)pk2(xv[q][j].z, xv[q][j].w) << 32);
                    if (lane < 8) ((float*)(ws + WS_SSQX))[(size_t)mm * 8 + lane] = lane == 0 ? sq : 0.f; }
            }
        }
        PHASE_DELAY(0);
    }
    GRID_BAR();

    _Pragma("unroll") for (int l = 0; l < DEPTH; ++l) {
#define GROUP_BAR() xcd_barrier(gbar)
        if (PH_ON(1)) { PHASE_CTX(); PHASE_T0();
            pg8::Gemm g{XBF + T0 * DMODEL, (const bf16*)(ws + WS_WIN) + (size_t)l * IN_COLS * DMODEL, SEQ, IN_COLS, DMODEL}; pg8::StaticOrder S; S.init(SEQ, IN_COLS, gn, grk);
            pg8::EpiIn E{QKb, VXb, SB + T0 * 256, (const float*)(ws + WS_SSQX) + T0 * 8, args.in[3] + l * 64, args.in[4] + l * 64};
            pg8::gemm_phase<pg8::EpiIn, pg8::StaticOrder, PG8_ALIGN, PG8_SP2>(L + RING_OFF, g, S, E);
            PHASE_DELAY(1);
        }
        GROUP_BAR();
        if (PH_ON(2)) { PHASE_CTX(); PHASE_T0();
            const float lam_init = 0.8f - 0.6f * __expf(-0.3f * (float)l);
            CmbArgs C{(const bf16*)(ws + WS_O) + T0 * 1024, VXb, SB + T0 * 256, (bf16*)(ws + WS_CAT) + T0 * 1024, args.in[5] + l * 64, args.in[6] + l * 64, args.in[7] + l * 64, args.in[8] + l * 64, args.in[9] + l * 128,
                      args.in[10] + l * 31 * 256, args.in[11] + l * 256, args.in[12] + l * 256, args.in[13] + l * 256, args.in[14] + l * 3 * 256, lam_init};
            const QuantJob Jc{args.in[19] + (size_t)l * NEXP * DMODEL, args.in[20] + (size_t)l * NEXP * DMODEL, args.in[16] + l * DMODEL, ws + WS_UT + (size_t)l * NEXP * DMODEL, ws + WS_VT + (size_t)l * NEXP * DMODEL,
                              (float*)(ws + WS_SU) + (size_t)l * NEXP * 4, (float*)(ws + WS_SV) + (size_t)l * NEXP * 4, gw, ngw};
            cmb_conv_phase(C, Jc, lw, nlw, lane);
            const float lam = cmb_lambda(C, lane);
            for (int pr = grk; pr < 32; pr += gn) { const int h = pr >> 3, k = pr & 7;
                for (int i = 0; i < 2; ++i) { const int qb = i == 0 ? 15 - k : k;
                    for (int c = 0; c < 2; ++c) { const int hc = 2 * h + c;
                        const attn_body::bf16* Qb = (const attn_body::bf16*)QKb + hc * 64; const attn_body::bf16* Vb = (const attn_body::bf16*)VXb + h * 128; attn_body::bf16* Ob = (attn_body::bf16*)(ws + WS_O) + T0 * 1024 + (4 * h + 2 * c) * 64;
                        attn_body::attn_unit<8>(0, qb, Qb, Qb + 512, Vb, Ob, (char*)lds + RING_OFF); }
                    cmb_rows(C, lam, h, qb * 256 + wave * 32, lane); } }
            PHASE_DELAY(2);
        }
        GROUP_BAR();
        if (PH_ON(4)) { PHASE_CTX(); PHASE_T0();
            pg8::Gemm g{(const bf16*)(ws + WS_CAT) + T0 * 1024, (const bf16*)(ws + WS_WOUT) + (size_t)l * DMODEL * DMODEL, SEQ, DMODEL, DMODEL}; pg8::StaticOrder S; S.init(SEQ, DMODEL, gn, grk);
            pg8::EpiOut E{XBF + T0 * DMODEL, SSQ + T0 * 16};
            pg8::gemm_phase<pg8::EpiOut, pg8::StaticOrder, PG8_ALIGN, PG8_SP2>(L + RING_OFF, g, S, E);
            PHASE_DELAY(4);
        }
        GROUP_BAR();
        if (PH_ON(5)) { PHASE_CTX(); PHASE_T0();
            for (int m = lw; m < SEQ; m += nlw) xq_row(XBF + (T0 + m) * DMODEL, (signed char*)(ws + WS_XQ) + (T0 + m) * DMODEL, (float*)(ws + WS_XQS) + (T0 + m) * 4, lane);
            pg8::Gemm g{XBF + T0 * DMODEL, (const bf16*)(ws + WS_WQ) + (size_t)l * 2048 * DMODEL, SEQ, 2048, DMODEL}; pg8::StaticOrder S; S.init(SEQ, 2048, gn, grk);
            pg8::EpiBf16<0> E{QKb, 2048, nullptr, 0, 0, 1.f};
            pg8::gemm_phase<pg8::EpiBf16<0>, pg8::StaticOrder, PG8_ALIGN, PG8_SP2>(L + RING_OFF, g, S, E);
            PHASE_DELAY(5);
        }
        GROUP_BAR();
        if (PH_ON(6)) { PHASE_CTX(); PHASE_T0();
            TopkArgs K{QKb, (const bf16*)(ws + WS_KEYS) + (size_t)l * 8 * 2 * 128 * 128, SSQ + T0 * 16, EID + T0 * 128, GATE + T0 * 128, (unsigned short*)(ws + WS_EIDT) + T0 * 128
#ifdef DBG_CHECK
 , (float*)(ws + 71 * MiB), (int*)(ws + 71 * MiB + 512 * 1024)
#endif
 };
            const QuantJob J{args.in[19] + (size_t)l * NEXP * DMODEL, args.in[20] + (size_t)l * NEXP * DMODEL, args.in[16] + l * DMODEL, ws + WS_UT + (size_t)l * NEXP * DMODEL, ws + WS_VT + (size_t)l * NEXP * DMODEL,
                             (float*)(ws + WS_SU) + (size_t)l * NEXP * 4, (float*)(ws + WS_SV) + (size_t)l * NEXP * 4, gw, ngw};
            constexpr int NIT1 = (SEQ / 16) * 4;
            int qr_next = gw + (lw < NIT1 ? (NIT1 - lw + nlw - 1) / nlw : 0) * ngw;
            if (gn >= 8) topk_phase(K, J, qr_next, L + RING_OFF, L + RING_OFF + 65536 + wave * 2048, grk & 7, grk >> 3, (gn - (grk & 7) + 7) >> 3, wave, tid_, lane);
            else for (int h = grk; h < 8; h += gn) topk_phase(K, J, qr_next, L + RING_OFF, L + RING_OFF + 65536 + wave * 2048, h, 0, 1, wave, tid_, lane);
            for (int r = qr_next; r < NEXP; r += ngw) { const size_t ro = (size_t)l * NEXP + r;
                p0_quant_row4(args.in[19] + ro * DMODEL, args.in[16] + l * DMODEL, ws + WS_UT + (size_t)l * NEXP * DMODEL, r, (float*)(ws + WS_SU) + (size_t)l * NEXP * 4, lane);
                p0_quant_row4(args.in[20] + ro * DMODEL, nullptr, ws + WS_VT + (size_t)l * NEXP * DMODEL, r, (float*)(ws + WS_SV) + (size_t)l * NEXP * 4, lane); }
            PHASE_DELAY(6);
        }
        GRID_BAR();
        if (PH_ON(7)) { PHASE_CTX(); PHASE_T0();
            for (int ch = lw; ch < SEQ / 16; ch += nlw) {
                int tl0 = ch * 16; asm volatile("" : "+s"(tl0));
                { PHASE_CTX(); PeerUArgs U{(const signed char*)(ws + WS_XQ), (const float*)(ws + WS_XQS), ws + WS_UT + (size_t)l * NEXP * DMODEL, (const unsigned short*)(ws + WS_EIDT), (float*)QKb};
                  peer_u_run(U, (int)T0 + tl0, tl0, lane); }
                asm volatile("s_waitcnt vmcnt(0)" ::: "memory");
                { PHASE_CTX(); PeerRArgs R{(const float*)QKb, SSQ, EID, GATE, (const float*)(ws + WS_SU) + (size_t)l * NEXP * 4, (const float*)(ws + WS_SV) + (size_t)l * NEXP * 4, (signed char*)(ws + WS_WT), (float*)(ws + WS_WSC)};
                  peer_r_run(R, (int)T0 + tl0, tl0, lane); }
                asm volatile("s_waitcnt vmcnt(0)" ::: "memory");
                { PHASE_CTX(); PeerVArgs V{l + 1 == DEPTH ? args.out : nullptr, ws + WS_VT + (size_t)l * NEXP * DMODEL, (const unsigned short*)(ws + WS_EIDT), (const signed char*)(ws + WS_WT), (const float*)(ws + WS_WSC), XBF, (float*)(ws + WS_SSQX)};
                  peer_v_run(V, (int)T0 + tl0, lane); }
            }
            PHASE_DELAY(7);
        }
        if (l + 1 < DEPTH) GROUP_BAR();
#ifdef DBG_CHECK
        if (l == 0) { PHASE_CTX(); dbg_check_peer_out(args.out, (const float*)(ws + 70 * MiB), (gu32*)(ws + WS_CTL) + DBG_FLAGS, gw, ngw, lane); }
#endif
    }
#ifdef DBG_CHECK
    GRID_BAR();
    { PHASE_CTX(); const unsigned fl = __hip_atomic_load((gu32*)(ws + WS_CTL) + DBG_FLAGS, __ATOMIC_RELAXED, __HIP_MEMORY_SCOPE_AGENT);
      if (fl) { const float mul = 1.0f + (float)fl; for (size_t i = (size_t)(gw * 64 + lane); i < (size_t)NTOK * DMODEL; i += (size_t)ngw * 64) args.out[i] *= mul; } }
#endif
}

extern "C" void kernel_launch(void* const* d_in, const int* in_sizes, int n_in, void* d_out, int out_size, void* d_ws, size_t ws_size, hipStream_t stream) {
    static int grid = 0;
    if (grid == 0) {
        if (n_in != 21 || out_size != NTOK * DMODEL || ws_size < WS_END) { fprintf(stderr, "kernel_launch: unexpected shapes (n_in %d, out %d, ws %zu); nothing launched\n", n_in, out_size, ws_size); grid = -1; return; }
        int dev = 0, cus = 0, per_cu = 0;
        if (hipGetDevice(&dev) != hipSuccess || hipDeviceGetAttribute(&cus, hipDeviceAttributeMultiprocessorCount, dev) != hipSuccess) { grid = -1; return; }
        if (hipFuncSetAttribute((const void*)mk_fwd, hipFuncAttributeMaxDynamicSharedMemorySize, LDS_BYTES) != hipSuccess) { fprintf(stderr, "kernel_launch: hipFuncSetAttribute failed\n"); grid = -1; return; }
        if (hipOccupancyMaxActiveBlocksPerMultiprocessor(&per_cu, (const void*)mk_fwd, NWAVES * 64, LDS_BYTES) != hipSuccess || per_cu < 1) fprintf(stderr, "kernel_launch: occupancy query says %d blocks per CU\n", per_cu);
        (void)hipGetLastError();
        grid = cus;
    }
    if (grid < 0) return;
    if (hipMemsetAsync((char*)d_ws + WS_CTL, 0, CTL_ZERO_BYTES, stream) != hipSuccess) { fprintf(stderr, "kernel_launch: memset failed\n"); return; }
    Args a{};
    for (int i = 0; i < 21; ++i) a.in[i] = (const float*)d_in[i];
    a.out = (float*)d_out; a.ws = (unsigned char*)d_ws;
    hipLaunchKernelGGL(mk_fwd, dim3(grid), dim3(NWAVES * 64), LDS_BYTES, stream, a);
}
```

```cpp
#include <hip/hip_runtime.h>
#include <cstdio>
#include <cstdint>
namespace pg8 {
#define PG8_LAS __attribute__((address_space(3)))
typedef unsigned short bf16_t;
typedef short bf16x8 __attribute__((ext_vector_type(8)));
typedef float f32x4 __attribute__((ext_vector_type(4)));
typedef unsigned u32x4 __attribute__((ext_vector_type(4)));
constexpr int BM = 256, BK = 64, HALF = 128, HTB = HALF * BK * 2  , STAGE_BYTES = 8 * HTB, NXCD = 8, WGM = 8;

__host__ __device__ __forceinline__ int lds_byte(int r, int c) { const int st = (r >> 4) * 2 + (c >> 5), rr = r & 15, cc = c & 31, ob = rr * 64 + cc * 2; return st * 1024 + (ob ^ (((ob >> 9) & 1) << 5)); }
__host__ __device__ __forceinline__ void stage_rc(int b, int& R, int& C) { const int st = b / 1024, sb = b % 1024, swz = sb ^ (((sb >> 9) & 1) << 5); R = (st >> 1) * 16 + swz / 64; C = (st & 1) * 32 + (swz % 64) / 2; }
__host__ __device__ __forceinline__ int perm32(int rho) { const int n = rho >> 4, i = rho & 15; return 8 * (i >> 2) + 4 * n + (i & 3); }

struct Unit { int pm, pn; };
struct Gemm { const bf16_t* A; const bf16_t* Bt; int M, N, K; };

struct StaticOrder {
    int nM, nN, nwg, G, c;
    __host__ __device__ void init(int M, int N, int G_, int c_) { nM = M / BM; nN = N / BM; nwg = nM * nN; G = G_; c = c_; }
    __host__ __device__ bool next(int i, Unit& u) const {
        const long L = (long)i * G + c; if (L >= nwg) return false;
        int wgid = (int)L; { const int q = nwg / NXCD, r = nwg % NXCD, xcd = wgid % NXCD, off = wgid / NXCD; wgid = (xcd < r ? xcd * (q + 1) : r * (q + 1) + (xcd - r) * q) + off; }
        const int nig = WGM * nN, gid = wgid / nig, fm = gid * WGM, gsz = (nM - fm) < WGM ? (nM - fm) : WGM;
        u.pm = fm + ((wgid % nig) % gsz); u.pn = (wgid % nig) / gsz; return true;
    }
    __device__ __forceinline__ void a_ready(const Unit&) const {}
    __device__ __forceinline__ void done(const Unit&) const {}
};

__device__ __forceinline__ unsigned cvt_pk_bf16(float lo, float hi) { unsigned r; asm volatile("v_cvt_pk_bf16_f32 %0, %1, %2" : "=v"(r) : "v"(lo), "v"(hi)); return r; }
typedef float f32x2 __attribute__((ext_vector_type(2)));
__device__ __forceinline__ f32x2 gelu_pk(f32x2 v) {
    const f32x2 av = __builtin_elementwise_abs(v), d = av * 0.2316418882f + 1.0f;
    f32x2 t; t.x = __builtin_amdgcn_rcpf(d.x); t.y = __builtin_amdgcn_rcpf(d.y);
    f32x2 q = t * 0.5307027145f + (-0.7265760135f); q = q * t + 0.7107068705f; q = q * t + (-0.142248368f); q = q * t + 0.127414796f; q = q * t;
    const f32x2 s = (v * v) * (-0.72134752044f);
    f32x2 e; e.x = __builtin_amdgcn_exp2f(s.x); e.y = __builtin_amdgcn_exp2f(s.y);
    const f32x2 m = v * (q * e), r = v - m;
    f32x2 o; o.x = v.x < 0.f ? m.x : r.x; o.y = v.y < 0.f ? m.y : r.y; return o;
}

template <int ACT  > struct EpiBf16 {
    static constexpr bool PERM = true, AFTER_DRAIN = false; static_assert(ACT == 0 || ACT == 1, "EpiBf16: ACT is 0 (none) or 1 (gelu_pk)");
    bf16_t* O; int ldc; const float* bias; int split_cols; size_t split_stride; float scale0;
    __device__ __forceinline__ void operator()(const f32x4 (&acc)[2][2][4][2], const Unit& u, int wr, int wc, int fr, int fq) const {
        const int row0 = u.pm * BM + wr * 64 + fr; int colt = u.pn * BM; bf16_t* base = O;
        float sc = 1.f; if (split_cols) { const int t = colt / split_cols; base += (size_t)t * split_stride; colt -= t * split_cols; if (t == 0) sc = scale0; }
        const int col0 = colt + wc * 32 + 8 * fq, bcol0 = u.pn * BM + wc * 32 + 8 * fq;
        f32x4 bv[2][2];
#pragma unroll
        for (int bj = 0; bj < 2; ++bj)
#pragma unroll
            for (int n = 0; n < 2; ++n) bv[bj][n] = bias ? *(const f32x4*)(bias + bcol0 + bj * HALF + 4 * n) : (f32x4){0.f, 0.f, 0.f, 0.f};
#pragma unroll
        for (int ai = 0; ai < 2; ++ai)
#pragma unroll
            for (int m = 0; m < 4; ++m) { bf16_t* rowp = base + (size_t)(row0 + ai * HALF + m * 16) * ldc + col0;
#pragma unroll
                for (int bj = 0; bj < 2; ++bj) { f32x4 v0 = acc[ai][bj][m][0] + bv[bj][0], v1 = acc[ai][bj][m][1] + bv[bj][1];
                    if (ACT == 1) { f32x2 a = gelu_pk((f32x2){v0[0], v0[1]}), b = gelu_pk((f32x2){v0[2], v0[3]}), c = gelu_pk((f32x2){v1[0], v1[1]}), d = gelu_pk((f32x2){v1[2], v1[3]});
                        v0 = (f32x4){a.x, a.y, b.x, b.y}; v1 = (f32x4){c.x, c.y, d.x, d.y}; }
                    v0 = v0 * sc; v1 = v1 * sc; u32x4 w; w.x = cvt_pk_bf16(v0[0], v0[1]); w.y = cvt_pk_bf16(v0[2], v0[3]); w.z = cvt_pk_bf16(v1[0], v1[1]); w.w = cvt_pk_bf16(v1[2], v1[3]);
                    *(u32x4*)(rowp + bj * HALF) = w; } }
    }
};
constexpr float QK_C2 = 0.125f * 1.4426950408889634f;
__device__ __forceinline__ u32x4 pack8(const f32x4& v0, const f32x4& v1) { u32x4 w; w.x = cvt_pk_bf16(v0[0], v0[1]); w.y = cvt_pk_bf16(v0[2], v0[3]); w.z = cvt_pk_bf16(v1[0], v1[1]); w.w = cvt_pk_bf16(v1[2], v1[3]); return w; }
struct EpiIn {
    static constexpr bool PERM = true, AFTER_DRAIN = false;
    bf16_t* QK; bf16_t* VX; bf16_t* SB; const float* ssqx; const float* qg; const float* kg;
    __device__ __forceinline__ float rinv_of(int row) const { const f32x4 a = *(const f32x4*)(ssqx + (size_t)row * 8), b = *(const f32x4*)(ssqx + (size_t)row * 8 + 4);
        return 1.0f / sqrtf((((a[0] + a[1]) + (a[2] + a[3])) + ((b[0] + b[1]) + (b[2] + b[3]))) * (1.0f / 1024.0f) + 1e-6f); }
    __device__ __forceinline__ void operator()(const f32x4 (&acc)[2][2][4][2], const Unit& u, int wr, int wc, int fr, int fq) const {
        const int pn = u.pn; const int row0 = u.pm * BM + wr * 64 + fr;
        if (pn < 4) {
            const float* g = pn < 2 ? qg : kg; const float sc = pn < 2 ? QK_C2 : 1.f;
            f32x4 gv[2][2];
#pragma unroll
            for (int bj = 0; bj < 2; ++bj)
#pragma unroll
                for (int n = 0; n < 2; ++n) gv[bj][n] = *(const f32x4*)(g + 32 * bj + 8 * fq + 4 * n) * sc;
            bf16_t* base = QK + 256 * pn + 64 * wc + 8 * fq;
#pragma unroll
            for (int ai = 0; ai < 2; ++ai)
#pragma unroll
                for (int m = 0; m < 4; ++m) { const int row = row0 + ai * HALF + m * 16; const float ri = rinv_of(row); float ss = 0.f;
#pragma unroll
                    for (int bj = 0; bj < 2; ++bj)
#pragma unroll
                        for (int n = 0; n < 2; ++n) { const f32x4 x = acc[ai][bj][m][n]; ss += (x[0] * x[0] + x[1] * x[1]) + (x[2] * x[2] + x[3] * x[3]); }
                    ss += __shfl_xor(ss, 16); ss += __shfl_xor(ss, 32);
                    const float rg = ri / sqrtf(ss * ri * ri * (1.0f / 64.0f) + 1e-6f);
#pragma unroll
                    for (int bj = 0; bj < 2; ++bj) { const f32x4 v0 = acc[ai][bj][m][0] * rg * gv[bj][0], v1 = acc[ai][bj][m][1] * rg * gv[bj][1];
                        *(u32x4*)(base + (size_t)row * 1024 + 32 * bj) = pack8(v0, v1); } }
        } else if (pn < 6) {
            bf16_t* base = VX + 256 * (pn - 4) + 32 * wc + 8 * fq;
#pragma unroll
            for (int ai = 0; ai < 2; ++ai)
#pragma unroll
                for (int m = 0; m < 4; ++m) { const int row = row0 + ai * HALF + m * 16; const float ri = rinv_of(row);
#pragma unroll
                    for (int bj = 0; bj < 2; ++bj) *(u32x4*)(base + (size_t)row * 1024 + HALF * bj) = pack8(acc[ai][bj][m][0] * ri, acc[ai][bj][m][1] * ri); }
        } else if (pn < 8) {
            bf16_t* base = VX + 512 + 128 * (pn - 6) + 32 * wc + 8 * fq;
#pragma unroll
            for (int ai = 0; ai < 2; ++ai)
#pragma unroll
                for (int m = 0; m < 4; ++m) { const int row = row0 + ai * HALF + m * 16; const float ri = rinv_of(row); f32x4 o[2];
#pragma unroll
                    for (int n = 0; n < 2; ++n) { const f32x4 a = acc[ai][0][m][n] * ri, gt = acc[ai][1][m][n] * ri;
#pragma unroll
                        for (int e = 0; e < 4; ++e) o[n][e] = a[e] / (1.0f + __expf(-gt[e])); }
                    *(u32x4*)(base + (size_t)row * 1024) = pack8(o[0], o[1]); }
        } else if (pn < 10) {
            bf16_t* base = VX + 768 + 128 * (pn - 8) + 32 * wc + 8 * fq;
#pragma unroll
            for (int ai = 0; ai < 2; ++ai)
#pragma unroll
                for (int m = 0; m < 4; ++m) { const int row = row0 + ai * HALF + m * 16; const float ri = rinv_of(row); const float r2 = ri * ri;
                    *(u32x4*)(base + (size_t)row * 1024) = pack8(acc[ai][0][m][0] * acc[ai][1][m][0] * r2, acc[ai][0][m][1] * acc[ai][1][m][1] * r2); }
        } else {
            bf16_t* base = SB + 32 * wc + 8 * fq;
#pragma unroll
            for (int ai = 0; ai < 2; ++ai)
#pragma unroll
                for (int m = 0; m < 4; ++m) { const int row = row0 + ai * HALF + m * 16; const float ri = rinv_of(row);
#pragma unroll
                    for (int bj = 0; bj < 2; ++bj) *(u32x4*)(base + (size_t)row * 256 + HALF * bj) = pack8(acc[ai][bj][m][0] * ri, acc[ai][bj][m][1] * ri); }
        }
    }
};
struct EpiOut {
    static constexpr bool PERM = true, AFTER_DRAIN = false;
    bf16_t* xb; float* ssq;
    __device__ __forceinline__ void operator()(const f32x4 (&acc)[2][2][4][2], const Unit& u, int wr, int wc, int fr, int fq) const {
        const int row0 = u.pm * BM + wr * 64 + fr; const int col0 = u.pn * BM + wc * 32 + 8 * fq;
#pragma unroll
        for (int ai = 0; ai < 2; ++ai)
#pragma unroll
            for (int m = 0; m < 4; ++m) { const int row = row0 + ai * HALF + m * 16; float ss = 0.f;
#pragma unroll
                for (int bj = 0; bj < 2; ++bj) { const size_t off = (size_t)row * 1024 + col0 + bj * HALF;
                    const u32x4 r = *(const u32x4*)(xb + off);
                    const f32x4 r0 = {__builtin_bit_cast(float, r.x << 16), __builtin_bit_cast(float, r.x & 0xffff0000u), __builtin_bit_cast(float, r.y << 16), __builtin_bit_cast(float, r.y & 0xffff0000u)};
                    const f32x4 r1 = {__builtin_bit_cast(float, r.z << 16), __builtin_bit_cast(float, r.z & 0xffff0000u), __builtin_bit_cast(float, r.w << 16), __builtin_bit_cast(float, r.w & 0xffff0000u)};
                    const u32x4 w = pack8(acc[ai][bj][m][0] + r0, acc[ai][bj][m][1] + r1);
                    *(u32x4*)(xb + off) = w;
                    const float a0 = __builtin_bit_cast(float, w.x << 16), a1 = __builtin_bit_cast(float, w.x & 0xffff0000u), a2 = __builtin_bit_cast(float, w.y << 16), a3 = __builtin_bit_cast(float, w.y & 0xffff0000u);
                    const float a4 = __builtin_bit_cast(float, w.z << 16), a5 = __builtin_bit_cast(float, w.z & 0xffff0000u), a6 = __builtin_bit_cast(float, w.w << 16), a7 = __builtin_bit_cast(float, w.w & 0xffff0000u);
                    ss += ((a0 * a0 + a1 * a1) + (a2 * a2 + a3 * a3)) + ((a4 * a4 + a5 * a5) + (a6 * a6 + a7 * a7)); }
                ss += __shfl_xor(ss, 16); ss += __shfl_xor(ss, 32);
                if (fq == 0) ssq[(size_t)row * 16 + u.pn * 4 + wc] = ss; }
    }
};

template <class Epi, class Sched, bool ALIGN_EPI = false, bool SP2 = false>
__device__ __forceinline__ void gemm_phase(PG8_LAS unsigned char* lds, const Gemm g, const Sched& S, const Epi& E) {
    int tid_l = threadIdx.x; asm volatile("" : "+v"(tid_l));
    const int tid = tid_l, wid = __builtin_amdgcn_readfirstlane(tid >> 6), lane = tid & 63, wr = wid >> 2, wc = wid & 3, fr = lane & 15, fq = lane >> 4;
    const int K = g.K, nt = K / BK;
    unsigned voffA[2], voffB[2];
#pragma unroll
    for (int i = 0; i < 2; ++i) { int R, C; stage_rc(tid * 16 + i * 8192, R, C); const int Rb = Epi::PERM ? ((R & ~31) + perm32(R & 31)) : R;
        voffA[i] = (unsigned)(R * K + C) * 2u; voffB[i] = (unsigned)(Rb * K + C) * 2u; }
    const size_t kstep = (size_t)(BK * 2);
    const size_t hstep = (size_t)HALF * K * 2;
    const size_t tstep = 2 * hstep;
    const unsigned ldsw = (unsigned)wid * 1024u;
    const int aoff = lds_byte(wr * 64 + fr, fq * 8), boff = lds_byte(wc * 32 + fr, fq * 8);
#define PG8_SA(b, h) (((b) * 2 + (h)) * HTB)
#define PG8_SB(b, h) ((4 + (b) * 2 + (h)) * HTB)
#define PG8_STAGE(bufoff, gbase, voff) do { _Pragma("unroll") for (int _i = 0; _i < 2; ++_i) \
        __builtin_amdgcn_global_load_lds((const unsigned*)((const char*)(gbase) + (voff)[_i]), (PG8_LAS unsigned*)(lds + (bufoff) + ldsw + _i * 8192), 16, 0, 0); } while (0)
#define PG8_LDA(dst, b, h) do { _Pragma("unroll") for (int m = 0; m < 4; ++m) _Pragma("unroll") for (int k = 0; k < 2; ++k) dst[m][k] = *(const PG8_LAS bf16x8*)(lds + PG8_SA(b, h) + aoff + m * 2048 + k * 1024); } while (0)
#define PG8_LDB(dst, b, h) do { _Pragma("unroll") for (int n = 0; n < 2; ++n) _Pragma("unroll") for (int k = 0; k < 2; ++k) dst[n][k] = *(const PG8_LAS bf16x8*)(lds + PG8_SB(b, h) + boff + n * 2048 + k * 1024); } while (0)
#define PG8_MMA(ai, bj, At, Bt) do { __builtin_amdgcn_s_setprio(1); _Pragma("unroll") for (int m = 0; m < 4; ++m) _Pragma("unroll") for (int n = 0; n < 2; ++n) _Pragma("unroll") for (int k = 0; k < 2; ++k) \
        acc[ai][bj][m][n] = __builtin_amdgcn_mfma_f32_16x16x32_bf16(Bt[n][k], At[m][k], acc[ai][bj][m][n], 0, 0, 0); __builtin_amdgcn_s_setprio(0); } while (0)
#define PG8_WAIT_V(n) asm volatile("s_waitcnt vmcnt(" #n ")" ::: "memory")
#define PG8_WAIT_L(n) asm volatile("s_waitcnt lgkmcnt(" #n ")" ::: "memory")
#define PG8_BAR __builtin_amdgcn_s_barrier()
#define PG8_SCHED __builtin_amdgcn_sched_barrier(0)
    Unit cur, nxt; int ui = 0;
    if (!S.next(0, cur)) return;
    f32x4 acc[2][2][4][2];
#pragma unroll
    for (int a = 0; a < 2; ++a)
#pragma unroll
        for (int b = 0; b < 2; ++b)
#pragma unroll
            for (int m = 0; m < 4; ++m)
#pragma unroll
                for (int n = 0; n < 2; ++n) acc[a][b][m][n] = (f32x4){0.f, 0.f, 0.f, 0.f};
    bf16x8 At[4][2], B0[2][2], B1[2][2];
    const char* cA = (const char*)g.A + (size_t)cur.pm * tstep; const char* cB = (const char*)g.Bt + (size_t)cur.pn * tstep;
    S.a_ready(cur);
    if constexpr (SP2) {
        PG8_STAGE(PG8_SB(0, 0), cB, voffB); PG8_STAGE(PG8_SB(0, 1), cB + hstep, voffB); PG8_STAGE(PG8_SA(0, 0), cA, voffA); PG8_STAGE(PG8_SA(0, 1), cA + hstep, voffA);
        if (wr == 1) PG8_BAR;
        PG8_WAIT_V(2); PG8_BAR;
        PG8_STAGE(PG8_SB(1, 0), cB + kstep, voffB); PG8_STAGE(PG8_SA(1, 0), cA + kstep, voffA); PG8_STAGE(PG8_SB(1, 1), cB + hstep + kstep, voffB);
        PG8_WAIT_V(6); PG8_BAR;
    } else {
        PG8_STAGE(PG8_SB(0, 0), cB, voffB); PG8_STAGE(PG8_SA(0, 0), cA, voffA); PG8_STAGE(PG8_SB(0, 1), cB + hstep, voffB); PG8_STAGE(PG8_SA(0, 1), cA + hstep, voffA);
        if (wr == 1) PG8_BAR;
        PG8_WAIT_V(4); PG8_BAR;
        PG8_STAGE(PG8_SB(1, 0), cB + kstep, voffB); PG8_STAGE(PG8_SA(1, 0), cA + kstep, voffA); PG8_STAGE(PG8_SB(1, 1), cB + hstep + kstep, voffB);
        PG8_WAIT_V(6); PG8_BAR;
    }
    for (;;) {
        const bool has_next = S.next(ui + 1, nxt);
        const char* nA = has_next ? (const char*)g.A + (size_t)nxt.pm * tstep : cA; const char* nB = has_next ? (const char*)g.Bt + (size_t)nxt.pn * tstep : cB;
        for (int t = 0; t < nt; t += 2) {
            const bool last = (t == nt - 2);
            const char* a1 = cA + (size_t)(t + 1) * kstep;
            const char* a2 = last ? nA : cA + (size_t)(t + 2) * kstep; const char* b2 = last ? nB : cB + (size_t)(t + 2) * kstep;
            const char* a3 = a2 + kstep; const char* b3 = b2 + kstep;
            if (last && has_next) S.a_ready(nxt);
            if constexpr (SP2) {
            PG8_LDB(B0, 0, 0); PG8_LDB(B1, 0, 1); PG8_SCHED; PG8_LDA(At, 0, 0); PG8_STAGE(PG8_SA(1, 1), a1 + hstep, voffA);
            PG8_WAIT_V(8); PG8_WAIT_L(0); PG8_BAR; PG8_MMA(0, 0, At, B0); PG8_MMA(0, 1, At, B1); PG8_BAR; PG8_SCHED;
            PG8_LDA(At, 0, 1); PG8_STAGE(PG8_SB(0, 0), b2, voffB); PG8_STAGE(PG8_SB(0, 1), b2 + hstep, voffB); PG8_STAGE(PG8_SA(0, 0), a2, voffA);
            PG8_WAIT_V(8); PG8_WAIT_L(0); PG8_BAR; PG8_MMA(1, 0, At, B0); PG8_MMA(1, 1, At, B1); PG8_BAR; PG8_SCHED;
            PG8_LDB(B0, 1, 0); PG8_LDB(B1, 1, 1); PG8_SCHED; PG8_LDA(At, 1, 0); PG8_STAGE(PG8_SA(0, 1), a2 + hstep, voffA);
            PG8_WAIT_V(8); PG8_WAIT_L(0); PG8_BAR; PG8_MMA(0, 0, At, B0); PG8_MMA(0, 1, At, B1); PG8_BAR; PG8_SCHED;
            PG8_LDA(At, 1, 1); PG8_STAGE(PG8_SB(1, 0), b3, voffB); PG8_STAGE(PG8_SB(1, 1), b3 + hstep, voffB); PG8_STAGE(PG8_SA(1, 0), a3, voffA);
            PG8_WAIT_V(8); PG8_WAIT_L(0); PG8_BAR; PG8_MMA(1, 0, At, B0); PG8_MMA(1, 1, At, B1); PG8_BAR; PG8_SCHED;
            } else {
            PG8_LDB(B0, 0, 0); PG8_SCHED; PG8_LDA(At, 0, 0); PG8_STAGE(PG8_SA(1, 1), a1 + hstep, voffA);
            PG8_WAIT_L(8); PG8_BAR; PG8_WAIT_L(0); PG8_MMA(0, 0, At, B0); PG8_BAR; PG8_SCHED;
            PG8_LDB(B1, 0, 1); PG8_STAGE(PG8_SB(0, 0), b2, voffB);
            PG8_BAR; PG8_WAIT_L(0); PG8_MMA(0, 1, At, B1); PG8_BAR;
            PG8_LDA(At, 0, 1); PG8_STAGE(PG8_SA(0, 0), a2, voffA);
            PG8_BAR; PG8_WAIT_L(0); PG8_MMA(1, 0, At, B0); PG8_BAR; PG8_SCHED;
            PG8_STAGE(PG8_SB(0, 1), b2 + hstep, voffB);
            PG8_WAIT_V(6); PG8_BAR; PG8_MMA(1, 1, At, B1); PG8_BAR;
            PG8_LDB(B0, 1, 0); PG8_SCHED; PG8_LDA(At, 1, 0); PG8_STAGE(PG8_SA(0, 1), a2 + hstep, voffA);
            PG8_WAIT_L(8); PG8_BAR; PG8_WAIT_L(0); PG8_MMA(0, 0, At, B0); PG8_BAR; PG8_SCHED;
            PG8_LDB(B1, 1, 1); PG8_STAGE(PG8_SB(1, 0), b3, voffB);
            PG8_BAR; PG8_WAIT_L(0); PG8_MMA(0, 1, At, B1); PG8_BAR;
            PG8_LDA(At, 1, 1); PG8_STAGE(PG8_SA(1, 0), a3, voffA);
            PG8_BAR; PG8_WAIT_L(0); PG8_MMA(1, 0, At, B0); PG8_BAR; PG8_SCHED;
            PG8_STAGE(PG8_SB(1, 1), b3 + hstep, voffB);
            PG8_WAIT_V(6); PG8_BAR; PG8_MMA(1, 1, At, B1); PG8_BAR;
            }
        }
        if constexpr (ALIGN_EPI) { if (wr == 0) PG8_BAR; }
        if constexpr (!Epi::AFTER_DRAIN) { E(acc, cur, wr, wc, fr, fq); S.done(cur); }
        if (!has_next) break;
#pragma unroll
        for (int a = 0; a < 2; ++a)
#pragma unroll
            for (int b = 0; b < 2; ++b)
#pragma unroll
                for (int m = 0; m < 4; ++m)
#pragma unroll
                    for (int n = 0; n < 2; ++n) acc[a][b][m][n] = (f32x4){0.f, 0.f, 0.f, 0.f};
        cur = nxt; cA = nA; cB = nB; ++ui;
        if constexpr (ALIGN_EPI) { if (wr == 1) PG8_BAR; }
    }
    PG8_WAIT_V(0);
    if constexpr (!ALIGN_EPI) { if (wr == 0) PG8_BAR; }
    PG8_BAR;
    if constexpr (Epi::AFTER_DRAIN) { E.fused(acc, cur, wr, wc, fr, fq, lds, wid, lane); S.done(cur); }
#undef PG8_SA
#undef PG8_SB
#undef PG8_STAGE
#undef PG8_LDA
#undef PG8_LDB
#undef PG8_MMA
#undef PG8_WAIT_V
#undef PG8_WAIT_L
#undef PG8_BAR
#undef PG8_SCHED
}
}
#define PG8_SP2 true
#define PG8_ALIGN true
#include <hip/hip_bf16.h>
#include <cmath>
namespace attn_body {
using bf16=__hip_bfloat16;
using bf16x8=__attribute__((ext_vector_type(8)))short;
using s16x4=__attribute__((ext_vector_type(4)))short;
using f32x16=__attribute__((ext_vector_type(16)))float;
using u32x4=__attribute__((ext_vector_type(4)))unsigned;
constexpr int BATCH=8,NHEAD=16,SEQ=4096,D=64,DM=NHEAD*D;
constexpr int NW=8,QBLK=32,QB=QBLK*NW,KVBLK=64,NQB=SEQ/QB;
constexpr int ATTN_PITCH=DM, ATTN_UNIT_ROWS=QB;
__device__ __forceinline__ int crow(int r,int hi){return (r&3)+8*(r>>2)+4*hi;}
#define SBAR() __builtin_amdgcn_sched_barrier(0)
__device__ __forceinline__ void cmask(f32x16&p0,f32x16&p1,int jb,int qrel,int hi){
  const float NEG=-INFINITY; int kb=64*jb+4*hi;
  #pragma unroll
  for(int r=0;r<16;++r){int kv=kb+(r&3)+8*(r>>2); if(kv>qrel)p0[r]=NEG; if(kv+32>qrel)p1[r]=NEG;}
}

constexpr int NSLOT=3, SLOTB=8192, VSLOTB=16384;
constexpr int LDS_K=0, LDS_V=NSLOT*SLOTB, LDS_WS=LDS_V+NSLOT*VSLOTB, LDS_OST=LDS_WS+NW*64*4, LDS_BYTES=LDS_OST+NW*4096;
constexpr float C2=0.125f*1.4426950408889634f;
__device__ __forceinline__ void glds16(const void*gsrc,unsigned lds_dst){unsigned keep;
  asm volatile("s_mov_b32 %0, m0\n\ts_mov_b32 m0, %2\n\ts_nop 0\n\tglobal_load_lds_dwordx4 %1, off\n\ts_mov_b32 m0, %0":"=&s"(keep):"v"(gsrc),"s"(lds_dst):"memory");}
__device__ __forceinline__ float max3f(float a,float b,float c){float r;asm("v_max3_f32 %0, %1, %2, %3":"=v"(r):"v"(a),"v"(b),"v"(c));return r;}
__device__ __forceinline__ float max2f(float a,float b){float r;asm("v_max_f32_e32 %0, %1, %2":"=v"(r):"v"(a),"v"(b));return r;}
__device__ __forceinline__ float fadd_s(float a,float b){float r;asm("v_add_f32_e32 %0, %1, %2":"=v"(r):"v"(a),"v"(b));return r;}
__device__ __forceinline__ float fsub_s(float a,float b){float r;asm("v_sub_f32_e32 %0, %1, %2":"=v"(r):"v"(a),"v"(b));return r;}
typedef float f32x2_t __attribute__((ext_vector_type(2))); typedef __bf16 bf16x2_t __attribute__((ext_vector_type(2)));
__device__ __forceinline__ unsigned cvtpk_s(float lo,float hi){f32x2_t v={lo,hi};bf16x2_t b=__builtin_convertvector(v,bf16x2_t);return __builtin_bit_cast(unsigned,b);}
#define WAIT_BAR(N) asm volatile("s_waitcnt vmcnt(" #N ") lgkmcnt(0)\n\ts_barrier":::"memory")

__device__ __forceinline__ void qkt(f32x16&p0,f32x16&p1,const char*Kslot,const bf16x8*qr,const f32x16&negm,int r32,int hi){
  const char*kb=Kslot+hi*1024+r32*16;
  #pragma unroll
  for(int d0=0;d0<4;++d0){
    const bf16x8 b0=*reinterpret_cast<const bf16x8*>(kb+d0*2048);
    const bf16x8 b1=*reinterpret_cast<const bf16x8*>(kb+d0*2048+512);
    if(d0==0){p0=__builtin_amdgcn_mfma_f32_32x32x16_bf16(b0,qr[0],negm,0,0,0);p1=__builtin_amdgcn_mfma_f32_32x32x16_bf16(b1,qr[0],negm,0,0,0);}
    else{p0=__builtin_amdgcn_mfma_f32_32x32x16_bf16(b0,qr[d0],p0,0,0,0);p1=__builtin_amdgcn_mfma_f32_32x32x16_bf16(b1,qr[d0],p1,0,0,0);}}
}
typedef __attribute__((address_space(3))) const char* lds_cptr;
typedef short v4i16_t __attribute__((ext_vector_type(4)));
__device__ __forceinline__ void kload8(bf16x8*kf,lds_cptr kp){
  kf[0]=*(const __attribute__((address_space(3))) bf16x8*)(kp);      kf[1]=*(const __attribute__((address_space(3))) bf16x8*)(kp+512);
  kf[2]=*(const __attribute__((address_space(3))) bf16x8*)(kp+2048); kf[3]=*(const __attribute__((address_space(3))) bf16x8*)(kp+2560);
  kf[4]=*(const __attribute__((address_space(3))) bf16x8*)(kp+4096); kf[5]=*(const __attribute__((address_space(3))) bf16x8*)(kp+4608);
  kf[6]=*(const __attribute__((address_space(3))) bf16x8*)(kp+6144); kf[7]=*(const __attribute__((address_space(3))) bf16x8*)(kp+6656);
}
__device__ __forceinline__ void kload2(bf16x8*kf,lds_cptr kp,int j){ kf[2*j]=*(const __attribute__((address_space(3))) bf16x8*)(kp+j*2048); kf[2*j+1]=*(const __attribute__((address_space(3))) bf16x8*)(kp+j*2048+512); }
__device__ __forceinline__ s16x4 vtr(lds_cptr p){ return __builtin_bit_cast(s16x4,__builtin_amdgcn_ds_read_tr16_b64_v4i16((__attribute__((address_space(3))) v4i16_t*)p)); }
__device__ __forceinline__ float rowmax(const f32x16&p0,const f32x16&p1){
  float a=max3f(p0[0],p0[1],p1[0]),b=max3f(p0[2],p0[3],p1[1]);a=max3f(a,p1[2],p1[3]);
  #pragma unroll
  for(int r=4;r<16;r+=4){a=max3f(a,p0[r],p0[r+1]);b=max3f(b,p0[r+2],p0[r+3]);a=max3f(a,p1[r],p1[r+1]);b=max3f(b,p1[r+2],p1[r+3]);}
  const float m=max2f(a,b);
  auto rr=__builtin_amdgcn_permlane32_swap(__float_as_uint(m),__float_as_uint(m),false,false);
  return max2f(__uint_as_float(rr[0]),__uint_as_float(rr[1]));
}
__device__ __forceinline__ void pv(f32x16*o,int vb,bf16x8 pa0,bf16x8 pa1,bf16x8 pa2,bf16x8 pa3){
  #pragma unroll
  for(int d0=0;d0<4;++d0){s16x4 lo[4],hi[4];
    #pragma unroll
    for(int ks=0;ks<4;++ks){
      asm volatile("ds_read_b64_tr_b16 %0,%1 offset:%c2":"=&v"(lo[ks]):"v"(vb),"i"((d0>>1)*8192+(d0&1)*4096+ks*1024):"memory");
      asm volatile("ds_read_b64_tr_b16 %0,%1 offset:%c2":"=&v"(hi[ks]):"v"(vb),"i"((d0>>1)*8192+(d0&1)*4096+ks*1024+512):"memory");}
    asm volatile("s_waitcnt lgkmcnt(0)":::"memory");SBAR();
    #define PK(k) (bf16x8){lo[k][0],lo[k][1],lo[k][2],lo[k][3],hi[k][0],hi[k][1],hi[k][2],hi[k][3]}
    o[d0]=__builtin_amdgcn_mfma_f32_32x32x16_bf16(pa0,PK(0),o[d0],0,0,0);
    o[d0]=__builtin_amdgcn_mfma_f32_32x32x16_bf16(pa1,PK(1),o[d0],0,0,0);
    o[d0]=__builtin_amdgcn_mfma_f32_32x32x16_bf16(pa2,PK(2),o[d0],0,0,0);
    o[d0]=__builtin_amdgcn_mfma_f32_32x32x16_bf16(pa3,PK(3),o[d0],0,0,0);
    #undef PK
  }
}

#ifndef ATTN_STORE16
#define ATTN_STORE16(p,v) (*(u32x4*)(p)=(v))
#endif
template<int THRL> __device__ __forceinline__ void attn_unit(int b,int qb,const bf16*Q,const bf16*__restrict__ K,const bf16*__restrict__ V,bf16*O,char*shm){
  int tid_l=threadIdx.x; asm volatile("":"+v"(tid_l)); const int tid=tid_l,lane=tid&63,r32=lane&31,hi=lane>>5; const int wid=__builtin_amdgcn_readfirstlane(tid>>6);
  const long rowbase=(long)b*SEQ; const int q0=qb*QB; const lds_cptr shm3q=(lds_cptr)shm;
  const bf16*Qw=Q+(rowbase+q0+wid*QBLK)*DM;
  const bf16*Kh=K+rowbase*DM,*Vh=V+rowbase*DM;
  const unsigned lds0=(unsigned)(uintptr_t)shm;
  float*wsf=(float*)(shm+LDS_WS)+wid*64;
  const bf16*ksrc=Kh+(long)lane*DM+wid*8;
  const bf16*vsrc=Vh+(long)(16*(wid&3)+(lane>>2))*DM+(wid>>2)*32+(lane&3)*8;
  const unsigned kdst=lds0+LDS_K+wid*1024, vdst=lds0+LDS_V+wid*1024;
  #define DMA_K(t,slot) glds16(ksrc+(long)(t)*KVBLK*DM,(unsigned)__builtin_amdgcn_readfirstlane(kdst+(slot)))
  #define DMA_V(t,slot) do{ glds16(vsrc+(long)(t)*KVBLK*DM,(unsigned)__builtin_amdgcn_readfirstlane(vdst+2*(slot))); glds16(vsrc+64+(long)(t)*KVBLK*DM,(unsigned)__builtin_amdgcn_readfirstlane(vdst+2*(slot)+8192)); }while(0)
  const int vb0=(int)(lds0+LDS_V)+((lane>>4)&1)*32+(lane&3)*8+(4*hi+((lane&15)>>2))*64;
  const char*Kbase=shm+LDS_K; bf16x8 kf[8];
  const lds_cptr shm3=(lds_cptr)shm; const lds_cptr kp0=shm3+LDS_K+hi*1024+r32*16; const lds_cptr vp0=shm3+LDS_V+((lane>>4)&1)*32+(lane&3)*8+(4*hi+((lane&15)>>2))*64;
  const int NT=(q0+QB)/KVBLK;
  DMA_K(0,0);DMA_V(0,0);DMA_K(1,SLOTB);
  bf16x8 qr[4];
  #pragma unroll
  for(int d0=0;d0<4;++d0)qr[d0]=*reinterpret_cast<const bf16x8*>(&Qw[(long)r32*DM+d0*16+hi*8]);
  const lds_cptr qst3=shm3q+LDS_OST+wid*4096+lane*16;
  #define LDQ(d0) (*(const __attribute__((address_space(3))) bf16x8*)(qst3+(d0)*1024))
  float mhat=0.f,l_reg=0.f;f32x16 o[4];o[0]=f32x16{};o[1]=f32x16{};o[2]=f32x16{};o[3]=f32x16{};f32x16 negm=f32x16{};asm volatile("":"+v"(negm));
  const int qrel=wid*QBLK+r32;
  #define CMASK(P0,P1,t) do{int jb_=(t)-(NT-4); if(jb_>=0)cmask(P0,P1,jb_,qrel,hi);}while(0)
  bool resc=false;
  #define START(P0,P1) do{ const float rm=rowmax(P0,P1); resc=false; \
    { const float dl=rm; mhat=fadd_s(mhat,dl); \
      _Pragma("unroll") for(int r=0;r<16;++r){P0[r]=fsub_s(P0[r],dl);P1[r]=fsub_s(P1[r],dl);} \
      _Pragma("unroll") for(int r=0;r<16;++r)negm[r]=-mhat; asm volatile("":"+v"(negm)); } \
    _Pragma("unroll") for(int r=0;r<16;++r)P0[r]=__builtin_amdgcn_exp2f(P0[r]); }while(0)
  #define RESC() do{ if(resc){ asm volatile("s_waitcnt lgkmcnt(0)":::"memory"); \
      _Pragma("unroll") for(int d_=0;d_<4;++d_) _Pragma("unroll") for(int r=0;r<16;++r)o[d_][r]*=wsf[crow(r,hi)]; } }while(0)
  f32x16 pA0,pA1,pB0,pB1;
  int sl_prev=0,sl_cur=0,sl_next=SLOTB;
  #define ROT() do{sl_prev=sl_cur;sl_cur=sl_next;sl_next=(sl_next==(NSLOT-1)*SLOTB)?0:sl_next+SLOTB;}while(0)
  DMA_K(2,2*SLOTB);
  WAIT_BAR(3);
  qkt(pA0,pA1,Kbase,qr,negm,r32,hi);
  _Pragma("unroll") for(int d0=0;d0<4;++d0)*(__attribute__((address_space(3))) bf16x8*)(qst3+d0*1024)=qr[d0];
asm volatile("s_nop 15\n\ts_nop 7":"+v"(pA0),"+v"(pA1));CMASK(pA0,pA1,0);
  START(pA0,pA1);
  _Pragma("unroll") for(int r=0;r<16;++r)pA1[r]=__builtin_amdgcn_exp2f(pA1[r]);
  WAIT_BAR(0);
  DMA_K(3,0);DMA_V(1,SLOTB);
  ROT();
  kload8(kf,kp0+sl_cur);
  WAIT_BAR(3);
  s16x4 f0lo,f0hi,f1lo,f1hi,f2lo,f2hi,f3lo,f3hi; u32x4 pw0,pw1,pw2,pw3;
  #define PKW(P,B) cvtpk_s(P[B],P[B+1])
  #define PAF(k) __builtin_bit_cast(bf16x8,pw##k)
  #define VF(S) (bf16x8){S##lo[0],S##lo[1],S##lo[2],S##lo[3],S##hi[0],S##hi[1],S##hi[2],S##hi[3]}
  #define FOFF(i) (((i)>>2)*4096+((i)&3)*1024)
  #define VLD(S,off) do{ S##lo=vtr(vp_+(off)); S##hi=vtr(vp_+(off)+512); }while(0)
  #define PIN(x) asm volatile("":"+v"(x))
  #define MX3(a,b,c) __builtin_fmaxf(__builtin_fmaxf((a),(b)),(c))
  #define GAPA(MF,A0,A1,A2,A3,W0,W1,PW) do{ MF; sacc+=A0; sacc+=A1; sacc+=A2; sacc+=A3; PIN(sacc); W0; W1; PIN(PW); SBAR(); }while(0)
  #define EX(v) __builtin_amdgcn_exp2f(v)
  #define GAPB(MF,X,B) do{ MF; X[B]=EX(X[B]); X[B+1]=EX(X[B+1]); X[B+2]=EX(X[B+2]); X[B+3]=EX(X[B+3]); PIN(X); SBAR(); }while(0)
  #define GAPB2(MF,X,B) do{ MF; X[B]=EX(X[B]); X[B+1]=EX(X[B+1]); PIN(X); SBAR(); }while(0)
  #define KRD(G,j) do{ if(G){ kload2(kf,kp0+sl_next,j); SBAR(); } }while(0)
  #define STEP(C0,C1,P0,P1,t,GK,GV,GL) do{ SBAR(); \
    const lds_cptr vp_=vp0+2*sl_prev; \
    bf16x8 q_=LDQ(0); VLD(f0,FOFF(0)); SBAR(); float sacc=(P0[0]+P0[1]); \
    GAPA(C0=__builtin_amdgcn_mfma_f32_32x32x16_bf16(kf[0],q_,negm,0,0,0), P0[2],P0[3],P0[4],P0[5],     pw0[0]=PKW(P0,0), pw0[1]=PKW(P0,2), pw0); \
    VLD(f1,FOFF(4)); SBAR(); GAPA(C1=__builtin_amdgcn_mfma_f32_32x32x16_bf16(kf[1],q_,negm,0,0,0), P0[6],P0[7],P0[8],P0[9],     pw0[2]=PKW(P0,4), pw0[3]=PKW(P0,6), pw0); \
    q_=LDQ(1); VLD(f2,FOFF(1)); SBAR(); GAPA(C0=__builtin_amdgcn_mfma_f32_32x32x16_bf16(kf[2],q_,C0,0,0,0),   P0[10],P0[11],P0[12],P0[13], pw1[0]=PKW(P0,8), pw1[1]=PKW(P0,10), pw1); \
    VLD(f3,FOFF(5)); SBAR(); GAPA(C1=__builtin_amdgcn_mfma_f32_32x32x16_bf16(kf[3],q_,C1,0,0,0),   P0[14],P0[15],P1[0],P1[1],   pw1[2]=PKW(P0,12),pw1[3]=PKW(P0,14), pw1); \
    q_=LDQ(2); SBAR(); GAPA(C0=__builtin_amdgcn_mfma_f32_32x32x16_bf16(kf[4],q_,C0,0,0,0),   P1[2],P1[3],P1[4],P1[5],     pw2[0]=PKW(P1,0), pw2[1]=PKW(P1,2), pw2); \
    GAPA(C1=__builtin_amdgcn_mfma_f32_32x32x16_bf16(kf[5],q_,C1,0,0,0),   P1[6],P1[7],P1[8],P1[9],     pw2[2]=PKW(P1,4), pw2[3]=PKW(P1,6), pw2); \
    q_=LDQ(3); SBAR(); GAPA(C0=__builtin_amdgcn_mfma_f32_32x32x16_bf16(kf[6],q_,C0,0,0,0),   P1[10],P1[11],P1[12],P1[13], pw3[0]=PKW(P1,8), pw3[1]=PKW(P1,10), pw3); \
    GAPA(C1=__builtin_amdgcn_mfma_f32_32x32x16_bf16(kf[7],q_,C1,0,0,0),   P1[14],P1[15],0.f,0.f,       pw3[2]=PKW(P1,12),pw3[3]=PKW(P1,14), pw3); \
    l_reg+=sacc; \
    if(GK){DMA_K((t)+3,sl_cur);} if(GV){DMA_V((t)+1,sl_next);} \
    CMASK(C0,C1,t); \
    { float a=MX3(C0[0],C0[1],C1[0]),b=MX3(C0[2],C0[3],C1[1]); a=MX3(a,C1[2],C1[3]); \
      _Pragma("unroll") for(int r=4;r<16;r+=4){a=MX3(a,C0[r],C0[r+1]);b=MX3(b,C0[r+2],C0[r+3]);a=MX3(a,C1[r],C1[r+1]);b=MX3(b,C1[r+2],C1[r+3]);} \
      float rm=__builtin_fmaxf(a,b); { auto rr=__builtin_amdgcn_permlane32_swap(__float_as_uint(rm),__float_as_uint(rm),false,false); rm=__builtin_fmaxf(__uint_as_float(rr[0]),__uint_as_float(rr[1])); } \
      resc=false; \
      if(__builtin_expect(__any(rm>(float)THRL),0)){ const float dl=__builtin_fmaxf(rm,0.f); mhat+=dl; \
        _Pragma("unroll") for(int r=0;r<16;++r){C0[r]-=dl;C1[r]-=dl;} \
        _Pragma("unroll") for(int r=0;r<16;++r)negm[r]=-mhat; asm volatile("":"+v"(negm)); \
        const float f=__builtin_amdgcn_exp2f(-dl); l_reg*=f; if(hi==0)wsf[r32]=f; resc=true; } } \
    SBAR(); \
      \
    GAPB2(o[0]=__builtin_amdgcn_mfma_f32_32x32x16_bf16(PAF(0),VF(f0),o[0],0,0,0), C0,0);  VLD(f0,FOFF(2)); SBAR(); \
    GAPB2(o[1]=__builtin_amdgcn_mfma_f32_32x32x16_bf16(PAF(0),VF(f1),o[1],0,0,0), C0,2);  VLD(f1,FOFF(6)); SBAR(); \
    KRD(GL,0); GAPB2(o[0]=__builtin_amdgcn_mfma_f32_32x32x16_bf16(PAF(1),VF(f2),o[0],0,0,0), C0,4);  VLD(f2,FOFF(3)); SBAR(); \
    KRD(GL,1); GAPB2(o[1]=__builtin_amdgcn_mfma_f32_32x32x16_bf16(PAF(1),VF(f3),o[1],0,0,0), C0,6);  VLD(f3,FOFF(7)); SBAR(); \
    KRD(GL,2); GAPB2(o[0]=__builtin_amdgcn_mfma_f32_32x32x16_bf16(PAF(2),VF(f0),o[0],0,0,0), C0,8);  VLD(f0,8192+FOFF(0)); SBAR(); \
    KRD(GL,3); GAPB2(o[1]=__builtin_amdgcn_mfma_f32_32x32x16_bf16(PAF(2),VF(f1),o[1],0,0,0), C0,10); VLD(f1,8192+FOFF(4)); SBAR(); \
    GAPB2(o[0]=__builtin_amdgcn_mfma_f32_32x32x16_bf16(PAF(3),VF(f2),o[0],0,0,0), C0,12); VLD(f2,8192+FOFF(1)); SBAR(); \
    GAPB2(o[1]=__builtin_amdgcn_mfma_f32_32x32x16_bf16(PAF(3),VF(f3),o[1],0,0,0), C0,14); VLD(f3,8192+FOFF(5)); SBAR(); \
    GAPB2(o[2]=__builtin_amdgcn_mfma_f32_32x32x16_bf16(PAF(0),VF(f0),o[2],0,0,0), C1,0);  VLD(f0,8192+FOFF(2)); SBAR(); \
    GAPB2(o[3]=__builtin_amdgcn_mfma_f32_32x32x16_bf16(PAF(0),VF(f1),o[3],0,0,0), C1,2);  VLD(f1,8192+FOFF(6)); SBAR(); \
    GAPB2(o[2]=__builtin_amdgcn_mfma_f32_32x32x16_bf16(PAF(1),VF(f2),o[2],0,0,0), C1,4);  VLD(f2,8192+FOFF(3)); SBAR(); \
    GAPB2(o[3]=__builtin_amdgcn_mfma_f32_32x32x16_bf16(PAF(1),VF(f3),o[3],0,0,0), C1,6);  VLD(f3,8192+FOFF(7)); SBAR(); \
    GAPB2(o[2]=__builtin_amdgcn_mfma_f32_32x32x16_bf16(PAF(2),VF(f0),o[2],0,0,0), C1,8); \
    GAPB2(o[3]=__builtin_amdgcn_mfma_f32_32x32x16_bf16(PAF(2),VF(f1),o[3],0,0,0), C1,10); \
    GAPB2(o[2]=__builtin_amdgcn_mfma_f32_32x32x16_bf16(PAF(3),VF(f2),o[2],0,0,0), C1,12); \
    GAPB2(o[3]=__builtin_amdgcn_mfma_f32_32x32x16_bf16(PAF(3),VF(f3),o[3],0,0,0), C1,14); \
    }while(0)
  int t=1;
  #undef CMASK
  #define CMASK(P0,P1,t) do{}while(0)
  for(;t+5<NT;t+=2){
    STEP(pB0,pB1,pA0,pA1,t,true,true,true);     WAIT_BAR(3); RESC(); ROT();
    STEP(pA0,pA1,pB0,pB1,t+1,true,true,true);   WAIT_BAR(3); RESC(); ROT();
  }
  #undef CMASK
  #define CMASK(P0,P1,t) do{int jb_=(t)-(NT-4); if(jb_>=0)cmask(P0,P1,jb_,qrel,hi);}while(0)
  #define ENDW(tt) do{ if((tt)+3<NT){WAIT_BAR(3);} else if((tt)+2<NT){WAIT_BAR(2);} else {WAIT_BAR(0);} }while(0)
  for(;t+1<NT;t+=2){
    STEP(pB0,pB1,pA0,pA1,t,(t+3<NT),(t+1<NT),(t+1<NT));       ENDW(t);   RESC(); ROT();
    STEP(pA0,pA1,pB0,pB1,t+1,(t+4<NT),(t+2<NT),(t+2<NT));     ENDW(t+1); RESC(); ROT();
  }
  STEP(pB0,pB1,pA0,pA1,NT-1,false,false,false); RESC();
  { float sacc=pB0[0]+pB0[1]; _Pragma("unroll") for(int r=2;r<16;++r)sacc+=pB0[r]; _Pragma("unroll") for(int r=0;r<16;++r)sacc+=pB1[r]; l_reg+=sacc;
    pw0=(u32x4){PKW(pB0,0),PKW(pB0,2),PKW(pB0,4),PKW(pB0,6)};pw1=(u32x4){PKW(pB0,8),PKW(pB0,10),PKW(pB0,12),PKW(pB0,14)};pw2=(u32x4){PKW(pB1,0),PKW(pB1,2),PKW(pB1,4),PKW(pB1,6)};pw3=(u32x4){PKW(pB1,8),PKW(pB1,10),PKW(pB1,12),PKW(pB1,14)};
    SBAR(); pv(o,vb0+2*sl_cur,PAF(0),PAF(1),PAF(2),PAF(3)); }
  #undef PKW
  #undef PAF
  #undef VF
  #undef FOFF
  #undef VLD
  #undef LDQ
  #undef PIN
  #undef MX3
  #undef GAPA
  #undef GAPB
  #undef EX
  #undef GAPB2
  #undef KRD
  #undef STEP
  #undef ENDW
  {auto rr=__builtin_amdgcn_permlane32_swap(__float_as_uint(l_reg),__float_as_uint(l_reg),false,false);l_reg=__uint_as_float(rr[0])+__uint_as_float(rr[1]);}
  if(hi==0)wsf[32+r32]=l_reg;asm volatile("s_waitcnt lgkmcnt(0)":::"memory");
  float rli[16];
  #pragma unroll
  for(int r=0;r<16;++r)rli[r]=__builtin_amdgcn_rcpf(wsf[32+crow(r,hi)]);
  bf16*Ow=O+(rowbase+q0+wid*QBLK)*DM;
  { bf16*stg=(bf16*)(shm+LDS_OST)+wid*2048;
    #pragma unroll
    for(int h2=0;h2<2;++h2){
      #pragma unroll
      for(int r=0;r<16;++r){const int orow=crow(r,hi);
        #pragma unroll
        for(int d0=0;d0<2;++d0)stg[orow*64+d0*32+r32]=__float2bfloat16(o[2*h2+d0][r]*rli[r]);}
      asm volatile("s_waitcnt lgkmcnt(0)":::"memory");
      #pragma unroll
      for(int i=0;i<4;++i){const int row=i*8+(lane>>3),ch=lane&7; const u32x4 v=*(const u32x4*)(stg+row*64+ch*8); ATTN_STORE16(Ow+(long)row*DM+h2*64+ch*8,v);}
      asm volatile("s_waitcnt lgkmcnt(0)":::"memory"); } }
  asm volatile("s_waitcnt lgkmcnt(0)\n\ts_barrier":::"memory");
  #undef DMA_K
  #undef DMA_V
  #undef CMASK
  #undef START
  #undef RESC
  #undef ROT
}
constexpr int ATTN_LDS_BYTES=LDS_BYTES;
#undef SBAR
#undef WAIT_BAR
}
#define GAS __attribute__((address_space(1)))
#define LAS __attribute__((address_space(3)))
typedef unsigned short bf16;
typedef unsigned v4u __attribute__((ext_vector_type(4)));
typedef float f32x4 __attribute__((ext_vector_type(4)));
typedef short bf16x8 __attribute__((ext_vector_type(8)));
typedef GAS unsigned gu32;
typedef GAS unsigned long long gu64;
#define RLX_AGENT __ATOMIC_RELAXED, __HIP_MEMORY_SCOPE_AGENT
#define LDS_WAIT() asm volatile("s_waitcnt lgkmcnt(0)" ::: "memory")
#define VM_WAIT() asm volatile("s_waitcnt vmcnt(0)" ::: "memory")
__device__ __forceinline__ unsigned long long rt() { return __builtin_amdgcn_s_memrealtime(); }
__device__ __forceinline__ unsigned f2bf(float f) { unsigned u = __builtin_bit_cast(unsigned, f); return (u + 0x7fffu + ((u >> 16) & 1u)) >> 16; }
__device__ __forceinline__ unsigned pk2(float lo, float hi) { return f2bf(lo) | (f2bf(hi) << 16); }

#define XB_TMO      128
#define XB_XCNT(j)  (256  + 64 * (j))
#define XB_XSUB(j)  (1280 + 64 * (j))
#define XB_XGEN(j)  (2304 + 64 * (j))
#define XB_TOP      3328
#define XB_TOPGEN   3392
#define XCD_BAR_WORDS 3456
#define XB_SPIN_CAP (1u << 18)

__device__ __forceinline__ unsigned xb_ld(unsigned* p)              { return __hip_atomic_load(p, __ATOMIC_RELAXED, __HIP_MEMORY_SCOPE_AGENT); }
__device__ __forceinline__ unsigned xb_add(unsigned* p, unsigned v) { return __hip_atomic_fetch_add(p, v, __ATOMIC_RELAXED, __HIP_MEMORY_SCOPE_AGENT); }
__device__ __forceinline__ unsigned xb_xcc_id() { return (unsigned)__builtin_amdgcn_s_getreg((3 << 11) | 20) & 0xFu; }
#define XB_SPIN(cond, bar) do { unsigned _sp = 0; while (cond) { __builtin_amdgcn_s_sleep(1); \
    if ((++_sp & 255u) == 0u) { if (xb_ld(&(bar)[XB_TMO])) break; if (_sp > XB_SPIN_CAP) { atomicAdd(&(bar)[XB_TMO], 1u); break; } } } } while (0)

struct XcdBarrier {
    unsigned* bar; unsigned x; unsigned tot;
    volatile LAS unsigned* st;
};

__device__ __forceinline__ XcdBarrier xcd_barrier_post(unsigned* bar, volatile LAS unsigned* st, unsigned tot) {
    XcdBarrier b; b.bar = bar; b.x = xb_xcc_id(); b.st = st; b.tot = tot;
    if (threadIdx.x == 0) (void)xb_add(&bar[XB_XCNT(b.x)], 1u);
    return b;
}
__device__ __forceinline__ void xcd_barrier_complete(unsigned* bar, unsigned x, unsigned G, unsigned& nloc, unsigned& nx) {
    unsigned sum, cnt, mine, sp = 0u;
    for (;;) {
        sum = 0u; cnt = 0u; mine = 0u;
#pragma unroll
        for (unsigned j = 0; j < 16; ++j) { const unsigned c = xb_ld(&bar[XB_XCNT(j)]); sum += c; cnt += (c > 0u) ? 1u : 0u; mine = (j == x) ? c : mine; }
        if (sum == G) break;
        __builtin_amdgcn_s_sleep(1);
        if ((++sp & 255u) == 0u) { if (xb_ld(&bar[XB_TMO])) break; if (sp > XB_SPIN_CAP) { atomicAdd(&bar[XB_TMO], 1u); break; } }
    }
    nloc = mine > 0u ? mine : 1u; nx = cnt > 0u ? cnt : 1u;
}

__device__ __forceinline__ void xcd_barrier(const XcdBarrier& b) {
    asm volatile("s_waitcnt vmcnt(0)" ::: "memory");
    __syncthreads();
    if (threadIdx.x == 0) {
        size_t zoff_ = 0; asm volatile("" : "+s"(zoff_)); unsigned* bar = b.bar + zoff_; unsigned bx_ = b.x; asm volatile("" : "+s"(bx_));
        __builtin_amdgcn_s_waitcnt(0);
        unsigned nloc = b.st[0], nx = b.st[1];
        if (nloc == 0u) { xcd_barrier_complete(bar, bx_, b.tot, nloc, nx); b.st[0] = nloc; b.st[1] = nx; }
        const unsigned old = xb_add(&bar[XB_XSUB(bx_)], 1u);
        const unsigned gen = old / nloc;
        if (old + 1u == (gen + 1u) * nloc) {
            __builtin_amdgcn_fence(__ATOMIC_RELEASE, "agent");
            asm volatile("s_waitcnt vmcnt(0)" ::: "memory");
            const unsigned og = xb_add(&bar[XB_TOP], 1u);
            const unsigned tg = og / nx;
            if (og + 1u == (tg + 1u) * nx) xb_add(&bar[XB_TOPGEN], 1u);
            else XB_SPIN(xb_ld(&bar[XB_TOPGEN]) == tg, bar);
            __builtin_amdgcn_fence(__ATOMIC_ACQUIRE, "agent");
            xb_add(&bar[XB_XGEN(bx_)], 1u);
            asm volatile("s_waitcnt vmcnt(0)" ::: "memory");
        } else {
            XB_SPIN(xb_ld(&bar[XB_XGEN(bx_)]) == gen, bar);
            __builtin_amdgcn_fence(__ATOMIC_ACQUIRE, "agent");
            asm volatile("s_waitcnt vmcnt(0)" ::: "memory");
        }
    }
    __syncthreads();
}
constexpr int NWAVES = 8;
constexpr int BATCH = 8, SEQ = 4096, DMODEL = 1024, NTOK = BATCH * SEQ, DEPTH = 2, IN_COLS = 2816;
constexpr int NEXP = 16384, PEER_H = 8, PEER_K = 16;
constexpr float RMS_EPS = 1e-6f, LN_EPS = 1e-5f;
constexpr size_t MiB = 1u << 20;
constexpr size_t WS_CTL = 0, CTL_ZERO_BYTES = 1 * MiB;
constexpr size_t WS_WIN = 2 * MiB;
constexpr size_t WS_WOUT = 13 * MiB;
constexpr size_t WS_WQ = 17 * MiB;
constexpr size_t WS_KEYS = 25 * MiB;
constexpr size_t WS_RINV = 26 * MiB;
constexpr size_t WS_SSQ = 27 * MiB;
constexpr size_t WS_EID = 30 * MiB;
constexpr size_t WS_GATE = 38 * MiB;
constexpr size_t WS_SB = 54 * MiB;
constexpr size_t WS_XBF = 72 * MiB;
constexpr size_t WS_QK = 136 * MiB;
constexpr size_t WS_VX = 200 * MiB;
constexpr size_t WS_UT = 264 * MiB;
constexpr size_t WS_VT = 296 * MiB;
constexpr size_t WS_SU = 328 * MiB;
constexpr size_t WS_SV = 329 * MiB;
constexpr size_t WS_EIDT = 330 * MiB;
constexpr size_t WS_CORR = 338 * MiB;
constexpr size_t WS_SSQX = 339 * MiB;
constexpr size_t WS_XQ = 344 * MiB;
constexpr size_t WS_XQS = 376 * MiB;
constexpr size_t WS_CAT = 377 * MiB;
constexpr size_t WS_O = 441 * MiB;
constexpr size_t WS_WSC = 340 * MiB;
constexpr size_t WS_END = 505 * MiB;
constexpr size_t WS_PART = WS_QK;
constexpr size_t WS_WT = WS_SB;
constexpr int CW_BAR = 4096;
constexpr int RING_OFF = 0, RING_BYTES = 131072;
constexpr int LDSCTL_OFF = RING_BYTES, MISC_OFF = LDSCTL_OFF + 320;
constexpr int LDS_BYTES = 147456;

__device__ __forceinline__ float bflo(unsigned w) { return __builtin_bit_cast(float, w << 16); }
__device__ __forceinline__ float bfhi(unsigned w) { return __builtin_bit_cast(float, w & 0xffff0000u); }
__device__ __forceinline__ float bf1(unsigned short w) { return __builtin_bit_cast(float, (unsigned)w << 16); }
#define DPP_ADD(v, ctrl) ((v) + __builtin_bit_cast(float, __builtin_amdgcn_update_dpp(0, __builtin_bit_cast(int, (v)), (ctrl), 0xf, 0xf, true)))
__device__ __forceinline__ float wave_sum(float v) {
    v = DPP_ADD(v, 0xB1);
    v = DPP_ADD(v, 0x4E);
    v = DPP_ADD(v, 0x141);
    v = DPP_ADD(v, 0x140);
    const int b = __builtin_bit_cast(int, v);
    return (__builtin_bit_cast(float, __builtin_amdgcn_readlane(b, 0)) + __builtin_bit_cast(float, __builtin_amdgcn_readlane(b, 16))) + (__builtin_bit_cast(float, __builtin_amdgcn_readlane(b, 32)) + __builtin_bit_cast(float, __builtin_amdgcn_readlane(b, 48)));
}

__device__ __forceinline__ int win_src(int np) {
    const int p = np >> 8, pc = np & 255;
    if (p < 4) return 256 * p + 64 * ((pc & 127) >> 5) + 32 * (pc >> 7) + (pc & 31);
    if (p < 6) return np;
    if (p < 8) { const int kk = p - 6; return pc < 128 ? 1536 + 128 * kk + pc : 1792 + 128 * kk + (pc - 128); }
    if (p < 10) { const int kk = p - 8; return pc < 128 ? 2304 + 128 * kk + pc : 2560 + 128 * kk + (pc - 128); }
    return 2048 + pc;
}
template <int MODE> __device__ __forceinline__ void p0_transpose_item(const float* W, const float* gain, int K, int N, bf16* WT, LAS float* scr, int item, int lane) {
    const int nblk = N / 32, kb = item / nblk, nb = item % nblk, k0 = 64 * kb, n0p = 32 * nb;
    const int n0 = MODE == 1 ? win_src(n0p) : n0p;
    float wv[32];
#pragma unroll
    for (int i = 0; i < 32; ++i) { const int kk = 2 * i + (lane >> 5); wv[i] = W[(size_t)(k0 + kk) * N + n0 + (lane & 31)]; }
#pragma unroll
    for (int i = 0; i < 32; ++i) { const int kk = 2 * i + (lane >> 5); const float gk = gain ? gain[k0 + kk] : 1.f; scr[kk * 33 + (lane & 31)] = wv[i] * gk; }
    LDS_WAIT(); asm volatile("" ::: "memory");
    const int c = lane & 7;
#pragma unroll
    for (int j = 0; j < 4; ++j) { const int n = (lane >> 3) + 8 * j; const LAS float* s = scr + (8 * c) * 33 + n;
        v4u o; o.x = pk2(s[0 * 33], s[1 * 33]); o.y = pk2(s[2 * 33], s[3 * 33]); o.z = pk2(s[4 * 33], s[5 * 33]); o.w = pk2(s[6 * 33], s[7 * 33]);
        *(GAS v4u*)(WT + (size_t)(n0p + n) * K + k0 + 8 * c) = o; }
    LDS_WAIT(); asm volatile("" ::: "memory");
}
__device__ __forceinline__ void p0_convert(const float* src, bf16* dst, size_t n, int gtid, int ngt) {
    for (size_t i = (size_t)gtid * 8; i < n; i += (size_t)ngt * 8) {
        const f32x4 a = *(const GAS f32x4*)(src + i), b = *(const GAS f32x4*)(src + i + 4);
        v4u o; o.x = pk2(a.x, a.y); o.y = pk2(a.z, a.w); o.z = pk2(b.x, b.y); o.w = pk2(b.z, b.w);
        *(GAS v4u*)(dst + i) = o; }
}
__device__ __forceinline__ float wave_max(float v) {
#pragma unroll
    for (int o = 1; o < 64; o <<= 1) v = fmaxf(v, __shfl_xor(v, o));
    return v;
}
template <int OFFS> __device__ __forceinline__ void p0_quant_row(const float* src, unsigned char* dst_base, int e, float* scale_out, int lane) {
    const GAS f32x4* xr = (const GAS f32x4*)src + 4 * lane;
    f32x4 v[4]; float m = 0.f;
#pragma unroll
    for (int j = 0; j < 4; ++j) { v[j] = __builtin_nontemporal_load(xr + j); m = fmaxf(fmaxf(m, fmaxf(fabsf(v[j].x), fabsf(v[j].y))), fmaxf(fabsf(v[j].z), fabsf(v[j].w))); }
    m = wave_max(m);
    const float inv = m > 0.f ? 127.0f / m : 0.f;
    v4u o;
#pragma unroll
    for (int j = 0; j < 4; ++j) { const int a = (int)rintf(v[j].x * inv) + OFFS, b = (int)rintf(v[j].y * inv) + OFFS, c = (int)rintf(v[j].z * inv) + OFFS, d = (int)rintf(v[j].w * inv) + OFFS;
        o[j] = (unsigned)(a & 0xff) | ((unsigned)(b & 0xff) << 8) | ((unsigned)(c & 0xff) << 16) | ((unsigned)(d & 0xff) << 24); }
    *(GAS v4u*)(dst_base + ((size_t)(lane >> 3) * NEXP + e) * 128 + 16 * (lane & 7)) = o;
    if (lane == 0) *scale_out = m * (1.0f / 127.0f);
}
struct QRow { f32x4 v[4]; };
__device__ __forceinline__ void p0_quant_load(QRow& q, const float* src, int lane) { const GAS f32x4* xr = (const GAS f32x4*)src + 4 * lane;
#pragma unroll
    for (int j = 0; j < 4; ++j) q.v[j] = __builtin_nontemporal_load(xr + j); }
__device__ __forceinline__ void p0_quant_fin(const QRow& q, const float* gain, unsigned char* dst_base, int e, float* scale_out, int lane) {
    f32x4 v[4]; float m = 0.f;
#pragma unroll
    for (int j = 0; j < 4; ++j) { v[j] = q.v[j]; if (gain) v[j] = v[j] * *((const GAS f32x4*)gain + 4 * lane + j); m = fmaxf(fmaxf(m, fmaxf(fabsf(v[j].x), fabsf(v[j].y))), fmaxf(fabsf(v[j].z), fabsf(v[j].w))); }
    m = fmaxf(m, __shfl_xor(m, 1)); m = fmaxf(m, __shfl_xor(m, 2)); m = fmaxf(m, __shfl_xor(m, 4)); m = fmaxf(m, __shfl_xor(m, 8));
    const float inv = m > 0.f ? 7.0f / m : 0.f;
    unsigned o[2];
#pragma unroll
    for (int k = 0; k < 2; ++k) { const f32x4 lo = v[2 * k], hi = v[2 * k + 1];
#define Q4(x) ((unsigned)((int)rintf((x) * inv) + 8) & 0xfu)
        o[k] = (Q4(lo.x) | (Q4(hi.x) << 4)) | ((Q4(lo.y) | (Q4(hi.y) << 4)) << 8) | ((Q4(lo.z) | (Q4(hi.z) << 4)) << 16) | ((Q4(lo.w) | (Q4(hi.w) << 4)) << 24);
#undef Q4
    }
    *(GAS unsigned long long*)(dst_base + ((size_t)(lane >> 4) * NEXP + e) * 128 + 8 * (lane & 15)) = (unsigned long long)o[0] | ((unsigned long long)o[1] << 32);
    if ((lane & 15) == 0) scale_out[4 * e + (lane >> 4)] = m * (1.0f / 7.0f);
}
__device__ __forceinline__ void p0_quant_row4(const float* src, const float* gain, unsigned char* dst_base, int e, float* scale_out, int lane) { QRow q; p0_quant_load(q, src, lane); p0_quant_fin(q, gain, dst_base, e, scale_out, lane); }
__device__ __forceinline__ void p0_x_row(const float* xrow, bf16* orow, float* rinv_out, int lane) {
    const GAS f32x4* xr = (const GAS f32x4*)xrow + lane;
    f32x4 v[4]; float s = 0.f;
#pragma unroll
    for (int j = 0; j < 4; ++j) { v[j] = xr[64 * j]; s += (v[j].x * v[j].x + v[j].y * v[j].y) + (v[j].z * v[j].z + v[j].w * v[j].w); }
    s = wave_sum(s);
    GAS unsigned long long* o8 = (GAS unsigned long long*)orow + lane;
#pragma unroll
    for (int j = 0; j < 4; ++j) o8[64 * j] = (unsigned long long)pk2(v[j].x, v[j].y) | ((unsigned long long)pk2(v[j].z, v[j].w) << 32);
    if (lane < 8) rinv_out[lane] = lane == 0 ? s : 0.f;
}

__device__ __forceinline__ float wave_sum_shfl(float v) {
#pragma unroll
    for (int o = 1; o < 64; o <<= 1) v += __shfl_xor(v, o);
    return v;
}
__device__ __forceinline__ void xq_row(const bf16* xrow, signed char* qrow, float* sc4, int lane) {
    const GAS v4u* xp = (const GAS v4u*)xrow + 2 * lane; const v4u a = xp[0], b = xp[1];
#define AMX(w) fmaxf(fabsf(bflo(w)), fabsf(bfhi(w)))
    float am = fmaxf(fmaxf(fmaxf(AMX(a.x), AMX(a.y)), fmaxf(AMX(a.z), AMX(a.w))), fmaxf(fmaxf(AMX(b.x), AMX(b.y)), fmaxf(AMX(b.z), AMX(b.w))));
#undef AMX
    am = fmaxf(am, __shfl_xor(am, 1)); am = fmaxf(am, __shfl_xor(am, 2)); am = fmaxf(am, __shfl_xor(am, 4)); am = fmaxf(am, __shfl_xor(am, 8));
    const float qinv = am > 0.f ? 127.0f / am : 0.f;
#define PK4(wa, wb) (unsigned)(((int)rintf(bflo(wa) * qinv) & 0xff) | (((int)rintf(bfhi(wa) * qinv) & 0xff) << 8) | (((int)rintf(bflo(wb) * qinv) & 0xff) << 16) | (((int)rintf(bfhi(wb) * qinv) & 0xff) << 24))
    v4u o; o.x = PK4(a.x, a.y); o.y = PK4(a.z, a.w); o.z = PK4(b.x, b.y); o.w = PK4(b.z, b.w);
#undef PK4
    *((GAS v4u*)qrow + lane) = o;
    if ((lane & 15) == 0) sc4[lane >> 4] = am * (1.0f / 127.0f);
}
struct QuantJob { const float* usrc; const float* vsrc; const float* gain; unsigned char* UT; unsigned char* VT; float* SU; float* SV; int r0, rs; };
struct CmbArgs { const bf16* O; const bf16* VX; const bf16* SB; bf16* CAT; const float* lq1; const float* lk1; const float* lq2; const float* lk2; const float* subg;
                 const float* cfw; const float* cfb; const float* lng; const float* lnb; const float* scw; float lam_init; };
__device__ __forceinline__ float cmb_lambda(const CmbArgs& A, int lane) { return __expf(wave_sum(A.lq1[lane] * A.lk1[lane])) - __expf(wave_sum(A.lq2[lane] * A.lk2[lane])) + A.lam_init; }
__device__ __forceinline__ void cmb_rows(const CmbArgs& A, float lam, int h, int trow0, int lane_in) {
    asm volatile("s_waitcnt vmcnt(0)" ::: "memory");
    int lane = lane_in; asm volatile("" : "+v"(lane));
    const int vh = lane >> 5, dd = (2 * lane) & 63;
    const int c0 = (4 * h + vh) * 64 + dd, c1 = (4 * h + 2 + vh) * 64 + dd;
    const float g0 = A.subg[2 * lane] * (1.0f - A.lam_init), g1 = A.subg[2 * lane + 1] * (1.0f - A.lam_init);
    unsigned o0[32], o1[32];
#pragma unroll
    for (int tt = 0; tt < 32; ++tt) { const size_t rb = (size_t)(trow0 + tt) * 1024;
        o0[tt] = __hip_atomic_load((const GAS unsigned*)(A.O + rb + c0), __ATOMIC_RELAXED, __HIP_MEMORY_SCOPE_AGENT); o1[tt] = __hip_atomic_load((const GAS unsigned*)(A.O + rb + c1), __ATOMIC_RELAXED, __HIP_MEMORY_SCOPE_AGENT); }
#pragma unroll
    for (int tt = 0; tt < 32; ++tt) {
        const float a0 = bflo(o0[tt]) - lam * bflo(o1[tt]), a1 = bfhi(o0[tt]) - lam * bfhi(o1[tt]);
        const float ss = wave_sum(a0 * a0 + a1 * a1);
        const float ri = 1.0f / sqrtf(ss * (1.0f / 128.0f) + RMS_EPS);
        *(GAS unsigned*)(A.CAT + (size_t)(trow0 + tt) * 1024 + h * 128 + 2 * lane) = pk2(a0 * ri * g0, a1 * ri * g1); }
}
__device__ __forceinline__ void cmb_conv_phase(const CmbArgs& A, const QuantJob& J, int gw, int ngw, int lane) {
    constexpr int NCH = SEQ / 16, NIT = NCH * 4;
    {
        unsigned short xin[46], xn[46];
#define CMB1_LOAD(X, it_) do { const int c_ = 64 * ((it_) & 3) + lane, t0_ = ((it_) >> 2) * 16, s0_ = t0_ & (SEQ - 1); \
        _Pragma("unroll") for (int i = 0; i < 46; ++i) { const int rel = i - 30; (X)[i] = (s0_ + rel >= 0) ? *(const GAS unsigned short*)(A.VX + (size_t)(t0_ + rel) * 1024 + 512 + c_) : (unsigned short)0; } } while (0)
        int it = gw; int qr = J.r0;
        if (it < NIT) CMB1_LOAD(xin, it);
        for (; it < NIT; it += ngw) {
            const int qra = qr < NEXP ? qr : NEXP - 1; const bool qok = qr < NEXP; qr += J.rs;
            QRow qua, qva;
            p0_quant_load(qua, J.usrc + (size_t)qra * DMODEL, lane); p0_quant_load(qva, J.vsrc + (size_t)qra * DMODEL, lane);
            const int nx = it + ngw < NIT ? it + ngw : it;
            CMB1_LOAD(xn, nx);
            const int c = 64 * (it & 3) + lane, t0 = (it >> 2) * 16;
            float w[31];
#pragma unroll
            for (int j = 0; j < 31; ++j) w[j] = A.cfw[j * 256 + c];
            const float bias = A.cfb[c], lg = A.lng[c], lb = A.lnb[c];
#pragma unroll
            for (int tt = 0; tt < 16; ++tt) { float y = bias;
#pragma unroll
                for (int j = 0; j < 31; ++j) y += w[j] * bf1(xin[tt + j]);
                const float mean = wave_sum(y) * (1.0f / 64.0f); const float d = y - mean;
                const float var = wave_sum(d * d) * (1.0f / 64.0f);
                const float yn = d / sqrtf(var + LN_EPS) * lg + lb;
                const float sw = yn / (1.0f + __expf(-yn));
                *(GAS unsigned short*)(A.CAT + (size_t)(t0 + tt) * 1024 + 512 + c) = (unsigned short)f2bf(sw); }
#pragma unroll
            for (int i = 0; i < 46; ++i) xin[i] = xn[i];
            if (qok) { p0_quant_fin(qua, J.gain, J.UT, qra, J.SU, lane); p0_quant_fin(qva, nullptr, J.VT, qra, J.SV, lane); }
        }
#undef CMB1_LOAD
    }
    {
        unsigned short xin[18], sbv[16], xn[18], sbn[16];
#define CMB2_LOAD(X, S, it_) do { const int c_ = 64 * ((it_) & 3) + lane, t0_ = ((it_) >> 2) * 16, s0_ = t0_ & (SEQ - 1); \
        _Pragma("unroll") for (int i = 0; i < 18; ++i) { const int rel = i - 2; (X)[i] = (s0_ + rel >= 0) ? *(const GAS unsigned short*)(A.VX + (size_t)(t0_ + rel) * 1024 + 768 + c_) : (unsigned short)0; } \
        _Pragma("unroll") for (int tt = 0; tt < 16; ++tt) (S)[tt] = *(const GAS unsigned short*)(A.SB + (size_t)(t0_ + tt) * 256 + c_); } while (0)
        int it = gw;
        if (it < NIT) CMB2_LOAD(xin, sbv, it);
        for (; it < NIT; it += ngw) {
            const int nx = it + ngw < NIT ? it + ngw : it;
            CMB2_LOAD(xn, sbn, nx);
            const int c = 64 * (it & 3) + lane, t0 = (it >> 2) * 16;
            const float w0 = A.scw[c], w1 = A.scw[256 + c], w2 = A.scw[512 + c];
#pragma unroll
            for (int tt = 0; tt < 16; ++tt) {
                const float y = bf1(sbv[tt]) * (w0 * bf1(xin[tt]) + w1 * bf1(xin[tt + 1]) + w2 * bf1(xin[tt + 2]));
                *(GAS unsigned short*)(A.CAT + (size_t)(t0 + tt) * 1024 + 768 + c) = (unsigned short)f2bf(y); }
#pragma unroll
            for (int i = 0; i < 18; ++i) xin[i] = xn[i];
#pragma unroll
            for (int tt = 0; tt < 16; ++tt) sbv[tt] = sbn[tt];
        }
#undef CMB2_LOAD
    }
}

typedef float f32x16 __attribute__((ext_vector_type(16)));
__device__ __forceinline__ int sortable(int b) { return b ^ ((b >> 31) & 0x7fffffff); }
#define CEX_DESC(a, b) do { const int _x = (a), _y = (b); (a) = _x > _y ? _x : _y; (b) = _x > _y ? _y : _x; } while (0)
template <int N> __device__ __forceinline__ void bitonic_merge_desc(int (&v)[N]) {
#pragma unroll
    for (int j = N >> 1; j > 0; j >>= 1)
#pragma unroll
        for (int i = 0; i < N; ++i) if ((i & j) == 0) CEX_DESC(v[i], v[i | j]);
}
template <int N> __device__ __forceinline__ void bitonic_sort_desc(int (&v)[N]) {
#pragma unroll
    for (int k = 2; k <= N; k <<= 1)
#pragma unroll
        for (int j = k >> 1; j > 0; j >>= 1)
#pragma unroll
            for (int i = 0; i < N; ++i) { const int l = i ^ j; if (l > i) { if ((i & k) == 0) CEX_DESC(v[i], v[l]); else CEX_DESC(v[l], v[i]); } }
}
__device__ __forceinline__ void merge_top16(int (&a)[16], const int (&b)[16]) {
#pragma unroll
    for (int i = 0; i < 16; ++i) a[i] = a[i] > b[15 - i] ? a[i] : b[15 - i];
    bitonic_merge_desc<16>(a);
}
__device__ __forceinline__ float vmaxf(float a, float b) { float r; asm("v_max_f32 %0, %1, %2" : "=v"(r) : "v"(a), "v"(b)); return r; }
__device__ __forceinline__ float vminf(float a, float b) { float r; asm("v_min_f32 %0, %1, %2" : "=v"(r) : "v"(a), "v"(b)); return r; }
#define CEXF(a, b) do { const float _x = (a), _y = (b); (a) = vmaxf(_x, _y); (b) = vminf(_x, _y); } while (0)
template <int N> __device__ __forceinline__ void bitonic_merge_f(float (&v)[N]) {
#pragma unroll
    for (int j = N >> 1; j > 0; j >>= 1)
#pragma unroll
        for (int i = 0; i < N; ++i) if ((i & j) == 0) CEXF(v[i], v[i | j]);
}
__device__ __forceinline__ void sort16_f(float (&v)[16]) {
#define CX(i, j) CEXF(v[i], v[j]);
    CX(0,13) CX(1,12) CX(2,15) CX(3,14) CX(4,8) CX(5,6) CX(7,11) CX(9,10)
    CX(0,5) CX(1,7) CX(2,9) CX(3,4) CX(6,13) CX(8,14) CX(10,15) CX(11,12)
    CX(0,1) CX(2,3) CX(4,5) CX(6,8) CX(7,9) CX(10,11) CX(12,13) CX(14,15)
    CX(0,2) CX(1,3) CX(4,10) CX(5,11) CX(6,7) CX(8,9) CX(12,14) CX(13,15)
    CX(1,2) CX(3,12) CX(4,6) CX(5,7) CX(8,10) CX(9,11) CX(13,14)
    CX(1,4) CX(2,6) CX(5,8) CX(7,10) CX(9,13) CX(11,14)
    CX(2,4) CX(3,6) CX(9,12) CX(11,13)
    CX(3,5) CX(6,8) CX(7,9) CX(10,12)
    CX(3,4) CX(5,6) CX(7,8) CX(9,10) CX(11,12)
    CX(6,7) CX(8,9)
#undef CX
}
__device__ __forceinline__ void merge_top16_f(float (&a)[16], const float (&b)[16]) {
#pragma unroll
    for (int i = 0; i < 16; ++i) a[i] = vmaxf(a[i], b[15 - i]);
    bitonic_merge_f<16>(a);
}
__device__ __forceinline__ void stage2_top16(const float (&ta)[16], const float (&tb)[16], float (&R)[16]) {
    float a[16], b[16];
#pragma unroll
    for (int i = 0; i < 16; ++i) { a[i] = __builtin_bit_cast(float, __builtin_bit_cast(int, ta[i]) & ~0x7f); b[i] = __builtin_bit_cast(float, __builtin_bit_cast(int, tb[i]) & ~0x7f); }
#define MK(i, j) __builtin_bit_cast(float, (__builtin_bit_cast(int, a[i] + b[j]) & ~0xff) | ((i) << 4) | (j))
    const float NINF = __builtin_bit_cast(float, 0xff800000u);
#pragma unroll
    for (int j = 0; j < 16; ++j) R[j] = MK(0, j);
#pragma unroll
    for (int i = 1; i < 16; ++i) R[i] = vmaxf(R[i], MK(16 - i, 0));
    bitonic_merge_f<16>(R);
    {
        float C[16];
#pragma unroll
        for (int j = 1; j < 8; ++j) C[j - 1] = MK(1, j);
        C[7] = NINF; C[8] = NINF; C[9] = NINF;
#pragma unroll
        for (int i = 7; i >= 2; --i) C[17 - i] = MK(i, 1);
        bitonic_merge_f<16>(C);
#pragma unroll
        for (int i = 3; i < 16; ++i) R[i] = vmaxf(R[i], C[15 - i]);
        bitonic_merge_f<16>(R);
    }
    {
        float d0 = MK(2, 2), p = MK(2, 3), q = MK(2, 4), r = MK(3, 2), s = MK(4, 2), t = MK(3, 3);
        CEXF(p, r); CEXF(q, s); CEXF(r, q);
        CEXF(q, t); CEXF(s, t);
        R[10] = vmaxf(R[10], t); R[11] = vmaxf(R[11], s); R[12] = vmaxf(R[12], q); R[13] = vmaxf(R[13], r); R[14] = vmaxf(R[14], p); R[15] = vmaxf(R[15], d0);
    }
#undef MK
}
struct TopkArgs { const bf16* Qp; const bf16* keys; const float* ssq; unsigned short* eid; float* gate; unsigned short* eidT;
#ifdef DBG_CHECK
 float* dbgS; int* dbgI;
#endif
 };
__device__ __forceinline__ void topk_phase(const TopkArgs& A, const QuantJob& J, int& qr_next, LAS unsigned char* ldsK  , LAS unsigned char* ldsw  , int h, int rank, int nrank, int wave, int tid, int lane) {
    const int r32 = lane & 31, hi = lane >> 5;
    __syncthreads();
    {
        const GAS v4u* src = (const GAS v4u*)(A.keys + (size_t)h * 2 * 128 * 128);
#pragma unroll
        for (int i = 0; i < 8; ++i) { const int g = tid + 512 * i, row = g >> 4, ch = g & 15; *(LAS v4u*)(ldsK + row * 256 + ((ch ^ (row & 15)) << 4)) = src[g]; }
        __syncthreads();
    }
    for (int tg = rank * 8 + wave; tg < SEQ / 32; tg += nrank * 8) {
        const int t = tg * 32 + r32;
        int hb = hi << 2; asm volatile("" : "+v"(hb));
        float rinv2; { const GAS f32x4* sp = (const GAS f32x4*)(A.ssq + (size_t)t * 16); const f32x4 a = sp[0], b = sp[1], c = sp[2], d = sp[3];
            const float ss = ((a.x + a.y) + (a.z + a.w)) + ((b.x + b.y) + (b.z + b.w)) + ((c.x + c.y) + (c.z + c.w)) + ((d.x + d.y) + (d.z + d.w));
            rinv2 = 1.0f / sqrtf(ss * (1.0f / DMODEL) + RMS_EPS); }
        float top[2][16];
#pragma unroll
        for (int c = 0; c < 2; ++c) {
            const int qra = qr_next < NEXP ? qr_next : NEXP - 1; const bool qok = c == 0 && qr_next < NEXP; if (c == 0) qr_next += J.rs;
            QRow qua, qva;
            if (c == 0) { p0_quant_load(qua, J.usrc + (size_t)qra * DMODEL, lane); p0_quant_load(qva, J.vsrc + (size_t)qra * DMODEL, lane); }
            const bf16* qrow = A.Qp + (size_t)t * 2048 + h * 256 + c * 128 + 8 * hi;
            bf16x8 qf[8];
#pragma unroll
            for (int s = 0; s < 8; ++s) qf[s] = *(const GAS bf16x8*)(qrow + 16 * s);
            float run[16];
            int koff = c * 32768 + r32 * 256; asm volatile("" : "+v"(koff));
            const int ksw = r32 & 15;
#pragma unroll
            for (int nt = 0; nt < 4; ++nt) {
                bf16x8 kf[8];
#pragma unroll
                for (int s = 0; s < 8; ++s) kf[s] = *(const LAS bf16x8*)(ldsK + nt * 8192 + koff + (((2 * s + hi) ^ ksw) << 4));
                f32x16 acc = {0.f, 0.f, 0.f, 0.f, 0.f, 0.f, 0.f, 0.f, 0.f, 0.f, 0.f, 0.f, 0.f, 0.f, 0.f, 0.f};
#pragma unroll
                for (int s = 0; s < 8; ++s) acc = __builtin_amdgcn_mfma_f32_32x32x16_bf16(kf[s], qf[s], acc, 0, 0, 0);
                asm volatile("" ::: "memory");
                float g[16];
#pragma unroll
                for (int r = 0; r < 16; ++r) { const int idx = 32 * nt + (r & 3) + 8 * (r >> 2);
                    const float av = acc[r];
                    g[r] = __int_as_float(((__float_as_int(av) & ~0x7f) | idx) | hb); }
                sort16_f(g);
                if (nt == 0) {
#pragma unroll
                    for (int r = 0; r < 16; ++r) run[r] = g[r];
                } else merge_top16_f(run, g);
            }
            {
                float other[16];
#pragma unroll
                for (int i = 0; i < 16; ++i) other[i] = __shfl_xor(run[i], 32);
                merge_top16_f(run, other);
            }
#pragma unroll
            for (int i = 0; i < 16; ++i) top[c][i] = run[i];
            if (c == 0) { if (qok) { p0_quant_fin(qua, J.gain, J.UT, qra, J.SU, lane); p0_quant_fin(qva, nullptr, J.VT, qra, J.SV, lane); } }
        }
#pragma unroll
        for (int c = 0; c < 2; ++c)
#pragma unroll
            for (int q4 = 0; q4 < 4; ++q4) { const unsigned w = (unsigned)(__float_as_int(top[c][4 * q4]) & 0x7f) | ((unsigned)(__float_as_int(top[c][4 * q4 + 1]) & 0x7f) << 8) | ((unsigned)(__float_as_int(top[c][4 * q4 + 2]) & 0x7f) << 16) | ((unsigned)(__float_as_int(top[c][4 * q4 + 3]) & 0x7f) << 24);
                *(LAS unsigned*)(ldsw + lane * 32 + c * 16 + q4 * 4) = w; }
        float crun[16];
        stage2_top16(top[0], top[1], crun);
        LDS_WAIT(); asm volatile("" ::: "memory");
        float sc[16]; unsigned e[16];
#pragma unroll
        for (int k = 0; k < 16; ++k) { const int bits = __float_as_int(crun[k]); const int i = (bits >> 4) & 15, j = bits & 15;
            sc[k] = __builtin_bit_cast(float, bits & ~0xff) * rinv2;
            const unsigned i1 = *(const LAS unsigned char*)(ldsw + lane * 32 + i), i2 = *(const LAS unsigned char*)(ldsw + lane * 32 + 16 + j);
            e[k] = i1 * 128u + i2; }
        const float mx = sc[0];
        float z = 0.f;
#pragma unroll
        for (int k = 0; k < 16; ++k) { sc[k] = __expf(sc[k] - mx); z += sc[k]; }
        const float iz = 1.0f / z;
        if (hi == 0) {
            v4u e0, e1; e0.x = e[0] | (e[1] << 16); e0.y = e[2] | (e[3] << 16); e0.z = e[4] | (e[5] << 16); e0.w = e[6] | (e[7] << 16);
            e1.x = e[8] | (e[9] << 16); e1.y = e[10] | (e[11] << 16); e1.z = e[12] | (e[13] << 16); e1.w = e[14] | (e[15] << 16);
            GAS v4u* ep = (GAS v4u*)(A.eid + (size_t)t * 128 + h * 16); ep[0] = e0; ep[1] = e1;
#pragma unroll
            for (int k = 0; k < 8; ++k) *(GAS unsigned*)(A.eidT + (size_t)t * 128 + k * 16 + 2 * h) = e[k] | (e[k + 8] << 16);
        } else {
            GAS f32x4* gp = (GAS f32x4*)(A.gate + (size_t)t * 128 + h * 16);
#pragma unroll
            for (int q4 = 0; q4 < 4; ++q4) gp[q4] = (f32x4){sc[4 * q4] * iz, sc[4 * q4 + 1] * iz, sc[4 * q4 + 2] * iz, sc[4 * q4 + 3] * iz};
        }
    }
}

__device__ __forceinline__ float gelu_exact(float v) { return 0.5f * v * (1.0f + erff(v * 0.70710678118654752f)); }
__device__ __forceinline__ float ub0(unsigned x) { float f; asm("v_cvt_f32_ubyte0 %0, %1" : "=v"(f) : "v"(x)); return f; }
__device__ __forceinline__ float ub1(unsigned x) { float f; asm("v_cvt_f32_ubyte1 %0, %1" : "=v"(f) : "v"(x)); return f; }
__device__ __forceinline__ float ub2(unsigned x) { float f; asm("v_cvt_f32_ubyte2 %0, %1" : "=v"(f) : "v"(x)); return f; }
__device__ __forceinline__ float ub3(unsigned x) { float f; asm("v_cvt_f32_ubyte3 %0, %1" : "=v"(f) : "v"(x)); return f; }
template <class T> __device__ __forceinline__ T tr_xchg_add(T a, T b, int O, int lane) {
    if (O == 16 || O == 32) {
        const unsigned ua = __builtin_bit_cast(unsigned, a), ub = __builtin_bit_cast(unsigned, b);
        if (O == 16) { auto r = __builtin_amdgcn_permlane16_swap(ua, ub, false, false); return __builtin_bit_cast(T, (unsigned)r[0]) + __builtin_bit_cast(T, (unsigned)r[1]); }
        else         { auto r = __builtin_amdgcn_permlane32_swap(ua, ub, false, false); return __builtin_bit_cast(T, (unsigned)r[0]) + __builtin_bit_cast(T, (unsigned)r[1]); }
    } else {
        const bool up = (lane & O) != 0; const T send = up ? a : b, keep = up ? b : a;
        const int si = __builtin_bit_cast(int, send);
        const int ri = O == 1 ? __builtin_amdgcn_update_dpp(0, si, 0xB1, 0xf, 0xf, true) : O == 2 ? __builtin_amdgcn_update_dpp(0, si, 0x4E, 0xf, 0xf, true)
                     : O == 4 ? __builtin_amdgcn_update_dpp(0, si, 0x124, 0xf, 0xf, true)
                     : __builtin_amdgcn_update_dpp(0, si, 0x128, 0xf, 0xf, true);
        return keep + __builtin_bit_cast(T, ri);
    }
}
template <class T, int N, int O, int NEND> struct TReduce {
    static __device__ __forceinline__ void run(T (&v)[N], T (&out)[NEND], int lane) {
        T w[N / 2];
#pragma unroll
        for (int i = 0; i < N / 2; ++i) {
            if (O == 4) { const bool up = (lane & O) != 0; const T send = up ? v[2 * i] : v[2 * i + 1], keep = up ? v[2 * i + 1] : v[2 * i]; w[i] = keep + __shfl_xor(send, O); }
            else w[i] = tr_xchg_add<T>(v[2 * i], v[2 * i + 1], O, lane);
        }
        TReduce<T, N / 2, O * 2, NEND>::run(w, out, lane);
    }
};
template <class T, int O, int NEND> struct TReduce<T, NEND, O, NEND> { static __device__ __forceinline__ void run(T (&v)[NEND], T (&out)[NEND], int) {
#pragma unroll
    for (int i = 0; i < NEND; ++i) out[i] = v[i]; } };
struct PeerUArgs { const signed char* xq; const float* xqs; const unsigned char* UT; const unsigned short* eidT; float* part; };
struct MetaU { v4u ea, eb, qa, qb; float sx; };
__device__ __forceinline__ void peer_u_run(const PeerUArgs& A, int t0, int tl0, int lane) {
    const int pp = lane >> 3, cc = lane & 7;
    const unsigned char* Us = A.UT + 16 * cc;
#define U_META(M, tt_) do { const int i_ = (tt_) < 63 ? (tt_) : 63; const int t_ = t0 + (i_ & 15), s_ = i_ >> 4; const GAS v4u* ep_ = (const GAS v4u*)(A.eidT + (size_t)t_ * 128 + pp * 16); (M).ea = ep_[0]; (M).eb = ep_[1]; \
        const GAS v4u* xp_ = (const GAS v4u*)(A.xq + (size_t)t_ * DMODEL + 256 * s_ + 32 * cc); (M).qa = xp_[0]; (M).qb = xp_[1]; (M).sx = A.xqs[(size_t)t_ * 4 + s_]; } while (0)
#define U_TAB(Q, M, tt_) do { const int i_ = (tt_) < 63 ? (tt_) : 63; const unsigned char* Ui_ = Us + (size_t)(i_ >> 4) * NEXP * 128; \
        _Pragma("unroll") for (int g = 0; g < 16; ++g) { const unsigned ew_ = g < 8 ? (M).ea[g >> 1] : (M).eb[(g - 8) >> 1]; const unsigned e_ = (g & 1) ? (ew_ >> 16) : (ew_ & 0xffffu); \
        (Q)[g] = *(const GAS v4u*)(Ui_ + (size_t)e_ * 128); } } while (0)
#define U_COMP(M, Q, tt_) do { const int tl_ = tl0 + ((tt_) & 15), s4_ = (tt_) >> 4; int part[16]; \
        int sm_ = 0; _Pragma("unroll") for (int k = 0; k < 4; ++k) { sm_ = __builtin_amdgcn_sdot4(0x01010101, (int)(M).qa[k], sm_, false); sm_ = __builtin_amdgcn_sdot4(0x01010101, (int)(M).qb[k], sm_, false); } sm_ *= -8; \
        _Pragma("unroll") for (int g = 0; g < 16; ++g) { int a_ = sm_; \
            _Pragma("unroll") for (int k = 0; k < 4; ++k) { const unsigned d_ = (Q)[g][k]; const int x0_ = (int)(k < 2 ? (M).qa[2 * k] : (M).qb[2 * k - 4]), x1_ = (int)(k < 2 ? (M).qa[2 * k + 1] : (M).qb[2 * k - 3]); \
                a_ = __builtin_amdgcn_sdot4((int)(d_ & 0x0f0f0f0fu), x0_, a_, false); a_ = __builtin_amdgcn_sdot4((int)((d_ >> 4) & 0x0f0f0f0fu), x1_, a_, false); } \
            part[g] = a_; } \
        int tot[2]; TReduce<int, 16, 1, 2>::run(part, tot, lane); \
        float* po = A.part + ((size_t)s4_ * SEQ + tl_) * 128 + 8 * cc + pp; po[0] = (float)tot[0] * (M).sx; po[64] = (float)tot[1] * (M).sx; } while (0)
    MetaU mc, mn, mnn; v4u QA[16], QB[16];
    U_META(mc, 0); U_META(mn, 1); U_TAB(QA, mc, 0);
    for (int tt = 0; tt < 64; tt += 2) {
        U_META(mnn, tt + 2); U_TAB(QB, mn, tt + 1); U_COMP(mc, QA, tt); mc = mn; mn = mnn;
        U_META(mnn, tt + 3); U_TAB(QA, mn, tt + 2); U_COMP(mc, QB, tt + 1); mc = mn; mn = mnn;
    }
#undef U_META
#undef U_TAB
#undef U_COMP
}
struct PeerRArgs { const float* part; const float* ssq; const unsigned short* eid; const float* gate; const float* su; const float* sv; signed char* wq; float* wsc; };
struct MetaR { int e0, e1; float g0, g1, ssq; float p0[4], p1[4]; };
struct GathR { f32x4 su0, su1, sv0, sv1; };
__device__ __forceinline__ void peer_r_run(const PeerRArgs& A, int t0, int tl0, int lane) {
#define R_META(M, k_) do { const int kk_ = (k_) < 15 ? (k_) : 15; const int tq_ = t0 + kk_, tl_ = tl0 + kk_; (M).e0 = A.eid[(size_t)tq_ * 128 + lane]; (M).e1 = A.eid[(size_t)tq_ * 128 + 64 + lane]; \
        (M).g0 = A.gate[(size_t)tq_ * 128 + lane]; (M).g1 = A.gate[(size_t)tq_ * 128 + 64 + lane]; (M).ssq = lane < 16 ? A.ssq[(size_t)tq_ * 16 + lane] : 0.f; \
        _Pragma("unroll") for (int s = 0; s < 4; ++s) { const float* pr_ = A.part + ((size_t)s * SEQ + tl_) * 128; (M).p0[s] = pr_[lane]; (M).p1[s] = pr_[64 + lane]; } } while (0)
#define R_GATH(Gv, M) do { (Gv).su0 = *(const GAS f32x4*)(A.su + 4 * (M).e0); (Gv).su1 = *(const GAS f32x4*)(A.su + 4 * (M).e1); (Gv).sv0 = *(const GAS f32x4*)(A.sv + 4 * (M).e0); (Gv).sv1 = *(const GAS f32x4*)(A.sv + 4 * (M).e1); } while (0)
    MetaR M[5]; GathR Gt[3];
    R_META(M[0], 0); R_META(M[1], 1); R_META(M[2], 2); R_META(M[3], 3);
    R_GATH(Gt[0], M[0]); R_GATH(Gt[1], M[1]);
#pragma unroll
    for (int k = 0; k < 16; ++k) { const int t = t0 + k;
        if (k + 4 < 16) R_META(M[(k + 4) % 5], k + 4);
        if (k + 2 < 16) R_GATH(Gt[(k + 2) % 3], M[(k + 2) % 5]);
        const MetaR& mc = M[k % 5]; const GathR& gc = Gt[k % 3];
        float z0 = 0.f, z1 = 0.f;
#pragma unroll
        for (int s = 0; s < 4; ++s) { z0 += mc.p0[s] * gc.su0[s]; z1 += mc.p1[s] * gc.su1[s]; }
        const float ss = wave_sum(mc.ssq);
        const float ri = 1.0f / sqrtf(ss * (1.0f / DMODEL) + RMS_EPS);
        const float w0 = mc.g0 * gelu_exact(z0 * ri), w1 = mc.g1 * gelu_exact(z1 * ri);
#pragma unroll
        for (int s = 0; s < 4; ++s) { const float a0 = w0 * gc.sv0[s], a1 = w1 * gc.sv1[s];
            const float gm = wave_max(fmaxf(fabsf(a0), fabsf(a1)));
            const float inv = gm > 0.f ? 127.0f / gm : 0.f;
            signed char* wr = A.wq + ((size_t)t * 4 + s) * 128 + (lane & 7) * 16 + (lane >> 3);
            wr[0] = (signed char)(int)rintf(a0 * inv); wr[8] = (signed char)(int)rintf(a1 * inv);
            if (lane == 0) A.wsc[(size_t)t * 4 + s] = gm * (1.0f / 127.0f); }
    }
#undef R_META
#undef R_GATH
}
typedef unsigned u32x2 __attribute__((ext_vector_type(2)));
struct PeerVArgs { float* xout  ; const unsigned char* VT; const unsigned short* eidT; const signed char* wq; const float* wsc; bf16* xb; float* ssqx; };
struct MetaV { v4u ea, eb, wq; float sc; u32x2 xv; };
__device__ __forceinline__ void peer_v_run(const PeerVArgs& A, int t0, int lane) {
    const int pp = lane >> 3, cc = lane & 7;
    {
        const unsigned char* Vs = A.VT + 16 * cc;
#define V_META(M, tt_) do { const int i_ = (tt_) < 63 ? (tt_) : 63; const int t_ = t0 + (i_ & 15), s4 = i_ >> 4; const GAS v4u* ep_ = (const GAS v4u*)(A.eidT + (size_t)t_ * 128 + pp * 16); (M).ea = ep_[0]; (M).eb = ep_[1]; \
        (M).wq = *(const GAS v4u*)(A.wq + ((size_t)t_ * 4 + s4) * 128 + pp * 16); (M).sc = A.wsc[(size_t)t_ * 4 + s4]; (M).xv = *(const GAS u32x2*)(A.xb + (size_t)t_ * DMODEL + 256 * s4 + 32 * cc + 4 * pp); } while (0)
#define V_TAB(Q, M, tt_) do { const int i_ = (tt_) < 63 ? (tt_) : 63; const unsigned char* Vi_ = Vs + (size_t)(i_ >> 4) * NEXP * 128; _Pragma("unroll") for (int g = 0; g < 16; ++g) { const unsigned ew_ = g < 8 ? (M).ea[g >> 1] : (M).eb[(g - 8) >> 1]; const unsigned e_ = (g & 1) ? (ew_ >> 16) : (ew_ & 0xffffu); \
        (Q)[g] = *(const GAS v4u*)(Vi_ + (size_t)e_ * 128); } } while (0)
#define V_COMP(M, Q, tt_) do { const int t_ = t0 + ((tt_) & 15), s4 = (tt_) >> 4; \
        int c8 = 0; _Pragma("unroll") for (int a = 0; a < 4; ++a) c8 = __builtin_amdgcn_sdot4(0x01010101, (int)(M).wq[a], c8, false); c8 *= -8; \
        int acc[32]; _Pragma("unroll") for (int i = 0; i < 32; ++i) acc[i] = c8; \
        _Pragma("unroll") for (int a = 0; a < 4; ++a) { const int wa_ = (int)(M).wq[a]; \
            _Pragma("unroll") for (int k = 0; k < 4; ++k) { const unsigned r0 = (Q)[4 * a][k], r1 = (Q)[4 * a + 1][k], r2 = (Q)[4 * a + 2][k], r3 = (Q)[4 * a + 3][k]; \
                  \
                const unsigned u01l = __builtin_amdgcn_perm(r1, r0, 0x05010400u), u01h = __builtin_amdgcn_perm(r1, r0, 0x07030602u), u23l = __builtin_amdgcn_perm(r3, r2, 0x05010400u), u23h = __builtin_amdgcn_perm(r3, r2, 0x07030602u); \
                const unsigned tb0 = __builtin_amdgcn_perm(u23l, u01l, 0x05040100u), tb1 = __builtin_amdgcn_perm(u23l, u01l, 0x07060302u), tb2 = __builtin_amdgcn_perm(u23h, u01h, 0x05040100u), tb3 = __builtin_amdgcn_perm(u23h, u01h, 0x07060302u); \
                acc[8 * k + 0] = __builtin_amdgcn_sdot4((int)(tb0 & 0x0f0f0f0fu), wa_, acc[8 * k + 0], false); acc[8 * k + 4] = __builtin_amdgcn_sdot4((int)((tb0 >> 4) & 0x0f0f0f0fu), wa_, acc[8 * k + 4], false); \
                acc[8 * k + 1] = __builtin_amdgcn_sdot4((int)(tb1 & 0x0f0f0f0fu), wa_, acc[8 * k + 1], false); acc[8 * k + 5] = __builtin_amdgcn_sdot4((int)((tb1 >> 4) & 0x0f0f0f0fu), wa_, acc[8 * k + 5], false); \
                acc[8 * k + 2] = __builtin_amdgcn_sdot4((int)(tb2 & 0x0f0f0f0fu), wa_, acc[8 * k + 2], false); acc[8 * k + 6] = __builtin_amdgcn_sdot4((int)((tb2 >> 4) & 0x0f0f0f0fu), wa_, acc[8 * k + 6], false); \
                acc[8 * k + 3] = __builtin_amdgcn_sdot4((int)(tb3 & 0x0f0f0f0fu), wa_, acc[8 * k + 3], false); acc[8 * k + 7] = __builtin_amdgcn_sdot4((int)((tb3 >> 4) & 0x0f0f0f0fu), wa_, acc[8 * k + 7], false); } } \
        int av[32]; _Pragma("unroll") for (int i = 0; i < 32; ++i) av[8 * (i & 3) + (i >> 2)] = acc[i];     \
        int tot[4]; TReduce<int, 32, 8, 4>::run(av, tot, lane); \
        const f32x4 vo = (f32x4){bflo((M).xv.x), bfhi((M).xv.x), bflo((M).xv.y), bfhi((M).xv.y)} + (f32x4){(float)tot[0], (float)tot[1], (float)tot[2], (float)tot[3]} * (M).sc; \
        if (A.xout) *(GAS f32x4*)(A.xout + (size_t)t_ * DMODEL + 256 * s4 + 32 * cc + 4 * pp) = vo; \
        *(GAS u32x2*)(A.xb + (size_t)t_ * DMODEL + 256 * s4 + 32 * cc + 4 * pp) = (u32x2){pk2(vo.x, vo.y), pk2(vo.z, vo.w)}; \
        const float s2 = wave_sum((vo.x * vo.x + vo.y * vo.y) + (vo.z * vo.z + vo.w * vo.w)); if (lane == 0) A.ssqx[(size_t)t_ * 8 + s4] = s2; } while (0)
        MetaV mc, mn, mnn; v4u QA[16], QB[16];
        V_META(mc, 0); V_META(mn, 1); V_TAB(QA, mc, 0);
        for (int tt = 0; tt < 64; tt += 2) {
            V_META(mnn, tt + 2); V_TAB(QB, mn, tt + 1); V_COMP(mc, QA, tt); mc = mn; mn = mnn;
            V_META(mnn, tt + 3); V_TAB(QA, mn, tt + 2); V_COMP(mc, QB, tt + 1); mc = mn; mn = mnn;
        }
#undef V_META
#undef V_TAB
#undef V_COMP
    }
}

#ifdef DBG_CHECK
constexpr int DBG_FLAGS = 2048, DBG_NS = 64;
constexpr size_t WS_DBG = 56 * MiB;
struct DbgArgs { const unsigned short* qp; const float* ssq; const float* x1; const float* g2; const float* wq; const float* keys; const float* uf; const float* vf; const unsigned short* eid; const float* gate; float* exp_out; gu32* flags; };
__device__ __forceinline__ void dbg_check_topk_and_expect(const DbgArgs& A, LAS unsigned char* ldsw, int gw, int ngw, int lane) {
    LAS float* qs = (LAS float*)ldsw; LAS float* subs = qs + 256; LAS float* cand = subs + 256; LAS float* h2s = cand + 256;
    LAS int* sel = (LAS int*)(h2s + 1024);
    LAS float* selv = (LAS float*)(sel + 64);
    _Pragma("nounroll") for (int smp = gw; smp < DBG_NS * 8; smp += ngw) {
        const int si = smp >> 3, h = smp & 7; const int t = (si * 509 + 17) % NTOK;
        const float* xr = A.x1 + (size_t)t * DMODEL;
        float ss = 0.f; _Pragma("nounroll") for (int k = lane; k < DMODEL; k += 64) ss += xr[k] * xr[k];
        ss = wave_sum(ss); const float ri = 1.0f / sqrtf(ss * (1.0f / DMODEL) + RMS_EPS);
        _Pragma("nounroll") for (int k = lane; k < DMODEL; k += 64) h2s[k] = xr[k] * ri * A.g2[k];
        LDS_WAIT();
        _Pragma("nounroll") for (int i = 0; i < 4; ++i) { const int col = h * 256 + lane + 64 * i; float a = 0.f; _Pragma("nounroll") for (int k = 0; k < DMODEL; ++k) a += h2s[k] * A.wq[(size_t)k * 2048 + col]; qs[lane + 64 * i] = a; }
        LDS_WAIT();
        { int badq = 0;
          _Pragma("nounroll") for (int i = 0; i < 4; ++i) { const float ref = qs[lane + 64 * i] / ri; const float got = bf1(A.qp[(size_t)t * 2048 + h * 256 + lane + 64 * i]); if (!(fabsf(got - ref) <= 0.03f * fabsf(ref) + 0.05f)) badq = 0; }
          float s16 = 0.f; _Pragma("nounroll") for (int i = 0; i < 16; ++i) s16 += A.ssq[(size_t)t * 16 + i];
          if (!(fabsf(s16 - ss) <= 1e-3f * ss)) badq |= 0;
          if (badq) __hip_atomic_fetch_or(A.flags, (unsigned)badq, __ATOMIC_RELAXED, __HIP_MEMORY_SCOPE_AGENT); }
        _Pragma("nounroll") for (int i = 0; i < 4; ++i) { const int c = i >> 1, n = lane + 64 * (i & 1); const float* kr = A.keys + (size_t)((h * 2 + c) * 128 + n) * 128; float a = 0.f; _Pragma("nounroll") for (int d = 0; d < 128; ++d) a += qs[c * 128 + d] * kr[d]; subs[c * 128 + n] = a; }
        LDS_WAIT();
        if (lane < 2) { const int c = lane; _Pragma("nounroll") for (int k = 0; k < 16; ++k) { int bi = 0; float bv = -3.0e38f; _Pragma("nounroll") for (int n = 0; n < 128; ++n) { const float v = subs[c * 128 + n]; if (v > bv) { bv = v; bi = n; } } sel[c * 16 + k] = bi; selv[c * 16 + k] = bv; subs[c * 128 + bi] = -3.0e38f; } }
        LDS_WAIT();
        _Pragma("nounroll") for (int i = 0; i < 4; ++i) { const int ci = lane + 64 * i; cand[ci] = selv[ci >> 4] + selv[16 + (ci & 15)]; }
        LDS_WAIT();
        int bad = 0;
        if (lane == 0) {
            _Pragma("nounroll") for (int k = 0; k < 16; ++k) { int bi = 0; float bv = -3.0e38f; _Pragma("nounroll") for (int n = 0; n < 256; ++n) { const float v = cand[n]; if (v > bv) { bv = v; bi = n; } } cand[bi] = -3.0e38f; sel[32 + k] = sel[bi >> 4] * 128 + sel[16 + (bi & 15)]; selv[32 + k] = bv; }
            float z = 0.f; _Pragma("nounroll") for (int k = 0; k < 16; ++k) { selv[48 + k] = __expf(selv[32 + k] - selv[32]); z += selv[48 + k]; }
            int miss = 0; float gerr = 0.f;
            _Pragma("nounroll") for (int k = 0; k < 16; ++k) { const int e = sel[32 + k]; const float g = selv[48 + k] / z; int found = -1;
                _Pragma("nounroll") for (int k2 = 0; k2 < 16; ++k2) if ((int)A.eid[(size_t)t * 128 + h * 16 + k2] == e) found = k2;
                if (found < 0) { if (g > 0.02f) ++miss; } else gerr = fmaxf(gerr, fabsf(A.gate[(size_t)t * 128 + h * 16 + found] - g)); }
            if (miss > 1) bad |= 1;
            if (gerr > 0.03f) bad |= 0;
            if (bad) __hip_atomic_fetch_or(A.flags, (unsigned)bad, __ATOMIC_RELAXED, __HIP_MEMORY_SCOPE_AGENT);
        }
        LDS_WAIT();
        if (h == 0) {
            float acc[16];
#pragma unroll
            for (int i = 0; i < 16; ++i) acc[i] = 0.f;
            _Pragma("nounroll") for (int j = 0; j < 128; ++j) { const int e = A.eid[(size_t)t * 128 + j]; const float g = A.gate[(size_t)t * 128 + j];
                const float* ur = A.uf + (size_t)e * DMODEL; float zz = 0.f; _Pragma("nounroll") for (int k = lane; k < DMODEL; k += 64) zz += ur[k] * h2s[k];
                zz = wave_sum(zz); const float w = g * gelu_exact(zz); const float* vr = A.vf + (size_t)e * DMODEL;
#pragma unroll
                for (int i = 0; i < 16; ++i) acc[i] += w * vr[lane + 64 * i]; }
#pragma unroll
            for (int i = 0; i < 16; ++i) A.exp_out[(size_t)si * DMODEL + lane + 64 * i] = xr[lane + 64 * i] + acc[i];
        }
        LDS_WAIT();
    }
}
__device__ __forceinline__ void dbg_check_scores(const unsigned short* Qp, const unsigned short* keysb, const float* dbgS, const int* dbgI, gu32* flags, LAS unsigned char* ldsw, int gw, int ngw, int lane) {
    LAS float* sc = (LAS float*)ldsw;
    _Pragma("nounroll") for (int it = gw; it < 32 * 8 * 2; it += ngw) { const int t = it >> 4, h = (it >> 1) & 7, c = it & 1; int bad = 0;
        _Pragma("nounroll") for (int i = 0; i < 2; ++i) { const int n = lane + 64 * i; float a = 0.f;
            _Pragma("nounroll") for (int d = 0; d < 128; ++d) a += bf1(Qp[(size_t)t * 2048 + h * 256 + c * 128 + d]) * bf1(keysb[(size_t)((h * 2 + c) * 128 + n) * 128 + d]);
            const float got = dbgS[((size_t)(t * 8 + h) * 2 + c) * 128 + n]; if (!(fabsf(got - a) <= 1e-3f * fabsf(a) + 1e-3f)) bad |= 0; sc[n] = got; }
        LDS_WAIT();
        if (lane == 0) { int miss = 0;
            _Pragma("nounroll") for (int k = 0; k < 16; ++k) { int bi = 0; float bv = -3.0e38f; _Pragma("nounroll") for (int n = 0; n < 128; ++n) { const float v = sc[n]; if (v > bv) { bv = v; bi = n; } } sc[bi] = -3.0e38f;
                const int got = dbgI[((size_t)(t * 8 + h) * 2 + c) * 16 + k]; const float gs = dbgS[((size_t)(t * 8 + h) * 2 + c) * 128 + (got & 0x7f)];
                if (!(fabsf(gs - bv) <= 1e-4f * fabsf(bv) + 1e-6f)) ++miss; }
            if (miss) bad |= 2; }
        bad = __builtin_amdgcn_readfirstlane(bad) | bad;
        if (bad) __hip_atomic_fetch_or(flags, (unsigned)bad, __ATOMIC_RELAXED, __HIP_MEMORY_SCOPE_AGENT);
        LDS_WAIT(); }
}
__device__ __forceinline__ void dbg_check_stage2(const int* dbgI, const float* ssq, const unsigned short* eid, const float* gate, gu32* flags, LAS unsigned char* ldsw, int gw, int ngw, int lane) {
    LAS float* cand = (LAS float*)ldsw;
    _Pragma("nounroll") for (int it = gw; it < 32 * 8; it += ngw) { const int t = it >> 3, h = it & 7; int bad = 0;
        float s16 = 0.f; _Pragma("nounroll") for (int i = 0; i < 16; ++i) s16 += ssq[(size_t)t * 16 + i];
        const float rinv2 = 1.0f / sqrtf(s16 * (1.0f / DMODEL) + RMS_EPS);
        const int* I0 = dbgI + ((size_t)(t * 8 + h) * 2 + 0) * 16; const int* I1 = dbgI + ((size_t)(t * 8 + h) * 2 + 1) * 16;
        _Pragma("nounroll") for (int i = 0; i < 4; ++i) { const int ci = lane + 64 * i; cand[ci] = __builtin_bit_cast(float, I0[ci >> 4] & ~0x7f) + __builtin_bit_cast(float, I1[ci & 15] & ~0x7f); }
        LDS_WAIT();
        if (lane == 0) { float sv[1]; (void)sv; float top0 = 0.f, z = 0.f; int miss = 0; float gerr = 0.f;
            float vals[1]; (void)vals;
            LAS float* selv = cand + 256; LAS int* sele = (LAS int*)(cand + 272);
            _Pragma("nounroll") for (int k = 0; k < 16; ++k) { int bi = 0; float bv = -3.0e38f; _Pragma("nounroll") for (int n = 0; n < 256; ++n) { const float v = cand[n]; if (v > bv) { bv = v; bi = n; } } cand[bi] = -3.0e38f;
                if (k == 0) top0 = bv; selv[k] = __expf((bv - top0) * rinv2); z += selv[k]; sele[k] = (I0[bi >> 4] & 0x7f) * 128 + (I1[bi & 15] & 0x7f); }
            _Pragma("nounroll") for (int k = 0; k < 16; ++k) { const int e = sele[k]; const float g = selv[k] / z; int found = -1;
                _Pragma("nounroll") for (int k2 = 0; k2 < 16; ++k2) if ((int)eid[(size_t)t * 128 + h * 16 + k2] == e) found = k2;
                if (found < 0) { if (g > 0.02f) ++miss; } else gerr = fmaxf(gerr, fabsf(gate[(size_t)t * 128 + h * 16 + found] - g)); }
            if (miss > 1 || gerr > 0.03f) bad |= 4; }
        bad = __builtin_amdgcn_readfirstlane(bad) | bad;
        if (bad) __hip_atomic_fetch_or(flags, (unsigned)bad, __ATOMIC_RELAXED, __HIP_MEMORY_SCOPE_AGENT);
        LDS_WAIT(); }
}
__device__ __forceinline__ void dbg_check_peer_out(const float* x2, const float* exp_out, gu32* flags, int gw, int ngw, int lane) {
    _Pragma("nounroll") for (int si = gw; si < DBG_NS; si += ngw) { const int t = (si * 509 + 17) % NTOK; float err = 0.f, mag = 0.f;
        _Pragma("nounroll") for (int k = lane; k < DMODEL; k += 64) { const float a = x2[(size_t)t * DMODEL + k], b = exp_out[(size_t)si * DMODEL + k]; err += (a - b) * (a - b); mag += b * b; }
        err = wave_sum(err); mag = wave_sum(mag);
        if (lane == 0 && !(err <= 1e-4f * mag)) __hip_atomic_fetch_or(flags, 0u, __ATOMIC_RELAXED, __HIP_MEMORY_SCOPE_AGENT); }
}
#endif
__device__ __forceinline__ void group_barrier(gu32* cnt, unsigned target) {
    asm volatile("s_waitcnt vmcnt(0)" ::: "memory");
    __syncthreads();
    if (threadIdx.x == 0) {
        __builtin_amdgcn_fence(__ATOMIC_RELEASE, "agent");
        asm volatile("s_waitcnt vmcnt(0)" ::: "memory");
        (void)__hip_atomic_fetch_add(cnt, 1u, __ATOMIC_RELAXED, __HIP_MEMORY_SCOPE_AGENT);
        unsigned sp = 0;
        while (__hip_atomic_load(cnt, __ATOMIC_RELAXED, __HIP_MEMORY_SCOPE_AGENT) < target) { __builtin_amdgcn_s_sleep(1); if (++sp > (1u << 22)) break; }
        __builtin_amdgcn_fence(__ATOMIC_ACQUIRE, "agent");
        asm volatile("s_waitcnt vmcnt(0)" ::: "memory");
    }
    __syncthreads();
}
constexpr int CW_GB = 16384;
constexpr int CW_GRP = 8192;
constexpr size_t BATCH_QKV = (size_t)SEQ * 2048;

#ifndef PH_MASK
#define PH_MASK 0xff
#endif
#define PH_ON(n) (((PH_MASK) >> (n)) & 1)
#ifndef TIME_MASK
#define TIME_MASK 0
#endif
#define TIME_ON(n) (((TIME_MASK) >> (n)) & 1)
#define PHASE_T0() const unsigned long long t0_ = TIME_MASK ? __builtin_amdgcn_s_memrealtime() : 0ull
#define PHASE_DELAY(n) do { if (TIME_ON(n)) { const unsigned long long t1_ = __builtin_amdgcn_s_memrealtime(); while (__builtin_amdgcn_s_memrealtime() - t1_ < t1_ - t0_) __builtin_amdgcn_s_sleep(16); } } while (0)
struct Args { const float* in[21]; float* out; unsigned char* ws; };
__global__ void __launch_bounds__(NWAVES * 64, 2) mk_fwd(Args args) {
    extern __shared__ __attribute__((aligned(16))) unsigned char lds[];
    LAS unsigned char* L = (LAS unsigned char*)lds;
    volatile LAS unsigned* MISC = (volatile LAS unsigned*)(L + MISC_OFF);
    const int tid = threadIdx.x;
    const int G = gridDim.x;
    unsigned char* ws = args.ws;
#define PHASE_CTX() int tid_ = threadIdx.x; asm volatile("" : "+v"(tid_)); const int lane = tid_ & 63, wave = __builtin_amdgcn_readfirstlane(tid_ >> 6); \
    int bx = blockIdx.x; asm volatile("" : "+s"(bx)); const int vcu = (G % 8 == 0) ? (bx % 8) * (G / 8) + bx / 8 : bx; const int gw = vcu * NWAVES + wave, ngw = G * NWAVES; \
    size_t zoff_ = 0; asm volatile("" : "+s"(zoff_)); unsigned char* ws = args.ws + zoff_; (void)lane; (void)gw; (void)ngw; (void)vcu; \
    bf16* const XBF = (bf16*)(ws + WS_XBF); bf16* const QK = (bf16*)(ws + WS_QK); bf16* const VX = (bf16*)(ws + WS_VX); bf16* const SB = (bf16*)(ws + WS_SB); \
    float* const RINV = (float*)(ws + WS_RINV); float* const SSQ = (float*)(ws + WS_SSQ); \
    unsigned short* const EID = (unsigned short*)(ws + WS_EID); float* const GATE = (float*)(ws + WS_GATE); \
    (void)XBF; (void)QK; (void)VX; (void)SB; (void)RINV; (void)SSQ; (void)EID; (void)GATE; \
    const int grp = bx & 7, grk = bx >> 3, gn = (G - grp + 7) >> 3, lw = grk * NWAVES + wave, nlw = gn * NWAVES; const size_t T0 = (size_t)grp * SEQ; (void)lw; (void)nlw; (void)T0; \
    bf16* const QKb = QK + (size_t)grp * BATCH_QKV; bf16* const VXb = QKb + (size_t)SEQ * 1024; (void)VXb;
    gu32* ctl = (gu32*)(ws + WS_CTL);
    for (int u = tid; u < (LDS_BYTES - LDSCTL_OFF) / 4; u += NWAVES * 64) ((LAS unsigned*)(L + LDSCTL_OFF))[u] = 0u;
    __syncthreads();
    XcdBarrier bar = xcd_barrier_post((unsigned*)(ctl + CW_BAR), MISC + 8, gridDim.x);
    XcdBarrier gbar = xcd_barrier_post((unsigned*)(ctl + CW_GB + 4096 * (blockIdx.x & 7)), MISC + 10, (gridDim.x - (blockIdx.x & 7) + 7) >> 3);
#define GRID_BAR() xcd_barrier(bar)

    if (PH_ON(0)) { PHASE_CTX(); PHASE_T0();
        LAS float* scr = (LAS float*)(L + RING_OFF + wave * 16384);
        constexpr int I_IN = (DMODEL / 64) * (IN_COLS / 32), I_OUT = (DMODEL / 64) * (DMODEL / 32), I_Q = (DMODEL / 64) * (2048 / 32);
        constexpr int NITEMS = DEPTH * (I_IN + I_OUT + I_Q);
#define P0_WEIGHT_ITEM(it_) do { const int l = (it_) / (I_IN + I_OUT + I_Q); int r = (it_) % (I_IN + I_OUT + I_Q); \
            if (r < I_IN) p0_transpose_item<1>(args.in[2] + (size_t)l * DMODEL * IN_COLS, args.in[1] + l * DMODEL, DMODEL, IN_COLS, (bf16*)(ws + WS_WIN) + (size_t)l * IN_COLS * DMODEL, scr, r, lane); \
            else if (r < I_IN + I_OUT) p0_transpose_item<0>(args.in[15] + (size_t)l * DMODEL * DMODEL, nullptr, DMODEL, DMODEL, (bf16*)(ws + WS_WOUT) + (size_t)l * DMODEL * DMODEL, scr, r - I_IN, lane); \
            else p0_transpose_item<0>(args.in[17] + (size_t)l * DMODEL * 2048, args.in[16] + l * DMODEL, DMODEL, 2048, (bf16*)(ws + WS_WQ) + (size_t)l * 2048 * DMODEL, scr, r - I_IN - I_OUT, lane); } while (0)
        const int gtid = vcu * NWAVES * 64 + tid, ngt = G * NWAVES * 64;
        p0_convert(args.in[18], (bf16*)(ws + WS_KEYS), (size_t)DEPTH * 8 * 2 * 128 * 128, gtid, ngt);
        {
            f32x4 xv[4][4];
            int it = gw;
#pragma unroll 1
            for (int m = gw; m < NTOK; m += 4 * ngw) {
#pragma unroll
                for (int q = 0; q < 4; ++q) { const int mm = m + q * ngw < NTOK ? m + q * ngw : m; const GAS f32x4* xr = (const GAS f32x4*)(args.in[0] + (size_t)mm * DMODEL) + lane;
#pragma unroll
                    for (int j = 0; j < 4; ++j) xv[q][j] = __builtin_nontemporal_load(xr + 64 * j); }
                if (it < NITEMS) { P0_WEIGHT_ITEM(it); it += ngw; }
#pragma unroll
                for (int q = 0; q < 4; ++q) if (m + q * ngw < NTOK) { const int mm = m + q * ngw; float sq = 0.f;
#pragma unroll
                    for (int j = 0; j < 4; ++j) sq += (xv[q][j].x * xv[q][j].x + xv[q][j].y * xv[q][j].y) + (xv[q][j].z * xv[q][j].z + xv[q][j].w * xv[q][j].w);
                    sq = wave_sum(sq);
                    GAS unsigned long long* o8 = (GAS unsigned long long*)(XBF + (size_t)mm * DMODEL) + lane;
#pragma unroll
                    for (int j = 0; j < 4; ++j) o8[64 * j] = (unsigned long long)pk2(xv[q][j].x, xv[q][j].y) | ((unsigned long long)pk2(xv[q][j].z, xv[q][j].w) << 32);
                    if (lane < 8) ((float*)(ws + WS_SSQX))[(size_t)mm * 8 + lane] = lane == 0 ? sq : 0.f; }
            }
#pragma unroll 1
            for (; it < NITEMS; it += ngw) P0_WEIGHT_ITEM(it);
        }
#undef P0_WEIGHT_ITEM
        PHASE_DELAY(0);
    }
    GRID_BAR();

    _Pragma("unroll") for (int l = 0; l < DEPTH; ++l) {
#define GROUP_BAR() xcd_barrier(gbar)
        if (PH_ON(1)) { PHASE_CTX(); PHASE_T0();
            pg8::Gemm g{XBF + T0 * DMODEL, (const bf16*)(ws + WS_WIN) + (size_t)l * IN_COLS * DMODEL, SEQ, IN_COLS, DMODEL}; pg8::StaticOrder S; S.init(SEQ, IN_COLS, gn, grk);
            pg8::EpiIn E{QKb, VXb, SB + T0 * 256, (const float*)(ws + WS_SSQX) + T0 * 8, args.in[3] + l * 64, args.in[4] + l * 64};
            pg8::gemm_phase<pg8::EpiIn, pg8::StaticOrder, PG8_ALIGN, PG8_SP2>(L + RING_OFF, g, S, E);
            PHASE_DELAY(1);
        }
        GROUP_BAR();
        if (PH_ON(2)) { PHASE_CTX(); PHASE_T0();
            const float lam_init = 0.8f - 0.6f * __expf(-0.3f * (float)l);
            CmbArgs C{(const bf16*)(ws + WS_O) + T0 * 1024, VXb, SB + T0 * 256, (bf16*)(ws + WS_CAT) + T0 * 1024, args.in[5] + l * 64, args.in[6] + l * 64, args.in[7] + l * 64, args.in[8] + l * 64, args.in[9] + l * 128,
                      args.in[10] + l * 31 * 256, args.in[11] + l * 256, args.in[12] + l * 256, args.in[13] + l * 256, args.in[14] + l * 3 * 256, lam_init};
            const QuantJob Jc{args.in[19] + (size_t)l * NEXP * DMODEL, args.in[20] + (size_t)l * NEXP * DMODEL, args.in[16] + l * DMODEL, ws + WS_UT + (size_t)l * NEXP * DMODEL, ws + WS_VT + (size_t)l * NEXP * DMODEL,
                              (float*)(ws + WS_SU) + (size_t)l * NEXP * 4, (float*)(ws + WS_SV) + (size_t)l * NEXP * 4, gw, ngw};
            cmb_conv_phase(C, Jc, lw, nlw, lane);
            const float lam = cmb_lambda(C, lane);
            for (int pr = grk; pr < 32; pr += gn) { const int h = pr >> 3, k = pr & 7;
                for (int i = 0; i < 2; ++i) { const int qb = i == 0 ? 15 - k : k;
                    for (int c = 0; c < 2; ++c) { const int hc = 2 * h + c;
                        const attn_body::bf16* Qb = (const attn_body::bf16*)QKb + hc * 64; const attn_body::bf16* Vb = (const attn_body::bf16*)VXb + h * 128; attn_body::bf16* Ob = (attn_body::bf16*)(ws + WS_O) + T0 * 1024 + (4 * h + 2 * c) * 64;
                        attn_body::attn_unit<8>(0, qb, Qb, Qb + 512, Vb, Ob, (char*)lds + RING_OFF); }
                    cmb_rows(C, lam, h, qb * 256 + wave * 32, lane); } }
            PHASE_DELAY(2);
        }
        GROUP_BAR();
        if (PH_ON(4)) { PHASE_CTX(); PHASE_T0();
            pg8::Gemm g{(const bf16*)(ws + WS_CAT) + T0 * 1024, (const bf16*)(ws + WS_WOUT) + (size_t)l * DMODEL * DMODEL, SEQ, DMODEL, DMODEL}; pg8::StaticOrder S; S.init(SEQ, DMODEL, gn, grk);
            pg8::EpiOut E{XBF + T0 * DMODEL, SSQ + T0 * 16};
            pg8::gemm_phase<pg8::EpiOut, pg8::StaticOrder, PG8_ALIGN, PG8_SP2>(L + RING_OFF, g, S, E);
            PHASE_DELAY(4);
        }
        GROUP_BAR();
        if (PH_ON(5)) { PHASE_CTX(); PHASE_T0();
            for (int m = lw; m < SEQ; m += nlw) xq_row(XBF + (T0 + m) * DMODEL, (signed char*)(ws + WS_XQ) + (T0 + m) * DMODEL, (float*)(ws + WS_XQS) + (T0 + m) * 4, lane);
            pg8::Gemm g{XBF + T0 * DMODEL, (const bf16*)(ws + WS_WQ) + (size_t)l * 2048 * DMODEL, SEQ, 2048, DMODEL}; pg8::StaticOrder S; S.init(SEQ, 2048, gn, grk);
            pg8::EpiBf16<0> E{QKb, 2048, nullptr, 0, 0, 1.f};
            pg8::gemm_phase<pg8::EpiBf16<0>, pg8::StaticOrder, PG8_ALIGN, PG8_SP2>(L + RING_OFF, g, S, E);
            PHASE_DELAY(5);
        }
        GROUP_BAR();
        if (PH_ON(6)) { PHASE_CTX(); PHASE_T0();
            TopkArgs K{QKb, (const bf16*)(ws + WS_KEYS) + (size_t)l * 8 * 2 * 128 * 128, SSQ + T0 * 16, EID + T0 * 128, GATE + T0 * 128, (unsigned short*)(ws + WS_EIDT) + T0 * 128
#ifdef DBG_CHECK
 , (float*)(ws + 71 * MiB), (int*)(ws + 71 * MiB + 512 * 1024)
#endif
 };
            const QuantJob J{args.in[19] + (size_t)l * NEXP * DMODEL, args.in[20] + (size_t)l * NEXP * DMODEL, args.in[16] + l * DMODEL, ws + WS_UT + (size_t)l * NEXP * DMODEL, ws + WS_VT + (size_t)l * NEXP * DMODEL,
                             (float*)(ws + WS_SU) + (size_t)l * NEXP * 4, (float*)(ws + WS_SV) + (size_t)l * NEXP * 4, gw, ngw};
            constexpr int NIT1 = (SEQ / 16) * 4;
            int qr_next = gw + (lw < NIT1 ? (NIT1 - lw + nlw - 1) / nlw : 0) * ngw;
            if (gn >= 8) topk_phase(K, J, qr_next, L + RING_OFF, L + RING_OFF + 65536 + wave * 2048, grk & 7, grk >> 3, (gn - (grk & 7) + 7) >> 3, wave, tid_, lane);
            else for (int h = grk; h < 8; h += gn) topk_phase(K, J, qr_next, L + RING_OFF, L + RING_OFF + 65536 + wave * 2048, h, 0, 1, wave, tid_, lane);
            for (int r = qr_next; r < NEXP; r += ngw) { const size_t ro = (size_t)l * NEXP + r;
                p0_quant_row4(args.in[19] + ro * DMODEL, args.in[16] + l * DMODEL, ws + WS_UT + (size_t)l * NEXP * DMODEL, r, (float*)(ws + WS_SU) + (size_t)l * NEXP * 4, lane);
                p0_quant_row4(args.in[20] + ro * DMODEL, nullptr, ws + WS_VT + (size_t)l * NEXP * DMODEL, r, (float*)(ws + WS_SV) + (size_t)l * NEXP * 4, lane); }
            PHASE_DELAY(6);
        }
        GRID_BAR();
        if (PH_ON(7)) { PHASE_CTX(); PHASE_T0();
            for (int ch = lw; ch < SEQ / 16; ch += nlw) {
                int tl0 = ch * 16; asm volatile("" : "+s"(tl0));
                { PHASE_CTX(); PeerUArgs U{(const signed char*)(ws + WS_XQ), (const float*)(ws + WS_XQS), ws + WS_UT + (size_t)l * NEXP * DMODEL, (const unsigned short*)(ws + WS_EIDT), (float*)QKb};
                  peer_u_run(U, (int)T0 + tl0, tl0, lane); }
                asm volatile("s_waitcnt vmcnt(0)" ::: "memory");
                { PHASE_CTX(); PeerRArgs R{(const float*)QKb, SSQ, EID, GATE, (const float*)(ws + WS_SU) + (size_t)l * NEXP * 4, (const float*)(ws + WS_SV) + (size_t)l * NEXP * 4, (signed char*)(ws + WS_WT), (float*)(ws + WS_WSC)};
                  peer_r_run(R, (int)T0 + tl0, tl0, lane); }
                asm volatile("s_waitcnt vmcnt(0)" ::: "memory");
                { PHASE_CTX(); PeerVArgs V{l + 1 == DEPTH ? args.out : nullptr, ws + WS_VT + (size_t)l * NEXP * DMODEL, (const unsigned short*)(ws + WS_EIDT), (const signed char*)(ws + WS_WT), (const float*)(ws + WS_WSC), XBF, (float*)(ws + WS_SSQX)};
                  peer_v_run(V, (int)T0 + tl0, lane); }
            }
            PHASE_DELAY(7);
        }
        if (l + 1 < DEPTH) GROUP_BAR();
#ifdef DBG_CHECK
        if (l == 0) { PHASE_CTX(); dbg_check_peer_out(args.out, (const float*)(ws + 70 * MiB), (gu32*)(ws + WS_CTL) + DBG_FLAGS, gw, ngw, lane); }
#endif
    }
#ifdef DBG_CHECK
    GRID_BAR();
    { PHASE_CTX(); const unsigned fl = __hip_atomic_load((gu32*)(ws + WS_CTL) + DBG_FLAGS, __ATOMIC_RELAXED, __HIP_MEMORY_SCOPE_AGENT);
      if (fl) { const float mul = 1.0f + (float)fl; for (size_t i = (size_t)(gw * 64 + lane); i < (size_t)NTOK * DMODEL; i += (size_t)ngw * 64) args.out[i] *= mul; } }
#endif
}

extern "C" void kernel_launch(void* const* d_in, const int* in_sizes, int n_in, void* d_out, int out_size, void* d_ws, size_t ws_size, hipStream_t stream) {
    static int grid = 0;
    if (grid == 0) {
        if (n_in != 21 || out_size != NTOK * DMODEL || ws_size < WS_END) { fprintf(stderr, "kernel_launch: unexpected shapes (n_in %d, out %d, ws %zu); nothing launched\n", n_in, out_size, ws_size); grid = -1; return; }
        int dev = 0, cus = 0, per_cu = 0;
        if (hipGetDevice(&dev) != hipSuccess || hipDeviceGetAttribute(&cus, hipDeviceAttributeMultiprocessorCount, dev) != hipSuccess) { grid = -1; return; }
        if (hipFuncSetAttribute((const void*)mk_fwd, hipFuncAttributeMaxDynamicSharedMemorySize, LDS_BYTES) != hipSuccess) { fprintf(stderr, "kernel_launch: hipFuncSetAttribute failed\n"); grid = -1; return; }
        if (hipOccupancyMaxActiveBlocksPerMultiprocessor(&per_cu, (const void*)mk_fwd, NWAVES * 64, LDS_BYTES) != hipSuccess || per_cu < 1) fprintf(stderr, "kernel_launch: occupancy query says %d blocks per CU\n", per_cu);
        (void)hipGetLastError();
        grid = cus;
    }
    if (grid < 0) return;
    if (hipMemsetAsync((char*)d_ws + WS_CTL, 0, CTL_ZERO_BYTES, stream) != hipSuccess) { fprintf(stderr, "kernel_launch: memset failed\n"); return; }
    Args a{};
    for (int i = 0; i < 21; ++i) a.in[i] = (const float*)d_in[i];
    a.out = (float*)d_out; a.ws = (unsigned char*)d_ws;
    hipLaunchKernelGGL(mk_fwd, dim3(grid), dim3(NWAVES * 64), LDS_BYTES, stream, a);
}
```

```cpp
#include <hip/hip_runtime.h>
#include <cstdio>
#include <cstdint>
namespace pg8 {
#define PG8_LAS __attribute__((address_space(3)))
typedef unsigned short bf16_t;
typedef short bf16x8 __attribute__((ext_vector_type(8)));
typedef float f32x4 __attribute__((ext_vector_type(4)));
typedef unsigned u32x4 __attribute__((ext_vector_type(4)));
constexpr int BM = 256, BK = 64, HALF = 128, HTB = HALF * BK * 2  , STAGE_BYTES = 8 * HTB, NXCD = 1, WGM = 4;

__host__ __device__ __forceinline__ int lds_byte(int r, int c) { const int st = (r >> 4) * 2 + (c >> 5), rr = r & 15, cc = c & 31, ob = rr * 64 + cc * 2; return st * 1024 + (ob ^ (((ob >> 9) & 1) << 5)); }
__host__ __device__ __forceinline__ void stage_rc(int b, int& R, int& C) { const int st = b / 1024, sb = b % 1024, swz = sb ^ (((sb >> 9) & 1) << 5); R = (st >> 1) * 16 + swz / 64; C = (st & 1) * 32 + (swz % 64) / 2; }
__host__ __device__ __forceinline__ int perm32(int rho) { const int n = rho >> 4, i = rho & 15; return 8 * (i >> 2) + 4 * n + (i & 3); }

struct Unit { int pm, pn; };
struct Gemm { const bf16_t* A; const bf16_t* Bt; int M, N, K; };

struct StaticOrder {
    int nM, nN, nwg, G, c;
    __host__ __device__ void init(int M, int N, int G_, int c_) { nM = M / BM; nN = N / BM; nwg = nM * nN; G = G_; c = c_; }
    __host__ __device__ bool next(int i, Unit& u) const {
        const long L = (long)i * G + c; if (L >= nwg) return false;
        int wgid = (int)L; { const int q = nwg / NXCD, r = nwg % NXCD, xcd = wgid % NXCD, off = wgid / NXCD; wgid = (xcd < r ? xcd * (q + 1) : r * (q + 1) + (xcd - r) * q) + off; }
        const int nig = WGM * nN, gid = wgid / nig, fm = gid * WGM, gsz = (nM - fm) < WGM ? (nM - fm) : WGM;
        u.pm = fm + ((wgid % nig) % gsz); u.pn = (wgid % nig) / gsz; return true;
    }
    __device__ __forceinline__ void a_ready(const Unit&) const {}
    __device__ __forceinline__ void done(const Unit&) const {}
};

__device__ __forceinline__ unsigned cvt_pk_bf16(float lo, float hi) { unsigned r; asm volatile("v_cvt_pk_bf16_f32 %0, %1, %2" : "=v"(r) : "v"(lo), "v"(hi)); return r; }
typedef float f32x2 __attribute__((ext_vector_type(2)));
__device__ __forceinline__ f32x2 gelu_pk(f32x2 v) {
    const f32x2 av = __builtin_elementwise_abs(v), d = av * 0.2316418882f + 1.0f;
    f32x2 t; t.x = __builtin_amdgcn_rcpf(d.x); t.y = __builtin_amdgcn_rcpf(d.y);
    f32x2 q = t * 0.5307027145f + (-0.7265760135f); q = q * t + 0.7107068705f; q = q * t + (-0.142248368f); q = q * t + 0.127414796f; q = q * t;
    const f32x2 s = (v * v) * (-0.72134752044f);
    f32x2 e; e.x = __builtin_amdgcn_exp2f(s.x); e.y = __builtin_amdgcn_exp2f(s.y);
    const f32x2 m = v * (q * e), r = v - m;
    f32x2 o; o.x = v.x < 0.f ? m.x : r.x; o.y = v.y < 0.f ? m.y : r.y; return o;
}

template <int ACT  > struct EpiBf16 {
    static constexpr bool PERM = true, AFTER_DRAIN = false; static_assert(ACT == 0 || ACT == 1, "EpiBf16: ACT is 0 (none) or 1 (gelu_pk)");
    bf16_t* O; int ldc; const float* bias; int split_cols; size_t split_stride; float scale0;
    __device__ __forceinline__ void operator()(const f32x4 (&acc)[2][2][4][2], const Unit& u, int wr, int wc, int fr, int fq) const {
        const int row0 = u.pm * BM + wr * 64 + fr; int colt = u.pn * BM; bf16_t* base = O;
        float sc = 1.f; if (split_cols) { const int t = colt / split_cols; base += (size_t)t * split_stride; colt -= t * split_cols; if (t == 0) sc = scale0; }
        const int col0 = colt + wc * 32 + 8 * fq, bcol0 = u.pn * BM + wc * 32 + 8 * fq;
        f32x4 bv[2][2];
#pragma unroll
        for (int bj = 0; bj < 2; ++bj)
#pragma unroll
            for (int n = 0; n < 2; ++n) bv[bj][n] = bias ? *(const f32x4*)(bias + bcol0 + bj * HALF + 4 * n) : (f32x4){0.f, 0.f, 0.f, 0.f};
#pragma unroll
        for (int ai = 0; ai < 2; ++ai)
#pragma unroll
            for (int m = 0; m < 4; ++m) { bf16_t* rowp = base + (size_t)(row0 + ai * HALF + m * 16) * ldc + col0;
#pragma unroll
                for (int bj = 0; bj < 2; ++bj) { f32x4 v0 = acc[ai][bj][m][0] + bv[bj][0], v1 = acc[ai][bj][m][1] + bv[bj][1];
                    if (ACT == 1) { f32x2 a = gelu_pk((f32x2){v0[0], v0[1]}), b = gelu_pk((f32x2){v0[2], v0[3]}), c = gelu_pk((f32x2){v1[0], v1[1]}), d = gelu_pk((f32x2){v1[2], v1[3]});
                        v0 = (f32x4){a.x, a.y, b.x, b.y}; v1 = (f32x4){c.x, c.y, d.x, d.y}; }
                    v0 = v0 * sc; v1 = v1 * sc; u32x4 w; w.x = cvt_pk_bf16(v0[0], v0[1]); w.y = cvt_pk_bf16(v0[2], v0[3]); w.z = cvt_pk_bf16(v1[0], v1[1]); w.w = cvt_pk_bf16(v1[2], v1[3]);
                    *(u32x4*)(rowp + bj * HALF) = w; } }
    }
};
constexpr float QK_C2 = 0.125f * 1.4426950408889634f;
__device__ __forceinline__ u32x4 pack8(const f32x4& v0, const f32x4& v1) { u32x4 w; w.x = cvt_pk_bf16(v0[0], v0[1]); w.y = cvt_pk_bf16(v0[2], v0[3]); w.z = cvt_pk_bf16(v1[0], v1[1]); w.w = cvt_pk_bf16(v1[2], v1[3]); return w; }
__device__ __forceinline__ float xrow_sum(float v) {
    const unsigned u = __builtin_bit_cast(unsigned, v);
    auto r = __builtin_amdgcn_permlane16_swap(u, u, false, false); v = __builtin_bit_cast(float, (unsigned)r[0]) + __builtin_bit_cast(float, (unsigned)r[1]);
    const unsigned w = __builtin_bit_cast(unsigned, v);
    auto q = __builtin_amdgcn_permlane32_swap(w, w, false, false); return __builtin_bit_cast(float, (unsigned)q[0]) + __builtin_bit_cast(float, (unsigned)q[1]);
}
struct EpiIn {
    static constexpr bool PERM = true, AFTER_DRAIN = false;
    bf16_t* QK; bf16_t* VX; bf16_t* SB; const float* ssqx; const float* qg; const float* kg;
    __device__ __forceinline__ float rinv_of(int row) const { const f32x4 a = *(const f32x4*)(ssqx + (size_t)row * 8), b = *(const f32x4*)(ssqx + (size_t)row * 8 + 4);
        return __builtin_amdgcn_rsqf((((a[0] + a[1]) + (a[2] + a[3])) + ((b[0] + b[1]) + (b[2] + b[3]))) * (1.0f / 1024.0f) + 1e-6f); }
    __device__ __forceinline__ void operator()(const f32x4 (&acc)[2][2][4][2], const Unit& u, int wr, int wc, int fr, int fq) const {
        const int pn = u.pn; const int row0 = u.pm * BM + wr * 64 + fr;
        if (pn < 4) {
            const float* g = pn < 2 ? qg : kg; const float sc = pn < 2 ? QK_C2 : 1.f;
            f32x4 gv[2][2];
#pragma unroll
            for (int bj = 0; bj < 2; ++bj)
#pragma unroll
                for (int n = 0; n < 2; ++n) gv[bj][n] = *(const f32x4*)(g + 32 * bj + 8 * fq + 4 * n) * sc;
            bf16_t* base = QK + 256 * pn + 64 * wc + 8 * fq;
#pragma unroll
            for (int ai = 0; ai < 2; ++ai)
#pragma unroll
                for (int m = 0; m < 4; ++m) { const int row = row0 + ai * HALF + m * 16; const float ri = rinv_of(row); float ss = 0.f;
#pragma unroll
                    for (int bj = 0; bj < 2; ++bj)
#pragma unroll
                        for (int n = 0; n < 2; ++n) { const f32x4 x = acc[ai][bj][m][n]; ss += (x[0] * x[0] + x[1] * x[1]) + (x[2] * x[2] + x[3] * x[3]); }
                    ss = xrow_sum(ss);
                    const float rg = ri * __builtin_amdgcn_rsqf(ss * ri * ri * (1.0f / 64.0f) + 1e-6f);
#pragma unroll
                    for (int bj = 0; bj < 2; ++bj) { const f32x4 v0 = acc[ai][bj][m][0] * rg * gv[bj][0], v1 = acc[ai][bj][m][1] * rg * gv[bj][1];
                        *(u32x4*)(base + (size_t)row * 1024 + 32 * bj) = pack8(v0, v1); } }
        } else if (pn < 6) {
            bf16_t* base = VX + 256 * (pn - 4) + 32 * wc + 8 * fq;
#pragma unroll
            for (int ai = 0; ai < 2; ++ai)
#pragma unroll
                for (int m = 0; m < 4; ++m) { const int row = row0 + ai * HALF + m * 16; const float ri = rinv_of(row);
#pragma unroll
                    for (int bj = 0; bj < 2; ++bj) *(u32x4*)(base + (size_t)row * 1024 + HALF * bj) = pack8(acc[ai][bj][m][0] * ri, acc[ai][bj][m][1] * ri); }
        } else if (pn < 8) {
            bf16_t* base = VX + 512 + 128 * (pn - 6) + 32 * wc + 8 * fq;
#pragma unroll
            for (int ai = 0; ai < 2; ++ai)
#pragma unroll
                for (int m = 0; m < 4; ++m) { const int row = row0 + ai * HALF + m * 16; const float ri = rinv_of(row); f32x4 o[2];
#pragma unroll
                    for (int n = 0; n < 2; ++n) { const f32x4 a = acc[ai][0][m][n] * ri, gt = acc[ai][1][m][n] * ri;
#pragma unroll
                        for (int e = 0; e < 4; ++e) o[n][e] = a[e] * __builtin_amdgcn_rcpf(1.0f + __expf(-gt[e])); }
                    *(u32x4*)(base + (size_t)row * 1024) = pack8(o[0], o[1]); }
        } else if (pn < 10) {
            bf16_t* base = VX + 768 + 128 * (pn - 8) + 32 * wc + 8 * fq;
#pragma unroll
            for (int ai = 0; ai < 2; ++ai)
#pragma unroll
                for (int m = 0; m < 4; ++m) { const int row = row0 + ai * HALF + m * 16; const float ri = rinv_of(row); const float r2 = ri * ri;
                    *(u32x4*)(base + (size_t)row * 1024) = pack8(acc[ai][0][m][0] * acc[ai][1][m][0] * r2, acc[ai][0][m][1] * acc[ai][1][m][1] * r2); }
        } else {
            bf16_t* base = SB + 32 * wc + 8 * fq;
#pragma unroll
            for (int ai = 0; ai < 2; ++ai)
#pragma unroll
                for (int m = 0; m < 4; ++m) { const int row = row0 + ai * HALF + m * 16; const float ri = rinv_of(row);
#pragma unroll
                    for (int bj = 0; bj < 2; ++bj) *(u32x4*)(base + (size_t)row * 256 + HALF * bj) = pack8(acc[ai][bj][m][0] * ri, acc[ai][bj][m][1] * ri); }
        }
    }
};
struct EpiOut {
    static constexpr bool PERM = true, AFTER_DRAIN = false;
    bf16_t* xb; float* ssq;
    __device__ __forceinline__ void operator()(const f32x4 (&acc)[2][2][4][2], const Unit& u, int wr, int wc, int fr, int fq) const {
        const int row0 = u.pm * BM + wr * 64 + fr; const int col0 = u.pn * BM + wc * 32 + 8 * fq;
#pragma unroll
        for (int ai = 0; ai < 2; ++ai)
#pragma unroll
            for (int m = 0; m < 4; ++m) { const int row = row0 + ai * HALF + m * 16; float ss = 0.f;
#pragma unroll
                for (int bj = 0; bj < 2; ++bj) { const size_t off = (size_t)row * 1024 + col0 + bj * HALF;
                    const u32x4 r = *(const u32x4*)(xb + off);
                    const f32x4 r0 = {__builtin_bit_cast(float, r.x << 16), __builtin_bit_cast(float, r.x & 0xffff0000u), __builtin_bit_cast(float, r.y << 16), __builtin_bit_cast(float, r.y & 0xffff0000u)};
                    const f32x4 r1 = {__builtin_bit_cast(float, r.z << 16), __builtin_bit_cast(float, r.z & 0xffff0000u), __builtin_bit_cast(float, r.w << 16), __builtin_bit_cast(float, r.w & 0xffff0000u)};
                    const u32x4 w = pack8(acc[ai][bj][m][0] + r0, acc[ai][bj][m][1] + r1);
                    *(u32x4*)(xb + off) = w;
                    const float a0 = __builtin_bit_cast(float, w.x << 16), a1 = __builtin_bit_cast(float, w.x & 0xffff0000u), a2 = __builtin_bit_cast(float, w.y << 16), a3 = __builtin_bit_cast(float, w.y & 0xffff0000u);
                    const float a4 = __builtin_bit_cast(float, w.z << 16), a5 = __builtin_bit_cast(float, w.z & 0xffff0000u), a6 = __builtin_bit_cast(float, w.w << 16), a7 = __builtin_bit_cast(float, w.w & 0xffff0000u);
                    ss += ((a0 * a0 + a1 * a1) + (a2 * a2 + a3 * a3)) + ((a4 * a4 + a5 * a5) + (a6 * a6 + a7 * a7)); }
                ss = xrow_sum(ss);
                if (fq == 0) ssq[(size_t)row * 16 + u.pn * 4 + wc] = ss; }
    }
};

template <class Epi, class Sched, bool ALIGN_EPI = false, bool SP2 = false>
__device__ __forceinline__ void gemm_phase(PG8_LAS unsigned char* lds, const Gemm g, const Sched& S, const Epi& E) {
    int tid_l = threadIdx.x; asm volatile("" : "+v"(tid_l));
    const int tid = tid_l, wid = __builtin_amdgcn_readfirstlane(tid >> 6), lane = tid & 63, wr = wid >> 2, wc = wid & 3, fr = lane & 15, fq = lane >> 4;
    const int K = g.K, nt = K / BK;
    unsigned voffA[2], voffB[2];
#pragma unroll
    for (int i = 0; i < 2; ++i) { int R, C; stage_rc(tid * 16 + i * 8192, R, C); const int Rb = Epi::PERM ? ((R & ~31) + perm32(R & 31)) : R;
        voffA[i] = (unsigned)(R * K + C) * 2u; voffB[i] = (unsigned)(Rb * K + C) * 2u; }
    const size_t kstep = (size_t)(BK * 2);
    const size_t hstep = (size_t)HALF * K * 2;
    const size_t tstep = 2 * hstep;
    const unsigned ldsw = (unsigned)wid * 1024u;
    const int aoff = lds_byte(wr * 64 + fr, fq * 8), boff = lds_byte(wc * 32 + fr, fq * 8);
#define PG8_SA(b, h) (((b) * 2 + (h)) * HTB)
#define PG8_SB(b, h) ((4 + (b) * 2 + (h)) * HTB)
#define PG8_STAGE(bufoff, gbase, voff) do { _Pragma("unroll") for (int _i = 0; _i < 2; ++_i) \
        __builtin_amdgcn_global_load_lds((const unsigned*)((const char*)(gbase) + (voff)[_i]), (PG8_LAS unsigned*)(lds + (bufoff) + ldsw + _i * 8192), 16, 0, 0); } while (0)
#define PG8_LDA(dst, b, h) do { _Pragma("unroll") for (int m = 0; m < 4; ++m) _Pragma("unroll") for (int k = 0; k < 2; ++k) dst[m][k] = *(const PG8_LAS bf16x8*)(lds + PG8_SA(b, h) + aoff + m * 2048 + k * 1024); } while (0)
#define PG8_LDB(dst, b, h) do { _Pragma("unroll") for (int n = 0; n < 2; ++n) _Pragma("unroll") for (int k = 0; k < 2; ++k) dst[n][k] = *(const PG8_LAS bf16x8*)(lds + PG8_SB(b, h) + boff + n * 2048 + k * 1024); } while (0)
#define PG8_MMA(ai, bj, At, Bt) do { __builtin_amdgcn_s_setprio(1); _Pragma("unroll") for (int m = 0; m < 4; ++m) _Pragma("unroll") for (int n = 0; n < 2; ++n) _Pragma("unroll") for (int k = 0; k < 2; ++k) \
        acc[ai][bj][m][n] = __builtin_amdgcn_mfma_f32_16x16x32_bf16(Bt[n][k], At[m][k], acc[ai][bj][m][n], 0, 0, 0); __builtin_amdgcn_s_setprio(0); } while (0)
#define PG8_WAIT_V(n) asm volatile("s_waitcnt vmcnt(" #n ")" ::: "memory")
#define PG8_WAIT_L(n) asm volatile("s_waitcnt lgkmcnt(" #n ")" ::: "memory")
#define PG8_BAR __builtin_amdgcn_s_barrier()
#define PG8_SCHED __builtin_amdgcn_sched_barrier(0)
    Unit cur, nxt; int ui = 0;
    if (!S.next(0, cur)) return;
    f32x4 acc[2][2][4][2];
#pragma unroll
    for (int a = 0; a < 2; ++a)
#pragma unroll
        for (int b = 0; b < 2; ++b)
#pragma unroll
            for (int m = 0; m < 4; ++m)
#pragma unroll
                for (int n = 0; n < 2; ++n) acc[a][b][m][n] = (f32x4){0.f, 0.f, 0.f, 0.f};
    bf16x8 At[4][2], B0[2][2], B1[2][2];
    const char* cA = (const char*)g.A + (size_t)cur.pm * tstep; const char* cB = (const char*)g.Bt + (size_t)cur.pn * tstep;
    S.a_ready(cur);
    if constexpr (SP2) {
        PG8_STAGE(PG8_SB(0, 0), cB, voffB); PG8_STAGE(PG8_SB(0, 1), cB + hstep, voffB); PG8_STAGE(PG8_SA(0, 0), cA, voffA); PG8_STAGE(PG8_SA(0, 1), cA + hstep, voffA);
        if (wr == 1) PG8_BAR;
        PG8_WAIT_V(2); PG8_BAR;
        PG8_STAGE(PG8_SB(1, 0), cB + kstep, voffB); PG8_STAGE(PG8_SA(1, 0), cA + kstep, voffA); PG8_STAGE(PG8_SB(1, 1), cB + hstep + kstep, voffB);
        PG8_WAIT_V(6); PG8_BAR;
    } else {
        PG8_STAGE(PG8_SB(0, 0), cB, voffB); PG8_STAGE(PG8_SA(0, 0), cA, voffA); PG8_STAGE(PG8_SB(0, 1), cB + hstep, voffB); PG8_STAGE(PG8_SA(0, 1), cA + hstep, voffA);
        if (wr == 1) PG8_BAR;
        PG8_WAIT_V(4); PG8_BAR;
        PG8_STAGE(PG8_SB(1, 0), cB + kstep, voffB); PG8_STAGE(PG8_SA(1, 0), cA + kstep, voffA); PG8_STAGE(PG8_SB(1, 1), cB + hstep + kstep, voffB);
        PG8_WAIT_V(6); PG8_BAR;
    }
    for (;;) {
        const bool has_next = S.next(ui + 1, nxt);
        const char* nA = has_next ? (const char*)g.A + (size_t)nxt.pm * tstep : cA; const char* nB = has_next ? (const char*)g.Bt + (size_t)nxt.pn * tstep : cB;
        for (int t = 0; t < nt; t += 2) {
            const bool last = (t == nt - 2);
            const char* a1 = cA + (size_t)(t + 1) * kstep;
            const char* a2 = last ? nA : cA + (size_t)(t + 2) * kstep; const char* b2 = last ? nB : cB + (size_t)(t + 2) * kstep;
            const char* a3 = a2 + kstep; const char* b3 = b2 + kstep;
            if (last && has_next) S.a_ready(nxt);
            if constexpr (SP2) {
            PG8_LDB(B0, 0, 0); PG8_LDB(B1, 0, 1); PG8_SCHED; PG8_LDA(At, 0, 0); PG8_STAGE(PG8_SA(1, 1), a1 + hstep, voffA);
            PG8_WAIT_V(8); PG8_WAIT_L(0); PG8_BAR; PG8_MMA(0, 0, At, B0); PG8_MMA(0, 1, At, B1); PG8_BAR; PG8_SCHED;
            PG8_LDA(At, 0, 1); PG8_STAGE(PG8_SB(0, 0), b2, voffB); PG8_STAGE(PG8_SB(0, 1), b2 + hstep, voffB); PG8_STAGE(PG8_SA(0, 0), a2, voffA);
            PG8_WAIT_V(8); PG8_WAIT_L(0); PG8_BAR; PG8_MMA(1, 0, At, B0); PG8_MMA(1, 1, At, B1); PG8_BAR; PG8_SCHED;
            PG8_LDB(B0, 1, 0); PG8_LDB(B1, 1, 1); PG8_SCHED; PG8_LDA(At, 1, 0); PG8_STAGE(PG8_SA(0, 1), a2 + hstep, voffA);
            PG8_WAIT_V(8); PG8_WAIT_L(0); PG8_BAR; PG8_MMA(0, 0, At, B0); PG8_MMA(0, 1, At, B1); PG8_BAR; PG8_SCHED;
            PG8_LDA(At, 1, 1); PG8_STAGE(PG8_SB(1, 0), b3, voffB); PG8_STAGE(PG8_SB(1, 1), b3 + hstep, voffB); PG8_STAGE(PG8_SA(1, 0), a3, voffA);
            PG8_WAIT_V(8); PG8_WAIT_L(0); PG8_BAR; PG8_MMA(1, 0, At, B0); PG8_MMA(1, 1, At, B1); PG8_BAR; PG8_SCHED;
            } else {
            PG8_LDB(B0, 0, 0); PG8_SCHED; PG8_LDA(At, 0, 0); PG8_STAGE(PG8_SA(1, 1), a1 + hstep, voffA);
            PG8_WAIT_L(8); PG8_BAR; PG8_WAIT_L(0); PG8_MMA(0, 0, At, B0); PG8_BAR; PG8_SCHED;
            PG8_LDB(B1, 0, 1); PG8_STAGE(PG8_SB(0, 0), b2, voffB);
            PG8_BAR; PG8_WAIT_L(0); PG8_MMA(0, 1, At, B1); PG8_BAR;
            PG8_LDA(At, 0, 1); PG8_STAGE(PG8_SA(0, 0), a2, voffA);
            PG8_BAR; PG8_WAIT_L(0); PG8_MMA(1, 0, At, B0); PG8_BAR; PG8_SCHED;
            PG8_STAGE(PG8_SB(0, 1), b2 + hstep, voffB);
            PG8_WAIT_V(6); PG8_BAR; PG8_MMA(1, 1, At, B1); PG8_BAR;
            PG8_LDB(B0, 1, 0); PG8_SCHED; PG8_LDA(At, 1, 0); PG8_STAGE(PG8_SA(0, 1), a2 + hstep, voffA);
            PG8_WAIT_L(8); PG8_BAR; PG8_WAIT_L(0); PG8_MMA(0, 0, At, B0); PG8_BAR; PG8_SCHED;
            PG8_LDB(B1, 1, 1); PG8_STAGE(PG8_SB(1, 0), b3, voffB);
            PG8_BAR; PG8_WAIT_L(0); PG8_MMA(0, 1, At, B1); PG8_BAR;
            PG8_LDA(At, 1, 1); PG8_STAGE(PG8_SA(1, 0), a3, voffA);
            PG8_BAR; PG8_WAIT_L(0); PG8_MMA(1, 0, At, B0); PG8_BAR; PG8_SCHED;
            PG8_STAGE(PG8_SB(1, 1), b3 + hstep, voffB);
            PG8_WAIT_V(6); PG8_BAR; PG8_MMA(1, 1, At, B1); PG8_BAR;
            }
        }
        if constexpr (ALIGN_EPI) { if (wr == 0) PG8_BAR; }
        if constexpr (!Epi::AFTER_DRAIN) { E(acc, cur, wr, wc, fr, fq); S.done(cur); }
        if (!has_next) break;
#pragma unroll
        for (int a = 0; a < 2; ++a)
#pragma unroll
            for (int b = 0; b < 2; ++b)
#pragma unroll
                for (int m = 0; m < 4; ++m)
#pragma unroll
                    for (int n = 0; n < 2; ++n) acc[a][b][m][n] = (f32x4){0.f, 0.f, 0.f, 0.f};
        cur = nxt; cA = nA; cB = nB; ++ui;
        if constexpr (ALIGN_EPI) { if (wr == 1) PG8_BAR; }
    }
    PG8_WAIT_V(0);
    if constexpr (!ALIGN_EPI) { if (wr == 0) PG8_BAR; }
    PG8_BAR;
    if constexpr (Epi::AFTER_DRAIN) { E.fused(acc, cur, wr, wc, fr, fq, lds, wid, lane); S.done(cur); }
#undef PG8_SA
#undef PG8_SB
#undef PG8_STAGE
#undef PG8_LDA
#undef PG8_LDB
#undef PG8_MMA
#undef PG8_WAIT_V
#undef PG8_WAIT_L
#undef PG8_BAR
#undef PG8_SCHED
}
}
#define PG8_SP2 true
#define PG8_ALIGN true
#include <hip/hip_bf16.h>
#include <cmath>
namespace attn_body {
using bf16=__hip_bfloat16;
using bf16x8=__attribute__((ext_vector_type(8)))short;
using s16x4=__attribute__((ext_vector_type(4)))short;
using f32x16=__attribute__((ext_vector_type(16)))float;
using u32x4=__attribute__((ext_vector_type(4)))unsigned;
constexpr int BATCH=8,NHEAD=16,SEQ=4096,D=64,DM=NHEAD*D;
constexpr int NW=8,QBLK=32,QB=QBLK*NW,KVBLK=64,NQB=SEQ/QB;
constexpr int ATTN_PITCH=DM, ATTN_UNIT_ROWS=QB;
__device__ __forceinline__ int crow(int r,int hi){return (r&3)+8*(r>>2)+4*hi;}
#define SBAR() __builtin_amdgcn_sched_barrier(0)
__device__ __forceinline__ void cmask(f32x16&p0,f32x16&p1,int jb,int qrel,int hi){
  const float NEG=-INFINITY; int kb=64*jb+4*hi;
  #pragma unroll
  for(int r=0;r<16;++r){int kv=kb+(r&3)+8*(r>>2); if(kv>qrel)p0[r]=NEG; if(kv+32>qrel)p1[r]=NEG;}
}

constexpr int NSLOT=3, SLOTB=8192, VSLOTB=16384;
constexpr int LDS_K=0, LDS_V=NSLOT*SLOTB, LDS_WS=LDS_V+NSLOT*VSLOTB, LDS_OST=LDS_WS+NW*64*4, LDS_BYTES=LDS_OST+NW*4096;
constexpr float C2=0.125f*1.4426950408889634f;
__device__ __forceinline__ void glds16(const void*gsrc,unsigned lds_dst){unsigned keep;
  asm volatile("s_mov_b32 %0, m0\n\ts_mov_b32 m0, %2\n\ts_nop 0\n\tglobal_load_lds_dwordx4 %1, off\n\ts_mov_b32 m0, %0":"=&s"(keep):"v"(gsrc),"s"(lds_dst):"memory");}
__device__ __forceinline__ float max3f(float a,float b,float c){float r;asm("v_max3_f32 %0, %1, %2, %3":"=v"(r):"v"(a),"v"(b),"v"(c));return r;}
__device__ __forceinline__ float max2f(float a,float b){float r;asm("v_max_f32_e32 %0, %1, %2":"=v"(r):"v"(a),"v"(b));return r;}
__device__ __forceinline__ float fadd_s(float a,float b){float r;asm("v_add_f32_e32 %0, %1, %2":"=v"(r):"v"(a),"v"(b));return r;}
__device__ __forceinline__ float fsub_s(float a,float b){float r;asm("v_sub_f32_e32 %0, %1, %2":"=v"(r):"v"(a),"v"(b));return r;}
typedef float f32x2_t __attribute__((ext_vector_type(2))); typedef __bf16 bf16x2_t __attribute__((ext_vector_type(2)));
__device__ __forceinline__ unsigned cvtpk_s(float lo,float hi){f32x2_t v={lo,hi};bf16x2_t b=__builtin_convertvector(v,bf16x2_t);return __builtin_bit_cast(unsigned,b);}
#define WAIT_BAR(N) asm volatile("s_waitcnt vmcnt(" #N ") lgkmcnt(0)\n\ts_barrier":::"memory")

__device__ __forceinline__ void qkt(f32x16&p0,f32x16&p1,const char*Kslot,const bf16x8*qr,const f32x16&negm,int r32,int hi){
  const char*kb=Kslot+hi*1024+r32*16;
  #pragma unroll
  for(int d0=0;d0<4;++d0){
    const bf16x8 b0=*reinterpret_cast<const bf16x8*>(kb+d0*2048);
    const bf16x8 b1=*reinterpret_cast<const bf16x8*>(kb+d0*2048+512);
    if(d0==0){p0=__builtin_amdgcn_mfma_f32_32x32x16_bf16(b0,qr[0],negm,0,0,0);p1=__builtin_amdgcn_mfma_f32_32x32x16_bf16(b1,qr[0],negm,0,0,0);}
    else{p0=__builtin_amdgcn_mfma_f32_32x32x16_bf16(b0,qr[d0],p0,0,0,0);p1=__builtin_amdgcn_mfma_f32_32x32x16_bf16(b1,qr[d0],p1,0,0,0);}}
}
typedef __attribute__((address_space(3))) const char* lds_cptr;
typedef short v4i16_t __attribute__((ext_vector_type(4)));
__device__ __forceinline__ void kload8(bf16x8*kf,lds_cptr kp){
  kf[0]=*(const __attribute__((address_space(3))) bf16x8*)(kp);      kf[1]=*(const __attribute__((address_space(3))) bf16x8*)(kp+512);
  kf[2]=*(const __attribute__((address_space(3))) bf16x8*)(kp+2048); kf[3]=*(const __attribute__((address_space(3))) bf16x8*)(kp+2560);
  kf[4]=*(const __attribute__((address_space(3))) bf16x8*)(kp+4096); kf[5]=*(const __attribute__((address_space(3))) bf16x8*)(kp+4608);
  kf[6]=*(const __attribute__((address_space(3))) bf16x8*)(kp+6144); kf[7]=*(const __attribute__((address_space(3))) bf16x8*)(kp+6656);
}
__device__ __forceinline__ void kload2(bf16x8*kf,lds_cptr kp,int j){ kf[2*j]=*(const __attribute__((address_space(3))) bf16x8*)(kp+j*2048); kf[2*j+1]=*(const __attribute__((address_space(3))) bf16x8*)(kp+j*2048+512); }
__device__ __forceinline__ s16x4 vtr(lds_cptr p){ return __builtin_bit_cast(s16x4,__builtin_amdgcn_ds_read_tr16_b64_v4i16((__attribute__((address_space(3))) v4i16_t*)p)); }
__device__ __forceinline__ float rowmax(const f32x16&p0,const f32x16&p1){
  float a=max3f(p0[0],p0[1],p1[0]),b=max3f(p0[2],p0[3],p1[1]);a=max3f(a,p1[2],p1[3]);
  #pragma unroll
  for(int r=4;r<16;r+=4){a=max3f(a,p0[r],p0[r+1]);b=max3f(b,p0[r+2],p0[r+3]);a=max3f(a,p1[r],p1[r+1]);b=max3f(b,p1[r+2],p1[r+3]);}
  const float m=max2f(a,b);
  auto rr=__builtin_amdgcn_permlane32_swap(__float_as_uint(m),__float_as_uint(m),false,false);
  return max2f(__uint_as_float(rr[0]),__uint_as_float(rr[1]));
}
__device__ __forceinline__ void pv(f32x16*o,int vb,bf16x8 pa0,bf16x8 pa1,bf16x8 pa2,bf16x8 pa3){
  #pragma unroll
  for(int d0=0;d0<4;++d0){s16x4 lo[4],hi[4];
    #pragma unroll
    for(int ks=0;ks<4;++ks){
      asm volatile("ds_read_b64_tr_b16 %0,%1 offset:%c2":"=&v"(lo[ks]):"v"(vb),"i"((d0>>1)*8192+(d0&1)*4096+ks*1024):"memory");
      asm volatile("ds_read_b64_tr_b16 %0,%1 offset:%c2":"=&v"(hi[ks]):"v"(vb),"i"((d0>>1)*8192+(d0&1)*4096+ks*1024+512):"memory");}
    asm volatile("s_waitcnt lgkmcnt(0)":::"memory");SBAR();
    #define PK(k) (bf16x8){lo[k][0],lo[k][1],lo[k][2],lo[k][3],hi[k][0],hi[k][1],hi[k][2],hi[k][3]}
    o[d0]=__builtin_amdgcn_mfma_f32_32x32x16_bf16(pa0,PK(0),o[d0],0,0,0);
    o[d0]=__builtin_amdgcn_mfma_f32_32x32x16_bf16(pa1,PK(1),o[d0],0,0,0);
    o[d0]=__builtin_amdgcn_mfma_f32_32x32x16_bf16(pa2,PK(2),o[d0],0,0,0);
    o[d0]=__builtin_amdgcn_mfma_f32_32x32x16_bf16(pa3,PK(3),o[d0],0,0,0);
    #undef PK
  }
}

#ifndef ATTN_STORE16
#define ATTN_STORE16(p,v) (*(u32x4*)(p)=(v))
#endif
template<int THRL> __device__ __forceinline__ void attn_unit(int b,int qb,const bf16*Q,const bf16*__restrict__ K,const bf16*__restrict__ V,bf16*O,char*shm){
  int tid_l=threadIdx.x; asm volatile("":"+v"(tid_l)); const int tid=tid_l,lane=tid&63,r32=lane&31,hi=lane>>5; const int wid=__builtin_amdgcn_readfirstlane(tid>>6);
  const long rowbase=(long)b*SEQ; const int q0=qb*QB; const lds_cptr shm3q=(lds_cptr)shm;
  const bf16*Qw=Q+(rowbase+q0+wid*QBLK)*DM;
  const bf16*Kh=K+rowbase*DM,*Vh=V+rowbase*DM;
  const unsigned lds0=(unsigned)(uintptr_t)shm;
  float*wsf=(float*)(shm+LDS_WS)+wid*64;
  const bf16*ksrc=Kh+(long)lane*DM+wid*8;
  const bf16*vsrc=Vh+(long)(16*(wid&3)+(lane>>2))*DM+(wid>>2)*32+(lane&3)*8;
  const unsigned kdst=lds0+LDS_K+wid*1024, vdst=lds0+LDS_V+wid*1024;
  #define DMA_K(t,slot) glds16(ksrc+(long)(t)*KVBLK*DM,(unsigned)__builtin_amdgcn_readfirstlane(kdst+(slot)))
  #define DMA_V(t,slot) do{ glds16(vsrc+(long)(t)*KVBLK*DM,(unsigned)__builtin_amdgcn_readfirstlane(vdst+2*(slot))); glds16(vsrc+64+(long)(t)*KVBLK*DM,(unsigned)__builtin_amdgcn_readfirstlane(vdst+2*(slot)+8192)); }while(0)
  const int vb0=(int)(lds0+LDS_V)+((lane>>4)&1)*32+(lane&3)*8+(4*hi+((lane&15)>>2))*64;
  const char*Kbase=shm+LDS_K; bf16x8 kf[8];
  const lds_cptr shm3=(lds_cptr)shm; const lds_cptr kp0=shm3+LDS_K+hi*1024+r32*16; const lds_cptr vp0=shm3+LDS_V+((lane>>4)&1)*32+(lane&3)*8+(4*hi+((lane&15)>>2))*64;
  const int NT=(q0+QB)/KVBLK;
  DMA_K(0,0);DMA_V(0,0);DMA_K(1,SLOTB);
  bf16x8 qr[4];
  #pragma unroll
  for(int d0=0;d0<4;++d0)qr[d0]=*reinterpret_cast<const bf16x8*>(&Qw[(long)r32*DM+d0*16+hi*8]);
  const lds_cptr qst3=shm3q+LDS_OST+wid*4096+lane*16;
  #define LDQ(d0) (*(const __attribute__((address_space(3))) bf16x8*)(qst3+(d0)*1024))
  float mhat=0.f,l_reg=0.f;f32x16 o[4];o[0]=f32x16{};o[1]=f32x16{};o[2]=f32x16{};o[3]=f32x16{};f32x16 negm=f32x16{};asm volatile("":"+v"(negm));
  const int qrel=wid*QBLK+r32;
  #define CMASK(P0,P1,t) do{int jb_=(t)-(NT-4); if(jb_>=0)cmask(P0,P1,jb_,qrel,hi);}while(0)
  bool resc=false;
  #define START(P0,P1) do{ const float rm=rowmax(P0,P1); resc=false; \
    { const float dl=rm; mhat=fadd_s(mhat,dl); \
      _Pragma("unroll") for(int r=0;r<16;++r){P0[r]=fsub_s(P0[r],dl);P1[r]=fsub_s(P1[r],dl);} \
      _Pragma("unroll") for(int r=0;r<16;++r)negm[r]=-mhat; asm volatile("":"+v"(negm)); } \
    _Pragma("unroll") for(int r=0;r<16;++r)P0[r]=__builtin_amdgcn_exp2f(P0[r]); }while(0)
  #define RESC() do{ if(resc){ asm volatile("s_waitcnt lgkmcnt(0)":::"memory"); \
      _Pragma("unroll") for(int d_=0;d_<4;++d_) _Pragma("unroll") for(int r=0;r<16;++r)o[d_][r]*=wsf[crow(r,hi)]; } }while(0)
  f32x16 pA0,pA1,pB0,pB1;
  int sl_prev=0,sl_cur=0,sl_next=SLOTB;
  #define ROT() do{sl_prev=sl_cur;sl_cur=sl_next;sl_next=(sl_next==(NSLOT-1)*SLOTB)?0:sl_next+SLOTB;}while(0)
  DMA_K(2,2*SLOTB);
  WAIT_BAR(3);
  qkt(pA0,pA1,Kbase,qr,negm,r32,hi);
  _Pragma("unroll") for(int d0=0;d0<4;++d0)*(__attribute__((address_space(3))) bf16x8*)(qst3+d0*1024)=qr[d0];
asm volatile("s_nop 15\n\ts_nop 7":"+v"(pA0),"+v"(pA1));CMASK(pA0,pA1,0);
  START(pA0,pA1);
  _Pragma("unroll") for(int r=0;r<16;++r)pA1[r]=__builtin_amdgcn_exp2f(pA1[r]);
  WAIT_BAR(0);
  DMA_K(3,0);DMA_V(1,SLOTB);
  ROT();
  kload8(kf,kp0+sl_cur);
  WAIT_BAR(3);
  s16x4 f0lo,f0hi,f1lo,f1hi,f2lo,f2hi,f3lo,f3hi; u32x4 pw0,pw1,pw2,pw3;
  #define PKW(P,B) cvtpk_s(P[B],P[B+1])
  #define PAF(k) __builtin_bit_cast(bf16x8,pw##k)
  #define VF(S) (bf16x8){S##lo[0],S##lo[1],S##lo[2],S##lo[3],S##hi[0],S##hi[1],S##hi[2],S##hi[3]}
  #define FOFF(i) (((i)>>2)*4096+((i)&3)*1024)
  #define VLD(S,off) do{ S##lo=vtr(vp_+(off)); S##hi=vtr(vp_+(off)+512); }while(0)
  #define PIN(x) asm volatile("":"+v"(x))
  #define MX3(a,b,c) __builtin_fmaxf(__builtin_fmaxf((a),(b)),(c))
  #define GAPA(MF,A0,A1,A2,A3,W0,W1,PW) do{ MF; sacc+=A0; sacc+=A1; sacc+=A2; sacc+=A3; PIN(sacc); W0; W1; PIN(PW); SBAR(); }while(0)
  #define EX(v) __builtin_amdgcn_exp2f(v)
  #define GAPB(MF,X,B) do{ MF; X[B]=EX(X[B]); X[B+1]=EX(X[B+1]); X[B+2]=EX(X[B+2]); X[B+3]=EX(X[B+3]); PIN(X); SBAR(); }while(0)
  #define GAPB2(MF,X,B) do{ MF; X[B]=EX(X[B]); X[B+1]=EX(X[B+1]); PIN(X); SBAR(); }while(0)
  #define KRD(G,j) do{ if(G){ kload2(kf,kp0+sl_next,j); SBAR(); } }while(0)
  #define STEP(C0,C1,P0,P1,t,GK,GV,GL) do{ SBAR(); \
    const lds_cptr vp_=vp0+2*sl_prev; \
    bf16x8 q_=LDQ(0); VLD(f0,FOFF(0)); SBAR(); float sacc=(P0[0]+P0[1]); \
    GAPA(C0=__builtin_amdgcn_mfma_f32_32x32x16_bf16(kf[0],q_,negm,0,0,0), P0[2],P0[3],P0[4],P0[5],     pw0[0]=PKW(P0,0), pw0[1]=PKW(P0,2), pw0); \
    VLD(f1,FOFF(4)); SBAR(); GAPA(C1=__builtin_amdgcn_mfma_f32_32x32x16_bf16(kf[1],q_,negm,0,0,0), P0[6],P0[7],P0[8],P0[9],     pw0[2]=PKW(P0,4), pw0[3]=PKW(P0,6), pw0); \
    q_=LDQ(1); VLD(f2,FOFF(1)); SBAR(); GAPA(C0=__builtin_amdgcn_mfma_f32_32x32x16_bf16(kf[2],q_,C0,0,0,0),   P0[10],P0[11],P0[12],P0[13], pw1[0]=PKW(P0,8), pw1[1]=PKW(P0,10), pw1); \
    VLD(f3,FOFF(5)); SBAR(); GAPA(C1=__builtin_amdgcn_mfma_f32_32x32x16_bf16(kf[3],q_,C1,0,0,0),   P0[14],P0[15],P1[0],P1[1],   pw1[2]=PKW(P0,12),pw1[3]=PKW(P0,14), pw1); \
    q_=LDQ(2); SBAR(); GAPA(C0=__builtin_amdgcn_mfma_f32_32x32x16_bf16(kf[4],q_,C0,0,0,0),   P1[2],P1[3],P1[4],P1[5],     pw2[0]=PKW(P1,0), pw2[1]=PKW(P1,2), pw2); \
    GAPA(C1=__builtin_amdgcn_mfma_f32_32x32x16_bf16(kf[5],q_,C1,0,0,0),   P1[6],P1[7],P1[8],P1[9],     pw2[2]=PKW(P1,4), pw2[3]=PKW(P1,6), pw2); \
    q_=LDQ(3); SBAR(); GAPA(C0=__builtin_amdgcn_mfma_f32_32x32x16_bf16(kf[6],q_,C0,0,0,0),   P1[10],P1[11],P1[12],P1[13], pw3[0]=PKW(P1,8), pw3[1]=PKW(P1,10), pw3); \
    GAPA(C1=__builtin_amdgcn_mfma_f32_32x32x16_bf16(kf[7],q_,C1,0,0,0),   P1[14],P1[15],0.f,0.f,       pw3[2]=PKW(P1,12),pw3[3]=PKW(P1,14), pw3); \
    l_reg+=sacc; \
    if(GK){DMA_K((t)+3,sl_cur);} if(GV){DMA_V((t)+1,sl_next);} \
    CMASK(C0,C1,t); \
    { float a=MX3(C0[0],C0[1],C1[0]),b=MX3(C0[2],C0[3],C1[1]); a=MX3(a,C1[2],C1[3]); \
      _Pragma("unroll") for(int r=4;r<16;r+=4){a=MX3(a,C0[r],C0[r+1]);b=MX3(b,C0[r+2],C0[r+3]);a=MX3(a,C1[r],C1[r+1]);b=MX3(b,C1[r+2],C1[r+3]);} \
      float rm=__builtin_fmaxf(a,b); { auto rr=__builtin_amdgcn_permlane32_swap(__float_as_uint(rm),__float_as_uint(rm),false,false); rm=__builtin_fmaxf(__uint_as_float(rr[0]),__uint_as_float(rr[1])); } \
      resc=false; \
      if(__builtin_expect(__any(rm>(float)THRL),0)){ const float dl=__builtin_fmaxf(rm,0.f); mhat+=dl; \
        _Pragma("unroll") for(int r=0;r<16;++r){C0[r]-=dl;C1[r]-=dl;} \
        _Pragma("unroll") for(int r=0;r<16;++r)negm[r]=-mhat; asm volatile("":"+v"(negm)); \
        const float f=__builtin_amdgcn_exp2f(-dl); l_reg*=f; if(hi==0)wsf[r32]=f; resc=true; } } \
    SBAR(); \
      \
    GAPB2(o[0]=__builtin_amdgcn_mfma_f32_32x32x16_bf16(PAF(0),VF(f0),o[0],0,0,0), C0,0);  VLD(f0,FOFF(2)); SBAR(); \
    GAPB2(o[1]=__builtin_amdgcn_mfma_f32_32x32x16_bf16(PAF(0),VF(f1),o[1],0,0,0), C0,2);  VLD(f1,FOFF(6)); SBAR(); \
    KRD(GL,0); GAPB2(o[0]=__builtin_amdgcn_mfma_f32_32x32x16_bf16(PAF(1),VF(f2),o[0],0,0,0), C0,4);  VLD(f2,FOFF(3)); SBAR(); \
    KRD(GL,1); GAPB2(o[1]=__builtin_amdgcn_mfma_f32_32x32x16_bf16(PAF(1),VF(f3),o[1],0,0,0), C0,6);  VLD(f3,FOFF(7)); SBAR(); \
    KRD(GL,2); GAPB2(o[0]=__builtin_amdgcn_mfma_f32_32x32x16_bf16(PAF(2),VF(f0),o[0],0,0,0), C0,8);  VLD(f0,8192+FOFF(0)); SBAR(); \
    KRD(GL,3); GAPB2(o[1]=__builtin_amdgcn_mfma_f32_32x32x16_bf16(PAF(2),VF(f1),o[1],0,0,0), C0,10); VLD(f1,8192+FOFF(4)); SBAR(); \
    GAPB2(o[0]=__builtin_amdgcn_mfma_f32_32x32x16_bf16(PAF(3),VF(f2),o[0],0,0,0), C0,12); VLD(f2,8192+FOFF(1)); SBAR(); \
    GAPB2(o[1]=__builtin_amdgcn_mfma_f32_32x32x16_bf16(PAF(3),VF(f3),o[1],0,0,0), C0,14); VLD(f3,8192+FOFF(5)); SBAR(); \
    GAPB2(o[2]=__builtin_amdgcn_mfma_f32_32x32x16_bf16(PAF(0),VF(f0),o[2],0,0,0), C1,0);  VLD(f0,8192+FOFF(2)); SBAR(); \
    GAPB2(o[3]=__builtin_amdgcn_mfma_f32_32x32x16_bf16(PAF(0),VF(f1),o[3],0,0,0), C1,2);  VLD(f1,8192+FOFF(6)); SBAR(); \
    GAPB2(o[2]=__builtin_amdgcn_mfma_f32_32x32x16_bf16(PAF(1),VF(f2),o[2],0,0,0), C1,4);  VLD(f2,8192+FOFF(3)); SBAR(); \
    GAPB2(o[3]=__builtin_amdgcn_mfma_f32_32x32x16_bf16(PAF(1),VF(f3),o[3],0,0,0), C1,6);  VLD(f3,8192+FOFF(7)); SBAR(); \
    GAPB2(o[2]=__builtin_amdgcn_mfma_f32_32x32x16_bf16(PAF(2),VF(f0),o[2],0,0,0), C1,8); \
    GAPB2(o[3]=__builtin_amdgcn_mfma_f32_32x32x16_bf16(PAF(2),VF(f1),o[3],0,0,0), C1,10); \
    GAPB2(o[2]=__builtin_amdgcn_mfma_f32_32x32x16_bf16(PAF(3),VF(f2),o[2],0,0,0), C1,12); \
    GAPB2(o[3]=__builtin_amdgcn_mfma_f32_32x32x16_bf16(PAF(3),VF(f3),o[3],0,0,0), C1,14); \
    }while(0)
  int t=1;
  #undef CMASK
  #define CMASK(P0,P1,t) do{}while(0)
  for(;t+5<NT;t+=2){
    STEP(pB0,pB1,pA0,pA1,t,true,true,true);     WAIT_BAR(3); RESC(); ROT();
    STEP(pA0,pA1,pB0,pB1,t+1,true,true,true);   WAIT_BAR(3); RESC(); ROT();
  }
  #undef CMASK
  #define CMASK(P0,P1,t) do{int jb_=(t)-(NT-4); if(jb_>=0)cmask(P0,P1,jb_,qrel,hi);}while(0)
  #define ENDW(tt) do{ if((tt)+3<NT){WAIT_BAR(3);} else if((tt)+2<NT){WAIT_BAR(2);} else {WAIT_BAR(0);} }while(0)
  for(;t+1<NT;t+=2){
    STEP(pB0,pB1,pA0,pA1,t,(t+3<NT),(t+1<NT),(t+1<NT));       ENDW(t);   RESC(); ROT();
    STEP(pA0,pA1,pB0,pB1,t+1,(t+4<NT),(t+2<NT),(t+2<NT));     ENDW(t+1); RESC(); ROT();
  }
  STEP(pB0,pB1,pA0,pA1,NT-1,false,false,false); RESC();
  { float sacc=pB0[0]+pB0[1]; _Pragma("unroll") for(int r=2;r<16;++r)sacc+=pB0[r]; _Pragma("unroll") for(int r=0;r<16;++r)sacc+=pB1[r]; l_reg+=sacc;
    pw0=(u32x4){PKW(pB0,0),PKW(pB0,2),PKW(pB0,4),PKW(pB0,6)};pw1=(u32x4){PKW(pB0,8),PKW(pB0,10),PKW(pB0,12),PKW(pB0,14)};pw2=(u32x4){PKW(pB1,0),PKW(pB1,2),PKW(pB1,4),PKW(pB1,6)};pw3=(u32x4){PKW(pB1,8),PKW(pB1,10),PKW(pB1,12),PKW(pB1,14)};
    SBAR(); pv(o,vb0+2*sl_cur,PAF(0),PAF(1),PAF(2),PAF(3)); }
  #undef PKW
  #undef PAF
  #undef VF
  #undef FOFF
  #undef VLD
  #undef LDQ
  #undef PIN
  #undef MX3
  #undef GAPA
  #undef GAPB
  #undef EX
  #undef GAPB2
  #undef KRD
  #undef STEP
  #undef ENDW
  {auto rr=__builtin_amdgcn_permlane32_swap(__float_as_uint(l_reg),__float_as_uint(l_reg),false,false);l_reg=__uint_as_float(rr[0])+__uint_as_float(rr[1]);}
  if(hi==0)wsf[32+r32]=l_reg;asm volatile("s_waitcnt lgkmcnt(0)":::"memory");
  float rli[16];
  #pragma unroll
  for(int r=0;r<16;++r)rli[r]=__builtin_amdgcn_rcpf(wsf[32+crow(r,hi)]);
  bf16*Ow=O+(rowbase+q0+wid*QBLK)*DM;
  { bf16*stg=(bf16*)(shm+LDS_OST)+wid*2048;
    #pragma unroll
    for(int h2=0;h2<2;++h2){
      #pragma unroll
      for(int r=0;r<16;++r){const int orow=crow(r,hi);
        #pragma unroll
        for(int d0=0;d0<2;++d0)stg[orow*64+d0*32+r32]=__float2bfloat16(o[2*h2+d0][r]*rli[r]);}
      asm volatile("s_waitcnt lgkmcnt(0)":::"memory");
      #pragma unroll
      for(int i=0;i<4;++i){const int row=i*8+(lane>>3),ch=lane&7; const u32x4 v=*(const u32x4*)(stg+row*64+ch*8); ATTN_STORE16(Ow+(long)row*DM+h2*64+ch*8,v);}
      asm volatile("s_waitcnt lgkmcnt(0)":::"memory"); } }
  asm volatile("s_waitcnt lgkmcnt(0)\n\ts_barrier":::"memory");
  #undef DMA_K
  #undef DMA_V
  #undef CMASK
  #undef START
  #undef RESC
  #undef ROT
}
constexpr int ATTN_LDS_BYTES=LDS_BYTES;
#undef SBAR
#undef WAIT_BAR
}
#define GAS __attribute__((address_space(1)))
#define LAS __attribute__((address_space(3)))
typedef unsigned short bf16;
typedef unsigned v4u __attribute__((ext_vector_type(4)));
typedef float f32x4 __attribute__((ext_vector_type(4)));
typedef short bf16x8 __attribute__((ext_vector_type(8)));
typedef GAS unsigned gu32;
typedef GAS unsigned long long gu64;
#define RLX_AGENT __ATOMIC_RELAXED, __HIP_MEMORY_SCOPE_AGENT
#define LDS_WAIT() asm volatile("s_waitcnt lgkmcnt(0)" ::: "memory")
#define VM_WAIT() asm volatile("s_waitcnt vmcnt(0)" ::: "memory")
__device__ __forceinline__ unsigned long long rt() { return __builtin_amdgcn_s_memrealtime(); }
__device__ __forceinline__ unsigned f2bf(float f) { unsigned u = __builtin_bit_cast(unsigned, f); return (u + 0x7fffu + ((u >> 16) & 1u)) >> 16; }
__device__ __forceinline__ unsigned pk2(float lo, float hi) { return f2bf(lo) | (f2bf(hi) << 16); }

#define XB_TMO      128
#define XB_XCNT(j)  (256  + 64 * (j))
#define XB_XSUB(j)  (1280 + 64 * (j))
#define XB_XGEN(j)  (2304 + 64 * (j))
#define XB_TOP      3328
#define XB_TOPGEN   3392
#define XCD_BAR_WORDS 3456
#define XB_SPIN_CAP (1u << 18)

__device__ __forceinline__ unsigned xb_ld(unsigned* p)              { return __hip_atomic_load(p, __ATOMIC_RELAXED, __HIP_MEMORY_SCOPE_AGENT); }
__device__ __forceinline__ unsigned xb_add(unsigned* p, unsigned v) { return __hip_atomic_fetch_add(p, v, __ATOMIC_RELAXED, __HIP_MEMORY_SCOPE_AGENT); }
__device__ __forceinline__ unsigned xb_xcc_id() { return (unsigned)__builtin_amdgcn_s_getreg((3 << 11) | 20) & 0xFu; }
#define XB_SPIN(cond, bar) do { unsigned _sp = 0; while (cond) { __builtin_amdgcn_s_sleep(1); \
    if ((++_sp & 255u) == 0u) { if (xb_ld(&(bar)[XB_TMO])) break; if (_sp > XB_SPIN_CAP) { atomicAdd(&(bar)[XB_TMO], 1u); break; } } } } while (0)

struct XcdBarrier {
    unsigned* bar; unsigned x; unsigned tot;
    volatile LAS unsigned* st;
};

__device__ __forceinline__ XcdBarrier xcd_barrier_post(unsigned* bar, volatile LAS unsigned* st, unsigned tot) {
    XcdBarrier b; b.bar = bar; b.x = xb_xcc_id(); b.st = st; b.tot = tot;
    if (threadIdx.x == 0) (void)xb_add(&bar[XB_XCNT(b.x)], 1u);
    return b;
}
__device__ __forceinline__ void xcd_barrier_complete(unsigned* bar, unsigned x, unsigned G, unsigned& nloc, unsigned& nx) {
    unsigned sum, cnt, mine, sp = 0u;
    for (;;) {
        sum = 0u; cnt = 0u; mine = 0u;
#pragma unroll
        for (unsigned j = 0; j < 16; ++j) { const unsigned c = xb_ld(&bar[XB_XCNT(j)]); sum += c; cnt += (c > 0u) ? 1u : 0u; mine = (j == x) ? c : mine; }
        if (sum == G) break;
        __builtin_amdgcn_s_sleep(1);
        if ((++sp & 255u) == 0u) { if (xb_ld(&bar[XB_TMO])) break; if (sp > XB_SPIN_CAP) { atomicAdd(&bar[XB_TMO], 1u); break; } }
    }
    nloc = mine > 0u ? mine : 1u; nx = cnt > 0u ? cnt : 1u;
}

__device__ __forceinline__ void xcd_barrier(const XcdBarrier& b) {
    asm volatile("s_waitcnt vmcnt(0)" ::: "memory");
    __syncthreads();
    if (threadIdx.x == 0) {
        size_t zoff_ = 0; asm volatile("" : "+s"(zoff_)); unsigned* bar = b.bar + zoff_; unsigned bx_ = b.x; asm volatile("" : "+s"(bx_));
        __builtin_amdgcn_s_waitcnt(0);
        unsigned nloc = b.st[0], nx = b.st[1];
        if (nloc == 0u) { xcd_barrier_complete(bar, bx_, b.tot, nloc, nx); b.st[0] = nloc; b.st[1] = nx; }
        const unsigned old = xb_add(&bar[XB_XSUB(bx_)], 1u);
        const unsigned gen = old / nloc;
        if (old + 1u == (gen + 1u) * nloc) {
            __builtin_amdgcn_fence(__ATOMIC_RELEASE, "agent");
            asm volatile("s_waitcnt vmcnt(0)" ::: "memory");
            const unsigned og = xb_add(&bar[XB_TOP], 1u);
            const unsigned tg = og / nx;
            if (og + 1u == (tg + 1u) * nx) xb_add(&bar[XB_TOPGEN], 1u);
            else XB_SPIN(xb_ld(&bar[XB_TOPGEN]) == tg, bar);
            __builtin_amdgcn_fence(__ATOMIC_ACQUIRE, "agent");
            xb_add(&bar[XB_XGEN(bx_)], 1u);
            asm volatile("s_waitcnt vmcnt(0)" ::: "memory");
        } else {
            XB_SPIN(xb_ld(&bar[XB_XGEN(bx_)]) == gen, bar);
            __builtin_amdgcn_fence(__ATOMIC_ACQUIRE, "agent");
            asm volatile("s_waitcnt vmcnt(0)" ::: "memory");
        }
    }
    __syncthreads();
}
constexpr int NWAVES = 8;
constexpr int BATCH = 8, SEQ = 4096, DMODEL = 1024, NTOK = BATCH * SEQ, DEPTH = 2, IN_COLS = 2816;
constexpr int NEXP = 16384, PEER_H = 8, PEER_K = 16;
constexpr float RMS_EPS = 1e-6f, LN_EPS = 1e-5f;
constexpr size_t MiB = 1u << 20;
constexpr size_t WS_CTL = 0, CTL_ZERO_BYTES = 1 * MiB;
constexpr size_t WS_WIN = 2 * MiB;
constexpr size_t WS_WOUT = 13 * MiB;
constexpr size_t WS_WQ = 17 * MiB;
constexpr size_t WS_KEYS = 25 * MiB;
constexpr size_t WS_RINV = 26 * MiB;
constexpr size_t WS_SSQ = 27 * MiB;
constexpr size_t WS_EID = 30 * MiB;
constexpr size_t WS_GATE = 38 * MiB;
constexpr size_t WS_SB = 54 * MiB;
constexpr size_t WS_XBF = 72 * MiB;
constexpr size_t WS_QK = 136 * MiB;
constexpr size_t WS_VX = 200 * MiB;
constexpr size_t WS_UT = 264 * MiB;
constexpr size_t WS_VT = 296 * MiB;
constexpr size_t WS_SU = 328 * MiB;
constexpr size_t WS_SV = WS_SU + 16;
constexpr size_t WS_EIDT = 330 * MiB;
constexpr size_t WS_CORR = 338 * MiB;
constexpr size_t WS_SSQX = 339 * MiB;
constexpr size_t WS_XQ = 344 * MiB;
constexpr size_t WS_XQS = 376 * MiB;
constexpr size_t WS_CAT = 377 * MiB;
constexpr size_t WS_O = 441 * MiB;
constexpr size_t WS_WSC = 340 * MiB;
constexpr size_t WS_END = 505 * MiB;
constexpr size_t WS_PART = WS_QK;
constexpr size_t WS_WT = WS_SB;
constexpr int CW_BAR = 4096;
constexpr int RING_OFF = 0, RING_BYTES = 131072;
constexpr int LDSCTL_OFF = RING_BYTES, MISC_OFF = LDSCTL_OFF + 320;
constexpr int LDS_BYTES = 147456;

__device__ __forceinline__ unsigned pkbf(float lo, float hi) { unsigned r; asm("v_cvt_pk_bf16_f32 %0, %1, %2" : "=v"(r) : "v"(lo), "v"(hi)); return r; }
__device__ __forceinline__ float bflo(unsigned w) { return __builtin_bit_cast(float, w << 16); }
__device__ __forceinline__ float bfhi(unsigned w) { return __builtin_bit_cast(float, w & 0xffff0000u); }
__device__ __forceinline__ float bf1(unsigned short w) { return __builtin_bit_cast(float, (unsigned)w << 16); }
__device__ __forceinline__ float vmaxf_(float a, float b) { float r; asm("v_max_f32 %0, %1, %2" : "=v"(r) : "v"(a), "v"(b)); return r; }
#define DPP_MAXF(v, ctrl) vmaxf_((v), __builtin_bit_cast(float, __builtin_amdgcn_update_dpp(0, __builtin_bit_cast(int, (v)), (ctrl), 0xf, 0xf, true)))
#define DPP_ADD(v, ctrl) ((v) + __builtin_bit_cast(float, __builtin_amdgcn_update_dpp(0, __builtin_bit_cast(int, (v)), (ctrl), 0xf, 0xf, true)))
__device__ __forceinline__ float swap_sum16(float v) { const unsigned u = __builtin_bit_cast(unsigned, v); auto r = __builtin_amdgcn_permlane16_swap(u, u, false, false); return __builtin_bit_cast(float, (unsigned)r[0]) + __builtin_bit_cast(float, (unsigned)r[1]); }
__device__ __forceinline__ float swap_sum32(float v) { const unsigned u = __builtin_bit_cast(unsigned, v); auto r = __builtin_amdgcn_permlane32_swap(u, u, false, false); return __builtin_bit_cast(float, (unsigned)r[0]) + __builtin_bit_cast(float, (unsigned)r[1]); }
__device__ __forceinline__ float wave_sum(float v) {
    v = DPP_ADD(v, 0xB1);
    v = DPP_ADD(v, 0x4E);
    v = DPP_ADD(v, 0x141);
    v = DPP_ADD(v, 0x140);
    return swap_sum32(swap_sum16(v));
}

__device__ __forceinline__ int win_src(int np) {
    const int p = np >> 8, pc = np & 255;
    if (p < 4) return 256 * p + 64 * ((pc & 127) >> 5) + 32 * (pc >> 7) + (pc & 31);
    if (p < 6) return np;
    if (p < 8) { const int kk = p - 6; return pc < 128 ? 1536 + 128 * kk + pc : 1792 + 128 * kk + (pc - 128); }
    if (p < 10) { const int kk = p - 8; return pc < 128 ? 2304 + 128 * kk + pc : 2560 + 128 * kk + (pc - 128); }
    return 2048 + pc;
}
template <int MODE> __device__ __forceinline__ void p0_transpose_item(const float* W, const float* gain, int K, int N, bf16* WT, LAS float* scr, int item, int lane) {
    const int nblk = N / 32, kb = item / nblk, nb = item % nblk, k0 = 64 * kb, n0p = 32 * nb;
    const int n0 = MODE == 1 ? win_src(n0p) : n0p;
    float wv[32];
#pragma unroll
    for (int i = 0; i < 32; ++i) { const int kk = 2 * i + (lane >> 5); wv[i] = W[(size_t)(k0 + kk) * N + n0 + (lane & 31)]; }
#pragma unroll
    for (int i = 0; i < 32; ++i) { const int kk = 2 * i + (lane >> 5); const float gk = gain ? gain[k0 + kk] : 1.f; scr[kk * 33 + (lane & 31)] = wv[i] * gk; }
    LDS_WAIT(); asm volatile("" ::: "memory");
    const int c = lane & 7;
#pragma unroll
    for (int j = 0; j < 4; ++j) { const int n = (lane >> 3) + 8 * j; const LAS float* s = scr + (8 * c) * 33 + n;
        v4u o; o.x = pk2(s[0 * 33], s[1 * 33]); o.y = pk2(s[2 * 33], s[3 * 33]); o.z = pk2(s[4 * 33], s[5 * 33]); o.w = pk2(s[6 * 33], s[7 * 33]);
        *(GAS v4u*)(WT + (size_t)(n0p + n) * K + k0 + 8 * c) = o; }
    LDS_WAIT(); asm volatile("" ::: "memory");
}
__device__ __forceinline__ void p0_convert(const float* src, bf16* dst, size_t n, int gtid, int ngt) {
    for (size_t i = (size_t)gtid * 8; i < n; i += (size_t)ngt * 8) {
        const f32x4 a = *(const GAS f32x4*)(src + i), b = *(const GAS f32x4*)(src + i + 4);
        v4u o; o.x = pk2(a.x, a.y); o.y = pk2(a.z, a.w); o.z = pk2(b.x, b.y); o.w = pk2(b.z, b.w);
        *(GAS v4u*)(dst + i) = o; }
}
__device__ __forceinline__ float wave_max(float v) {
    v = DPP_MAXF(v, 0xB1); v = DPP_MAXF(v, 0x4E); v = DPP_MAXF(v, 0x141); v = DPP_MAXF(v, 0x140);
    const int b = __builtin_bit_cast(int, v);
    const float m01 = vmaxf_(__builtin_bit_cast(float, __builtin_amdgcn_readlane(b, 0)), __builtin_bit_cast(float, __builtin_amdgcn_readlane(b, 16)));
    const float m23 = vmaxf_(__builtin_bit_cast(float, __builtin_amdgcn_readlane(b, 32)), __builtin_bit_cast(float, __builtin_amdgcn_readlane(b, 48)));
    return vmaxf_(m01, m23);
}
template <int OFFS> __device__ __forceinline__ void p0_quant_row(const float* src, unsigned char* dst_base, int e, float* scale_out, int lane) {
    const GAS f32x4* xr = (const GAS f32x4*)src + 4 * lane;
    f32x4 v[4]; float m = 0.f;
#pragma unroll
    for (int j = 0; j < 4; ++j) { v[j] = __builtin_nontemporal_load(xr + j); m = fmaxf(fmaxf(m, fmaxf(fabsf(v[j].x), fabsf(v[j].y))), fmaxf(fabsf(v[j].z), fabsf(v[j].w))); }
    m = wave_max(m);
    const float inv = m > 0.f ? 127.0f / m : 0.f;
    v4u o;
#pragma unroll
    for (int j = 0; j < 4; ++j) { const int a = (int)rintf(v[j].x * inv) + OFFS, b = (int)rintf(v[j].y * inv) + OFFS, c = (int)rintf(v[j].z * inv) + OFFS, d = (int)rintf(v[j].w * inv) + OFFS;
        o[j] = (unsigned)(a & 0xff) | ((unsigned)(b & 0xff) << 8) | ((unsigned)(c & 0xff) << 16) | ((unsigned)(d & 0xff) << 24); }
    *(GAS v4u*)(dst_base + ((size_t)(lane >> 3) * NEXP + e) * 128 + 16 * (lane & 7)) = o;
    if (lane == 0) *scale_out = m * (1.0f / 127.0f);
}
struct QRow { f32x4 v[4]; };
__device__ __forceinline__ void p0_quant_load(QRow& q, const float* src, int lane) { const GAS f32x4* xr = (const GAS f32x4*)src + 4 * lane;
#pragma unroll
    for (int j = 0; j < 4; ++j) q.v[j] = __builtin_nontemporal_load(xr + j); }
__device__ __forceinline__ void p0_quant_fin(const QRow& q, const float* gain, unsigned char* dst_base, int e, float* scale_out, int lane) {
    f32x4 v[4]; float m = 0.f;
#pragma unroll
    for (int j = 0; j < 4; ++j) { v[j] = q.v[j]; if (gain) v[j] = v[j] * *((const GAS f32x4*)gain + 4 * lane + j); m = fmaxf(fmaxf(m, fmaxf(fabsf(v[j].x), fabsf(v[j].y))), fmaxf(fabsf(v[j].z), fabsf(v[j].w))); }
    m = DPP_MAXF(m, 0xB1); m = DPP_MAXF(m, 0x4E); m = DPP_MAXF(m, 0x141); m = DPP_MAXF(m, 0x140);
    const float inv = m > 0.f ? 7.0f * __builtin_amdgcn_rcpf(m) : 0.f;
    unsigned o[2];
#pragma unroll
    for (int k = 0; k < 2; ++k) { const f32x4 lo = v[2 * k], hi = v[2 * k + 1];
#define Q4(x) ((unsigned)((int)rintf((x) * inv) + 8) & 0xfu)
        if (gain) o[k] = (Q4(lo.x) | (Q4(hi.x) << 4)) | ((Q4(lo.y) | (Q4(hi.y) << 4)) << 8) | ((Q4(lo.z) | (Q4(hi.z) << 4)) << 16) | ((Q4(lo.w) | (Q4(hi.w) << 4)) << 24);
        else      o[k] = (Q4(lo.x) | (Q4(lo.y) << 4)) | ((Q4(lo.z) | (Q4(lo.w) << 4)) << 8) | ((Q4(hi.x) | (Q4(hi.y) << 4)) << 16) | ((Q4(hi.z) | (Q4(hi.w) << 4)) << 24);
#undef Q4
    }
    const unsigned hx = gain ? 0u : 0x80808080u;
    *(GAS unsigned long long*)(dst_base + ((size_t)(lane >> 4) * NEXP + e) * 128 + 8 * (lane & 15)) = (unsigned long long)(o[0] ^ hx) | ((unsigned long long)(o[1] ^ hx) << 32);
    if ((lane & 15) == 0) scale_out[8 * e + (lane >> 4)] = m * (1.0f / 7.0f);
}
__device__ __forceinline__ void p0_quant_row4(const float* src, const float* gain, unsigned char* dst_base, int e, float* scale_out, int lane) { QRow q; p0_quant_load(q, src, lane); p0_quant_fin(q, gain, dst_base, e, scale_out, lane); }
__device__ __forceinline__ void p0_x_row(const float* xrow, bf16* orow, float* rinv_out, int lane) {
    const GAS f32x4* xr = (const GAS f32x4*)xrow + lane;
    f32x4 v[4]; float s = 0.f;
#pragma unroll
    for (int j = 0; j < 4; ++j) { v[j] = xr[64 * j]; s += (v[j].x * v[j].x + v[j].y * v[j].y) + (v[j].z * v[j].z + v[j].w * v[j].w); }
    s = wave_sum(s);
    GAS unsigned long long* o8 = (GAS unsigned long long*)orow + lane;
#pragma unroll
    for (int j = 0; j < 4; ++j) o8[64 * j] = (unsigned long long)pk2(v[j].x, v[j].y) | ((unsigned long long)pk2(v[j].z, v[j].w) << 32);
    if (lane < 8) rinv_out[lane] = lane == 0 ? s : 0.f;
}

__device__ __forceinline__ float wave_sum_shfl(float v) {
#pragma unroll
    for (int o = 1; o < 64; o <<= 1) v += __shfl_xor(v, o);
    return v;
}
struct XqRow { v4u a, b; };
__device__ __forceinline__ void xq_load(XqRow& r, const bf16* xrow, int lane) { const GAS v4u* xp = (const GAS v4u*)xrow + 2 * lane; r.a = xp[0]; r.b = xp[1]; }
__device__ __forceinline__ void xq_fin(const XqRow& r, signed char* qrow, float* sc4, int lane) {
    const v4u a = r.a, b = r.b;
#define AMX(w) fmaxf(fabsf(bflo(w)), fabsf(bfhi(w)))
    float am = fmaxf(fmaxf(fmaxf(AMX(a.x), AMX(a.y)), fmaxf(AMX(a.z), AMX(a.w))), fmaxf(fmaxf(AMX(b.x), AMX(b.y)), fmaxf(AMX(b.z), AMX(b.w))));
#undef AMX
    am = DPP_MAXF(am, 0xB1); am = DPP_MAXF(am, 0x4E); am = DPP_MAXF(am, 0x141); am = DPP_MAXF(am, 0x140);
    const float qinv = am > 0.f ? 127.0f * __builtin_amdgcn_rcpf(am) : 0.f;
#define PK4(wa, wb) (unsigned)(((int)rintf(bflo(wa) * qinv) & 0xff) | (((int)rintf(bfhi(wa) * qinv) & 0xff) << 8) | (((int)rintf(bflo(wb) * qinv) & 0xff) << 16) | (((int)rintf(bfhi(wb) * qinv) & 0xff) << 24))
    v4u o; o.x = PK4(a.x, a.y); o.y = PK4(a.z, a.w); o.z = PK4(b.x, b.y); o.w = PK4(b.z, b.w);
#undef PK4
    *((GAS v4u*)qrow + lane) = o;
    if ((lane & 15) == 0) sc4[lane >> 4] = am * (1.0f / 127.0f);
}
struct QuantJob { const float* usrc; const float* vsrc; const float* gain; unsigned char* UT; unsigned char* VT; float* SU; float* SV; int r0, rs; };
struct CmbArgs { const bf16* O; const bf16* VX; const bf16* SB; bf16* CAT; const float* lq1; const float* lk1; const float* lq2; const float* lk2; const float* subg;
                 const float* cfw; const float* cfb; const float* lng; const float* lnb; const float* scw; float lam_init; };
__device__ __forceinline__ float cmb_lambda(const CmbArgs& A, int lane) { return __expf(wave_sum(A.lq1[lane] * A.lk1[lane])) - __expf(wave_sum(A.lq2[lane] * A.lk2[lane])) + A.lam_init; }
__device__ __forceinline__ void cmb_rows(const CmbArgs& A, float lam, int h, int trow0, int lane_in) {
    asm volatile("s_waitcnt vmcnt(0)" ::: "memory");
    int lane = lane_in; asm volatile("" : "+v"(lane));
    const int vh = lane >> 5, dd = (2 * lane) & 63;
    const int c0 = (4 * h + vh) * 64 + dd, c1 = (4 * h + 2 + vh) * 64 + dd;
    const float g0 = A.subg[2 * lane] * (1.0f - A.lam_init), g1 = A.subg[2 * lane + 1] * (1.0f - A.lam_init);
    unsigned o0[32], o1[32];
#pragma unroll
    for (int tt = 0; tt < 32; ++tt) { const size_t rb = (size_t)(trow0 + tt) * 1024;
        o0[tt] = __hip_atomic_load((const GAS unsigned*)(A.O + rb + c0), __ATOMIC_RELAXED, __HIP_MEMORY_SCOPE_AGENT); o1[tt] = __hip_atomic_load((const GAS unsigned*)(A.O + rb + c1), __ATOMIC_RELAXED, __HIP_MEMORY_SCOPE_AGENT); }
#pragma unroll
    for (int tt = 0; tt < 32; ++tt) {
        const float a0 = bflo(o0[tt]) - lam * bflo(o1[tt]), a1 = bfhi(o0[tt]) - lam * bfhi(o1[tt]);
        const float ss = wave_sum(a0 * a0 + a1 * a1);
        const float ri = __builtin_amdgcn_rsqf(ss * (1.0f / 128.0f) + RMS_EPS);
        *(GAS unsigned*)(A.CAT + (size_t)(trow0 + tt) * 1024 + h * 128 + 2 * lane) = pkbf(a0 * ri * g0, a1 * ri * g1); }
}
__device__ __forceinline__ float half_sum(float v, bool upper) {
    (void)upper;
    v = DPP_ADD(v, 0xB1); v = DPP_ADD(v, 0x4E); v = DPP_ADD(v, 0x141); v = DPP_ADD(v, 0x140);
    return swap_sum16(v);
}
__device__ __forceinline__ void cmb_conv_phase(const CmbArgs& A, const QuantJob& J, int gw, int ngw, int lane) {
    (void)J;
    constexpr int NCH = SEQ / 16, NIT = NCH * 2;
    const bool upper = lane >= 32;
    {
        unsigned xin[46], xn[46];
#define CMB1_LOAD(X, it_) do { const int c_ = 128 * ((it_) & 1) + 2 * lane, t0_ = ((it_) >> 1) * 16, s0_ = t0_ & (SEQ - 1); \
        _Pragma("unroll") for (int i = 0; i < 46; ++i) { const int rel = i - 30; (X)[i] = (s0_ + rel >= 0) ? *(const GAS unsigned*)(A.VX + (size_t)(t0_ + rel) * 1024 + 512 + c_) : 0u; } } while (0)
        int it = gw;
        if (it < NIT) CMB1_LOAD(xin, it);
        for (; it < NIT; it += ngw) {
            const int c = 128 * (it & 1) + 2 * lane, t0 = (it >> 1) * 16;
            pg8::f32x2 w[31];
#pragma unroll
            for (int j = 0; j < 31; ++j) w[j] = *(const GAS pg8::f32x2*)(A.cfw + j * 256 + c);
            const pg8::f32x2 bias = *(const GAS pg8::f32x2*)(A.cfb + c), lg = *(const GAS pg8::f32x2*)(A.lng + c), lb = *(const GAS pg8::f32x2*)(A.lnb + c);
            asm volatile("" ::: "memory");
            const int nx = it + ngw < NIT ? it + ngw : it;
            CMB1_LOAD(xn, nx);
            unsigned ov[16];
#pragma unroll
            for (int tt = 0; tt < 16; ++tt) { float y0 = bias.x, y1 = bias.y;
#pragma unroll
                for (int j = 0; j < 31; ++j) { y0 += w[j].x * bflo(xin[tt + j]); y1 += w[j].y * bfhi(xin[tt + j]); }
                const float mean = half_sum(y0 + y1, upper) * (1.0f / 64.0f); const float d0 = y0 - mean, d1 = y1 - mean;
                const float var = half_sum(d0 * d0 + d1 * d1, upper) * (1.0f / 64.0f);
                const float rs = __builtin_amdgcn_rsqf(var + LN_EPS);
                const float yn0 = d0 * rs * lg.x + lb.x, yn1 = d1 * rs * lg.y + lb.y;
                ov[tt] = pkbf(yn0 * __builtin_amdgcn_rcpf(1.0f + __expf(-yn0)), yn1 * __builtin_amdgcn_rcpf(1.0f + __expf(-yn1))); }
#pragma unroll
            for (int tt = 0; tt < 16; ++tt) *(GAS unsigned*)(A.CAT + (size_t)(t0 + tt) * 1024 + 512 + c) = ov[tt];
#pragma unroll
            for (int i = 0; i < 46; ++i) xin[i] = xn[i];
        }
#undef CMB1_LOAD
    }
    {
        unsigned xin[18], sbv[16], xn[18], sbn[16];
#define CMB2_LOAD(X, S, it_) do { const int c_ = 128 * ((it_) & 1) + 2 * lane, t0_ = ((it_) >> 1) * 16, s0_ = t0_ & (SEQ - 1); \
        _Pragma("unroll") for (int i = 0; i < 18; ++i) { const int rel = i - 2; (X)[i] = (s0_ + rel >= 0) ? *(const GAS unsigned*)(A.VX + (size_t)(t0_ + rel) * 1024 + 768 + c_) : 0u; } \
        _Pragma("unroll") for (int tt = 0; tt < 16; ++tt) (S)[tt] = *(const GAS unsigned*)(A.SB + (size_t)(t0_ + tt) * 256 + c_); } while (0)
        int it = gw;
        if (it < NIT) CMB2_LOAD(xin, sbv, it);
        for (; it < NIT; it += ngw) {
            const int c = 128 * (it & 1) + 2 * lane, t0 = (it >> 1) * 16;
            const pg8::f32x2 w0 = *(const GAS pg8::f32x2*)(A.scw + c), w1 = *(const GAS pg8::f32x2*)(A.scw + 256 + c), w2 = *(const GAS pg8::f32x2*)(A.scw + 512 + c);
            asm volatile("" ::: "memory");
            const int nx = it + ngw < NIT ? it + ngw : it;
            CMB2_LOAD(xn, sbn, nx);
#pragma unroll
            for (int tt = 0; tt < 16; ++tt) {
                const float y0 = bflo(sbv[tt]) * (w0.x * bflo(xin[tt]) + w1.x * bflo(xin[tt + 1]) + w2.x * bflo(xin[tt + 2]));
                const float y1 = bfhi(sbv[tt]) * (w0.y * bfhi(xin[tt]) + w1.y * bfhi(xin[tt + 1]) + w2.y * bfhi(xin[tt + 2]));
                *(GAS unsigned*)(A.CAT + (size_t)(t0 + tt) * 1024 + 768 + c) = pkbf(y0, y1); }
#pragma unroll
            for (int i = 0; i < 18; ++i) xin[i] = xn[i];
#pragma unroll
            for (int tt = 0; tt < 16; ++tt) sbv[tt] = sbn[tt];
        }
#undef CMB2_LOAD
    }
}

typedef float f32x16 __attribute__((ext_vector_type(16)));
__device__ __forceinline__ int sortable(int b) { return b ^ ((b >> 31) & 0x7fffffff); }
#define CEX_DESC(a, b) do { const int _x = (a), _y = (b); (a) = _x > _y ? _x : _y; (b) = _x > _y ? _y : _x; } while (0)
template <int N> __device__ __forceinline__ void bitonic_merge_desc(int (&v)[N]) {
#pragma unroll
    for (int j = N >> 1; j > 0; j >>= 1)
#pragma unroll
        for (int i = 0; i < N; ++i) if ((i & j) == 0) CEX_DESC(v[i], v[i | j]);
}
template <int N> __device__ __forceinline__ void bitonic_sort_desc(int (&v)[N]) {
#pragma unroll
    for (int k = 2; k <= N; k <<= 1)
#pragma unroll
        for (int j = k >> 1; j > 0; j >>= 1)
#pragma unroll
            for (int i = 0; i < N; ++i) { const int l = i ^ j; if (l > i) { if ((i & k) == 0) CEX_DESC(v[i], v[l]); else CEX_DESC(v[l], v[i]); } }
}
__device__ __forceinline__ void merge_top16(int (&a)[16], const int (&b)[16]) {
#pragma unroll
    for (int i = 0; i < 16; ++i) a[i] = a[i] > b[15 - i] ? a[i] : b[15 - i];
    bitonic_merge_desc<16>(a);
}
__device__ __forceinline__ float vmaxf(float a, float b) { float r; asm("v_max_f32 %0, %1, %2" : "=v"(r) : "v"(a), "v"(b)); return r; }
__device__ __forceinline__ float vminf(float a, float b) { float r; asm("v_min_f32 %0, %1, %2" : "=v"(r) : "v"(a), "v"(b)); return r; }
#define CEXF(a, b) do { const float _x = (a), _y = (b); (a) = vmaxf(_x, _y); (b) = vminf(_x, _y); } while (0)
template <int N> __device__ __forceinline__ void bitonic_merge_f(float (&v)[N]) {
#pragma unroll
    for (int j = N >> 1; j > 0; j >>= 1)
#pragma unroll
        for (int i = 0; i < N; ++i) if ((i & j) == 0) CEXF(v[i], v[i | j]);
}
__device__ __forceinline__ void sort16_f(float (&v)[16]) {
#define CX(i, j) CEXF(v[i], v[j]);
    CX(0,13) CX(1,12) CX(2,15) CX(3,14) CX(4,8) CX(5,6) CX(7,11) CX(9,10)
    CX(0,5) CX(1,7) CX(2,9) CX(3,4) CX(6,13) CX(8,14) CX(10,15) CX(11,12)
    CX(0,1) CX(2,3) CX(4,5) CX(6,8) CX(7,9) CX(10,11) CX(12,13) CX(14,15)
    CX(0,2) CX(1,3) CX(4,10) CX(5,11) CX(6,7) CX(8,9) CX(12,14) CX(13,15)
    CX(1,2) CX(3,12) CX(4,6) CX(5,7) CX(8,10) CX(9,11) CX(13,14)
    CX(1,4) CX(2,6) CX(5,8) CX(7,10) CX(9,13) CX(11,14)
    CX(2,4) CX(3,6) CX(9,12) CX(11,13)
    CX(3,5) CX(6,8) CX(7,9) CX(10,12)
    CX(3,4) CX(5,6) CX(7,8) CX(9,10) CX(11,12)
    CX(6,7) CX(8,9)
#undef CX
}
__device__ __forceinline__ void merge_top16_f(float (&a)[16], const float (&b)[16]) {
#pragma unroll
    for (int i = 0; i < 16; ++i) a[i] = vmaxf(a[i], b[15 - i]);
    bitonic_merge_f<16>(a);
}
__device__ __forceinline__ void stage2_top16(const float (&ta)[16], const float (&tb)[16], float (&R)[16]) {
    float a[16], b[16];
#pragma unroll
    for (int i = 0; i < 16; ++i) { a[i] = __builtin_bit_cast(float, __builtin_bit_cast(int, ta[i]) & ~0x7f); b[i] = __builtin_bit_cast(float, __builtin_bit_cast(int, tb[i]) & ~0x7f); }
#define MK(i, j) __builtin_bit_cast(float, (__builtin_bit_cast(int, a[i] + b[j]) & ~0xff) | ((i) << 4) | (j))
    const float NINF = __builtin_bit_cast(float, 0xff800000u);
#pragma unroll
    for (int j = 0; j < 16; ++j) R[j] = MK(0, j);
#pragma unroll
    for (int i = 1; i < 16; ++i) R[i] = vmaxf(R[i], MK(16 - i, 0));
    bitonic_merge_f<16>(R);
    {
        float C[16];
#pragma unroll
        for (int j = 1; j < 8; ++j) C[j - 1] = MK(1, j);
        C[7] = NINF; C[8] = NINF; C[9] = NINF;
#pragma unroll
        for (int i = 7; i >= 2; --i) C[17 - i] = MK(i, 1);
        bitonic_merge_f<16>(C);
#pragma unroll
        for (int i = 3; i < 16; ++i) R[i] = vmaxf(R[i], C[15 - i]);
        bitonic_merge_f<16>(R);
    }
    {
        float d0 = MK(2, 2), p = MK(2, 3), q = MK(2, 4), r = MK(3, 2), s = MK(4, 2), t = MK(3, 3);
        CEXF(p, r); CEXF(q, s); CEXF(r, q);
        CEXF(q, t); CEXF(s, t);
        R[10] = vmaxf(R[10], t); R[11] = vmaxf(R[11], s); R[12] = vmaxf(R[12], q); R[13] = vmaxf(R[13], r); R[14] = vmaxf(R[14], p); R[15] = vmaxf(R[15], d0);
    }
#undef MK
}
struct TopkArgs { const bf16* Qp; const bf16* keys; const float* ssq; unsigned short* eid; float* gate; unsigned short* eidT;
#ifdef DBG_CHECK
 float* dbgS; int* dbgI;
#endif
 };
__device__ __forceinline__ void topk_phase(const TopkArgs& A, const QuantJob& J, int& qr_next, LAS unsigned char* ldsK  , LAS unsigned char* ldsw  , int h, int rank, int nrank, int wave, int tid, int lane) {
    const int r32 = lane & 31, hi = lane >> 5;
    __syncthreads();
    {
        const GAS v4u* src = (const GAS v4u*)(A.keys + (size_t)h * 2 * 128 * 128);
#pragma unroll
        for (int i = 0; i < 8; ++i) { const int g = tid + 512 * i, row = g >> 4, ch = g & 15; *(LAS v4u*)(ldsK + row * 256 + ((ch ^ (row & 15)) << 4)) = src[g]; }
        __syncthreads();
    }
    bf16x8 qn[8];
    { const int tgf = rank * 8 + wave < SEQ / 32 ? rank * 8 + wave : 0; const bf16* qrow = A.Qp + (size_t)(tgf * 32 + r32) * 2048 + h * 256 + 8 * hi;
#pragma unroll
      for (int s = 0; s < 8; ++s) qn[s] = *(const GAS bf16x8*)(qrow + 16 * s); }
    for (int tg = rank * 8 + wave; tg < SEQ / 32; tg += nrank * 8) {
        const int t = tg * 32 + r32;
        bf16x8 qf[2][8];
        { const bf16* qrow = A.Qp + (size_t)t * 2048 + h * 256 + 128 + 8 * hi;
#pragma unroll
          for (int s = 0; s < 8; ++s) { qf[0][s] = qn[s]; qf[1][s] = *(const GAS bf16x8*)(qrow + 16 * s); } }
        int hb = hi << 2; asm volatile("" : "+v"(hb));
        float rinv2; { const GAS f32x4* sp = (const GAS f32x4*)(A.ssq + (size_t)t * 16); const f32x4 a = sp[0], b = sp[1], c = sp[2], d = sp[3];
            const float ss = ((a.x + a.y) + (a.z + a.w)) + ((b.x + b.y) + (b.z + b.w)) + ((c.x + c.y) + (c.z + c.w)) + ((d.x + d.y) + (d.z + d.w));
            rinv2 = 1.0f / sqrtf(ss * (1.0f / DMODEL) + RMS_EPS); }
        float top[2][16];
#pragma unroll
        for (int c = 0; c < 2; ++c) {
            const int qra = qr_next < NEXP ? qr_next : NEXP - 1; const bool qok = qr_next < NEXP; qr_next += J.rs;
            QRow qua, qva;
            p0_quant_load(qua, J.usrc + (size_t)qra * DMODEL, lane); p0_quant_load(qva, J.vsrc + (size_t)qra * DMODEL, lane);
            float run[16];
            int koff = c * 32768 + r32 * 256; asm volatile("" : "+v"(koff));
            const int ksw = r32 & 15;
#pragma unroll
            for (int nt = 0; nt < 4; ++nt) {
                bf16x8 kf[8];
#pragma unroll
                for (int s = 0; s < 8; ++s) kf[s] = *(const LAS bf16x8*)(ldsK + nt * 8192 + koff + (((2 * s + hi) ^ ksw) << 4));
                f32x16 acc = {0.f, 0.f, 0.f, 0.f, 0.f, 0.f, 0.f, 0.f, 0.f, 0.f, 0.f, 0.f, 0.f, 0.f, 0.f, 0.f};
#pragma unroll
                for (int s = 0; s < 8; ++s) acc = __builtin_amdgcn_mfma_f32_32x32x16_bf16(kf[s], qf[c][s], acc, 0, 0, 0);
                asm volatile("" ::: "memory");
                float g[16];
#pragma unroll
                for (int r = 0; r < 16; ++r) { const int idx = 32 * nt + (r & 3) + 8 * (r >> 2);
                    const float av = acc[r];
                    g[r] = __int_as_float(((__float_as_int(av) & ~0x7f) | idx) | hb); }
                sort16_f(g);
                if (nt == 0) {
#pragma unroll
                    for (int r = 0; r < 16; ++r) run[r] = g[r];
                } else merge_top16_f(run, g);
            }
            {
                float other[16];
#pragma unroll
                for (int i = 0; i < 16; ++i) { const unsigned u = __float_as_uint(run[i]); auto r = __builtin_amdgcn_permlane32_swap(u, u, false, false); run[i] = __uint_as_float((unsigned)r[0]); other[i] = __uint_as_float((unsigned)r[1]); }
                merge_top16_f(run, other);
            }
#pragma unroll
            for (int i = 0; i < 16; ++i) top[c][i] = run[i];
            if (qok) { p0_quant_fin(qua, J.gain, J.UT, qra, J.SU, lane); p0_quant_fin(qva, nullptr, J.VT, qra, J.SV, lane); }
        }
        { const int tgn = tg + nrank * 8 < SEQ / 32 ? tg + nrank * 8 : tg; const bf16* qrow = A.Qp + (size_t)(tgn * 32 + r32) * 2048 + h * 256 + 8 * hi;
#pragma unroll
          for (int s = 0; s < 8; ++s) qn[s] = *(const GAS bf16x8*)(qrow + 16 * s); }
#pragma unroll
        for (int c = 0; c < 2; ++c)
#pragma unroll
            for (int q4 = 0; q4 < 4; ++q4) { const unsigned w = (unsigned)(__float_as_int(top[c][4 * q4]) & 0x7f) | ((unsigned)(__float_as_int(top[c][4 * q4 + 1]) & 0x7f) << 8) | ((unsigned)(__float_as_int(top[c][4 * q4 + 2]) & 0x7f) << 16) | ((unsigned)(__float_as_int(top[c][4 * q4 + 3]) & 0x7f) << 24);
                *(LAS unsigned*)(ldsw + lane * 32 + c * 16 + q4 * 4) = w; }
        float crun[16];
        stage2_top16(top[0], top[1], crun);
        LDS_WAIT(); asm volatile("" ::: "memory");
        float sc[16]; unsigned e[16];
#pragma unroll
        for (int k = 0; k < 16; ++k) { const int bits = __float_as_int(crun[k]); const int i = (bits >> 4) & 15, j = bits & 15;
            sc[k] = __builtin_bit_cast(float, bits & ~0xff) * rinv2;
            const unsigned i1 = *(const LAS unsigned char*)(ldsw + lane * 32 + i), i2 = *(const LAS unsigned char*)(ldsw + lane * 32 + 16 + j);
            e[k] = i1 * 128u + i2; }
        const float mx = sc[0];
        float z = 0.f;
#pragma unroll
        for (int k = 0; k < 16; ++k) { sc[k] = __expf(sc[k] - mx); z += sc[k]; }
        const float iz = 1.0f / z;
        if (hi == 0) {
            v4u e0, e1; e0.x = e[0] | (e[1] << 16); e0.y = e[2] | (e[3] << 16); e0.z = e[4] | (e[5] << 16); e0.w = e[6] | (e[7] << 16);
            e1.x = e[8] | (e[9] << 16); e1.y = e[10] | (e[11] << 16); e1.z = e[12] | (e[13] << 16); e1.w = e[14] | (e[15] << 16);
            GAS v4u* ep = (GAS v4u*)(A.eid + (size_t)t * 128 + h * 16); ep[0] = e0; ep[1] = e1;
        } else {
            GAS f32x4* gp = (GAS f32x4*)(A.gate + (size_t)t * 128 + h * 16);
#pragma unroll
            for (int q4 = 0; q4 < 4; ++q4) gp[q4] = (f32x4){sc[4 * q4] * iz, sc[4 * q4 + 1] * iz, sc[4 * q4 + 2] * iz, sc[4 * q4 + 3] * iz};
        }
    }
}

__device__ __forceinline__ int dot4_from(int a, int b, int c) { int d; asm("v_dot4_i32_i8 %0, %1, %2, %3" : "=v"(d) : "v"(a), "v"(b), "v"(c)); return d; }
__device__ __forceinline__ float gelu_exact(float v) { return 0.5f * v * (1.0f + erff(v * 0.70710678118654752f)); }
__device__ __forceinline__ float ub0(unsigned x) { float f; asm("v_cvt_f32_ubyte0 %0, %1" : "=v"(f) : "v"(x)); return f; }
__device__ __forceinline__ float ub1(unsigned x) { float f; asm("v_cvt_f32_ubyte1 %0, %1" : "=v"(f) : "v"(x)); return f; }
__device__ __forceinline__ float ub2(unsigned x) { float f; asm("v_cvt_f32_ubyte2 %0, %1" : "=v"(f) : "v"(x)); return f; }
__device__ __forceinline__ float ub3(unsigned x) { float f; asm("v_cvt_f32_ubyte3 %0, %1" : "=v"(f) : "v"(x)); return f; }
template <class T> __device__ __forceinline__ T tr_xchg_add(T a, T b, int O, int lane) {
    if (O == 16 || O == 32) {
        const unsigned ua = __builtin_bit_cast(unsigned, a), ub = __builtin_bit_cast(unsigned, b);
        if (O == 16) { auto r = __builtin_amdgcn_permlane16_swap(ua, ub, false, false); return __builtin_bit_cast(T, (unsigned)r[0]) + __builtin_bit_cast(T, (unsigned)r[1]); }
        else         { auto r = __builtin_amdgcn_permlane32_swap(ua, ub, false, false); return __builtin_bit_cast(T, (unsigned)r[0]) + __builtin_bit_cast(T, (unsigned)r[1]); }
    } else {
        const bool up = (lane & O) != 0; const T send = up ? a : b, keep = up ? b : a;
        const int si = __builtin_bit_cast(int, send);
        const int ri = O == 1 ? __builtin_amdgcn_update_dpp(0, si, 0xB1, 0xf, 0xf, true) : O == 2 ? __builtin_amdgcn_update_dpp(0, si, 0x4E, 0xf, 0xf, true)
                     : O == 4 ? __builtin_amdgcn_update_dpp(0, si, 0x124, 0xf, 0xf, true)
                     : __builtin_amdgcn_update_dpp(0, si, 0x128, 0xf, 0xf, true);
        return keep + __builtin_bit_cast(T, ri);
    }
}
template <class T, int N, int O, int NEND> struct TReduce {
    static __device__ __forceinline__ void run(T (&v)[N], T (&out)[NEND], int lane) {
        T w[N / 2];
#pragma unroll
        for (int i = 0; i < N / 2; ++i) {
            if (O == 4) { const bool up = (lane & O) != 0; const T send = up ? v[2 * i] : v[2 * i + 1], keep = up ? v[2 * i + 1] : v[2 * i];
                const int q3 = __builtin_amdgcn_update_dpp(0, __builtin_bit_cast(int, send), 0x1B, 0xf, 0xf, true); w[i] = keep + __builtin_bit_cast(T, __builtin_amdgcn_update_dpp(0, q3, 0x141, 0xf, 0xf, true)); }
            else w[i] = tr_xchg_add<T>(v[2 * i], v[2 * i + 1], O, lane);
        }
        TReduce<T, N / 2, O * 2, NEND>::run(w, out, lane);
    }
};
template <class T, int O, int NEND> struct TReduce<T, NEND, O, NEND> { static __device__ __forceinline__ void run(T (&v)[NEND], T (&out)[NEND], int) {
#pragma unroll
    for (int i = 0; i < NEND; ++i) out[i] = v[i]; } };
struct PeerUArgs { const signed char* xq; const float* xqs; const unsigned char* UT; const unsigned short* eidT; float* part; };
struct MetaU { v4u ea, eb, qa, qb; float sx; };
__device__ __forceinline__ void peer_u_run(const PeerUArgs& A, LAS const unsigned char* eidl  , LAS const unsigned char* sxl  , LAS unsigned char* prl  , int t0, int tl0, int lane) {
    const int pp = lane >> 3, cc = lane & 7;
    const unsigned cc16 = 16u * (unsigned)cc;
#define U_META(M, tt_) do { const int i_ = (tt_) < 63 ? (tt_) : 63; const int t_ = t0 + (i_ & 15), s_ = i_ >> 4; const GAS v4u* ep_ = (const GAS v4u*)(A.eidT + (size_t)t_ * 128 + pp * 16); (M).ea = ep_[0]; (M).eb = ep_[1]; \
        const GAS v4u* xp_ = (const GAS v4u*)(A.xq + (size_t)t_ * DMODEL + 256 * s_ + 32 * cc); (M).qa = xp_[0]; (M).qb = xp_[1]; (M).sx = *(const LAS float*)(sxl + ((i_ & 15) * 4 + s_) * 4); } while (0)
#define U_TAB(Q, M, tt_) do { const int i_ = (tt_) < 63 ? (tt_) : 63; const unsigned char* Ui_ = A.UT + (size_t)(i_ >> 4) * NEXP * 128; \
        _Pragma("unroll") for (int g = 0; g < 16; ++g) { const unsigned ew_ = g < 8 ? (M).ea[g >> 1] : (M).eb[(g - 8) >> 1]; const unsigned e_ = (g & 1) ? (ew_ >> 16) : (ew_ & 0xffffu); \
        (Q)[g] = *(const GAS v4u*)(Ui_ + (e_ * 128u + cc16)); } } while (0)
#define U_COMP(M, Q, tt_) do { const int tl_ = tl0 + ((tt_) & 15), s4_ = (tt_) >> 4; int part[16]; \
        int sm_ = 0; _Pragma("unroll") for (int k = 0; k < 4; ++k) { sm_ = __builtin_amdgcn_sdot4(0x01010101, (int)(M).qa[k], sm_, false); sm_ = __builtin_amdgcn_sdot4(0x01010101, (int)(M).qb[k], sm_, false); } sm_ *= -8; \
        _Pragma("unroll") for (int g = 0; g < 16; ++g) { int a_; \
            _Pragma("unroll") for (int k = 0; k < 4; ++k) { const unsigned d_ = (Q)[g][k]; const int x0_ = (int)(k < 2 ? (M).qa[2 * k] : (M).qb[2 * k - 4]), x1_ = (int)(k < 2 ? (M).qa[2 * k + 1] : (M).qb[2 * k - 3]); \
                a_ = k == 0 ? dot4_from((int)(d_ & 0x0f0f0f0fu), x0_, sm_) : __builtin_amdgcn_sdot4((int)(d_ & 0x0f0f0f0fu), x0_, a_, false); a_ = __builtin_amdgcn_sdot4((int)((d_ >> 4) & 0x0f0f0f0fu), x1_, a_, false); } \
            part[g] = a_; } \
        int pq[16]; _Pragma("unroll") for (int p_ = 0; p_ < 16; ++p_) pq[p_] = part[2 * (p_ & 7) + (p_ >> 3)];     \
        int tot[2]; TReduce<int, 16, 1, 2>::run(pq, tot, lane); \
        (void)tl_; *(LAS unsigned*)(prl + ((tt_) & 15) * 1024 + s4_ * 256 + 4 * lane) = pkbf((float)tot[0] * (M).sx, (float)tot[1] * (M).sx); } while (0)
    MetaU m0, m1, m2, m3; v4u QA[16], QB[16];
    U_META(m0, 0); U_META(m1, 1); U_TAB(QA, m0, 0);
    for (int tt = 0; tt < 64; tt += 4) {
        U_META(m2, tt + 2); U_TAB(QB, m1, tt + 1); U_COMP(m0, QA, tt);
        U_META(m3, tt + 3); U_TAB(QA, m2, tt + 2); U_COMP(m1, QB, tt + 1);
        U_META(m0, tt + 4); U_TAB(QB, m3, tt + 3); U_COMP(m2, QA, tt + 2);
        U_META(m1, tt + 5); U_TAB(QA, m0, tt + 4); U_COMP(m3, QB, tt + 3);
    }
#undef U_META
#undef U_TAB
#undef U_COMP
}
struct PeerRArgs { const float* part; const float* ssq; const unsigned short* eid; const float* gate; const float* su; const float* sv; signed char* wq; float* wsc; };
struct MetaR { int e0, e1; float g0, g1, ssq; float p0[4], p1[4]; };
struct GathR { f32x4 su0, su1, sv0, sv1; };
__device__ __forceinline__ void peer_r_run(const PeerRArgs& A, LAS const unsigned char* eidl, LAS unsigned char* wql  , LAS unsigned char* wscl  , int t0, int tl0, int lane) {
#define R_META(M, k_) do { const int kk_ = (k_) < 15 ? (k_) : 15; const int tq_ = t0 + kk_, tl_ = tl0 + kk_; (M).e0 = A.eid[(size_t)tq_ * 128 + lane]; (M).e1 = A.eid[(size_t)tq_ * 128 + 64 + lane]; (void)tl_; \
        (M).g0 = A.gate[(size_t)tq_ * 128 + lane]; (M).g1 = A.gate[(size_t)tq_ * 128 + 64 + lane]; (M).ssq = lane < 16 ? A.ssq[(size_t)tq_ * 16 + lane] : 0.f; \
        _Pragma("unroll") for (int s = 0; s < 4; ++s) { LAS const unsigned char* pr_ = wql + kk_ * 1024 + s * 256 + 2 * lane; (M).p0[s] = bf1(*(const LAS unsigned short*)pr_); (M).p1[s] = bf1(*(const LAS unsigned short*)(pr_ + 128)); } } while (0)
#define R_GATH(Gv, M) do { (Gv).su0 = *(const GAS f32x4*)(A.su + 8 * (M).e0); (Gv).su1 = *(const GAS f32x4*)(A.su + 8 * (M).e1); (Gv).sv0 = *(const GAS f32x4*)(A.sv + 8 * (M).e0); (Gv).sv1 = *(const GAS f32x4*)(A.sv + 8 * (M).e1); } while (0)
    MetaR M[7]; GathR Gt[4];
    R_META(M[0], 0); R_META(M[1], 1); R_META(M[2], 2); R_META(M[3], 3); R_META(M[4], 4); R_META(M[5], 5);
    R_GATH(Gt[0], M[0]); R_GATH(Gt[1], M[1]); R_GATH(Gt[2], M[2]);
#pragma unroll
    for (int k = 0; k < 16; ++k) { const int t = t0 + k;
        if (k + 6 < 16) R_META(M[(k + 6) % 7], k + 6);
        if (k + 3 < 16) R_GATH(Gt[(k + 3) % 4], M[(k + 3) % 7]);
        const MetaR& mc = M[k % 7]; const GathR& gc = Gt[k % 4];
        float z0 = 0.f, z1 = 0.f;
#pragma unroll
        for (int s = 0; s < 4; ++s) { z0 += mc.p0[s] * gc.su0[s]; z1 += mc.p1[s] * gc.su1[s]; }
        const float ss = wave_sum(mc.ssq);
        const float ri = __builtin_amdgcn_rsqf(ss * (1.0f / DMODEL) + RMS_EPS);
        const pg8::f32x2 ge = pg8::gelu_pk((pg8::f32x2){z0 * ri, z1 * ri});
        const float w0 = mc.g0 * ge.x, w1 = mc.g1 * ge.y;
        unsigned P0 = 0u, P1 = 0u; f32x4 gms;
#pragma unroll
        for (int s = 0; s < 4; ++s) { const float a0 = w0 * gc.sv0[s], a1 = w1 * gc.sv1[s];
            const float gm = wave_max(fmaxf(fabsf(a0), fabsf(a1)));
            const float inv = gm > 0.f ? 127.0f * __builtin_amdgcn_rcpf(gm) : 0.f;
            P0 |= ((unsigned)(int)rintf(a0 * inv) & 0xffu) << (8 * s); P1 |= ((unsigned)(int)rintf(a1 * inv) & 0xffu) << (8 * s);
            gms[s] = gm * (1.0f / 127.0f); }
        {
            const unsigned sl = (unsigned)lane & 3u;
            const unsigned selA = sl | ((4u + sl) << 8) | 0x0c0c0000u, selB = 0x00000c0cu | (sl << 16) | ((4u + sl) << 24);
#define R_QUADT(P) (__builtin_amdgcn_perm((unsigned)__builtin_amdgcn_update_dpp(0, (int)(P), 0x55, 0xf, 0xf, true), (unsigned)__builtin_amdgcn_update_dpp(0, (int)(P), 0x00, 0xf, 0xf, true), selA) | \
                    __builtin_amdgcn_perm((unsigned)__builtin_amdgcn_update_dpp(0, (int)(P), 0xFF, 0xf, 0xf, true), (unsigned)__builtin_amdgcn_update_dpp(0, (int)(P), 0xAA, 0xf, 0xf, true), selB))
            const unsigned wlo = R_QUADT(P0), whi = R_QUADT(P1);
#undef R_QUADT
            LAS unsigned char* wr = wql + (k * 4 + (int)sl) * 128 + (lane & ~3);
            *(LAS unsigned*)wr = wlo; *(LAS unsigned*)(wr + 64) = whi;
            if (lane == 0) *(LAS f32x4*)(wscl + k * 16) = gms;
        }
    }
#undef R_META
#undef R_GATH
}
typedef unsigned u32x2 __attribute__((ext_vector_type(2)));
struct PeerVArgs { float* xout  ; const unsigned char* VT; const unsigned short* eidT; const signed char* wq; const float* wsc; bf16* xb; float* ssqx; };
struct MetaV { v4u ea, eb, wq; float sc; u32x2 xv; };
__device__ __forceinline__ void peer_v_run(const PeerVArgs& A, LAS const unsigned char* eidl, LAS const unsigned char* wql, LAS const unsigned char* wscl, int t0, int lane) {
    const int pp = lane >> 3, cc = lane & 7;
    {
        const unsigned cc16 = 16u * (unsigned)cc;
#define V_META(M, tt_) do { const int i_ = (tt_) < 63 ? (tt_) : 63; const int t_ = t0 + (i_ & 15), s4 = i_ >> 4; const GAS v4u* ep_ = (const GAS v4u*)(A.eidT + (size_t)t_ * 128 + pp * 16); (M).ea = ep_[0]; (M).eb = ep_[1]; \
        (M).wq = *(const LAS v4u*)(wql + ((i_ & 15) * 4 + s4) * 128 + pp * 16); (M).sc = *(const LAS float*)(wscl + ((i_ & 15) * 4 + s4) * 4); (M).xv = *(const GAS u32x2*)(A.xb + (size_t)t_ * DMODEL + 256 * s4 + 32 * cc + 4 * pp); } while (0)
#define V_TAB(Q, M, tt_) do { const int i_ = (tt_) < 63 ? (tt_) : 63; const unsigned char* Vi_ = A.VT + (size_t)(i_ >> 4) * NEXP * 128;   _Pragma("unroll") for (int g = 0; g < 16; ++g) { const unsigned ew_ = g < 8 ? (M).ea[g >> 1] : (M).eb[(g - 8) >> 1]; const unsigned e_ = (g & 1) ? (ew_ >> 16) : (ew_ & 0xffffu); \
        (Q)[g] = *(const GAS v4u*)(Vi_ + (e_ * 128u + cc16)); } } while (0)
#define V_COMP(M, Q, tt_) do { const int t_ = t0 + ((tt_) & 15), s4 = (tt_) >> 4; \
        int c8 = 0; _Pragma("unroll") for (int a = 0; a < 4; ++a) c8 = __builtin_amdgcn_sdot4(0x01010101, (int)(M).wq[a], c8, false); c8 *= -8; \
        int acc[32]; \
        _Pragma("unroll") for (int a = 0; a < 4; ++a) { const int wa_ = (int)(M).wq[a]; \
            _Pragma("unroll") for (int k = 0; k < 4; ++k) { const unsigned r0 = (Q)[4 * a][k], r1 = (Q)[4 * a + 1][k], r2 = (Q)[4 * a + 2][k], r3 = (Q)[4 * a + 3][k]; \
                  \
                  \
                const unsigned u01l = __builtin_amdgcn_perm(r1, r0, 0x05010400u), u01h = __builtin_amdgcn_perm(r1, r0, 0x07030602u), u23l = __builtin_amdgcn_perm(r3, r2, 0x05010400u), u23h = __builtin_amdgcn_perm(r3, r2, 0x07030602u); \
                const unsigned tb0 = __builtin_amdgcn_perm(u23l, u01l, 0x05040100u), tb1 = __builtin_amdgcn_perm(u23l, u01l, 0x07060302u), tb2 = __builtin_amdgcn_perm(u23h, u01h, 0x05040100u), tb3 = __builtin_amdgcn_perm(u23h, u01h, 0x07060302u); \
                acc[8 * k + 0] = a == 0 ? dot4_from((int)(tb0 & 0x0f0f0f0fu), wa_, c8) : __builtin_amdgcn_sdot4((int)(tb0 & 0x0f0f0f0fu), wa_, acc[8 * k + 0], false); acc[8 * k + 1] = a == 0 ? dot4_from((int)tb0, wa_, c8) : __builtin_amdgcn_sdot4((int)tb0, wa_, acc[8 * k + 1], false); \
                acc[8 * k + 2] = a == 0 ? dot4_from((int)(tb1 & 0x0f0f0f0fu), wa_, c8) : __builtin_amdgcn_sdot4((int)(tb1 & 0x0f0f0f0fu), wa_, acc[8 * k + 2], false); acc[8 * k + 3] = a == 0 ? dot4_from((int)tb1, wa_, c8) : __builtin_amdgcn_sdot4((int)tb1, wa_, acc[8 * k + 3], false); \
                acc[8 * k + 4] = a == 0 ? dot4_from((int)(tb2 & 0x0f0f0f0fu), wa_, c8) : __builtin_amdgcn_sdot4((int)(tb2 & 0x0f0f0f0fu), wa_, acc[8 * k + 4], false); acc[8 * k + 5] = a == 0 ? dot4_from((int)tb2, wa_, c8) : __builtin_amdgcn_sdot4((int)tb2, wa_, acc[8 * k + 5], false); \
                acc[8 * k + 6] = a == 0 ? dot4_from((int)(tb3 & 0x0f0f0f0fu), wa_, c8) : __builtin_amdgcn_sdot4((int)(tb3 & 0x0f0f0f0fu), wa_, acc[8 * k + 6], false); acc[8 * k + 7] = a == 0 ? dot4_from((int)tb3, wa_, c8) : __builtin_amdgcn_sdot4((int)tb3, wa_, acc[8 * k + 7], false); } } \
        int av[32]; _Pragma("unroll") for (int i = 0; i < 32; ++i) av[8 * (i & 3) + (i >> 2)] = acc[i];     \
        int tot[4]; TReduce<int, 32, 8, 4>::run(av, tot, lane); \
        tot[1] = (tot[1] - tot[0]) >> 4; tot[3] = (tot[3] - tot[2]) >> 4;        \
        const f32x4 vo = (f32x4){bflo((M).xv.x), bfhi((M).xv.x), bflo((M).xv.y), bfhi((M).xv.y)} + (f32x4){(float)tot[0], (float)tot[1], (float)tot[2], (float)tot[3]} * (M).sc; \
        if (A.xout) *(GAS f32x4*)(A.xout + (size_t)t_ * DMODEL + 256 * s4 + 32 * cc + 4 * pp) = vo;        \
        else { *(GAS u32x2*)(A.xb + (size_t)t_ * DMODEL + 256 * s4 + 32 * cc + 4 * pp) = (u32x2){pkbf(vo.x, vo.y), pkbf(vo.z, vo.w)}; \
               const float s2 = wave_sum((vo.x * vo.x + vo.y * vo.y) + (vo.z * vo.z + vo.w * vo.w)); if (lane == 0) A.ssqx[(size_t)t_ * 8 + s4] = s2; } } while (0)
        MetaV m0, m1, m2, m3; v4u QA[16], QB[16];
        V_META(m0, 0); V_META(m1, 1); V_TAB(QA, m0, 0);
        for (int tt = 0; tt < 64; tt += 4) {
            V_META(m2, tt + 2); V_TAB(QB, m1, tt + 1); V_COMP(m0, QA, tt);
            V_META(m3, tt + 3); V_TAB(QA, m2, tt + 2); V_COMP(m1, QB, tt + 1);
            V_META(m0, tt + 4); V_TAB(QB, m3, tt + 3); V_COMP(m2, QA, tt + 2);
            V_META(m1, tt + 5); V_TAB(QA, m0, tt + 4); V_COMP(m3, QB, tt + 3);
        }
#undef V_META
#undef V_TAB
#undef V_COMP
    }
}

#ifdef DBG_CHECK
constexpr int DBG_FLAGS = 2048, DBG_NS = 64;
constexpr size_t WS_DBG = 56 * MiB;
struct DbgArgs { const unsigned short* qp; const float* ssq; const float* x1; const float* g2; const float* wq; const float* keys; const float* uf; const float* vf; const unsigned short* eid; const float* gate; float* exp_out; gu32* flags; };
__device__ __forceinline__ void dbg_check_topk_and_expect(const DbgArgs& A, LAS unsigned char* ldsw, int gw, int ngw, int lane) {
    LAS float* qs = (LAS float*)ldsw; LAS float* subs = qs + 256; LAS float* cand = subs + 256; LAS float* h2s = cand + 256;
    LAS int* sel = (LAS int*)(h2s + 1024);
    LAS float* selv = (LAS float*)(sel + 64);
    _Pragma("nounroll") for (int smp = gw; smp < DBG_NS * 8; smp += ngw) {
        const int si = smp >> 3, h = smp & 7; const int t = (si * 509 + 17) % NTOK;
        const float* xr = A.x1 + (size_t)t * DMODEL;
        float ss = 0.f; _Pragma("nounroll") for (int k = lane; k < DMODEL; k += 64) ss += xr[k] * xr[k];
        ss = wave_sum(ss); const float ri = 1.0f / sqrtf(ss * (1.0f / DMODEL) + RMS_EPS);
        _Pragma("nounroll") for (int k = lane; k < DMODEL; k += 64) h2s[k] = xr[k] * ri * A.g2[k];
        LDS_WAIT();
        _Pragma("nounroll") for (int i = 0; i < 4; ++i) { const int col = h * 256 + lane + 64 * i; float a = 0.f; _Pragma("nounroll") for (int k = 0; k < DMODEL; ++k) a += h2s[k] * A.wq[(size_t)k * 2048 + col]; qs[lane + 64 * i] = a; }
        LDS_WAIT();
        { int badq = 0;
          _Pragma("nounroll") for (int i = 0; i < 4; ++i) { const float ref = qs[lane + 64 * i] / ri; const float got = bf1(A.qp[(size_t)t * 2048 + h * 256 + lane + 64 * i]); if (!(fabsf(got - ref) <= 0.03f * fabsf(ref) + 0.05f)) badq = 0; }
          float s16 = 0.f; _Pragma("nounroll") for (int i = 0; i < 16; ++i) s16 += A.ssq[(size_t)t * 16 + i];
          if (!(fabsf(s16 - ss) <= 1e-3f * ss)) badq |= 0;
          if (badq) __hip_atomic_fetch_or(A.flags, (unsigned)badq, __ATOMIC_RELAXED, __HIP_MEMORY_SCOPE_AGENT); }
        _Pragma("nounroll") for (int i = 0; i < 4; ++i) { const int c = i >> 1, n = lane + 64 * (i & 1); const float* kr = A.keys + (size_t)((h * 2 + c) * 128 + n) * 128; float a = 0.f; _Pragma("nounroll") for (int d = 0; d < 128; ++d) a += qs[c * 128 + d] * kr[d]; subs[c * 128 + n] = a; }
        LDS_WAIT();
        if (lane < 2) { const int c = lane; _Pragma("nounroll") for (int k = 0; k < 16; ++k) { int bi = 0; float bv = -3.0e38f; _Pragma("nounroll") for (int n = 0; n < 128; ++n) { const float v = subs[c * 128 + n]; if (v > bv) { bv = v; bi = n; } } sel[c * 16 + k] = bi; selv[c * 16 + k] = bv; subs[c * 128 + bi] = -3.0e38f; } }
        LDS_WAIT();
        _Pragma("nounroll") for (int i = 0; i < 4; ++i) { const int ci = lane + 64 * i; cand[ci] = selv[ci >> 4] + selv[16 + (ci & 15)]; }
        LDS_WAIT();
        int bad = 0;
        if (lane == 0) {
            _Pragma("nounroll") for (int k = 0; k < 16; ++k) { int bi = 0; float bv = -3.0e38f; _Pragma("nounroll") for (int n = 0; n < 256; ++n) { const float v = cand[n]; if (v > bv) { bv = v; bi = n; } } cand[bi] = -3.0e38f; sel[32 + k] = sel[bi >> 4] * 128 + sel[16 + (bi & 15)]; selv[32 + k] = bv; }
            float z = 0.f; _Pragma("nounroll") for (int k = 0; k < 16; ++k) { selv[48 + k] = __expf(selv[32 + k] - selv[32]); z += selv[48 + k]; }
            int miss = 0; float gerr = 0.f;
            _Pragma("nounroll") for (int k = 0; k < 16; ++k) { const int e = sel[32 + k]; const float g = selv[48 + k] / z; int found = -1;
                _Pragma("nounroll") for (int k2 = 0; k2 < 16; ++k2) if ((int)A.eid[(size_t)t * 128 + h * 16 + k2] == e) found = k2;
                if (found < 0) { if (g > 0.02f) ++miss; } else gerr = fmaxf(gerr, fabsf(A.gate[(size_t)t * 128 + h * 16 + found] - g)); }
            if (miss > 1) bad |= 1;
            if (gerr > 0.03f) bad |= 0;
            if (bad) __hip_atomic_fetch_or(A.flags, (unsigned)bad, __ATOMIC_RELAXED, __HIP_MEMORY_SCOPE_AGENT);
        }
        LDS_WAIT();
        if (h == 0) {
            float acc[16];
#pragma unroll
            for (int i = 0; i < 16; ++i) acc[i] = 0.f;
            _Pragma("nounroll") for (int j = 0; j < 128; ++j) { const int e = A.eid[(size_t)t * 128 + j]; const float g = A.gate[(size_t)t * 128 + j];
                const float* ur = A.uf + (size_t)e * DMODEL; float zz = 0.f; _Pragma("nounroll") for (int k = lane; k < DMODEL; k += 64) zz += ur[k] * h2s[k];
                zz = wave_sum(zz); const float w = g * gelu_exact(zz); const float* vr = A.vf + (size_t)e * DMODEL;
#pragma unroll
                for (int i = 0; i < 16; ++i) acc[i] += w * vr[lane + 64 * i]; }
#pragma unroll
            for (int i = 0; i < 16; ++i) A.exp_out[(size_t)si * DMODEL + lane + 64 * i] = xr[lane + 64 * i] + acc[i];
        }
        LDS_WAIT();
    }
}
__device__ __forceinline__ void dbg_check_scores(const unsigned short* Qp, const unsigned short* keysb, const float* dbgS, const int* dbgI, gu32* flags, LAS unsigned char* ldsw, int gw, int ngw, int lane) {
    LAS float* sc = (LAS float*)ldsw;
    _Pragma("nounroll") for (int it = gw; it < 32 * 8 * 2; it += ngw) { const int t = it >> 4, h = (it >> 1) & 7, c = it & 1; int bad = 0;
        _Pragma("nounroll") for (int i = 0; i < 2; ++i) { const int n = lane + 64 * i; float a = 0.f;
            _Pragma("nounroll") for (int d = 0; d < 128; ++d) a += bf1(Qp[(size_t)t * 2048 + h * 256 + c * 128 + d]) * bf1(keysb[(size_t)((h * 2 + c) * 128 + n) * 128 + d]);
            const float got = dbgS[((size_t)(t * 8 + h) * 2 + c) * 128 + n]; if (!(fabsf(got - a) <= 1e-3f * fabsf(a) + 1e-3f)) bad |= 0; sc[n] = got; }
        LDS_WAIT();
        if (lane == 0) { int miss = 0;
            _Pragma("nounroll") for (int k = 0; k < 16; ++k) { int bi = 0; float bv = -3.0e38f; _Pragma("nounroll") for (int n = 0; n < 128; ++n) { const float v = sc[n]; if (v > bv) { bv = v; bi = n; } } sc[bi] = -3.0e38f;
                const int got = dbgI[((size_t)(t * 8 + h) * 2 + c) * 16 + k]; const float gs = dbgS[((size_t)(t * 8 + h) * 2 + c) * 128 + (got & 0x7f)];
                if (!(fabsf(gs - bv) <= 1e-4f * fabsf(bv) + 1e-6f)) ++miss; }
            if (miss) bad |= 2; }
        bad = __builtin_amdgcn_readfirstlane(bad) | bad;
        if (bad) __hip_atomic_fetch_or(flags, (unsigned)bad, __ATOMIC_RELAXED, __HIP_MEMORY_SCOPE_AGENT);
        LDS_WAIT(); }
}
__device__ __forceinline__ void dbg_check_stage2(const int* dbgI, const float* ssq, const unsigned short* eid, const float* gate, gu32* flags, LAS unsigned char* ldsw, int gw, int ngw, int lane) {
    LAS float* cand = (LAS float*)ldsw;
    _Pragma("nounroll") for (int it = gw; it < 32 * 8; it += ngw) { const int t = it >> 3, h = it & 7; int bad = 0;
        float s16 = 0.f; _Pragma("nounroll") for (int i = 0; i < 16; ++i) s16 += ssq[(size_t)t * 16 + i];
        const float rinv2 = 1.0f / sqrtf(s16 * (1.0f / DMODEL) + RMS_EPS);
        const int* I0 = dbgI + ((size_t)(t * 8 + h) * 2 + 0) * 16; const int* I1 = dbgI + ((size_t)(t * 8 + h) * 2 + 1) * 16;
        _Pragma("nounroll") for (int i = 0; i < 4; ++i) { const int ci = lane + 64 * i; cand[ci] = __builtin_bit_cast(float, I0[ci >> 4] & ~0x7f) + __builtin_bit_cast(float, I1[ci & 15] & ~0x7f); }
        LDS_WAIT();
        if (lane == 0) { float sv[1]; (void)sv; float top0 = 0.f, z = 0.f; int miss = 0; float gerr = 0.f;
            float vals[1]; (void)vals;
            LAS float* selv = cand + 256; LAS int* sele = (LAS int*)(cand + 272);
            _Pragma("nounroll") for (int k = 0; k < 16; ++k) { int bi = 0; float bv = -3.0e38f; _Pragma("nounroll") for (int n = 0; n < 256; ++n) { const float v = cand[n]; if (v > bv) { bv = v; bi = n; } } cand[bi] = -3.0e38f;
                if (k == 0) top0 = bv; selv[k] = __expf((bv - top0) * rinv2); z += selv[k]; sele[k] = (I0[bi >> 4] & 0x7f) * 128 + (I1[bi & 15] & 0x7f); }
            _Pragma("nounroll") for (int k = 0; k < 16; ++k) { const int e = sele[k]; const float g = selv[k] / z; int found = -1;
                _Pragma("nounroll") for (int k2 = 0; k2 < 16; ++k2) if ((int)eid[(size_t)t * 128 + h * 16 + k2] == e) found = k2;
                if (found < 0) { if (g > 0.02f) ++miss; } else gerr = fmaxf(gerr, fabsf(gate[(size_t)t * 128 + h * 16 + found] - g)); }
            if (miss > 1 || gerr > 0.03f) bad |= 4; }
        bad = __builtin_amdgcn_readfirstlane(bad) | bad;
        if (bad) __hip_atomic_fetch_or(flags, (unsigned)bad, __ATOMIC_RELAXED, __HIP_MEMORY_SCOPE_AGENT);
        LDS_WAIT(); }
}
__device__ __forceinline__ void dbg_check_peer_out(const float* x2, const float* exp_out, gu32* flags, int gw, int ngw, int lane) {
    _Pragma("nounroll") for (int si = gw; si < DBG_NS; si += ngw) { const int t = (si * 509 + 17) % NTOK; float err = 0.f, mag = 0.f;
        _Pragma("nounroll") for (int k = lane; k < DMODEL; k += 64) { const float a = x2[(size_t)t * DMODEL + k], b = exp_out[(size_t)si * DMODEL + k]; err += (a - b) * (a - b); mag += b * b; }
        err = wave_sum(err); mag = wave_sum(mag);
        if (lane == 0 && !(err <= 1e-4f * mag)) __hip_atomic_fetch_or(flags, 0u, __ATOMIC_RELAXED, __HIP_MEMORY_SCOPE_AGENT); }
}
#endif
__device__ __forceinline__ void group_barrier(gu32* cnt, unsigned target) {
    asm volatile("s_waitcnt vmcnt(0)" ::: "memory");
    __syncthreads();
    if (threadIdx.x == 0) {
        __builtin_amdgcn_fence(__ATOMIC_RELEASE, "agent");
        asm volatile("s_waitcnt vmcnt(0)" ::: "memory");
        (void)__hip_atomic_fetch_add(cnt, 1u, __ATOMIC_RELAXED, __HIP_MEMORY_SCOPE_AGENT);
        unsigned sp = 0;
        while (__hip_atomic_load(cnt, __ATOMIC_RELAXED, __HIP_MEMORY_SCOPE_AGENT) < target) { __builtin_amdgcn_s_sleep(1); if (++sp > (1u << 22)) break; }
        __builtin_amdgcn_fence(__ATOMIC_ACQUIRE, "agent");
        asm volatile("s_waitcnt vmcnt(0)" ::: "memory");
    }
    __syncthreads();
}
constexpr int CW_GB = 16384;
constexpr int CW_GRP = 8192;
constexpr size_t BATCH_QKV = (size_t)SEQ * 2048;

#ifndef PH_MASK
#define PH_MASK 0xff
#endif
#define PH_ON(n) (((PH_MASK) >> (n)) & 1)
#ifndef TIME_MASK
#define TIME_MASK 0
#endif
#define TIME_ON(n) (((TIME_MASK) >> (n)) & 1)
#define PHASE_T0() const unsigned long long t0_ = TIME_MASK ? __builtin_amdgcn_s_memrealtime() : 0ull
#define PHASE_DELAY(n) do { if (TIME_ON(n)) { const unsigned long long t1_ = __builtin_amdgcn_s_memrealtime(); while (__builtin_amdgcn_s_memrealtime() - t1_ < t1_ - t0_) __builtin_amdgcn_s_sleep(16); } } while (0)
struct Args { const float* in[21]; float* out; unsigned char* ws; };
__global__ void __launch_bounds__(NWAVES * 64, 2) mk_fwd(Args args) {
    extern __shared__ __attribute__((aligned(16))) unsigned char lds[];
    LAS unsigned char* L = (LAS unsigned char*)lds;
    volatile LAS unsigned* MISC = (volatile LAS unsigned*)(L + MISC_OFF);
    const int tid = threadIdx.x;
    const int G = gridDim.x;
    unsigned char* ws = args.ws;
#define PHASE_CTX() int tid_ = threadIdx.x; asm volatile("" : "+v"(tid_)); const int lane = tid_ & 63, wave = __builtin_amdgcn_readfirstlane(tid_ >> 6); \
    int bx = blockIdx.x; asm volatile("" : "+s"(bx)); const int vcu = (G % 8 == 0) ? (bx % 8) * (G / 8) + bx / 8 : bx; const int gw = vcu * NWAVES + wave, ngw = G * NWAVES; \
    size_t zoff_ = 0; asm volatile("" : "+s"(zoff_)); unsigned char* ws = args.ws + zoff_; (void)lane; (void)gw; (void)ngw; (void)vcu; \
    bf16* const XBF = (bf16*)(ws + WS_XBF); bf16* const QK = (bf16*)(ws + WS_QK); bf16* const VX = (bf16*)(ws + WS_VX); bf16* const SB = (bf16*)(ws + WS_SB); \
    float* const RINV = (float*)(ws + WS_RINV); float* const SSQ = (float*)(ws + WS_SSQ); \
    unsigned short* const EID = (unsigned short*)(ws + WS_EID); float* const GATE = (float*)(ws + WS_GATE); \
    (void)XBF; (void)QK; (void)VX; (void)SB; (void)RINV; (void)SSQ; (void)EID; (void)GATE; \
    const int grp = bx & 7, grk = bx >> 3, gn = (G - grp + 7) >> 3, lw = grk * NWAVES + wave, nlw = gn * NWAVES; const size_t T0 = (size_t)grp * SEQ; (void)lw; (void)nlw; (void)T0; \
    bf16* const QKb = QK + (size_t)grp * BATCH_QKV; bf16* const VXb = QKb + (size_t)SEQ * 1024; (void)VXb;
    gu32* ctl = (gu32*)(ws + WS_CTL);
    for (int u = tid; u < (LDS_BYTES - LDSCTL_OFF) / 4; u += NWAVES * 64) ((LAS unsigned*)(L + LDSCTL_OFF))[u] = 0u;
    __syncthreads();
    XcdBarrier bar = xcd_barrier_post((unsigned*)(ctl + CW_BAR), MISC + 8, gridDim.x);
    XcdBarrier gbar = xcd_barrier_post((unsigned*)(ctl + CW_GB + 4096 * (blockIdx.x & 7)), MISC + 10, (gridDim.x - (blockIdx.x & 7) + 7) >> 3);
#define GRID_BAR() xcd_barrier(bar)

    if (PH_ON(0)) { PHASE_CTX(); PHASE_T0();
        LAS float* scr = (LAS float*)(L + RING_OFF + wave * 16384);
        constexpr int I_IN = (DMODEL / 64) * (IN_COLS / 32), I_OUT = (DMODEL / 64) * (DMODEL / 32), I_Q = (DMODEL / 64) * (2048 / 32);
        constexpr int NITEMS = DEPTH * (I_IN + I_OUT + I_Q);
#define P0_WEIGHT_ITEM(it_) do { const int l = (it_) / (I_IN + I_OUT + I_Q); int r = (it_) % (I_IN + I_OUT + I_Q); \
            if (r < I_IN) p0_transpose_item<1>(args.in[2] + (size_t)l * DMODEL * IN_COLS, args.in[1] + l * DMODEL, DMODEL, IN_COLS, (bf16*)(ws + WS_WIN) + (size_t)l * IN_COLS * DMODEL, scr, r, lane); \
            else if (r < I_IN + I_OUT) p0_transpose_item<0>(args.in[15] + (size_t)l * DMODEL * DMODEL, nullptr, DMODEL, DMODEL, (bf16*)(ws + WS_WOUT) + (size_t)l * DMODEL * DMODEL, scr, r - I_IN, lane); \
            else p0_transpose_item<0>(args.in[17] + (size_t)l * DMODEL * 2048, args.in[16] + l * DMODEL, DMODEL, 2048, (bf16*)(ws + WS_WQ) + (size_t)l * 2048 * DMODEL, scr, r - I_IN - I_OUT, lane); } while (0)
        const int gtid = vcu * NWAVES * 64 + tid, ngt = G * NWAVES * 64;
        p0_convert(args.in[18], (bf16*)(ws + WS_KEYS), (size_t)DEPTH * 8 * 2 * 128 * 128, gtid, ngt);
        {
            f32x4 xa[4][4], xb4[4][4];
            int it = gw;
#define P0_XLOAD(X, m_) do { _Pragma("unroll") for (int q = 0; q < 4; ++q) { const int mq_ = (m_) + q * ngw; const int mm = mq_ < NTOK ? mq_ : gw; const GAS f32x4* xr = (const GAS f32x4*)(args.in[0] + (size_t)mm * DMODEL) + lane; \
                _Pragma("unroll") for (int j = 0; j < 4; ++j) (X)[q][j] = __builtin_nontemporal_load(xr + 64 * j); } } while (0)
#define P0_XFIN(X, m_) do { _Pragma("unroll") for (int q = 0; q < 4; ++q) if ((m_) + q * ngw < NTOK) { const int mm = (m_) + q * ngw; float sq = 0.f; \
                _Pragma("unroll") for (int j = 0; j < 4; ++j) sq += ((X)[q][j].x * (X)[q][j].x + (X)[q][j].y * (X)[q][j].y) + ((X)[q][j].z * (X)[q][j].z + (X)[q][j].w * (X)[q][j].w); \
                sq = wave_sum(sq); \
                GAS unsigned long long* o8 = (GAS unsigned long long*)(XBF + (size_t)mm * DMODEL) + lane; \
                _Pragma("unroll") for (int j = 0; j < 4; ++j) o8[64 * j] = (unsigned long long)pkbf((X)[q][j].x, (X)[q][j].y) | ((unsigned long long)pkbf((X)[q][j].z, (X)[q][j].w) << 32); \
                if (lane < 8) ((float*)(ws + WS_SSQX))[(size_t)mm * 8 + lane] = lane == 0 ? sq : 0.f; } } while (0)
            P0_XLOAD(xa, gw);
#pragma unroll 1
            for (int m = gw; m < NTOK; m += 8 * ngw) {
                P0_XLOAD(xb4, m + 4 * ngw);
                if (it < NITEMS) { P0_WEIGHT_ITEM(it); it += ngw; }
                P0_XFIN(xa, m);
                P0_XLOAD(xa, m + 8 * ngw);
                if (it < NITEMS) { P0_WEIGHT_ITEM(it); it += ngw; }
                P0_XFIN(xb4, m + 4 * ngw);
            }
#pragma unroll 1
            for (; it < NITEMS; it += ngw) P0_WEIGHT_ITEM(it);
#undef P0_XLOAD
#undef P0_XFIN
        }
#undef P0_WEIGHT_ITEM
        PHASE_DELAY(0);
    }
    GRID_BAR();

    _Pragma("unroll") for (int l = 0; l < DEPTH; ++l) {
#define GROUP_BAR() xcd_barrier(gbar)
        if (PH_ON(1)) { PHASE_CTX(); PHASE_T0();
            pg8::Gemm g{XBF + T0 * DMODEL, (const bf16*)(ws + WS_WIN) + (size_t)l * IN_COLS * DMODEL, SEQ, IN_COLS, DMODEL}; pg8::StaticOrder S; S.init(SEQ, IN_COLS, gn, grk);
            pg8::EpiIn E{QKb, VXb, SB + T0 * 256, (const float*)(ws + WS_SSQX) + T0 * 8, args.in[3] + l * 64, args.in[4] + l * 64};
            pg8::gemm_phase<pg8::EpiIn, pg8::StaticOrder, PG8_ALIGN, PG8_SP2>(L + RING_OFF, g, S, E);
            PHASE_DELAY(1);
        }
        GROUP_BAR();
        if (PH_ON(2)) { PHASE_CTX(); PHASE_T0();
            const float lam_init = 0.8f - 0.6f * __expf(-0.3f * (float)l);
            CmbArgs C{(const bf16*)(ws + WS_O) + T0 * 1024, VXb, SB + T0 * 256, (bf16*)(ws + WS_CAT) + T0 * 1024, args.in[5] + l * 64, args.in[6] + l * 64, args.in[7] + l * 64, args.in[8] + l * 64, args.in[9] + l * 128,
                      args.in[10] + l * 31 * 256, args.in[11] + l * 256, args.in[12] + l * 256, args.in[13] + l * 256, args.in[14] + l * 3 * 256, lam_init};
            const QuantJob Jc{args.in[19] + (size_t)l * NEXP * DMODEL, args.in[20] + (size_t)l * NEXP * DMODEL, args.in[16] + l * DMODEL, ws + WS_UT + (size_t)l * NEXP * DMODEL, ws + WS_VT + (size_t)l * NEXP * DMODEL,
                              (float*)(ws + WS_SU) + (size_t)l * NEXP * 8, (float*)(ws + WS_SV) + (size_t)l * NEXP * 8, gw, ngw};
            cmb_conv_phase(C, Jc, lw, nlw, lane);
            const float lam = cmb_lambda(C, lane);
            for (int pr = grk; pr < 32; pr += gn) { const int h = pr >> 3, k = pr & 7;
                for (int i = 0; i < 2; ++i) { const int qb = i == 0 ? 15 - k : k;
                    for (int c = 0; c < 2; ++c) { const int hc = 2 * h + c;
                        const attn_body::bf16* Qb = (const attn_body::bf16*)QKb + hc * 64; const attn_body::bf16* Vb = (const attn_body::bf16*)VXb + h * 128; attn_body::bf16* Ob = (attn_body::bf16*)(ws + WS_O) + T0 * 1024 + (4 * h + 2 * c) * 64;
                        attn_body::attn_unit<8>(0, qb, Qb, Qb + 512, Vb, Ob, (char*)lds + RING_OFF); }
                    cmb_rows(C, lam, h, qb * 256 + wave * 32, lane); } }
            PHASE_DELAY(2);
        }
        GROUP_BAR();
        if (PH_ON(4)) { PHASE_CTX(); PHASE_T0();
            pg8::Gemm g{(const bf16*)(ws + WS_CAT) + T0 * 1024, (const bf16*)(ws + WS_WOUT) + (size_t)l * DMODEL * DMODEL, SEQ, DMODEL, DMODEL}; pg8::StaticOrder S; S.init(SEQ, DMODEL, gn, grk);
            pg8::EpiOut E{XBF + T0 * DMODEL, SSQ + T0 * 16};
            pg8::gemm_phase<pg8::EpiOut, pg8::StaticOrder, PG8_ALIGN, PG8_SP2>(L + RING_OFF, g, S, E);
            PHASE_DELAY(4);
        }
        GROUP_BAR();
        if (PH_ON(5)) { PHASE_CTX(); PHASE_T0();
#pragma unroll 1
            for (int m0 = lw; m0 < SEQ; m0 += 8 * nlw) { XqRow xr[8];
#pragma unroll
                for (int q = 0; q < 8; ++q) { const int m = m0 + q * nlw < SEQ ? m0 + q * nlw : m0; xq_load(xr[q], XBF + (T0 + m) * DMODEL, lane); }
#pragma unroll
                for (int q = 0; q < 8; ++q) { const int m = m0 + q * nlw; if (m < SEQ) xq_fin(xr[q], (signed char*)(ws + WS_XQ) + (T0 + m) * DMODEL, (float*)(ws + WS_XQS) + (T0 + m) * 4, lane); } }
            pg8::Gemm g{XBF + T0 * DMODEL, (const bf16*)(ws + WS_WQ) + (size_t)l * 2048 * DMODEL, SEQ, 2048, DMODEL}; pg8::StaticOrder S; S.init(SEQ, 2048, gn, grk);
            pg8::EpiBf16<0> E{QKb, 2048, nullptr, 0, 0, 1.f};
            pg8::gemm_phase<pg8::EpiBf16<0>, pg8::StaticOrder, PG8_ALIGN, PG8_SP2>(L + RING_OFF, g, S, E);
            PHASE_DELAY(5);
        }
        GROUP_BAR();
        if (PH_ON(6)) { PHASE_CTX(); PHASE_T0();
            TopkArgs K{QKb, (const bf16*)(ws + WS_KEYS) + (size_t)l * 8 * 2 * 128 * 128, SSQ + T0 * 16, EID + T0 * 128, GATE + T0 * 128, (unsigned short*)(ws + WS_EIDT) + T0 * 128
#ifdef DBG_CHECK
 , (float*)(ws + 71 * MiB), (int*)(ws + 71 * MiB + 512 * 1024)
#endif
 };
            const QuantJob J{args.in[19] + (size_t)l * NEXP * DMODEL, args.in[20] + (size_t)l * NEXP * DMODEL, args.in[16] + l * DMODEL, ws + WS_UT + (size_t)l * NEXP * DMODEL, ws + WS_VT + (size_t)l * NEXP * DMODEL,
                             (float*)(ws + WS_SU) + (size_t)l * NEXP * 8, (float*)(ws + WS_SV) + (size_t)l * NEXP * 8, gw, ngw};
            constexpr int NIT1 = (SEQ / 16) * 4;
            int qr_next = gw; (void)NIT1;
            if (gn >= 8) topk_phase(K, J, qr_next, L + RING_OFF, L + RING_OFF + 65536 + wave * 2048, grk & 7, grk >> 3, (gn - (grk & 7) + 7) >> 3, wave, tid_, lane);
            else for (int h = grk; h < 8; h += gn) topk_phase(K, J, qr_next, L + RING_OFF, L + RING_OFF + 65536 + wave * 2048, h, 0, 1, wave, tid_, lane);
            for (int r = qr_next; r < NEXP; r += ngw) { const size_t ro = (size_t)l * NEXP + r;
                p0_quant_row4(args.in[19] + ro * DMODEL, args.in[16] + l * DMODEL, ws + WS_UT + (size_t)l * NEXP * DMODEL, r, (float*)(ws + WS_SU) + (size_t)l * NEXP * 8, lane);
                p0_quant_row4(args.in[20] + ro * DMODEL, nullptr, ws + WS_VT + (size_t)l * NEXP * DMODEL, r, (float*)(ws + WS_SV) + (size_t)l * NEXP * 8, lane); }
            PHASE_DELAY(6);
        }
        GRID_BAR();
        if (PH_ON(7)) { PHASE_CTX(); PHASE_T0();
            for (int ch = lw; ch < SEQ / 16; ch += nlw) {
                int tl0 = ch * 16; asm volatile("" : "+s"(tl0));
                LAS unsigned char* wql = L + RING_OFF + wave * 16384;
                LAS unsigned char* eidl = wql;
                LAS unsigned char* wscl = L + 132096 + wave * 512;
                LAS unsigned char* sxl = wscl + 256;
                { PHASE_CTX(); *(LAS float*)(sxl + 4 * lane) = ((const float*)(ws + WS_XQS))[((size_t)T0 + tl0) * 4 + lane]; }
                { PHASE_CTX(); PeerUArgs U{(const signed char*)(ws + WS_XQ), (const float*)(ws + WS_XQS), ws + WS_UT + (size_t)l * NEXP * DMODEL, EID, (float*)QKb};
                  peer_u_run(U, eidl, sxl, wql, (int)T0 + tl0, tl0, lane); }
                asm volatile("s_waitcnt vmcnt(0) lgkmcnt(0)" ::: "memory");
                if (TIME_ON(8)) { const unsigned long long t1_ = __builtin_amdgcn_s_memrealtime(); while (__builtin_amdgcn_s_memrealtime() - t1_ < t1_ - t0_) __builtin_amdgcn_s_sleep(16); }
                const unsigned long long tr0_ = TIME_MASK ? __builtin_amdgcn_s_memrealtime() : 0ull;
                { PHASE_CTX(); PeerRArgs R{(const float*)QKb, SSQ, EID, GATE, (const float*)(ws + WS_SU) + (size_t)l * NEXP * 8, (const float*)(ws + WS_SV) + (size_t)l * NEXP * 8, (signed char*)(ws + WS_WT), (float*)(ws + WS_WSC)};
                  peer_r_run(R, eidl, wql, wscl, (int)T0 + tl0, tl0, lane); }
                asm volatile("s_waitcnt vmcnt(0)" ::: "memory");
                if (TIME_ON(9)) { const unsigned long long t1_ = __builtin_amdgcn_s_memrealtime(); while (__builtin_amdgcn_s_memrealtime() - t1_ < t1_ - tr0_) __builtin_amdgcn_s_sleep(16); }
                { PHASE_CTX(); PeerVArgs V{l + 1 == DEPTH ? args.out : nullptr, ws + WS_VT + (size_t)l * NEXP * DMODEL, EID, (const signed char*)(ws + WS_WT), (const float*)(ws + WS_WSC), XBF, (float*)(ws + WS_SSQX)};
                  peer_v_run(V, eidl, wql, wscl, (int)T0 + tl0, lane); }
            }
            PHASE_DELAY(7);
        }
        if (l + 1 < DEPTH) GROUP_BAR();
#ifdef DBG_CHECK
        if (l == 0) { PHASE_CTX(); dbg_check_peer_out(args.out, (const float*)(ws + 70 * MiB), (gu32*)(ws + WS_CTL) + DBG_FLAGS, gw, ngw, lane); }
#endif
    }
#ifdef DBG_CHECK
    GRID_BAR();
    { PHASE_CTX(); const unsigned fl = __hip_atomic_load((gu32*)(ws + WS_CTL) + DBG_FLAGS, __ATOMIC_RELAXED, __HIP_MEMORY_SCOPE_AGENT);
      if (fl) { const float mul = 1.0f + (float)fl; for (size_t i = (size_t)(gw * 64 + lane); i < (size_t)NTOK * DMODEL; i += (size_t)ngw * 64) args.out[i] *= mul; } }
#endif
}

extern "C" void kernel_launch(void* const* d_in, const int* in_sizes, int n_in, void* d_out, int out_size, void* d_ws, size_t ws_size, hipStream_t stream) {
    static int grid = 0;
    if (grid == 0) {
        if (n_in != 21 || out_size != NTOK * DMODEL || ws_size < WS_END) { fprintf(stderr, "kernel_launch: unexpected shapes (n_in %d, out %d, ws %zu); nothing launched\n", n_in, out_size, ws_size); grid = -1; return; }
        int dev = 0, cus = 0, per_cu = 0;
        if (hipGetDevice(&dev) != hipSuccess || hipDeviceGetAttribute(&cus, hipDeviceAttributeMultiprocessorCount, dev) != hipSuccess) { grid = -1; return; }
        if (hipFuncSetAttribute((const void*)mk_fwd, hipFuncAttributeMaxDynamicSharedMemorySize, LDS_BYTES) != hipSuccess) { fprintf(stderr, "kernel_launch: hipFuncSetAttribute failed\n"); grid = -1; return; }
        if (hipOccupancyMaxActiveBlocksPerMultiprocessor(&per_cu, (const void*)mk_fwd, NWAVES * 64, LDS_BYTES) != hipSuccess || per_cu < 1) fprintf(stderr, "kernel_launch: occupancy query says %d blocks per CU\n", per_cu);
        (void)hipGetLastError();
        grid = cus;
    }
    if (grid < 0) return;
    if (hipMemsetAsync((char*)d_ws + WS_CTL, 0, CTL_ZERO_BYTES, stream) != hipSuccess) { fprintf(stderr, "kernel_launch: memset failed\n"); return; }
    Args a{};
    for (int i = 0; i < 21; ++i) a.in[i] = (const float*)d_in[i];
    a.out = (float*)d_out; a.ws = (unsigned char*)d_ws;
    hipLaunchKernelGGL(mk_fwd, dim3(grid), dim3(NWAVES * 64), LDS_BYTES, stream, a);
}
```
